# Optimizing an MI355X kernel written in HIP

```python
import jax
import jax.numpy as jnp
from jax import lax
import numpy as np

D_MODEL = 1024
BATCH = 2
SEQ = 16384
DEPTH = 4

GRID_W = 64
CTX_LEN = 256
HEAD_DIM = 64
SCALE = HEAD_DIM ** -0.5
ROPE_HALF = HEAD_DIM // 2
ROPE_FREQS = HEAD_DIM // 4
ROPE_THETA = 10000.0
Q_BLOCK = 128
A_HEADS = 8
A_KV_HEADS = 2
B_HEADS = 8
B_KV_HEADS = 2
WINDOW = 128
C_HEADS = 8
NA_ROWS = 8
NA_COLS = 16
D_HEADS = 8
DECAY_LORA = 64
ICLR_LORA = 64
GATE_LORA = 128
GN_EPS = 64e-5
RMS_EPS = 1e-6
NEG_INF = -1e30
FFN_HIDDEN = -(-8 * D_MODEL // (3 * 256)) * 256

A_Q = A_HEADS * HEAD_DIM
A_KV = A_KV_HEADS * HEAD_DIM
B_Q = B_HEADS * HEAD_DIM
B_KV = B_KV_HEADS * HEAD_DIM
C_W = C_HEADS * HEAD_DIM
D_W = D_HEADS * HEAD_DIM
EVEN_WIDTHS = (A_Q, A_KV, A_KV, B_Q, B_KV, B_KV)
EVEN_IN = A_Q + 2 * A_KV + B_Q + 2 * B_KV
EVEN_MIX = A_Q + B_Q
D_SHIFT_W = 3 * D_W + DECAY_LORA + ICLR_LORA + GATE_LORA
ODD_IN = 3 * C_W + D_SHIFT_W
ODD_MIX = C_W + D_W
N_EVEN = (DEPTH + 1) // 2
N_ODD = DEPTH // 2

kernel_name = "hybrid_axialgqa_swa_natten_rwkv7_dit"


def _split(t, widths):
    return jnp.split(t, [int(o) for o in np.cumsum(widths)[:-1]], axis=-1)


def rms_norm(t, gain):
    tf = t.astype(jnp.float32)
    tf = tf * lax.rsqrt(jnp.mean(tf * tf, axis=-1, keepdims=True) + RMS_EPS)
    return (tf * gain.astype(jnp.float32)).astype(t.dtype)


def modulate(t, shift, scale):
    return t * (1 + scale) + shift


def heads(t, n):
    return t.reshape(t.shape[:-1] + (n, HEAD_DIM))


def group(q, n_kv):
    return q.reshape(q.shape[:2] + (n_kv, q.shape[2] // n_kv, HEAD_DIM))


def axial_rope_tables(n_tokens):
    t = jnp.arange(n_tokens, dtype=jnp.int32)
    row = (t // GRID_W).astype(jnp.float32)
    col = (t % GRID_W).astype(jnp.float32)
    inv = ROPE_THETA ** (-jnp.arange(ROPE_FREQS, dtype=jnp.float32) / ROPE_FREQS)
    ang = jnp.concatenate([row[:, None] * inv, col[:, None] * inv], axis=-1)
    return jnp.cos(ang), jnp.sin(ang)


def apply_rope(t, cos, sin):
    c = cos[None, :, None, :].astype(t.dtype)
    s = sin[None, :, None, :].astype(t.dtype)
    t1, t2 = t[..., :ROPE_HALF], t[..., ROPE_HALF:]
    return jnp.concatenate([t1 * c - t2 * s, t1 * s + t2 * c], axis=-1)


def _sink_column(sink, shape):
    col = sink.astype(jnp.float32).reshape(1, shape[1], shape[2], 1, 1)
    return jnp.broadcast_to(col, shape[:-1] + (1,))


def dense_attention(q, k, v, sink=None):
    B, L, HKV, G, _ = q.shape
    n = k.shape[1]
    s = jnp.einsum('bqkgd,bnkd->bkgqn', q, k, preferred_element_type=jnp.float32) * SCALE
    if sink is not None:
        s = jnp.concatenate([s, _sink_column(sink, s.shape)], axis=-1)
    p = jax.nn.softmax(s, axis=-1)[..., :n].astype(v.dtype)
    return jnp.einsum('bkgqn,bnkd->bqkgd', p, v).reshape(B, L, HKV * G * HEAD_DIM)


def global_attention(q, k, v, kc, vc):
    B, S, HKV, G, _ = q.shape
    nblk = S // Q_BLOCK
    keys = jnp.concatenate([k, kc], axis=1)
    vals = jnp.concatenate([v, vc], axis=1)
    qb = jnp.moveaxis(q.reshape(B, nblk, Q_BLOCK, HKV, G, HEAD_DIM), 1, 0)

    def block(qblk):
        s = jnp.einsum('bqkgd,bnkd->bkgqn', qblk, keys, preferred_element_type=jnp.float32) * SCALE
        p = jax.nn.softmax(s, axis=-1).astype(vals.dtype)
        return jnp.einsum('bkgqn,bnkd->bqkgd', p, vals)

    o = lax.map(block, qb)
    return jnp.moveaxis(o, 0, 1).reshape(B, S, HKV * G * HEAD_DIM)


def window_attention(q, k, v, kc, vc, sink):
    B, S, HKV, G, _ = q.shape
    nblk = S // Q_BLOCK
    span = Q_BLOCK + 2 * WINDOW
    n_ctx = kc.shape[1]
    pad = ((0, 0), (WINDOW, WINDOW), (0, 0), (0, 0))
    kp, vp = jnp.pad(k, pad), jnp.pad(v, pad)
    qb = jnp.moveaxis(q.reshape(B, nblk, Q_BLOCK, HKV, G, HEAD_DIM), 1, 0)
    qi = jnp.arange(Q_BLOCK)[:, None]
    kj = jnp.arange(span)[None, :]
    band = jnp.abs(kj - WINDOW - qi) <= WINDOW

    def block(args):
        qblk, start = args
        ks = lax.dynamic_slice_in_dim(kp, start, span, axis=1)
        vs = lax.dynamic_slice_in_dim(vp, start, span, axis=1)
        pos = start - WINDOW + kj
        valid = band & (pos >= 0) & (pos < S)
        s_loc = jnp.einsum('bqkgd,bnkd->bkgqn', qblk, ks, preferred_element_type=jnp.float32) * SCALE
        s_loc = jnp.where(valid, s_loc, NEG_INF)
        s_ctx = jnp.einsum('bqkgd,bnkd->bkgqn', qblk, kc, preferred_element_type=jnp.float32) * SCALE
        s = jnp.concatenate([s_loc, s_ctx, _sink_column(sink, s_loc.shape)], axis=-1)
        p = jax.nn.softmax(s, axis=-1).astype(v.dtype)
        return (jnp.einsum('bkgqn,bnkd->bqkgd', p[..., :span], vs)
                + jnp.einsum('bkgqn,bnkd->bqkgd', p[..., span:span + n_ctx], vc))

    o = lax.map(block, (qb, jnp.arange(nblk) * Q_BLOCK))
    return jnp.moveaxis(o, 0, 1).reshape(B, S, HKV * G * HEAD_DIM)


def neighborhood_attention(q, k, v, kc, vc, rpb):
    B, S, H, _ = q.shape
    rows = S // GRID_W
    kr = min(NA_ROWS, rows)
    n_loc = kr * NA_COLS
    qg = jnp.moveaxis(q.reshape(B, rows, GRID_W, H, HEAD_DIM), 1, 0)
    kg = k.reshape(B, rows, GRID_W, H, HEAD_DIM)
    vg = v.reshape(B, rows, GRID_W, H, HEAD_DIM)
    col = jnp.arange(GRID_W)
    col_idx = jnp.clip(col - NA_COLS // 2, 0, GRID_W - NA_COLS)[:, None] + jnp.arange(NA_COLS)[None, :]
    dcol = col_idx - col[:, None] + NA_COLS - 1
    row_start = jnp.clip(jnp.arange(rows) - kr // 2, 0, rows - kr)

    def block(args):
        q_row, r, rs = args
        ks = lax.dynamic_slice_in_dim(kg, rs, kr, axis=1)[:, :, col_idx]
        vs = lax.dynamic_slice_in_dim(vg, rs, kr, axis=1)[:, :, col_idx]
        drow = rs + jnp.arange(kr) - r + NA_ROWS - 1
        bias = rpb[:, drow[None, :, None], dcol[:, None, :]].astype(jnp.float32)
        s_loc = jnp.einsum('bchd,bicjhd->bhcij', q_row, ks, preferred_element_type=jnp.float32) * SCALE + bias
        s_ctx = jnp.einsum('bchd,bnhd->bhcn', q_row, kc, preferred_element_type=jnp.float32) * SCALE
        s = jnp.concatenate([s_loc.reshape(B, H, GRID_W, n_loc), s_ctx], axis=-1)
        p = jax.nn.softmax(s, axis=-1).astype(v.dtype)
        p_loc = p[..., :n_loc].reshape(B, H, GRID_W, kr, NA_COLS)
        return (jnp.einsum('bhcij,bicjhd->bchd', p_loc, vs)
                + jnp.einsum('bhcn,bnhd->bchd', p[..., n_loc:], vc))

    o = lax.map(block, (qg, jnp.arange(rows), row_start))
    return jnp.moveaxis(o, 0, 1).reshape(B, S, H * HEAD_DIM)


def centred_shift_mix(z, mu):
    zp = jnp.pad(z, ((0, 0), (1, 1), (0, 0)))
    return z + (0.5 * (zp[:, :-2] + zp[:, 2:]) - z) * mu


def rwkv7_inputs(zd, w0, w2, a0, a2, g2, k_k, k_a):
    r, k, v, wd, ad, gd = _split(zd, (D_W, D_W, D_W, DECAY_LORA, ICLR_LORA, GATE_LORA))
    g = jax.nn.sigmoid(gd) @ g2
    kk = heads(k * k_k, D_HEADS).astype(jnp.float32)
    kk = kk / jnp.maximum(jnp.sqrt(jnp.sum(kk * kk, axis=-1, keepdims=True)), 1e-12)
    decay, kd, av = [], [], []
    for d in range(2):
        w = -jax.nn.softplus(-(w0[d] + jnp.tanh(wd) @ w2[d])) - 0.5
        a = jax.nn.sigmoid(a0[d] + ad @ a2[d])
        decay.append(heads(jnp.exp(-jnp.exp(w.astype(jnp.float32))), D_HEADS))
        kd.append(heads(k * (1 + (a - 1) * k_a), D_HEADS))
        av.append(heads(a, D_HEADS))
    return {"r": heads(r, D_HEADS), "v": heads(v, D_HEADS), "kk": kk, "g": g,
            "decay": decay, "k": kd, "a": av}


def wkv7_scan(state0, p, d, reverse, emit):
    seq = [p["decay"][d], p["k"][d], p["v"], p["kk"], p["a"][d]] + ([p["r"]] if emit else [])
    xs = tuple(jnp.moveaxis(t.astype(jnp.float32), 1, 0) for t in seq)

    def step(S, inp):
        w_t, k_t, v_t, kk_t, a_t = inp[:5]
        sa = jnp.einsum('bhvk,bhk->bhv', S, kk_t)
        S = (S * w_t[:, :, None, :] - sa[..., None] * (kk_t * a_t)[:, :, None, :]
             + v_t[..., None] * k_t[:, :, None, :])
        return S, (jnp.einsum('bhvk,bhk->bhv', S, inp[5]) if emit else None)

    S, ys = lax.scan(step, state0, xs, reverse=reverse)
    return S, (jnp.moveaxis(ys, 0, 1) if emit else None)


def rwkv7_readout(y, p, r_k, ln_w, ln_b):
    B, L, H, N = y.shape
    mean = jnp.mean(y, axis=-1, keepdims=True)
    var = jnp.mean(jnp.square(y - mean), axis=-1, keepdims=True)
    yn = ((y - mean) * lax.rsqrt(var + GN_EPS)).reshape(B, L, H * N)
    yn = yn * ln_w.astype(jnp.float32) + ln_b.astype(jnp.float32)
    r = p["r"].astype(jnp.float32)
    ksum = (p["k"][0] + p["k"][1]).astype(jnp.float32)
    bonus = jnp.sum(r * ksum * r_k.astype(jnp.float32), axis=-1, keepdims=True) * p["v"].astype(jnp.float32)
    return (yn + bonus.reshape(B, L, H * N)) * p["g"].astype(jnp.float32)


def even_mixer(h, hc, w_in, w_out, q_gain, k_gain, sink, cos, sin, need_ctx):
    qa, ka, va, qb, kb, vb = _split(h @ w_in, EVEN_WIDTHS)
    qca, kca, vca, qcb, kcb, vcb = _split(hc @ w_in, EVEN_WIDTHS)
    qa = apply_rope(rms_norm(heads(qa, A_HEADS), q_gain), cos, sin)
    ka = apply_rope(rms_norm(heads(ka, A_KV_HEADS), k_gain), cos, sin)
    kca = rms_norm(heads(kca, A_KV_HEADS), k_gain)
    va, vca = heads(va, A_KV_HEADS), heads(vca, A_KV_HEADS)
    qb = apply_rope(heads(qb, B_HEADS), cos, sin)
    kb = apply_rope(heads(kb, B_KV_HEADS), cos, sin)
    kcb, vb, vcb = heads(kcb, B_KV_HEADS), heads(vb, B_KV_HEADS), heads(vcb, B_KV_HEADS)
    y_a = global_attention(group(qa, A_KV_HEADS), ka, va, kca, vca)
    y_b = window_attention(group(qb, B_KV_HEADS), kb, vb, kcb, vcb, sink)
    y = jnp.concatenate([y_a, y_b], axis=-1) @ w_out
    if not need_ctx:
        return y, None
    qca = rms_norm(heads(qca, A_HEADS), q_gain)
    yc_a = dense_attention(group(qca, A_KV_HEADS), kca, vca)
    yc_b = dense_attention(group(heads(qcb, B_HEADS), B_KV_HEADS), kcb, vcb, sink)
    return y, jnp.concatenate([yc_a, yc_b], axis=-1) @ w_out


def odd_mixer(h, hc, w_in, w_out, rpb, mu, w0, w2, a0, a2, g2, k_k, k_a, r_k, ln_w, ln_b, need_ctx):
    q, k, v, zd = _split(h @ w_in, (C_W, C_W, C_W, D_SHIFT_W))
    qc, kc, vc, zdc = _split(hc @ w_in, (C_W, C_W, C_W, D_SHIFT_W))
    kc, vc = heads(kc, C_HEADS), heads(vc, C_HEADS)
    y_c = neighborhood_attention(heads(q, C_HEADS), heads(k, C_HEADS), heads(v, C_HEADS), kc, vc, rpb)
    lat = rwkv7_inputs(centred_shift_mix(zd, mu), w0, w2, a0, a2, g2, k_k, k_a)
    cx = rwkv7_inputs(centred_shift_mix(zdc, mu), w0, w2, a0, a2, g2, k_k, k_a)
    zero = jnp.zeros((h.shape[0], D_HEADS, HEAD_DIM, HEAD_DIM), jnp.float32)
    s_fwd, yc_fwd = wkv7_scan(zero, cx, 0, False, need_ctx)
    s_bwd, yc_bwd = wkv7_scan(zero, cx, 1, True, need_ctx)
    _, y_fwd = wkv7_scan(s_fwd, lat, 0, False, True)
    _, y_bwd = wkv7_scan(s_bwd, lat, 1, True, True)
    y_d = rwkv7_readout(y_fwd + y_bwd, lat, r_k, ln_w, ln_b).astype(h.dtype)
    y = jnp.concatenate([y_c, y_d], axis=-1) @ w_out
    if not need_ctx:
        return y, None
    yc_c = dense_attention(heads(qc, C_HEADS)[:, :, :, None], kc, vc)
    yc_d = rwkv7_readout(yc_fwd + yc_bwd, cx, r_k, ln_w, ln_b).astype(hc.dtype)
    return y, jnp.concatenate([yc_c, yc_d], axis=-1) @ w_out


def swiglu(h, w_in, w_out):
    gate, up = jnp.split(h @ w_in, 2, axis=-1)
    return (jax.nn.silu(gate) * up) @ w_out


def setup_inputs(seed: int = 0) -> dict:
    key = jax.random.key(seed)
    ks = iter(jax.random.split(key, 40))

    def nrm(shape, scale):
        return scale * jax.random.normal(next(ks), shape, jnp.float32)

    D = D_MODEL
    return {
        "x": nrm((BATCH, SEQ, D), 1.0),
        "c": nrm((BATCH, D), 1.0),
        "ctx": nrm((BATCH, CTX_LEN, D), 1.0),
        "c_ctx": nrm((D,), 1.0),
        "w_mod": nrm((DEPTH, D, 6 * D), 0.5 * D ** -0.5),
        "b_mod": nrm((DEPTH, 6 * D), 0.02),
        "norm_mix": 1.0 + nrm((DEPTH, D), 0.02),
        "norm_ffn": 1.0 + nrm((DEPTH, D), 0.02),
        "w_in_even": nrm((N_EVEN, D, EVEN_IN), D ** -0.5),
        "w_out_even": nrm((N_EVEN, EVEN_MIX, D), EVEN_MIX ** -0.5),
        "q_norm_a": 1.0 + nrm((N_EVEN, HEAD_DIM), 0.02),
        "k_norm_a": 1.0 + nrm((N_EVEN, HEAD_DIM), 0.02),
        "sink_b": nrm((N_EVEN, B_HEADS), 0.5),
        "w_in_odd": nrm((N_ODD, D, ODD_IN), D ** -0.5),
        "w_out_odd": nrm((N_ODD, ODD_MIX, D), ODD_MIX ** -0.5),
        "rpb_c": nrm((N_ODD, C_HEADS, 2 * NA_ROWS - 1, 2 * NA_COLS - 1), 0.2),
        "shift_mu": jax.random.uniform(next(ks), (N_ODD, D_SHIFT_W), jnp.float32),
        "decay_w0": -1.0 + nrm((N_ODD, 2, D_W), 0.3),
        "decay_w2": nrm((N_ODD, 2, DECAY_LORA, D_W), 0.1),
        "iclr_a0": nrm((N_ODD, 2, D_W), 0.3),
        "iclr_a2": nrm((N_ODD, 2, ICLR_LORA, D_W), 0.1),
        "gate_g2": nrm((N_ODD, GATE_LORA, D_W), GATE_LORA ** -0.5),
        "k_k": 0.85 + nrm((N_ODD, D_W), 0.05),
        "k_a": 1.0 + nrm((N_ODD, D_W), 0.05),
        "r_k": nrm((N_ODD, D_HEADS, HEAD_DIM), 0.1),
        "ln_x_w": 1.0 + nrm((N_ODD, D_W), 0.02),
        "ln_x_b": nrm((N_ODD, D_W), 0.02),
        "w_ffn_in": nrm((DEPTH, D, 2 * FFN_HIDDEN), D ** -0.5),
        "w_ffn_out": nrm((DEPTH, FFN_HIDDEN, D), FFN_HIDDEN ** -0.5),
        "norm_out": 1.0 + nrm((D,), 0.02),
    }


def reference(x, c, ctx, c_ctx, w_mod, b_mod, norm_mix, norm_ffn, w_in_even, w_out_even, q_norm_a, k_norm_a,
              sink_b, w_in_odd, w_out_odd, rpb_c, shift_mu, decay_w0, decay_w2, iclr_a0, iclr_a2, gate_g2,
              k_k, k_a, r_k, ln_x_w, ln_x_b, w_ffn_in, w_ffn_out, norm_out):
    cos, sin = axial_rope_tables(x.shape[1])
    silu_c = jax.nn.silu(c)
    silu_cc = jax.nn.silu(c_ctx)
    for layer in range(DEPTH):
        need_ctx = layer < DEPTH - 1
        mod = (silu_c @ w_mod[layer] + b_mod[layer])[:, None, :]
        modc = silu_cc @ w_mod[layer] + b_mod[layer]
        sh1, sc1, g1, sh2, sc2, g2 = jnp.split(mod, 6, axis=-1)
        csh1, csc1, cg1, csh2, csc2, cg2 = jnp.split(modc, 6, axis=-1)
        h = modulate(rms_norm(x, norm_mix[layer]), sh1, sc1)
        hc = modulate(rms_norm(ctx, norm_mix[layer]), csh1, csc1)
        i = layer // 2
        if layer % 2 == 0:
            y, yc = even_mixer(h, hc, w_in_even[i], w_out_even[i], q_norm_a[i], k_norm_a[i], sink_b[i],
                               cos, sin, need_ctx)
        else:
            y, yc = odd_mixer(h, hc, w_in_odd[i], w_out_odd[i], rpb_c[i], shift_mu[i], decay_w0[i], decay_w2[i],
                              iclr_a0[i], iclr_a2[i], gate_g2[i], k_k[i], k_a[i], r_k[i], ln_x_w[i], ln_x_b[i],
                              need_ctx)
        x = x + g1 * y
        x = x + g2 * swiglu(modulate(rms_norm(x, norm_ffn[layer]), sh2, sc2), w_ffn_in[layer], w_ffn_out[layer])
        if need_ctx:
            ctx = ctx + cg1 * yc
            ctx = ctx + cg2 * swiglu(modulate(rms_norm(ctx, norm_ffn[layer]), csh2, csc2),
                                     w_ffn_in[layer], w_ffn_out[layer])
    return rms_norm(x, norm_out)
```

```cpp
#include <hip/hip_runtime.h>
#include <hip/hip_cooperative_groups.h>
#include <cstdio>
#include <cstdint>
namespace cg = cooperative_groups;

#define DEV __device__ __forceinline__
typedef unsigned short u16;
typedef short bf16x8 __attribute__((ext_vector_type(8)));
typedef float f32x4 __attribute__((ext_vector_type(4)));
typedef const __attribute__((address_space(4))) float* cfp;
typedef const __attribute__((address_space(4))) unsigned* cup;

constexpr int DM = 1024, NB = 2, SEQ = 16384, NCTX = 256, RPB = SEQ + NCTX, MROWS = NB * RPB;
constexpr int FFH = 2816, ZDW = 1792;
constexpr float LOG2E = 1.4426950408889634f;
constexpr int NTHR = 512, NWAVE = 8;

constexpr size_t MiB = 1u << 20;
constexpr size_t OFF_MOD = 0;
constexpr size_t OFF_XC = 1 * MiB;
constexpr size_t OFF_AO = 29 * MiB;
constexpr size_t OFF_HN = 94 * MiB;
constexpr size_t OFF_RAW = 159 * MiB;
constexpr size_t OFF_ZD = 257 * MiB;
constexpr size_t SZ_H = (size_t)RPB * 512 * 2;
constexpr size_t OFF_DEC = 94 * MiB;
constexpr size_t OFF_KD = OFF_DEC + 4 * SZ_H;
constexpr size_t OFF_BQ = OFF_KD + 2 * SZ_H;
constexpr size_t OFF_KK = OFF_BQ + 2 * SZ_H;
constexpr size_t OFF_R = OFF_KK + SZ_H;
constexpr size_t OFF_V = 371 * MiB;
constexpr size_t OFF_G = OFF_V + SZ_H;
constexpr size_t OFF_LA = OFF_G + SZ_H;
constexpr size_t OFF_Y0 = 412 * MiB;
constexpr size_t OFF_Y1 = OFF_Y0 + 2 * SZ_H;
constexpr size_t WS_NEED = 480 * MiB;
static_assert(OFF_R + SZ_H <= OFF_ZD, "scan map");
static_assert(OFF_LA + SZ_H / 2 <= OFF_Y0, "scan map 2");
static_assert(OFF_Y1 + 2 * SZ_H <= WS_NEED, "scan map 3");
static_assert(OFF_RAW + (size_t)MROWS * FFH * 2 <= WS_NEED, "ffn hidden");

struct Params { const float* in[30]; float* out; unsigned char* ws; };
typedef const __attribute__((address_space(4))) Params* PPtr;
DEV int tidx() { int t = threadIdx.x; asm volatile("" : "+v"(t)); return t; }
DEV PPtr launder(PPtr p) { asm volatile("" : "+s"(p)); return p; }

DEV unsigned f2bf(float f) { unsigned u = __float_as_uint(f); return (u + 0x7fffu + ((u >> 16) & 1u)) >> 16; }
DEV float bf2f(u16 h) { return __uint_as_float(((unsigned)h) << 16); }
DEV float bflo(unsigned u) { return __uint_as_float(u << 16); }
DEV float bfhi(unsigned u) { return __uint_as_float(u & 0xffff0000u); }
DEV unsigned pk2(float lo, float hi) { return f2bf(lo) | (f2bf(hi) << 16); }
DEV float wave_sum(float v) {
#pragma unroll
    for (int o = 1; o < 64; o <<= 1) v += __shfl_xor(v, o);
    return v;
}
DEV float* xrow_ptr(PPtr p, int m) {
    int b = m / RPB, q = m - b * RPB;
    return q < SEQ ? p->out + (size_t)(b * SEQ + q) * DM : (float*)(p->ws + OFF_XC) + (size_t)(b * NCTX + (q - SEQ)) * DM;
}
DEV int mod_idx(int m) { int b = m / RPB, q = m - b * RPB; return q < SEQ ? b : 2; }
DEV float sigmoidf_(float x) { return 1.f / (1.f + __expf(-x)); }

DEV void phase_init(PPtr p, char* lds) {
    const int tid = tidx();
    const size_t gt = (size_t)blockIdx.x * NTHR + tid, ng = (size_t)gridDim.x * NTHR;
    {
        const float4* s = (const float4*)p->in[0]; float4* d = (float4*)p->out;
        const size_t n = (size_t)NB * SEQ * DM / 4;
        for (size_t i = gt; i < n; i += ng) d[i] = s[i];
        const float4* s2 = (const float4*)p->in[2]; float4* d2 = (float4*)(p->ws + OFF_XC);
        const size_t n2 = (size_t)NB * NCTX * DM / 4;
        for (size_t i = gt; i < n2; i += ng) d2[i] = s2[i];
    }
    float* red = (float*)lds;
    float* mod = (float*)(p->ws + OFF_MOD);
    const float* c = p->in[1]; const float* cc = p->in[3];
    for (int item = blockIdx.x; item < 192; item += gridDim.x) {
        const int l = item / 48, n0 = (item % 48) * 128, col = tid & 127, kp = tid >> 7;
        const float* w = p->in[4] + (size_t)l * DM * 6144 + n0 + col;
        float a0 = 0.f, a1 = 0.f, a2 = 0.f;
        for (int k = kp * 256; k < kp * 256 + 256; ++k) {
            const float wv = w[(size_t)k * 6144];
            const float c0 = c[k], c1 = c[DM + k], c2 = cc[k];
            a0 += c0 * sigmoidf_(c0) * wv; a1 += c1 * sigmoidf_(c1) * wv; a2 += c2 * sigmoidf_(c2) * wv;
        }
        red[(kp * 3 + 0) * 128 + col] = a0; red[(kp * 3 + 1) * 128 + col] = a1; red[(kp * 3 + 2) * 128 + col] = a2;
        __syncthreads();
        if (tid < 384) {
            const int mb = tid >> 7, cl = tid & 127;
            float s = red[(0 * 3 + mb) * 128 + cl] + red[(1 * 3 + mb) * 128 + cl] + red[(2 * 3 + mb) * 128 + cl] + red[(3 * 3 + mb) * 128 + cl];
            mod[(size_t)(l * 3 + mb) * 6144 + n0 + cl] = s + p->in[5][l * 6144 + n0 + cl];
        }
        __syncthreads();
    }
}

DEV void phase_normmod(PPtr p, int layer, int which) {
    const int lane = tidx() & 63, gw = blockIdx.x * NWAVE + (tidx() >> 6), ngw = gridDim.x * NWAVE;
    const float* gain = p->in[which ? 7 : 6] + layer * DM;
    const float* mod = (const float*)(p->ws + OFF_MOD) + (size_t)layer * 3 * 6144;
    u16* HN = (u16*)(p->ws + OFF_HN);
    for (int m = gw; m < MROWS; m += ngw) {
        const float* xr = xrow_ptr(p, m);
        const float* md = mod + mod_idx(m) * 6144 + (which ? 3072 : 0);
        float4 v[4]; float ss = 0.f;
#pragma unroll
        for (int j = 0; j < 4; ++j) { v[j] = ((const float4*)xr)[lane + 64 * j]; ss += v[j].x * v[j].x + v[j].y * v[j].y + v[j].z * v[j].z + v[j].w * v[j].w; }
        ss = wave_sum(ss);
        const float rstd = rsqrtf(ss * (1.f / DM) + 1e-6f);
#pragma unroll
        for (int j = 0; j < 4; ++j) {
            const int k = (lane + 64 * j) * 4;
            const float4 g = *(const float4*)(gain + k), sh = *(const float4*)(md + k), sc = *(const float4*)(md + 1024 + k);
            const float o0 = v[j].x * rstd * g.x * (1.f + sc.x) + sh.x, o1 = v[j].y * rstd * g.y * (1.f + sc.y) + sh.y;
            const float o2 = v[j].z * rstd * g.z * (1.f + sc.z) + sh.z, o3 = v[j].w * rstd * g.w * (1.f + sc.w) + sh.w;
            uint2 w; w.x = pk2(o0, o1); w.y = pk2(o2, o3);
            *(uint2*)(HN + (size_t)m * DM + k) = w;
        }
    }
}

template <int DUAL, class Epi>
DEV void gemm_simple(const u16* A, int lda, const float* W, int ldw, int dualoff, int M, int N, int K, const Epi& epi, char* lds) {
    u16* sA = (u16*)lds; u16* sB = sA + 128 * 40; u16* sB2 = sB + 128 * 40;
    const int tid = tidx(), lane = tid & 63, wave = tid >> 6, wm = wave >> 2, wn = wave & 3, r16 = lane & 15, quad = lane >> 4;
    const int mt = M / 128, nt = N / 128;
    for (int item = blockIdx.x; item < mt * nt; item += gridDim.x) {
        const int tn = item / mt, tm = item - tn * mt, m0 = tm * 128, n0 = tn * 128;
        f32x4 acc[4][2], acc2[4][2];
#pragma unroll
        for (int a = 0; a < 4; ++a)
#pragma unroll
            for (int b = 0; b < 2; ++b) { acc[a][b] = (f32x4){0.f, 0.f, 0.f, 0.f}; acc2[a][b] = (f32x4){0.f, 0.f, 0.f, 0.f}; }
        for (int k0 = 0; k0 < K; k0 += 32) {
            {
                const int row = tid >> 2, kc = (tid & 3) * 8;
                const uint4 v = *(const uint4*)(A + (size_t)(m0 + row) * lda + k0 + kc);
                *(uint4*)(sA + row * 40 + kc) = v;
            }
            {
                const int kk = tid >> 4, nc = (tid & 15) * 8;
                const float* wp = W + (size_t)(k0 + kk) * ldw + n0 + nc;
                const float4 a = *(const float4*)wp, b = *(const float4*)(wp + 4);
                sB[(nc + 0) * 40 + kk] = (u16)f2bf(a.x); sB[(nc + 1) * 40 + kk] = (u16)f2bf(a.y); sB[(nc + 2) * 40 + kk] = (u16)f2bf(a.z); sB[(nc + 3) * 40 + kk] = (u16)f2bf(a.w);
                sB[(nc + 4) * 40 + kk] = (u16)f2bf(b.x); sB[(nc + 5) * 40 + kk] = (u16)f2bf(b.y); sB[(nc + 6) * 40 + kk] = (u16)f2bf(b.z); sB[(nc + 7) * 40 + kk] = (u16)f2bf(b.w);
                if (DUAL) {
                    const float4 c = *(const float4*)(wp + dualoff), d = *(const float4*)(wp + dualoff + 4);
                    sB2[(nc + 0) * 40 + kk] = (u16)f2bf(c.x); sB2[(nc + 1) * 40 + kk] = (u16)f2bf(c.y); sB2[(nc + 2) * 40 + kk] = (u16)f2bf(c.z); sB2[(nc + 3) * 40 + kk] = (u16)f2bf(c.w);
                    sB2[(nc + 4) * 40 + kk] = (u16)f2bf(d.x); sB2[(nc + 5) * 40 + kk] = (u16)f2bf(d.y); sB2[(nc + 6) * 40 + kk] = (u16)f2bf(d.z); sB2[(nc + 7) * 40 + kk] = (u16)f2bf(d.w);
                }
            }
            __syncthreads();
            bf16x8 af[4], bfr[2], bfr2[2];
#pragma unroll
            for (int mi = 0; mi < 4; ++mi) af[mi] = *(const bf16x8*)(sA + (wm * 64 + mi * 16 + r16) * 40 + quad * 8);
#pragma unroll
            for (int ni = 0; ni < 2; ++ni) {
                bfr[ni] = *(const bf16x8*)(sB + (wn * 32 + ni * 16 + r16) * 40 + quad * 8);
                if (DUAL) bfr2[ni] = *(const bf16x8*)(sB2 + (wn * 32 + ni * 16 + r16) * 40 + quad * 8);
            }
#pragma unroll
            for (int mi = 0; mi < 4; ++mi)
#pragma unroll
                for (int ni = 0; ni < 2; ++ni) {
                    acc[mi][ni] = __builtin_amdgcn_mfma_f32_16x16x32_bf16(af[mi], bfr[ni], acc[mi][ni], 0, 0, 0);
                    if (DUAL) acc2[mi][ni] = __builtin_amdgcn_mfma_f32_16x16x32_bf16(af[mi], bfr2[ni], acc2[mi][ni], 0, 0, 0);
                }
            __syncthreads();
        }
#pragma unroll
        for (int mi = 0; mi < 4; ++mi)
#pragma unroll
            for (int ni = 0; ni < 2; ++ni)
#pragma unroll
                for (int j = 0; j < 4; ++j) {
                    const int row = m0 + wm * 64 + mi * 16 + quad * 4 + j, col = n0 + wn * 32 + ni * 16 + r16;
                    epi(row, col, acc[mi][ni][j], DUAL ? acc2[mi][ni][j] : 0.f);
                }
    }
}

struct EpiStore { u16* O; int ld; DEV void operator()(int r, int c, float v, float) const { O[(size_t)r * ld + c] = (u16)f2bf(v); } };
struct EpiStoreOdd { u16* Q; u16* Z;
    DEV void operator()(int r, int c, float v, float) const { if (c < 1536) Q[(size_t)r * 1536 + c] = (u16)f2bf(v); else Z[(size_t)r * ZDW + (c - 1536)] = (u16)f2bf(v); } };
struct EpiResid { PPtr p; const float* gate;
    DEV void operator()(int r, int c, float v, float) const { float* xr = xrow_ptr(p, r); xr[c] += gate[mod_idx(r) * 6144 + c] * v; } };
struct EpiSwiglu { u16* H;
    DEV void operator()(int r, int c, float g, float u) const { H[(size_t)r * FFH + c] = (u16)f2bf(g * sigmoidf_(g) * u); } };

DEV void phase_even_post(PPtr p, int li) {
    const int lane = tidx() & 63, gw = blockIdx.x * NWAVE + (tidx() >> 6), ngw = gridDim.x * NWAVE;
    u16* RAW = (u16*)(p->ws + OFF_RAW);
    const float* qg = p->in[10] + li * 64; const float* kg = p->in[11] + li * 64;
    const int half = lane >> 5, i = lane & 31;
    const float inv = powf(10000.f, -(float)(i & 15) / 16.f);
    for (int m = gw; m < MROWS; m += ngw) {
        const int b = m / RPB, q = m - b * RPB;
        float cs = 1.f, sn = 0.f;
        if (q < SEQ) { const float pos = (i < 16) ? (float)(q >> 6) : (float)(q & 63); const float ang = pos * inv; sn = sinf(ang); cs = cosf(ang); }
        u16* row = RAW + (size_t)m * 1536;
        for (int hs = 0; hs < 20; hs += 2) {
            const int s = hs + half; int c0; const float* gn = nullptr;
            if (s < 8) { c0 = s * 64; gn = qg; } else if (s < 10) { c0 = 512 + (s - 8) * 64; gn = kg; } else if (s < 18) { c0 = 768 + (s - 10) * 64; } else { c0 = 1280 + (s - 18) * 64; }
            float v1 = bf2f(row[c0 + i]), v2 = bf2f(row[c0 + i + 32]);
            if (hs < 10) {
                float ss = v1 * v1 + v2 * v2;
#pragma unroll
                for (int o = 1; o < 32; o <<= 1) ss += __shfl_xor(ss, o);
                const float rs = rsqrtf(ss * (1.f / 64.f) + 1e-6f);
                v1 *= rs * gn[i]; v2 *= rs * gn[i + 32];
            }
            const float o1 = v1 * cs - v2 * sn, o2 = v1 * sn + v2 * cs;
            row[c0 + i] = (u16)f2bf(o1); row[c0 + i + 32] = (u16)f2bf(o2);
        }
    }
}

template <int mode, bool qctx>
DEV void attn_wave(const u16* QB, int pitch, int qcol, int kcol, int vcol, u16* AO, int ocol,
                   int b, int hk, int blk, const float* sinkp, const float* rpb, u16* sV) {
    const int lane = tidx() & 63, qi = lane & 15, quad = lane >> 4;
    const bool gqa = mode < 2;
    const size_t rowb = (size_t)b * RPB;
    const float SCL = 0.125f * LOG2E;
    int qtok[4], qhead[4]; bf16x8 qf[4][2];
#pragma unroll
    for (int i = 0; i < 4; ++i) {
        qtok[i] = gqa ? blk * 16 + qi : blk * 64 + i * 16 + qi; qhead[i] = gqa ? hk * 4 + i : hk;
        const size_t m = rowb + (qctx ? SEQ : 0) + qtok[i];
        const u16* qp = QB + m * pitch + qcol + qhead[i] * 64 + quad * 8;
        qf[i][0] = *(const bf16x8*)qp; qf[i][1] = *(const bf16x8*)(qp + 32);
    }
    f32x4 o[4][4]; float mrun[4], lrun[4];
#pragma unroll
    for (int i = 0; i < 4; ++i) {
#pragma unroll
        for (int d = 0; d < 4; ++d) o[i][d] = (f32x4){0.f, 0.f, 0.f, 0.f};
        if (mode == 1) { mrun[i] = sinkp[qhead[i]] * LOG2E; lrun[i] = (quad == 0) ? 1.f : 0.f; } else { mrun[i] = -1e30f; lrun[i] = 0.f; }
    }
    const u16* Kb = QB + kcol + hk * 64; const u16* Vb = QB + vcol + hk * 64;
    int n_local, ustart, rs = 0;
    if (qctx) { n_local = 0; ustart = 0; }
    else if (mode == 0) { n_local = RPB / 32; ustart = 0; }
    else if (mode == 1) { n_local = 9; ustart = blk * 16 - 128; }
    else { rs = min(max(blk - 4, 0), 248); n_local = 16; ustart = rs * 64; }
    const int n_ctx = (mode == 0 && !qctx) ? 0 : 8;
    for (int tt = 0; tt < n_local + n_ctx; ++tt) {
        const bool loc = tt < n_local;
        const int u0 = loc ? ustart + 32 * tt : SEQ + 32 * (tt - n_local);
        const bool masked = loc && mode != 0;
        bf16x8 kf[2][2];
#pragma unroll
        for (int kt = 0; kt < 2; ++kt) {
            const int u = min(max(u0 + kt * 16 + qi, 0), RPB - 1);
            const u16* kp = Kb + (rowb + u) * pitch + quad * 8;
            kf[kt][0] = *(const bf16x8*)kp; kf[kt][1] = *(const bf16x8*)(kp + 32);
        }
#pragma unroll
        for (int c = 0; c < 4; ++c) {
            const int idx = c * 64 + lane, key = idx >> 3, dc = idx & 7;
            const int u = min(max(u0 + key, 0), RPB - 1);
            const uint4 v = *(const uint4*)(Vb + (rowb + u) * pitch + dc * 8);
            *(uint4*)(sV + key * 72 + dc * 8) = v;
        }
        bf16x8 vf[4];
#pragma unroll
        for (int dt = 0; dt < 4; ++dt)
#pragma unroll
            for (int jj = 0; jj < 8; ++jj) {
                const int key = (jj < 4) ? quad * 4 + jj : 16 + quad * 4 + (jj - 4);
                vf[dt][jj] = (short)sV[key * 72 + dt * 16 + qi];
            }
#pragma unroll
        for (int i = 0; i < 4; ++i) {
            f32x4 s0 = (f32x4){0.f, 0.f, 0.f, 0.f}, s1 = (f32x4){0.f, 0.f, 0.f, 0.f};
            s0 = __builtin_amdgcn_mfma_f32_16x16x32_bf16(kf[0][0], qf[i][0], s0, 0, 0, 0);
            s0 = __builtin_amdgcn_mfma_f32_16x16x32_bf16(kf[0][1], qf[i][1], s0, 0, 0, 0);
            s1 = __builtin_amdgcn_mfma_f32_16x16x32_bf16(kf[1][0], qf[i][0], s1, 0, 0, 0);
            s1 = __builtin_amdgcn_mfma_f32_16x16x32_bf16(kf[1][1], qf[i][1], s1, 0, 0, 0);
            float sc[8];
#pragma unroll
            for (int j = 0; j < 4; ++j) { sc[j] = s0[j] * SCL; sc[4 + j] = s1[j] * SCL; }
            if (masked) {
                const int t = qtok[i];
#pragma unroll
                for (int e = 0; e < 8; ++e) {
                    const int u = u0 + (e >> 2) * 16 + quad * 4 + (e & 3);
                    if (mode == 1) {
                        const int dd = t - u;
                        const bool ok = (u >= 0) && (u < SEQ) && (dd <= 128) && (dd >= -128);
                        if (!ok) sc[e] = -INFINITY;
                    } else {
                        const int c = t & 63, r = t >> 6, ur = u >> 6, uc = u & 63;
                        const int cst = min(max(c - 8, 0), 48);
                        const bool ok = (uc >= cst) && (uc < cst + 16);
                        const int dr = min(max(ur - r + 7, 0), 14), dcx = min(max(uc - c + 15, 0), 30);
                        const float bias = rpb[(qhead[i] * 15 + dr) * 31 + dcx];
                        sc[e] = ok ? sc[e] + bias * LOG2E : -INFINITY;
                    }
                }
            }
            float mx = fmaxf(fmaxf(fmaxf(sc[0], sc[1]), fmaxf(sc[2], sc[3])), fmaxf(fmaxf(sc[4], sc[5]), fmaxf(sc[6], sc[7])));
            mx = fmaxf(mx, __shfl_xor(mx, 16)); mx = fmaxf(mx, __shfl_xor(mx, 32));
            const float mn = fmaxf(mrun[i], mx);
            const float al = __builtin_amdgcn_exp2f(mrun[i] - mn);
            mrun[i] = mn;
            float pe[8], ps = 0.f;
#pragma unroll
            for (int e = 0; e < 8; ++e) { pe[e] = __builtin_amdgcn_exp2f(sc[e] - mn); ps += pe[e]; }
            lrun[i] = lrun[i] * al + ps;
            union { unsigned u[4]; bf16x8 v; } pf;
            pf.u[0] = pk2(pe[0], pe[1]); pf.u[1] = pk2(pe[2], pe[3]); pf.u[2] = pk2(pe[4], pe[5]); pf.u[3] = pk2(pe[6], pe[7]);
#pragma unroll
            for (int dt = 0; dt < 4; ++dt) {
                o[i][dt] = o[i][dt] * al;
                o[i][dt] = __builtin_amdgcn_mfma_f32_16x16x32_bf16(vf[dt], pf.v, o[i][dt], 0, 0, 0);
            }
        }
    }
#pragma unroll
    for (int i = 0; i < 4; ++i) {
        float l = lrun[i]; l += __shfl_xor(l, 16); l += __shfl_xor(l, 32);
        const float inv = 1.f / l;
        const size_t m = rowb + (qctx ? SEQ : 0) + qtok[i];
        u16* op = AO + m * DM + ocol + qhead[i] * 64 + quad * 4;
#pragma unroll
        for (int dt = 0; dt < 4; ++dt) {
            uint2 w; w.x = pk2(o[i][dt][0] * inv, o[i][dt][1] * inv); w.y = pk2(o[i][dt][2] * inv, o[i][dt][3] * inv);
            *(uint2*)(op + dt * 16) = w;
        }
    }
}

DEV void phase_attn_even(PPtr p, int li, char* lds) {
    const int wave = tidx() >> 6, gw = blockIdx.x * NWAVE + wave, ngw = gridDim.x * NWAVE;
    u16* sV = (u16*)lds + wave * (32 * 72);
    const u16* RAW = (const u16*)(p->ws + OFF_RAW); u16* AO = (u16*)(p->ws + OFF_AO);
    const float* sink = p->in[12] + li * 8;
    for (int t = gw; t < 8320; t += ngw) {
        if (t < 4096) attn_wave<0, false>(RAW, 1536, 0, 512, 640, AO, 0, t >> 11, (t >> 10) & 1, t & 1023, nullptr, nullptr, sV);
        else if (t < 8192) { const int u = t - 4096; attn_wave<1, false>(RAW, 1536, 768, 1280, 1408, AO, 512, u >> 11, (u >> 10) & 1, u & 1023, sink, nullptr, sV); }
        else if (t < 8256) { const int u = t - 8192; attn_wave<0, true>(RAW, 1536, 0, 512, 640, AO, 0, u >> 5, (u >> 4) & 1, u & 15, nullptr, nullptr, sV); }
        else { const int u = t - 8256; attn_wave<1, true>(RAW, 1536, 768, 1280, 1408, AO, 512, u >> 5, (u >> 4) & 1, u & 15, sink, nullptr, sV); }
    }
}
DEV void phase_attn_odd(PPtr p, int li, char* lds) {
    const int wave = tidx() >> 6, gw = blockIdx.x * NWAVE + wave, ngw = gridDim.x * NWAVE;
    u16* sV = (u16*)lds + wave * (32 * 72);
    const u16* QKV = (const u16*)(p->ws + OFF_RAW); u16* AO = (u16*)(p->ws + OFF_AO);
    const float* rpb = p->in[15] + li * 8 * 15 * 31;
    for (int t = gw; t < 4160; t += ngw) {
        if (t < 4096) attn_wave<2, false>(QKV, 1536, 0, 512, 1024, AO, 0, t >> 11, (t >> 8) & 7, t & 255, nullptr, rpb, sV);
        else { const int u = t - 4096; attn_wave<2, true>(QKV, 1536, 0, 512, 1024, AO, 0, u >> 5, (u >> 2) & 7, u & 3, nullptr, rpb, sV); }
    }
}

DEV float shiftmix_at(const u16* ZDb, int pp, int ch, float mu) {
    const bool lat = pp < SEQ; const int lo = lat ? 0 : SEQ, hi = lat ? SEQ : RPB;
    const u16* zc = ZDb + (size_t)pp * ZDW + ch;
    const float z = bf2f(zc[0]);
    const float a = (pp - 1 >= lo) ? bf2f(zc[-ZDW]) : 0.f, c = (pp + 1 < hi) ? bf2f(zc[ZDW]) : 0.f;
    return z + (0.5f * (a + c) - z) * mu;
}
DEV void phase_rwkv_prep(PPtr p, int li, int bb) {
    const int lane = tidx() & 63, gw = blockIdx.x * NWAVE + (tidx() >> 6), ngw = gridDim.x * NWAVE;
    const u16* ZDb = (const u16*)(p->ws + OFF_ZD) + (size_t)bb * RPB * ZDW;
    const float* mu = p->in[16] + li * ZDW; const float* kkw = p->in[22] + li * 512;
    u16* R = (u16*)(p->ws + OFF_R); u16* KK = (u16*)(p->ws + OFF_KK); u16* V = (u16*)(p->ws + OFF_V); u16* LA = (u16*)(p->ws + OFF_LA);
    for (int pp = gw; pp < RPB; pp += ngw) {
        for (int j = 0; j < 28; ++j) {
            const int ch = lane + 64 * j;
            const float zs = shiftmix_at(ZDb, pp, ch, mu[ch]);
            if (j < 8) R[(size_t)pp * 512 + ch] = (u16)f2bf(zs);
            else if (j < 16) {
                const float t = zs * kkw[ch - 512]; const float ss = wave_sum(t * t);
                KK[(size_t)pp * 512 + ch - 512] = (u16)f2bf(t / fmaxf(sqrtf(ss), 1e-12f));
            } else if (j < 24) V[(size_t)pp * 512 + ch - 1024] = (u16)f2bf(zs);
            else if (j == 24) LA[(size_t)pp * 256 + lane] = (u16)f2bf(tanhf(zs));
            else if (j == 25) LA[(size_t)pp * 256 + 64 + lane] = (u16)f2bf(zs);
            else LA[(size_t)pp * 256 + 128 + (ch - 1664)] = (u16)f2bf(sigmoidf_(zs));
        }
    }
}
struct EpiDecay { float* DEC; const float* w0; int d;
    DEV void operator()(int r, int c, float v, float) const {
        const float x = -(w0[c] + v); const float sp = x > 20.f ? x : log1pf(expf(x)); const float w = -sp - 0.5f;
        DEC[((size_t)r * 2 + d) * 512 + c] = expf(-expf(w)); } };
struct EpiIclr { u16* KD; u16* BQ; const u16* KK; const u16* ZDb; const float* a0; const float* ka; const float* muk; int d;
    DEV void operator()(int r, int c, float v, float) const {
        const float a = sigmoidf_(a0[c] + v);
        const float k = shiftmix_at(ZDb, r, 512 + c, muk[c]);
        KD[((size_t)r * 2 + d) * 512 + c] = (u16)f2bf(k * (1.f + (a - 1.f) * ka[c]));
        BQ[((size_t)r * 2 + d) * 512 + c] = (u16)f2bf(bf2f(KK[(size_t)r * 512 + c]) * a); } };
struct EpiGate { u16* G; DEV void operator()(int r, int c, float v, float) const { G[(size_t)r * 512 + c] = (u16)f2bf(v); } };

DEV void phase_scan_seq(PPtr p, int bb) {
    if ((tidx() >> 6) != 0 || blockIdx.x >= 16) return;
    const int lane = tidx() & 63, h = blockIdx.x >> 1, d = blockIdx.x & 1;
    const float* DEC = (const float*)(p->ws + OFF_DEC); const u16* KD = (const u16*)(p->ws + OFF_KD); const u16* BQ = (const u16*)(p->ws + OFF_BQ);
    const u16* KK = (const u16*)(p->ws + OFF_KK); const u16* R = (const u16*)(p->ws + OFF_R); const u16* V = (const u16*)(p->ws + OFF_V);
    float* Y = (float*)(p->ws + (d ? OFF_Y1 : OFF_Y0));
    float S[64];
#pragma unroll
    for (int j = 0; j < 64; ++j) S[j] = 0.f;
    for (int s = 0; s < RPB; ++s) {
        const int pp = (s < NCTX) ? (d ? SEQ + NCTX - 1 - s : SEQ + s) : (d ? SEQ - 1 - (s - NCTX) : s - NCTX);
        const size_t e1 = (size_t)pp * 512 + h * 64, e2 = ((size_t)pp * 2 + d) * 512 + h * 64;
        cfp dec = (cfp)(uintptr_t)(DEC + e2);
        cup kd = (cup)(uintptr_t)(KD + e2), bq = (cup)(uintptr_t)(BQ + e2), kk = (cup)(uintptr_t)(KK + e1), rr = (cup)(uintptr_t)(R + e1);
        const float vv = bf2f(V[e1 + lane]);
        float sa0 = 0.f, sa1 = 0.f;
#pragma unroll
        for (int c4 = 0; c4 < 4; ++c4) {
            cup kc = kk + c4 * 8; asm volatile("" : "+s"(kc));
#pragma unroll
            for (int j = 0; j < 8; ++j) { const unsigned u = kc[j]; sa0 += S[2 * (c4 * 8 + j)] * bflo(u); sa1 += S[2 * (c4 * 8 + j) + 1] * bfhi(u); }
        }
        const float nsa = -(sa0 + sa1);
        float y0 = 0.f, y1 = 0.f;
#pragma unroll
        for (int c4 = 0; c4 < 4; ++c4) {
            cup kdc = kd + c4 * 8, bqc = bq + c4 * 8, rrc = rr + c4 * 8; cfp dc = dec + c4 * 16;
            asm volatile("" : "+s"(kdc), "+s"(bqc), "+s"(rrc), "+s"(dc));
#pragma unroll
            for (int j = 0; j < 8; ++j) {
                const int jj = c4 * 8 + j;
                const unsigned uk = kdc[j], ub = bqc[j], ur = rrc[j];
                const float d0 = dc[2 * j], d1 = dc[2 * j + 1];
                const float t0 = vv * bflo(uk) + nsa * bflo(ub), t1 = vv * bfhi(uk) + nsa * bfhi(ub);
                S[2 * jj] = S[2 * jj] * d0 + t0; S[2 * jj + 1] = S[2 * jj + 1] * d1 + t1;
                y0 += S[2 * jj] * bflo(ur); y1 += S[2 * jj + 1] * bfhi(ur);
            }
        }
        Y[e1 + lane] = y0 + y1;
    }
}
DEV void phase_readout(PPtr p, int li, int bb) {
    const int lane = tidx() & 63, gw = blockIdx.x * NWAVE + (tidx() >> 6), ngw = gridDim.x * NWAVE;
    const float* Y0 = (const float*)(p->ws + OFF_Y0); const float* Y1 = (const float*)(p->ws + OFF_Y1);
    const u16* KD = (const u16*)(p->ws + OFF_KD); const u16* R = (const u16*)(p->ws + OFF_R); const u16* V = (const u16*)(p->ws + OFF_V); const u16* G = (const u16*)(p->ws + OFF_G);
    const float* rk = p->in[24] + li * 512; const float* lnw = p->in[25] + li * 512; const float* lnb = p->in[26] + li * 512;
    u16* AO = (u16*)(p->ws + OFF_AO);
    for (int pp = gw; pp < RPB; pp += ngw) {
        const size_t m = (size_t)bb * RPB + pp;
        for (int h = 0; h < 8; ++h) {
            const int c = h * 64 + lane; const size_t e = (size_t)pp * 512 + c;
            const float y = Y0[e] + Y1[e];
            const float mean = wave_sum(y) * (1.f / 64.f); const float dv = y - mean; const float var = wave_sum(dv * dv) * (1.f / 64.f);
            const float yn = dv * rsqrtf(var + 64e-5f) * lnw[c] + lnb[c];
            const float r = bf2f(R[e]); const float ks = bf2f(KD[((size_t)pp * 2) * 512 + c]) + bf2f(KD[((size_t)pp * 2 + 1) * 512 + c]);
            const float bs = wave_sum(r * ks * rk[c]);
            AO[m * DM + 512 + c] = (u16)f2bf((yn + bs * bf2f(V[e])) * bf2f(G[e]));
        }
    }
}
DEV void phase_final(PPtr p) {
    const int lane = tidx() & 63, gw = blockIdx.x * NWAVE + (tidx() >> 6), ngw = gridDim.x * NWAVE;
    const float* gain = p->in[29];
    for (int m = gw; m < NB * SEQ; m += ngw) {
        float4* xr = (float4*)(p->out + (size_t)m * DM);
        float4 v[4]; float ss = 0.f;
#pragma unroll
        for (int j = 0; j < 4; ++j) { v[j] = xr[lane + 64 * j]; ss += v[j].x * v[j].x + v[j].y * v[j].y + v[j].z * v[j].z + v[j].w * v[j].w; }
        ss = wave_sum(ss);
        const float rstd = rsqrtf(ss * (1.f / DM) + 1e-6f);
#pragma unroll
        for (int j = 0; j < 4; ++j) {
            const float4 g = *(const float4*)(gain + (lane + 64 * j) * 4);
            float4 o; o.x = v[j].x * rstd * g.x; o.y = v[j].y * rstd * g.y; o.z = v[j].z * rstd * g.z; o.w = v[j].w * rstd * g.w;
            xr[lane + 64 * j] = o;
        }
    }
}

__global__ void __launch_bounds__(NTHR) mega(Params p_unused) {
    PPtr kp = (PPtr)__builtin_amdgcn_kernarg_segment_ptr();
#define p launder(kp)
    __shared__ __attribute__((aligned(16))) char lds[40960];
    cg::grid_group grid = cg::this_grid();
#define SYNC() do { __threadfence(); grid.sync(); __threadfence(); } while (0)
    unsigned char* ws = kp->ws;
    const float* mod = (const float*)(ws + OFF_MOD);
    u16* HN = (u16*)(ws + OFF_HN); u16* AO = (u16*)(ws + OFF_AO); u16* RAW = (u16*)(ws + OFF_RAW); u16* ZD = (u16*)(ws + OFF_ZD);
    phase_init(p, lds); SYNC();
    for (int layer = 0; layer < 4; ++layer) {
        const int li = layer >> 1;
        const float* lmod = mod + (size_t)layer * 3 * 6144;
        phase_normmod(p, layer, 0); SYNC();
        if (!(layer & 1)) {
            { EpiStore e{RAW, 1536}; gemm_simple<0>(HN, DM, p->in[8] + (size_t)li * DM * 1536, 1536, 0, MROWS, 1536, DM, e, lds); } SYNC();
            phase_even_post(p, li); SYNC();
            phase_attn_even(p, li, lds); SYNC();
            { EpiResid e{p, lmod + 2048}; gemm_simple<0>(AO, DM, p->in[9] + (size_t)li * DM * DM, DM, 0, MROWS, DM, DM, e, lds); } SYNC();
        } else {
            { EpiStoreOdd e{RAW, ZD}; gemm_simple<0>(HN, DM, p->in[13] + (size_t)li * DM * 3328, 3328, 0, MROWS, 3328, DM, e, lds); } SYNC();
            phase_attn_odd(p, li, lds); SYNC();
            for (int bb = 0; bb < 2; ++bb) {
                phase_rwkv_prep(p, li, bb); SYNC();
                const u16* LA = (const u16*)(ws + OFF_LA); const u16* ZDb = ZD + (size_t)bb * RPB * ZDW;
                for (int d = 0; d < 2; ++d) {
                    { EpiDecay e{(float*)(ws + OFF_DEC), p->in[17] + (li * 2 + d) * 512, d}; gemm_simple<0>(LA, 256, p->in[18] + (size_t)(li * 2 + d) * 64 * 512, 512, 0, RPB, 512, 64, e, lds); }
                    { EpiIclr e{(u16*)(ws + OFF_KD), (u16*)(ws + OFF_BQ), (const u16*)(ws + OFF_KK), ZDb, p->in[19] + (li * 2 + d) * 512, p->in[23] + li * 512, p->in[16] + li * ZDW + 512, d};
                      gemm_simple<0>(LA + 64, 256, p->in[20] + (size_t)(li * 2 + d) * 64 * 512, 512, 0, RPB, 512, 64, e, lds); }
                }
                { EpiGate e{(u16*)(ws + OFF_G)}; gemm_simple<0>(LA + 128, 256, p->in[21] + (size_t)li * 128 * 512, 512, 0, RPB, 512, 128, e, lds); }
                SYNC();
                phase_scan_seq(p, bb); SYNC();
                phase_readout(p, li, bb); SYNC();
            }
            { EpiResid e{p, lmod + 2048}; gemm_simple<0>(AO, DM, p->in[14] + (size_t)li * DM * DM, DM, 0, MROWS, DM, DM, e, lds); } SYNC();
        }
        phase_normmod(p, layer, 1); SYNC();
        { EpiSwiglu e{RAW}; gemm_simple<1>(HN, DM, p->in[27] + (size_t)layer * DM * 5632, 5632, FFH, MROWS, FFH, DM, e, lds); } SYNC();
        { EpiResid e{p, lmod + 5120}; gemm_simple<0>(RAW, FFH, p->in[28] + (size_t)layer * FFH * DM, DM, 0, MROWS, DM, FFH, e, lds); } SYNC();
    }
    phase_final(p);
#undef p
}

extern "C" void kernel_launch(void* const* d_in, const int* in_sizes, int n_in, void* d_out, int out_size, void* d_ws, size_t ws_size, hipStream_t stream) {
    static int grid = 0;
    if (grid == 0) {
        if (n_in != 30 || ws_size < WS_NEED || out_size != NB * SEQ * DM) { fprintf(stderr, "kernel_launch: unexpected problem shape (n_in %d ws %zu out %d)\n", n_in, ws_size, out_size); grid = -1; return; }
        int dev = 0, cus = 0, per_cu = 0;
        hipGetDevice(&dev);
        hipDeviceGetAttribute(&cus, hipDeviceAttributeMultiprocessorCount, dev);
        hipOccupancyMaxActiveBlocksPerMultiprocessor(&per_cu, (const void*)mega, NTHR, 0);
        if (per_cu < 1) per_cu = 1;
        if (per_cu > 1) per_cu = 1;
        grid = cus * per_cu;
    }
    if (grid < 0) return;
    Params p{};
    for (int i = 0; i < 30; ++i) p.in[i] = (const float*)d_in[i];
    p.out = (float*)d_out; p.ws = (unsigned char*)d_ws;
    void* args[] = {&p};
    hipError_t e = hipLaunchCooperativeKernel((const void*)mega, dim3(grid), dim3(NTHR), args, 0, stream);
    if (e != hipSuccess) fprintf(stderr, "cooperative launch failed: %s (grid %d)\n", hipGetErrorString(e), grid);
}
```

```cpp
#include <hip/hip_runtime.h>
#include <hip/hip_cooperative_groups.h>
#include <cstdio>
#include <cstdint>
namespace cg = cooperative_groups;

#define DEV __device__ __forceinline__
typedef unsigned short u16;
typedef short bf16x8 __attribute__((ext_vector_type(8)));
typedef float f32x4 __attribute__((ext_vector_type(4)));
typedef const __attribute__((address_space(4))) float* cfp;
typedef const __attribute__((address_space(4))) unsigned* cup;

constexpr int DM = 1024, NB = 2, SEQ = 16384, NCTX = 256, RPB = SEQ + NCTX, MROWS = NB * RPB;
constexpr int FFH = 2816, ZDW = 1792;
constexpr float LOG2E = 1.4426950408889634f;
constexpr int NTHR = 512, NWAVE = 8;

constexpr size_t MiB = 1u << 20;
constexpr size_t OFF_MOD = 0;
constexpr size_t OFF_XC = 1 * MiB;
constexpr size_t OFF_AO = 29 * MiB;
constexpr size_t OFF_HN = 94 * MiB;
constexpr size_t OFF_RAW = 159 * MiB;
constexpr size_t OFF_ZD = 257 * MiB;
constexpr size_t SZ_H = (size_t)RPB * 512 * 2;
constexpr size_t OFF_DEC = 94 * MiB;
constexpr size_t OFF_KD = OFF_DEC + 4 * SZ_H;
constexpr size_t OFF_BQ = OFF_KD + 2 * SZ_H;
constexpr size_t OFF_KK = OFF_BQ + 2 * SZ_H;
constexpr size_t OFF_R = OFF_KK + SZ_H;
constexpr size_t OFF_V = 371 * MiB;
constexpr size_t OFF_G = OFF_V + SZ_H;
constexpr size_t OFF_LA = OFF_G + SZ_H;
constexpr size_t OFF_Y0 = 412 * MiB;
constexpr size_t OFF_PU = OFF_Y0 + 2 * SZ_H;
constexpr size_t WS_NEED = 509 * MiB;
constexpr int NCH = 128, CLEN = 130;
static_assert(OFF_R + SZ_H <= OFF_ZD, "scan map");
static_assert(OFF_LA + SZ_H / 2 <= OFF_Y0, "scan map 2");
static_assert(OFF_PU + 64 * MiB <= WS_NEED, "scan map 3");
static_assert(OFF_RAW + (size_t)MROWS * FFH * 2 <= WS_NEED, "ffn hidden");

struct Params { const float* in[30]; float* out; unsigned char* ws; };
typedef const __attribute__((address_space(4))) Params* PPtr;
DEV int tidx() { int t = threadIdx.x; asm volatile("" : "+v"(t)); return t; }
DEV PPtr launder(PPtr p) { asm volatile("" : "+s"(p)); return p; }

DEV unsigned f2bf(float f) { unsigned u = __float_as_uint(f); return (u + 0x7fffu + ((u >> 16) & 1u)) >> 16; }
DEV float bf2f(u16 h) { return __uint_as_float(((unsigned)h) << 16); }
DEV float bflo(unsigned u) { return __uint_as_float(u << 16); }
DEV float bfhi(unsigned u) { return __uint_as_float(u & 0xffff0000u); }
DEV unsigned pk2(float lo, float hi) { return f2bf(lo) | (f2bf(hi) << 16); }
DEV float wave_sum(float v) {
#pragma unroll
    for (int o = 1; o < 64; o <<= 1) v += __shfl_xor(v, o);
    return v;
}
DEV float* xrow_ptr(PPtr p, int m) {
    int b = m / RPB, q = m - b * RPB;
    return q < SEQ ? p->out + (size_t)(b * SEQ + q) * DM : (float*)(p->ws + OFF_XC) + (size_t)(b * NCTX + (q - SEQ)) * DM;
}
DEV int mod_idx(int m) { int b = m / RPB, q = m - b * RPB; return q < SEQ ? b : 2; }
DEV float sigmoidf_(float x) { return 1.f / (1.f + __expf(-x)); }

DEV void phase_init(PPtr p, char* lds) {
    const int tid = tidx();
    const size_t gt = (size_t)blockIdx.x * NTHR + tid, ng = (size_t)gridDim.x * NTHR;
    {
        const float4* s = (const float4*)p->in[0]; float4* d = (float4*)p->out;
        const size_t n = (size_t)NB * SEQ * DM / 4;
        for (size_t i = gt; i < n; i += ng) d[i] = s[i];
        const float4* s2 = (const float4*)p->in[2]; float4* d2 = (float4*)(p->ws + OFF_XC);
        const size_t n2 = (size_t)NB * NCTX * DM / 4;
        for (size_t i = gt; i < n2; i += ng) d2[i] = s2[i];
    }
    float* red = (float*)lds;
    float* mod = (float*)(p->ws + OFF_MOD);
    const float* c = p->in[1]; const float* cc = p->in[3];
    for (int item = blockIdx.x; item < 192; item += gridDim.x) {
        const int l = item / 48, n0 = (item % 48) * 128, col = tid & 127, kp = tid >> 7;
        const float* w = p->in[4] + (size_t)l * DM * 6144 + n0 + col;
        float a0 = 0.f, a1 = 0.f, a2 = 0.f;
        for (int k = kp * 256; k < kp * 256 + 256; ++k) {
            const float wv = w[(size_t)k * 6144];
            const float c0 = c[k], c1 = c[DM + k], c2 = cc[k];
            a0 += c0 * sigmoidf_(c0) * wv; a1 += c1 * sigmoidf_(c1) * wv; a2 += c2 * sigmoidf_(c2) * wv;
        }
        red[(kp * 3 + 0) * 128 + col] = a0; red[(kp * 3 + 1) * 128 + col] = a1; red[(kp * 3 + 2) * 128 + col] = a2;
        __syncthreads();
        if (tid < 384) {
            const int mb = tid >> 7, cl = tid & 127;
            float s = red[(0 * 3 + mb) * 128 + cl] + red[(1 * 3 + mb) * 128 + cl] + red[(2 * 3 + mb) * 128 + cl] + red[(3 * 3 + mb) * 128 + cl];
            mod[(size_t)(l * 3 + mb) * 6144 + n0 + cl] = s + p->in[5][l * 6144 + n0 + cl];
        }
        __syncthreads();
    }
}

DEV void phase_normmod(PPtr p, int layer, int which) {
    const int lane = tidx() & 63, gw = blockIdx.x * NWAVE + (tidx() >> 6), ngw = gridDim.x * NWAVE;
    const float* gain = p->in[which ? 7 : 6] + layer * DM;
    const float* mod = (const float*)(p->ws + OFF_MOD) + (size_t)layer * 3 * 6144;
    u16* HN = (u16*)(p->ws + OFF_HN);
    for (int m = gw; m < MROWS; m += ngw) {
        const float* xr = xrow_ptr(p, m);
        const float* md = mod + mod_idx(m) * 6144 + (which ? 3072 : 0);
        float4 v[4]; float ss = 0.f;
#pragma unroll
        for (int j = 0; j < 4; ++j) { v[j] = ((const float4*)xr)[lane + 64 * j]; ss += v[j].x * v[j].x + v[j].y * v[j].y + v[j].z * v[j].z + v[j].w * v[j].w; }
        ss = wave_sum(ss);
        const float rstd = rsqrtf(ss * (1.f / DM) + 1e-6f);
#pragma unroll
        for (int j = 0; j < 4; ++j) {
            const int k = (lane + 64 * j) * 4;
            const float4 g = *(const float4*)(gain + k), sh = *(const float4*)(md + k), sc = *(const float4*)(md + 1024 + k);
            const float o0 = v[j].x * rstd * g.x * (1.f + sc.x) + sh.x, o1 = v[j].y * rstd * g.y * (1.f + sc.y) + sh.y;
            const float o2 = v[j].z * rstd * g.z * (1.f + sc.z) + sh.z, o3 = v[j].w * rstd * g.w * (1.f + sc.w) + sh.w;
            uint2 w; w.x = pk2(o0, o1); w.y = pk2(o2, o3);
            *(uint2*)(HN + (size_t)m * DM + k) = w;
        }
    }
}

template <int DUAL, class Epi>
DEV void gemm_simple(const u16* A, int lda, const float* W, int ldw, int dualoff, int M, int N, int K, const Epi& epi, char* lds) {
    u16* sA = (u16*)lds; u16* sB = sA + 128 * 40; u16* sB2 = sB + 128 * 40;
    const int tid = tidx(), lane = tid & 63, wave = tid >> 6, wm = wave >> 2, wn = wave & 3, r16 = lane & 15, quad = lane >> 4;
    const int mt = M / 128, nt = N / 128;
    for (int item = blockIdx.x; item < mt * nt; item += gridDim.x) {
        const int tn = item / mt, tm = item - tn * mt, m0 = tm * 128, n0 = tn * 128;
        f32x4 acc[4][2], acc2[4][2];
#pragma unroll
        for (int a = 0; a < 4; ++a)
#pragma unroll
            for (int b = 0; b < 2; ++b) { acc[a][b] = (f32x4){0.f, 0.f, 0.f, 0.f}; acc2[a][b] = (f32x4){0.f, 0.f, 0.f, 0.f}; }
        for (int k0 = 0; k0 < K; k0 += 32) {
            {
                const int row = tid >> 2, kc = (tid & 3) * 8;
                const uint4 v = *(const uint4*)(A + (size_t)(m0 + row) * lda + k0 + kc);
                *(uint4*)(sA + row * 40 + kc) = v;
            }
            {
                const int kk = tid >> 4, nc = (tid & 15) * 8;
                const float* wp = W + (size_t)(k0 + kk) * ldw + n0 + nc;
                const float4 a = *(const float4*)wp, b = *(const float4*)(wp + 4);
                sB[(nc + 0) * 40 + kk] = (u16)f2bf(a.x); sB[(nc + 1) * 40 + kk] = (u16)f2bf(a.y); sB[(nc + 2) * 40 + kk] = (u16)f2bf(a.z); sB[(nc + 3) * 40 + kk] = (u16)f2bf(a.w);
                sB[(nc + 4) * 40 + kk] = (u16)f2bf(b.x); sB[(nc + 5) * 40 + kk] = (u16)f2bf(b.y); sB[(nc + 6) * 40 + kk] = (u16)f2bf(b.z); sB[(nc + 7) * 40 + kk] = (u16)f2bf(b.w);
                if (DUAL) {
                    const float4 c = *(const float4*)(wp + dualoff), d = *(const float4*)(wp + dualoff + 4);
                    sB2[(nc + 0) * 40 + kk] = (u16)f2bf(c.x); sB2[(nc + 1) * 40 + kk] = (u16)f2bf(c.y); sB2[(nc + 2) * 40 + kk] = (u16)f2bf(c.z); sB2[(nc + 3) * 40 + kk] = (u16)f2bf(c.w);
                    sB2[(nc + 4) * 40 + kk] = (u16)f2bf(d.x); sB2[(nc + 5) * 40 + kk] = (u16)f2bf(d.y); sB2[(nc + 6) * 40 + kk] = (u16)f2bf(d.z); sB2[(nc + 7) * 40 + kk] = (u16)f2bf(d.w);
                }
            }
            __syncthreads();
            bf16x8 af[4], bfr[2], bfr2[2];
#pragma unroll
            for (int mi = 0; mi < 4; ++mi) af[mi] = *(const bf16x8*)(sA + (wm * 64 + mi * 16 + r16) * 40 + quad * 8);
#pragma unroll
            for (int ni = 0; ni < 2; ++ni) {
                bfr[ni] = *(const bf16x8*)(sB + (wn * 32 + ni * 16 + r16) * 40 + quad * 8);
                if (DUAL) bfr2[ni] = *(const bf16x8*)(sB2 + (wn * 32 + ni * 16 + r16) * 40 + quad * 8);
            }
#pragma unroll
            for (int mi = 0; mi < 4; ++mi)
#pragma unroll
                for (int ni = 0; ni < 2; ++ni) {
                    acc[mi][ni] = __builtin_amdgcn_mfma_f32_16x16x32_bf16(af[mi], bfr[ni], acc[mi][ni], 0, 0, 0);
                    if (DUAL) acc2[mi][ni] = __builtin_amdgcn_mfma_f32_16x16x32_bf16(af[mi], bfr2[ni], acc2[mi][ni], 0, 0, 0);
                }
            __syncthreads();
        }
#pragma unroll
        for (int mi = 0; mi < 4; ++mi)
#pragma unroll
            for (int ni = 0; ni < 2; ++ni)
#pragma unroll
                for (int j = 0; j < 4; ++j) {
                    const int row = m0 + wm * 64 + mi * 16 + quad * 4 + j, col = n0 + wn * 32 + ni * 16 + r16;
                    epi(row, col, acc[mi][ni][j], DUAL ? acc2[mi][ni][j] : 0.f);
                }
    }
}

struct EpiStore { u16* O; int ld; DEV void operator()(int r, int c, float v, float) const { O[(size_t)r * ld + c] = (u16)f2bf(v); } };
struct EpiStoreOdd { u16* Q; u16* Z;
    DEV void operator()(int r, int c, float v, float) const { if (c < 1536) Q[(size_t)r * 1536 + c] = (u16)f2bf(v); else Z[(size_t)r * ZDW + (c - 1536)] = (u16)f2bf(v); } };
struct EpiResid { PPtr p; const float* gate;
    DEV void operator()(int r, int c, float v, float) const { float* xr = xrow_ptr(p, r); xr[c] += gate[mod_idx(r) * 6144 + c] * v; } };
struct EpiSwiglu { u16* H;
    DEV void operator()(int r, int c, float g, float u) const { H[(size_t)r * FFH + c] = (u16)f2bf(g * sigmoidf_(g) * u); } };

DEV void phase_even_post(PPtr p, int li) {
    const int lane = tidx() & 63, gw = blockIdx.x * NWAVE + (tidx() >> 6), ngw = gridDim.x * NWAVE;
    u16* RAW = (u16*)(p->ws + OFF_RAW);
    const float* qg = p->in[10] + li * 64; const float* kg = p->in[11] + li * 64;
    const int half = lane >> 5, i = lane & 31;
    const float inv = powf(10000.f, -(float)(i & 15) / 16.f);
    for (int m = gw; m < MROWS; m += ngw) {
        const int b = m / RPB, q = m - b * RPB;
        float cs = 1.f, sn = 0.f;
        if (q < SEQ) { const float pos = (i < 16) ? (float)(q >> 6) : (float)(q & 63); const float ang = pos * inv; sn = sinf(ang); cs = cosf(ang); }
        u16* row = RAW + (size_t)m * 1536;
        for (int hs = 0; hs < 20; hs += 2) {
            const int s = hs + half; int c0; const float* gn = nullptr;
            if (s < 8) { c0 = s * 64; gn = qg; } else if (s < 10) { c0 = 512 + (s - 8) * 64; gn = kg; } else if (s < 18) { c0 = 768 + (s - 10) * 64; } else { c0 = 1280 + (s - 18) * 64; }
            float v1 = bf2f(row[c0 + i]), v2 = bf2f(row[c0 + i + 32]);
            if (hs < 10) {
                float ss = v1 * v1 + v2 * v2;
#pragma unroll
                for (int o = 1; o < 32; o <<= 1) ss += __shfl_xor(ss, o);
                const float rs = rsqrtf(ss * (1.f / 64.f) + 1e-6f);
                v1 *= rs * gn[i]; v2 *= rs * gn[i + 32];
            }
            const float o1 = v1 * cs - v2 * sn, o2 = v1 * sn + v2 * cs;
            row[c0 + i] = (u16)f2bf(o1); row[c0 + i + 32] = (u16)f2bf(o2);
        }
    }
}

template <int mode, bool qctx>
DEV void attn_wave(const u16* QB, int pitch, int qcol, int kcol, int vcol, u16* AO, int ocol,
                   int b, int hk, int blk, const float* sinkp, const float* rpb, u16* sV) {
    const int lane = tidx() & 63, qi = lane & 15, quad = lane >> 4;
    const bool gqa = mode < 2;
    const size_t rowb = (size_t)b * RPB;
    const float SCL = 0.125f * LOG2E;
    int qtok[4], qhead[4]; bf16x8 qf[4][2];
#pragma unroll
    for (int i = 0; i < 4; ++i) {
        qtok[i] = gqa ? blk * 16 + qi : blk * 64 + i * 16 + qi; qhead[i] = gqa ? hk * 4 + i : hk;
        const size_t m = rowb + (qctx ? SEQ : 0) + qtok[i];
        const u16* qp = QB + m * pitch + qcol + qhead[i] * 64 + quad * 8;
        qf[i][0] = *(const bf16x8*)qp; qf[i][1] = *(const bf16x8*)(qp + 32);
    }
    f32x4 o[4][4]; float mrun[4], lrun[4];
#pragma unroll
    for (int i = 0; i < 4; ++i) {
#pragma unroll
        for (int d = 0; d < 4; ++d) o[i][d] = (f32x4){0.f, 0.f, 0.f, 0.f};
        if (mode == 1) { mrun[i] = sinkp[qhead[i]] * LOG2E; lrun[i] = (quad == 0) ? 1.f : 0.f; } else { mrun[i] = -1e30f; lrun[i] = 0.f; }
    }
    const u16* Kb = QB + kcol + hk * 64; const u16* Vb = QB + vcol + hk * 64;
    int n_local, ustart, rs = 0;
    if (qctx) { n_local = 0; ustart = 0; }
    else if (mode == 0) { n_local = RPB / 32; ustart = 0; }
    else if (mode == 1) { n_local = 9; ustart = blk * 16 - 128; }
    else { rs = min(max(blk - 4, 0), 248); n_local = 16; ustart = rs * 64; }
    const int n_ctx = (mode == 0 && !qctx) ? 0 : 8;
    for (int tt = 0; tt < n_local + n_ctx; ++tt) {
        const bool loc = tt < n_local;
        const int u0 = loc ? ustart + 32 * tt : SEQ + 32 * (tt - n_local);
        const bool masked = loc && mode != 0;
        bf16x8 kf[2][2];
#pragma unroll
        for (int kt = 0; kt < 2; ++kt) {
            const int u = min(max(u0 + kt * 16 + qi, 0), RPB - 1);
            const u16* kp = Kb + (rowb + u) * pitch + quad * 8;
            kf[kt][0] = *(const bf16x8*)kp; kf[kt][1] = *(const bf16x8*)(kp + 32);
        }
#pragma unroll
        for (int c = 0; c < 4; ++c) {
            const int idx = c * 64 + lane, key = idx >> 3, dc = idx & 7;
            const int u = min(max(u0 + key, 0), RPB - 1);
            const uint4 v = *(const uint4*)(Vb + (rowb + u) * pitch + dc * 8);
            *(uint4*)(sV + key * 72 + dc * 8) = v;
        }
        bf16x8 vf[4];
#pragma unroll
        for (int dt = 0; dt < 4; ++dt)
#pragma unroll
            for (int jj = 0; jj < 8; ++jj) {
                const int key = (jj < 4) ? quad * 4 + jj : 16 + quad * 4 + (jj - 4);
                vf[dt][jj] = (short)sV[key * 72 + dt * 16 + qi];
            }
#pragma unroll
        for (int i = 0; i < 4; ++i) {
            f32x4 s0 = (f32x4){0.f, 0.f, 0.f, 0.f}, s1 = (f32x4){0.f, 0.f, 0.f, 0.f};
            s0 = __builtin_amdgcn_mfma_f32_16x16x32_bf16(kf[0][0], qf[i][0], s0, 0, 0, 0);
            s0 = __builtin_amdgcn_mfma_f32_16x16x32_bf16(kf[0][1], qf[i][1], s0, 0, 0, 0);
            s1 = __builtin_amdgcn_mfma_f32_16x16x32_bf16(kf[1][0], qf[i][0], s1, 0, 0, 0);
            s1 = __builtin_amdgcn_mfma_f32_16x16x32_bf16(kf[1][1], qf[i][1], s1, 0, 0, 0);
            float sc[8];
#pragma unroll
            for (int j = 0; j < 4; ++j) { sc[j] = s0[j] * SCL; sc[4 + j] = s1[j] * SCL; }
            if (masked) {
                const int t = qtok[i];
#pragma unroll
                for (int e = 0; e < 8; ++e) {
                    const int u = u0 + (e >> 2) * 16 + quad * 4 + (e & 3);
                    if (mode == 1) {
                        const int dd = t - u;
                        const bool ok = (u >= 0) && (u < SEQ) && (dd <= 128) && (dd >= -128);
                        if (!ok) sc[e] = -INFINITY;
                    } else {
                        const int c = t & 63, r = t >> 6, ur = u >> 6, uc = u & 63;
                        const int cst = min(max(c - 8, 0), 48);
                        const bool ok = (uc >= cst) && (uc < cst + 16);
                        const int dr = min(max(ur - r + 7, 0), 14), dcx = min(max(uc - c + 15, 0), 30);
                        const float bias = rpb[(qhead[i] * 15 + dr) * 31 + dcx];
                        sc[e] = ok ? sc[e] + bias * LOG2E : -INFINITY;
                    }
                }
            }
            float mx = fmaxf(fmaxf(fmaxf(sc[0], sc[1]), fmaxf(sc[2], sc[3])), fmaxf(fmaxf(sc[4], sc[5]), fmaxf(sc[6], sc[7])));
            mx = fmaxf(mx, __shfl_xor(mx, 16)); mx = fmaxf(mx, __shfl_xor(mx, 32));
            const float mn = fmaxf(mrun[i], mx);
            const float al = __builtin_amdgcn_exp2f(mrun[i] - mn);
            mrun[i] = mn;
            float pe[8], ps = 0.f;
#pragma unroll
            for (int e = 0; e < 8; ++e) { pe[e] = __builtin_amdgcn_exp2f(sc[e] - mn); ps += pe[e]; }
            lrun[i] = lrun[i] * al + ps;
            union { unsigned u[4]; bf16x8 v; } pf;
            pf.u[0] = pk2(pe[0], pe[1]); pf.u[1] = pk2(pe[2], pe[3]); pf.u[2] = pk2(pe[4], pe[5]); pf.u[3] = pk2(pe[6], pe[7]);
#pragma unroll
            for (int dt = 0; dt < 4; ++dt) {
                o[i][dt] = o[i][dt] * al;
                o[i][dt] = __builtin_amdgcn_mfma_f32_16x16x32_bf16(vf[dt], pf.v, o[i][dt], 0, 0, 0);
            }
        }
    }
#pragma unroll
    for (int i = 0; i < 4; ++i) {
        float l = lrun[i]; l += __shfl_xor(l, 16); l += __shfl_xor(l, 32);
        const float inv = 1.f / l;
        const size_t m = rowb + (qctx ? SEQ : 0) + qtok[i];
        u16* op = AO + m * DM + ocol + qhead[i] * 64 + quad * 4;
#pragma unroll
        for (int dt = 0; dt < 4; ++dt) {
            uint2 w; w.x = pk2(o[i][dt][0] * inv, o[i][dt][1] * inv); w.y = pk2(o[i][dt][2] * inv, o[i][dt][3] * inv);
            *(uint2*)(op + dt * 16) = w;
        }
    }
}

DEV void phase_attn_even(PPtr p, int li, char* lds) {
    const int wave = tidx() >> 6, gw = blockIdx.x * NWAVE + wave, ngw = gridDim.x * NWAVE;
    u16* sV = (u16*)lds + wave * (32 * 72);
    const u16* RAW = (const u16*)(p->ws + OFF_RAW); u16* AO = (u16*)(p->ws + OFF_AO);
    const float* sink = p->in[12] + li * 8;
    for (int t = gw; t < 8320; t += ngw) {
        if (t < 4096) attn_wave<0, false>(RAW, 1536, 0, 512, 640, AO, 0, t >> 11, (t >> 10) & 1, t & 1023, nullptr, nullptr, sV);
        else if (t < 8192) { const int u = t - 4096; attn_wave<1, false>(RAW, 1536, 768, 1280, 1408, AO, 512, u >> 11, (u >> 10) & 1, u & 1023, sink, nullptr, sV); }
        else if (t < 8256) { const int u = t - 8192; attn_wave<0, true>(RAW, 1536, 0, 512, 640, AO, 0, u >> 5, (u >> 4) & 1, u & 15, nullptr, nullptr, sV); }
        else { const int u = t - 8256; attn_wave<1, true>(RAW, 1536, 768, 1280, 1408, AO, 512, u >> 5, (u >> 4) & 1, u & 15, sink, nullptr, sV); }
    }
}
DEV void phase_attn_odd(PPtr p, int li, char* lds) {
    const int wave = tidx() >> 6, gw = blockIdx.x * NWAVE + wave, ngw = gridDim.x * NWAVE;
    u16* sV = (u16*)lds + wave * (32 * 72);
    const u16* QKV = (const u16*)(p->ws + OFF_RAW); u16* AO = (u16*)(p->ws + OFF_AO);
    const float* rpb = p->in[15] + li * 8 * 15 * 31;
    for (int t = gw; t < 4160; t += ngw) {
        if (t < 4096) attn_wave<2, false>(QKV, 1536, 0, 512, 1024, AO, 0, t >> 11, (t >> 8) & 7, t & 255, nullptr, rpb, sV);
        else { const int u = t - 4096; attn_wave<2, true>(QKV, 1536, 0, 512, 1024, AO, 0, u >> 5, (u >> 2) & 7, u & 3, nullptr, rpb, sV); }
    }
}

DEV float shiftmix_at(const u16* ZDb, int pp, int ch, float mu) {
    const bool lat = pp < SEQ; const int lo = lat ? 0 : SEQ, hi = lat ? SEQ : RPB;
    const u16* zc = ZDb + (size_t)pp * ZDW + ch;
    const float z = bf2f(zc[0]);
    const float a = (pp - 1 >= lo) ? bf2f(zc[-ZDW]) : 0.f, c = (pp + 1 < hi) ? bf2f(zc[ZDW]) : 0.f;
    return z + (0.5f * (a + c) - z) * mu;
}
DEV void phase_rwkv_prep(PPtr p, int li, int bb) {
    const int lane = tidx() & 63, gw = blockIdx.x * NWAVE + (tidx() >> 6), ngw = gridDim.x * NWAVE;
    const u16* ZDb = (const u16*)(p->ws + OFF_ZD) + (size_t)bb * RPB * ZDW;
    const float* mu = p->in[16] + li * ZDW; const float* kkw = p->in[22] + li * 512;
    u16* R = (u16*)(p->ws + OFF_R); u16* KK = (u16*)(p->ws + OFF_KK); u16* V = (u16*)(p->ws + OFF_V); u16* LA = (u16*)(p->ws + OFF_LA);
    {
        float4* Yz = (float4*)(p->ws + OFF_Y0); const float4 z = {0.f, 0.f, 0.f, 0.f};
        for (size_t i = (size_t)gw * 64 + lane; i < (size_t)RPB * 512 / 4; i += (size_t)ngw * 64) Yz[i] = z;
    }
    for (int pp = gw; pp < RPB; pp += ngw) {
        for (int j = 0; j < 28; ++j) {
            const int ch = lane + 64 * j;
            const float zs = shiftmix_at(ZDb, pp, ch, mu[ch]);
            if (j < 8) R[(size_t)pp * 512 + ch] = (u16)f2bf(zs);
            else if (j < 16) {
                const float t = zs * kkw[ch - 512]; const float ss = wave_sum(t * t);
                KK[(size_t)pp * 512 + ch - 512] = (u16)f2bf(t / fmaxf(sqrtf(ss), 1e-12f));
            } else if (j < 24) V[(size_t)pp * 512 + ch - 1024] = (u16)f2bf(zs);
            else if (j == 24) LA[(size_t)pp * 256 + lane] = (u16)f2bf(tanhf(zs));
            else if (j == 25) LA[(size_t)pp * 256 + 64 + lane] = (u16)f2bf(zs);
            else LA[(size_t)pp * 256 + 128 + (ch - 1664)] = (u16)f2bf(sigmoidf_(zs));
        }
    }
}
struct EpiDecay { float* DEC; const float* w0; int d;
    DEV void operator()(int r, int c, float v, float) const {
        const float x = -(w0[c] + v); const float sp = x > 20.f ? x : log1pf(expf(x)); const float w = -sp - 0.5f;
        DEC[((size_t)r * 2 + d) * 512 + c] = expf(-expf(w)); } };
struct EpiIclr { u16* KD; u16* BQ; const u16* KK; const u16* ZDb; const float* a0; const float* ka; const float* muk; int d;
    DEV void operator()(int r, int c, float v, float) const {
        const float a = sigmoidf_(a0[c] + v);
        const float k = shiftmix_at(ZDb, r, 512 + c, muk[c]);
        KD[((size_t)r * 2 + d) * 512 + c] = (u16)f2bf(k * (1.f + (a - 1.f) * ka[c]));
        BQ[((size_t)r * 2 + d) * 512 + c] = (u16)f2bf(bf2f(KK[(size_t)r * 512 + c]) * a); } };
struct EpiGate { u16* G; DEV void operator()(int r, int c, float v, float) const { G[(size_t)r * 512 + c] = (u16)f2bf(v); } };

DEV int pos_to_pp(int s, int d) { return (s < NCTX) ? (d ? SEQ + NCTX - 1 - s : SEQ + s) : (d ? SEQ - 1 - (s - NCTX) : s - NCTX); }
DEV void phase_scan1(PPtr p) {
    const int tid = tidx(), lane = tid & 63, gw = blockIdx.x * NWAVE + __builtin_amdgcn_readfirstlane(tid >> 6), ngw = gridDim.x * NWAVE;
    const float* DEC = (const float*)(p->ws + OFF_DEC); const u16* KD = (const u16*)(p->ws + OFF_KD); const u16* BQ = (const u16*)(p->ws + OFF_BQ);
    const u16* KK = (const u16*)(p->ws + OFF_KK); const u16* V = (const u16*)(p->ws + OFF_V);
    float* PU = (float*)(p->ws + OFF_PU);
    for (int task = gw; task < 16 * NCH; task += ngw) {
        const int seq = task >> 7, c = task & 127, h = seq >> 1, d = seq & 1;
        float P[64], U[64];
#pragma unroll
        for (int j = 0; j < 64; ++j) { P[j] = (j == lane) ? 1.f : 0.f; U[j] = 0.f; }
        for (int st = 0; st < CLEN; ++st) {
            const int pp = pos_to_pp(c * CLEN + st, d);
            const size_t e1 = (size_t)pp * 512 + h * 64, e2 = ((size_t)pp * 2 + d) * 512 + h * 64;
            cfp dec = (cfp)(uintptr_t)(DEC + e2);
            cup kd = (cup)(uintptr_t)(KD + e2), bq = (cup)(uintptr_t)(BQ + e2), kk = (cup)(uintptr_t)(KK + e1);
            const float vv = bf2f(V[e1 + lane]);
            float sp0 = 0.f, sp1 = 0.f, su0 = 0.f, su1 = 0.f;
#pragma unroll
            for (int c4 = 0; c4 < 4; ++c4) {
                cup kc = kk + c4 * 8; asm volatile("" : "+s"(kc));
#pragma unroll
                for (int j = 0; j < 8; ++j) { const unsigned u = kc[j]; const int jj = c4 * 8 + j; const float k0 = bflo(u), k1 = bfhi(u);
                    sp0 += P[2 * jj] * k0; sp1 += P[2 * jj + 1] * k1; su0 += U[2 * jj] * k0; su1 += U[2 * jj + 1] * k1; }
            }
            const float nsp = -(sp0 + sp1), nsu = -(su0 + su1);
#pragma unroll
            for (int c4 = 0; c4 < 4; ++c4) {
                cup kdc = kd + c4 * 8, bqc = bq + c4 * 8; cfp dc = dec + c4 * 16;
                asm volatile("" : "+s"(kdc), "+s"(bqc), "+s"(dc));
#pragma unroll
                for (int j = 0; j < 8; ++j) {
                    const int jj = c4 * 8 + j;
                    const unsigned uk = kdc[j], ub = bqc[j];
                    const float d0 = dc[2 * j], d1 = dc[2 * j + 1], b0 = bflo(ub), b1 = bfhi(ub);
                    P[2 * jj] = P[2 * jj] * d0 + nsp * b0; P[2 * jj + 1] = P[2 * jj + 1] * d1 + nsp * b1;
                    U[2 * jj] = U[2 * jj] * d0 + (vv * bflo(uk) + nsu * b0); U[2 * jj + 1] = U[2 * jj + 1] * d1 + (vv * bfhi(uk) + nsu * b1);
                }
            }
        }
        float4* o = (float4*)(PU + ((size_t)task * 2) * 4096 + lane * 64);
#pragma unroll
        for (int j = 0; j < 16; ++j) { o[j] = (float4){P[4 * j], P[4 * j + 1], P[4 * j + 2], P[4 * j + 3]}; o[1024 + j] = (float4){U[4 * j], U[4 * j + 1], U[4 * j + 2], U[4 * j + 3]}; }
    }
}
DEV void phase_scan2(PPtr p, char* lds) {
    if (blockIdx.x >= 16) return;
    const int tid = tidx(), lane = tid & 63, w = __builtin_amdgcn_readfirstlane(tid >> 6), seq = blockIdx.x;
    float* sS = (float*)lds;
    float* PU = (float*)(p->ws + OFF_PU);
    float S[64], mine[8];
#pragma unroll
    for (int j = 0; j < 64; ++j) S[j] = 0.f;
#pragma unroll
    for (int j = 0; j < 8; ++j) mine[j] = 0.f;
    for (int c = 0; c < NCH; ++c) {
        float* Pm = PU + ((size_t)(seq * NCH + c) * 2) * 4096; float* Um = Pm + 4096;
        float4* up = (float4*)(Um + lane * 64 + 8 * w);
        const float4 u0 = up[0], u1 = up[1];
        up[0] = (float4){mine[0], mine[1], mine[2], mine[3]}; up[1] = (float4){mine[4], mine[5], mine[6], mine[7]};
        float nw[8] = {u0.x, u0.y, u0.z, u0.w, u1.x, u1.y, u1.z, u1.w};
        const int w8 = __builtin_amdgcn_readfirstlane(8 * w);
#pragma unroll
        for (int i8 = 0; i8 < 8; ++i8) {
            cfp pr = (cfp)(uintptr_t)(Pm + (i8 * 8) * 64 + w8); asm volatile("" : "+s"(pr));
#pragma unroll
            for (int ii = 0; ii < 8; ++ii) {
#pragma unroll
                for (int k = 0; k < 8; ++k) nw[k] += S[i8 * 8 + ii] * pr[ii * 64 + k];
            }
        }
#pragma unroll
        for (int k = 0; k < 8; ++k) { sS[lane * 68 + 8 * w + k] = nw[k]; mine[k] = nw[k]; }
        __syncthreads();
#pragma unroll
        for (int j = 0; j < 16; ++j) { const float4 t = *(const float4*)(sS + lane * 68 + 4 * j); S[4 * j] = t.x; S[4 * j + 1] = t.y; S[4 * j + 2] = t.z; S[4 * j + 3] = t.w; }
        __syncthreads();
    }
}
DEV void phase_scan3(PPtr p) {
    const int tid = tidx(), lane = tid & 63, gw = blockIdx.x * NWAVE + __builtin_amdgcn_readfirstlane(tid >> 6), ngw = gridDim.x * NWAVE;
    const float* DEC = (const float*)(p->ws + OFF_DEC); const u16* KD = (const u16*)(p->ws + OFF_KD); const u16* BQ = (const u16*)(p->ws + OFF_BQ);
    const u16* KK = (const u16*)(p->ws + OFF_KK); const u16* R = (const u16*)(p->ws + OFF_R); const u16* V = (const u16*)(p->ws + OFF_V);
    const float* PU = (const float*)(p->ws + OFF_PU);
    float* Y = (float*)(p->ws + OFF_Y0);
    for (int task = gw; task < 16 * NCH; task += ngw) {
        const int seq = task >> 7, c = task & 127, h = seq >> 1, d = seq & 1;
        float S[64];
        {
            const float4* si = (const float4*)(PU + ((size_t)task * 2 + 1) * 4096 + lane * 64);
#pragma unroll
            for (int j = 0; j < 16; ++j) { const float4 t = si[j]; S[4 * j] = t.x; S[4 * j + 1] = t.y; S[4 * j + 2] = t.z; S[4 * j + 3] = t.w; }
        }
        for (int st = 0; st < CLEN; ++st) {
            const int pp = pos_to_pp(c * CLEN + st, d);
            const size_t e1 = (size_t)pp * 512 + h * 64, e2 = ((size_t)pp * 2 + d) * 512 + h * 64;
            cfp dec = (cfp)(uintptr_t)(DEC + e2);
            cup kd = (cup)(uintptr_t)(KD + e2), bq = (cup)(uintptr_t)(BQ + e2), kk = (cup)(uintptr_t)(KK + e1), rr = (cup)(uintptr_t)(R + e1);
            const float vv = bf2f(V[e1 + lane]);
            float sa0 = 0.f, sa1 = 0.f;
#pragma unroll
            for (int c4 = 0; c4 < 4; ++c4) {
                cup kc = kk + c4 * 8; asm volatile("" : "+s"(kc));
#pragma unroll
                for (int j = 0; j < 8; ++j) { const unsigned u = kc[j]; sa0 += S[2 * (c4 * 8 + j)] * bflo(u); sa1 += S[2 * (c4 * 8 + j) + 1] * bfhi(u); }
            }
            const float nsa = -(sa0 + sa1);
            float y0 = 0.f, y1 = 0.f;
#pragma unroll
            for (int c4 = 0; c4 < 4; ++c4) {
                cup kdc = kd + c4 * 8, bqc = bq + c4 * 8, rrc = rr + c4 * 8; cfp dc = dec + c4 * 16;
                asm volatile("" : "+s"(kdc), "+s"(bqc), "+s"(rrc), "+s"(dc));
#pragma unroll
                for (int j = 0; j < 8; ++j) {
                    const int jj = c4 * 8 + j;
                    const unsigned uk = kdc[j], ub = bqc[j], ur = rrc[j];
                    const float d0 = dc[2 * j], d1 = dc[2 * j + 1];
                    const float t0 = vv * bflo(uk) + nsa * bflo(ub), t1 = vv * bfhi(uk) + nsa * bfhi(ub);
                    S[2 * jj] = S[2 * jj] * d0 + t0; S[2 * jj + 1] = S[2 * jj + 1] * d1 + t1;
                    y0 += S[2 * jj] * bflo(ur); y1 += S[2 * jj + 1] * bfhi(ur);
                }
            }
            unsafeAtomicAdd(Y + e1 + lane, y0 + y1);
        }
    }
}
DEV void phase_readout(PPtr p, int li, int bb) {
    const int lane = tidx() & 63, gw = blockIdx.x * NWAVE + (tidx() >> 6), ngw = gridDim.x * NWAVE;
    const float* Y0 = (const float*)(p->ws + OFF_Y0);
    const u16* KD = (const u16*)(p->ws + OFF_KD); const u16* R = (const u16*)(p->ws + OFF_R); const u16* V = (const u16*)(p->ws + OFF_V); const u16* G = (const u16*)(p->ws + OFF_G);
    const float* rk = p->in[24] + li * 512; const float* lnw = p->in[25] + li * 512; const float* lnb = p->in[26] + li * 512;
    u16* AO = (u16*)(p->ws + OFF_AO);
    for (int pp = gw; pp < RPB; pp += ngw) {
        const size_t m = (size_t)bb * RPB + pp;
        for (int h = 0; h < 8; ++h) {
            const int c = h * 64 + lane; const size_t e = (size_t)pp * 512 + c;
            const float y = Y0[e];
            const float mean = wave_sum(y) * (1.f / 64.f); const float dv = y - mean; const float var = wave_sum(dv * dv) * (1.f / 64.f);
            const float yn = dv * rsqrtf(var + 64e-5f) * lnw[c] + lnb[c];
            const float r = bf2f(R[e]); const float ks = bf2f(KD[((size_t)pp * 2) * 512 + c]) + bf2f(KD[((size_t)pp * 2 + 1) * 512 + c]);
            const float bs = wave_sum(r * ks * rk[c]);
            AO[m * DM + 512 + c] = (u16)f2bf((yn + bs * bf2f(V[e])) * bf2f(G[e]));
        }
    }
}
DEV void phase_final(PPtr p) {
    const int lane = tidx() & 63, gw = blockIdx.x * NWAVE + (tidx() >> 6), ngw = gridDim.x * NWAVE;
    const float* gain = p->in[29];
    for (int m = gw; m < NB * SEQ; m += ngw) {
        float4* xr = (float4*)(p->out + (size_t)m * DM);
        float4 v[4]; float ss = 0.f;
#pragma unroll
        for (int j = 0; j < 4; ++j) { v[j] = xr[lane + 64 * j]; ss += v[j].x * v[j].x + v[j].y * v[j].y + v[j].z * v[j].z + v[j].w * v[j].w; }
        ss = wave_sum(ss);
        const float rstd = rsqrtf(ss * (1.f / DM) + 1e-6f);
#pragma unroll
        for (int j = 0; j < 4; ++j) {
            const float4 g = *(const float4*)(gain + (lane + 64 * j) * 4);
            float4 o; o.x = v[j].x * rstd * g.x; o.y = v[j].y * rstd * g.y; o.z = v[j].z * rstd * g.z; o.w = v[j].w * rstd * g.w;
            xr[lane + 64 * j] = o;
        }
    }
}

__global__ void __launch_bounds__(NTHR) mega(Params p_unused) {
    PPtr kp = (PPtr)__builtin_amdgcn_kernarg_segment_ptr();
#define p launder(kp)
    __shared__ __attribute__((aligned(16))) char lds[40960];
    cg::grid_group grid = cg::this_grid();
#define SYNC() do { __threadfence(); grid.sync(); __threadfence(); } while (0)
    unsigned char* ws = kp->ws;
    const float* mod = (const float*)(ws + OFF_MOD);
    u16* HN = (u16*)(ws + OFF_HN); u16* AO = (u16*)(ws + OFF_AO); u16* RAW = (u16*)(ws + OFF_RAW); u16* ZD = (u16*)(ws + OFF_ZD);
    phase_init(p, lds); SYNC();
    for (int layer = 0; layer < 4; ++layer) {
        const int li = layer >> 1;
        const float* lmod = mod + (size_t)layer * 3 * 6144;
        phase_normmod(p, layer, 0); SYNC();
        if (!(layer & 1)) {
            { EpiStore e{RAW, 1536}; gemm_simple<0>(HN, DM, p->in[8] + (size_t)li * DM * 1536, 1536, 0, MROWS, 1536, DM, e, lds); } SYNC();
            phase_even_post(p, li); SYNC();
            phase_attn_even(p, li, lds); SYNC();
            { EpiResid e{p, lmod + 2048}; gemm_simple<0>(AO, DM, p->in[9] + (size_t)li * DM * DM, DM, 0, MROWS, DM, DM, e, lds); } SYNC();
        } else {
            { EpiStoreOdd e{RAW, ZD}; gemm_simple<0>(HN, DM, p->in[13] + (size_t)li * DM * 3328, 3328, 0, MROWS, 3328, DM, e, lds); } SYNC();
            phase_attn_odd(p, li, lds); SYNC();
            for (int bb = 0; bb < 2; ++bb) {
                phase_rwkv_prep(p, li, bb); SYNC();
                const u16* LA = (const u16*)(ws + OFF_LA); const u16* ZDb = ZD + (size_t)bb * RPB * ZDW;
                for (int d = 0; d < 2; ++d) {
                    { EpiDecay e{(float*)(ws + OFF_DEC), p->in[17] + (li * 2 + d) * 512, d}; gemm_simple<0>(LA, 256, p->in[18] + (size_t)(li * 2 + d) * 64 * 512, 512, 0, RPB, 512, 64, e, lds); }
                    { EpiIclr e{(u16*)(ws + OFF_KD), (u16*)(ws + OFF_BQ), (const u16*)(ws + OFF_KK), ZDb, p->in[19] + (li * 2 + d) * 512, p->in[23] + li * 512, p->in[16] + li * ZDW + 512, d};
                      gemm_simple<0>(LA + 64, 256, p->in[20] + (size_t)(li * 2 + d) * 64 * 512, 512, 0, RPB, 512, 64, e, lds); }
                }
                { EpiGate e{(u16*)(ws + OFF_G)}; gemm_simple<0>(LA + 128, 256, p->in[21] + (size_t)li * 128 * 512, 512, 0, RPB, 512, 128, e, lds); }
                SYNC();
                phase_scan1(p); SYNC();
                phase_scan2(p, lds); SYNC();
                phase_scan3(p); SYNC();
                phase_readout(p, li, bb); SYNC();
            }
            { EpiResid e{p, lmod + 2048}; gemm_simple<0>(AO, DM, p->in[14] + (size_t)li * DM * DM, DM, 0, MROWS, DM, DM, e, lds); } SYNC();
        }
        phase_normmod(p, layer, 1); SYNC();
        { EpiSwiglu e{RAW}; gemm_simple<1>(HN, DM, p->in[27] + (size_t)layer * DM * 5632, 5632, FFH, MROWS, FFH, DM, e, lds); } SYNC();
        { EpiResid e{p, lmod + 5120}; gemm_simple<0>(RAW, FFH, p->in[28] + (size_t)layer * FFH * DM, DM, 0, MROWS, DM, FFH, e, lds); } SYNC();
    }
    phase_final(p);
#undef p
}

extern "C" void kernel_launch(void* const* d_in, const int* in_sizes, int n_in, void* d_out, int out_size, void* d_ws, size_t ws_size, hipStream_t stream) {
    static int grid = 0;
    if (grid == 0) {
        if (n_in != 30 || ws_size < WS_NEED || out_size != NB * SEQ * DM) { fprintf(stderr, "kernel_launch: unexpected problem shape (n_in %d ws %zu out %d)\n", n_in, ws_size, out_size); grid = -1; return; }
        int dev = 0, cus = 0, per_cu = 0;
        hipGetDevice(&dev);
        hipDeviceGetAttribute(&cus, hipDeviceAttributeMultiprocessorCount, dev);
        hipOccupancyMaxActiveBlocksPerMultiprocessor(&per_cu, (const void*)mega, NTHR, 0);
        if (per_cu < 1) per_cu = 1;
        if (per_cu > 1) per_cu = 1;
        grid = cus * per_cu;
    }
    if (grid < 0) return;
    Params p{};
    for (int i = 0; i < 30; ++i) p.in[i] = (const float*)d_in[i];
    p.out = (float*)d_out; p.ws = (unsigned char*)d_ws;
    void* args[] = {&p};
    hipError_t e = hipLaunchCooperativeKernel((const void*)mega, dim3(grid), dim3(NTHR), args, 0, stream);
    if (e != hipSuccess) fprintf(stderr, "cooperative launch failed: %s (grid %d)\n", hipGetErrorString(e), grid);
}
```

```cpp
#include <hip/hip_runtime.h>
#include <hip/hip_cooperative_groups.h>
#include <cstdio>
#include <cstdint>
namespace cg = cooperative_groups;

#define DEV __device__ __forceinline__
typedef unsigned short u16;
typedef short bf16x8 __attribute__((ext_vector_type(8)));
typedef float f32x4 __attribute__((ext_vector_type(4)));
typedef const __attribute__((address_space(4))) float* cfp;
typedef const __attribute__((address_space(4))) unsigned* cup;

constexpr int DM = 1024, NB = 2, SEQ = 16384, NCTX = 256, RPB = SEQ + NCTX, MROWS = NB * RPB;
constexpr int FFH = 2816, ZDW = 1792;
constexpr float LOG2E = 1.4426950408889634f;
constexpr int NTHR = 512, NWAVE = 8;
constexpr int LDS_BYTES = 132096;

constexpr size_t MiB = 1u << 20;
constexpr size_t OFF_MOD = 0;
constexpr size_t OFF_XC = 1 * MiB;
constexpr size_t OFF_WB = 3 * MiB;
constexpr size_t OFF_AO = 29 * MiB;
constexpr size_t OFF_HN = 94 * MiB;
constexpr size_t OFF_RAW = 159 * MiB;
constexpr size_t OFF_ZD = 257 * MiB;
constexpr size_t SZ_H = (size_t)RPB * 512 * 2;
constexpr size_t OFF_DEC = 94 * MiB;
constexpr size_t OFF_KD = OFF_DEC + 4 * SZ_H;
constexpr size_t OFF_BQ = OFF_KD + 2 * SZ_H;
constexpr size_t OFF_KK = OFF_BQ + 2 * SZ_H;
constexpr size_t OFF_R = OFF_KK + SZ_H;
constexpr size_t OFF_V = 371 * MiB;
constexpr size_t OFF_G = OFF_V + SZ_H;
constexpr size_t OFF_LA = OFF_G + SZ_H;
constexpr size_t OFF_Y0 = 412 * MiB;
constexpr size_t OFF_PU = OFF_Y0 + 2 * SZ_H;
constexpr size_t WS_NEED = 509 * MiB;
constexpr int NCH = 128, CLEN = 130;
static_assert(OFF_R + SZ_H <= OFF_ZD, "scan map");
static_assert(OFF_LA + SZ_H / 2 <= OFF_Y0, "scan map 2");
static_assert(OFF_PU + 64 * MiB <= WS_NEED, "scan map 3");
static_assert(OFF_RAW + (size_t)MROWS * FFH * 2 <= WS_NEED, "ffn hidden");

struct Params { const float* in[30]; float* out; unsigned char* ws; };
typedef const __attribute__((address_space(4))) Params* PPtr;
DEV int tidx() { int t = threadIdx.x; asm volatile("" : "+v"(t)); return t; }
DEV PPtr launder(PPtr p) { asm volatile("" : "+s"(p)); return p; }

DEV unsigned f2bf(float f) { unsigned u = __float_as_uint(f); return (u + 0x7fffu + ((u >> 16) & 1u)) >> 16; }
DEV float bf2f(u16 h) { return __uint_as_float(((unsigned)h) << 16); }
DEV float bflo(unsigned u) { return __uint_as_float(u << 16); }
DEV float bfhi(unsigned u) { return __uint_as_float(u & 0xffff0000u); }
DEV unsigned pk2(float lo, float hi) { return f2bf(lo) | (f2bf(hi) << 16); }
DEV float wave_sum(float v) {
#pragma unroll
    for (int o = 1; o < 64; o <<= 1) v += __shfl_xor(v, o);
    return v;
}
DEV float* xrow_ptr(PPtr p, int m) {
    int b = m / RPB, q = m - b * RPB;
    return q < SEQ ? p->out + (size_t)(b * SEQ + q) * DM : (float*)(p->ws + OFF_XC) + (size_t)(b * NCTX + (q - SEQ)) * DM;
}
DEV int mod_idx(int m) { int b = m / RPB, q = m - b * RPB; return q < SEQ ? b : 2; }
DEV float sigmoidf_(float x) { return 1.f / (1.f + __expf(-x)); }

DEV void phase_init(PPtr p, char* lds) {
    const int tid = tidx();
    const size_t gt = (size_t)blockIdx.x * NTHR + tid, ng = (size_t)gridDim.x * NTHR;
    {
        const float4* s = (const float4*)p->in[0]; float4* d = (float4*)p->out;
        const size_t n = (size_t)NB * SEQ * DM / 4;
        for (size_t i = gt; i < n; i += ng) d[i] = s[i];
        const float4* s2 = (const float4*)p->in[2]; float4* d2 = (float4*)(p->ws + OFF_XC);
        const size_t n2 = (size_t)NB * NCTX * DM / 4;
        for (size_t i = gt; i < n2; i += ng) d2[i] = s2[i];
    }
    float* red = (float*)lds;
    float* mod = (float*)(p->ws + OFF_MOD);
    const float* c = p->in[1]; const float* cc = p->in[3];
    for (int item = blockIdx.x; item < 192; item += gridDim.x) {
        const int l = item / 48, n0 = (item % 48) * 128, col = tid & 127, kp = tid >> 7;
        const float* w = p->in[4] + (size_t)l * DM * 6144 + n0 + col;
        float a0 = 0.f, a1 = 0.f, a2 = 0.f;
        for (int k = kp * 256; k < kp * 256 + 256; ++k) {
            const float wv = w[(size_t)k * 6144];
            const float c0 = c[k], c1 = c[DM + k], c2 = cc[k];
            a0 += c0 * sigmoidf_(c0) * wv; a1 += c1 * sigmoidf_(c1) * wv; a2 += c2 * sigmoidf_(c2) * wv;
        }
        red[(kp * 3 + 0) * 128 + col] = a0; red[(kp * 3 + 1) * 128 + col] = a1; red[(kp * 3 + 2) * 128 + col] = a2;
        __syncthreads();
        if (tid < 384) {
            const int mb = tid >> 7, cl = tid & 127;
            float s = red[(0 * 3 + mb) * 128 + cl] + red[(1 * 3 + mb) * 128 + cl] + red[(2 * 3 + mb) * 128 + cl] + red[(3 * 3 + mb) * 128 + cl];
            mod[(size_t)(l * 3 + mb) * 6144 + n0 + cl] = s + p->in[5][l * 6144 + n0 + cl];
        }
        __syncthreads();
    }
}

DEV void phase_normmod(PPtr p, int layer, int which) {
    const int lane = tidx() & 63, gw = blockIdx.x * NWAVE + (tidx() >> 6), ngw = gridDim.x * NWAVE;
    const float* gain = p->in[which ? 7 : 6] + layer * DM;
    const float* mod = (const float*)(p->ws + OFF_MOD) + (size_t)layer * 3 * 6144;
    u16* HN = (u16*)(p->ws + OFF_HN);
    for (int m = gw; m < MROWS; m += ngw) {
        const float* xr = xrow_ptr(p, m);
        const float* md = mod + mod_idx(m) * 6144 + (which ? 3072 : 0);
        float4 v[4]; float ss = 0.f;
#pragma unroll
        for (int j = 0; j < 4; ++j) { v[j] = ((const float4*)xr)[lane + 64 * j]; ss += v[j].x * v[j].x + v[j].y * v[j].y + v[j].z * v[j].z + v[j].w * v[j].w; }
        ss = wave_sum(ss);
        const float rstd = rsqrtf(ss * (1.f / DM) + 1e-6f);
#pragma unroll
        for (int j = 0; j < 4; ++j) {
            const int k = (lane + 64 * j) * 4;
            const float4 g = *(const float4*)(gain + k), sh = *(const float4*)(md + k), sc = *(const float4*)(md + 1024 + k);
            const float o0 = v[j].x * rstd * g.x * (1.f + sc.x) + sh.x, o1 = v[j].y * rstd * g.y * (1.f + sc.y) + sh.y;
            const float o2 = v[j].z * rstd * g.z * (1.f + sc.z) + sh.z, o3 = v[j].w * rstd * g.w * (1.f + sc.w) + sh.w;
            uint2 w; w.x = pk2(o0, o1); w.y = pk2(o2, o3);
            *(uint2*)(HN + (size_t)m * DM + k) = w;
        }
    }
}

template <int DUAL, class Epi>
DEV void gemm_simple(const u16* A, int lda, const float* W, int ldw, int dualoff, int M, int N, int K, const Epi& epi, char* lds) {
    u16* sA = (u16*)lds; u16* sB = sA + 128 * 40; u16* sB2 = sB + 128 * 40;
    const int tid = tidx(), lane = tid & 63, wave = tid >> 6, wm = wave >> 2, wn = wave & 3, r16 = lane & 15, quad = lane >> 4;
    const int mt = M / 128, nt = N / 128;
    for (int item = blockIdx.x; item < mt * nt; item += gridDim.x) {
        const int tn = item / mt, tm = item - tn * mt, m0 = tm * 128, n0 = tn * 128;
        f32x4 acc[4][2], acc2[4][2];
#pragma unroll
        for (int a = 0; a < 4; ++a)
#pragma unroll
            for (int b = 0; b < 2; ++b) { acc[a][b] = (f32x4){0.f, 0.f, 0.f, 0.f}; acc2[a][b] = (f32x4){0.f, 0.f, 0.f, 0.f}; }
        for (int k0 = 0; k0 < K; k0 += 32) {
            {
                const int row = tid >> 2, kc = (tid & 3) * 8;
                const uint4 v = *(const uint4*)(A + (size_t)(m0 + row) * lda + k0 + kc);
                *(uint4*)(sA + row * 40 + kc) = v;
            }
            {
                const int kk = tid >> 4, nc = (tid & 15) * 8;
                const float* wp = W + (size_t)(k0 + kk) * ldw + n0 + nc;
                const float4 a = *(const float4*)wp, b = *(const float4*)(wp + 4);
                sB[(nc + 0) * 40 + kk] = (u16)f2bf(a.x); sB[(nc + 1) * 40 + kk] = (u16)f2bf(a.y); sB[(nc + 2) * 40 + kk] = (u16)f2bf(a.z); sB[(nc + 3) * 40 + kk] = (u16)f2bf(a.w);
                sB[(nc + 4) * 40 + kk] = (u16)f2bf(b.x); sB[(nc + 5) * 40 + kk] = (u16)f2bf(b.y); sB[(nc + 6) * 40 + kk] = (u16)f2bf(b.z); sB[(nc + 7) * 40 + kk] = (u16)f2bf(b.w);
                if (DUAL) {
                    const float4 c = *(const float4*)(wp + dualoff), d = *(const float4*)(wp + dualoff + 4);
                    sB2[(nc + 0) * 40 + kk] = (u16)f2bf(c.x); sB2[(nc + 1) * 40 + kk] = (u16)f2bf(c.y); sB2[(nc + 2) * 40 + kk] = (u16)f2bf(c.z); sB2[(nc + 3) * 40 + kk] = (u16)f2bf(c.w);
                    sB2[(nc + 4) * 40 + kk] = (u16)f2bf(d.x); sB2[(nc + 5) * 40 + kk] = (u16)f2bf(d.y); sB2[(nc + 6) * 40 + kk] = (u16)f2bf(d.z); sB2[(nc + 7) * 40 + kk] = (u16)f2bf(d.w);
                }
            }
            __syncthreads();
            bf16x8 af[4], bfr[2], bfr2[2];
#pragma unroll
            for (int mi = 0; mi < 4; ++mi) af[mi] = *(const bf16x8*)(sA + (wm * 64 + mi * 16 + r16) * 40 + quad * 8);
#pragma unroll
            for (int ni = 0; ni < 2; ++ni) {
                bfr[ni] = *(const bf16x8*)(sB + (wn * 32 + ni * 16 + r16) * 40 + quad * 8);
                if (DUAL) bfr2[ni] = *(const bf16x8*)(sB2 + (wn * 32 + ni * 16 + r16) * 40 + quad * 8);
            }
#pragma unroll
            for (int mi = 0; mi < 4; ++mi)
#pragma unroll
                for (int ni = 0; ni < 2; ++ni) {
                    acc[mi][ni] = __builtin_amdgcn_mfma_f32_16x16x32_bf16(af[mi], bfr[ni], acc[mi][ni], 0, 0, 0);
                    if (DUAL) acc2[mi][ni] = __builtin_amdgcn_mfma_f32_16x16x32_bf16(af[mi], bfr2[ni], acc2[mi][ni], 0, 0, 0);
                }
            __syncthreads();
        }
#pragma unroll
        for (int mi = 0; mi < 4; ++mi)
#pragma unroll
            for (int ni = 0; ni < 2; ++ni)
#pragma unroll
                for (int j = 0; j < 4; ++j) {
                    const int row = m0 + wm * 64 + mi * 16 + quad * 4 + j, col = n0 + wn * 32 + ni * 16 + r16;
                    epi(row, col, acc[mi][ni][j], DUAL ? acc2[mi][ni][j] : 0.f);
                }
    }
}

struct EpiStore { u16* O; int ld; DEV void operator()(int r, int c, float v, float) const { O[(size_t)r * ld + c] = (u16)f2bf(v); } };
struct EpiStoreOdd { u16* Q; u16* Z;
    DEV void operator()(int r, int c, float v, float) const { if (c < 1536) Q[(size_t)r * 1536 + c] = (u16)f2bf(v); else Z[(size_t)r * ZDW + (c - 1536)] = (u16)f2bf(v); } };
struct EpiResid { PPtr p; const float* gate;
    DEV void operator()(int r, int c, float v, float) const { float* xr = xrow_ptr(p, r); xr[c] += gate[mod_idx(r) * 6144 + c] * v; } };
struct EpiSwiglu { u16* H;
    DEV void operator()(int r, int c, float g, float u) const { H[(size_t)r * FFH + c] = (u16)f2bf(g * sigmoidf_(g) * u); } };


namespace pg8 {
#define PG8_LAS __attribute__((address_space(3)))
typedef unsigned short bf16_t;
typedef short bf16x8 __attribute__((ext_vector_type(8)));
typedef float f32x4 __attribute__((ext_vector_type(4)));
typedef unsigned u32x4 __attribute__((ext_vector_type(4)));
constexpr int BM = 256, BK = 64, HALF = 128, HTB = HALF * BK * 2  , STAGE_BYTES = 8 * HTB, NXCD = 8, WGM = 8;

__host__ __device__ __forceinline__ int lds_byte(int r, int c) { const int st = (r >> 4) * 2 + (c >> 5), rr = r & 15, cc = c & 31, ob = rr * 64 + cc * 2; return st * 1024 + (ob ^ (((ob >> 9) & 1) << 5)); }
__host__ __device__ __forceinline__ void stage_rc(int b, int& R, int& C) { const int st = b / 1024, sb = b % 1024, swz = sb ^ (((sb >> 9) & 1) << 5); R = (st >> 1) * 16 + swz / 64; C = (st & 1) * 32 + (swz % 64) / 2; }
__host__ __device__ __forceinline__ int perm32(int rho) { const int n = rho >> 4, i = rho & 15; return 8 * (i >> 2) + 4 * n + (i & 3); }

struct Unit { int pm, pn; };
struct Gemm { const bf16_t* A; const bf16_t* Bt; int M, N, K; };

struct StaticOrder {
    int nM, nN, nwg, G, c;
    __host__ __device__ void init(int M, int N, int G_, int c_) { nM = M / BM; nN = N / BM; nwg = nM * nN; G = G_; c = c_; }
    __host__ __device__ bool next(int i, Unit& u) const {
        const long L = (long)i * G + c; if (L >= nwg) return false;
        int wgid = (int)L; { const int q = nwg / NXCD, r = nwg % NXCD, xcd = wgid % NXCD, off = wgid / NXCD; wgid = (xcd < r ? xcd * (q + 1) : r * (q + 1) + (xcd - r) * q) + off; }
        const int nig = WGM * nN, gid = wgid / nig, fm = gid * WGM, gsz = (nM - fm) < WGM ? (nM - fm) : WGM;
        u.pm = fm + ((wgid % nig) % gsz); u.pn = (wgid % nig) / gsz; return true;
    }
    __device__ __forceinline__ void a_ready(const Unit&) const {}
    __device__ __forceinline__ void done(const Unit&) const {}
};
__device__ __forceinline__ unsigned cvt_pk_bf16(float lo, float hi) { unsigned r; asm volatile("v_cvt_pk_bf16_f32 %0, %1, %2" : "=v"(r) : "v"(lo), "v"(hi)); return r; }
template <class Epi, class Sched, bool ALIGN_EPI = false, bool SP2 = false>
__device__ __forceinline__ void gemm_phase(PG8_LAS unsigned char* lds, const Gemm g, const Sched& S, const Epi& E) {
    const int tid = tidx(), wid = __builtin_amdgcn_readfirstlane(tid >> 6), lane = tid & 63, wr = wid >> 2, wc = wid & 3, fr = lane & 15, fq = lane >> 4;
    const int K = g.K, nt = K / BK;
    unsigned voffA[2], voffB[2];
#pragma unroll
    for (int i = 0; i < 2; ++i) { int R, C; stage_rc(tid * 16 + i * 8192, R, C); const int Rb = Epi::PERM ? ((R & ~31) + perm32(R & 31)) : R;
        voffA[i] = (unsigned)(R * K + C) * 2u; voffB[i] = (unsigned)(Rb * K + C) * 2u; }
    const size_t kstep = (size_t)(BK * 2);
    const size_t hstep = (size_t)HALF * K * 2;
    const size_t tstep = 2 * hstep;
    const unsigned ldsw = (unsigned)wid * 1024u;
    const int aoff = lds_byte(wr * 64 + fr, fq * 8), boff = lds_byte(wc * 32 + fr, fq * 8);
#define PG8_SA(b, h) (((b) * 2 + (h)) * HTB)
#define PG8_SB(b, h) ((4 + (b) * 2 + (h)) * HTB)
#define PG8_STAGE(bufoff, gbase, voff) do { _Pragma("unroll") for (int _i = 0; _i < 2; ++_i) \
        __builtin_amdgcn_global_load_lds((const unsigned*)((const char*)(gbase) + (voff)[_i]), (PG8_LAS unsigned*)(lds + (bufoff) + ldsw + _i * 8192), 16, 0, 0); } while (0)
#define PG8_LDA(dst, b, h) do { _Pragma("unroll") for (int m = 0; m < 4; ++m) _Pragma("unroll") for (int k = 0; k < 2; ++k) dst[m][k] = *(const PG8_LAS bf16x8*)(lds + PG8_SA(b, h) + aoff + m * 2048 + k * 1024); } while (0)
#define PG8_LDB(dst, b, h) do { _Pragma("unroll") for (int n = 0; n < 2; ++n) _Pragma("unroll") for (int k = 0; k < 2; ++k) dst[n][k] = *(const PG8_LAS bf16x8*)(lds + PG8_SB(b, h) + boff + n * 2048 + k * 1024); } while (0)
#define PG8_MMA(ai, bj, At, Bt) do { __builtin_amdgcn_s_setprio(1); _Pragma("unroll") for (int m = 0; m < 4; ++m) _Pragma("unroll") for (int n = 0; n < 2; ++n) _Pragma("unroll") for (int k = 0; k < 2; ++k) \
        acc[ai][bj][m][n] = __builtin_amdgcn_mfma_f32_16x16x32_bf16(Bt[n][k], At[m][k], acc[ai][bj][m][n], 0, 0, 0); __builtin_amdgcn_s_setprio(0); } while (0)
#define PG8_WAIT_V(n) asm volatile("s_waitcnt vmcnt(" #n ")" ::: "memory")
#define PG8_WAIT_L(n) asm volatile("s_waitcnt lgkmcnt(" #n ")" ::: "memory")
#define PG8_BAR __builtin_amdgcn_s_barrier()
#define PG8_SCHED __builtin_amdgcn_sched_barrier(0)
    Unit cur, nxt; int ui = 0;
    if (!S.next(0, cur)) return;
    f32x4 acc[2][2][4][2];
#pragma unroll
    for (int a = 0; a < 2; ++a)
#pragma unroll
        for (int b = 0; b < 2; ++b)
#pragma unroll
            for (int m = 0; m < 4; ++m)
#pragma unroll
                for (int n = 0; n < 2; ++n) acc[a][b][m][n] = (f32x4){0.f, 0.f, 0.f, 0.f};
    bf16x8 At[4][2], B0[2][2], B1[2][2];
    const char* cA = (const char*)g.A + (size_t)cur.pm * tstep; const char* cB = (const char*)g.Bt + (size_t)cur.pn * tstep;
    S.a_ready(cur);
    if constexpr (SP2) {
        PG8_STAGE(PG8_SB(0, 0), cB, voffB); PG8_STAGE(PG8_SB(0, 1), cB + hstep, voffB); PG8_STAGE(PG8_SA(0, 0), cA, voffA); PG8_STAGE(PG8_SA(0, 1), cA + hstep, voffA);
        if (wr == 1) PG8_BAR;
        PG8_WAIT_V(2); PG8_BAR;
        PG8_STAGE(PG8_SB(1, 0), cB + kstep, voffB); PG8_STAGE(PG8_SA(1, 0), cA + kstep, voffA); PG8_STAGE(PG8_SB(1, 1), cB + hstep + kstep, voffB);
        PG8_WAIT_V(6); PG8_BAR;
    } else {
        PG8_STAGE(PG8_SB(0, 0), cB, voffB); PG8_STAGE(PG8_SA(0, 0), cA, voffA); PG8_STAGE(PG8_SB(0, 1), cB + hstep, voffB); PG8_STAGE(PG8_SA(0, 1), cA + hstep, voffA);
        if (wr == 1) PG8_BAR;
        PG8_WAIT_V(4); PG8_BAR;
        PG8_STAGE(PG8_SB(1, 0), cB + kstep, voffB); PG8_STAGE(PG8_SA(1, 0), cA + kstep, voffA); PG8_STAGE(PG8_SB(1, 1), cB + hstep + kstep, voffB);
        PG8_WAIT_V(6); PG8_BAR;
    }
    for (;;) {
        const bool has_next = S.next(ui + 1, nxt);
        const char* nA = has_next ? (const char*)g.A + (size_t)nxt.pm * tstep : cA; const char* nB = has_next ? (const char*)g.Bt + (size_t)nxt.pn * tstep : cB;
        for (int t = 0; t < nt; t += 2) {
            const bool last = (t == nt - 2);
            const char* a1 = cA + (size_t)(t + 1) * kstep;
            const char* a2 = last ? nA : cA + (size_t)(t + 2) * kstep; const char* b2 = last ? nB : cB + (size_t)(t + 2) * kstep;
            const char* a3 = a2 + kstep; const char* b3 = b2 + kstep;
            if (last && has_next) S.a_ready(nxt);
            if constexpr (SP2) {
            PG8_LDB(B0, 0, 0); PG8_LDB(B1, 0, 1); PG8_SCHED; PG8_LDA(At, 0, 0); PG8_STAGE(PG8_SA(1, 1), a1 + hstep, voffA);
            PG8_WAIT_V(8); PG8_WAIT_L(0); PG8_BAR; PG8_MMA(0, 0, At, B0); PG8_MMA(0, 1, At, B1); PG8_BAR; PG8_SCHED;
            PG8_LDA(At, 0, 1); PG8_STAGE(PG8_SB(0, 0), b2, voffB); PG8_STAGE(PG8_SB(0, 1), b2 + hstep, voffB); PG8_STAGE(PG8_SA(0, 0), a2, voffA);
            PG8_WAIT_V(8); PG8_WAIT_L(0); PG8_BAR; PG8_MMA(1, 0, At, B0); PG8_MMA(1, 1, At, B1); PG8_BAR; PG8_SCHED;
            PG8_LDB(B0, 1, 0); PG8_LDB(B1, 1, 1); PG8_SCHED; PG8_LDA(At, 1, 0); PG8_STAGE(PG8_SA(0, 1), a2 + hstep, voffA);
            PG8_WAIT_V(8); PG8_WAIT_L(0); PG8_BAR; PG8_MMA(0, 0, At, B0); PG8_MMA(0, 1, At, B1); PG8_BAR; PG8_SCHED;
            PG8_LDA(At, 1, 1); PG8_STAGE(PG8_SB(1, 0), b3, voffB); PG8_STAGE(PG8_SB(1, 1), b3 + hstep, voffB); PG8_STAGE(PG8_SA(1, 0), a3, voffA);
            PG8_WAIT_V(8); PG8_WAIT_L(0); PG8_BAR; PG8_MMA(1, 0, At, B0); PG8_MMA(1, 1, At, B1); PG8_BAR; PG8_SCHED;
            } else {
            PG8_LDB(B0, 0, 0); PG8_SCHED; PG8_LDA(At, 0, 0); PG8_STAGE(PG8_SA(1, 1), a1 + hstep, voffA);
            PG8_WAIT_L(8); PG8_BAR; PG8_WAIT_L(0); PG8_MMA(0, 0, At, B0); PG8_BAR; PG8_SCHED;
            PG8_LDB(B1, 0, 1); PG8_STAGE(PG8_SB(0, 0), b2, voffB);
            PG8_BAR; PG8_WAIT_L(0); PG8_MMA(0, 1, At, B1); PG8_BAR;
            PG8_LDA(At, 0, 1); PG8_STAGE(PG8_SA(0, 0), a2, voffA);
            PG8_BAR; PG8_WAIT_L(0); PG8_MMA(1, 0, At, B0); PG8_BAR; PG8_SCHED;
            PG8_STAGE(PG8_SB(0, 1), b2 + hstep, voffB);
            PG8_WAIT_V(6); PG8_BAR; PG8_MMA(1, 1, At, B1); PG8_BAR;
            PG8_LDB(B0, 1, 0); PG8_SCHED; PG8_LDA(At, 1, 0); PG8_STAGE(PG8_SA(0, 1), a2 + hstep, voffA);
            PG8_WAIT_L(8); PG8_BAR; PG8_WAIT_L(0); PG8_MMA(0, 0, At, B0); PG8_BAR; PG8_SCHED;
            PG8_LDB(B1, 1, 1); PG8_STAGE(PG8_SB(1, 0), b3, voffB);
            PG8_BAR; PG8_WAIT_L(0); PG8_MMA(0, 1, At, B1); PG8_BAR;
            PG8_LDA(At, 1, 1); PG8_STAGE(PG8_SA(1, 0), a3, voffA);
            PG8_BAR; PG8_WAIT_L(0); PG8_MMA(1, 0, At, B0); PG8_BAR; PG8_SCHED;
            PG8_STAGE(PG8_SB(1, 1), b3 + hstep, voffB);
            PG8_WAIT_V(6); PG8_BAR; PG8_MMA(1, 1, At, B1); PG8_BAR;
            }
        }
        if constexpr (ALIGN_EPI) { if (wr == 0) PG8_BAR; }
        if constexpr (!Epi::AFTER_DRAIN) { E(acc, cur, wr, wc, fr, fq); S.done(cur); }
        if (!has_next) break;
#pragma unroll
        for (int a = 0; a < 2; ++a)
#pragma unroll
            for (int b = 0; b < 2; ++b)
#pragma unroll
                for (int m = 0; m < 4; ++m)
#pragma unroll
                    for (int n = 0; n < 2; ++n) acc[a][b][m][n] = (f32x4){0.f, 0.f, 0.f, 0.f};
        cur = nxt; cA = nA; cB = nB; ++ui;
        if constexpr (ALIGN_EPI) { if (wr == 1) PG8_BAR; }
    }
    PG8_WAIT_V(0);
    if constexpr (!ALIGN_EPI) { if (wr == 0) PG8_BAR; }
    PG8_BAR;
    if constexpr (Epi::AFTER_DRAIN) { E.fused(acc, cur, wr, wc, fr, fq, lds, wid, lane); S.done(cur); }
#undef PG8_SA
#undef PG8_SB
#undef PG8_STAGE
#undef PG8_LDA
#undef PG8_LDB
#undef PG8_MMA
#undef PG8_WAIT_V
#undef PG8_WAIT_L
#undef PG8_BAR
#undef PG8_SCHED
}

struct EpiStoreT {
    static constexpr bool PERM = true, AFTER_DRAIN = false;
    bf16_t* O0; int ld0; int split; bf16_t* O1; int ld1;
    __device__ __forceinline__ void operator()(const f32x4 (&acc)[2][2][4][2], const Unit& u, int wr, int wc, int fr, int fq) const {
        const int row0 = u.pm * BM + wr * 64 + fr; int colt = u.pn * BM; bf16_t* base = O0; int ld = ld0;
        if (colt >= split) { base = O1; ld = ld1; colt -= split; }
        const int col0 = colt + wc * 32 + 8 * fq;
#pragma unroll
        for (int ai = 0; ai < 2; ++ai)
#pragma unroll
            for (int m = 0; m < 4; ++m) { bf16_t* rowp = base + (size_t)(row0 + ai * HALF + m * 16) * ld + col0;
#pragma unroll
                for (int bj = 0; bj < 2; ++bj) { const f32x4 v0 = acc[ai][bj][m][0], v1 = acc[ai][bj][m][1];
                    u32x4 w; w.x = cvt_pk_bf16(v0[0], v0[1]); w.y = cvt_pk_bf16(v0[2], v0[3]); w.z = cvt_pk_bf16(v1[0], v1[1]); w.w = cvt_pk_bf16(v1[2], v1[3]);
                    *(u32x4*)(rowp + bj * HALF) = w; } }
    }
};
struct EpiResidT {
    static constexpr bool PERM = true, AFTER_DRAIN = false;
    PPtr p; const float* gate;
    __device__ __forceinline__ void operator()(const f32x4 (&acc)[2][2][4][2], const Unit& u, int wr, int wc, int fr, int fq) const {
        float* xb = xrow_ptr(p, u.pm * BM); const float* g = gate + mod_idx(u.pm * BM) * 6144;
        const int col0 = u.pn * BM + wc * 32 + 8 * fq;
#pragma unroll
        for (int ai = 0; ai < 2; ++ai)
#pragma unroll
            for (int m = 0; m < 4; ++m) { float* xr = xb + (size_t)(ai * HALF + wr * 64 + m * 16 + fr) * DM;
#pragma unroll
                for (int bj = 0; bj < 2; ++bj) { const int col = col0 + bj * HALF; const f32x4 v0 = acc[ai][bj][m][0], v1 = acc[ai][bj][m][1];
                    const f32x4 g0 = *(const f32x4*)(g + col), g1 = *(const f32x4*)(g + col + 4);
                    f32x4 x0 = *(const f32x4*)(xr + col), x1 = *(const f32x4*)(xr + col + 4);
                    x0 += g0 * v0; x1 += g1 * v1;
                    *(f32x4*)(xr + col) = x0; *(f32x4*)(xr + col + 4) = x1; } }
    }
};
struct EpiSwigluT {
    static constexpr bool PERM = true, AFTER_DRAIN = false;
    bf16_t* H;
    __device__ __forceinline__ void operator()(const f32x4 (&acc)[2][2][4][2], const Unit& u, int wr, int wc, int fr, int fq) const {
        const int row0 = u.pm * BM + wr * 64 + fr; const int col0 = u.pn * BM + wc * 32 + 8 * fq;
#pragma unroll
        for (int ai = 0; ai < 2; ++ai)
#pragma unroll
            for (int m = 0; m < 4; ++m) { bf16_t* rowp = H + (size_t)(row0 + ai * HALF + m * 16) * FFH;
#pragma unroll
                for (int bj = 0; bj < 2; ++bj) { const f32x4 gt = acc[ai][bj][m][0], up = acc[ai][bj][m][1];
                    float h[4];
#pragma unroll
                    for (int j = 0; j < 4; ++j) h[j] = gt[j] * sigmoidf_(gt[j]) * up[j];
                    uint2 w; w.x = cvt_pk_bf16(h[0], h[1]); w.y = cvt_pk_bf16(h[2], h[3]);
                    *(uint2*)(rowp + ((col0 + bj * HALF) >> 1)) = w; } }
    }
};
}

DEV void transpose_item(const float* W, int K, int N, u16* WT, int mode, float* scr, int item, int lane) {
    const int nblk = N / 32, kb = item / nblk, nb = item - kb * nblk, k0 = 64 * kb, n0 = 32 * nb;
#pragma unroll 8
    for (int i = 0; i < 32; ++i) { const int kk = 2 * i + (lane >> 5); scr[kk * 33 + (lane & 31)] = W[(size_t)(k0 + kk) * N + n0 + (lane & 31)]; }
    asm volatile("s_waitcnt lgkmcnt(0)" ::: "memory");
    const int c = lane & 7;
#pragma unroll
    for (int j = 0; j < 4; ++j) {
        const int n = (lane >> 3) + 8 * j; const float* sp = scr + (8 * c) * 33 + n;
        uint4 o; o.x = pk2(sp[0 * 33], sp[1 * 33]); o.y = pk2(sp[2 * 33], sp[3 * 33]); o.z = pk2(sp[4 * 33], sp[5 * 33]); o.w = pk2(sp[6 * 33], sp[7 * 33]);
        const int ns = n0 + n;
        int drow = ns;
        if (mode) { const int nn = ns >= FFH ? 1 : 0; const int g = ns - nn * FFH; drow = 8 * (g >> 2) + 4 * nn + (g & 3); }
        *(uint4*)(WT + (size_t)drow * K + k0 + 8 * c) = o;
    }
    asm volatile("s_waitcnt lgkmcnt(0)" ::: "memory");
}
constexpr size_t WB_IN = 0, WB_OUT = (size_t)3328 * 1024, WB_F1 = WB_OUT + (size_t)1024 * 1024, WB_F2 = WB_F1 + (size_t)5632 * 1024;
DEV void phase_wprep(PPtr p, int layer, char* lds) {
    const int tid = tidx(), lane = tid & 63, wave = tid >> 6, gw = blockIdx.x * NWAVE + wave, ngw = gridDim.x * NWAVE;
    float* scr = (float*)lds + wave * (64 * 33);
    u16* WB = (u16*)(p->ws + OFF_WB);
    const int li = layer >> 1, odd = layer & 1;
    const int nin = odd ? 3328 : 1536;
    const float* win = odd ? p->in[13] + (size_t)li * DM * 3328 : p->in[8] + (size_t)li * DM * 1536;
    const float* wout = (odd ? p->in[14] : p->in[9]) + (size_t)li * DM * DM;
    const float* wf1 = p->in[27] + (size_t)layer * DM * 5632; const float* wf2 = p->in[28] + (size_t)layer * FFH * DM;
    const int i0 = 16 * (nin / 32), i1 = i0 + 16 * 32, i2 = i1 + 16 * 176, i3 = i2 + 44 * 32;
    for (int it = gw; it < i3; it += ngw) {
        if (it < i0) transpose_item(win, DM, nin, WB + WB_IN, 0, scr, it, lane);
        else if (it < i1) transpose_item(wout, DM, DM, WB + WB_OUT, 0, scr, it - i0, lane);
        else if (it < i2) transpose_item(wf1, DM, 5632, WB + WB_F1, 1, scr, it - i1, lane);
        else transpose_item(wf2, FFH, DM, WB + WB_F2, 0, scr, it - i2, lane);
    }
}

DEV void phase_even_post(PPtr p, int li) {
    const int lane = tidx() & 63, gw = blockIdx.x * NWAVE + (tidx() >> 6), ngw = gridDim.x * NWAVE;
    u16* RAW = (u16*)(p->ws + OFF_RAW);
    const float* qg = p->in[10] + li * 64; const float* kg = p->in[11] + li * 64;
    const int half = lane >> 5, i = lane & 31;
    const float inv = powf(10000.f, -(float)(i & 15) / 16.f);
    for (int m = gw; m < MROWS; m += ngw) {
        const int b = m / RPB, q = m - b * RPB;
        float cs = 1.f, sn = 0.f;
        if (q < SEQ) { const float pos = (i < 16) ? (float)(q >> 6) : (float)(q & 63); const float ang = pos * inv; sn = sinf(ang); cs = cosf(ang); }
        u16* row = RAW + (size_t)m * 1536;
        for (int hs = 0; hs < 20; hs += 2) {
            const int s = hs + half; int c0; const float* gn = nullptr;
            if (s < 8) { c0 = s * 64; gn = qg; } else if (s < 10) { c0 = 512 + (s - 8) * 64; gn = kg; } else if (s < 18) { c0 = 768 + (s - 10) * 64; } else { c0 = 1280 + (s - 18) * 64; }
            float v1 = bf2f(row[c0 + i]), v2 = bf2f(row[c0 + i + 32]);
            if (hs < 10) {
                float ss = v1 * v1 + v2 * v2;
#pragma unroll
                for (int o = 1; o < 32; o <<= 1) ss += __shfl_xor(ss, o);
                const float rs = rsqrtf(ss * (1.f / 64.f) + 1e-6f);
                v1 *= rs * gn[i]; v2 *= rs * gn[i + 32];
            }
            const float o1 = v1 * cs - v2 * sn, o2 = v1 * sn + v2 * cs;
            row[c0 + i] = (u16)f2bf(o1); row[c0 + i + 32] = (u16)f2bf(o2);
        }
    }
}

template <int mode, bool qctx>
DEV void attn_wave(const u16* QB, int pitch, int qcol, int kcol, int vcol, u16* AO, int ocol,
                   int b, int hk, int blk, const float* sinkp, const float* rpb, u16* sV) {
    const int lane = tidx() & 63, qi = lane & 15, quad = lane >> 4;
    const bool gqa = mode < 2;
    const size_t rowb = (size_t)b * RPB;
    const float SCL = 0.125f * LOG2E;
    int qtok[4], qhead[4]; bf16x8 qf[4][2];
#pragma unroll
    for (int i = 0; i < 4; ++i) {
        qtok[i] = gqa ? blk * 16 + qi : blk * 64 + i * 16 + qi; qhead[i] = gqa ? hk * 4 + i : hk;
        const size_t m = rowb + (qctx ? SEQ : 0) + qtok[i];
        const u16* qp = QB + m * pitch + qcol + qhead[i] * 64 + quad * 8;
        qf[i][0] = *(const bf16x8*)qp; qf[i][1] = *(const bf16x8*)(qp + 32);
    }
    f32x4 o[4][4]; float mrun[4], lrun[4];
#pragma unroll
    for (int i = 0; i < 4; ++i) {
#pragma unroll
        for (int d = 0; d < 4; ++d) o[i][d] = (f32x4){0.f, 0.f, 0.f, 0.f};
        if (mode == 1) { mrun[i] = sinkp[qhead[i]] * LOG2E; lrun[i] = (quad == 0) ? 1.f : 0.f; } else { mrun[i] = -1e30f; lrun[i] = 0.f; }
    }
    const u16* Kb = QB + kcol + hk * 64; const u16* Vb = QB + vcol + hk * 64;
    int n_local, ustart, rs = 0;
    if (qctx) { n_local = 0; ustart = 0; }
    else if (mode == 0) { n_local = RPB / 32; ustart = 0; }
    else if (mode == 1) { n_local = 9; ustart = blk * 16 - 128; }
    else { rs = min(max(blk - 4, 0), 248); n_local = 16; ustart = rs * 64; }
    const int n_ctx = (mode == 0 && !qctx) ? 0 : 8;
    for (int tt = 0; tt < n_local + n_ctx; ++tt) {
        const bool loc = tt < n_local;
        const int u0 = loc ? ustart + 32 * tt : SEQ + 32 * (tt - n_local);
        const bool masked = loc && mode != 0;
        bf16x8 kf[2][2];
#pragma unroll
        for (int kt = 0; kt < 2; ++kt) {
            const int u = min(max(u0 + kt * 16 + qi, 0), RPB - 1);
            const u16* kp = Kb + (rowb + u) * pitch + quad * 8;
            kf[kt][0] = *(const bf16x8*)kp; kf[kt][1] = *(const bf16x8*)(kp + 32);
        }
#pragma unroll
        for (int c = 0; c < 4; ++c) {
            const int idx = c * 64 + lane, key = idx >> 3, dc = idx & 7;
            const int u = min(max(u0 + key, 0), RPB - 1);
            const uint4 v = *(const uint4*)(Vb + (rowb + u) * pitch + dc * 8);
            *(uint4*)(sV + key * 72 + dc * 8) = v;
        }
        bf16x8 vf[4];
#pragma unroll
        for (int dt = 0; dt < 4; ++dt)
#pragma unroll
            for (int jj = 0; jj < 8; ++jj) {
                const int key = (jj < 4) ? quad * 4 + jj : 16 + quad * 4 + (jj - 4);
                vf[dt][jj] = (short)sV[key * 72 + dt * 16 + qi];
            }
#pragma unroll
        for (int i = 0; i < 4; ++i) {
            f32x4 s0 = (f32x4){0.f, 0.f, 0.f, 0.f}, s1 = (f32x4){0.f, 0.f, 0.f, 0.f};
            s0 = __builtin_amdgcn_mfma_f32_16x16x32_bf16(kf[0][0], qf[i][0], s0, 0, 0, 0);
            s0 = __builtin_amdgcn_mfma_f32_16x16x32_bf16(kf[0][1], qf[i][1], s0, 0, 0, 0);
            s1 = __builtin_amdgcn_mfma_f32_16x16x32_bf16(kf[1][0], qf[i][0], s1, 0, 0, 0);
            s1 = __builtin_amdgcn_mfma_f32_16x16x32_bf16(kf[1][1], qf[i][1], s1, 0, 0, 0);
            float sc[8];
#pragma unroll
            for (int j = 0; j < 4; ++j) { sc[j] = s0[j] * SCL; sc[4 + j] = s1[j] * SCL; }
            if (masked) {
                const int t = qtok[i];
#pragma unroll
                for (int e = 0; e < 8; ++e) {
                    const int u = u0 + (e >> 2) * 16 + quad * 4 + (e & 3);
                    if (mode == 1) {
                        const int dd = t - u;
                        const bool ok = (u >= 0) && (u < SEQ) && (dd <= 128) && (dd >= -128);
                        if (!ok) sc[e] = -INFINITY;
                    } else {
                        const int c = t & 63, r = t >> 6, ur = u >> 6, uc = u & 63;
                        const int cst = min(max(c - 8, 0), 48);
                        const bool ok = (uc >= cst) && (uc < cst + 16);
                        const int dr = min(max(ur - r + 7, 0), 14), dcx = min(max(uc - c + 15, 0), 30);
                        const float bias = rpb[(qhead[i] * 15 + dr) * 31 + dcx];
                        sc[e] = ok ? sc[e] + bias * LOG2E : -INFINITY;
                    }
                }
            }
            float mx = fmaxf(fmaxf(fmaxf(sc[0], sc[1]), fmaxf(sc[2], sc[3])), fmaxf(fmaxf(sc[4], sc[5]), fmaxf(sc[6], sc[7])));
            mx = fmaxf(mx, __shfl_xor(mx, 16)); mx = fmaxf(mx, __shfl_xor(mx, 32));
            const float mn = fmaxf(mrun[i], mx);
            const float al = __builtin_amdgcn_exp2f(mrun[i] - mn);
            mrun[i] = mn;
            float pe[8], ps = 0.f;
#pragma unroll
            for (int e = 0; e < 8; ++e) { pe[e] = __builtin_amdgcn_exp2f(sc[e] - mn); ps += pe[e]; }
            lrun[i] = lrun[i] * al + ps;
            union { unsigned u[4]; bf16x8 v; } pf;
            pf.u[0] = pk2(pe[0], pe[1]); pf.u[1] = pk2(pe[2], pe[3]); pf.u[2] = pk2(pe[4], pe[5]); pf.u[3] = pk2(pe[6], pe[7]);
#pragma unroll
            for (int dt = 0; dt < 4; ++dt) {
                o[i][dt] = o[i][dt] * al;
                o[i][dt] = __builtin_amdgcn_mfma_f32_16x16x32_bf16(vf[dt], pf.v, o[i][dt], 0, 0, 0);
            }
        }
    }
#pragma unroll
    for (int i = 0; i < 4; ++i) {
        float l = lrun[i]; l += __shfl_xor(l, 16); l += __shfl_xor(l, 32);
        const float inv = 1.f / l;
        const size_t m = rowb + (qctx ? SEQ : 0) + qtok[i];
        u16* op = AO + m * DM + ocol + qhead[i] * 64 + quad * 4;
#pragma unroll
        for (int dt = 0; dt < 4; ++dt) {
            uint2 w; w.x = pk2(o[i][dt][0] * inv, o[i][dt][1] * inv); w.y = pk2(o[i][dt][2] * inv, o[i][dt][3] * inv);
            *(uint2*)(op + dt * 16) = w;
        }
    }
}

DEV void phase_attn_even(PPtr p, int li, char* lds) {
    const int wave = tidx() >> 6, gw = blockIdx.x * NWAVE + wave, ngw = gridDim.x * NWAVE;
    u16* sV = (u16*)lds + wave * (32 * 72);
    const u16* RAW = (const u16*)(p->ws + OFF_RAW); u16* AO = (u16*)(p->ws + OFF_AO);
    const float* sink = p->in[12] + li * 8;
    for (int t = gw; t < 8320; t += ngw) {
        if (t < 4096) attn_wave<0, false>(RAW, 1536, 0, 512, 640, AO, 0, t >> 11, (t >> 10) & 1, t & 1023, nullptr, nullptr, sV);
        else if (t < 8192) { const int u = t - 4096; attn_wave<1, false>(RAW, 1536, 768, 1280, 1408, AO, 512, u >> 11, (u >> 10) & 1, u & 1023, sink, nullptr, sV); }
        else if (t < 8256) { const int u = t - 8192; attn_wave<0, true>(RAW, 1536, 0, 512, 640, AO, 0, u >> 5, (u >> 4) & 1, u & 15, nullptr, nullptr, sV); }
        else { const int u = t - 8256; attn_wave<1, true>(RAW, 1536, 768, 1280, 1408, AO, 512, u >> 5, (u >> 4) & 1, u & 15, sink, nullptr, sV); }
    }
}
DEV void phase_attn_odd(PPtr p, int li, char* lds) {
    const int wave = tidx() >> 6, gw = blockIdx.x * NWAVE + wave, ngw = gridDim.x * NWAVE;
    u16* sV = (u16*)lds + wave * (32 * 72);
    const u16* QKV = (const u16*)(p->ws + OFF_RAW); u16* AO = (u16*)(p->ws + OFF_AO);
    const float* rpb = p->in[15] + li * 8 * 15 * 31;
    for (int t = gw; t < 4160; t += ngw) {
        if (t < 4096) attn_wave<2, false>(QKV, 1536, 0, 512, 1024, AO, 0, t >> 11, (t >> 8) & 7, t & 255, nullptr, rpb, sV);
        else { const int u = t - 4096; attn_wave<2, true>(QKV, 1536, 0, 512, 1024, AO, 0, u >> 5, (u >> 2) & 7, u & 3, nullptr, rpb, sV); }
    }
}

DEV float shiftmix_at(const u16* ZDb, int pp, int ch, float mu) {
    const bool lat = pp < SEQ; const int lo = lat ? 0 : SEQ, hi = lat ? SEQ : RPB;
    const u16* zc = ZDb + (size_t)pp * ZDW + ch;
    const float z = bf2f(zc[0]);
    const float a = (pp - 1 >= lo) ? bf2f(zc[-ZDW]) : 0.f, c = (pp + 1 < hi) ? bf2f(zc[ZDW]) : 0.f;
    return z + (0.5f * (a + c) - z) * mu;
}
DEV void phase_rwkv_prep(PPtr p, int li, int bb) {
    const int lane = tidx() & 63, gw = blockIdx.x * NWAVE + (tidx() >> 6), ngw = gridDim.x * NWAVE;
    const u16* ZDb = (const u16*)(p->ws + OFF_ZD) + (size_t)bb * RPB * ZDW;
    const float* mu = p->in[16] + li * ZDW; const float* kkw = p->in[22] + li * 512;
    u16* R = (u16*)(p->ws + OFF_R); u16* KK = (u16*)(p->ws + OFF_KK); u16* V = (u16*)(p->ws + OFF_V); u16* LA = (u16*)(p->ws + OFF_LA);
    {
        float4* Yz = (float4*)(p->ws + OFF_Y0); const float4 z = {0.f, 0.f, 0.f, 0.f};
        for (size_t i = (size_t)gw * 64 + lane; i < (size_t)RPB * 512 / 4; i += (size_t)ngw * 64) Yz[i] = z;
    }
    for (int pp = gw; pp < RPB; pp += ngw) {
        for (int j = 0; j < 28; ++j) {
            const int ch = lane + 64 * j;
            const float zs = shiftmix_at(ZDb, pp, ch, mu[ch]);
            if (j < 8) R[(size_t)pp * 512 + ch] = (u16)f2bf(zs);
            else if (j < 16) {
                const float t = zs * kkw[ch - 512]; const float ss = wave_sum(t * t);
                KK[(size_t)pp * 512 + ch - 512] = (u16)f2bf(t / fmaxf(sqrtf(ss), 1e-12f));
            } else if (j < 24) V[(size_t)pp * 512 + ch - 1024] = (u16)f2bf(zs);
            else if (j == 24) LA[(size_t)pp * 256 + lane] = (u16)f2bf(tanhf(zs));
            else if (j == 25) LA[(size_t)pp * 256 + 64 + lane] = (u16)f2bf(zs);
            else LA[(size_t)pp * 256 + 128 + (ch - 1664)] = (u16)f2bf(sigmoidf_(zs));
        }
    }
}
struct EpiDecay { float* DEC; const float* w0; int d;
    DEV void operator()(int r, int c, float v, float) const {
        const float x = -(w0[c] + v); const float sp = x > 20.f ? x : log1pf(expf(x)); const float w = -sp - 0.5f;
        DEC[((size_t)r * 2 + d) * 512 + c] = expf(-expf(w)); } };
struct EpiIclr { u16* KD; u16* BQ; const u16* KK; const u16* ZDb; const float* a0; const float* ka; const float* muk; int d;
    DEV void operator()(int r, int c, float v, float) const {
        const float a = sigmoidf_(a0[c] + v);
        const float k = shiftmix_at(ZDb, r, 512 + c, muk[c]);
        KD[((size_t)r * 2 + d) * 512 + c] = (u16)f2bf(k * (1.f + (a - 1.f) * ka[c]));
        BQ[((size_t)r * 2 + d) * 512 + c] = (u16)f2bf(bf2f(KK[(size_t)r * 512 + c]) * a); } };
struct EpiGate { u16* G; DEV void operator()(int r, int c, float v, float) const { G[(size_t)r * 512 + c] = (u16)f2bf(v); } };

DEV int pos_to_pp(int s, int d) { return (s < NCTX) ? (d ? SEQ + NCTX - 1 - s : SEQ + s) : (d ? SEQ - 1 - (s - NCTX) : s - NCTX); }
DEV void phase_scan1(PPtr p) {
    const int tid = tidx(), lane = tid & 63, gw = blockIdx.x * NWAVE + __builtin_amdgcn_readfirstlane(tid >> 6), ngw = gridDim.x * NWAVE;
    const float* DEC = (const float*)(p->ws + OFF_DEC); const u16* KD = (const u16*)(p->ws + OFF_KD); const u16* BQ = (const u16*)(p->ws + OFF_BQ);
    const u16* KK = (const u16*)(p->ws + OFF_KK); const u16* V = (const u16*)(p->ws + OFF_V);
    float* PU = (float*)(p->ws + OFF_PU);
    for (int task = gw; task < 16 * NCH; task += ngw) {
        const int seq = task >> 7, c = task & 127, h = seq >> 1, d = seq & 1;
        float P[64], U[64];
#pragma unroll
        for (int j = 0; j < 64; ++j) { P[j] = (j == lane) ? 1.f : 0.f; U[j] = 0.f; }
        for (int st = 0; st < CLEN; ++st) {
            const int pp = pos_to_pp(c * CLEN + st, d);
            const size_t e1 = (size_t)pp * 512 + h * 64, e2 = ((size_t)pp * 2 + d) * 512 + h * 64;
            cfp dec = (cfp)(uintptr_t)(DEC + e2);
            cup kd = (cup)(uintptr_t)(KD + e2), bq = (cup)(uintptr_t)(BQ + e2), kk = (cup)(uintptr_t)(KK + e1);
            const float vv = bf2f(V[e1 + lane]);
            float sp0 = 0.f, sp1 = 0.f, su0 = 0.f, su1 = 0.f;
#pragma unroll
            for (int c4 = 0; c4 < 4; ++c4) {
                cup kc = kk + c4 * 8; asm volatile("" : "+s"(kc));
#pragma unroll
                for (int j = 0; j < 8; ++j) { const unsigned u = kc[j]; const int jj = c4 * 8 + j; const float k0 = bflo(u), k1 = bfhi(u);
                    sp0 += P[2 * jj] * k0; sp1 += P[2 * jj + 1] * k1; su0 += U[2 * jj] * k0; su1 += U[2 * jj + 1] * k1; }
            }
            const float nsp = -(sp0 + sp1), nsu = -(su0 + su1);
#pragma unroll
            for (int c4 = 0; c4 < 4; ++c4) {
                cup kdc = kd + c4 * 8, bqc = bq + c4 * 8; cfp dc = dec + c4 * 16;
                asm volatile("" : "+s"(kdc), "+s"(bqc), "+s"(dc));
#pragma unroll
                for (int j = 0; j < 8; ++j) {
                    const int jj = c4 * 8 + j;
                    const unsigned uk = kdc[j], ub = bqc[j];
                    const float d0 = dc[2 * j], d1 = dc[2 * j + 1], b0 = bflo(ub), b1 = bfhi(ub);
                    P[2 * jj] = P[2 * jj] * d0 + nsp * b0; P[2 * jj + 1] = P[2 * jj + 1] * d1 + nsp * b1;
                    U[2 * jj] = U[2 * jj] * d0 + (vv * bflo(uk) + nsu * b0); U[2 * jj + 1] = U[2 * jj + 1] * d1 + (vv * bfhi(uk) + nsu * b1);
                }
            }
        }
        float4* o = (float4*)(PU + ((size_t)task * 2) * 4096 + lane * 64);
#pragma unroll
        for (int j = 0; j < 16; ++j) { o[j] = (float4){P[4 * j], P[4 * j + 1], P[4 * j + 2], P[4 * j + 3]}; o[1024 + j] = (float4){U[4 * j], U[4 * j + 1], U[4 * j + 2], U[4 * j + 3]}; }
    }
}
DEV void phase_scan2(PPtr p, char* lds) {
    if (blockIdx.x >= 16) return;
    const int tid = tidx(), lane = tid & 63, w = __builtin_amdgcn_readfirstlane(tid >> 6), seq = blockIdx.x;
    float* sS = (float*)lds;
    float* PU = (float*)(p->ws + OFF_PU);
    float S[64], mine[8];
#pragma unroll
    for (int j = 0; j < 64; ++j) S[j] = 0.f;
#pragma unroll
    for (int j = 0; j < 8; ++j) mine[j] = 0.f;
    for (int c = 0; c < NCH; ++c) {
        float* Pm = PU + ((size_t)(seq * NCH + c) * 2) * 4096; float* Um = Pm + 4096;
        float4* up = (float4*)(Um + lane * 64 + 8 * w);
        const float4 u0 = up[0], u1 = up[1];
        up[0] = (float4){mine[0], mine[1], mine[2], mine[3]}; up[1] = (float4){mine[4], mine[5], mine[6], mine[7]};
        float nw[8] = {u0.x, u0.y, u0.z, u0.w, u1.x, u1.y, u1.z, u1.w};
        const int w8 = __builtin_amdgcn_readfirstlane(8 * w);
#pragma unroll
        for (int i8 = 0; i8 < 8; ++i8) {
            cfp pr = (cfp)(uintptr_t)(Pm + (i8 * 8) * 64 + w8); asm volatile("" : "+s"(pr));
#pragma unroll
            for (int ii = 0; ii < 8; ++ii) {
#pragma unroll
                for (int k = 0; k < 8; ++k) nw[k] += S[i8 * 8 + ii] * pr[ii * 64 + k];
            }
        }
#pragma unroll
        for (int k = 0; k < 8; ++k) { sS[lane * 68 + 8 * w + k] = nw[k]; mine[k] = nw[k]; }
        __syncthreads();
#pragma unroll
        for (int j = 0; j < 16; ++j) { const float4 t = *(const float4*)(sS + lane * 68 + 4 * j); S[4 * j] = t.x; S[4 * j + 1] = t.y; S[4 * j + 2] = t.z; S[4 * j + 3] = t.w; }
        __syncthreads();
    }
}
DEV void phase_scan3(PPtr p) {
    const int tid = tidx(), lane = tid & 63, gw = blockIdx.x * NWAVE + __builtin_amdgcn_readfirstlane(tid >> 6), ngw = gridDim.x * NWAVE;
    const float* DEC = (const float*)(p->ws + OFF_DEC); const u16* KD = (const u16*)(p->ws + OFF_KD); const u16* BQ = (const u16*)(p->ws + OFF_BQ);
    const u16* KK = (const u16*)(p->ws + OFF_KK); const u16* R = (const u16*)(p->ws + OFF_R); const u16* V = (const u16*)(p->ws + OFF_V);
    const float* PU = (const float*)(p->ws + OFF_PU);
    float* Y = (float*)(p->ws + OFF_Y0);
    for (int task = gw; task < 16 * NCH; task += ngw) {
        const int seq = task >> 7, c = task & 127, h = seq >> 1, d = seq & 1;
        float S[64];
        {
            const float4* si = (const float4*)(PU + ((size_t)task * 2 + 1) * 4096 + lane * 64);
#pragma unroll
            for (int j = 0; j < 16; ++j) { const float4 t = si[j]; S[4 * j] = t.x; S[4 * j + 1] = t.y; S[4 * j + 2] = t.z; S[4 * j + 3] = t.w; }
        }
        for (int st = 0; st < CLEN; ++st) {
            const int pp = pos_to_pp(c * CLEN + st, d);
            const size_t e1 = (size_t)pp * 512 + h * 64, e2 = ((size_t)pp * 2 + d) * 512 + h * 64;
            cfp dec = (cfp)(uintptr_t)(DEC + e2);
            cup kd = (cup)(uintptr_t)(KD + e2), bq = (cup)(uintptr_t)(BQ + e2), kk = (cup)(uintptr_t)(KK + e1), rr = (cup)(uintptr_t)(R + e1);
            const float vv = bf2f(V[e1 + lane]);
            float sa0 = 0.f, sa1 = 0.f;
#pragma unroll
            for (int c4 = 0; c4 < 4; ++c4) {
                cup kc = kk + c4 * 8; asm volatile("" : "+s"(kc));
#pragma unroll
                for (int j = 0; j < 8; ++j) { const unsigned u = kc[j]; sa0 += S[2 * (c4 * 8 + j)] * bflo(u); sa1 += S[2 * (c4 * 8 + j) + 1] * bfhi(u); }
            }
            const float nsa = -(sa0 + sa1);
            float y0 = 0.f, y1 = 0.f;
#pragma unroll
            for (int c4 = 0; c4 < 4; ++c4) {
                cup kdc = kd + c4 * 8, bqc = bq + c4 * 8, rrc = rr + c4 * 8; cfp dc = dec + c4 * 16;
                asm volatile("" : "+s"(kdc), "+s"(bqc), "+s"(rrc), "+s"(dc));
#pragma unroll
                for (int j = 0; j < 8; ++j) {
                    const int jj = c4 * 8 + j;
                    const unsigned uk = kdc[j], ub = bqc[j], ur = rrc[j];
                    const float d0 = dc[2 * j], d1 = dc[2 * j + 1];
                    const float t0 = vv * bflo(uk) + nsa * bflo(ub), t1 = vv * bfhi(uk) + nsa * bfhi(ub);
                    S[2 * jj] = S[2 * jj] * d0 + t0; S[2 * jj + 1] = S[2 * jj + 1] * d1 + t1;
                    y0 += S[2 * jj] * bflo(ur); y1 += S[2 * jj + 1] * bfhi(ur);
                }
            }
            unsafeAtomicAdd(Y + e1 + lane, y0 + y1);
        }
    }
}
DEV void phase_readout(PPtr p, int li, int bb) {
    const int lane = tidx() & 63, gw = blockIdx.x * NWAVE + (tidx() >> 6), ngw = gridDim.x * NWAVE;
    const float* Y0 = (const float*)(p->ws + OFF_Y0);
    const u16* KD = (const u16*)(p->ws + OFF_KD); const u16* R = (const u16*)(p->ws + OFF_R); const u16* V = (const u16*)(p->ws + OFF_V); const u16* G = (const u16*)(p->ws + OFF_G);
    const float* rk = p->in[24] + li * 512; const float* lnw = p->in[25] + li * 512; const float* lnb = p->in[26] + li * 512;
    u16* AO = (u16*)(p->ws + OFF_AO);
    for (int pp = gw; pp < RPB; pp += ngw) {
        const size_t m = (size_t)bb * RPB + pp;
        for (int h = 0; h < 8; ++h) {
            const int c = h * 64 + lane; const size_t e = (size_t)pp * 512 + c;
            const float y = Y0[e];
            const float mean = wave_sum(y) * (1.f / 64.f); const float dv = y - mean; const float var = wave_sum(dv * dv) * (1.f / 64.f);
            const float yn = dv * rsqrtf(var + 64e-5f) * lnw[c] + lnb[c];
            const float r = bf2f(R[e]); const float ks = bf2f(KD[((size_t)pp * 2) * 512 + c]) + bf2f(KD[((size_t)pp * 2 + 1) * 512 + c]);
            const float bs = wave_sum(r * ks * rk[c]);
            AO[m * DM + 512 + c] = (u16)f2bf((yn + bs * bf2f(V[e])) * bf2f(G[e]));
        }
    }
}
DEV void phase_final(PPtr p) {
    const int lane = tidx() & 63, gw = blockIdx.x * NWAVE + (tidx() >> 6), ngw = gridDim.x * NWAVE;
    const float* gain = p->in[29];
    for (int m = gw; m < NB * SEQ; m += ngw) {
        float4* xr = (float4*)(p->out + (size_t)m * DM);
        float4 v[4]; float ss = 0.f;
#pragma unroll
        for (int j = 0; j < 4; ++j) { v[j] = xr[lane + 64 * j]; ss += v[j].x * v[j].x + v[j].y * v[j].y + v[j].z * v[j].z + v[j].w * v[j].w; }
        ss = wave_sum(ss);
        const float rstd = rsqrtf(ss * (1.f / DM) + 1e-6f);
#pragma unroll
        for (int j = 0; j < 4; ++j) {
            const float4 g = *(const float4*)(gain + (lane + 64 * j) * 4);
            float4 o; o.x = v[j].x * rstd * g.x; o.y = v[j].y * rstd * g.y; o.z = v[j].z * rstd * g.z; o.w = v[j].w * rstd * g.w;
            xr[lane + 64 * j] = o;
        }
    }
}

#define p launder(kp)
#define SYNC() do { __threadfence(); grid.sync(); __threadfence(); } while (0)
template <int layer>
DEV void do_layer(PPtr kp, cg::grid_group& grid, char* lds) {
    unsigned char* ws = launder(kp)->ws;
    const float* mod = (const float*)(ws + OFF_MOD);
    u16* HN = (u16*)(ws + OFF_HN); u16* AO = (u16*)(ws + OFF_AO); u16* RAW = (u16*)(ws + OFF_RAW); u16* ZD = (u16*)(ws + OFF_ZD);
        const int li = layer >> 1;
        const float* lmod = mod + (size_t)layer * 3 * 6144;
        phase_wprep(p, layer, lds); phase_normmod(p, layer, 0); SYNC();
        const pg8::bf16_t* WB = (const pg8::bf16_t*)(ws + OFF_WB);
#define GEMM8(A_, B_, N_, K_, E_) do { pg8::Gemm g_{(const pg8::bf16_t*)(A_), (B_), MROWS, (N_), (K_)}; pg8::StaticOrder S_; S_.init(MROWS, (N_), (int)gridDim.x, (int)blockIdx.x); \
            pg8::gemm_phase<decltype(E_), pg8::StaticOrder, true, true>((PG8_LAS unsigned char*)lds, g_, S_, E_); } while (0)
        if (!(layer & 1)) {
            { pg8::EpiStoreT e{RAW, 1536, 1 << 30, RAW, 1536}; GEMM8(HN, WB + WB_IN, 1536, DM, e); } SYNC();
            phase_even_post(p, li); SYNC();
            phase_attn_even(p, li, lds); SYNC();
            { pg8::EpiResidT e{p, lmod + 2048}; GEMM8(AO, WB + WB_OUT, DM, DM, e); } SYNC();
        } else {
            { pg8::EpiStoreT e{RAW, 1536, 1536, ZD, ZDW}; GEMM8(HN, WB + WB_IN, 3328, DM, e); } SYNC();
            phase_attn_odd(p, li, lds); SYNC();
            for (int bb = 0; bb < 2; ++bb) {
                phase_rwkv_prep(p, li, bb); SYNC();
                const u16* LA = (const u16*)(ws + OFF_LA); const u16* ZDb = ZD + (size_t)bb * RPB * ZDW;
                for (int d = 0; d < 2; ++d) {
                    { EpiDecay e{(float*)(ws + OFF_DEC), p->in[17] + (li * 2 + d) * 512, d}; gemm_simple<0>(LA, 256, p->in[18] + (size_t)(li * 2 + d) * 64 * 512, 512, 0, RPB, 512, 64, e, lds); }
                    { EpiIclr e{(u16*)(ws + OFF_KD), (u16*)(ws + OFF_BQ), (const u16*)(ws + OFF_KK), ZDb, p->in[19] + (li * 2 + d) * 512, p->in[23] + li * 512, p->in[16] + li * ZDW + 512, d};
                      gemm_simple<0>(LA + 64, 256, p->in[20] + (size_t)(li * 2 + d) * 64 * 512, 512, 0, RPB, 512, 64, e, lds); }
                }
                { EpiGate e{(u16*)(ws + OFF_G)}; gemm_simple<0>(LA + 128, 256, p->in[21] + (size_t)li * 128 * 512, 512, 0, RPB, 512, 128, e, lds); }
                SYNC();
                phase_scan1(p); SYNC();
                phase_scan2(p, lds); SYNC();
                phase_scan3(p); SYNC();
                phase_readout(p, li, bb); SYNC();
            }
            { pg8::EpiResidT e{p, lmod + 2048}; GEMM8(AO, WB + WB_OUT, DM, DM, e); } SYNC();
        }
        phase_normmod(p, layer, 1); SYNC();
        { pg8::EpiSwigluT e{RAW}; GEMM8(HN, WB + WB_F1, 5632, DM, e); } SYNC();
        { pg8::EpiResidT e{p, lmod + 5120}; GEMM8(RAW, WB + WB_F2, DM, FFH, e); } SYNC();
    }
__global__ void __launch_bounds__(NTHR) mega(Params p_unused) {
    PPtr kp = (PPtr)__builtin_amdgcn_kernarg_segment_ptr();
    extern __shared__ __attribute__((aligned(16))) char lds[];
    cg::grid_group grid = cg::this_grid();
    phase_init(p, lds); SYNC();
    do_layer<0>(kp, grid, lds);
    do_layer<1>(kp, grid, lds);
    do_layer<2>(kp, grid, lds);
    do_layer<3>(kp, grid, lds);
    phase_final(p);
}
#undef p
#undef SYNC

extern "C" void kernel_launch(void* const* d_in, const int* in_sizes, int n_in, void* d_out, int out_size, void* d_ws, size_t ws_size, hipStream_t stream) {
    static int grid = 0;
    if (grid == 0) {
        if (n_in != 30 || ws_size < WS_NEED || out_size != NB * SEQ * DM) { fprintf(stderr, "kernel_launch: unexpected problem shape (n_in %d ws %zu out %d)\n", n_in, ws_size, out_size); grid = -1; return; }
        int dev = 0, cus = 0, per_cu = 0;
        hipGetDevice(&dev);
        hipDeviceGetAttribute(&cus, hipDeviceAttributeMultiprocessorCount, dev);
        hipFuncSetAttribute((const void*)mega, hipFuncAttributeMaxDynamicSharedMemorySize, LDS_BYTES);
        hipOccupancyMaxActiveBlocksPerMultiprocessor(&per_cu, (const void*)mega, NTHR, LDS_BYTES);
        if (per_cu < 1) per_cu = 1;
        if (per_cu > 1) per_cu = 1;
        grid = cus * per_cu;
    }
    if (grid < 0) return;
    Params p{};
    for (int i = 0; i < 30; ++i) p.in[i] = (const float*)d_in[i];
    p.out = (float*)d_out; p.ws = (unsigned char*)d_ws;
    void* args[] = {&p};
    hipError_t e = hipLaunchCooperativeKernel((const void*)mega, dim3(grid), dim3(NTHR), args, LDS_BYTES, stream);
    if (e != hipSuccess) fprintf(stderr, "cooperative launch failed: %s (grid %d)\n", hipGetErrorString(e), grid);
}
```

```cpp
#include <hip/hip_runtime.h>
#include <hip/hip_cooperative_groups.h>
#include <cstdio>
#include <cstdint>
namespace cg = cooperative_groups;

#define DEV __device__ __forceinline__
typedef unsigned short u16;
typedef short bf16x8 __attribute__((ext_vector_type(8)));
typedef float f32x4 __attribute__((ext_vector_type(4)));
typedef const __attribute__((address_space(4))) float* cfp;
typedef const __attribute__((address_space(4))) unsigned* cup;

constexpr int DM = 1024, NB = 2, SEQ = 16384, NCTX = 256, RPB = SEQ + NCTX, MROWS = NB * RPB;
constexpr int FFH = 2816, ZDW = 1792;
constexpr float LOG2E = 1.4426950408889634f;
constexpr int NTHR = 512, NWAVE = 8;
constexpr int LDS_BYTES = 132096;

constexpr size_t MiB = 1u << 20;
constexpr size_t OFF_MOD = 0;
constexpr size_t OFF_XC = 1 * MiB;
constexpr size_t OFF_WB = 3 * MiB;
constexpr size_t OFF_AO = 29 * MiB;
constexpr size_t OFF_HN = 94 * MiB;
constexpr size_t OFF_RAW = 159 * MiB;
constexpr size_t OFF_ZD = 257 * MiB;
constexpr size_t SZ_H = (size_t)RPB * 512 * 2;
constexpr size_t OFF_DEC = 94 * MiB;
constexpr size_t OFF_KD = OFF_DEC + 4 * SZ_H;
constexpr size_t OFF_BQ = OFF_KD + 2 * SZ_H;
constexpr size_t OFF_KK = OFF_BQ + 2 * SZ_H;
constexpr size_t OFF_R = OFF_KK + SZ_H;
constexpr size_t OFF_V = 371 * MiB;
constexpr size_t OFF_G = OFF_V + SZ_H;
constexpr size_t OFF_LA = OFF_G + SZ_H;
constexpr size_t OFF_Y0 = 412 * MiB;
constexpr size_t OFF_PU = OFF_Y0 + 2 * SZ_H;
constexpr size_t WS_NEED = 509 * MiB;
constexpr int NCH = 128, CLEN = 130;
static_assert(OFF_R + SZ_H <= OFF_ZD, "scan map");
static_assert(OFF_LA + SZ_H / 2 <= OFF_Y0, "scan map 2");
static_assert(OFF_PU + 64 * MiB <= WS_NEED, "scan map 3");
static_assert(OFF_RAW + (size_t)MROWS * FFH * 2 <= WS_NEED, "ffn hidden");

struct Params { const float* in[30]; float* out; unsigned char* ws; };
typedef const __attribute__((address_space(4))) Params* PPtr;
DEV int tidx() { int t = threadIdx.x; asm volatile("" : "+v"(t)); return t; }
DEV PPtr launder(PPtr p) { asm volatile("" : "+s"(p)); return p; }

DEV unsigned f2bf(float f) { unsigned u = __float_as_uint(f); return (u + 0x7fffu + ((u >> 16) & 1u)) >> 16; }
DEV float bf2f(u16 h) { return __uint_as_float(((unsigned)h) << 16); }
DEV float bflo(unsigned u) { return __uint_as_float(u << 16); }
DEV float bfhi(unsigned u) { return __uint_as_float(u & 0xffff0000u); }
DEV unsigned pk2(float lo, float hi) { return f2bf(lo) | (f2bf(hi) << 16); }
DEV float wave_sum(float v) {
#pragma unroll
    for (int o = 1; o < 64; o <<= 1) v += __shfl_xor(v, o);
    return v;
}
DEV float* xrow_ptr(PPtr p, int m) {
    int b = m / RPB, q = m - b * RPB;
    return q < SEQ ? p->out + (size_t)(b * SEQ + q) * DM : (float*)(p->ws + OFF_XC) + (size_t)(b * NCTX + (q - SEQ)) * DM;
}
DEV int mod_idx(int m) { int b = m / RPB, q = m - b * RPB; return q < SEQ ? b : 2; }
DEV float sigmoidf_(float x) { return 1.f / (1.f + __expf(-x)); }

DEV void phase_init(PPtr p, char* lds) {
    const int tid = tidx();
    const size_t gt = (size_t)blockIdx.x * NTHR + tid, ng = (size_t)gridDim.x * NTHR;
    {
        const float4* s = (const float4*)p->in[0]; float4* d = (float4*)p->out;
        const size_t n = (size_t)NB * SEQ * DM / 4;
        for (size_t i = gt; i < n; i += ng) d[i] = s[i];
        const float4* s2 = (const float4*)p->in[2]; float4* d2 = (float4*)(p->ws + OFF_XC);
        const size_t n2 = (size_t)NB * NCTX * DM / 4;
        for (size_t i = gt; i < n2; i += ng) d2[i] = s2[i];
    }
    float* red = (float*)lds;
    float* mod = (float*)(p->ws + OFF_MOD);
    const float* c = p->in[1]; const float* cc = p->in[3];
    for (int item = blockIdx.x; item < 192; item += gridDim.x) {
        const int l = item / 48, n0 = (item % 48) * 128, col = tid & 127, kp = tid >> 7;
        const float* w = p->in[4] + (size_t)l * DM * 6144 + n0 + col;
        float a0 = 0.f, a1 = 0.f, a2 = 0.f;
        for (int k = kp * 256; k < kp * 256 + 256; ++k) {
            const float wv = w[(size_t)k * 6144];
            const float c0 = c[k], c1 = c[DM + k], c2 = cc[k];
            a0 += c0 * sigmoidf_(c0) * wv; a1 += c1 * sigmoidf_(c1) * wv; a2 += c2 * sigmoidf_(c2) * wv;
        }
        red[(kp * 3 + 0) * 128 + col] = a0; red[(kp * 3 + 1) * 128 + col] = a1; red[(kp * 3 + 2) * 128 + col] = a2;
        __syncthreads();
        if (tid < 384) {
            const int mb = tid >> 7, cl = tid & 127;
            float s = red[(0 * 3 + mb) * 128 + cl] + red[(1 * 3 + mb) * 128 + cl] + red[(2 * 3 + mb) * 128 + cl] + red[(3 * 3 + mb) * 128 + cl];
            mod[(size_t)(l * 3 + mb) * 6144 + n0 + cl] = s + p->in[5][l * 6144 + n0 + cl];
        }
        __syncthreads();
    }
}

DEV void phase_normmod(PPtr p, int layer, int which) {
    const int lane = tidx() & 63, gw = blockIdx.x * NWAVE + (tidx() >> 6), ngw = gridDim.x * NWAVE;
    const float* gain = p->in[which ? 7 : 6] + layer * DM;
    const float* mod = (const float*)(p->ws + OFF_MOD) + (size_t)layer * 3 * 6144;
    u16* HN = (u16*)(p->ws + OFF_HN);
    for (int m = gw; m < MROWS; m += ngw) {
        const float* xr = xrow_ptr(p, m);
        const float* md = mod + mod_idx(m) * 6144 + (which ? 3072 : 0);
        float4 v[4]; float ss = 0.f;
#pragma unroll
        for (int j = 0; j < 4; ++j) { v[j] = ((const float4*)xr)[lane + 64 * j]; ss += v[j].x * v[j].x + v[j].y * v[j].y + v[j].z * v[j].z + v[j].w * v[j].w; }
        ss = wave_sum(ss);
        const float rstd = rsqrtf(ss * (1.f / DM) + 1e-6f);
#pragma unroll
        for (int j = 0; j < 4; ++j) {
            const int k = (lane + 64 * j) * 4;
            const float4 g = *(const float4*)(gain + k), sh = *(const float4*)(md + k), sc = *(const float4*)(md + 1024 + k);
            const float o0 = v[j].x * rstd * g.x * (1.f + sc.x) + sh.x, o1 = v[j].y * rstd * g.y * (1.f + sc.y) + sh.y;
            const float o2 = v[j].z * rstd * g.z * (1.f + sc.z) + sh.z, o3 = v[j].w * rstd * g.w * (1.f + sc.w) + sh.w;
            uint2 w; w.x = pk2(o0, o1); w.y = pk2(o2, o3);
            *(uint2*)(HN + (size_t)m * DM + k) = w;
        }
    }
}

template <int DUAL, class Epi>
DEV void gemm_simple(const u16* A, int lda, const float* W, int ldw, int dualoff, int M, int N, int K, const Epi& epi, char* lds) {
    u16* sA = (u16*)lds; u16* sB = sA + 128 * 40; u16* sB2 = sB + 128 * 40;
    const int tid = tidx(), lane = tid & 63, wave = tid >> 6, wm = wave >> 2, wn = wave & 3, r16 = lane & 15, quad = lane >> 4;
    const int mt = M / 128, nt = N / 128;
    for (int item = blockIdx.x; item < mt * nt; item += gridDim.x) {
        const int tn = item / mt, tm = item - tn * mt, m0 = tm * 128, n0 = tn * 128;
        f32x4 acc[4][2], acc2[4][2];
#pragma unroll
        for (int a = 0; a < 4; ++a)
#pragma unroll
            for (int b = 0; b < 2; ++b) { acc[a][b] = (f32x4){0.f, 0.f, 0.f, 0.f}; acc2[a][b] = (f32x4){0.f, 0.f, 0.f, 0.f}; }
        for (int k0 = 0; k0 < K; k0 += 32) {
            {
                const int row = tid >> 2, kc = (tid & 3) * 8;
                const uint4 v = *(const uint4*)(A + (size_t)(m0 + row) * lda + k0 + kc);
                *(uint4*)(sA + row * 40 + kc) = v;
            }
            {
                const int kk = tid >> 4, nc = (tid & 15) * 8;
                const float* wp = W + (size_t)(k0 + kk) * ldw + n0 + nc;
                const float4 a = *(const float4*)wp, b = *(const float4*)(wp + 4);
                sB[(nc + 0) * 40 + kk] = (u16)f2bf(a.x); sB[(nc + 1) * 40 + kk] = (u16)f2bf(a.y); sB[(nc + 2) * 40 + kk] = (u16)f2bf(a.z); sB[(nc + 3) * 40 + kk] = (u16)f2bf(a.w);
                sB[(nc + 4) * 40 + kk] = (u16)f2bf(b.x); sB[(nc + 5) * 40 + kk] = (u16)f2bf(b.y); sB[(nc + 6) * 40 + kk] = (u16)f2bf(b.z); sB[(nc + 7) * 40 + kk] = (u16)f2bf(b.w);
                if (DUAL) {
                    const float4 c = *(const float4*)(wp + dualoff), d = *(const float4*)(wp + dualoff + 4);
                    sB2[(nc + 0) * 40 + kk] = (u16)f2bf(c.x); sB2[(nc + 1) * 40 + kk] = (u16)f2bf(c.y); sB2[(nc + 2) * 40 + kk] = (u16)f2bf(c.z); sB2[(nc + 3) * 40 + kk] = (u16)f2bf(c.w);
                    sB2[(nc + 4) * 40 + kk] = (u16)f2bf(d.x); sB2[(nc + 5) * 40 + kk] = (u16)f2bf(d.y); sB2[(nc + 6) * 40 + kk] = (u16)f2bf(d.z); sB2[(nc + 7) * 40 + kk] = (u16)f2bf(d.w);
                }
            }
            __syncthreads();
            bf16x8 af[4], bfr[2], bfr2[2];
#pragma unroll
            for (int mi = 0; mi < 4; ++mi) af[mi] = *(const bf16x8*)(sA + (wm * 64 + mi * 16 + r16) * 40 + quad * 8);
#pragma unroll
            for (int ni = 0; ni < 2; ++ni) {
                bfr[ni] = *(const bf16x8*)(sB + (wn * 32 + ni * 16 + r16) * 40 + quad * 8);
                if (DUAL) bfr2[ni] = *(const bf16x8*)(sB2 + (wn * 32 + ni * 16 + r16) * 40 + quad * 8);
            }
#pragma unroll
            for (int mi = 0; mi < 4; ++mi)
#pragma unroll
                for (int ni = 0; ni < 2; ++ni) {
                    acc[mi][ni] = __builtin_amdgcn_mfma_f32_16x16x32_bf16(af[mi], bfr[ni], acc[mi][ni], 0, 0, 0);
                    if (DUAL) acc2[mi][ni] = __builtin_amdgcn_mfma_f32_16x16x32_bf16(af[mi], bfr2[ni], acc2[mi][ni], 0, 0, 0);
                }
            __syncthreads();
        }
#pragma unroll
        for (int mi = 0; mi < 4; ++mi)
#pragma unroll
            for (int ni = 0; ni < 2; ++ni)
#pragma unroll
                for (int j = 0; j < 4; ++j) {
                    const int row = m0 + wm * 64 + mi * 16 + quad * 4 + j, col = n0 + wn * 32 + ni * 16 + r16;
                    epi(row, col, acc[mi][ni][j], DUAL ? acc2[mi][ni][j] : 0.f);
                }
    }
}

struct EpiStore { u16* O; int ld; DEV void operator()(int r, int c, float v, float) const { O[(size_t)r * ld + c] = (u16)f2bf(v); } };
struct EpiStoreOdd { u16* Q; u16* Z;
    DEV void operator()(int r, int c, float v, float) const { if (c < 1536) Q[(size_t)r * 1536 + c] = (u16)f2bf(v); else Z[(size_t)r * ZDW + (c - 1536)] = (u16)f2bf(v); } };
struct EpiResid { PPtr p; const float* gate;
    DEV void operator()(int r, int c, float v, float) const { float* xr = xrow_ptr(p, r); xr[c] += gate[mod_idx(r) * 6144 + c] * v; } };
struct EpiSwiglu { u16* H;
    DEV void operator()(int r, int c, float g, float u) const { H[(size_t)r * FFH + c] = (u16)f2bf(g * sigmoidf_(g) * u); } };


namespace pg8 {
#define PG8_LAS __attribute__((address_space(3)))
typedef unsigned short bf16_t;
typedef short bf16x8 __attribute__((ext_vector_type(8)));
typedef float f32x4 __attribute__((ext_vector_type(4)));
typedef unsigned u32x4 __attribute__((ext_vector_type(4)));
constexpr int BM = 256, BK = 64, HALF = 128, HTB = HALF * BK * 2  , STAGE_BYTES = 8 * HTB, NXCD = 8, WGM = 8;

__host__ __device__ __forceinline__ int lds_byte(int r, int c) { const int st = (r >> 4) * 2 + (c >> 5), rr = r & 15, cc = c & 31, ob = rr * 64 + cc * 2; return st * 1024 + (ob ^ (((ob >> 9) & 1) << 5)); }
__host__ __device__ __forceinline__ void stage_rc(int b, int& R, int& C) { const int st = b / 1024, sb = b % 1024, swz = sb ^ (((sb >> 9) & 1) << 5); R = (st >> 1) * 16 + swz / 64; C = (st & 1) * 32 + (swz % 64) / 2; }
__host__ __device__ __forceinline__ int perm32(int rho) { const int n = rho >> 4, i = rho & 15; return 8 * (i >> 2) + 4 * n + (i & 3); }

struct Unit { int pm, pn; };
struct Gemm { const bf16_t* A; const bf16_t* Bt; int M, N, K; };

struct StaticOrder {
    int nM, nN, nwg, G, c;
    __host__ __device__ void init(int M, int N, int G_, int c_) { nM = M / BM; nN = N / BM; nwg = nM * nN; G = G_; c = c_; }
    __host__ __device__ bool next(int i, Unit& u) const {
        const long L = (long)i * G + c; if (L >= nwg) return false;
        int wgid = (int)L; { const int q = nwg / NXCD, r = nwg % NXCD, xcd = wgid % NXCD, off = wgid / NXCD; wgid = (xcd < r ? xcd * (q + 1) : r * (q + 1) + (xcd - r) * q) + off; }
        const int nig = WGM * nN, gid = wgid / nig, fm = gid * WGM, gsz = (nM - fm) < WGM ? (nM - fm) : WGM;
        u.pm = fm + ((wgid % nig) % gsz); u.pn = (wgid % nig) / gsz; return true;
    }
    __device__ __forceinline__ void a_ready(const Unit&) const {}
    __device__ __forceinline__ void done(const Unit&) const {}
};
__device__ __forceinline__ unsigned cvt_pk_bf16(float lo, float hi) { unsigned r; asm volatile("v_cvt_pk_bf16_f32 %0, %1, %2" : "=v"(r) : "v"(lo), "v"(hi)); return r; }
template <class Epi, class Sched, bool ALIGN_EPI = false, bool SP2 = false>
__device__ __forceinline__ void gemm_phase(PG8_LAS unsigned char* lds, const Gemm g, const Sched& S, const Epi& E) {
    const int tid = tidx(), wid = __builtin_amdgcn_readfirstlane(tid >> 6), lane = tid & 63, wr = wid >> 2, wc = wid & 3, fr = lane & 15, fq = lane >> 4;
    const int K = g.K, nt = K / BK;
    unsigned voffA[2], voffB[2];
#pragma unroll
    for (int i = 0; i < 2; ++i) { int R, C; stage_rc(tid * 16 + i * 8192, R, C); const int Rb = Epi::PERM ? ((R & ~31) + perm32(R & 31)) : R;
        voffA[i] = (unsigned)(R * K + C) * 2u; voffB[i] = (unsigned)(Rb * K + C) * 2u; }
    const size_t kstep = (size_t)(BK * 2);
    const size_t hstep = (size_t)HALF * K * 2;
    const size_t tstep = 2 * hstep;
    const unsigned ldsw = (unsigned)wid * 1024u;
    const int aoff = lds_byte(wr * 64 + fr, fq * 8), boff = lds_byte(wc * 32 + fr, fq * 8);
#define PG8_SA(b, h) (((b) * 2 + (h)) * HTB)
#define PG8_SB(b, h) ((4 + (b) * 2 + (h)) * HTB)
#define PG8_STAGE(bufoff, gbase, voff) do { _Pragma("unroll") for (int _i = 0; _i < 2; ++_i) \
        __builtin_amdgcn_global_load_lds((const unsigned*)((const char*)(gbase) + (voff)[_i]), (PG8_LAS unsigned*)(lds + (bufoff) + ldsw + _i * 8192), 16, 0, 0); } while (0)
#define PG8_LDA(dst, b, h) do { _Pragma("unroll") for (int m = 0; m < 4; ++m) _Pragma("unroll") for (int k = 0; k < 2; ++k) dst[m][k] = *(const PG8_LAS bf16x8*)(lds + PG8_SA(b, h) + aoff + m * 2048 + k * 1024); } while (0)
#define PG8_LDB(dst, b, h) do { _Pragma("unroll") for (int n = 0; n < 2; ++n) _Pragma("unroll") for (int k = 0; k < 2; ++k) dst[n][k] = *(const PG8_LAS bf16x8*)(lds + PG8_SB(b, h) + boff + n * 2048 + k * 1024); } while (0)
#define PG8_MMA(ai, bj, At, Bt) do { __builtin_amdgcn_s_setprio(1); _Pragma("unroll") for (int m = 0; m < 4; ++m) _Pragma("unroll") for (int n = 0; n < 2; ++n) _Pragma("unroll") for (int k = 0; k < 2; ++k) \
        acc[ai][bj][m][n] = __builtin_amdgcn_mfma_f32_16x16x32_bf16(Bt[n][k], At[m][k], acc[ai][bj][m][n], 0, 0, 0); __builtin_amdgcn_s_setprio(0); } while (0)
#define PG8_WAIT_V(n) asm volatile("s_waitcnt vmcnt(" #n ")" ::: "memory")
#define PG8_WAIT_L(n) asm volatile("s_waitcnt lgkmcnt(" #n ")" ::: "memory")
#define PG8_BAR __builtin_amdgcn_s_barrier()
#define PG8_SCHED __builtin_amdgcn_sched_barrier(0)
    Unit cur, nxt; int ui = 0;
    if (!S.next(0, cur)) return;
    f32x4 acc[2][2][4][2];
#pragma unroll
    for (int a = 0; a < 2; ++a)
#pragma unroll
        for (int b = 0; b < 2; ++b)
#pragma unroll
            for (int m = 0; m < 4; ++m)
#pragma unroll
                for (int n = 0; n < 2; ++n) acc[a][b][m][n] = (f32x4){0.f, 0.f, 0.f, 0.f};
    bf16x8 At[4][2], B0[2][2], B1[2][2];
    const char* cA = (const char*)g.A + (size_t)cur.pm * tstep; const char* cB = (const char*)g.Bt + (size_t)cur.pn * tstep;
    S.a_ready(cur);
    if constexpr (SP2) {
        PG8_STAGE(PG8_SB(0, 0), cB, voffB); PG8_STAGE(PG8_SB(0, 1), cB + hstep, voffB); PG8_STAGE(PG8_SA(0, 0), cA, voffA); PG8_STAGE(PG8_SA(0, 1), cA + hstep, voffA);
        if (wr == 1) PG8_BAR;
        PG8_WAIT_V(2); PG8_BAR;
        PG8_STAGE(PG8_SB(1, 0), cB + kstep, voffB); PG8_STAGE(PG8_SA(1, 0), cA + kstep, voffA); PG8_STAGE(PG8_SB(1, 1), cB + hstep + kstep, voffB);
        PG8_WAIT_V(6); PG8_BAR;
    } else {
        PG8_STAGE(PG8_SB(0, 0), cB, voffB); PG8_STAGE(PG8_SA(0, 0), cA, voffA); PG8_STAGE(PG8_SB(0, 1), cB + hstep, voffB); PG8_STAGE(PG8_SA(0, 1), cA + hstep, voffA);
        if (wr == 1) PG8_BAR;
        PG8_WAIT_V(4); PG8_BAR;
        PG8_STAGE(PG8_SB(1, 0), cB + kstep, voffB); PG8_STAGE(PG8_SA(1, 0), cA + kstep, voffA); PG8_STAGE(PG8_SB(1, 1), cB + hstep + kstep, voffB);
        PG8_WAIT_V(6); PG8_BAR;
    }
    for (;;) {
        const bool has_next = S.next(ui + 1, nxt);
        const char* nA = has_next ? (const char*)g.A + (size_t)nxt.pm * tstep : cA; const char* nB = has_next ? (const char*)g.Bt + (size_t)nxt.pn * tstep : cB;
        for (int t = 0; t < nt; t += 2) {
            const bool last = (t == nt - 2);
            const char* a1 = cA + (size_t)(t + 1) * kstep;
            const char* a2 = last ? nA : cA + (size_t)(t + 2) * kstep; const char* b2 = last ? nB : cB + (size_t)(t + 2) * kstep;
            const char* a3 = a2 + kstep; const char* b3 = b2 + kstep;
            if (last && has_next) S.a_ready(nxt);
            if constexpr (SP2) {
            PG8_LDB(B0, 0, 0); PG8_LDB(B1, 0, 1); PG8_SCHED; PG8_LDA(At, 0, 0); PG8_STAGE(PG8_SA(1, 1), a1 + hstep, voffA);
            PG8_WAIT_V(8); PG8_WAIT_L(0); PG8_BAR; PG8_MMA(0, 0, At, B0); PG8_MMA(0, 1, At, B1); PG8_BAR; PG8_SCHED;
            PG8_LDA(At, 0, 1); PG8_STAGE(PG8_SB(0, 0), b2, voffB); PG8_STAGE(PG8_SB(0, 1), b2 + hstep, voffB); PG8_STAGE(PG8_SA(0, 0), a2, voffA);
            PG8_WAIT_V(8); PG8_WAIT_L(0); PG8_BAR; PG8_MMA(1, 0, At, B0); PG8_MMA(1, 1, At, B1); PG8_BAR; PG8_SCHED;
            PG8_LDB(B0, 1, 0); PG8_LDB(B1, 1, 1); PG8_SCHED; PG8_LDA(At, 1, 0); PG8_STAGE(PG8_SA(0, 1), a2 + hstep, voffA);
            PG8_WAIT_V(8); PG8_WAIT_L(0); PG8_BAR; PG8_MMA(0, 0, At, B0); PG8_MMA(0, 1, At, B1); PG8_BAR; PG8_SCHED;
            PG8_LDA(At, 1, 1); PG8_STAGE(PG8_SB(1, 0), b3, voffB); PG8_STAGE(PG8_SB(1, 1), b3 + hstep, voffB); PG8_STAGE(PG8_SA(1, 0), a3, voffA);
            PG8_WAIT_V(8); PG8_WAIT_L(0); PG8_BAR; PG8_MMA(1, 0, At, B0); PG8_MMA(1, 1, At, B1); PG8_BAR; PG8_SCHED;
            } else {
            PG8_LDB(B0, 0, 0); PG8_SCHED; PG8_LDA(At, 0, 0); PG8_STAGE(PG8_SA(1, 1), a1 + hstep, voffA);
            PG8_WAIT_L(8); PG8_BAR; PG8_WAIT_L(0); PG8_MMA(0, 0, At, B0); PG8_BAR; PG8_SCHED;
            PG8_LDB(B1, 0, 1); PG8_STAGE(PG8_SB(0, 0), b2, voffB);
            PG8_BAR; PG8_WAIT_L(0); PG8_MMA(0, 1, At, B1); PG8_BAR;
            PG8_LDA(At, 0, 1); PG8_STAGE(PG8_SA(0, 0), a2, voffA);
            PG8_BAR; PG8_WAIT_L(0); PG8_MMA(1, 0, At, B0); PG8_BAR; PG8_SCHED;
            PG8_STAGE(PG8_SB(0, 1), b2 + hstep, voffB);
            PG8_WAIT_V(6); PG8_BAR; PG8_MMA(1, 1, At, B1); PG8_BAR;
            PG8_LDB(B0, 1, 0); PG8_SCHED; PG8_LDA(At, 1, 0); PG8_STAGE(PG8_SA(0, 1), a2 + hstep, voffA);
            PG8_WAIT_L(8); PG8_BAR; PG8_WAIT_L(0); PG8_MMA(0, 0, At, B0); PG8_BAR; PG8_SCHED;
            PG8_LDB(B1, 1, 1); PG8_STAGE(PG8_SB(1, 0), b3, voffB);
            PG8_BAR; PG8_WAIT_L(0); PG8_MMA(0, 1, At, B1); PG8_BAR;
            PG8_LDA(At, 1, 1); PG8_STAGE(PG8_SA(1, 0), a3, voffA);
            PG8_BAR; PG8_WAIT_L(0); PG8_MMA(1, 0, At, B0); PG8_BAR; PG8_SCHED;
            PG8_STAGE(PG8_SB(1, 1), b3 + hstep, voffB);
            PG8_WAIT_V(6); PG8_BAR; PG8_MMA(1, 1, At, B1); PG8_BAR;
            }
        }
        if constexpr (ALIGN_EPI) { if (wr == 0) PG8_BAR; }
        if constexpr (!Epi::AFTER_DRAIN) { E(acc, cur, wr, wc, fr, fq); S.done(cur); }
        if (!has_next) break;
#pragma unroll
        for (int a = 0; a < 2; ++a)
#pragma unroll
            for (int b = 0; b < 2; ++b)
#pragma unroll
                for (int m = 0; m < 4; ++m)
#pragma unroll
                    for (int n = 0; n < 2; ++n) acc[a][b][m][n] = (f32x4){0.f, 0.f, 0.f, 0.f};
        cur = nxt; cA = nA; cB = nB; ++ui;
        if constexpr (ALIGN_EPI) { if (wr == 1) PG8_BAR; }
    }
    PG8_WAIT_V(0);
    if constexpr (!ALIGN_EPI) { if (wr == 0) PG8_BAR; }
    PG8_BAR;
    if constexpr (Epi::AFTER_DRAIN) { E.fused(acc, cur, wr, wc, fr, fq, lds, wid, lane); S.done(cur); }
#undef PG8_SA
#undef PG8_SB
#undef PG8_STAGE
#undef PG8_LDA
#undef PG8_LDB
#undef PG8_MMA
#undef PG8_WAIT_V
#undef PG8_WAIT_L
#undef PG8_BAR
#undef PG8_SCHED
}

struct EpiStoreT {
    static constexpr bool PERM = true, AFTER_DRAIN = false;
    bf16_t* O0; int ld0; int split; bf16_t* O1; int ld1;
    __device__ __forceinline__ void operator()(const f32x4 (&acc)[2][2][4][2], const Unit& u, int wr, int wc, int fr, int fq) const {
        const int row0 = u.pm * BM + wr * 64 + fr; int colt = u.pn * BM; bf16_t* base = O0; int ld = ld0;
        if (colt >= split) { base = O1; ld = ld1; colt -= split; }
        const int col0 = colt + wc * 32 + 8 * fq;
#pragma unroll
        for (int ai = 0; ai < 2; ++ai)
#pragma unroll
            for (int m = 0; m < 4; ++m) { bf16_t* rowp = base + (size_t)(row0 + ai * HALF + m * 16) * ld + col0;
#pragma unroll
                for (int bj = 0; bj < 2; ++bj) { const f32x4 v0 = acc[ai][bj][m][0], v1 = acc[ai][bj][m][1];
                    u32x4 w; w.x = cvt_pk_bf16(v0[0], v0[1]); w.y = cvt_pk_bf16(v0[2], v0[3]); w.z = cvt_pk_bf16(v1[0], v1[1]); w.w = cvt_pk_bf16(v1[2], v1[3]);
                    *(u32x4*)(rowp + bj * HALF) = w; } }
    }
};
struct EpiResidT {
    static constexpr bool PERM = true, AFTER_DRAIN = false;
    PPtr p; const float* gate;
    __device__ __forceinline__ void operator()(const f32x4 (&acc)[2][2][4][2], const Unit& u, int wr, int wc, int fr, int fq) const {
        float* xb = xrow_ptr(p, u.pm * BM); const float* g = gate + mod_idx(u.pm * BM) * 6144;
        const int col0 = u.pn * BM + wc * 32 + 8 * fq;
#pragma unroll
        for (int ai = 0; ai < 2; ++ai)
#pragma unroll
            for (int m = 0; m < 4; ++m) { float* xr = xb + (size_t)(ai * HALF + wr * 64 + m * 16 + fr) * DM;
#pragma unroll
                for (int bj = 0; bj < 2; ++bj) { const int col = col0 + bj * HALF; const f32x4 v0 = acc[ai][bj][m][0], v1 = acc[ai][bj][m][1];
                    const f32x4 g0 = *(const f32x4*)(g + col), g1 = *(const f32x4*)(g + col + 4);
                    f32x4 x0 = *(const f32x4*)(xr + col), x1 = *(const f32x4*)(xr + col + 4);
                    x0 += g0 * v0; x1 += g1 * v1;
                    *(f32x4*)(xr + col) = x0; *(f32x4*)(xr + col + 4) = x1; } }
    }
};
struct EpiSwigluT {
    static constexpr bool PERM = true, AFTER_DRAIN = false;
    bf16_t* H;
    __device__ __forceinline__ void operator()(const f32x4 (&acc)[2][2][4][2], const Unit& u, int wr, int wc, int fr, int fq) const {
        const int row0 = u.pm * BM + wr * 64 + fr; const int col0 = u.pn * BM + wc * 32 + 8 * fq;
#pragma unroll
        for (int ai = 0; ai < 2; ++ai)
#pragma unroll
            for (int m = 0; m < 4; ++m) { bf16_t* rowp = H + (size_t)(row0 + ai * HALF + m * 16) * FFH;
#pragma unroll
                for (int bj = 0; bj < 2; ++bj) { const f32x4 gt = acc[ai][bj][m][0], up = acc[ai][bj][m][1];
                    float h[4];
#pragma unroll
                    for (int j = 0; j < 4; ++j) h[j] = gt[j] * sigmoidf_(gt[j]) * up[j];
                    uint2 w; w.x = cvt_pk_bf16(h[0], h[1]); w.y = cvt_pk_bf16(h[2], h[3]);
                    *(uint2*)(rowp + ((col0 + bj * HALF) >> 1)) = w; } }
    }
};
}

DEV void transpose_item(const float* W, int K, int N, u16* WT, int mode, float* scr, int item, int lane) {
    const int nblk = N / 32, kb = item / nblk, nb = item - kb * nblk, k0 = 64 * kb, n0 = 32 * nb;
#pragma unroll 8
    for (int i = 0; i < 32; ++i) { const int kk = 2 * i + (lane >> 5); scr[kk * 33 + (lane & 31)] = W[(size_t)(k0 + kk) * N + n0 + (lane & 31)]; }
    asm volatile("s_waitcnt lgkmcnt(0)" ::: "memory");
    const int c = lane & 7;
#pragma unroll
    for (int j = 0; j < 4; ++j) {
        const int n = (lane >> 3) + 8 * j; const float* sp = scr + (8 * c) * 33 + n;
        uint4 o; o.x = pk2(sp[0 * 33], sp[1 * 33]); o.y = pk2(sp[2 * 33], sp[3 * 33]); o.z = pk2(sp[4 * 33], sp[5 * 33]); o.w = pk2(sp[6 * 33], sp[7 * 33]);
        const int ns = n0 + n;
        int drow = ns;
        if (mode) { const int nn = ns >= FFH ? 1 : 0; const int g = ns - nn * FFH; drow = 8 * (g >> 2) + 4 * nn + (g & 3); }
        *(uint4*)(WT + (size_t)drow * K + k0 + 8 * c) = o;
    }
    asm volatile("s_waitcnt lgkmcnt(0)" ::: "memory");
}
constexpr size_t WB_IN = 0, WB_OUT = (size_t)3328 * 1024, WB_F1 = WB_OUT + (size_t)1024 * 1024, WB_F2 = WB_F1 + (size_t)5632 * 1024;
DEV void phase_wprep(PPtr p, int layer, char* lds) {
    const int tid = tidx(), lane = tid & 63, wave = tid >> 6, gw = blockIdx.x * NWAVE + wave, ngw = gridDim.x * NWAVE;
    float* scr = (float*)lds + wave * (64 * 33);
    u16* WB = (u16*)(p->ws + OFF_WB);
    const int li = layer >> 1, odd = layer & 1;
    const int nin = odd ? 3328 : 1536;
    const float* win = odd ? p->in[13] + (size_t)li * DM * 3328 : p->in[8] + (size_t)li * DM * 1536;
    const float* wout = (odd ? p->in[14] : p->in[9]) + (size_t)li * DM * DM;
    const float* wf1 = p->in[27] + (size_t)layer * DM * 5632; const float* wf2 = p->in[28] + (size_t)layer * FFH * DM;
    const int i0 = 16 * (nin / 32), i1 = i0 + 16 * 32, i2 = i1 + 16 * 176, i3 = i2 + 44 * 32;
    for (int it = gw; it < i3; it += ngw) {
        if (it < i0) transpose_item(win, DM, nin, WB + WB_IN, 0, scr, it, lane);
        else if (it < i1) transpose_item(wout, DM, DM, WB + WB_OUT, 0, scr, it - i0, lane);
        else if (it < i2) transpose_item(wf1, DM, 5632, WB + WB_F1, 1, scr, it - i1, lane);
        else transpose_item(wf2, FFH, DM, WB + WB_F2, 0, scr, it - i2, lane);
    }
}

#include <hip/hip_bf16.h>
#include <cmath>
namespace attn_body {
using bf16=__hip_bfloat16;
using bf16x8=__attribute__((ext_vector_type(8)))short;
using s16x4=__attribute__((ext_vector_type(4)))short;
using f32x16=__attribute__((ext_vector_type(16)))float;
using u32x4=__attribute__((ext_vector_type(4)))unsigned;
constexpr int D=64,PQ=1536,PO=1024,KROWS=16640,RPBA=16640;
constexpr int NW=8,QBLK=32,QB=QBLK*NW,KVBLK=64;
constexpr int ATTN_UNIT_ROWS=QB;
__device__ __forceinline__ int crow(int r,int hi){return (r&3)+8*(r>>2)+4*hi;}
#define SBAR() __builtin_amdgcn_sched_barrier(0)
__device__ __forceinline__ void cmask(f32x16&p0,f32x16&p1,int jb,int qrel,int hi){
  const float NEG=-INFINITY; int kb=64*jb+4*hi;
  #pragma unroll
  for(int r=0;r<16;++r){int kv=kb+(r&3)+8*(r>>2); if(kv>qrel)p0[r]=NEG; if(kv+32>qrel)p1[r]=NEG;}
}

constexpr int NSLOT=3, SLOTB=8192;
constexpr int LDS_K=0, LDS_V=NSLOT*SLOTB, LDS_WS=2*NSLOT*SLOTB, LDS_OST=LDS_WS+NW*64*4, LDS_BYTES=LDS_OST+NW*4096;
constexpr float C2=0.125f*1.4426950408889634f;
__device__ __forceinline__ void glds16(const void*gsrc,unsigned lds_dst){unsigned keep;
  asm volatile("s_mov_b32 %0, m0\n\ts_mov_b32 m0, %2\n\ts_nop 0\n\tglobal_load_lds_dwordx4 %1, off\n\ts_mov_b32 m0, %0":"=&s"(keep):"v"(gsrc),"s"(lds_dst):"memory");}
__device__ __forceinline__ float max3f(float a,float b,float c){float r;asm("v_max3_f32 %0, %1, %2, %3":"=v"(r):"v"(a),"v"(b),"v"(c));return r;}
__device__ __forceinline__ float max2f(float a,float b){float r;asm("v_max_f32_e32 %0, %1, %2":"=v"(r):"v"(a),"v"(b));return r;}
__device__ __forceinline__ float fadd_s(float a,float b){float r;asm("v_add_f32_e32 %0, %1, %2":"=v"(r):"v"(a),"v"(b));return r;}
__device__ __forceinline__ float fsub_s(float a,float b){float r;asm("v_sub_f32_e32 %0, %1, %2":"=v"(r):"v"(a),"v"(b));return r;}
typedef float f32x2_t __attribute__((ext_vector_type(2))); typedef __bf16 bf16x2_t __attribute__((ext_vector_type(2)));
__device__ __forceinline__ unsigned cvtpk_s(float lo,float hi){f32x2_t v={lo,hi};bf16x2_t b=__builtin_convertvector(v,bf16x2_t);return __builtin_bit_cast(unsigned,b);}
#define WAIT_BAR(N) asm volatile("s_waitcnt vmcnt(" #N ") lgkmcnt(0)\n\ts_barrier":::"memory")

__device__ __forceinline__ void qkt(f32x16&p0,f32x16&p1,const char*Kslot,const bf16x8*qr,const f32x16&negm,int r32,int hi){
  const char*kb=Kslot+hi*1024+r32*16;
  #pragma unroll
  for(int d0=0;d0<4;++d0){
    const bf16x8 b0=*reinterpret_cast<const bf16x8*>(kb+d0*2048);
    const bf16x8 b1=*reinterpret_cast<const bf16x8*>(kb+d0*2048+512);
    if(d0==0){p0=__builtin_amdgcn_mfma_f32_32x32x16_bf16(b0,qr[0],negm,0,0,0);p1=__builtin_amdgcn_mfma_f32_32x32x16_bf16(b1,qr[0],negm,0,0,0);}
    else{p0=__builtin_amdgcn_mfma_f32_32x32x16_bf16(b0,qr[d0],p0,0,0,0);p1=__builtin_amdgcn_mfma_f32_32x32x16_bf16(b1,qr[d0],p1,0,0,0);}}
}
typedef __attribute__((address_space(3))) const char* lds_cptr;
typedef short v4i16_t __attribute__((ext_vector_type(4)));
__device__ __forceinline__ void kload8(bf16x8*kf,lds_cptr kp){
  kf[0]=*(const __attribute__((address_space(3))) bf16x8*)(kp);      kf[1]=*(const __attribute__((address_space(3))) bf16x8*)(kp+512);
  kf[2]=*(const __attribute__((address_space(3))) bf16x8*)(kp+2048); kf[3]=*(const __attribute__((address_space(3))) bf16x8*)(kp+2560);
  kf[4]=*(const __attribute__((address_space(3))) bf16x8*)(kp+4096); kf[5]=*(const __attribute__((address_space(3))) bf16x8*)(kp+4608);
  kf[6]=*(const __attribute__((address_space(3))) bf16x8*)(kp+6144); kf[7]=*(const __attribute__((address_space(3))) bf16x8*)(kp+6656);
}
__device__ __forceinline__ void kload2(bf16x8*kf,lds_cptr kp,int j){ kf[2*j]=*(const __attribute__((address_space(3))) bf16x8*)(kp+j*2048); kf[2*j+1]=*(const __attribute__((address_space(3))) bf16x8*)(kp+j*2048+512); }
__device__ __forceinline__ s16x4 vtr(lds_cptr p){ return __builtin_bit_cast(s16x4,__builtin_amdgcn_ds_read_tr16_b64_v4i16((__attribute__((address_space(3))) v4i16_t*)p)); }
__device__ __forceinline__ float rowmax(const f32x16&p0,const f32x16&p1){
  float a=max3f(p0[0],p0[1],p1[0]),b=max3f(p0[2],p0[3],p1[1]);a=max3f(a,p1[2],p1[3]);
  #pragma unroll
  for(int r=4;r<16;r+=4){a=max3f(a,p0[r],p0[r+1]);b=max3f(b,p0[r+2],p0[r+3]);a=max3f(a,p1[r],p1[r+1]);b=max3f(b,p1[r+2],p1[r+3]);}
  const float m=max2f(a,b);
  auto rr=__builtin_amdgcn_permlane32_swap(__float_as_uint(m),__float_as_uint(m),false,false);
  return max2f(__uint_as_float(rr[0]),__uint_as_float(rr[1]));
}
__device__ __forceinline__ void pv(f32x16*o,int vb,bf16x8 pa0,bf16x8 pa1,bf16x8 pa2,bf16x8 pa3){
  #pragma unroll
  for(int d0=0;d0<2;++d0){s16x4 lo[4],hi[4];
    #pragma unroll
    for(int ks=0;ks<4;++ks){
      asm volatile("ds_read_b64_tr_b16 %0,%1 offset:%c2":"=&v"(lo[ks]):"v"(vb),"i"(d0*4096+ks*1024):"memory");
      asm volatile("ds_read_b64_tr_b16 %0,%1 offset:%c2":"=&v"(hi[ks]):"v"(vb),"i"(d0*4096+ks*1024+512):"memory");}
    asm volatile("s_waitcnt lgkmcnt(0)":::"memory");SBAR();
    #define PK(k) (bf16x8){lo[k][0],lo[k][1],lo[k][2],lo[k][3],hi[k][0],hi[k][1],hi[k][2],hi[k][3]}
    o[d0]=__builtin_amdgcn_mfma_f32_32x32x16_bf16(pa0,PK(0),o[d0],0,0,0);
    o[d0]=__builtin_amdgcn_mfma_f32_32x32x16_bf16(pa1,PK(1),o[d0],0,0,0);
    o[d0]=__builtin_amdgcn_mfma_f32_32x32x16_bf16(pa2,PK(2),o[d0],0,0,0);
    o[d0]=__builtin_amdgcn_mfma_f32_32x32x16_bf16(pa3,PK(3),o[d0],0,0,0);
    #undef PK
  }
}

#ifndef ATTN_STORE16
#define ATTN_STORE16(p,v) (*(u32x4*)(p)=(v))
#endif
template<int THRL> __device__ __forceinline__ void attn_unit(int b,int h,int qb,const bf16*Q,const bf16*__restrict__ K,const bf16*__restrict__ V,bf16*O,char*shm){
  const int tid=tidx(),lane=tid&63,r32=lane&31,hi=lane>>5; const int wid=__builtin_amdgcn_readfirstlane(tid>>6);
  const long rowbase=(long)b*RPBA; const int q0=qb*QB;
  const bf16*Qw=Q+(rowbase+q0+wid*QBLK)*PQ+h*D;
  const bf16*Kh=K+rowbase*PQ+(h>>2)*D,*Vh=V+rowbase*PQ+(h>>2)*D;
  const unsigned lds0=(unsigned)(uintptr_t)shm;
  float*wsf=(float*)(shm+LDS_WS)+wid*64;
  const bf16*ksrc=Kh+(long)lane*PQ+wid*8;
  const bf16*vsrc=Vh+(long)(16*(wid&3)+(lane>>2))*PQ+(wid>>2)*32+(lane&3)*8;
  const unsigned kdst=lds0+LDS_K+wid*1024, vdst=lds0+LDS_V+wid*1024;
  #define DMA_K(t,slot) glds16(ksrc+(long)(t)*KVBLK*PQ,(unsigned)__builtin_amdgcn_readfirstlane(kdst+(slot)))
  #define DMA_V(t,slot) glds16(vsrc+(long)(t)*KVBLK*PQ,(unsigned)__builtin_amdgcn_readfirstlane(vdst+(slot)))
  const int vb0=(int)(lds0+LDS_V)+((lane>>4)&1)*32+(lane&3)*8+(4*hi+((lane&15)>>2))*64;
  const char*Kbase=shm+LDS_K; bf16x8 kf[8];
  const lds_cptr shm3=(lds_cptr)shm; const lds_cptr kp0=shm3+LDS_K+hi*1024+r32*16; const lds_cptr vp0=shm3+LDS_V+((lane>>4)&1)*32+(lane&3)*8+(4*hi+((lane&15)>>2))*64;
  const int NT=KROWS/KVBLK;
  DMA_K(0,0);DMA_V(0,0);DMA_K(1,SLOTB);
  bf16x8 qr[4];
  #pragma unroll
  for(int d0=0;d0<4;++d0)qr[d0]=*reinterpret_cast<const bf16x8*>(&Qw[(long)r32*PQ+d0*16+hi*8]);
  float mhat=0.f,l_reg=0.f;f32x16 o[2];o[0]=f32x16{};o[1]=f32x16{};f32x16 negm=f32x16{};asm volatile("":"+v"(negm));
  const int qrel=wid*QBLK+r32;
  #define CMASK(P0,P1,t) do{}while(0)
  bool resc=false;
  #define START(P0,P1) do{ const float rm=rowmax(P0,P1); resc=false; \
    { const float dl=rm; mhat=fadd_s(mhat,dl); \
      _Pragma("unroll") for(int r=0;r<16;++r){P0[r]=fsub_s(P0[r],dl);P1[r]=fsub_s(P1[r],dl);} \
      _Pragma("unroll") for(int r=0;r<16;++r)negm[r]=-mhat; asm volatile("":"+v"(negm)); } \
    _Pragma("unroll") for(int r=0;r<16;++r)P0[r]=__builtin_amdgcn_exp2f(P0[r]); }while(0)
  #define RESC() do{ if(resc){ asm volatile("s_waitcnt lgkmcnt(0)":::"memory"); \
      _Pragma("unroll") for(int d_=0;d_<2;++d_) _Pragma("unroll") for(int r=0;r<16;++r)o[d_][r]*=wsf[crow(r,hi)]; } }while(0)
  f32x16 pA0,pA1,pB0,pB1;
  int sl_prev=0,sl_cur=0,sl_next=SLOTB;
  #define ROT() do{sl_prev=sl_cur;sl_cur=sl_next;sl_next=(sl_next==(NSLOT-1)*SLOTB)?0:sl_next+SLOTB;}while(0)
  DMA_K(2,2*SLOTB);
  WAIT_BAR(3);
  qkt(pA0,pA1,Kbase,qr,negm,r32,hi);asm volatile("s_nop 15\n\ts_nop 7":"+v"(pA0),"+v"(pA1));CMASK(pA0,pA1,0);
  START(pA0,pA1);
  _Pragma("unroll") for(int r=0;r<16;++r)pA1[r]=__builtin_amdgcn_exp2f(pA1[r]);
  WAIT_BAR(0);
  DMA_K(3,0);DMA_V(1,SLOTB);
  ROT();
  kload8(kf,kp0+sl_cur);
  WAIT_BAR(2);
  s16x4 vlo[8],vhi[8]; u32x4 pw0,pw1,pw2,pw3;
  #define PKW(P,B) cvtpk_s(P[B],P[B+1])
  #define PAF(k) __builtin_bit_cast(bf16x8,pw##k)
  #define VFR(i) (bf16x8){vlo[i][0],vlo[i][1],vlo[i][2],vlo[i][3],vhi[i][0],vhi[i][1],vhi[i][2],vhi[i][3]}
  #define PIN(x) asm volatile("":"+v"(x))
  #define MX3(a,b,c) __builtin_fmaxf(__builtin_fmaxf((a),(b)),(c))
  #define GAPA(MF,A0,A1,A2,A3,W0,W1,PW) do{ MF; sacc+=A0; sacc+=A1; sacc+=A2; sacc+=A3; PIN(sacc); W0; W1; PIN(PW); SBAR(); }while(0)
  #define EX(v) __builtin_amdgcn_exp2f(v)
  #define GAPB(MF,X,B) do{ MF; X[B]=EX(X[B]); X[B+1]=EX(X[B+1]); X[B+2]=EX(X[B+2]); X[B+3]=EX(X[B+3]); PIN(X); SBAR(); }while(0)
  #define VRD(i) do{ vlo[i]=vtr(vp_+(((i)>>2)*4096+((i)&3)*1024)); vhi[i]=vtr(vp_+(((i)>>2)*4096+((i)&3)*1024+512)); }while(0)
  #define KRD(G,j) do{ if(G){ kload2(kf,kp0+sl_next,j); SBAR(); } }while(0)
  #define STEP(C0,C1,P0,P1,t,GK,GV,GL) do{ SBAR(); \
    const lds_cptr vp_=vp0+sl_prev; \
    VRD(0); SBAR(); float sacc=(P0[0]+P0[1]); \
    GAPA(C0=__builtin_amdgcn_mfma_f32_32x32x16_bf16(kf[0],qr[0],negm,0,0,0), P0[2],P0[3],P0[4],P0[5],     pw0[0]=PKW(P0,0), pw0[1]=PKW(P0,2), pw0); \
    VRD(4); SBAR(); GAPA(C1=__builtin_amdgcn_mfma_f32_32x32x16_bf16(kf[1],qr[0],negm,0,0,0), P0[6],P0[7],P0[8],P0[9],     pw0[2]=PKW(P0,4), pw0[3]=PKW(P0,6), pw0); \
    VRD(1); SBAR(); GAPA(C0=__builtin_amdgcn_mfma_f32_32x32x16_bf16(kf[2],qr[1],C0,0,0,0),   P0[10],P0[11],P0[12],P0[13], pw1[0]=PKW(P0,8), pw1[1]=PKW(P0,10), pw1); \
    VRD(5); SBAR(); GAPA(C1=__builtin_amdgcn_mfma_f32_32x32x16_bf16(kf[3],qr[1],C1,0,0,0),   P0[14],P0[15],P1[0],P1[1],   pw1[2]=PKW(P0,12),pw1[3]=PKW(P0,14), pw1); \
    VRD(2); SBAR(); GAPA(C0=__builtin_amdgcn_mfma_f32_32x32x16_bf16(kf[4],qr[2],C0,0,0,0),   P1[2],P1[3],P1[4],P1[5],     pw2[0]=PKW(P1,0), pw2[1]=PKW(P1,2), pw2); \
    VRD(6); SBAR(); GAPA(C1=__builtin_amdgcn_mfma_f32_32x32x16_bf16(kf[5],qr[2],C1,0,0,0),   P1[6],P1[7],P1[8],P1[9],     pw2[2]=PKW(P1,4), pw2[3]=PKW(P1,6), pw2); \
    VRD(3); SBAR(); GAPA(C0=__builtin_amdgcn_mfma_f32_32x32x16_bf16(kf[6],qr[3],C0,0,0,0),   P1[10],P1[11],P1[12],P1[13], pw3[0]=PKW(P1,8), pw3[1]=PKW(P1,10), pw3); \
    VRD(7); SBAR(); GAPA(C1=__builtin_amdgcn_mfma_f32_32x32x16_bf16(kf[7],qr[3],C1,0,0,0),   P1[14],P1[15],0.f,0.f,       pw3[2]=PKW(P1,12),pw3[3]=PKW(P1,14), pw3); \
    l_reg+=sacc; \
    if(GK){DMA_K((t)+3,sl_cur);} if(GV){DMA_V((t)+1,sl_next);} \
    CMASK(C0,C1,t); \
    { float a=MX3(C0[0],C0[1],C1[0]),b=MX3(C0[2],C0[3],C1[1]); a=MX3(a,C1[2],C1[3]); \
      _Pragma("unroll") for(int r=4;r<16;r+=4){a=MX3(a,C0[r],C0[r+1]);b=MX3(b,C0[r+2],C0[r+3]);a=MX3(a,C1[r],C1[r+1]);b=MX3(b,C1[r+2],C1[r+3]);} \
      float rm=__builtin_fmaxf(a,b); { auto rr=__builtin_amdgcn_permlane32_swap(__float_as_uint(rm),__float_as_uint(rm),false,false); rm=__builtin_fmaxf(__uint_as_float(rr[0]),__uint_as_float(rr[1])); } \
      resc=false; \
      if(__builtin_expect(__any(rm>(float)THRL),0)){ const float dl=__builtin_fmaxf(rm,0.f); mhat+=dl; \
        _Pragma("unroll") for(int r=0;r<16;++r){C0[r]-=dl;C1[r]-=dl;} \
        _Pragma("unroll") for(int r=0;r<16;++r)negm[r]=-mhat; asm volatile("":"+v"(negm)); \
        const float f=__builtin_amdgcn_exp2f(-dl); l_reg*=f; if(hi==0)wsf[r32]=f; resc=true; } } \
    SBAR(); \
    GAPB(o[0]=__builtin_amdgcn_mfma_f32_32x32x16_bf16(PAF(0),VFR(0),o[0],0,0,0), C0,0); \
    GAPB(o[1]=__builtin_amdgcn_mfma_f32_32x32x16_bf16(PAF(0),VFR(4),o[1],0,0,0), C0,4); \
    KRD(GL,0); GAPB(o[0]=__builtin_amdgcn_mfma_f32_32x32x16_bf16(PAF(1),VFR(1),o[0],0,0,0), C0,8); \
    KRD(GL,1); GAPB(o[1]=__builtin_amdgcn_mfma_f32_32x32x16_bf16(PAF(1),VFR(5),o[1],0,0,0), C0,12); \
    KRD(GL,2); GAPB(o[0]=__builtin_amdgcn_mfma_f32_32x32x16_bf16(PAF(2),VFR(2),o[0],0,0,0), C1,0); \
    KRD(GL,3); GAPB(o[1]=__builtin_amdgcn_mfma_f32_32x32x16_bf16(PAF(2),VFR(6),o[1],0,0,0), C1,4); \
    GAPB(o[0]=__builtin_amdgcn_mfma_f32_32x32x16_bf16(PAF(3),VFR(3),o[0],0,0,0), C1,8); \
    GAPB(o[1]=__builtin_amdgcn_mfma_f32_32x32x16_bf16(PAF(3),VFR(7),o[1],0,0,0), C1,12); \
    }while(0)
  int t=1;
  #undef CMASK
  #define CMASK(P0,P1,t) do{}while(0)
  for(;t+5<NT;t+=2){
    STEP(pB0,pB1,pA0,pA1,t,true,true,true);     WAIT_BAR(2); RESC(); ROT();
    STEP(pA0,pA1,pB0,pB1,t+1,true,true,true);   WAIT_BAR(2); RESC(); ROT();
  }
  #undef CMASK
  #define CMASK(P0,P1,t) do{}while(0)
  #define ENDW(tt) do{ if((tt)+3<NT){WAIT_BAR(2);} else if((tt)+2<NT){WAIT_BAR(1);} else {WAIT_BAR(0);} }while(0)
  for(;t+1<NT;t+=2){
    STEP(pB0,pB1,pA0,pA1,t,(t+3<NT),(t+1<NT),(t+1<NT));       ENDW(t);   RESC(); ROT();
    STEP(pA0,pA1,pB0,pB1,t+1,(t+4<NT),(t+2<NT),(t+2<NT));     ENDW(t+1); RESC(); ROT();
  }
  STEP(pB0,pB1,pA0,pA1,NT-1,false,false,false); RESC();
  { float sacc=pB0[0]+pB0[1]; _Pragma("unroll") for(int r=2;r<16;++r)sacc+=pB0[r]; _Pragma("unroll") for(int r=0;r<16;++r)sacc+=pB1[r]; l_reg+=sacc;
    pw0=(u32x4){PKW(pB0,0),PKW(pB0,2),PKW(pB0,4),PKW(pB0,6)};pw1=(u32x4){PKW(pB0,8),PKW(pB0,10),PKW(pB0,12),PKW(pB0,14)};pw2=(u32x4){PKW(pB1,0),PKW(pB1,2),PKW(pB1,4),PKW(pB1,6)};pw3=(u32x4){PKW(pB1,8),PKW(pB1,10),PKW(pB1,12),PKW(pB1,14)};
    SBAR(); pv(o,vb0+sl_cur,PAF(0),PAF(1),PAF(2),PAF(3)); }
  #undef PKW
  #undef PAF
  #undef VFR
  #undef PIN
  #undef MX3
  #undef GAPA
  #undef GAPB
  #undef EX
  #undef VRD
  #undef KRD
  #undef STEP
  #undef ENDW
  {auto rr=__builtin_amdgcn_permlane32_swap(__float_as_uint(l_reg),__float_as_uint(l_reg),false,false);l_reg=__uint_as_float(rr[0])+__uint_as_float(rr[1]);}
  if(hi==0)wsf[32+r32]=l_reg;asm volatile("s_waitcnt lgkmcnt(0)":::"memory");
  float rli[16];
  #pragma unroll
  for(int r=0;r<16;++r)rli[r]=__builtin_amdgcn_rcpf(wsf[32+crow(r,hi)]);
  bf16*Ow=O+(rowbase+q0+wid*QBLK)*PO+h*D;
  { bf16*stg=(bf16*)(shm+LDS_OST)+wid*2048;
    #pragma unroll
    for(int r=0;r<16;++r){const int orow=crow(r,hi);
      #pragma unroll
      for(int d0=0;d0<2;++d0)stg[orow*64+d0*32+r32]=__float2bfloat16(o[d0][r]*rli[r]);}
    asm volatile("s_waitcnt lgkmcnt(0)":::"memory");
    #pragma unroll
    for(int i=0;i<4;++i){const int row=i*8+(lane>>3),ch=lane&7; const u32x4 v=*(const u32x4*)(stg+row*64+ch*8); ATTN_STORE16(Ow+(long)row*PO+ch*8,v);} }
  asm volatile("s_waitcnt lgkmcnt(0)\n\ts_barrier":::"memory");
  #undef DMA_K
  #undef DMA_V
  #undef CMASK
  #undef START
  #undef RESC
  #undef ROT
}
constexpr int ATTN_LDS_BYTES=LDS_BYTES;
#undef SBAR
#undef WAIT_BAR
}

DEV void phase_even_post(PPtr p, int li) {
    const int lane = tidx() & 63, gw = blockIdx.x * NWAVE + (tidx() >> 6), ngw = gridDim.x * NWAVE;
    u16* RAW = (u16*)(p->ws + OFF_RAW);
    const float* qg = p->in[10] + li * 64; const float* kg = p->in[11] + li * 64;
    const int half = lane >> 5, i = lane & 31;
    const float inv = powf(10000.f, -(float)(i & 15) / 16.f);
    for (int m = gw; m < MROWS; m += ngw) {
        const int b = m / RPB, q = m - b * RPB;
        float cs = 1.f, sn = 0.f;
        if (q < SEQ) { const float pos = (i < 16) ? (float)(q >> 6) : (float)(q & 63); const float ang = pos * inv; sn = sinf(ang); cs = cosf(ang); }
        u16* row = RAW + (size_t)m * 1536;
        for (int hs = 0; hs < 20; hs += 2) {
            const int s = hs + half; int c0; const float* gn = nullptr;
            if (s < 8) { c0 = s * 64; gn = qg; } else if (s < 10) { c0 = 512 + (s - 8) * 64; gn = kg; } else if (s < 18) { c0 = 768 + (s - 10) * 64; } else { c0 = 1280 + (s - 18) * 64; }
            float v1 = bf2f(row[c0 + i]), v2 = bf2f(row[c0 + i + 32]);
            if (hs < 10) {
                float ss = v1 * v1 + v2 * v2;
#pragma unroll
                for (int o = 1; o < 32; o <<= 1) ss += __shfl_xor(ss, o);
                const float rs = rsqrtf(ss * (1.f / 64.f) + 1e-6f);
                v1 *= rs * gn[i]; v2 *= rs * gn[i + 32];
            }
            float o1 = v1 * cs - v2 * sn, o2 = v1 * sn + v2 * cs;
            if (hs < 8 && q < SEQ) { o1 *= attn_body::C2; o2 *= attn_body::C2; }
            row[c0 + i] = (u16)f2bf(o1); row[c0 + i + 32] = (u16)f2bf(o2);
        }
    }
}

template <int mode, bool qctx>
DEV void attn_wave(const u16* QB, int pitch, int qcol, int kcol, int vcol, u16* AO, int ocol,
                   int b, int hk, int blk, const float* sinkp, const float* rpb, u16* sV) {
    const int lane = tidx() & 63, qi = lane & 15, quad = lane >> 4;
    const bool gqa = mode < 2;
    const size_t rowb = (size_t)b * RPB;
    const float SCL = 0.125f * LOG2E;
    int qtok[4], qhead[4]; bf16x8 qf[4][2];
#pragma unroll
    for (int i = 0; i < 4; ++i) {
        qtok[i] = gqa ? blk * 16 + qi : blk * 64 + i * 16 + qi; qhead[i] = gqa ? hk * 4 + i : hk;
        const size_t m = rowb + (qctx ? SEQ : 0) + qtok[i];
        const u16* qp = QB + m * pitch + qcol + qhead[i] * 64 + quad * 8;
        qf[i][0] = *(const bf16x8*)qp; qf[i][1] = *(const bf16x8*)(qp + 32);
    }
    f32x4 o[4][4]; float mrun[4], lrun[4];
#pragma unroll
    for (int i = 0; i < 4; ++i) {
#pragma unroll
        for (int d = 0; d < 4; ++d) o[i][d] = (f32x4){0.f, 0.f, 0.f, 0.f};
        if (mode == 1) { mrun[i] = sinkp[qhead[i]] * LOG2E; lrun[i] = (quad == 0) ? 1.f : 0.f; } else { mrun[i] = -1e30f; lrun[i] = 0.f; }
    }
    const u16* Kb = QB + kcol + hk * 64; const u16* Vb = QB + vcol + hk * 64;
    int n_local, ustart, rs = 0;
    if (qctx) { n_local = 0; ustart = 0; }
    else if (mode == 0) { n_local = RPB / 32; ustart = 0; }
    else if (mode == 1) { n_local = 9; ustart = blk * 16 - 128; }
    else { rs = min(max(blk - 4, 0), 248); n_local = 16; ustart = rs * 64; }
    const int n_ctx = (mode == 0 && !qctx) ? 0 : 8;
    for (int tt = 0; tt < n_local + n_ctx; ++tt) {
        const bool loc = tt < n_local;
        const int u0 = loc ? ustart + 32 * tt : SEQ + 32 * (tt - n_local);
        const bool masked = loc && mode != 0;
        bf16x8 kf[2][2];
#pragma unroll
        for (int kt = 0; kt < 2; ++kt) {
            const int u = min(max(u0 + kt * 16 + qi, 0), RPB - 1);
            const u16* kp = Kb + (rowb + u) * pitch + quad * 8;
            kf[kt][0] = *(const bf16x8*)kp; kf[kt][1] = *(const bf16x8*)(kp + 32);
        }
#pragma unroll
        for (int c = 0; c < 4; ++c) {
            const int idx = c * 64 + lane, key = idx >> 3, dc = idx & 7;
            const int u = min(max(u0 + key, 0), RPB - 1);
            const uint4 v = *(const uint4*)(Vb + (rowb + u) * pitch + dc * 8);
            *(uint4*)(sV + key * 72 + dc * 8) = v;
        }
        bf16x8 vf[4];
#pragma unroll
        for (int dt = 0; dt < 4; ++dt)
#pragma unroll
            for (int jj = 0; jj < 8; ++jj) {
                const int key = (jj < 4) ? quad * 4 + jj : 16 + quad * 4 + (jj - 4);
                vf[dt][jj] = (short)sV[key * 72 + dt * 16 + qi];
            }
#pragma unroll
        for (int i = 0; i < 4; ++i) {
            f32x4 s0 = (f32x4){0.f, 0.f, 0.f, 0.f}, s1 = (f32x4){0.f, 0.f, 0.f, 0.f};
            s0 = __builtin_amdgcn_mfma_f32_16x16x32_bf16(kf[0][0], qf[i][0], s0, 0, 0, 0);
            s0 = __builtin_amdgcn_mfma_f32_16x16x32_bf16(kf[0][1], qf[i][1], s0, 0, 0, 0);
            s1 = __builtin_amdgcn_mfma_f32_16x16x32_bf16(kf[1][0], qf[i][0], s1, 0, 0, 0);
            s1 = __builtin_amdgcn_mfma_f32_16x16x32_bf16(kf[1][1], qf[i][1], s1, 0, 0, 0);
            float sc[8];
#pragma unroll
            for (int j = 0; j < 4; ++j) { sc[j] = s0[j] * SCL; sc[4 + j] = s1[j] * SCL; }
            if (masked) {
                const int t = qtok[i];
#pragma unroll
                for (int e = 0; e < 8; ++e) {
                    const int u = u0 + (e >> 2) * 16 + quad * 4 + (e & 3);
                    if (mode == 1) {
                        const int dd = t - u;
                        const bool ok = (u >= 0) && (u < SEQ) && (dd <= 128) && (dd >= -128);
                        if (!ok) sc[e] = -INFINITY;
                    } else {
                        const int c = t & 63, r = t >> 6, ur = u >> 6, uc = u & 63;
                        const int cst = min(max(c - 8, 0), 48);
                        const bool ok = (uc >= cst) && (uc < cst + 16);
                        const int dr = min(max(ur - r + 7, 0), 14), dcx = min(max(uc - c + 15, 0), 30);
                        const float bias = rpb[(qhead[i] * 15 + dr) * 31 + dcx];
                        sc[e] = ok ? sc[e] + bias * LOG2E : -INFINITY;
                    }
                }
            }
            float mx = fmaxf(fmaxf(fmaxf(sc[0], sc[1]), fmaxf(sc[2], sc[3])), fmaxf(fmaxf(sc[4], sc[5]), fmaxf(sc[6], sc[7])));
            mx = fmaxf(mx, __shfl_xor(mx, 16)); mx = fmaxf(mx, __shfl_xor(mx, 32));
            const float mn = fmaxf(mrun[i], mx);
            const float al = __builtin_amdgcn_exp2f(mrun[i] - mn);
            mrun[i] = mn;
            float pe[8], ps = 0.f;
#pragma unroll
            for (int e = 0; e < 8; ++e) { pe[e] = __builtin_amdgcn_exp2f(sc[e] - mn); ps += pe[e]; }
            lrun[i] = lrun[i] * al + ps;
            union { unsigned u[4]; bf16x8 v; } pf;
            pf.u[0] = pk2(pe[0], pe[1]); pf.u[1] = pk2(pe[2], pe[3]); pf.u[2] = pk2(pe[4], pe[5]); pf.u[3] = pk2(pe[6], pe[7]);
#pragma unroll
            for (int dt = 0; dt < 4; ++dt) {
                o[i][dt] = o[i][dt] * al;
                o[i][dt] = __builtin_amdgcn_mfma_f32_16x16x32_bf16(vf[dt], pf.v, o[i][dt], 0, 0, 0);
            }
        }
    }
#pragma unroll
    for (int i = 0; i < 4; ++i) {
        float l = lrun[i]; l += __shfl_xor(l, 16); l += __shfl_xor(l, 32);
        const float inv = 1.f / l;
        const size_t m = rowb + (qctx ? SEQ : 0) + qtok[i];
        u16* op = AO + m * DM + ocol + qhead[i] * 64 + quad * 4;
#pragma unroll
        for (int dt = 0; dt < 4; ++dt) {
            uint2 w; w.x = pk2(o[i][dt][0] * inv, o[i][dt][1] * inv); w.y = pk2(o[i][dt][2] * inv, o[i][dt][3] * inv);
            *(uint2*)(op + dt * 16) = w;
        }
    }
}

DEV void phase_attn_even(PPtr p, int li, char* lds) {
    {
        const attn_body::bf16* RAWb = (const attn_body::bf16*)(p->ws + OFF_RAW); attn_body::bf16* AOb = (attn_body::bf16*)(p->ws + OFF_AO);
        const int G = gridDim.x, bx = blockIdx.x;
        if (G == 256) {
            const int vcu = (bx & 7) * 32 + (bx >> 3); const int x = vcu >> 5, combo = x >> 1, sub = (x & 1) * 32 + (vcu & 31);
            for (int i = 0; i < 4; ++i) attn_body::attn_unit<8>(combo >> 1, (combo & 1) * 4 + i, sub, RAWb, RAWb + 512, RAWb + 640, AOb, lds);
        } else {
            for (int u = bx; u < 1024; u += G) attn_body::attn_unit<8>(u >> 9, (u >> 6) & 7, u & 63, RAWb, RAWb + 512, RAWb + 640, AOb, lds);
        }
    }
    const int wave = tidx() >> 6, gw = blockIdx.x * NWAVE + wave, ngw = gridDim.x * NWAVE;
    u16* sV = (u16*)lds + wave * (32 * 72);
    const u16* RAW = (const u16*)(p->ws + OFF_RAW); u16* AO = (u16*)(p->ws + OFF_AO);
    const float* sink = p->in[12] + li * 8;
    for (int t = gw; t < 4224; t += ngw) {
        if (t < 4096) attn_wave<1, false>(RAW, 1536, 768, 1280, 1408, AO, 512, t >> 11, (t >> 10) & 1, t & 1023, sink, nullptr, sV);
        else if (t < 4160) { const int u = t - 4096; attn_wave<0, true>(RAW, 1536, 0, 512, 640, AO, 0, u >> 5, (u >> 4) & 1, u & 15, nullptr, nullptr, sV); }
        else { const int u = t - 4160; attn_wave<1, true>(RAW, 1536, 768, 1280, 1408, AO, 512, u >> 5, (u >> 4) & 1, u & 15, sink, nullptr, sV); }
    }
}
DEV void phase_attn_odd(PPtr p, int li, char* lds) {
    const int wave = tidx() >> 6, gw = blockIdx.x * NWAVE + wave, ngw = gridDim.x * NWAVE;
    u16* sV = (u16*)lds + wave * (32 * 72);
    const u16* QKV = (const u16*)(p->ws + OFF_RAW); u16* AO = (u16*)(p->ws + OFF_AO);
    const float* rpb = p->in[15] + li * 8 * 15 * 31;
    for (int t = gw; t < 4160; t += ngw) {
        if (t < 4096) attn_wave<2, false>(QKV, 1536, 0, 512, 1024, AO, 0, t >> 11, (t >> 8) & 7, t & 255, nullptr, rpb, sV);
        else { const int u = t - 4096; attn_wave<2, true>(QKV, 1536, 0, 512, 1024, AO, 0, u >> 5, (u >> 2) & 7, u & 3, nullptr, rpb, sV); }
    }
}

DEV float shiftmix_at(const u16* ZDb, int pp, int ch, float mu) {
    const bool lat = pp < SEQ; const int lo = lat ? 0 : SEQ, hi = lat ? SEQ : RPB;
    const u16* zc = ZDb + (size_t)pp * ZDW + ch;
    const float z = bf2f(zc[0]);
    const float a = (pp - 1 >= lo) ? bf2f(zc[-ZDW]) : 0.f, c = (pp + 1 < hi) ? bf2f(zc[ZDW]) : 0.f;
    return z + (0.5f * (a + c) - z) * mu;
}
DEV void phase_rwkv_prep(PPtr p, int li, int bb) {
    const int lane = tidx() & 63, gw = blockIdx.x * NWAVE + (tidx() >> 6), ngw = gridDim.x * NWAVE;
    const u16* ZDb = (const u16*)(p->ws + OFF_ZD) + (size_t)bb * RPB * ZDW;
    const float* mu = p->in[16] + li * ZDW; const float* kkw = p->in[22] + li * 512;
    u16* R = (u16*)(p->ws + OFF_R); u16* KK = (u16*)(p->ws + OFF_KK); u16* V = (u16*)(p->ws + OFF_V); u16* LA = (u16*)(p->ws + OFF_LA);
    {
        float4* Yz = (float4*)(p->ws + OFF_Y0); const float4 z = {0.f, 0.f, 0.f, 0.f};
        for (size_t i = (size_t)gw * 64 + lane; i < (size_t)RPB * 512 / 4; i += (size_t)ngw * 64) Yz[i] = z;
    }
    for (int pp = gw; pp < RPB; pp += ngw) {
        for (int j = 0; j < 28; ++j) {
            const int ch = lane + 64 * j;
            const float zs = shiftmix_at(ZDb, pp, ch, mu[ch]);
            if (j < 8) R[(size_t)pp * 512 + ch] = (u16)f2bf(zs);
            else if (j < 16) {
                const float t = zs * kkw[ch - 512]; const float ss = wave_sum(t * t);
                KK[(size_t)pp * 512 + ch - 512] = (u16)f2bf(t / fmaxf(sqrtf(ss), 1e-12f));
            } else if (j < 24) V[(size_t)pp * 512 + ch - 1024] = (u16)f2bf(zs);
            else if (j == 24) LA[(size_t)pp * 256 + lane] = (u16)f2bf(tanhf(zs));
            else if (j == 25) LA[(size_t)pp * 256 + 64 + lane] = (u16)f2bf(zs);
            else LA[(size_t)pp * 256 + 128 + (ch - 1664)] = (u16)f2bf(sigmoidf_(zs));
        }
    }
}
struct EpiDecay { float* DEC; const float* w0; int d;
    DEV void operator()(int r, int c, float v, float) const {
        const float x = -(w0[c] + v); const float sp = x > 20.f ? x : log1pf(expf(x)); const float w = -sp - 0.5f;
        DEC[((size_t)r * 2 + d) * 512 + c] = expf(-expf(w)); } };
struct EpiIclr { u16* KD; u16* BQ; const u16* KK; const u16* ZDb; const float* a0; const float* ka; const float* muk; int d;
    DEV void operator()(int r, int c, float v, float) const {
        const float a = sigmoidf_(a0[c] + v);
        const float k = shiftmix_at(ZDb, r, 512 + c, muk[c]);
        KD[((size_t)r * 2 + d) * 512 + c] = (u16)f2bf(k * (1.f + (a - 1.f) * ka[c]));
        BQ[((size_t)r * 2 + d) * 512 + c] = (u16)f2bf(bf2f(KK[(size_t)r * 512 + c]) * a); } };
struct EpiGate { u16* G; DEV void operator()(int r, int c, float v, float) const { G[(size_t)r * 512 + c] = (u16)f2bf(v); } };

DEV int pos_to_pp(int s, int d) { return (s < NCTX) ? (d ? SEQ + NCTX - 1 - s : SEQ + s) : (d ? SEQ - 1 - (s - NCTX) : s - NCTX); }
struct StepV { float d; unsigned a; unsigned b; float v; };
DEV StepV load_step(const float* DEC, const u16* KD, const u16* BQ, const u16* KK, const u16* R, const u16* V, int pp, int h, int d, int lane) {
    const size_t e1 = (size_t)pp * 512 + h * 64, e2 = ((size_t)pp * 2 + d) * 512 + h * 64;
    StepV s;
    s.d = DEC[e2 + lane];
    s.a = (lane < 32) ? ((const unsigned*)(KD + e2))[lane] : ((const unsigned*)(BQ + e2))[lane - 32];
    s.b = (lane < 32) ? ((const unsigned*)(KK + e1))[lane] : ((const unsigned*)(R + e1))[lane - 32];
    s.v = bf2f(V[e1 + lane]);
    return s;
}
#define RLU(x, j) ((unsigned)__builtin_amdgcn_readlane((int)(x), (j)))
#define RLF(x, j) __int_as_float(__builtin_amdgcn_readlane(__float_as_int(x), (j)))
template <int MODE>
DEV float scan_step(float (&S)[64], StepV c) {
    float sa0 = 0.f, sa1 = 0.f;
#pragma unroll
    for (int j = 0; j < 32; ++j) { const unsigned u = RLU(c.b, j); sa0 += S[2 * j] * bflo(u); sa1 += S[2 * j + 1] * bfhi(u);
        if ((j & 7) == 7) asm volatile("" : "+v"(c.b), "+v"(sa0), "+v"(sa1)); }
    const float nsa = -(sa0 + sa1), vv = c.v;
    float y0 = 0.f, y1 = 0.f;
#pragma unroll
    for (int j = 0; j < 32; ++j) {
        const unsigned ub = RLU(c.a, 32 + j);
        const float d0 = RLF(c.d, 2 * j), d1 = RLF(c.d, 2 * j + 1);
        float t0 = nsa * bflo(ub), t1 = nsa * bfhi(ub);
        if (MODE >= 1) { const unsigned uk = RLU(c.a, j); t0 += vv * bflo(uk); t1 += vv * bfhi(uk); }
        S[2 * j] = S[2 * j] * d0 + t0; S[2 * j + 1] = S[2 * j + 1] * d1 + t1;
        if (MODE == 2) { const unsigned ur = RLU(c.b, 32 + j); y0 += S[2 * j] * bflo(ur); y1 += S[2 * j + 1] * bfhi(ur); }
        if ((j & 3) == 3) asm volatile("" : "+v"(c.a), "+v"(c.b), "+v"(c.d), "+v"(y0), "+v"(y1));
    }
    return y0 + y1;
}
DEV void phase_scan1(PPtr p) {
    const int tid = tidx(), lane = tid & 63, gw = blockIdx.x * NWAVE + __builtin_amdgcn_readfirstlane(tid >> 6), ngw = gridDim.x * NWAVE;
    const float* DEC = (const float*)(p->ws + OFF_DEC); const u16* KD = (const u16*)(p->ws + OFF_KD); const u16* BQ = (const u16*)(p->ws + OFF_BQ);
    const u16* KK = (const u16*)(p->ws + OFF_KK); const u16* R = (const u16*)(p->ws + OFF_R); const u16* V = (const u16*)(p->ws + OFF_V);
    float* PU = (float*)(p->ws + OFF_PU);
    for (int task = gw; task < 16 * NCH; task += ngw) {
        const int seq = task >> 7, c = task & 127, h = seq >> 1, d = seq & 1;
#define LD(st) load_step(DEC, KD, BQ, KK, R, V, pos_to_pp(c * CLEN + min((st), CLEN - 1), d), h, d, lane)
        for (int which = 0; which < 2; ++which) {
            float X[64];
#pragma unroll
            for (int j = 0; j < 64; ++j) X[j] = (which == 0 && j == lane) ? 1.f : 0.f;
            StepV r0 = LD(0), r1 = LD(1), r2 = LD(2), r3 = LD(3);
            if (which == 0) {
#pragma unroll 1
                for (int st = 0; st < CLEN; ++st) { scan_step<0>(X, r0); r0 = r1; r1 = r2; r2 = r3; r3 = LD(st + 4); }
            } else {
#pragma unroll 1
                for (int st = 0; st < CLEN; ++st) { scan_step<1>(X, r0); r0 = r1; r1 = r2; r2 = r3; r3 = LD(st + 4); }
            }
            float4* o = (float4*)(PU + ((size_t)task * 2 + which) * 4096 + lane * 64);
#pragma unroll
            for (int j = 0; j < 16; ++j) o[j] = (float4){X[4 * j], X[4 * j + 1], X[4 * j + 2], X[4 * j + 3]};
        }
#undef LD
    }
}
DEV void phase_scan2(PPtr p, char* lds) {
    if (blockIdx.x >= 16) return;
    const int tid = tidx(), lane = tid & 63, w = __builtin_amdgcn_readfirstlane(tid >> 6), seq = blockIdx.x;
    float* sS = (float*)lds;
    float* sP = sS + 2 * 64 * 68;
    float* PU = (float*)(p->ws + OFF_PU) + (size_t)seq * NCH * 2 * 4096;
    const int rt = w >> 1, ct0 = (w & 1) * 2, r = lane & 15, q = lane >> 4;
    for (int i = tid; i < 64 * 68; i += NTHR) sS[i] = 0.f;
    const int prow = tid >> 3, pcol = (tid & 7) * 8;
#define PLOAD(c_, lo, hi) do { const float4* s_ = (const float4*)(PU + (size_t)(c_) * 8192 + prow * 64 + pcol); lo = s_[0]; hi = s_[1]; } while (0)
#define ULOAD(c_, u_) do { const float* s_ = PU + (size_t)(c_) * 8192 + 4096; _Pragma("unroll") for (int t = 0; t < 2; ++t) _Pragma("unroll") for (int j = 0; j < 4; ++j) u_[t][j] = s_[(16 * rt + 4 * q + j) * 64 + 16 * (ct0 + t) + r]; } while (0)
    float4 pa0, pa1, pb0, pb1;
    { float4 t0, t1; PLOAD(0, t0, t1); *(float4*)(sP + prow * 68 + pcol) = t0; *(float4*)(sP + prow * 68 + pcol + 4) = t1; }
    PLOAD(1, pa0, pa1); PLOAD(2, pb0, pb1);
    float ua[2][4], ub[2][4], mine[2][4];
    ULOAD(0, ua); ULOAD(1, ub);
#pragma unroll
    for (int t = 0; t < 2; ++t)
#pragma unroll
        for (int j = 0; j < 4; ++j) mine[t][j] = 0.f;
    __syncthreads();
    for (int c = 0; c < NCH; ++c) {
        const int cur = c & 1;
        float* Um = PU + (size_t)c * 8192 + 4096;
#pragma unroll
        for (int t = 0; t < 2; ++t)
#pragma unroll
            for (int j = 0; j < 4; ++j) Um[(16 * rt + 4 * q + j) * 64 + 16 * (ct0 + t) + r] = mine[t][j];
        f32x4 a0 = {ua[0][0], ua[0][1], ua[0][2], ua[0][3]}, a1 = {ua[1][0], ua[1][1], ua[1][2], ua[1][3]};
        const float* Sc = sS + cur * (64 * 68); const float* Pc = sP + cur * (64 * 68);
#pragma unroll
        for (int ks = 0; ks < 16; ++ks) {
            const float av = Sc[(16 * rt + r) * 68 + 4 * ks + q];
            const float b0 = Pc[(4 * ks + q) * 68 + 16 * ct0 + r], b1 = Pc[(4 * ks + q) * 68 + 16 * ct0 + 16 + r];
            a0 = __builtin_amdgcn_mfma_f32_16x16x4f32(av, b0, a0, 0, 0, 0);
            a1 = __builtin_amdgcn_mfma_f32_16x16x4f32(av, b1, a1, 0, 0, 0);
        }
        float* Sn = sS + (cur ^ 1) * (64 * 68);
#pragma unroll
        for (int j = 0; j < 4; ++j) { Sn[(16 * rt + 4 * q + j) * 68 + 16 * ct0 + r] = a0[j]; Sn[(16 * rt + 4 * q + j) * 68 + 16 * ct0 + 16 + r] = a1[j]; mine[0][j] = a0[j]; mine[1][j] = a1[j]; }
        { float* Pn = sP + (cur ^ 1) * (64 * 68); *(float4*)(Pn + prow * 68 + pcol) = pa0; *(float4*)(Pn + prow * 68 + pcol + 4) = pa1; }
        pa0 = pb0; pa1 = pb1;
        { const int c3 = min(c + 3, NCH - 1); PLOAD(c3, pb0, pb1); }
#pragma unroll
        for (int t = 0; t < 2; ++t)
#pragma unroll
            for (int j = 0; j < 4; ++j) ua[t][j] = ub[t][j];
        { const int c2 = c + 2; if (c2 < NCH) ULOAD(c2, ub); }
        __syncthreads();
    }
#undef PLOAD
#undef ULOAD
}
DEV void phase_scan3(PPtr p) {
    const int tid = tidx(), lane = tid & 63, gw = blockIdx.x * NWAVE + __builtin_amdgcn_readfirstlane(tid >> 6), ngw = gridDim.x * NWAVE;
    const float* DEC = (const float*)(p->ws + OFF_DEC); const u16* KD = (const u16*)(p->ws + OFF_KD); const u16* BQ = (const u16*)(p->ws + OFF_BQ);
    const u16* KK = (const u16*)(p->ws + OFF_KK); const u16* R = (const u16*)(p->ws + OFF_R); const u16* V = (const u16*)(p->ws + OFF_V);
    const float* PU = (const float*)(p->ws + OFF_PU);
    float* Y = (float*)(p->ws + OFF_Y0);
    for (int task = gw; task < 16 * NCH; task += ngw) {
        const int seq = task >> 7, c = task & 127, h = seq >> 1, d = seq & 1;
        float S[64];
        {
            const float4* si = (const float4*)(PU + ((size_t)task * 2 + 1) * 4096 + lane * 64);
#pragma unroll
            for (int j = 0; j < 16; ++j) { const float4 t = si[j]; S[4 * j] = t.x; S[4 * j + 1] = t.y; S[4 * j + 2] = t.z; S[4 * j + 3] = t.w; }
        }
#define LD(st) load_step(DEC, KD, BQ, KK, R, V, pos_to_pp(c * CLEN + min((st), CLEN - 1), d), h, d, lane)
#define YADD(st, y) unsafeAtomicAdd(Y + (size_t)pos_to_pp(c * CLEN + (st), d) * 512 + h * 64 + lane, (y))
        StepV r0 = LD(0), r1 = LD(1), r2 = LD(2), r3 = LD(3);
#pragma unroll 1
        for (int st = 0; st < CLEN; ++st) {
            const float y = scan_step<2>(S, r0); YADD(st, y); r0 = r1; r1 = r2; r2 = r3; r3 = LD(st + 4);
        }
#undef LD
#undef YADD
    }
}
DEV void phase_readout(PPtr p, int li, int bb) {
    const int lane = tidx() & 63, gw = blockIdx.x * NWAVE + (tidx() >> 6), ngw = gridDim.x * NWAVE;
    const float* Y0 = (const float*)(p->ws + OFF_Y0);
    const u16* KD = (const u16*)(p->ws + OFF_KD); const u16* R = (const u16*)(p->ws + OFF_R); const u16* V = (const u16*)(p->ws + OFF_V); const u16* G = (const u16*)(p->ws + OFF_G);
    const float* rk = p->in[24] + li * 512; const float* lnw = p->in[25] + li * 512; const float* lnb = p->in[26] + li * 512;
    u16* AO = (u16*)(p->ws + OFF_AO);
    for (int pp = gw; pp < RPB; pp += ngw) {
        const size_t m = (size_t)bb * RPB + pp;
        for (int h = 0; h < 8; ++h) {
            const int c = h * 64 + lane; const size_t e = (size_t)pp * 512 + c;
            const float y = Y0[e];
            const float mean = wave_sum(y) * (1.f / 64.f); const float dv = y - mean; const float var = wave_sum(dv * dv) * (1.f / 64.f);
            const float yn = dv * rsqrtf(var + 64e-5f) * lnw[c] + lnb[c];
            const float r = bf2f(R[e]); const float ks = bf2f(KD[((size_t)pp * 2) * 512 + c]) + bf2f(KD[((size_t)pp * 2 + 1) * 512 + c]);
            const float bs = wave_sum(r * ks * rk[c]);
            AO[m * DM + 512 + c] = (u16)f2bf((yn + bs * bf2f(V[e])) * bf2f(G[e]));
        }
    }
}
DEV void phase_final(PPtr p) {
    const int lane = tidx() & 63, gw = blockIdx.x * NWAVE + (tidx() >> 6), ngw = gridDim.x * NWAVE;
    const float* gain = p->in[29];
    for (int m = gw; m < NB * SEQ; m += ngw) {
        float4* xr = (float4*)(p->out + (size_t)m * DM);
        float4 v[4]; float ss = 0.f;
#pragma unroll
        for (int j = 0; j < 4; ++j) { v[j] = xr[lane + 64 * j]; ss += v[j].x * v[j].x + v[j].y * v[j].y + v[j].z * v[j].z + v[j].w * v[j].w; }
        ss = wave_sum(ss);
        const float rstd = rsqrtf(ss * (1.f / DM) + 1e-6f);
#pragma unroll
        for (int j = 0; j < 4; ++j) {
            const float4 g = *(const float4*)(gain + (lane + 64 * j) * 4);
            float4 o; o.x = v[j].x * rstd * g.x; o.y = v[j].y * rstd * g.y; o.z = v[j].z * rstd * g.z; o.w = v[j].w * rstd * g.w;
            xr[lane + 64 * j] = o;
        }
    }
}

constexpr size_t OFF_BAR = 768 * 1024;
DEV void gbar(PPtr kp_, unsigned& nbar) {
    asm volatile("s_waitcnt vmcnt(0)" ::: "memory");
    __syncthreads();
    if (threadIdx.x == 0) {
        unsigned* ctr = (unsigned*)(kp_->ws + OFF_BAR);
        __builtin_amdgcn_fence(__ATOMIC_RELEASE, "agent");
        asm volatile("s_waitcnt vmcnt(0)" ::: "memory");
        ++nbar;
        __hip_atomic_fetch_add(ctr, 1u, __ATOMIC_RELAXED, __HIP_MEMORY_SCOPE_AGENT);
        const unsigned target = nbar * gridDim.x;
        while (__hip_atomic_load(ctr, __ATOMIC_RELAXED, __HIP_MEMORY_SCOPE_AGENT) < target) __builtin_amdgcn_s_sleep(1);
        __builtin_amdgcn_fence(__ATOMIC_ACQUIRE, "agent");
        asm volatile("s_waitcnt vmcnt(0)" ::: "memory");
    }
    __syncthreads();
}
#define p launder(kp)
#define SYNC() gbar(launder(kp), nbar)
template <int layer>
DEV void do_layer(PPtr kp, unsigned& nbar, char* lds) {
    unsigned char* ws = launder(kp)->ws;
    const float* mod = (const float*)(ws + OFF_MOD);
    u16* HN = (u16*)(ws + OFF_HN); u16* AO = (u16*)(ws + OFF_AO); u16* RAW = (u16*)(ws + OFF_RAW); u16* ZD = (u16*)(ws + OFF_ZD);
        const int li = layer >> 1;
        const float* lmod = mod + (size_t)layer * 3 * 6144;
        phase_wprep(p, layer, lds); phase_normmod(p, layer, 0); SYNC();
        const pg8::bf16_t* WB = (const pg8::bf16_t*)(ws + OFF_WB);
#define GEMM8(A_, B_, N_, K_, E_) do { pg8::Gemm g_{(const pg8::bf16_t*)(A_), (B_), MROWS, (N_), (K_)}; pg8::StaticOrder S_; S_.init(MROWS, (N_), (int)gridDim.x, (int)blockIdx.x); \
            pg8::gemm_phase<decltype(E_), pg8::StaticOrder, true, true>((PG8_LAS unsigned char*)lds, g_, S_, E_); } while (0)
        if (!(layer & 1)) {
            { pg8::EpiStoreT e{RAW, 1536, 1 << 30, RAW, 1536}; GEMM8(HN, WB + WB_IN, 1536, DM, e); } SYNC();
            phase_even_post(p, li); SYNC();
            phase_attn_even(p, li, lds); SYNC();
            { pg8::EpiResidT e{p, lmod + 2048}; GEMM8(AO, WB + WB_OUT, DM, DM, e); } SYNC();
        } else {
            { pg8::EpiStoreT e{RAW, 1536, 1536, ZD, ZDW}; GEMM8(HN, WB + WB_IN, 3328, DM, e); } SYNC();
            phase_attn_odd(p, li, lds); SYNC();
            for (int bb = 0; bb < 2; ++bb) {
                phase_rwkv_prep(p, li, bb); SYNC();
                const u16* LA = (const u16*)(ws + OFF_LA); const u16* ZDb = ZD + (size_t)bb * RPB * ZDW;
                for (int d = 0; d < 2; ++d) {
                    { EpiDecay e{(float*)(ws + OFF_DEC), p->in[17] + (li * 2 + d) * 512, d}; gemm_simple<0>(LA, 256, p->in[18] + (size_t)(li * 2 + d) * 64 * 512, 512, 0, RPB, 512, 64, e, lds); }
                    { EpiIclr e{(u16*)(ws + OFF_KD), (u16*)(ws + OFF_BQ), (const u16*)(ws + OFF_KK), ZDb, p->in[19] + (li * 2 + d) * 512, p->in[23] + li * 512, p->in[16] + li * ZDW + 512, d};
                      gemm_simple<0>(LA + 64, 256, p->in[20] + (size_t)(li * 2 + d) * 64 * 512, 512, 0, RPB, 512, 64, e, lds); }
                }
                { EpiGate e{(u16*)(ws + OFF_G)}; gemm_simple<0>(LA + 128, 256, p->in[21] + (size_t)li * 128 * 512, 512, 0, RPB, 512, 128, e, lds); }
                SYNC();
                phase_scan1(p); SYNC();
                phase_scan2(p, lds); SYNC();
                phase_scan3(p); SYNC();
                phase_readout(p, li, bb); SYNC();
            }
            { pg8::EpiResidT e{p, lmod + 2048}; GEMM8(AO, WB + WB_OUT, DM, DM, e); } SYNC();
        }
        phase_normmod(p, layer, 1); SYNC();
        { pg8::EpiSwigluT e{RAW}; GEMM8(HN, WB + WB_F1, 5632, DM, e); } SYNC();
        { pg8::EpiResidT e{p, lmod + 5120}; GEMM8(RAW, WB + WB_F2, DM, FFH, e); } SYNC();
    }
__global__ void __launch_bounds__(NTHR) mega(Params p_unused) {
    PPtr kp = (PPtr)__builtin_amdgcn_kernarg_segment_ptr();
    extern __shared__ __attribute__((aligned(16))) char lds[];
    cg::grid_group grid = cg::this_grid();
    unsigned nbar = 0;
    grid.sync();
    phase_init(p, lds); SYNC();
    do_layer<0>(kp, nbar, lds);
    do_layer<1>(kp, nbar, lds);
    do_layer<2>(kp, nbar, lds);
    do_layer<3>(kp, nbar, lds);
    phase_final(p);
}
#undef p
#undef SYNC

extern "C" void kernel_launch(void* const* d_in, const int* in_sizes, int n_in, void* d_out, int out_size, void* d_ws, size_t ws_size, hipStream_t stream) {
    static int grid = 0;
    if (grid == 0) {
        if (n_in != 30 || ws_size < WS_NEED || out_size != NB * SEQ * DM) { fprintf(stderr, "kernel_launch: unexpected problem shape (n_in %d ws %zu out %d)\n", n_in, ws_size, out_size); grid = -1; return; }
        int dev = 0, cus = 0, per_cu = 0;
        hipGetDevice(&dev);
        hipDeviceGetAttribute(&cus, hipDeviceAttributeMultiprocessorCount, dev);
        hipFuncSetAttribute((const void*)mega, hipFuncAttributeMaxDynamicSharedMemorySize, LDS_BYTES);
        hipOccupancyMaxActiveBlocksPerMultiprocessor(&per_cu, (const void*)mega, NTHR, LDS_BYTES);
        if (per_cu < 1) per_cu = 1;
        if (per_cu > 1) per_cu = 1;
        grid = cus * per_cu;
    }
    if (grid < 0) return;
    Params p{};
    for (int i = 0; i < 30; ++i) p.in[i] = (const float*)d_in[i];
    p.out = (float*)d_out; p.ws = (unsigned char*)d_ws;
    hipMemsetAsync((char*)d_ws + OFF_BAR, 0, 256, stream);
    void* args[] = {&p};
    hipError_t e = hipLaunchCooperativeKernel((const void*)mega, dim3(grid), dim3(NTHR), args, LDS_BYTES, stream);
    if (e != hipSuccess) fprintf(stderr, "cooperative launch failed: %s (grid %d)\n", hipGetErrorString(e), grid);
}
```

```cpp
#include <hip/hip_runtime.h>
#include <hip/hip_cooperative_groups.h>
#include <cstdio>
#include <cstdint>
namespace cg = cooperative_groups;

#define DEV __device__ __forceinline__
typedef unsigned short u16;
typedef short bf16x8 __attribute__((ext_vector_type(8)));
typedef float f32x4 __attribute__((ext_vector_type(4)));
typedef const __attribute__((address_space(4))) float* cfp;
typedef const __attribute__((address_space(4))) unsigned* cup;

constexpr int DM = 1024, NB = 2, SEQ = 16384, NCTX = 256, RPB = SEQ + NCTX, MROWS = NB * RPB;
constexpr int FFH = 2816, ZDW = 1792;
constexpr float LOG2E = 1.4426950408889634f;
constexpr int NTHR = 512, NWAVE = 8;
constexpr int LDS_BYTES = 132096;

constexpr size_t MiB = 1u << 20;
constexpr size_t OFF_MOD = 0;
constexpr size_t OFF_XC = 1 * MiB;
constexpr size_t OFF_WB = 3 * MiB;
constexpr size_t OFF_AO = 29 * MiB;
constexpr size_t OFF_HN = 94 * MiB;
constexpr size_t OFF_RAW = 159 * MiB;
constexpr size_t OFF_ZD = 257 * MiB;
constexpr size_t SZ_H = (size_t)RPB * 512 * 2;
constexpr size_t OFF_DEC = 94 * MiB;
constexpr size_t OFF_KD = OFF_DEC + 4 * SZ_H;
constexpr size_t OFF_BQ = OFF_KD + 2 * SZ_H;
constexpr size_t OFF_KK = OFF_BQ + 2 * SZ_H;
constexpr size_t OFF_R = OFF_KK + SZ_H;
constexpr size_t OFF_V = 371 * MiB;
constexpr size_t OFF_G = OFF_V + SZ_H;
constexpr size_t OFF_LA = OFF_G + SZ_H;
constexpr size_t OFF_Y0 = 412 * MiB;
constexpr size_t OFF_PU = OFF_Y0 + 2 * SZ_H;
constexpr size_t WS_NEED = 509 * MiB;
constexpr int NCH = 128, CLEN = 130;
static_assert(OFF_R + SZ_H <= OFF_ZD, "scan map");
static_assert(OFF_LA + SZ_H / 2 <= OFF_Y0, "scan map 2");
static_assert(OFF_PU + 64 * MiB <= WS_NEED, "scan map 3");
static_assert(OFF_RAW + (size_t)MROWS * FFH * 2 <= WS_NEED, "ffn hidden");

struct Params { const float* in[30]; float* out; unsigned char* ws; };
typedef const __attribute__((address_space(4))) Params* PPtr;
DEV int tidx() { int t = threadIdx.x; asm volatile("" : "+v"(t)); return t; }
DEV PPtr launder(PPtr p) { asm volatile("" : "+s"(p)); return p; }

DEV unsigned f2bf(float f) { unsigned u = __float_as_uint(f); return (u + 0x7fffu + ((u >> 16) & 1u)) >> 16; }
DEV float bf2f(u16 h) { return __uint_as_float(((unsigned)h) << 16); }
DEV float bflo(unsigned u) { return __uint_as_float(u << 16); }
DEV float bfhi(unsigned u) { return __uint_as_float(u & 0xffff0000u); }
DEV unsigned pk2(float lo, float hi) { return f2bf(lo) | (f2bf(hi) << 16); }
DEV void unpack8(const uint4 u, float (&f)[8]) {
    f[0] = bflo(u.x); f[1] = bfhi(u.x); f[2] = bflo(u.y); f[3] = bfhi(u.y); f[4] = bflo(u.z); f[5] = bfhi(u.z); f[6] = bflo(u.w); f[7] = bfhi(u.w);
}
DEV uint4 pack8(const float (&f)[8]) { uint4 o; o.x = pk2(f[0], f[1]); o.y = pk2(f[2], f[3]); o.z = pk2(f[4], f[5]); o.w = pk2(f[6], f[7]); return o; }
DEV float wave_sum(float v) {
#pragma unroll
    for (int o = 1; o < 64; o <<= 1) v += __shfl_xor(v, o);
    return v;
}
DEV float* xrow_ptr(PPtr p, int m) {
    int b = m / RPB, q = m - b * RPB;
    return q < SEQ ? p->out + (size_t)(b * SEQ + q) * DM : (float*)(p->ws + OFF_XC) + (size_t)(b * NCTX + (q - SEQ)) * DM;
}
DEV int mod_idx(int m) { int b = m / RPB, q = m - b * RPB; return q < SEQ ? b : 2; }
DEV float sigmoidf_(float x) { return 1.f / (1.f + __expf(-x)); }

DEV void phase_init(PPtr p, char* lds) {
    const int tid = tidx();
    const size_t gt = (size_t)blockIdx.x * NTHR + tid, ng = (size_t)gridDim.x * NTHR;
    {
        const float4* s = (const float4*)p->in[0]; float4* d = (float4*)p->out;
        const size_t n = (size_t)NB * SEQ * DM / 4;
        for (size_t i = gt; i < n; i += ng) d[i] = s[i];
        const float4* s2 = (const float4*)p->in[2]; float4* d2 = (float4*)(p->ws + OFF_XC);
        const size_t n2 = (size_t)NB * NCTX * DM / 4;
        for (size_t i = gt; i < n2; i += ng) d2[i] = s2[i];
    }
    float* red = (float*)lds;
    float* mod = (float*)(p->ws + OFF_MOD);
    const float* c = p->in[1]; const float* cc = p->in[3];
    for (int item = blockIdx.x; item < 192; item += gridDim.x) {
        const int l = item / 48, n0 = (item % 48) * 128, col = tid & 127, kp = tid >> 7;
        const float* w = p->in[4] + (size_t)l * DM * 6144 + n0 + col;
        float a0 = 0.f, a1 = 0.f, a2 = 0.f;
        for (int k = kp * 256; k < kp * 256 + 256; ++k) {
            const float wv = w[(size_t)k * 6144];
            const float c0 = c[k], c1 = c[DM + k], c2 = cc[k];
            a0 += c0 * sigmoidf_(c0) * wv; a1 += c1 * sigmoidf_(c1) * wv; a2 += c2 * sigmoidf_(c2) * wv;
        }
        red[(kp * 3 + 0) * 128 + col] = a0; red[(kp * 3 + 1) * 128 + col] = a1; red[(kp * 3 + 2) * 128 + col] = a2;
        __syncthreads();
        if (tid < 384) {
            const int mb = tid >> 7, cl = tid & 127;
            float s = red[(0 * 3 + mb) * 128 + cl] + red[(1 * 3 + mb) * 128 + cl] + red[(2 * 3 + mb) * 128 + cl] + red[(3 * 3 + mb) * 128 + cl];
            mod[(size_t)(l * 3 + mb) * 6144 + n0 + cl] = s + p->in[5][l * 6144 + n0 + cl];
        }
        __syncthreads();
    }
}

DEV void phase_normmod(PPtr p, int layer, int which) {
    const int lane = tidx() & 63, gw = blockIdx.x * NWAVE + (tidx() >> 6), ngw = gridDim.x * NWAVE;
    const float* gain = p->in[which ? 7 : 6] + layer * DM;
    const float* mod = (const float*)(p->ws + OFF_MOD) + (size_t)layer * 3 * 6144;
    u16* HN = (u16*)(p->ws + OFF_HN);
    for (int m = gw; m < MROWS; m += ngw) {
        const float* xr = xrow_ptr(p, m);
        const float* md = mod + mod_idx(m) * 6144 + (which ? 3072 : 0);
        float4 v[4]; float ss = 0.f;
#pragma unroll
        for (int j = 0; j < 4; ++j) { v[j] = ((const float4*)xr)[lane + 64 * j]; ss += v[j].x * v[j].x + v[j].y * v[j].y + v[j].z * v[j].z + v[j].w * v[j].w; }
        ss = wave_sum(ss);
        const float rstd = rsqrtf(ss * (1.f / DM) + 1e-6f);
#pragma unroll
        for (int j = 0; j < 4; ++j) {
            const int k = (lane + 64 * j) * 4;
            const float4 g = *(const float4*)(gain + k), sh = *(const float4*)(md + k), sc = *(const float4*)(md + 1024 + k);
            const float o0 = v[j].x * rstd * g.x * (1.f + sc.x) + sh.x, o1 = v[j].y * rstd * g.y * (1.f + sc.y) + sh.y;
            const float o2 = v[j].z * rstd * g.z * (1.f + sc.z) + sh.z, o3 = v[j].w * rstd * g.w * (1.f + sc.w) + sh.w;
            uint2 w; w.x = pk2(o0, o1); w.y = pk2(o2, o3);
            *(uint2*)(HN + (size_t)m * DM + k) = w;
        }
    }
}

template <int DUAL, class Epi>
DEV void gemm_simple(const u16* A, int lda, const float* W, int ldw, int dualoff, int M, int N, int K, const Epi& epi, char* lds) {
    u16* sA = (u16*)lds; u16* sB = sA + 128 * 40; u16* sB2 = sB + 128 * 40;
    const int tid = tidx(), lane = tid & 63, wave = tid >> 6, wm = wave >> 2, wn = wave & 3, r16 = lane & 15, quad = lane >> 4;
    const int mt = M / 128, nt = N / 128;
    for (int item = blockIdx.x; item < mt * nt; item += gridDim.x) {
        const int tn = item / mt, tm = item - tn * mt, m0 = tm * 128, n0 = tn * 128;
        f32x4 acc[4][2], acc2[4][2];
#pragma unroll
        for (int a = 0; a < 4; ++a)
#pragma unroll
            for (int b = 0; b < 2; ++b) { acc[a][b] = (f32x4){0.f, 0.f, 0.f, 0.f}; acc2[a][b] = (f32x4){0.f, 0.f, 0.f, 0.f}; }
        for (int k0 = 0; k0 < K; k0 += 32) {
            {
                const int row = tid >> 2, kc = (tid & 3) * 8;
                const uint4 v = *(const uint4*)(A + (size_t)(m0 + row) * lda + k0 + kc);
                *(uint4*)(sA + row * 40 + kc) = v;
            }
            {
                const int kk = tid >> 4, nc = (tid & 15) * 8;
                const float* wp = W + (size_t)(k0 + kk) * ldw + n0 + nc;
                const float4 a = *(const float4*)wp, b = *(const float4*)(wp + 4);
                sB[(nc + 0) * 40 + kk] = (u16)f2bf(a.x); sB[(nc + 1) * 40 + kk] = (u16)f2bf(a.y); sB[(nc + 2) * 40 + kk] = (u16)f2bf(a.z); sB[(nc + 3) * 40 + kk] = (u16)f2bf(a.w);
                sB[(nc + 4) * 40 + kk] = (u16)f2bf(b.x); sB[(nc + 5) * 40 + kk] = (u16)f2bf(b.y); sB[(nc + 6) * 40 + kk] = (u16)f2bf(b.z); sB[(nc + 7) * 40 + kk] = (u16)f2bf(b.w);
                if (DUAL) {
                    const float4 c = *(const float4*)(wp + dualoff), d = *(const float4*)(wp + dualoff + 4);
                    sB2[(nc + 0) * 40 + kk] = (u16)f2bf(c.x); sB2[(nc + 1) * 40 + kk] = (u16)f2bf(c.y); sB2[(nc + 2) * 40 + kk] = (u16)f2bf(c.z); sB2[(nc + 3) * 40 + kk] = (u16)f2bf(c.w);
                    sB2[(nc + 4) * 40 + kk] = (u16)f2bf(d.x); sB2[(nc + 5) * 40 + kk] = (u16)f2bf(d.y); sB2[(nc + 6) * 40 + kk] = (u16)f2bf(d.z); sB2[(nc + 7) * 40 + kk] = (u16)f2bf(d.w);
                }
            }
            __syncthreads();
            bf16x8 af[4], bfr[2], bfr2[2];
#pragma unroll
            for (int mi = 0; mi < 4; ++mi) af[mi] = *(const bf16x8*)(sA + (wm * 64 + mi * 16 + r16) * 40 + quad * 8);
#pragma unroll
            for (int ni = 0; ni < 2; ++ni) {
                bfr[ni] = *(const bf16x8*)(sB + (wn * 32 + ni * 16 + r16) * 40 + quad * 8);
                if (DUAL) bfr2[ni] = *(const bf16x8*)(sB2 + (wn * 32 + ni * 16 + r16) * 40 + quad * 8);
            }
#pragma unroll
            for (int mi = 0; mi < 4; ++mi)
#pragma unroll
                for (int ni = 0; ni < 2; ++ni) {
                    acc[mi][ni] = __builtin_amdgcn_mfma_f32_16x16x32_bf16(af[mi], bfr[ni], acc[mi][ni], 0, 0, 0);
                    if (DUAL) acc2[mi][ni] = __builtin_amdgcn_mfma_f32_16x16x32_bf16(af[mi], bfr2[ni], acc2[mi][ni], 0, 0, 0);
                }
            __syncthreads();
        }
#pragma unroll
        for (int mi = 0; mi < 4; ++mi)
#pragma unroll
            for (int ni = 0; ni < 2; ++ni)
#pragma unroll
                for (int j = 0; j < 4; ++j) {
                    const int row = m0 + wm * 64 + mi * 16 + quad * 4 + j, col = n0 + wn * 32 + ni * 16 + r16;
                    epi(row, col, acc[mi][ni][j], DUAL ? acc2[mi][ni][j] : 0.f);
                }
    }
}

struct EpiStore { u16* O; int ld; DEV void operator()(int r, int c, float v, float) const { O[(size_t)r * ld + c] = (u16)f2bf(v); } };
struct EpiStoreOdd { u16* Q; u16* Z;
    DEV void operator()(int r, int c, float v, float) const { if (c < 1536) Q[(size_t)r * 1536 + c] = (u16)f2bf(v); else Z[(size_t)r * ZDW + (c - 1536)] = (u16)f2bf(v); } };
struct EpiResid { PPtr p; const float* gate;
    DEV void operator()(int r, int c, float v, float) const { float* xr = xrow_ptr(p, r); xr[c] += gate[mod_idx(r) * 6144 + c] * v; } };
struct EpiSwiglu { u16* H;
    DEV void operator()(int r, int c, float g, float u) const { H[(size_t)r * FFH + c] = (u16)f2bf(g * sigmoidf_(g) * u); } };


namespace pg8 {
#define PG8_LAS __attribute__((address_space(3)))
typedef unsigned short bf16_t;
typedef short bf16x8 __attribute__((ext_vector_type(8)));
typedef float f32x4 __attribute__((ext_vector_type(4)));
typedef unsigned u32x4 __attribute__((ext_vector_type(4)));
constexpr int BM = 256, BK = 64, HALF = 128, HTB = HALF * BK * 2  , STAGE_BYTES = 8 * HTB, NXCD = 8, WGM = 8;

__host__ __device__ __forceinline__ int lds_byte(int r, int c) { const int st = (r >> 4) * 2 + (c >> 5), rr = r & 15, cc = c & 31, ob = rr * 64 + cc * 2; return st * 1024 + (ob ^ (((ob >> 9) & 1) << 5)); }
__host__ __device__ __forceinline__ void stage_rc(int b, int& R, int& C) { const int st = b / 1024, sb = b % 1024, swz = sb ^ (((sb >> 9) & 1) << 5); R = (st >> 1) * 16 + swz / 64; C = (st & 1) * 32 + (swz % 64) / 2; }
__host__ __device__ __forceinline__ int perm32(int rho) { const int n = rho >> 4, i = rho & 15; return 8 * (i >> 2) + 4 * n + (i & 3); }

struct Unit { int pm, pn; };
struct Gemm { const bf16_t* A; const bf16_t* Bt; int M, N, K; };

struct StaticOrder {
    int nM, nN, nwg, G, c;
    __host__ __device__ void init(int M, int N, int G_, int c_) { nM = M / BM; nN = N / BM; nwg = nM * nN; G = G_; c = c_; }
    __host__ __device__ bool next(int i, Unit& u) const {
        const long L = (long)i * G + c; if (L >= nwg) return false;
        int wgid = (int)L; { const int q = nwg / NXCD, r = nwg % NXCD, xcd = wgid % NXCD, off = wgid / NXCD; wgid = (xcd < r ? xcd * (q + 1) : r * (q + 1) + (xcd - r) * q) + off; }
        const int nig = WGM * nN, gid = wgid / nig, fm = gid * WGM, gsz = (nM - fm) < WGM ? (nM - fm) : WGM;
        u.pm = fm + ((wgid % nig) % gsz); u.pn = (wgid % nig) / gsz; return true;
    }
    __device__ __forceinline__ void a_ready(const Unit&) const {}
    __device__ __forceinline__ void done(const Unit&) const {}
};
__device__ __forceinline__ unsigned cvt_pk_bf16(float lo, float hi) { unsigned r; asm volatile("v_cvt_pk_bf16_f32 %0, %1, %2" : "=v"(r) : "v"(lo), "v"(hi)); return r; }
template <class Epi, class Sched, bool ALIGN_EPI = false, bool SP2 = false>
__device__ __forceinline__ void gemm_phase(PG8_LAS unsigned char* lds, const Gemm g, const Sched& S, const Epi& E) {
    const int tid = tidx(), wid = __builtin_amdgcn_readfirstlane(tid >> 6), lane = tid & 63, wr = wid >> 2, wc = wid & 3, fr = lane & 15, fq = lane >> 4;
    const int K = g.K, nt = K / BK;
    unsigned voffA[2], voffB[2];
#pragma unroll
    for (int i = 0; i < 2; ++i) { int R, C; stage_rc(tid * 16 + i * 8192, R, C); const int Rb = Epi::PERM ? ((R & ~31) + perm32(R & 31)) : R;
        voffA[i] = (unsigned)(R * K + C) * 2u; voffB[i] = (unsigned)(Rb * K + C) * 2u; }
    const size_t kstep = (size_t)(BK * 2);
    const size_t hstep = (size_t)HALF * K * 2;
    const size_t tstep = 2 * hstep;
    const unsigned ldsw = (unsigned)wid * 1024u;
    const int aoff = lds_byte(wr * 64 + fr, fq * 8), boff = lds_byte(wc * 32 + fr, fq * 8);
#define PG8_SA(b, h) (((b) * 2 + (h)) * HTB)
#define PG8_SB(b, h) ((4 + (b) * 2 + (h)) * HTB)
#define PG8_STAGE(bufoff, gbase, voff) do { _Pragma("unroll") for (int _i = 0; _i < 2; ++_i) \
        __builtin_amdgcn_global_load_lds((const unsigned*)((const char*)(gbase) + (voff)[_i]), (PG8_LAS unsigned*)(lds + (bufoff) + ldsw + _i * 8192), 16, 0, 0); } while (0)
#define PG8_LDA(dst, b, h) do { _Pragma("unroll") for (int m = 0; m < 4; ++m) _Pragma("unroll") for (int k = 0; k < 2; ++k) dst[m][k] = *(const PG8_LAS bf16x8*)(lds + PG8_SA(b, h) + aoff + m * 2048 + k * 1024); } while (0)
#define PG8_LDB(dst, b, h) do { _Pragma("unroll") for (int n = 0; n < 2; ++n) _Pragma("unroll") for (int k = 0; k < 2; ++k) dst[n][k] = *(const PG8_LAS bf16x8*)(lds + PG8_SB(b, h) + boff + n * 2048 + k * 1024); } while (0)
#define PG8_MMA(ai, bj, At, Bt) do { __builtin_amdgcn_s_setprio(1); _Pragma("unroll") for (int m = 0; m < 4; ++m) _Pragma("unroll") for (int n = 0; n < 2; ++n) _Pragma("unroll") for (int k = 0; k < 2; ++k) \
        acc[ai][bj][m][n] = __builtin_amdgcn_mfma_f32_16x16x32_bf16(Bt[n][k], At[m][k], acc[ai][bj][m][n], 0, 0, 0); __builtin_amdgcn_s_setprio(0); } while (0)
#define PG8_WAIT_V(n) asm volatile("s_waitcnt vmcnt(" #n ")" ::: "memory")
#define PG8_WAIT_L(n) asm volatile("s_waitcnt lgkmcnt(" #n ")" ::: "memory")
#define PG8_BAR __builtin_amdgcn_s_barrier()
#define PG8_SCHED __builtin_amdgcn_sched_barrier(0)
    Unit cur, nxt; int ui = 0;
    if (!S.next(0, cur)) return;
    f32x4 acc[2][2][4][2];
#pragma unroll
    for (int a = 0; a < 2; ++a)
#pragma unroll
        for (int b = 0; b < 2; ++b)
#pragma unroll
            for (int m = 0; m < 4; ++m)
#pragma unroll
                for (int n = 0; n < 2; ++n) acc[a][b][m][n] = (f32x4){0.f, 0.f, 0.f, 0.f};
    bf16x8 At[4][2], B0[2][2], B1[2][2];
    const char* cA = (const char*)g.A + (size_t)cur.pm * tstep; const char* cB = (const char*)g.Bt + (size_t)cur.pn * tstep;
    S.a_ready(cur);
    if constexpr (SP2) {
        PG8_STAGE(PG8_SB(0, 0), cB, voffB); PG8_STAGE(PG8_SB(0, 1), cB + hstep, voffB); PG8_STAGE(PG8_SA(0, 0), cA, voffA); PG8_STAGE(PG8_SA(0, 1), cA + hstep, voffA);
        if (wr == 1) PG8_BAR;
        PG8_WAIT_V(2); PG8_BAR;
        PG8_STAGE(PG8_SB(1, 0), cB + kstep, voffB); PG8_STAGE(PG8_SA(1, 0), cA + kstep, voffA); PG8_STAGE(PG8_SB(1, 1), cB + hstep + kstep, voffB);
        PG8_WAIT_V(6); PG8_BAR;
    } else {
        PG8_STAGE(PG8_SB(0, 0), cB, voffB); PG8_STAGE(PG8_SA(0, 0), cA, voffA); PG8_STAGE(PG8_SB(0, 1), cB + hstep, voffB); PG8_STAGE(PG8_SA(0, 1), cA + hstep, voffA);
        if (wr == 1) PG8_BAR;
        PG8_WAIT_V(4); PG8_BAR;
        PG8_STAGE(PG8_SB(1, 0), cB + kstep, voffB); PG8_STAGE(PG8_SA(1, 0), cA + kstep, voffA); PG8_STAGE(PG8_SB(1, 1), cB + hstep + kstep, voffB);
        PG8_WAIT_V(6); PG8_BAR;
    }
    for (;;) {
        const bool has_next = S.next(ui + 1, nxt);
        const char* nA = has_next ? (const char*)g.A + (size_t)nxt.pm * tstep : cA; const char* nB = has_next ? (const char*)g.Bt + (size_t)nxt.pn * tstep : cB;
        for (int t = 0; t < nt; t += 2) {
            const bool last = (t == nt - 2);
            const char* a1 = cA + (size_t)(t + 1) * kstep;
            const char* a2 = last ? nA : cA + (size_t)(t + 2) * kstep; const char* b2 = last ? nB : cB + (size_t)(t + 2) * kstep;
            const char* a3 = a2 + kstep; const char* b3 = b2 + kstep;
            if (last && has_next) S.a_ready(nxt);
            if constexpr (SP2) {
            PG8_LDB(B0, 0, 0); PG8_LDB(B1, 0, 1); PG8_SCHED; PG8_LDA(At, 0, 0); PG8_STAGE(PG8_SA(1, 1), a1 + hstep, voffA);
            PG8_WAIT_V(8); PG8_WAIT_L(0); PG8_BAR; PG8_MMA(0, 0, At, B0); PG8_MMA(0, 1, At, B1); PG8_BAR; PG8_SCHED;
            PG8_LDA(At, 0, 1); PG8_STAGE(PG8_SB(0, 0), b2, voffB); PG8_STAGE(PG8_SB(0, 1), b2 + hstep, voffB); PG8_STAGE(PG8_SA(0, 0), a2, voffA);
            PG8_WAIT_V(8); PG8_WAIT_L(0); PG8_BAR; PG8_MMA(1, 0, At, B0); PG8_MMA(1, 1, At, B1); PG8_BAR; PG8_SCHED;
            PG8_LDB(B0, 1, 0); PG8_LDB(B1, 1, 1); PG8_SCHED; PG8_LDA(At, 1, 0); PG8_STAGE(PG8_SA(0, 1), a2 + hstep, voffA);
            PG8_WAIT_V(8); PG8_WAIT_L(0); PG8_BAR; PG8_MMA(0, 0, At, B0); PG8_MMA(0, 1, At, B1); PG8_BAR; PG8_SCHED;
            PG8_LDA(At, 1, 1); PG8_STAGE(PG8_SB(1, 0), b3, voffB); PG8_STAGE(PG8_SB(1, 1), b3 + hstep, voffB); PG8_STAGE(PG8_SA(1, 0), a3, voffA);
            PG8_WAIT_V(8); PG8_WAIT_L(0); PG8_BAR; PG8_MMA(1, 0, At, B0); PG8_MMA(1, 1, At, B1); PG8_BAR; PG8_SCHED;
            } else {
            PG8_LDB(B0, 0, 0); PG8_SCHED; PG8_LDA(At, 0, 0); PG8_STAGE(PG8_SA(1, 1), a1 + hstep, voffA);
            PG8_WAIT_L(8); PG8_BAR; PG8_WAIT_L(0); PG8_MMA(0, 0, At, B0); PG8_BAR; PG8_SCHED;
            PG8_LDB(B1, 0, 1); PG8_STAGE(PG8_SB(0, 0), b2, voffB);
            PG8_BAR; PG8_WAIT_L(0); PG8_MMA(0, 1, At, B1); PG8_BAR;
            PG8_LDA(At, 0, 1); PG8_STAGE(PG8_SA(0, 0), a2, voffA);
            PG8_BAR; PG8_WAIT_L(0); PG8_MMA(1, 0, At, B0); PG8_BAR; PG8_SCHED;
            PG8_STAGE(PG8_SB(0, 1), b2 + hstep, voffB);
            PG8_WAIT_V(6); PG8_BAR; PG8_MMA(1, 1, At, B1); PG8_BAR;
            PG8_LDB(B0, 1, 0); PG8_SCHED; PG8_LDA(At, 1, 0); PG8_STAGE(PG8_SA(0, 1), a2 + hstep, voffA);
            PG8_WAIT_L(8); PG8_BAR; PG8_WAIT_L(0); PG8_MMA(0, 0, At, B0); PG8_BAR; PG8_SCHED;
            PG8_LDB(B1, 1, 1); PG8_STAGE(PG8_SB(1, 0), b3, voffB);
            PG8_BAR; PG8_WAIT_L(0); PG8_MMA(0, 1, At, B1); PG8_BAR;
            PG8_LDA(At, 1, 1); PG8_STAGE(PG8_SA(1, 0), a3, voffA);
            PG8_BAR; PG8_WAIT_L(0); PG8_MMA(1, 0, At, B0); PG8_BAR; PG8_SCHED;
            PG8_STAGE(PG8_SB(1, 1), b3 + hstep, voffB);
            PG8_WAIT_V(6); PG8_BAR; PG8_MMA(1, 1, At, B1); PG8_BAR;
            }
        }
        if constexpr (ALIGN_EPI) { if (wr == 0) PG8_BAR; }
        if constexpr (!Epi::AFTER_DRAIN) { E(acc, cur, wr, wc, fr, fq); S.done(cur); }
        if (!has_next) break;
#pragma unroll
        for (int a = 0; a < 2; ++a)
#pragma unroll
            for (int b = 0; b < 2; ++b)
#pragma unroll
                for (int m = 0; m < 4; ++m)
#pragma unroll
                    for (int n = 0; n < 2; ++n) acc[a][b][m][n] = (f32x4){0.f, 0.f, 0.f, 0.f};
        cur = nxt; cA = nA; cB = nB; ++ui;
        if constexpr (ALIGN_EPI) { if (wr == 1) PG8_BAR; }
    }
    PG8_WAIT_V(0);
    if constexpr (!ALIGN_EPI) { if (wr == 0) PG8_BAR; }
    PG8_BAR;
    if constexpr (Epi::AFTER_DRAIN) { E.fused(acc, cur, wr, wc, fr, fq, lds, wid, lane); S.done(cur); }
#undef PG8_SA
#undef PG8_SB
#undef PG8_STAGE
#undef PG8_LDA
#undef PG8_LDB
#undef PG8_MMA
#undef PG8_WAIT_V
#undef PG8_WAIT_L
#undef PG8_BAR
#undef PG8_SCHED
}

struct EpiStoreT {
    static constexpr bool PERM = true, AFTER_DRAIN = false;
    bf16_t* O0; int ld0; int split; bf16_t* O1; int ld1;
    __device__ __forceinline__ void operator()(const f32x4 (&acc)[2][2][4][2], const Unit& u, int wr, int wc, int fr, int fq) const {
        const int row0 = u.pm * BM + wr * 64 + fr; int colt = u.pn * BM; bf16_t* base = O0; int ld = ld0;
        if (colt >= split) { base = O1; ld = ld1; colt -= split; }
        const int col0 = colt + wc * 32 + 8 * fq;
#pragma unroll
        for (int ai = 0; ai < 2; ++ai)
#pragma unroll
            for (int m = 0; m < 4; ++m) { bf16_t* rowp = base + (size_t)(row0 + ai * HALF + m * 16) * ld + col0;
#pragma unroll
                for (int bj = 0; bj < 2; ++bj) { const f32x4 v0 = acc[ai][bj][m][0], v1 = acc[ai][bj][m][1];
                    u32x4 w; w.x = cvt_pk_bf16(v0[0], v0[1]); w.y = cvt_pk_bf16(v0[2], v0[3]); w.z = cvt_pk_bf16(v1[0], v1[1]); w.w = cvt_pk_bf16(v1[2], v1[3]);
                    *(u32x4*)(rowp + bj * HALF) = w; } }
    }
};
struct EpiResidT {
    static constexpr bool PERM = true, AFTER_DRAIN = false;
    PPtr p; const float* gate;
    __device__ __forceinline__ void operator()(const f32x4 (&acc)[2][2][4][2], const Unit& u, int wr, int wc, int fr, int fq) const {
        float* xb = xrow_ptr(p, u.pm * BM); const float* g = gate + mod_idx(u.pm * BM) * 6144;
        const int col0 = u.pn * BM + wc * 32 + 8 * fq;
#pragma unroll
        for (int ai = 0; ai < 2; ++ai)
#pragma unroll
            for (int m = 0; m < 4; ++m) { float* xr = xb + (size_t)(ai * HALF + wr * 64 + m * 16 + fr) * DM;
#pragma unroll
                for (int bj = 0; bj < 2; ++bj) { const int col = col0 + bj * HALF; const f32x4 v0 = acc[ai][bj][m][0], v1 = acc[ai][bj][m][1];
                    const f32x4 g0 = *(const f32x4*)(g + col), g1 = *(const f32x4*)(g + col + 4);
                    f32x4 x0 = *(const f32x4*)(xr + col), x1 = *(const f32x4*)(xr + col + 4);
                    x0 += g0 * v0; x1 += g1 * v1;
                    *(f32x4*)(xr + col) = x0; *(f32x4*)(xr + col + 4) = x1; } }
    }
};
struct EpiSwigluT {
    static constexpr bool PERM = true, AFTER_DRAIN = false;
    bf16_t* H;
    __device__ __forceinline__ void operator()(const f32x4 (&acc)[2][2][4][2], const Unit& u, int wr, int wc, int fr, int fq) const {
        const int row0 = u.pm * BM + wr * 64 + fr; const int col0 = u.pn * BM + wc * 32 + 8 * fq;
#pragma unroll
        for (int ai = 0; ai < 2; ++ai)
#pragma unroll
            for (int m = 0; m < 4; ++m) { bf16_t* rowp = H + (size_t)(row0 + ai * HALF + m * 16) * FFH;
#pragma unroll
                for (int bj = 0; bj < 2; ++bj) { const f32x4 gt = acc[ai][bj][m][0], up = acc[ai][bj][m][1];
                    float h[4];
#pragma unroll
                    for (int j = 0; j < 4; ++j) h[j] = gt[j] * sigmoidf_(gt[j]) * up[j];
                    uint2 w; w.x = cvt_pk_bf16(h[0], h[1]); w.y = cvt_pk_bf16(h[2], h[3]);
                    *(uint2*)(rowp + ((col0 + bj * HALF) >> 1)) = w; } }
    }
};

struct EpiLoraT {
    static constexpr bool PERM = true, AFTER_DRAIN = false;
    float* DEC; bf16_t* KD; bf16_t* BQ; bf16_t* G; const bf16_t* KK; const bf16_t* ZDb;
    const float* w0; const float* a0; const float* ka; const float* muk;
    template <int TYPE>
    __device__ __forceinline__ void one(const f32x4 v, int r, int c, int d) const {
        if (TYPE == 0) {
            const float4 wa = *(const float4*)(w0 + d * 512 + c);
            const float ww[4] = {wa.x, wa.y, wa.z, wa.w};
            float o[4];
#pragma unroll
            for (int e = 0; e < 4; ++e) { const float x = -(ww[e] + v[e]); const float sp = x > 20.f ? x : log1pf(expf(x)); o[e] = expf(-expf(-sp - 0.5f)); }
            *(float4*)(DEC + ((size_t)r * 2 + d) * 512 + c) = (float4){o[0], o[1], o[2], o[3]};
        } else if (TYPE == 1) {
            const float4 aa = *(const float4*)(a0 + d * 512 + c), ka0 = *(const float4*)(ka + c), m0 = *(const float4*)(muk + c);
            const float a0v[4] = {aa.x, aa.y, aa.z, aa.w}, kav[4] = {ka0.x, ka0.y, ka0.z, ka0.w}, mm[4] = {m0.x, m0.y, m0.z, m0.w};
            const bool lat = r < SEQ; const int lo = lat ? 0 : SEQ, hi = lat ? SEQ : RPB;
            const bf16_t* zc = ZDb + (size_t)r * ZDW + 512 + c;
            const bool hp = r - 1 >= lo, hn = r + 1 < hi;
            const uint2 uz = *(const uint2*)zc, up = *(const uint2*)(hp ? zc - ZDW : zc), un = *(const uint2*)(hn ? zc + ZDW : zc), uk = *(const uint2*)(KK + (size_t)r * 512 + c);
            const float z[4] = {bflo(uz.x), bfhi(uz.x), bflo(uz.y), bfhi(uz.y)}, zp[4] = {bflo(up.x), bfhi(up.x), bflo(up.y), bfhi(up.y)};
            const float zn[4] = {bflo(un.x), bfhi(un.x), bflo(un.y), bfhi(un.y)}, kk[4] = {bflo(uk.x), bfhi(uk.x), bflo(uk.y), bfhi(uk.y)};
            const float fp = hp ? 0.5f : 0.f, fn = hn ? 0.5f : 0.f;
            float okd[4], obq[4];
#pragma unroll
            for (int e = 0; e < 4; ++e) {
                const float a = sigmoidf_(a0v[e] + v[e]);
                const float k = z[e] + ((fp * zp[e] + fn * zn[e]) - z[e]) * mm[e];
                okd[e] = k * (1.f + (a - 1.f) * kav[e]); obq[e] = kk[e] * a;
            }
            uint2 w1; w1.x = pk2(okd[0], okd[1]); w1.y = pk2(okd[2], okd[3]); *(uint2*)(KD + ((size_t)r * 2 + d) * 512 + c) = w1;
            uint2 w2; w2.x = pk2(obq[0], obq[1]); w2.y = pk2(obq[2], obq[3]); *(uint2*)(BQ + ((size_t)r * 2 + d) * 512 + c) = w2;
        } else {
            uint2 w; w.x = pk2(v[0], v[1]); w.y = pk2(v[2], v[3]); *(uint2*)(G + (size_t)r * 512 + c) = w;
        }
    }
    template <int TYPE>
    __device__ __forceinline__ void all(const f32x4 (&acc)[2][2][4][2], const Unit& u, int wr, int wc, int fr, int fq) const {
        const int d = (u.pn >> 1) & 1, cb = (u.pn & 1) * 256 + wc * 32 + 8 * fq;
#pragma unroll
        for (int ai = 0; ai < 2; ++ai)
#pragma unroll
            for (int m = 0; m < 4; ++m)
#pragma unroll
                for (int bj = 0; bj < 2; ++bj)
                {   const int r = u.pm * BM + ai * HALF + wr * 64 + m * 16 + fr, c = cb + bj * HALF;
                    one<TYPE>(acc[ai][bj][m][0], r, c, d); one<TYPE>(acc[ai][bj][m][1], r, c + 4, d); }
    }
    __device__ __forceinline__ void operator()(const f32x4 (&acc)[2][2][4][2], const Unit& u, int wr, int wc, int fr, int fq) const {
        const int type = u.pn >> 1;
        if (type < 2) all<0>(acc, u, wr, wc, fr, fq); else if (type < 4) all<1>(acc, u, wr, wc, fr, fq); else all<2>(acc, u, wr, wc, fr, fq);
    }
};
}

DEV void transpose_item(const float* W, int K, int N, u16* WT, int mode, float* scr, int item, int lane) {
    const int nblk = N / 32, kb = item / nblk, nb = item - kb * nblk, k0 = 64 * kb, n0 = 32 * nb;
#pragma unroll 8
    for (int i = 0; i < 32; ++i) { const int kk = 2 * i + (lane >> 5); scr[kk * 33 + (lane & 31)] = W[(size_t)(k0 + kk) * N + n0 + (lane & 31)]; }
    asm volatile("s_waitcnt lgkmcnt(0)" ::: "memory");
    const int c = lane & 7;
#pragma unroll
    for (int j = 0; j < 4; ++j) {
        const int n = (lane >> 3) + 8 * j; const float* sp = scr + (8 * c) * 33 + n;
        uint4 o; o.x = pk2(sp[0 * 33], sp[1 * 33]); o.y = pk2(sp[2 * 33], sp[3 * 33]); o.z = pk2(sp[4 * 33], sp[5 * 33]); o.w = pk2(sp[6 * 33], sp[7 * 33]);
        const int ns = n0 + n;
        int drow = ns;
        if (mode) { const int nn = ns >= FFH ? 1 : 0; const int g = ns - nn * FFH; drow = 8 * (g >> 2) + 4 * nn + (g & 3); }
        *(uint4*)(WT + (size_t)drow * K + k0 + 8 * c) = o;
    }
    asm volatile("s_waitcnt lgkmcnt(0)" ::: "memory");
}
constexpr size_t WB_IN = 0, WB_OUT = (size_t)3328 * 1024, WB_F1 = WB_OUT + (size_t)1024 * 1024, WB_F2 = WB_F1 + (size_t)5632 * 1024;
DEV void phase_wprep(PPtr p, int layer, char* lds) {
    const int tid = tidx(), lane = tid & 63, wave = tid >> 6, gw = blockIdx.x * NWAVE + wave, ngw = gridDim.x * NWAVE;
    float* scr = (float*)lds + wave * (64 * 33);
    u16* WB = (u16*)(p->ws + OFF_WB);
    const int li = layer >> 1, odd = layer & 1;
    const int nin = odd ? 3328 : 1536;
    const float* win = odd ? p->in[13] + (size_t)li * DM * 3328 : p->in[8] + (size_t)li * DM * 1536;
    const float* wout = (odd ? p->in[14] : p->in[9]) + (size_t)li * DM * DM;
    const float* wf1 = p->in[27] + (size_t)layer * DM * 5632; const float* wf2 = p->in[28] + (size_t)layer * FFH * DM;
    const int i0 = 16 * (nin / 32), i1 = i0 + 16 * 32, i2 = i1 + 16 * 176, i3 = i2 + 44 * 32;
    for (int it = gw; it < i3; it += ngw) {
        if (it < i0) transpose_item(win, DM, nin, WB + WB_IN, 0, scr, it, lane);
        else if (it < i1) transpose_item(wout, DM, DM, WB + WB_OUT, 0, scr, it - i0, lane);
        else if (it < i2) transpose_item(wf1, DM, 5632, WB + WB_F1, 1, scr, it - i1, lane);
        else transpose_item(wf2, FFH, DM, WB + WB_F2, 0, scr, it - i2, lane);
    }
}

#include <hip/hip_bf16.h>
#include <cmath>
namespace attn_body {
using bf16=__hip_bfloat16;
using bf16x8=__attribute__((ext_vector_type(8)))short;
using s16x4=__attribute__((ext_vector_type(4)))short;
using f32x16=__attribute__((ext_vector_type(16)))float;
using u32x4=__attribute__((ext_vector_type(4)))unsigned;
constexpr int D=64,PQ=1536,PO=1024,KROWS=16640,RPBA=16640;
constexpr int NW=8,QBLK=32,QB=QBLK*NW,KVBLK=64;
constexpr int ATTN_UNIT_ROWS=QB;
__device__ __forceinline__ int crow(int r,int hi){return (r&3)+8*(r>>2)+4*hi;}
#define SBAR() __builtin_amdgcn_sched_barrier(0)
__device__ __forceinline__ void cmask(f32x16&p0,f32x16&p1,int jb,int qrel,int hi){
  const float NEG=-INFINITY; int kb=64*jb+4*hi;
  #pragma unroll
  for(int r=0;r<16;++r){int kv=kb+(r&3)+8*(r>>2); if(kv>qrel)p0[r]=NEG; if(kv+32>qrel)p1[r]=NEG;}
}

constexpr int NSLOT=3, SLOTB=8192;
constexpr int LDS_K=0, LDS_V=NSLOT*SLOTB, LDS_WS=2*NSLOT*SLOTB, LDS_OST=LDS_WS+NW*64*4, LDS_BYTES=LDS_OST+NW*4096;
constexpr float C2=0.125f*1.4426950408889634f;
__device__ __forceinline__ void glds16(const void*gsrc,unsigned lds_dst){unsigned keep;
  asm volatile("s_mov_b32 %0, m0\n\ts_mov_b32 m0, %2\n\ts_nop 0\n\tglobal_load_lds_dwordx4 %1, off\n\ts_mov_b32 m0, %0":"=&s"(keep):"v"(gsrc),"s"(lds_dst):"memory");}
__device__ __forceinline__ float max3f(float a,float b,float c){float r;asm("v_max3_f32 %0, %1, %2, %3":"=v"(r):"v"(a),"v"(b),"v"(c));return r;}
__device__ __forceinline__ float max2f(float a,float b){float r;asm("v_max_f32_e32 %0, %1, %2":"=v"(r):"v"(a),"v"(b));return r;}
__device__ __forceinline__ float fadd_s(float a,float b){float r;asm("v_add_f32_e32 %0, %1, %2":"=v"(r):"v"(a),"v"(b));return r;}
__device__ __forceinline__ float fsub_s(float a,float b){float r;asm("v_sub_f32_e32 %0, %1, %2":"=v"(r):"v"(a),"v"(b));return r;}
typedef float f32x2_t __attribute__((ext_vector_type(2))); typedef __bf16 bf16x2_t __attribute__((ext_vector_type(2)));
__device__ __forceinline__ unsigned cvtpk_s(float lo,float hi){f32x2_t v={lo,hi};bf16x2_t b=__builtin_convertvector(v,bf16x2_t);return __builtin_bit_cast(unsigned,b);}
#define WAIT_BAR(N) asm volatile("s_waitcnt vmcnt(" #N ") lgkmcnt(0)\n\ts_barrier":::"memory")

__device__ __forceinline__ void qkt(f32x16&p0,f32x16&p1,const char*Kslot,const bf16x8*qr,const f32x16&negm,int r32,int hi){
  const char*kb=Kslot+hi*1024+r32*16;
  #pragma unroll
  for(int d0=0;d0<4;++d0){
    const bf16x8 b0=*reinterpret_cast<const bf16x8*>(kb+d0*2048);
    const bf16x8 b1=*reinterpret_cast<const bf16x8*>(kb+d0*2048+512);
    if(d0==0){p0=__builtin_amdgcn_mfma_f32_32x32x16_bf16(b0,qr[0],negm,0,0,0);p1=__builtin_amdgcn_mfma_f32_32x32x16_bf16(b1,qr[0],negm,0,0,0);}
    else{p0=__builtin_amdgcn_mfma_f32_32x32x16_bf16(b0,qr[d0],p0,0,0,0);p1=__builtin_amdgcn_mfma_f32_32x32x16_bf16(b1,qr[d0],p1,0,0,0);}}
}
typedef __attribute__((address_space(3))) const char* lds_cptr;
typedef short v4i16_t __attribute__((ext_vector_type(4)));
__device__ __forceinline__ void kload8(bf16x8*kf,lds_cptr kp){
  kf[0]=*(const __attribute__((address_space(3))) bf16x8*)(kp);      kf[1]=*(const __attribute__((address_space(3))) bf16x8*)(kp+512);
  kf[2]=*(const __attribute__((address_space(3))) bf16x8*)(kp+2048); kf[3]=*(const __attribute__((address_space(3))) bf16x8*)(kp+2560);
  kf[4]=*(const __attribute__((address_space(3))) bf16x8*)(kp+4096); kf[5]=*(const __attribute__((address_space(3))) bf16x8*)(kp+4608);
  kf[6]=*(const __attribute__((address_space(3))) bf16x8*)(kp+6144); kf[7]=*(const __attribute__((address_space(3))) bf16x8*)(kp+6656);
}
__device__ __forceinline__ void kload2(bf16x8*kf,lds_cptr kp,int j){ kf[2*j]=*(const __attribute__((address_space(3))) bf16x8*)(kp+j*2048); kf[2*j+1]=*(const __attribute__((address_space(3))) bf16x8*)(kp+j*2048+512); }
__device__ __forceinline__ s16x4 vtr(lds_cptr p){ return __builtin_bit_cast(s16x4,__builtin_amdgcn_ds_read_tr16_b64_v4i16((__attribute__((address_space(3))) v4i16_t*)p)); }
__device__ __forceinline__ float rowmax(const f32x16&p0,const f32x16&p1){
  float a=max3f(p0[0],p0[1],p1[0]),b=max3f(p0[2],p0[3],p1[1]);a=max3f(a,p1[2],p1[3]);
  #pragma unroll
  for(int r=4;r<16;r+=4){a=max3f(a,p0[r],p0[r+1]);b=max3f(b,p0[r+2],p0[r+3]);a=max3f(a,p1[r],p1[r+1]);b=max3f(b,p1[r+2],p1[r+3]);}
  const float m=max2f(a,b);
  auto rr=__builtin_amdgcn_permlane32_swap(__float_as_uint(m),__float_as_uint(m),false,false);
  return max2f(__uint_as_float(rr[0]),__uint_as_float(rr[1]));
}
__device__ __forceinline__ void pv(f32x16*o,int vb,bf16x8 pa0,bf16x8 pa1,bf16x8 pa2,bf16x8 pa3){
  #pragma unroll
  for(int d0=0;d0<2;++d0){s16x4 lo[4],hi[4];
    #pragma unroll
    for(int ks=0;ks<4;++ks){
      asm volatile("ds_read_b64_tr_b16 %0,%1 offset:%c2":"=&v"(lo[ks]):"v"(vb),"i"(d0*4096+ks*1024):"memory");
      asm volatile("ds_read_b64_tr_b16 %0,%1 offset:%c2":"=&v"(hi[ks]):"v"(vb),"i"(d0*4096+ks*1024+512):"memory");}
    asm volatile("s_waitcnt lgkmcnt(0)":::"memory");SBAR();
    #define PK(k) (bf16x8){lo[k][0],lo[k][1],lo[k][2],lo[k][3],hi[k][0],hi[k][1],hi[k][2],hi[k][3]}
    o[d0]=__builtin_amdgcn_mfma_f32_32x32x16_bf16(pa0,PK(0),o[d0],0,0,0);
    o[d0]=__builtin_amdgcn_mfma_f32_32x32x16_bf16(pa1,PK(1),o[d0],0,0,0);
    o[d0]=__builtin_amdgcn_mfma_f32_32x32x16_bf16(pa2,PK(2),o[d0],0,0,0);
    o[d0]=__builtin_amdgcn_mfma_f32_32x32x16_bf16(pa3,PK(3),o[d0],0,0,0);
    #undef PK
  }
}

#ifndef ATTN_STORE16
#define ATTN_STORE16(p,v) (*(u32x4*)(p)=(v))
#endif
template<int THRL> __device__ __forceinline__ void attn_unit(int b,int h,int qb,const bf16*Q,const bf16*__restrict__ K,const bf16*__restrict__ V,bf16*O,char*shm){
  const int tid=tidx(),lane=tid&63,r32=lane&31,hi=lane>>5; const int wid=__builtin_amdgcn_readfirstlane(tid>>6);
  const long rowbase=(long)b*RPBA; const int q0=qb*QB;
  const bf16*Qw=Q+(rowbase+q0+wid*QBLK)*PQ+h*D;
  const bf16*Kh=K+rowbase*PQ+(h>>2)*D,*Vh=V+rowbase*PQ+(h>>2)*D;
  const unsigned lds0=(unsigned)(uintptr_t)shm;
  float*wsf=(float*)(shm+LDS_WS)+wid*64;
  const bf16*ksrc=Kh+(long)lane*PQ+wid*8;
  const bf16*vsrc=Vh+(long)(16*(wid&3)+(lane>>2))*PQ+(wid>>2)*32+(lane&3)*8;
  const unsigned kdst=lds0+LDS_K+wid*1024, vdst=lds0+LDS_V+wid*1024;
  #define DMA_K(t,slot) glds16(ksrc+(long)(t)*KVBLK*PQ,(unsigned)__builtin_amdgcn_readfirstlane(kdst+(slot)))
  #define DMA_V(t,slot) glds16(vsrc+(long)(t)*KVBLK*PQ,(unsigned)__builtin_amdgcn_readfirstlane(vdst+(slot)))
  const int vb0=(int)(lds0+LDS_V)+((lane>>4)&1)*32+(lane&3)*8+(4*hi+((lane&15)>>2))*64;
  const char*Kbase=shm+LDS_K; bf16x8 kf[8];
  const lds_cptr shm3=(lds_cptr)shm; const lds_cptr kp0=shm3+LDS_K+hi*1024+r32*16; const lds_cptr vp0=shm3+LDS_V+((lane>>4)&1)*32+(lane&3)*8+(4*hi+((lane&15)>>2))*64;
  const int NT=KROWS/KVBLK;
  DMA_K(0,0);DMA_V(0,0);DMA_K(1,SLOTB);
  bf16x8 qr[4];
  #pragma unroll
  for(int d0=0;d0<4;++d0)qr[d0]=*reinterpret_cast<const bf16x8*>(&Qw[(long)r32*PQ+d0*16+hi*8]);
  float mhat=0.f,l_reg=0.f;f32x16 o[2];o[0]=f32x16{};o[1]=f32x16{};f32x16 negm=f32x16{};asm volatile("":"+v"(negm));
  const int qrel=wid*QBLK+r32;
  #define CMASK(P0,P1,t) do{}while(0)
  bool resc=false;
  #define START(P0,P1) do{ const float rm=rowmax(P0,P1); resc=false; \
    { const float dl=rm; mhat=fadd_s(mhat,dl); \
      _Pragma("unroll") for(int r=0;r<16;++r){P0[r]=fsub_s(P0[r],dl);P1[r]=fsub_s(P1[r],dl);} \
      _Pragma("unroll") for(int r=0;r<16;++r)negm[r]=-mhat; asm volatile("":"+v"(negm)); } \
    _Pragma("unroll") for(int r=0;r<16;++r)P0[r]=__builtin_amdgcn_exp2f(P0[r]); }while(0)
  #define RESC() do{ if(resc){ asm volatile("s_waitcnt lgkmcnt(0)":::"memory"); \
      _Pragma("unroll") for(int d_=0;d_<2;++d_) _Pragma("unroll") for(int r=0;r<16;++r)o[d_][r]*=wsf[crow(r,hi)]; } }while(0)
  f32x16 pA0,pA1,pB0,pB1;
  int sl_prev=0,sl_cur=0,sl_next=SLOTB;
  #define ROT() do{sl_prev=sl_cur;sl_cur=sl_next;sl_next=(sl_next==(NSLOT-1)*SLOTB)?0:sl_next+SLOTB;}while(0)
  DMA_K(2,2*SLOTB);
  WAIT_BAR(3);
  qkt(pA0,pA1,Kbase,qr,negm,r32,hi);asm volatile("s_nop 15\n\ts_nop 7":"+v"(pA0),"+v"(pA1));CMASK(pA0,pA1,0);
  START(pA0,pA1);
  _Pragma("unroll") for(int r=0;r<16;++r)pA1[r]=__builtin_amdgcn_exp2f(pA1[r]);
  WAIT_BAR(0);
  DMA_K(3,0);DMA_V(1,SLOTB);
  ROT();
  kload8(kf,kp0+sl_cur);
  WAIT_BAR(2);
  s16x4 vlo[8],vhi[8]; u32x4 pw0,pw1,pw2,pw3;
  #define PKW(P,B) cvtpk_s(P[B],P[B+1])
  #define PAF(k) __builtin_bit_cast(bf16x8,pw##k)
  #define VFR(i) (bf16x8){vlo[i][0],vlo[i][1],vlo[i][2],vlo[i][3],vhi[i][0],vhi[i][1],vhi[i][2],vhi[i][3]}
  #define PIN(x) asm volatile("":"+v"(x))
  #define MX3(a,b,c) __builtin_fmaxf(__builtin_fmaxf((a),(b)),(c))
  #define GAPA(MF,A0,A1,A2,A3,W0,W1,PW) do{ MF; sacc+=A0; sacc+=A1; sacc+=A2; sacc+=A3; PIN(sacc); W0; W1; PIN(PW); SBAR(); }while(0)
  #define EX(v) __builtin_amdgcn_exp2f(v)
  #define GAPB(MF,X,B) do{ MF; X[B]=EX(X[B]); X[B+1]=EX(X[B+1]); X[B+2]=EX(X[B+2]); X[B+3]=EX(X[B+3]); PIN(X); SBAR(); }while(0)
  #define VRD(i) do{ vlo[i]=vtr(vp_+(((i)>>2)*4096+((i)&3)*1024)); vhi[i]=vtr(vp_+(((i)>>2)*4096+((i)&3)*1024+512)); }while(0)
  #define KRD(G,j) do{ if(G){ kload2(kf,kp0+sl_next,j); SBAR(); } }while(0)
  #define STEP(C0,C1,P0,P1,t,GK,GV,GL) do{ SBAR(); \
    const lds_cptr vp_=vp0+sl_prev; \
    VRD(0); SBAR(); float sacc=(P0[0]+P0[1]); \
    GAPA(C0=__builtin_amdgcn_mfma_f32_32x32x16_bf16(kf[0],qr[0],negm,0,0,0), P0[2],P0[3],P0[4],P0[5],     pw0[0]=PKW(P0,0), pw0[1]=PKW(P0,2), pw0); \
    VRD(4); SBAR(); GAPA(C1=__builtin_amdgcn_mfma_f32_32x32x16_bf16(kf[1],qr[0],negm,0,0,0), P0[6],P0[7],P0[8],P0[9],     pw0[2]=PKW(P0,4), pw0[3]=PKW(P0,6), pw0); \
    VRD(1); SBAR(); GAPA(C0=__builtin_amdgcn_mfma_f32_32x32x16_bf16(kf[2],qr[1],C0,0,0,0),   P0[10],P0[11],P0[12],P0[13], pw1[0]=PKW(P0,8), pw1[1]=PKW(P0,10), pw1); \
    VRD(5); SBAR(); GAPA(C1=__builtin_amdgcn_mfma_f32_32x32x16_bf16(kf[3],qr[1],C1,0,0,0),   P0[14],P0[15],P1[0],P1[1],   pw1[2]=PKW(P0,12),pw1[3]=PKW(P0,14), pw1); \
    VRD(2); SBAR(); GAPA(C0=__builtin_amdgcn_mfma_f32_32x32x16_bf16(kf[4],qr[2],C0,0,0,0),   P1[2],P1[3],P1[4],P1[5],     pw2[0]=PKW(P1,0), pw2[1]=PKW(P1,2), pw2); \
    VRD(6); SBAR(); GAPA(C1=__builtin_amdgcn_mfma_f32_32x32x16_bf16(kf[5],qr[2],C1,0,0,0),   P1[6],P1[7],P1[8],P1[9],     pw2[2]=PKW(P1,4), pw2[3]=PKW(P1,6), pw2); \
    VRD(3); SBAR(); GAPA(C0=__builtin_amdgcn_mfma_f32_32x32x16_bf16(kf[6],qr[3],C0,0,0,0),   P1[10],P1[11],P1[12],P1[13], pw3[0]=PKW(P1,8), pw3[1]=PKW(P1,10), pw3); \
    VRD(7); SBAR(); GAPA(C1=__builtin_amdgcn_mfma_f32_32x32x16_bf16(kf[7],qr[3],C1,0,0,0),   P1[14],P1[15],0.f,0.f,       pw3[2]=PKW(P1,12),pw3[3]=PKW(P1,14), pw3); \
    l_reg+=sacc; \
    if(GK){DMA_K((t)+3,sl_cur);} if(GV){DMA_V((t)+1,sl_next);} \
    CMASK(C0,C1,t); \
    { float a=MX3(C0[0],C0[1],C1[0]),b=MX3(C0[2],C0[3],C1[1]); a=MX3(a,C1[2],C1[3]); \
      _Pragma("unroll") for(int r=4;r<16;r+=4){a=MX3(a,C0[r],C0[r+1]);b=MX3(b,C0[r+2],C0[r+3]);a=MX3(a,C1[r],C1[r+1]);b=MX3(b,C1[r+2],C1[r+3]);} \
      float rm=__builtin_fmaxf(a,b); { auto rr=__builtin_amdgcn_permlane32_swap(__float_as_uint(rm),__float_as_uint(rm),false,false); rm=__builtin_fmaxf(__uint_as_float(rr[0]),__uint_as_float(rr[1])); } \
      resc=false; \
      if(__builtin_expect(__any(rm>(float)THRL),0)){ const float dl=__builtin_fmaxf(rm,0.f); mhat+=dl; \
        _Pragma("unroll") for(int r=0;r<16;++r){C0[r]-=dl;C1[r]-=dl;} \
        _Pragma("unroll") for(int r=0;r<16;++r)negm[r]=-mhat; asm volatile("":"+v"(negm)); \
        const float f=__builtin_amdgcn_exp2f(-dl); l_reg*=f; if(hi==0)wsf[r32]=f; resc=true; } } \
    SBAR(); \
    GAPB(o[0]=__builtin_amdgcn_mfma_f32_32x32x16_bf16(PAF(0),VFR(0),o[0],0,0,0), C0,0); \
    GAPB(o[1]=__builtin_amdgcn_mfma_f32_32x32x16_bf16(PAF(0),VFR(4),o[1],0,0,0), C0,4); \
    KRD(GL,0); GAPB(o[0]=__builtin_amdgcn_mfma_f32_32x32x16_bf16(PAF(1),VFR(1),o[0],0,0,0), C0,8); \
    KRD(GL,1); GAPB(o[1]=__builtin_amdgcn_mfma_f32_32x32x16_bf16(PAF(1),VFR(5),o[1],0,0,0), C0,12); \
    KRD(GL,2); GAPB(o[0]=__builtin_amdgcn_mfma_f32_32x32x16_bf16(PAF(2),VFR(2),o[0],0,0,0), C1,0); \
    KRD(GL,3); GAPB(o[1]=__builtin_amdgcn_mfma_f32_32x32x16_bf16(PAF(2),VFR(6),o[1],0,0,0), C1,4); \
    GAPB(o[0]=__builtin_amdgcn_mfma_f32_32x32x16_bf16(PAF(3),VFR(3),o[0],0,0,0), C1,8); \
    GAPB(o[1]=__builtin_amdgcn_mfma_f32_32x32x16_bf16(PAF(3),VFR(7),o[1],0,0,0), C1,12); \
    }while(0)
  int t=1;
  #undef CMASK
  #define CMASK(P0,P1,t) do{}while(0)
  for(;t+5<NT;t+=2){
    STEP(pB0,pB1,pA0,pA1,t,true,true,true);     WAIT_BAR(2); RESC(); ROT();
    STEP(pA0,pA1,pB0,pB1,t+1,true,true,true);   WAIT_BAR(2); RESC(); ROT();
  }
  #undef CMASK
  #define CMASK(P0,P1,t) do{}while(0)
  #define ENDW(tt) do{ if((tt)+3<NT){WAIT_BAR(2);} else if((tt)+2<NT){WAIT_BAR(1);} else {WAIT_BAR(0);} }while(0)
  for(;t+1<NT;t+=2){
    STEP(pB0,pB1,pA0,pA1,t,(t+3<NT),(t+1<NT),(t+1<NT));       ENDW(t);   RESC(); ROT();
    STEP(pA0,pA1,pB0,pB1,t+1,(t+4<NT),(t+2<NT),(t+2<NT));     ENDW(t+1); RESC(); ROT();
  }
  STEP(pB0,pB1,pA0,pA1,NT-1,false,false,false); RESC();
  { float sacc=pB0[0]+pB0[1]; _Pragma("unroll") for(int r=2;r<16;++r)sacc+=pB0[r]; _Pragma("unroll") for(int r=0;r<16;++r)sacc+=pB1[r]; l_reg+=sacc;
    pw0=(u32x4){PKW(pB0,0),PKW(pB0,2),PKW(pB0,4),PKW(pB0,6)};pw1=(u32x4){PKW(pB0,8),PKW(pB0,10),PKW(pB0,12),PKW(pB0,14)};pw2=(u32x4){PKW(pB1,0),PKW(pB1,2),PKW(pB1,4),PKW(pB1,6)};pw3=(u32x4){PKW(pB1,8),PKW(pB1,10),PKW(pB1,12),PKW(pB1,14)};
    SBAR(); pv(o,vb0+sl_cur,PAF(0),PAF(1),PAF(2),PAF(3)); }
  #undef PKW
  #undef PAF
  #undef VFR
  #undef PIN
  #undef MX3
  #undef GAPA
  #undef GAPB
  #undef EX
  #undef VRD
  #undef KRD
  #undef STEP
  #undef ENDW
  {auto rr=__builtin_amdgcn_permlane32_swap(__float_as_uint(l_reg),__float_as_uint(l_reg),false,false);l_reg=__uint_as_float(rr[0])+__uint_as_float(rr[1]);}
  if(hi==0)wsf[32+r32]=l_reg;asm volatile("s_waitcnt lgkmcnt(0)":::"memory");
  float rli[16];
  #pragma unroll
  for(int r=0;r<16;++r)rli[r]=__builtin_amdgcn_rcpf(wsf[32+crow(r,hi)]);
  bf16*Ow=O+(rowbase+q0+wid*QBLK)*PO+h*D;
  { bf16*stg=(bf16*)(shm+LDS_OST)+wid*2048;
    #pragma unroll
    for(int r=0;r<16;++r){const int orow=crow(r,hi);
      #pragma unroll
      for(int d0=0;d0<2;++d0)stg[orow*64+d0*32+r32]=__float2bfloat16(o[d0][r]*rli[r]);}
    asm volatile("s_waitcnt lgkmcnt(0)":::"memory");
    #pragma unroll
    for(int i=0;i<4;++i){const int row=i*8+(lane>>3),ch=lane&7; const u32x4 v=*(const u32x4*)(stg+row*64+ch*8); ATTN_STORE16(Ow+(long)row*PO+ch*8,v);} }
  asm volatile("s_waitcnt lgkmcnt(0)\n\ts_barrier":::"memory");
  #undef DMA_K
  #undef DMA_V
  #undef CMASK
  #undef START
  #undef RESC
  #undef ROT
}
constexpr int ATTN_LDS_BYTES=LDS_BYTES;
#undef SBAR
#undef WAIT_BAR
}

DEV void phase_even_post(PPtr p, int li) {
    const int lane = tidx() & 63, gw = blockIdx.x * NWAVE + (tidx() >> 6), ngw = gridDim.x * NWAVE;
    u16* RAW = (u16*)(p->ws + OFF_RAW);
    const float* qg = p->in[10] + li * 64; const float* kg = p->in[11] + li * 64;
    const int half = lane >> 5, i = lane & 31;
    const float inv = powf(10000.f, -(float)(i & 15) / 16.f);
    for (int m = gw; m < MROWS; m += ngw) {
        const int b = m / RPB, q = m - b * RPB;
        float cs = 1.f, sn = 0.f;
        if (q < SEQ) { const float pos = (i < 16) ? (float)(q >> 6) : (float)(q & 63); const float ang = pos * inv; sn = sinf(ang); cs = cosf(ang); }
        u16* row = RAW + (size_t)m * 1536;
        for (int hs = 0; hs < 20; hs += 2) {
            const int s = hs + half; int c0; const float* gn = nullptr;
            if (s < 8) { c0 = s * 64; gn = qg; } else if (s < 10) { c0 = 512 + (s - 8) * 64; gn = kg; } else if (s < 18) { c0 = 768 + (s - 10) * 64; } else { c0 = 1280 + (s - 18) * 64; }
            float v1 = bf2f(row[c0 + i]), v2 = bf2f(row[c0 + i + 32]);
            if (hs < 10) {
                float ss = v1 * v1 + v2 * v2;
#pragma unroll
                for (int o = 1; o < 32; o <<= 1) ss += __shfl_xor(ss, o);
                const float rs = rsqrtf(ss * (1.f / 64.f) + 1e-6f);
                v1 *= rs * gn[i]; v2 *= rs * gn[i + 32];
            }
            float o1 = v1 * cs - v2 * sn, o2 = v1 * sn + v2 * cs;
            if (hs < 8 && q < SEQ) { o1 *= attn_body::C2; o2 *= attn_body::C2; }
            row[c0 + i] = (u16)f2bf(o1); row[c0 + i + 32] = (u16)f2bf(o2);
        }
    }
}

template <int mode, bool qctx>
DEV void attn_wave(const u16* QB, int pitch, int qcol, int kcol, int vcol, u16* AO, int ocol,
                   int b, int hk, int blk, const float* sinkp, const float* rpb, u16* sV) {
    const int lane = tidx() & 63, qi = lane & 15, quad = lane >> 4;
    const bool gqa = mode < 2;
    const size_t rowb = (size_t)b * RPB;
    const float SCL = 0.125f * LOG2E;
    int qtok[4], qhead[4]; bf16x8 qf[4][2];
#pragma unroll
    for (int i = 0; i < 4; ++i) {
        qtok[i] = gqa ? blk * 16 + qi : blk * 64 + i * 16 + qi; qhead[i] = gqa ? hk * 4 + i : hk;
        const size_t m = rowb + (qctx ? SEQ : 0) + qtok[i];
        const u16* qp = QB + m * pitch + qcol + qhead[i] * 64 + quad * 8;
        qf[i][0] = *(const bf16x8*)qp; qf[i][1] = *(const bf16x8*)(qp + 32);
    }
    f32x4 o[4][4]; float mrun[4], lrun[4];
#pragma unroll
    for (int i = 0; i < 4; ++i) {
#pragma unroll
        for (int d = 0; d < 4; ++d) o[i][d] = (f32x4){0.f, 0.f, 0.f, 0.f};
        if (mode == 1) { mrun[i] = sinkp[qhead[i]] * LOG2E; lrun[i] = (quad == 0) ? 1.f : 0.f; } else { mrun[i] = -1e30f; lrun[i] = 0.f; }
    }
    const u16* Kb = QB + kcol + hk * 64; const u16* Vb = QB + vcol + hk * 64;
    int n_local, ustart, rs = 0;
    if (qctx) { n_local = 0; ustart = 0; }
    else if (mode == 0) { n_local = RPB / 32; ustart = 0; }
    else if (mode == 1) { n_local = 9; ustart = blk * 16 - 128; }
    else { rs = min(max(blk - 4, 0), 248); n_local = 16; ustart = rs * 64; }
    const int n_ctx = (mode == 0 && !qctx) ? 0 : 8;
    for (int tt = 0; tt < n_local + n_ctx; ++tt) {
        const bool loc = tt < n_local;
        const int u0 = loc ? ustart + 32 * tt : SEQ + 32 * (tt - n_local);
        const bool masked = loc && mode != 0;
        bf16x8 kf[2][2];
#pragma unroll
        for (int kt = 0; kt < 2; ++kt) {
            const int u = min(max(u0 + kt * 16 + qi, 0), RPB - 1);
            const u16* kp = Kb + (rowb + u) * pitch + quad * 8;
            kf[kt][0] = *(const bf16x8*)kp; kf[kt][1] = *(const bf16x8*)(kp + 32);
        }
#pragma unroll
        for (int c = 0; c < 4; ++c) {
            const int idx = c * 64 + lane, key = idx >> 3, dc = idx & 7;
            const int u = min(max(u0 + key, 0), RPB - 1);
            const uint4 v = *(const uint4*)(Vb + (rowb + u) * pitch + dc * 8);
            *(uint4*)(sV + key * 72 + dc * 8) = v;
        }
        bf16x8 vf[4];
#pragma unroll
        for (int dt = 0; dt < 4; ++dt)
#pragma unroll
            for (int jj = 0; jj < 8; ++jj) {
                const int key = (jj < 4) ? quad * 4 + jj : 16 + quad * 4 + (jj - 4);
                vf[dt][jj] = (short)sV[key * 72 + dt * 16 + qi];
            }
#pragma unroll
        for (int i = 0; i < 4; ++i) {
            f32x4 s0 = (f32x4){0.f, 0.f, 0.f, 0.f}, s1 = (f32x4){0.f, 0.f, 0.f, 0.f};
            s0 = __builtin_amdgcn_mfma_f32_16x16x32_bf16(kf[0][0], qf[i][0], s0, 0, 0, 0);
            s0 = __builtin_amdgcn_mfma_f32_16x16x32_bf16(kf[0][1], qf[i][1], s0, 0, 0, 0);
            s1 = __builtin_amdgcn_mfma_f32_16x16x32_bf16(kf[1][0], qf[i][0], s1, 0, 0, 0);
            s1 = __builtin_amdgcn_mfma_f32_16x16x32_bf16(kf[1][1], qf[i][1], s1, 0, 0, 0);
            float sc[8];
#pragma unroll
            for (int j = 0; j < 4; ++j) { sc[j] = s0[j] * SCL; sc[4 + j] = s1[j] * SCL; }
            if (masked) {
                const int t = qtok[i];
#pragma unroll
                for (int e = 0; e < 8; ++e) {
                    const int u = u0 + (e >> 2) * 16 + quad * 4 + (e & 3);
                    if (mode == 1) {
                        const int dd = t - u;
                        const bool ok = (u >= 0) && (u < SEQ) && (dd <= 128) && (dd >= -128);
                        if (!ok) sc[e] = -INFINITY;
                    } else {
                        const int c = t & 63, r = t >> 6, ur = u >> 6, uc = u & 63;
                        const int cst = min(max(c - 8, 0), 48);
                        const bool ok = (uc >= cst) && (uc < cst + 16);
                        const int dr = min(max(ur - r + 7, 0), 14), dcx = min(max(uc - c + 15, 0), 30);
                        const float bias = rpb[(qhead[i] * 15 + dr) * 31 + dcx];
                        sc[e] = ok ? sc[e] + bias * LOG2E : -INFINITY;
                    }
                }
            }
            float mx = fmaxf(fmaxf(fmaxf(sc[0], sc[1]), fmaxf(sc[2], sc[3])), fmaxf(fmaxf(sc[4], sc[5]), fmaxf(sc[6], sc[7])));
            mx = fmaxf(mx, __shfl_xor(mx, 16)); mx = fmaxf(mx, __shfl_xor(mx, 32));
            const float mn = fmaxf(mrun[i], mx);
            const float al = __builtin_amdgcn_exp2f(mrun[i] - mn);
            mrun[i] = mn;
            float pe[8], ps = 0.f;
#pragma unroll
            for (int e = 0; e < 8; ++e) { pe[e] = __builtin_amdgcn_exp2f(sc[e] - mn); ps += pe[e]; }
            lrun[i] = lrun[i] * al + ps;
            union { unsigned u[4]; bf16x8 v; } pf;
            pf.u[0] = pk2(pe[0], pe[1]); pf.u[1] = pk2(pe[2], pe[3]); pf.u[2] = pk2(pe[4], pe[5]); pf.u[3] = pk2(pe[6], pe[7]);
#pragma unroll
            for (int dt = 0; dt < 4; ++dt) {
                o[i][dt] = o[i][dt] * al;
                o[i][dt] = __builtin_amdgcn_mfma_f32_16x16x32_bf16(vf[dt], pf.v, o[i][dt], 0, 0, 0);
            }
        }
    }
#pragma unroll
    for (int i = 0; i < 4; ++i) {
        float l = lrun[i]; l += __shfl_xor(l, 16); l += __shfl_xor(l, 32);
        const float inv = 1.f / l;
        const size_t m = rowb + (qctx ? SEQ : 0) + qtok[i];
        u16* op = AO + m * DM + ocol + qhead[i] * 64 + quad * 4;
#pragma unroll
        for (int dt = 0; dt < 4; ++dt) {
            uint2 w; w.x = pk2(o[i][dt][0] * inv, o[i][dt][1] * inv); w.y = pk2(o[i][dt][2] * inv, o[i][dt][3] * inv);
            *(uint2*)(op + dt * 16) = w;
        }
    }
}

DEV void phase_attn_even(PPtr p, int li, char* lds) {
    {
        const attn_body::bf16* RAWb = (const attn_body::bf16*)(p->ws + OFF_RAW); attn_body::bf16* AOb = (attn_body::bf16*)(p->ws + OFF_AO);
        const int G = gridDim.x, bx = blockIdx.x;
        if (G == 256) {
            const int vcu = (bx & 7) * 32 + (bx >> 3); const int x = vcu >> 5, combo = x >> 1, sub = (x & 1) * 32 + (vcu & 31);
            for (int i = 0; i < 4; ++i) attn_body::attn_unit<8>(combo >> 1, (combo & 1) * 4 + i, sub, RAWb, RAWb + 512, RAWb + 640, AOb, lds);
        } else {
            for (int u = bx; u < 1024; u += G) attn_body::attn_unit<8>(u >> 9, (u >> 6) & 7, u & 63, RAWb, RAWb + 512, RAWb + 640, AOb, lds);
        }
    }
    const int wave = tidx() >> 6, gw = blockIdx.x * NWAVE + wave, ngw = gridDim.x * NWAVE;
    u16* sV = (u16*)lds + wave * (32 * 72);
    const u16* RAW = (const u16*)(p->ws + OFF_RAW); u16* AO = (u16*)(p->ws + OFF_AO);
    const float* sink = p->in[12] + li * 8;
    for (int t = gw; t < 4224; t += ngw) {
        if (t < 4096) attn_wave<1, false>(RAW, 1536, 768, 1280, 1408, AO, 512, t >> 11, (t >> 10) & 1, t & 1023, sink, nullptr, sV);
        else if (t < 4160) { const int u = t - 4096; attn_wave<0, true>(RAW, 1536, 0, 512, 640, AO, 0, u >> 5, (u >> 4) & 1, u & 15, nullptr, nullptr, sV); }
        else { const int u = t - 4160; attn_wave<1, true>(RAW, 1536, 768, 1280, 1408, AO, 512, u >> 5, (u >> 4) & 1, u & 15, sink, nullptr, sV); }
    }
}
DEV void phase_attn_odd(PPtr p, int li, char* lds) {
    const int wave = tidx() >> 6, gw = blockIdx.x * NWAVE + wave, ngw = gridDim.x * NWAVE;
    u16* sV = (u16*)lds + wave * (32 * 72);
    const u16* QKV = (const u16*)(p->ws + OFF_RAW); u16* AO = (u16*)(p->ws + OFF_AO);
    const float* rpb = p->in[15] + li * 8 * 15 * 31;
    for (int t = gw; t < 4160; t += ngw) {
        if (t < 4096) attn_wave<2, false>(QKV, 1536, 0, 512, 1024, AO, 0, t >> 11, (t >> 8) & 7, t & 255, nullptr, rpb, sV);
        else { const int u = t - 4096; attn_wave<2, true>(QKV, 1536, 0, 512, 1024, AO, 0, u >> 5, (u >> 2) & 7, u & 3, nullptr, rpb, sV); }
    }
}

DEV float shiftmix_at(const u16* ZDb, int pp, int ch, float mu) {
    const bool lat = pp < SEQ; const int lo = lat ? 0 : SEQ, hi = lat ? SEQ : RPB;
    const u16* zc = ZDb + (size_t)pp * ZDW + ch;
    const float z = bf2f(zc[0]);
    const float a = (pp - 1 >= lo) ? bf2f(zc[-ZDW]) : 0.f, c = (pp + 1 < hi) ? bf2f(zc[ZDW]) : 0.f;
    return z + (0.5f * (a + c) - z) * mu;
}
DEV void phase_rwkv_prep(PPtr p, int li, int bb) {
    const int tid = tidx(), lane = tid & 63, gw = blockIdx.x * NWAVE + (tid >> 6), ngw = gridDim.x * NWAVE;
    const u16* ZDb = (const u16*)(p->ws + OFF_ZD) + (size_t)bb * RPB * ZDW;
    const float* mu = p->in[16] + li * ZDW; const float* kkw = p->in[22] + li * 512;
    u16* R = (u16*)(p->ws + OFF_R); u16* KK = (u16*)(p->ws + OFF_KK); u16* V = (u16*)(p->ws + OFF_V); u16* LA = (u16*)(p->ws + OFF_LA);
    {
        u16* LB = (u16*)(p->ws + OFF_PU);
        const float* w2 = p->in[18] + (size_t)li * 2 * 64 * 512; const float* a2 = p->in[20] + (size_t)li * 2 * 64 * 512; const float* g2 = p->in[21] + (size_t)li * 128 * 512;
        for (int idx = gw * 64 + lane; idx < 2560 * 32; idx += ngw * 64) {
            const int n = idx >> 5, kc = (idx & 31) * 8, type = n >> 9, nn = n & 511;
            float f[8];
#pragma unroll
            for (int e = 0; e < 8; ++e) {
                const int k = kc + e; float x = 0.f;
                if (type < 2) { if (k < 64) x = w2[((size_t)type * 64 + k) * 512 + nn]; }
                else if (type < 4) { if (k >= 64 && k < 128) x = a2[((size_t)(type - 2) * 64 + (k - 64)) * 512 + nn]; }
                else { if (k >= 128) x = g2[(size_t)(k - 128) * 512 + nn]; }
                f[e] = x;
            }
            *(uint4*)(LB + (size_t)n * 256 + kc) = pack8(f);
        }
    }
    {
        float4* Yz = (float4*)(p->ws + OFF_Y0); const float4 z = {0.f, 0.f, 0.f, 0.f};
        for (size_t i = (size_t)gw * 64 + lane; i < (size_t)RPB * 512 / 4; i += (size_t)ngw * 64) Yz[i] = z;
    }
    for (int pp = gw; pp < RPB; pp += ngw) {
        const bool lat = pp < SEQ; const int lo = lat ? 0 : SEQ, hi = lat ? SEQ : RPB;
        const bool hp = pp - 1 >= lo, hn = pp + 1 < hi;
        const u16* zc = ZDb + (size_t)pp * ZDW;
#pragma unroll
        for (int j = 0; j < 4; ++j) {
            const int c8 = lane + 64 * j;
            if (j == 3 && lane >= 32) break;
            const int ch = 8 * c8;
            float z[8], a[8], c[8], zs[8];
            unpack8(*(const uint4*)(zc + ch), z);
            if (hp) unpack8(*(const uint4*)(zc - ZDW + ch), a); else { for (int e = 0; e < 8; ++e) a[e] = 0.f; }
            if (hn) unpack8(*(const uint4*)(zc + ZDW + ch), c); else { for (int e = 0; e < 8; ++e) c[e] = 0.f; }
            const float4 m0 = *(const float4*)(mu + ch), m1 = *(const float4*)(mu + ch + 4);
            const float mm[8] = {m0.x, m0.y, m0.z, m0.w, m1.x, m1.y, m1.z, m1.w};
#pragma unroll
            for (int e = 0; e < 8; ++e) zs[e] = z[e] + (0.5f * (a[e] + c[e]) - z[e]) * mm[e];
            if (j == 0) *(uint4*)(R + (size_t)pp * 512 + ch) = pack8(zs);
            else if (j == 1) {
                const float4 k0 = *(const float4*)(kkw + ch - 512), k1 = *(const float4*)(kkw + ch - 512 + 4);
                const float kw[8] = {k0.x, k0.y, k0.z, k0.w, k1.x, k1.y, k1.z, k1.w};
                float t[8], ss = 0.f;
#pragma unroll
                for (int e = 0; e < 8; ++e) { t[e] = zs[e] * kw[e]; ss += t[e] * t[e]; }
                ss += __shfl_xor(ss, 1); ss += __shfl_xor(ss, 2); ss += __shfl_xor(ss, 4);
                const float inv = 1.f / fmaxf(sqrtf(ss), 1e-12f);
#pragma unroll
                for (int e = 0; e < 8; ++e) t[e] *= inv;
                *(uint4*)(KK + (size_t)pp * 512 + ch - 512) = pack8(t);
            } else if (j == 2) *(uint4*)(V + (size_t)pp * 512 + ch - 1024) = pack8(zs);
            else {
                float o[8];
#pragma unroll
                for (int e = 0; e < 8; ++e) o[e] = (lane < 8) ? tanhf(zs[e]) : (lane < 16) ? zs[e] : sigmoidf_(zs[e]);
                *(uint4*)(LA + (size_t)pp * 256 + ch - 1536) = pack8(o);
            }
        }
    }
}
struct EpiDecay { float* DEC; const float* w0; int d;
    DEV void operator()(int r, int c, float v, float) const {
        const float x = -(w0[c] + v); const float sp = x > 20.f ? x : log1pf(expf(x)); const float w = -sp - 0.5f;
        DEC[((size_t)r * 2 + d) * 512 + c] = expf(-expf(w)); } };
struct EpiIclr { u16* KD; u16* BQ; const u16* KK; const u16* ZDb; const float* a0; const float* ka; const float* muk; int d;
    DEV void operator()(int r, int c, float v, float) const {
        const float a = sigmoidf_(a0[c] + v);
        const float k = shiftmix_at(ZDb, r, 512 + c, muk[c]);
        KD[((size_t)r * 2 + d) * 512 + c] = (u16)f2bf(k * (1.f + (a - 1.f) * ka[c]));
        BQ[((size_t)r * 2 + d) * 512 + c] = (u16)f2bf(bf2f(KK[(size_t)r * 512 + c]) * a); } };
struct EpiGate { u16* G; DEV void operator()(int r, int c, float v, float) const { G[(size_t)r * 512 + c] = (u16)f2bf(v); } };

DEV int pos_to_pp(int s, int d) { return (s < NCTX) ? (d ? SEQ + NCTX - 1 - s : SEQ + s) : (d ? SEQ - 1 - (s - NCTX) : s - NCTX); }
struct StepV { float d; unsigned a; unsigned b; float v; };
DEV StepV load_step(const float* DEC, const u16* KD, const u16* BQ, const u16* KK, const u16* R, const u16* V, int pp, int h, int d, int lane) {
    const size_t e1 = (size_t)pp * 512 + h * 64, e2 = ((size_t)pp * 2 + d) * 512 + h * 64;
    StepV s;
    s.d = DEC[e2 + lane];
    s.a = (lane < 32) ? ((const unsigned*)(KD + e2))[lane] : ((const unsigned*)(BQ + e2))[lane - 32];
    s.b = (lane < 32) ? ((const unsigned*)(KK + e1))[lane] : ((const unsigned*)(R + e1))[lane - 32];
    s.v = bf2f(V[e1 + lane]);
    return s;
}
#define RLU(x, j) ((unsigned)__builtin_amdgcn_readlane((int)(x), (j)))
#define RLF(x, j) __int_as_float(__builtin_amdgcn_readlane(__float_as_int(x), (j)))
template <int MODE>
DEV float scan_step(float (&S)[64], StepV c) {
    float sa0 = 0.f, sa1 = 0.f;
#pragma unroll
    for (int j = 0; j < 32; ++j) { const unsigned u = RLU(c.b, j); sa0 += S[2 * j] * bflo(u); sa1 += S[2 * j + 1] * bfhi(u);
        if ((j & 7) == 7) asm volatile("" : "+v"(c.b), "+v"(sa0), "+v"(sa1)); }
    const float nsa = -(sa0 + sa1), vv = c.v;
    float y0 = 0.f, y1 = 0.f;
#pragma unroll
    for (int j = 0; j < 32; ++j) {
        const unsigned ub = RLU(c.a, 32 + j);
        const float d0 = RLF(c.d, 2 * j), d1 = RLF(c.d, 2 * j + 1);
        float t0 = nsa * bflo(ub), t1 = nsa * bfhi(ub);
        if (MODE >= 1) { const unsigned uk = RLU(c.a, j); t0 += vv * bflo(uk); t1 += vv * bfhi(uk); }
        S[2 * j] = S[2 * j] * d0 + t0; S[2 * j + 1] = S[2 * j + 1] * d1 + t1;
        if (MODE == 2) { const unsigned ur = RLU(c.b, 32 + j); y0 += S[2 * j] * bflo(ur); y1 += S[2 * j + 1] * bfhi(ur); }
        if ((j & 3) == 3) asm volatile("" : "+v"(c.a), "+v"(c.b), "+v"(c.d), "+v"(y0), "+v"(y1));
    }
    return y0 + y1;
}
DEV void phase_scan1(PPtr p) {
    const int tid = tidx(), lane = tid & 63, gw = blockIdx.x * NWAVE + __builtin_amdgcn_readfirstlane(tid >> 6), ngw = gridDim.x * NWAVE;
    const float* DEC = (const float*)(p->ws + OFF_DEC); const u16* KD = (const u16*)(p->ws + OFF_KD); const u16* BQ = (const u16*)(p->ws + OFF_BQ);
    const u16* KK = (const u16*)(p->ws + OFF_KK); const u16* R = (const u16*)(p->ws + OFF_R); const u16* V = (const u16*)(p->ws + OFF_V);
    float* PU = (float*)(p->ws + OFF_PU);
    for (int task = gw; task < 16 * NCH; task += ngw) {
        const int seq = task >> 7, c = task & 127, h = seq >> 1, d = seq & 1;
#define LD(st) load_step(DEC, KD, BQ, KK, R, V, pos_to_pp(c * CLEN + min((st), CLEN - 1), d), h, d, lane)
        for (int which = 0; which < 2; ++which) {
            float X[64];
#pragma unroll
            for (int j = 0; j < 64; ++j) X[j] = (which == 0 && j == lane) ? 1.f : 0.f;
            StepV r0 = LD(0), r1 = LD(1), r2 = LD(2), r3 = LD(3);
            if (which == 0) {
#pragma unroll 1
                for (int st = 0; st < CLEN; ++st) { scan_step<0>(X, r0); r0 = r1; r1 = r2; r2 = r3; r3 = LD(st + 4); }
            } else {
#pragma unroll 1
                for (int st = 0; st < CLEN; ++st) { scan_step<1>(X, r0); r0 = r1; r1 = r2; r2 = r3; r3 = LD(st + 4); }
            }
            float4* o = (float4*)(PU + ((size_t)task * 2 + which) * 4096 + lane * 64);
#pragma unroll
            for (int j = 0; j < 16; ++j) o[j] = (float4){X[4 * j], X[4 * j + 1], X[4 * j + 2], X[4 * j + 3]};
        }
#undef LD
    }
}
DEV void phase_scan2(PPtr p, char* lds) {
    if (blockIdx.x >= 16) return;
    const int tid = tidx(), lane = tid & 63, w = __builtin_amdgcn_readfirstlane(tid >> 6), seq = blockIdx.x;
    float* sS = (float*)lds;
    float* sP = sS + 2 * 64 * 68;
    float* PU = (float*)(p->ws + OFF_PU) + (size_t)seq * NCH * 2 * 4096;
    const int rt = w >> 1, ct0 = (w & 1) * 2, r = lane & 15, q = lane >> 4;
    for (int i = tid; i < 64 * 68; i += NTHR) sS[i] = 0.f;
    const int prow = tid >> 3, pcol = (tid & 7) * 8;
#define PLOAD(c_, lo, hi) do { const float4* s_ = (const float4*)(PU + (size_t)(c_) * 8192 + prow * 64 + pcol); lo = s_[0]; hi = s_[1]; } while (0)
#define ULOAD(c_, u_) do { const float* s_ = PU + (size_t)(c_) * 8192 + 4096; _Pragma("unroll") for (int t = 0; t < 2; ++t) _Pragma("unroll") for (int j = 0; j < 4; ++j) u_[t][j] = s_[(16 * rt + 4 * q + j) * 64 + 16 * (ct0 + t) + r]; } while (0)
    float4 pa0, pa1, pb0, pb1;
    { float4 t0, t1; PLOAD(0, t0, t1); *(float4*)(sP + prow * 68 + pcol) = t0; *(float4*)(sP + prow * 68 + pcol + 4) = t1; }
    PLOAD(1, pa0, pa1); PLOAD(2, pb0, pb1);
    float ua[2][4], ub[2][4], mine[2][4];
    ULOAD(0, ua); ULOAD(1, ub);
#pragma unroll
    for (int t = 0; t < 2; ++t)
#pragma unroll
        for (int j = 0; j < 4; ++j) mine[t][j] = 0.f;
    __syncthreads();
    for (int c = 0; c < NCH; ++c) {
        const int cur = c & 1;
        float* Um = PU + (size_t)c * 8192 + 4096;
#pragma unroll
        for (int t = 0; t < 2; ++t)
#pragma unroll
            for (int j = 0; j < 4; ++j) Um[(16 * rt + 4 * q + j) * 64 + 16 * (ct0 + t) + r] = mine[t][j];
        f32x4 a0 = {ua[0][0], ua[0][1], ua[0][2], ua[0][3]}, a1 = {ua[1][0], ua[1][1], ua[1][2], ua[1][3]};
        const float* Sc = sS + cur * (64 * 68); const float* Pc = sP + cur * (64 * 68);
#pragma unroll
        for (int ks = 0; ks < 16; ++ks) {
            const float av = Sc[(16 * rt + r) * 68 + 4 * ks + q];
            const float b0 = Pc[(4 * ks + q) * 68 + 16 * ct0 + r], b1 = Pc[(4 * ks + q) * 68 + 16 * ct0 + 16 + r];
            a0 = __builtin_amdgcn_mfma_f32_16x16x4f32(av, b0, a0, 0, 0, 0);
            a1 = __builtin_amdgcn_mfma_f32_16x16x4f32(av, b1, a1, 0, 0, 0);
        }
        float* Sn = sS + (cur ^ 1) * (64 * 68);
#pragma unroll
        for (int j = 0; j < 4; ++j) { Sn[(16 * rt + 4 * q + j) * 68 + 16 * ct0 + r] = a0[j]; Sn[(16 * rt + 4 * q + j) * 68 + 16 * ct0 + 16 + r] = a1[j]; mine[0][j] = a0[j]; mine[1][j] = a1[j]; }
        { float* Pn = sP + (cur ^ 1) * (64 * 68); *(float4*)(Pn + prow * 68 + pcol) = pa0; *(float4*)(Pn + prow * 68 + pcol + 4) = pa1; }
        pa0 = pb0; pa1 = pb1;
        { const int c3 = min(c + 3, NCH - 1); PLOAD(c3, pb0, pb1); }
#pragma unroll
        for (int t = 0; t < 2; ++t)
#pragma unroll
            for (int j = 0; j < 4; ++j) ua[t][j] = ub[t][j];
        { const int c2 = c + 2; if (c2 < NCH) ULOAD(c2, ub); }
        __syncthreads();
    }
#undef PLOAD
#undef ULOAD
}
DEV void phase_scan3(PPtr p) {
    const int tid = tidx(), lane = tid & 63, gw = blockIdx.x * NWAVE + __builtin_amdgcn_readfirstlane(tid >> 6), ngw = gridDim.x * NWAVE;
    const float* DEC = (const float*)(p->ws + OFF_DEC); const u16* KD = (const u16*)(p->ws + OFF_KD); const u16* BQ = (const u16*)(p->ws + OFF_BQ);
    const u16* KK = (const u16*)(p->ws + OFF_KK); const u16* R = (const u16*)(p->ws + OFF_R); const u16* V = (const u16*)(p->ws + OFF_V);
    const float* PU = (const float*)(p->ws + OFF_PU);
    float* Y = (float*)(p->ws + OFF_Y0);
    for (int task = gw; task < 16 * NCH; task += ngw) {
        const int seq = task >> 7, c = task & 127, h = seq >> 1, d = seq & 1;
        float S[64];
        {
            const float4* si = (const float4*)(PU + ((size_t)task * 2 + 1) * 4096 + lane * 64);
#pragma unroll
            for (int j = 0; j < 16; ++j) { const float4 t = si[j]; S[4 * j] = t.x; S[4 * j + 1] = t.y; S[4 * j + 2] = t.z; S[4 * j + 3] = t.w; }
        }
#define LD(st) load_step(DEC, KD, BQ, KK, R, V, pos_to_pp(c * CLEN + min((st), CLEN - 1), d), h, d, lane)
#define YADD(st, y) unsafeAtomicAdd(Y + (size_t)pos_to_pp(c * CLEN + (st), d) * 512 + h * 64 + lane, (y))
        StepV r0 = LD(0), r1 = LD(1), r2 = LD(2), r3 = LD(3);
#pragma unroll 1
        for (int st = 0; st < CLEN; ++st) {
            const float y = scan_step<2>(S, r0); YADD(st, y); r0 = r1; r1 = r2; r2 = r3; r3 = LD(st + 4);
        }
#undef LD
#undef YADD
    }
}
DEV void phase_readout(PPtr p, int li, int bb) {
    const int tid = tidx(), lane = tid & 63, gw = blockIdx.x * NWAVE + (tid >> 6), ngw = gridDim.x * NWAVE;
    const float* Y0 = (const float*)(p->ws + OFF_Y0);
    const u16* KD = (const u16*)(p->ws + OFF_KD); const u16* R = (const u16*)(p->ws + OFF_R); const u16* V = (const u16*)(p->ws + OFF_V); const u16* G = (const u16*)(p->ws + OFF_G);
    const float* rk = p->in[24] + li * 512; const float* lnw = p->in[25] + li * 512; const float* lnb = p->in[26] + li * 512;
    u16* AO = (u16*)(p->ws + OFF_AO);
    const int c = 8 * lane;
    float rkv[8], lw[8], lb[8];
    { const float4 a = *(const float4*)(rk + c), b = *(const float4*)(rk + c + 4); rkv[0] = a.x; rkv[1] = a.y; rkv[2] = a.z; rkv[3] = a.w; rkv[4] = b.x; rkv[5] = b.y; rkv[6] = b.z; rkv[7] = b.w; }
    { const float4 a = *(const float4*)(lnw + c), b = *(const float4*)(lnw + c + 4); lw[0] = a.x; lw[1] = a.y; lw[2] = a.z; lw[3] = a.w; lw[4] = b.x; lw[5] = b.y; lw[6] = b.z; lw[7] = b.w; }
    { const float4 a = *(const float4*)(lnb + c), b = *(const float4*)(lnb + c + 4); lb[0] = a.x; lb[1] = a.y; lb[2] = a.z; lb[3] = a.w; lb[4] = b.x; lb[5] = b.y; lb[6] = b.z; lb[7] = b.w; }
    for (int pp = gw; pp < RPB; pp += ngw) {
        const size_t m = (size_t)bb * RPB + pp, e = (size_t)pp * 512 + c;
        const float4 ya = *(const float4*)(Y0 + e), yb = *(const float4*)(Y0 + e + 4);
        const float y[8] = {ya.x, ya.y, ya.z, ya.w, yb.x, yb.y, yb.z, yb.w};
        float r[8], k0[8], k1[8], v[8], g[8];
        unpack8(*(const uint4*)(R + e), r); unpack8(*(const uint4*)(KD + ((size_t)pp * 2) * 512 + c), k0); unpack8(*(const uint4*)(KD + ((size_t)pp * 2 + 1) * 512 + c), k1);
        unpack8(*(const uint4*)(V + e), v); unpack8(*(const uint4*)(G + e), g);
        float sm = 0.f, bs = 0.f;
#pragma unroll
        for (int j = 0; j < 8; ++j) { sm += y[j]; bs += r[j] * (k0[j] + k1[j]) * rkv[j]; }
        sm += __shfl_xor(sm, 1); sm += __shfl_xor(sm, 2); sm += __shfl_xor(sm, 4);
        bs += __shfl_xor(bs, 1); bs += __shfl_xor(bs, 2); bs += __shfl_xor(bs, 4);
        const float mean = sm * (1.f / 64.f);
        float vs = 0.f;
#pragma unroll
        for (int j = 0; j < 8; ++j) { const float dv = y[j] - mean; vs += dv * dv; }
        vs += __shfl_xor(vs, 1); vs += __shfl_xor(vs, 2); vs += __shfl_xor(vs, 4);
        const float rstd = rsqrtf(vs * (1.f / 64.f) + 64e-5f);
        float o[8];
#pragma unroll
        for (int j = 0; j < 8; ++j) o[j] = ((y[j] - mean) * rstd * lw[j] + lb[j] + bs * v[j]) * g[j];
        *(uint4*)(AO + m * DM + 512 + c) = pack8(o);
    }
}
DEV void phase_final(PPtr p) {
    const int lane = tidx() & 63, gw = blockIdx.x * NWAVE + (tidx() >> 6), ngw = gridDim.x * NWAVE;
    const float* gain = p->in[29];
    for (int m = gw; m < NB * SEQ; m += ngw) {
        float4* xr = (float4*)(p->out + (size_t)m * DM);
        float4 v[4]; float ss = 0.f;
#pragma unroll
        for (int j = 0; j < 4; ++j) { v[j] = xr[lane + 64 * j]; ss += v[j].x * v[j].x + v[j].y * v[j].y + v[j].z * v[j].z + v[j].w * v[j].w; }
        ss = wave_sum(ss);
        const float rstd = rsqrtf(ss * (1.f / DM) + 1e-6f);
#pragma unroll
        for (int j = 0; j < 4; ++j) {
            const float4 g = *(const float4*)(gain + (lane + 64 * j) * 4);
            float4 o; o.x = v[j].x * rstd * g.x; o.y = v[j].y * rstd * g.y; o.z = v[j].z * rstd * g.z; o.w = v[j].w * rstd * g.w;
            xr[lane + 64 * j] = o;
        }
    }
}

constexpr size_t OFF_BAR = 768 * 1024;
DEV void gbar(PPtr kp_, unsigned& nbar) {
    asm volatile("s_waitcnt vmcnt(0)" ::: "memory");
    __syncthreads();
    if (threadIdx.x == 0) {
        unsigned* ctr = (unsigned*)(kp_->ws + OFF_BAR);
        __builtin_amdgcn_fence(__ATOMIC_RELEASE, "agent");
        asm volatile("s_waitcnt vmcnt(0)" ::: "memory");
        ++nbar;
        __hip_atomic_fetch_add(ctr, 1u, __ATOMIC_RELAXED, __HIP_MEMORY_SCOPE_AGENT);
        const unsigned target = nbar * gridDim.x;
        while (__hip_atomic_load(ctr, __ATOMIC_RELAXED, __HIP_MEMORY_SCOPE_AGENT) < target) __builtin_amdgcn_s_sleep(1);
        __builtin_amdgcn_fence(__ATOMIC_ACQUIRE, "agent");
        asm volatile("s_waitcnt vmcnt(0)" ::: "memory");
    }
    __syncthreads();
}
#define p launder(kp)
#define SYNC() gbar(launder(kp), nbar)
template <int bb>
DEV void do_rwkv_batch(PPtr kp, unsigned& nbar, char* lds, int li) {
    unsigned char* ws = launder(kp)->ws;
    u16* ZD = (u16*)(ws + OFF_ZD);
                phase_rwkv_prep(p, li, bb); SYNC();
                const u16* LA = (const u16*)(ws + OFF_LA); const u16* ZDb = ZD + (size_t)bb * RPB * ZDW;
                { pg8::EpiLoraT e{(float*)(ws + OFF_DEC), (u16*)(ws + OFF_KD), (u16*)(ws + OFF_BQ), (u16*)(ws + OFF_G), (const u16*)(ws + OFF_KK), ZDb,
                                  p->in[17] + (size_t)li * 1024, p->in[19] + (size_t)li * 1024, p->in[23] + li * 512, p->in[16] + li * ZDW + 512};
                  int kl_ = 256; asm volatile("" : "+s"(kl_));
                  pg8::Gemm g_{(const pg8::bf16_t*)LA, (const pg8::bf16_t*)(ws + OFF_PU), RPB, 2560, kl_}; pg8::StaticOrder S_; S_.init(RPB, 2560, (int)gridDim.x, (int)blockIdx.x);
                  pg8::gemm_phase<pg8::EpiLoraT, pg8::StaticOrder, true, true>((PG8_LAS unsigned char*)lds, g_, S_, e); }
                SYNC();
                phase_scan1(p); SYNC();
                phase_scan2(p, lds); SYNC();
                phase_scan3(p); SYNC();
                phase_readout(p, li, bb); SYNC();
            }
template <int layer>
DEV void do_layer(PPtr kp, unsigned& nbar, char* lds) {
    unsigned char* ws = launder(kp)->ws;
    const float* mod = (const float*)(ws + OFF_MOD);
    u16* HN = (u16*)(ws + OFF_HN); u16* AO = (u16*)(ws + OFF_AO); u16* RAW = (u16*)(ws + OFF_RAW); u16* ZD = (u16*)(ws + OFF_ZD);
        const int li = layer >> 1;
        const float* lmod = mod + (size_t)layer * 3 * 6144;
        phase_wprep(p, layer, lds); phase_normmod(p, layer, 0); SYNC();
        const pg8::bf16_t* WB = (const pg8::bf16_t*)(ws + OFF_WB);
#define GEMM8(A_, B_, N_, K_, E_) do { pg8::Gemm g_{(const pg8::bf16_t*)(A_), (B_), MROWS, (N_), (K_)}; pg8::StaticOrder S_; S_.init(MROWS, (N_), (int)gridDim.x, (int)blockIdx.x); \
            pg8::gemm_phase<decltype(E_), pg8::StaticOrder, true, true>((PG8_LAS unsigned char*)lds, g_, S_, E_); } while (0)
        if (!(layer & 1)) {
            { pg8::EpiStoreT e{RAW, 1536, 1 << 30, RAW, 1536}; GEMM8(HN, WB + WB_IN, 1536, DM, e); } SYNC();
            phase_even_post(p, li); SYNC();
            phase_attn_even(p, li, lds); SYNC();
            { pg8::EpiResidT e{p, lmod + 2048}; GEMM8(AO, WB + WB_OUT, DM, DM, e); } SYNC();
        } else {
            { pg8::EpiStoreT e{RAW, 1536, 1536, ZD, ZDW}; GEMM8(HN, WB + WB_IN, 3328, DM, e); } SYNC();
            phase_attn_odd(p, li, lds); SYNC();
            do_rwkv_batch<0>(kp, nbar, lds, li);
            do_rwkv_batch<1>(kp, nbar, lds, li);
            { pg8::EpiResidT e{p, lmod + 2048}; GEMM8(AO, WB + WB_OUT, DM, DM, e); } SYNC();
        }
        phase_normmod(p, layer, 1); SYNC();
        { pg8::EpiSwigluT e{RAW}; GEMM8(HN, WB + WB_F1, 5632, DM, e); } SYNC();
        { pg8::EpiResidT e{p, lmod + 5120}; GEMM8(RAW, WB + WB_F2, DM, FFH, e); } SYNC();
    }
__global__ void __launch_bounds__(NTHR) mega(Params p_unused) {
    PPtr kp = (PPtr)__builtin_amdgcn_kernarg_segment_ptr();
    extern __shared__ __attribute__((aligned(16))) char lds[];
    cg::grid_group grid = cg::this_grid();
    unsigned nbar = 0;
    grid.sync();
    phase_init(p, lds); SYNC();
    do_layer<0>(kp, nbar, lds);
    do_layer<1>(kp, nbar, lds);
    do_layer<2>(kp, nbar, lds);
    do_layer<3>(kp, nbar, lds);
    phase_final(p);
}
#undef p
#undef SYNC

extern "C" void kernel_launch(void* const* d_in, const int* in_sizes, int n_in, void* d_out, int out_size, void* d_ws, size_t ws_size, hipStream_t stream) {
    static int grid = 0;
    if (grid == 0) {
        if (n_in != 30 || ws_size < WS_NEED || out_size != NB * SEQ * DM) { fprintf(stderr, "kernel_launch: unexpected problem shape (n_in %d ws %zu out %d)\n", n_in, ws_size, out_size); grid = -1; return; }
        int dev = 0, cus = 0, per_cu = 0;
        hipGetDevice(&dev);
        hipDeviceGetAttribute(&cus, hipDeviceAttributeMultiprocessorCount, dev);
        hipFuncSetAttribute((const void*)mega, hipFuncAttributeMaxDynamicSharedMemorySize, LDS_BYTES);
        hipOccupancyMaxActiveBlocksPerMultiprocessor(&per_cu, (const void*)mega, NTHR, LDS_BYTES);
        if (per_cu < 1) per_cu = 1;
        if (per_cu > 1) per_cu = 1;
        grid = cus * per_cu;
    }
    if (grid < 0) return;
    Params p{};
    for (int i = 0; i < 30; ++i) p.in[i] = (const float*)d_in[i];
    p.out = (float*)d_out; p.ws = (unsigned char*)d_ws;
    hipMemsetAsync((char*)d_ws + OFF_BAR, 0, 256, stream);
    void* args[] = {&p};
    hipError_t e = hipLaunchCooperativeKernel((const void*)mega, dim3(grid), dim3(NTHR), args, LDS_BYTES, stream);
    if (e != hipSuccess) fprintf(stderr, "cooperative launch failed: %s (grid %d)\n", hipGetErrorString(e), grid);
}
```

```cpp
#include <hip/hip_runtime.h>
#include <hip/hip_cooperative_groups.h>
#include <cstdio>
#include <cstdint>
namespace cg = cooperative_groups;

#define DEV __device__ __forceinline__
typedef unsigned short u16;
typedef short bf16x8 __attribute__((ext_vector_type(8)));
typedef float f32x4 __attribute__((ext_vector_type(4)));
typedef const __attribute__((address_space(4))) float* cfp;
typedef const __attribute__((address_space(4))) unsigned* cup;

constexpr int DM = 1024, NB = 2, SEQ = 16384, NCTX = 256, RPB = SEQ + NCTX, MROWS = NB * RPB;
constexpr int FFH = 2816, ZDW = 1792;
constexpr float LOG2E = 1.4426950408889634f;
constexpr int NTHR = 512, NWAVE = 8;
constexpr int LDS_BYTES = 132096;

constexpr size_t MiB = 1u << 20;
constexpr size_t OFF_MOD = 0;
constexpr size_t OFF_XC = 1 * MiB;
constexpr size_t OFF_WB = 3 * MiB;
constexpr size_t OFF_AO = 29 * MiB;
constexpr size_t OFF_HN = 94 * MiB;
constexpr size_t OFF_RAW = 159 * MiB;
constexpr size_t OFF_ZD = 257 * MiB;
constexpr size_t SZ_H = (size_t)RPB * 512 * 2;
constexpr size_t OFF_DEC = 94 * MiB;
constexpr size_t OFF_KD = OFF_DEC + 4 * SZ_H;
constexpr size_t OFF_BQ = OFF_KD + 2 * SZ_H;
constexpr size_t OFF_KK = OFF_BQ + 2 * SZ_H;
constexpr size_t OFF_R = OFF_KK + SZ_H;
constexpr size_t OFF_V = 371 * MiB;
constexpr size_t OFF_G = OFF_V + SZ_H;
constexpr size_t OFF_LA = OFF_G + SZ_H;
constexpr size_t OFF_Y0 = 412 * MiB;
constexpr size_t OFF_PU = OFF_Y0 + 2 * SZ_H;
constexpr size_t WS_NEED = 509 * MiB;
constexpr int NCH = 128, CLEN = 130;
static_assert(OFF_R + SZ_H <= OFF_ZD, "scan map");
static_assert(OFF_LA + SZ_H / 2 <= OFF_Y0, "scan map 2");
static_assert(OFF_PU + 64 * MiB <= WS_NEED, "scan map 3");
static_assert(OFF_RAW + (size_t)MROWS * FFH * 2 <= WS_NEED, "ffn hidden");

struct Params { const float* in[30]; float* out; unsigned char* ws; };
typedef const __attribute__((address_space(4))) Params* PPtr;
DEV int tidx() { int t = threadIdx.x; asm volatile("" : "+v"(t)); return t; }
DEV PPtr launder(PPtr p) { asm volatile("" : "+s"(p)); return p; }

DEV unsigned f2bf(float f) { unsigned u = __float_as_uint(f); return (u + 0x7fffu + ((u >> 16) & 1u)) >> 16; }
DEV float bf2f(u16 h) { return __uint_as_float(((unsigned)h) << 16); }
DEV float bflo(unsigned u) { return __uint_as_float(u << 16); }
DEV float bfhi(unsigned u) { return __uint_as_float(u & 0xffff0000u); }
DEV unsigned pk2(float lo, float hi) { return f2bf(lo) | (f2bf(hi) << 16); }
DEV void unpack8(const uint4 u, float (&f)[8]) {
    f[0] = bflo(u.x); f[1] = bfhi(u.x); f[2] = bflo(u.y); f[3] = bfhi(u.y); f[4] = bflo(u.z); f[5] = bfhi(u.z); f[6] = bflo(u.w); f[7] = bfhi(u.w);
}
DEV uint4 pack8(const float (&f)[8]) { uint4 o; o.x = pk2(f[0], f[1]); o.y = pk2(f[2], f[3]); o.z = pk2(f[4], f[5]); o.w = pk2(f[6], f[7]); return o; }
DEV float wave_sum(float v) {
#pragma unroll
    for (int o = 1; o < 64; o <<= 1) v += __shfl_xor(v, o);
    return v;
}
DEV float* xrow_ptr(PPtr p, int m) {
    int b = m / RPB, q = m - b * RPB;
    return q < SEQ ? p->out + (size_t)(b * SEQ + q) * DM : (float*)(p->ws + OFF_XC) + (size_t)(b * NCTX + (q - SEQ)) * DM;
}
DEV int mod_idx(int m) { int b = m / RPB, q = m - b * RPB; return q < SEQ ? b : 2; }
DEV float sigmoidf_(float x) { return 1.f / (1.f + __expf(-x)); }

DEV void phase_init(PPtr p, char* lds) {
    const int tid = tidx();
    const size_t gt = (size_t)blockIdx.x * NTHR + tid, ng = (size_t)gridDim.x * NTHR;
    {
        const float4* s = (const float4*)p->in[0]; float4* d = (float4*)p->out;
        const size_t n = (size_t)NB * SEQ * DM / 4;
        for (size_t i = gt; i < n; i += ng) d[i] = s[i];
        const float4* s2 = (const float4*)p->in[2]; float4* d2 = (float4*)(p->ws + OFF_XC);
        const size_t n2 = (size_t)NB * NCTX * DM / 4;
        for (size_t i = gt; i < n2; i += ng) d2[i] = s2[i];
    }
    float* red = (float*)lds;
    float* mod = (float*)(p->ws + OFF_MOD);
    const float* c = p->in[1]; const float* cc = p->in[3];
    for (int item = blockIdx.x; item < 192; item += gridDim.x) {
        const int l = item / 48, n0 = (item % 48) * 128, col = tid & 127, kp = tid >> 7;
        const float* w = p->in[4] + (size_t)l * DM * 6144 + n0 + col;
        float a0 = 0.f, a1 = 0.f, a2 = 0.f;
        for (int k = kp * 256; k < kp * 256 + 256; ++k) {
            const float wv = w[(size_t)k * 6144];
            const float c0 = c[k], c1 = c[DM + k], c2 = cc[k];
            a0 += c0 * sigmoidf_(c0) * wv; a1 += c1 * sigmoidf_(c1) * wv; a2 += c2 * sigmoidf_(c2) * wv;
        }
        red[(kp * 3 + 0) * 128 + col] = a0; red[(kp * 3 + 1) * 128 + col] = a1; red[(kp * 3 + 2) * 128 + col] = a2;
        __syncthreads();
        if (tid < 384) {
            const int mb = tid >> 7, cl = tid & 127;
            float s = red[(0 * 3 + mb) * 128 + cl] + red[(1 * 3 + mb) * 128 + cl] + red[(2 * 3 + mb) * 128 + cl] + red[(3 * 3 + mb) * 128 + cl];
            mod[(size_t)(l * 3 + mb) * 6144 + n0 + cl] = s + p->in[5][l * 6144 + n0 + cl];
        }
        __syncthreads();
    }
}

DEV void phase_normmod(PPtr p, int layer, int which) {
    const int lane = tidx() & 63, gw = blockIdx.x * NWAVE + (tidx() >> 6), ngw = gridDim.x * NWAVE;
    const float* gain = p->in[which ? 7 : 6] + layer * DM;
    const float* mod = (const float*)(p->ws + OFF_MOD) + (size_t)layer * 3 * 6144;
    u16* HN = (u16*)(p->ws + OFF_HN);
    for (int m = gw; m < MROWS; m += ngw) {
        const float* xr = xrow_ptr(p, m);
        const float* md = mod + mod_idx(m) * 6144 + (which ? 3072 : 0);
        float4 v[4]; float ss = 0.f;
#pragma unroll
        for (int j = 0; j < 4; ++j) { v[j] = ((const float4*)xr)[lane + 64 * j]; ss += v[j].x * v[j].x + v[j].y * v[j].y + v[j].z * v[j].z + v[j].w * v[j].w; }
        ss = wave_sum(ss);
        const float rstd = rsqrtf(ss * (1.f / DM) + 1e-6f);
#pragma unroll
        for (int j = 0; j < 4; ++j) {
            const int k = (lane + 64 * j) * 4;
            const float4 g = *(const float4*)(gain + k), sh = *(const float4*)(md + k), sc = *(const float4*)(md + 1024 + k);
            const float o0 = v[j].x * rstd * g.x * (1.f + sc.x) + sh.x, o1 = v[j].y * rstd * g.y * (1.f + sc.y) + sh.y;
            const float o2 = v[j].z * rstd * g.z * (1.f + sc.z) + sh.z, o3 = v[j].w * rstd * g.w * (1.f + sc.w) + sh.w;
            uint2 w; w.x = pk2(o0, o1); w.y = pk2(o2, o3);
            *(uint2*)(HN + (size_t)m * DM + k) = w;
        }
    }
}

template <int DUAL, class Epi>
DEV void gemm_simple(const u16* A, int lda, const float* W, int ldw, int dualoff, int M, int N, int K, const Epi& epi, char* lds) {
    u16* sA = (u16*)lds; u16* sB = sA + 128 * 40; u16* sB2 = sB + 128 * 40;
    const int tid = tidx(), lane = tid & 63, wave = tid >> 6, wm = wave >> 2, wn = wave & 3, r16 = lane & 15, quad = lane >> 4;
    const int mt = M / 128, nt = N / 128;
    for (int item = blockIdx.x; item < mt * nt; item += gridDim.x) {
        const int tn = item / mt, tm = item - tn * mt, m0 = tm * 128, n0 = tn * 128;
        f32x4 acc[4][2], acc2[4][2];
#pragma unroll
        for (int a = 0; a < 4; ++a)
#pragma unroll
            for (int b = 0; b < 2; ++b) { acc[a][b] = (f32x4){0.f, 0.f, 0.f, 0.f}; acc2[a][b] = (f32x4){0.f, 0.f, 0.f, 0.f}; }
        for (int k0 = 0; k0 < K; k0 += 32) {
            {
                const int row = tid >> 2, kc = (tid & 3) * 8;
                const uint4 v = *(const uint4*)(A + (size_t)(m0 + row) * lda + k0 + kc);
                *(uint4*)(sA + row * 40 + kc) = v;
            }
            {
                const int kk = tid >> 4, nc = (tid & 15) * 8;
                const float* wp = W + (size_t)(k0 + kk) * ldw + n0 + nc;
                const float4 a = *(const float4*)wp, b = *(const float4*)(wp + 4);
                sB[(nc + 0) * 40 + kk] = (u16)f2bf(a.x); sB[(nc + 1) * 40 + kk] = (u16)f2bf(a.y); sB[(nc + 2) * 40 + kk] = (u16)f2bf(a.z); sB[(nc + 3) * 40 + kk] = (u16)f2bf(a.w);
                sB[(nc + 4) * 40 + kk] = (u16)f2bf(b.x); sB[(nc + 5) * 40 + kk] = (u16)f2bf(b.y); sB[(nc + 6) * 40 + kk] = (u16)f2bf(b.z); sB[(nc + 7) * 40 + kk] = (u16)f2bf(b.w);
                if (DUAL) {
                    const float4 c = *(const float4*)(wp + dualoff), d = *(const float4*)(wp + dualoff + 4);
                    sB2[(nc + 0) * 40 + kk] = (u16)f2bf(c.x); sB2[(nc + 1) * 40 + kk] = (u16)f2bf(c.y); sB2[(nc + 2) * 40 + kk] = (u16)f2bf(c.z); sB2[(nc + 3) * 40 + kk] = (u16)f2bf(c.w);
                    sB2[(nc + 4) * 40 + kk] = (u16)f2bf(d.x); sB2[(nc + 5) * 40 + kk] = (u16)f2bf(d.y); sB2[(nc + 6) * 40 + kk] = (u16)f2bf(d.z); sB2[(nc + 7) * 40 + kk] = (u16)f2bf(d.w);
                }
            }
            __syncthreads();
            bf16x8 af[4], bfr[2], bfr2[2];
#pragma unroll
            for (int mi = 0; mi < 4; ++mi) af[mi] = *(const bf16x8*)(sA + (wm * 64 + mi * 16 + r16) * 40 + quad * 8);
#pragma unroll
            for (int ni = 0; ni < 2; ++ni) {
                bfr[ni] = *(const bf16x8*)(sB + (wn * 32 + ni * 16 + r16) * 40 + quad * 8);
                if (DUAL) bfr2[ni] = *(const bf16x8*)(sB2 + (wn * 32 + ni * 16 + r16) * 40 + quad * 8);
            }
#pragma unroll
            for (int mi = 0; mi < 4; ++mi)
#pragma unroll
                for (int ni = 0; ni < 2; ++ni) {
                    acc[mi][ni] = __builtin_amdgcn_mfma_f32_16x16x32_bf16(af[mi], bfr[ni], acc[mi][ni], 0, 0, 0);
                    if (DUAL) acc2[mi][ni] = __builtin_amdgcn_mfma_f32_16x16x32_bf16(af[mi], bfr2[ni], acc2[mi][ni], 0, 0, 0);
                }
            __syncthreads();
        }
#pragma unroll
        for (int mi = 0; mi < 4; ++mi)
#pragma unroll
            for (int ni = 0; ni < 2; ++ni)
#pragma unroll
                for (int j = 0; j < 4; ++j) {
                    const int row = m0 + wm * 64 + mi * 16 + quad * 4 + j, col = n0 + wn * 32 + ni * 16 + r16;
                    epi(row, col, acc[mi][ni][j], DUAL ? acc2[mi][ni][j] : 0.f);
                }
    }
}

struct EpiStore { u16* O; int ld; DEV void operator()(int r, int c, float v, float) const { O[(size_t)r * ld + c] = (u16)f2bf(v); } };
struct EpiStoreOdd { u16* Q; u16* Z;
    DEV void operator()(int r, int c, float v, float) const { if (c < 1536) Q[(size_t)r * 1536 + c] = (u16)f2bf(v); else Z[(size_t)r * ZDW + (c - 1536)] = (u16)f2bf(v); } };
struct EpiResid { PPtr p; const float* gate;
    DEV void operator()(int r, int c, float v, float) const { float* xr = xrow_ptr(p, r); xr[c] += gate[mod_idx(r) * 6144 + c] * v; } };
struct EpiSwiglu { u16* H;
    DEV void operator()(int r, int c, float g, float u) const { H[(size_t)r * FFH + c] = (u16)f2bf(g * sigmoidf_(g) * u); } };


namespace pg8 {
#define PG8_LAS __attribute__((address_space(3)))
typedef unsigned short bf16_t;
typedef short bf16x8 __attribute__((ext_vector_type(8)));
typedef float f32x4 __attribute__((ext_vector_type(4)));
typedef unsigned u32x4 __attribute__((ext_vector_type(4)));
constexpr int BM = 256, BK = 64, HALF = 128, HTB = HALF * BK * 2  , STAGE_BYTES = 8 * HTB, NXCD = 8, WGM = 8;

__host__ __device__ __forceinline__ int lds_byte(int r, int c) { const int st = (r >> 4) * 2 + (c >> 5), rr = r & 15, cc = c & 31, ob = rr * 64 + cc * 2; return st * 1024 + (ob ^ (((ob >> 9) & 1) << 5)); }
__host__ __device__ __forceinline__ void stage_rc(int b, int& R, int& C) { const int st = b / 1024, sb = b % 1024, swz = sb ^ (((sb >> 9) & 1) << 5); R = (st >> 1) * 16 + swz / 64; C = (st & 1) * 32 + (swz % 64) / 2; }
__host__ __device__ __forceinline__ int perm32(int rho) { const int n = rho >> 4, i = rho & 15; return 8 * (i >> 2) + 4 * n + (i & 3); }

struct Unit { int pm, pn; };
struct Gemm { const bf16_t* A; const bf16_t* Bt; int M, N, K; };

struct StaticOrder {
    int nM, nN, nwg, G, c;
    __host__ __device__ void init(int M, int N, int G_, int c_) { nM = M / BM; nN = N / BM; nwg = nM * nN; G = G_; c = c_; }
    __host__ __device__ bool next(int i, Unit& u) const {
        const long L = (long)i * G + c; if (L >= nwg) return false;
        int wgid = (int)L; { const int q = nwg / NXCD, r = nwg % NXCD, xcd = wgid % NXCD, off = wgid / NXCD; wgid = (xcd < r ? xcd * (q + 1) : r * (q + 1) + (xcd - r) * q) + off; }
        const int nig = WGM * nN, gid = wgid / nig, fm = gid * WGM, gsz = (nM - fm) < WGM ? (nM - fm) : WGM;
        u.pm = fm + ((wgid % nig) % gsz); u.pn = (wgid % nig) / gsz; return true;
    }
    __device__ __forceinline__ void a_ready(const Unit&) const {}
    __device__ __forceinline__ void done(const Unit&) const {}
};
__device__ __forceinline__ unsigned cvt_pk_bf16(float lo, float hi) { unsigned r; asm volatile("v_cvt_pk_bf16_f32 %0, %1, %2" : "=v"(r) : "v"(lo), "v"(hi)); return r; }
template <class Epi, class Sched, bool ALIGN_EPI = false, bool SP2 = false>
__device__ __forceinline__ void gemm_phase(PG8_LAS unsigned char* lds, const Gemm g, const Sched& S, const Epi& E) {
    const int tid = tidx(), wid = __builtin_amdgcn_readfirstlane(tid >> 6), lane = tid & 63, wr = wid >> 2, wc = wid & 3, fr = lane & 15, fq = lane >> 4;
    const int K = g.K, nt = K / BK;
    unsigned voffA[2], voffB[2];
#pragma unroll
    for (int i = 0; i < 2; ++i) { int R, C; stage_rc(tid * 16 + i * 8192, R, C); const int Rb = Epi::PERM ? ((R & ~31) + perm32(R & 31)) : R;
        voffA[i] = (unsigned)(R * K + C) * 2u; voffB[i] = (unsigned)(Rb * K + C) * 2u; }
    const size_t kstep = (size_t)(BK * 2);
    const size_t hstep = (size_t)HALF * K * 2;
    const size_t tstep = 2 * hstep;
    const unsigned ldsw = (unsigned)wid * 1024u;
    const int aoff = lds_byte(wr * 64 + fr, fq * 8), boff = lds_byte(wc * 32 + fr, fq * 8);
#define PG8_SA(b, h) (((b) * 2 + (h)) * HTB)
#define PG8_SB(b, h) ((4 + (b) * 2 + (h)) * HTB)
#define PG8_STAGE(bufoff, gbase, voff) do { _Pragma("unroll") for (int _i = 0; _i < 2; ++_i) \
        __builtin_amdgcn_global_load_lds((const unsigned*)((const char*)(gbase) + (voff)[_i]), (PG8_LAS unsigned*)(lds + (bufoff) + ldsw + _i * 8192), 16, 0, 0); } while (0)
#define PG8_LDA(dst, b, h) do { _Pragma("unroll") for (int m = 0; m < 4; ++m) _Pragma("unroll") for (int k = 0; k < 2; ++k) dst[m][k] = *(const PG8_LAS bf16x8*)(lds + PG8_SA(b, h) + aoff + m * 2048 + k * 1024); } while (0)
#define PG8_LDB(dst, b, h) do { _Pragma("unroll") for (int n = 0; n < 2; ++n) _Pragma("unroll") for (int k = 0; k < 2; ++k) dst[n][k] = *(const PG8_LAS bf16x8*)(lds + PG8_SB(b, h) + boff + n * 2048 + k * 1024); } while (0)
#define PG8_MMA(ai, bj, At, Bt) do { __builtin_amdgcn_s_setprio(1); _Pragma("unroll") for (int m = 0; m < 4; ++m) _Pragma("unroll") for (int n = 0; n < 2; ++n) _Pragma("unroll") for (int k = 0; k < 2; ++k) \
        acc[ai][bj][m][n] = __builtin_amdgcn_mfma_f32_16x16x32_bf16(Bt[n][k], At[m][k], acc[ai][bj][m][n], 0, 0, 0); __builtin_amdgcn_s_setprio(0); } while (0)
#define PG8_WAIT_V(n) asm volatile("s_waitcnt vmcnt(" #n ")" ::: "memory")
#define PG8_WAIT_L(n) asm volatile("s_waitcnt lgkmcnt(" #n ")" ::: "memory")
#define PG8_BAR __builtin_amdgcn_s_barrier()
#define PG8_SCHED __builtin_amdgcn_sched_barrier(0)
    Unit cur, nxt; int ui = 0;
    if (!S.next(0, cur)) return;
    f32x4 acc[2][2][4][2];
#pragma unroll
    for (int a = 0; a < 2; ++a)
#pragma unroll
        for (int b = 0; b < 2; ++b)
#pragma unroll
            for (int m = 0; m < 4; ++m)
#pragma unroll
                for (int n = 0; n < 2; ++n) acc[a][b][m][n] = (f32x4){0.f, 0.f, 0.f, 0.f};
    bf16x8 At[4][2], B0[2][2], B1[2][2];
    const char* cA = (const char*)g.A + (size_t)cur.pm * tstep; const char* cB = (const char*)g.Bt + (size_t)cur.pn * tstep;
    S.a_ready(cur);
    if constexpr (SP2) {
        PG8_STAGE(PG8_SB(0, 0), cB, voffB); PG8_STAGE(PG8_SB(0, 1), cB + hstep, voffB); PG8_STAGE(PG8_SA(0, 0), cA, voffA); PG8_STAGE(PG8_SA(0, 1), cA + hstep, voffA);
        if (wr == 1) PG8_BAR;
        PG8_WAIT_V(2); PG8_BAR;
        PG8_STAGE(PG8_SB(1, 0), cB + kstep, voffB); PG8_STAGE(PG8_SA(1, 0), cA + kstep, voffA); PG8_STAGE(PG8_SB(1, 1), cB + hstep + kstep, voffB);
        PG8_WAIT_V(6); PG8_BAR;
    } else {
        PG8_STAGE(PG8_SB(0, 0), cB, voffB); PG8_STAGE(PG8_SA(0, 0), cA, voffA); PG8_STAGE(PG8_SB(0, 1), cB + hstep, voffB); PG8_STAGE(PG8_SA(0, 1), cA + hstep, voffA);
        if (wr == 1) PG8_BAR;
        PG8_WAIT_V(4); PG8_BAR;
        PG8_STAGE(PG8_SB(1, 0), cB + kstep, voffB); PG8_STAGE(PG8_SA(1, 0), cA + kstep, voffA); PG8_STAGE(PG8_SB(1, 1), cB + hstep + kstep, voffB);
        PG8_WAIT_V(6); PG8_BAR;
    }
    for (;;) {
        const bool has_next = S.next(ui + 1, nxt);
        const char* nA = has_next ? (const char*)g.A + (size_t)nxt.pm * tstep : cA; const char* nB = has_next ? (const char*)g.Bt + (size_t)nxt.pn * tstep : cB;
        for (int t = 0; t < nt; t += 2) {
            const bool last = (t == nt - 2);
            const char* a1 = cA + (size_t)(t + 1) * kstep;
            const char* a2 = last ? nA : cA + (size_t)(t + 2) * kstep; const char* b2 = last ? nB : cB + (size_t)(t + 2) * kstep;
            const char* a3 = a2 + kstep; const char* b3 = b2 + kstep;
            if (last && has_next) S.a_ready(nxt);
            if constexpr (SP2) {
            PG8_LDB(B0, 0, 0); PG8_LDB(B1, 0, 1); PG8_SCHED; PG8_LDA(At, 0, 0); PG8_STAGE(PG8_SA(1, 1), a1 + hstep, voffA);
            PG8_WAIT_V(8); PG8_WAIT_L(0); PG8_BAR; PG8_MMA(0, 0, At, B0); PG8_MMA(0, 1, At, B1); PG8_BAR; PG8_SCHED;
            PG8_LDA(At, 0, 1); PG8_STAGE(PG8_SB(0, 0), b2, voffB); PG8_STAGE(PG8_SB(0, 1), b2 + hstep, voffB); PG8_STAGE(PG8_SA(0, 0), a2, voffA);
            PG8_WAIT_V(8); PG8_WAIT_L(0); PG8_BAR; PG8_MMA(1, 0, At, B0); PG8_MMA(1, 1, At, B1); PG8_BAR; PG8_SCHED;
            PG8_LDB(B0, 1, 0); PG8_LDB(B1, 1, 1); PG8_SCHED; PG8_LDA(At, 1, 0); PG8_STAGE(PG8_SA(0, 1), a2 + hstep, voffA);
            PG8_WAIT_V(8); PG8_WAIT_L(0); PG8_BAR; PG8_MMA(0, 0, At, B0); PG8_MMA(0, 1, At, B1); PG8_BAR; PG8_SCHED;
            PG8_LDA(At, 1, 1); PG8_STAGE(PG8_SB(1, 0), b3, voffB); PG8_STAGE(PG8_SB(1, 1), b3 + hstep, voffB); PG8_STAGE(PG8_SA(1, 0), a3, voffA);
            PG8_WAIT_V(8); PG8_WAIT_L(0); PG8_BAR; PG8_MMA(1, 0, At, B0); PG8_MMA(1, 1, At, B1); PG8_BAR; PG8_SCHED;
            } else {
            PG8_LDB(B0, 0, 0); PG8_SCHED; PG8_LDA(At, 0, 0); PG8_STAGE(PG8_SA(1, 1), a1 + hstep, voffA);
            PG8_WAIT_L(8); PG8_BAR; PG8_WAIT_L(0); PG8_MMA(0, 0, At, B0); PG8_BAR; PG8_SCHED;
            PG8_LDB(B1, 0, 1); PG8_STAGE(PG8_SB(0, 0), b2, voffB);
            PG8_BAR; PG8_WAIT_L(0); PG8_MMA(0, 1, At, B1); PG8_BAR;
            PG8_LDA(At, 0, 1); PG8_STAGE(PG8_SA(0, 0), a2, voffA);
            PG8_BAR; PG8_WAIT_L(0); PG8_MMA(1, 0, At, B0); PG8_BAR; PG8_SCHED;
            PG8_STAGE(PG8_SB(0, 1), b2 + hstep, voffB);
            PG8_WAIT_V(6); PG8_BAR; PG8_MMA(1, 1, At, B1); PG8_BAR;
            PG8_LDB(B0, 1, 0); PG8_SCHED; PG8_LDA(At, 1, 0); PG8_STAGE(PG8_SA(0, 1), a2 + hstep, voffA);
            PG8_WAIT_L(8); PG8_BAR; PG8_WAIT_L(0); PG8_MMA(0, 0, At, B0); PG8_BAR; PG8_SCHED;
            PG8_LDB(B1, 1, 1); PG8_STAGE(PG8_SB(1, 0), b3, voffB);
            PG8_BAR; PG8_WAIT_L(0); PG8_MMA(0, 1, At, B1); PG8_BAR;
            PG8_LDA(At, 1, 1); PG8_STAGE(PG8_SA(1, 0), a3, voffA);
            PG8_BAR; PG8_WAIT_L(0); PG8_MMA(1, 0, At, B0); PG8_BAR; PG8_SCHED;
            PG8_STAGE(PG8_SB(1, 1), b3 + hstep, voffB);
            PG8_WAIT_V(6); PG8_BAR; PG8_MMA(1, 1, At, B1); PG8_BAR;
            }
        }
        if constexpr (ALIGN_EPI) { if (wr == 0) PG8_BAR; }
        if constexpr (!Epi::AFTER_DRAIN) { E(acc, cur, wr, wc, fr, fq); S.done(cur); }
        if (!has_next) break;
#pragma unroll
        for (int a = 0; a < 2; ++a)
#pragma unroll
            for (int b = 0; b < 2; ++b)
#pragma unroll
                for (int m = 0; m < 4; ++m)
#pragma unroll
                    for (int n = 0; n < 2; ++n) acc[a][b][m][n] = (f32x4){0.f, 0.f, 0.f, 0.f};
        cur = nxt; cA = nA; cB = nB; ++ui;
        if constexpr (ALIGN_EPI) { if (wr == 1) PG8_BAR; }
    }
    PG8_WAIT_V(0);
    if constexpr (!ALIGN_EPI) { if (wr == 0) PG8_BAR; }
    PG8_BAR;
    if constexpr (Epi::AFTER_DRAIN) { E.fused(acc, cur, wr, wc, fr, fq, lds, wid, lane); S.done(cur); }
#undef PG8_SA
#undef PG8_SB
#undef PG8_STAGE
#undef PG8_LDA
#undef PG8_LDB
#undef PG8_MMA
#undef PG8_WAIT_V
#undef PG8_WAIT_L
#undef PG8_BAR
#undef PG8_SCHED
}

struct EpiStoreT {
    static constexpr bool PERM = true, AFTER_DRAIN = false;
    bf16_t* O0; int ld0; int split; bf16_t* O1; int ld1;
    __device__ __forceinline__ void operator()(const f32x4 (&acc)[2][2][4][2], const Unit& u, int wr, int wc, int fr, int fq) const {
        const int row0 = u.pm * BM + wr * 64 + fr; int colt = u.pn * BM; bf16_t* base = O0; int ld = ld0;
        if (colt >= split) { base = O1; ld = ld1; colt -= split; }
        const int col0 = colt + wc * 32 + 8 * fq;
#pragma unroll
        for (int ai = 0; ai < 2; ++ai)
#pragma unroll
            for (int m = 0; m < 4; ++m) { bf16_t* rowp = base + (size_t)(row0 + ai * HALF + m * 16) * ld + col0;
#pragma unroll
                for (int bj = 0; bj < 2; ++bj) { const f32x4 v0 = acc[ai][bj][m][0], v1 = acc[ai][bj][m][1];
                    u32x4 w; w.x = cvt_pk_bf16(v0[0], v0[1]); w.y = cvt_pk_bf16(v0[2], v0[3]); w.z = cvt_pk_bf16(v1[0], v1[1]); w.w = cvt_pk_bf16(v1[2], v1[3]);
                    *(u32x4*)(rowp + bj * HALF) = w; } }
    }
};
struct EpiResidT {
    static constexpr bool PERM = true, AFTER_DRAIN = false;
    PPtr p; const float* gate;
    __device__ __forceinline__ void operator()(const f32x4 (&acc)[2][2][4][2], const Unit& u, int wr, int wc, int fr, int fq) const {
        float* xb = xrow_ptr(p, u.pm * BM); const float* g = gate + mod_idx(u.pm * BM) * 6144;
        const int col0 = u.pn * BM + wc * 32 + 8 * fq;
#pragma unroll
        for (int ai = 0; ai < 2; ++ai)
#pragma unroll
            for (int m = 0; m < 4; ++m) { float* xr = xb + (size_t)(ai * HALF + wr * 64 + m * 16 + fr) * DM;
#pragma unroll
                for (int bj = 0; bj < 2; ++bj) { const int col = col0 + bj * HALF; const f32x4 v0 = acc[ai][bj][m][0], v1 = acc[ai][bj][m][1];
                    const f32x4 g0 = *(const f32x4*)(g + col), g1 = *(const f32x4*)(g + col + 4);
                    f32x4 x0 = *(const f32x4*)(xr + col), x1 = *(const f32x4*)(xr + col + 4);
                    x0 += g0 * v0; x1 += g1 * v1;
                    *(f32x4*)(xr + col) = x0; *(f32x4*)(xr + col + 4) = x1; } }
    }
};
struct EpiSwigluT {
    static constexpr bool PERM = true, AFTER_DRAIN = false;
    bf16_t* H;
    __device__ __forceinline__ void operator()(const f32x4 (&acc)[2][2][4][2], const Unit& u, int wr, int wc, int fr, int fq) const {
        const int row0 = u.pm * BM + wr * 64 + fr; const int col0 = u.pn * BM + wc * 32 + 8 * fq;
#pragma unroll
        for (int ai = 0; ai < 2; ++ai)
#pragma unroll
            for (int m = 0; m < 4; ++m) { bf16_t* rowp = H + (size_t)(row0 + ai * HALF + m * 16) * FFH;
#pragma unroll
                for (int bj = 0; bj < 2; ++bj) { const f32x4 gt = acc[ai][bj][m][0], up = acc[ai][bj][m][1];
                    float h[4];
#pragma unroll
                    for (int j = 0; j < 4; ++j) h[j] = gt[j] * sigmoidf_(gt[j]) * up[j];
                    uint2 w; w.x = cvt_pk_bf16(h[0], h[1]); w.y = cvt_pk_bf16(h[2], h[3]);
                    *(uint2*)(rowp + ((col0 + bj * HALF) >> 1)) = w; } }
    }
};

struct EpiLoraT {
    static constexpr bool PERM = true, AFTER_DRAIN = false;
    float* DEC; bf16_t* KD; bf16_t* BQ; bf16_t* G; const bf16_t* KK; const bf16_t* ZDb;
    const float* w0; const float* a0; const float* ka; const float* muk;
    template <int TYPE>
    __device__ __forceinline__ void one(const f32x4 v, int r, int c, int d) const {
        if (TYPE == 0) {
            const float4 wa = *(const float4*)(w0 + d * 512 + c);
            const float ww[4] = {wa.x, wa.y, wa.z, wa.w};
            float o[4];
#pragma unroll
            for (int e = 0; e < 4; ++e) { const float x = -(ww[e] + v[e]); const float sp = x > 20.f ? x : log1pf(expf(x)); o[e] = expf(-expf(-sp - 0.5f)); }
            *(float4*)(DEC + ((size_t)r * 2 + d) * 512 + c) = (float4){o[0], o[1], o[2], o[3]};
        } else if (TYPE == 1) {
            const float4 aa = *(const float4*)(a0 + d * 512 + c), ka0 = *(const float4*)(ka + c), m0 = *(const float4*)(muk + c);
            const float a0v[4] = {aa.x, aa.y, aa.z, aa.w}, kav[4] = {ka0.x, ka0.y, ka0.z, ka0.w}, mm[4] = {m0.x, m0.y, m0.z, m0.w};
            const bool lat = r < SEQ; const int lo = lat ? 0 : SEQ, hi = lat ? SEQ : RPB;
            const bf16_t* zc = ZDb + (size_t)r * ZDW + 512 + c;
            const bool hp = r - 1 >= lo, hn = r + 1 < hi;
            const uint2 uz = *(const uint2*)zc, up = *(const uint2*)(hp ? zc - ZDW : zc), un = *(const uint2*)(hn ? zc + ZDW : zc), uk = *(const uint2*)(KK + (size_t)r * 512 + c);
            const float z[4] = {bflo(uz.x), bfhi(uz.x), bflo(uz.y), bfhi(uz.y)}, zp[4] = {bflo(up.x), bfhi(up.x), bflo(up.y), bfhi(up.y)};
            const float zn[4] = {bflo(un.x), bfhi(un.x), bflo(un.y), bfhi(un.y)}, kk[4] = {bflo(uk.x), bfhi(uk.x), bflo(uk.y), bfhi(uk.y)};
            const float fp = hp ? 0.5f : 0.f, fn = hn ? 0.5f : 0.f;
            float okd[4], obq[4];
#pragma unroll
            for (int e = 0; e < 4; ++e) {
                const float a = sigmoidf_(a0v[e] + v[e]);
                const float k = z[e] + ((fp * zp[e] + fn * zn[e]) - z[e]) * mm[e];
                okd[e] = k * (1.f + (a - 1.f) * kav[e]); obq[e] = kk[e] * a;
            }
            uint2 w1; w1.x = pk2(okd[0], okd[1]); w1.y = pk2(okd[2], okd[3]); *(uint2*)(KD + ((size_t)r * 2 + d) * 512 + c) = w1;
            uint2 w2; w2.x = pk2(obq[0], obq[1]); w2.y = pk2(obq[2], obq[3]); *(uint2*)(BQ + ((size_t)r * 2 + d) * 512 + c) = w2;
        } else {
            uint2 w; w.x = pk2(v[0], v[1]); w.y = pk2(v[2], v[3]); *(uint2*)(G + (size_t)r * 512 + c) = w;
        }
    }
    template <int TYPE>
    __device__ __forceinline__ void all(const f32x4 (&acc)[2][2][4][2], const Unit& u, int wr, int wc, int fr, int fq) const {
        const int d = (u.pn >> 1) & 1, cb = (u.pn & 1) * 256 + wc * 32 + 8 * fq;
#pragma unroll
        for (int ai = 0; ai < 2; ++ai)
#pragma unroll
            for (int m = 0; m < 4; ++m)
#pragma unroll
                for (int bj = 0; bj < 2; ++bj)
                {   const int r = u.pm * BM + ai * HALF + wr * 64 + m * 16 + fr, c = cb + bj * HALF;
                    one<TYPE>(acc[ai][bj][m][0], r, c, d); one<TYPE>(acc[ai][bj][m][1], r, c + 4, d); }
    }
    __device__ __forceinline__ void operator()(const f32x4 (&acc)[2][2][4][2], const Unit& u, int wr, int wc, int fr, int fq) const {
        const int type = u.pn >> 1;
        if (type < 2) all<0>(acc, u, wr, wc, fr, fq); else if (type < 4) all<1>(acc, u, wr, wc, fr, fq); else all<2>(acc, u, wr, wc, fr, fq);
    }
};
}

DEV void transpose_item(const float* W, int K, int N, u16* WT, int mode, float* scr, int item, int lane) {
    const int nblk = N / 32, kb = item / nblk, nb = item - kb * nblk, k0 = 64 * kb, n0 = 32 * nb;
#pragma unroll 8
    for (int i = 0; i < 32; ++i) { const int kk = 2 * i + (lane >> 5); scr[kk * 33 + (lane & 31)] = W[(size_t)(k0 + kk) * N + n0 + (lane & 31)]; }
    asm volatile("s_waitcnt lgkmcnt(0)" ::: "memory");
    const int c = lane & 7;
#pragma unroll
    for (int j = 0; j < 4; ++j) {
        const int n = (lane >> 3) + 8 * j; const float* sp = scr + (8 * c) * 33 + n;
        uint4 o; o.x = pk2(sp[0 * 33], sp[1 * 33]); o.y = pk2(sp[2 * 33], sp[3 * 33]); o.z = pk2(sp[4 * 33], sp[5 * 33]); o.w = pk2(sp[6 * 33], sp[7 * 33]);
        const int ns = n0 + n;
        int drow = ns;
        if (mode) { const int nn = ns >= FFH ? 1 : 0; const int g = ns - nn * FFH; drow = 8 * (g >> 2) + 4 * nn + (g & 3); }
        *(uint4*)(WT + (size_t)drow * K + k0 + 8 * c) = o;
    }
    asm volatile("s_waitcnt lgkmcnt(0)" ::: "memory");
}
constexpr size_t WB_IN = 0, WB_OUT = (size_t)3328 * 1024, WB_F1 = WB_OUT + (size_t)1024 * 1024, WB_F2 = WB_F1 + (size_t)5632 * 1024;
DEV void phase_wprep(PPtr p, int layer, char* lds) {
    const int tid = tidx(), lane = tid & 63, wave = tid >> 6, gw = blockIdx.x * NWAVE + wave, ngw = gridDim.x * NWAVE;
    float* scr = (float*)lds + wave * (64 * 33);
    u16* WB = (u16*)(p->ws + OFF_WB);
    const int li = layer >> 1, odd = layer & 1;
    const int nin = odd ? 3328 : 1536;
    const float* win = odd ? p->in[13] + (size_t)li * DM * 3328 : p->in[8] + (size_t)li * DM * 1536;
    const float* wout = (odd ? p->in[14] : p->in[9]) + (size_t)li * DM * DM;
    const float* wf1 = p->in[27] + (size_t)layer * DM * 5632; const float* wf2 = p->in[28] + (size_t)layer * FFH * DM;
    const int i0 = 16 * (nin / 32), i1 = i0 + 16 * 32, i2 = i1 + 16 * 176, i3 = i2 + 44 * 32;
    for (int it = gw; it < i3; it += ngw) {
        if (it < i0) transpose_item(win, DM, nin, WB + WB_IN, 0, scr, it, lane);
        else if (it < i1) transpose_item(wout, DM, DM, WB + WB_OUT, 0, scr, it - i0, lane);
        else if (it < i2) transpose_item(wf1, DM, 5632, WB + WB_F1, 1, scr, it - i1, lane);
        else transpose_item(wf2, FFH, DM, WB + WB_F2, 0, scr, it - i2, lane);
    }
}

#include <hip/hip_bf16.h>
#include <cmath>
namespace attn_body {
using bf16=__hip_bfloat16;
using bf16x8=__attribute__((ext_vector_type(8)))short;
using s16x4=__attribute__((ext_vector_type(4)))short;
using f32x16=__attribute__((ext_vector_type(16)))float;
using u32x4=__attribute__((ext_vector_type(4)))unsigned;
constexpr int D=64,PQ=1536,PO=1024,KROWS=16640,RPBA=16640;
constexpr int NW=8,QBLK=32,QB=QBLK*NW,KVBLK=64;
constexpr int ATTN_UNIT_ROWS=QB;
__device__ __forceinline__ int crow(int r,int hi){return (r&3)+8*(r>>2)+4*hi;}
#define SBAR() __builtin_amdgcn_sched_barrier(0)
__device__ __forceinline__ void cmask(f32x16&p0,f32x16&p1,int jb,int qrel,int hi){
  const float NEG=-INFINITY; int kb=64*jb+4*hi;
  #pragma unroll
  for(int r=0;r<16;++r){int kv=kb+(r&3)+8*(r>>2); if(kv>qrel)p0[r]=NEG; if(kv+32>qrel)p1[r]=NEG;}
}

constexpr int NSLOT=3, SLOTB=8192;
constexpr int LDS_K=0, LDS_V=NSLOT*SLOTB, LDS_WS=2*NSLOT*SLOTB, LDS_OST=LDS_WS+NW*64*4, LDS_BYTES=LDS_OST+NW*4096;
constexpr float C2=0.125f*1.4426950408889634f;
__device__ __forceinline__ void glds16(const void*gsrc,unsigned lds_dst){unsigned keep;
  asm volatile("s_mov_b32 %0, m0\n\ts_mov_b32 m0, %2\n\ts_nop 0\n\tglobal_load_lds_dwordx4 %1, off\n\ts_mov_b32 m0, %0":"=&s"(keep):"v"(gsrc),"s"(lds_dst):"memory");}
__device__ __forceinline__ float max3f(float a,float b,float c){float r;asm("v_max3_f32 %0, %1, %2, %3":"=v"(r):"v"(a),"v"(b),"v"(c));return r;}
__device__ __forceinline__ float max2f(float a,float b){float r;asm("v_max_f32_e32 %0, %1, %2":"=v"(r):"v"(a),"v"(b));return r;}
__device__ __forceinline__ float fadd_s(float a,float b){float r;asm("v_add_f32_e32 %0, %1, %2":"=v"(r):"v"(a),"v"(b));return r;}
__device__ __forceinline__ float fsub_s(float a,float b){float r;asm("v_sub_f32_e32 %0, %1, %2":"=v"(r):"v"(a),"v"(b));return r;}
typedef float f32x2_t __attribute__((ext_vector_type(2))); typedef __bf16 bf16x2_t __attribute__((ext_vector_type(2)));
__device__ __forceinline__ unsigned cvtpk_s(float lo,float hi){f32x2_t v={lo,hi};bf16x2_t b=__builtin_convertvector(v,bf16x2_t);return __builtin_bit_cast(unsigned,b);}
#define WAIT_BAR(N) asm volatile("s_waitcnt vmcnt(" #N ") lgkmcnt(0)\n\ts_barrier":::"memory")

__device__ __forceinline__ void qkt(f32x16&p0,f32x16&p1,const char*Kslot,const bf16x8*qr,const f32x16&negm,int r32,int hi){
  const char*kb=Kslot+hi*1024+r32*16;
  #pragma unroll
  for(int d0=0;d0<4;++d0){
    const bf16x8 b0=*reinterpret_cast<const bf16x8*>(kb+d0*2048);
    const bf16x8 b1=*reinterpret_cast<const bf16x8*>(kb+d0*2048+512);
    if(d0==0){p0=__builtin_amdgcn_mfma_f32_32x32x16_bf16(b0,qr[0],negm,0,0,0);p1=__builtin_amdgcn_mfma_f32_32x32x16_bf16(b1,qr[0],negm,0,0,0);}
    else{p0=__builtin_amdgcn_mfma_f32_32x32x16_bf16(b0,qr[d0],p0,0,0,0);p1=__builtin_amdgcn_mfma_f32_32x32x16_bf16(b1,qr[d0],p1,0,0,0);}}
}
typedef __attribute__((address_space(3))) const char* lds_cptr;
typedef short v4i16_t __attribute__((ext_vector_type(4)));
__device__ __forceinline__ void kload8(bf16x8*kf,lds_cptr kp){
  kf[0]=*(const __attribute__((address_space(3))) bf16x8*)(kp);      kf[1]=*(const __attribute__((address_space(3))) bf16x8*)(kp+512);
  kf[2]=*(const __attribute__((address_space(3))) bf16x8*)(kp+2048); kf[3]=*(const __attribute__((address_space(3))) bf16x8*)(kp+2560);
  kf[4]=*(const __attribute__((address_space(3))) bf16x8*)(kp+4096); kf[5]=*(const __attribute__((address_space(3))) bf16x8*)(kp+4608);
  kf[6]=*(const __attribute__((address_space(3))) bf16x8*)(kp+6144); kf[7]=*(const __attribute__((address_space(3))) bf16x8*)(kp+6656);
}
__device__ __forceinline__ void kload2(bf16x8*kf,lds_cptr kp,int j){ kf[2*j]=*(const __attribute__((address_space(3))) bf16x8*)(kp+j*2048); kf[2*j+1]=*(const __attribute__((address_space(3))) bf16x8*)(kp+j*2048+512); }
__device__ __forceinline__ s16x4 vtr(lds_cptr p){ return __builtin_bit_cast(s16x4,__builtin_amdgcn_ds_read_tr16_b64_v4i16((__attribute__((address_space(3))) v4i16_t*)p)); }
__device__ __forceinline__ float rowmax(const f32x16&p0,const f32x16&p1){
  float a=max3f(p0[0],p0[1],p1[0]),b=max3f(p0[2],p0[3],p1[1]);a=max3f(a,p1[2],p1[3]);
  #pragma unroll
  for(int r=4;r<16;r+=4){a=max3f(a,p0[r],p0[r+1]);b=max3f(b,p0[r+2],p0[r+3]);a=max3f(a,p1[r],p1[r+1]);b=max3f(b,p1[r+2],p1[r+3]);}
  const float m=max2f(a,b);
  auto rr=__builtin_amdgcn_permlane32_swap(__float_as_uint(m),__float_as_uint(m),false,false);
  return max2f(__uint_as_float(rr[0]),__uint_as_float(rr[1]));
}
__device__ __forceinline__ void pv(f32x16*o,int vb,bf16x8 pa0,bf16x8 pa1,bf16x8 pa2,bf16x8 pa3){
  #pragma unroll
  for(int d0=0;d0<2;++d0){s16x4 lo[4],hi[4];
    #pragma unroll
    for(int ks=0;ks<4;++ks){
      asm volatile("ds_read_b64_tr_b16 %0,%1 offset:%c2":"=&v"(lo[ks]):"v"(vb),"i"(d0*4096+ks*1024):"memory");
      asm volatile("ds_read_b64_tr_b16 %0,%1 offset:%c2":"=&v"(hi[ks]):"v"(vb),"i"(d0*4096+ks*1024+512):"memory");}
    asm volatile("s_waitcnt lgkmcnt(0)":::"memory");SBAR();
    #define PK(k) (bf16x8){lo[k][0],lo[k][1],lo[k][2],lo[k][3],hi[k][0],hi[k][1],hi[k][2],hi[k][3]}
    o[d0]=__builtin_amdgcn_mfma_f32_32x32x16_bf16(pa0,PK(0),o[d0],0,0,0);
    o[d0]=__builtin_amdgcn_mfma_f32_32x32x16_bf16(pa1,PK(1),o[d0],0,0,0);
    o[d0]=__builtin_amdgcn_mfma_f32_32x32x16_bf16(pa2,PK(2),o[d0],0,0,0);
    o[d0]=__builtin_amdgcn_mfma_f32_32x32x16_bf16(pa3,PK(3),o[d0],0,0,0);
    #undef PK
  }
}

#ifndef ATTN_STORE16
#define ATTN_STORE16(p,v) (*(u32x4*)(p)=(v))
#endif
template<int THRL> __device__ __forceinline__ void attn_unit(int b,int h,int qb,const bf16*Q,const bf16*__restrict__ K,const bf16*__restrict__ V,bf16*O,char*shm){
  const int tid=tidx(),lane=tid&63,r32=lane&31,hi=lane>>5; const int wid=__builtin_amdgcn_readfirstlane(tid>>6);
  const long rowbase=(long)b*RPBA; const int q0=qb*QB;
  const bf16*Qw=Q+(rowbase+q0+wid*QBLK)*PQ+h*D;
  const bf16*Kh=K+rowbase*PQ+(h>>2)*D,*Vh=V+rowbase*PQ+(h>>2)*D;
  const unsigned lds0=(unsigned)(uintptr_t)shm;
  float*wsf=(float*)(shm+LDS_WS)+wid*64;
  const bf16*ksrc=Kh+(long)lane*PQ+wid*8;
  const bf16*vsrc=Vh+(long)(16*(wid&3)+(lane>>2))*PQ+(wid>>2)*32+(lane&3)*8;
  const unsigned kdst=lds0+LDS_K+wid*1024, vdst=lds0+LDS_V+wid*1024;
  #define DMA_K(t,slot) glds16(ksrc+(long)(t)*KVBLK*PQ,(unsigned)__builtin_amdgcn_readfirstlane(kdst+(slot)))
  #define DMA_V(t,slot) glds16(vsrc+(long)(t)*KVBLK*PQ,(unsigned)__builtin_amdgcn_readfirstlane(vdst+(slot)))
  const int vb0=(int)(lds0+LDS_V)+((lane>>4)&1)*32+(lane&3)*8+(4*hi+((lane&15)>>2))*64;
  const char*Kbase=shm+LDS_K; bf16x8 kf[8];
  const lds_cptr shm3=(lds_cptr)shm; const lds_cptr kp0=shm3+LDS_K+hi*1024+r32*16; const lds_cptr vp0=shm3+LDS_V+((lane>>4)&1)*32+(lane&3)*8+(4*hi+((lane&15)>>2))*64;
  const int NT=KROWS/KVBLK;
  DMA_K(0,0);DMA_V(0,0);DMA_K(1,SLOTB);
  bf16x8 qr[4];
  #pragma unroll
  for(int d0=0;d0<4;++d0)qr[d0]=*reinterpret_cast<const bf16x8*>(&Qw[(long)r32*PQ+d0*16+hi*8]);
  float mhat=0.f,l_reg=0.f;f32x16 o[2];o[0]=f32x16{};o[1]=f32x16{};f32x16 negm=f32x16{};asm volatile("":"+v"(negm));
  const int qrel=wid*QBLK+r32;
  #define CMASK(P0,P1,t) do{}while(0)
  bool resc=false;
  #define START(P0,P1) do{ const float rm=rowmax(P0,P1); resc=false; \
    { const float dl=rm; mhat=fadd_s(mhat,dl); \
      _Pragma("unroll") for(int r=0;r<16;++r){P0[r]=fsub_s(P0[r],dl);P1[r]=fsub_s(P1[r],dl);} \
      _Pragma("unroll") for(int r=0;r<16;++r)negm[r]=-mhat; asm volatile("":"+v"(negm)); } \
    _Pragma("unroll") for(int r=0;r<16;++r)P0[r]=__builtin_amdgcn_exp2f(P0[r]); }while(0)
  #define RESC() do{ if(resc){ asm volatile("s_waitcnt lgkmcnt(0)":::"memory"); \
      _Pragma("unroll") for(int d_=0;d_<2;++d_) _Pragma("unroll") for(int r=0;r<16;++r)o[d_][r]*=wsf[crow(r,hi)]; } }while(0)
  f32x16 pA0,pA1,pB0,pB1;
  int sl_prev=0,sl_cur=0,sl_next=SLOTB;
  #define ROT() do{sl_prev=sl_cur;sl_cur=sl_next;sl_next=(sl_next==(NSLOT-1)*SLOTB)?0:sl_next+SLOTB;}while(0)
  DMA_K(2,2*SLOTB);
  WAIT_BAR(3);
  qkt(pA0,pA1,Kbase,qr,negm,r32,hi);asm volatile("s_nop 15\n\ts_nop 7":"+v"(pA0),"+v"(pA1));CMASK(pA0,pA1,0);
  START(pA0,pA1);
  _Pragma("unroll") for(int r=0;r<16;++r)pA1[r]=__builtin_amdgcn_exp2f(pA1[r]);
  WAIT_BAR(0);
  DMA_K(3,0);DMA_V(1,SLOTB);
  ROT();
  kload8(kf,kp0+sl_cur);
  WAIT_BAR(2);
  s16x4 vlo[8],vhi[8]; u32x4 pw0,pw1,pw2,pw3;
  #define PKW(P,B) cvtpk_s(P[B],P[B+1])
  #define PAF(k) __builtin_bit_cast(bf16x8,pw##k)
  #define VFR(i) (bf16x8){vlo[i][0],vlo[i][1],vlo[i][2],vlo[i][3],vhi[i][0],vhi[i][1],vhi[i][2],vhi[i][3]}
  #define PIN(x) asm volatile("":"+v"(x))
  #define MX3(a,b,c) __builtin_fmaxf(__builtin_fmaxf((a),(b)),(c))
  #define GAPA(MF,A0,A1,A2,A3,W0,W1,PW) do{ MF; sacc+=A0; sacc+=A1; sacc+=A2; sacc+=A3; PIN(sacc); W0; W1; PIN(PW); SBAR(); }while(0)
  #define EX(v) __builtin_amdgcn_exp2f(v)
  #define GAPB(MF,X,B) do{ MF; X[B]=EX(X[B]); X[B+1]=EX(X[B+1]); X[B+2]=EX(X[B+2]); X[B+3]=EX(X[B+3]); PIN(X); SBAR(); }while(0)
  #define VRD(i) do{ vlo[i]=vtr(vp_+(((i)>>2)*4096+((i)&3)*1024)); vhi[i]=vtr(vp_+(((i)>>2)*4096+((i)&3)*1024+512)); }while(0)
  #define KRD(G,j) do{ if(G){ kload2(kf,kp0+sl_next,j); SBAR(); } }while(0)
  #define STEP(C0,C1,P0,P1,t,GK,GV,GL) do{ SBAR(); \
    const lds_cptr vp_=vp0+sl_prev; \
    VRD(0); SBAR(); float sacc=(P0[0]+P0[1]); \
    GAPA(C0=__builtin_amdgcn_mfma_f32_32x32x16_bf16(kf[0],qr[0],negm,0,0,0), P0[2],P0[3],P0[4],P0[5],     pw0[0]=PKW(P0,0), pw0[1]=PKW(P0,2), pw0); \
    VRD(4); SBAR(); GAPA(C1=__builtin_amdgcn_mfma_f32_32x32x16_bf16(kf[1],qr[0],negm,0,0,0), P0[6],P0[7],P0[8],P0[9],     pw0[2]=PKW(P0,4), pw0[3]=PKW(P0,6), pw0); \
    VRD(1); SBAR(); GAPA(C0=__builtin_amdgcn_mfma_f32_32x32x16_bf16(kf[2],qr[1],C0,0,0,0),   P0[10],P0[11],P0[12],P0[13], pw1[0]=PKW(P0,8), pw1[1]=PKW(P0,10), pw1); \
    VRD(5); SBAR(); GAPA(C1=__builtin_amdgcn_mfma_f32_32x32x16_bf16(kf[3],qr[1],C1,0,0,0),   P0[14],P0[15],P1[0],P1[1],   pw1[2]=PKW(P0,12),pw1[3]=PKW(P0,14), pw1); \
    VRD(2); SBAR(); GAPA(C0=__builtin_amdgcn_mfma_f32_32x32x16_bf16(kf[4],qr[2],C0,0,0,0),   P1[2],P1[3],P1[4],P1[5],     pw2[0]=PKW(P1,0), pw2[1]=PKW(P1,2), pw2); \
    VRD(6); SBAR(); GAPA(C1=__builtin_amdgcn_mfma_f32_32x32x16_bf16(kf[5],qr[2],C1,0,0,0),   P1[6],P1[7],P1[8],P1[9],     pw2[2]=PKW(P1,4), pw2[3]=PKW(P1,6), pw2); \
    VRD(3); SBAR(); GAPA(C0=__builtin_amdgcn_mfma_f32_32x32x16_bf16(kf[6],qr[3],C0,0,0,0),   P1[10],P1[11],P1[12],P1[13], pw3[0]=PKW(P1,8), pw3[1]=PKW(P1,10), pw3); \
    VRD(7); SBAR(); GAPA(C1=__builtin_amdgcn_mfma_f32_32x32x16_bf16(kf[7],qr[3],C1,0,0,0),   P1[14],P1[15],0.f,0.f,       pw3[2]=PKW(P1,12),pw3[3]=PKW(P1,14), pw3); \
    l_reg+=sacc; \
    if(GK){DMA_K((t)+3,sl_cur);} if(GV){DMA_V((t)+1,sl_next);} \
    CMASK(C0,C1,t); \
    { float a=MX3(C0[0],C0[1],C1[0]),b=MX3(C0[2],C0[3],C1[1]); a=MX3(a,C1[2],C1[3]); \
      _Pragma("unroll") for(int r=4;r<16;r+=4){a=MX3(a,C0[r],C0[r+1]);b=MX3(b,C0[r+2],C0[r+3]);a=MX3(a,C1[r],C1[r+1]);b=MX3(b,C1[r+2],C1[r+3]);} \
      float rm=__builtin_fmaxf(a,b); { auto rr=__builtin_amdgcn_permlane32_swap(__float_as_uint(rm),__float_as_uint(rm),false,false); rm=__builtin_fmaxf(__uint_as_float(rr[0]),__uint_as_float(rr[1])); } \
      resc=false; \
      if(__builtin_expect(__any(rm>(float)THRL),0)){ const float dl=__builtin_fmaxf(rm,0.f); mhat+=dl; \
        _Pragma("unroll") for(int r=0;r<16;++r){C0[r]-=dl;C1[r]-=dl;} \
        _Pragma("unroll") for(int r=0;r<16;++r)negm[r]=-mhat; asm volatile("":"+v"(negm)); \
        const float f=__builtin_amdgcn_exp2f(-dl); l_reg*=f; if(hi==0)wsf[r32]=f; resc=true; } } \
    SBAR(); \
    GAPB(o[0]=__builtin_amdgcn_mfma_f32_32x32x16_bf16(PAF(0),VFR(0),o[0],0,0,0), C0,0); \
    GAPB(o[1]=__builtin_amdgcn_mfma_f32_32x32x16_bf16(PAF(0),VFR(4),o[1],0,0,0), C0,4); \
    KRD(GL,0); GAPB(o[0]=__builtin_amdgcn_mfma_f32_32x32x16_bf16(PAF(1),VFR(1),o[0],0,0,0), C0,8); \
    KRD(GL,1); GAPB(o[1]=__builtin_amdgcn_mfma_f32_32x32x16_bf16(PAF(1),VFR(5),o[1],0,0,0), C0,12); \
    KRD(GL,2); GAPB(o[0]=__builtin_amdgcn_mfma_f32_32x32x16_bf16(PAF(2),VFR(2),o[0],0,0,0), C1,0); \
    KRD(GL,3); GAPB(o[1]=__builtin_amdgcn_mfma_f32_32x32x16_bf16(PAF(2),VFR(6),o[1],0,0,0), C1,4); \
    GAPB(o[0]=__builtin_amdgcn_mfma_f32_32x32x16_bf16(PAF(3),VFR(3),o[0],0,0,0), C1,8); \
    GAPB(o[1]=__builtin_amdgcn_mfma_f32_32x32x16_bf16(PAF(3),VFR(7),o[1],0,0,0), C1,12); \
    }while(0)
  int t=1;
  #undef CMASK
  #define CMASK(P0,P1,t) do{}while(0)
  for(;t+5<NT;t+=2){
    STEP(pB0,pB1,pA0,pA1,t,true,true,true);     WAIT_BAR(2); RESC(); ROT();
    STEP(pA0,pA1,pB0,pB1,t+1,true,true,true);   WAIT_BAR(2); RESC(); ROT();
  }
  #undef CMASK
  #define CMASK(P0,P1,t) do{}while(0)
  #define ENDW(tt) do{ if((tt)+3<NT){WAIT_BAR(2);} else if((tt)+2<NT){WAIT_BAR(1);} else {WAIT_BAR(0);} }while(0)
  for(;t+1<NT;t+=2){
    STEP(pB0,pB1,pA0,pA1,t,(t+3<NT),(t+1<NT),(t+1<NT));       ENDW(t);   RESC(); ROT();
    STEP(pA0,pA1,pB0,pB1,t+1,(t+4<NT),(t+2<NT),(t+2<NT));     ENDW(t+1); RESC(); ROT();
  }
  STEP(pB0,pB1,pA0,pA1,NT-1,false,false,false); RESC();
  { float sacc=pB0[0]+pB0[1]; _Pragma("unroll") for(int r=2;r<16;++r)sacc+=pB0[r]; _Pragma("unroll") for(int r=0;r<16;++r)sacc+=pB1[r]; l_reg+=sacc;
    pw0=(u32x4){PKW(pB0,0),PKW(pB0,2),PKW(pB0,4),PKW(pB0,6)};pw1=(u32x4){PKW(pB0,8),PKW(pB0,10),PKW(pB0,12),PKW(pB0,14)};pw2=(u32x4){PKW(pB1,0),PKW(pB1,2),PKW(pB1,4),PKW(pB1,6)};pw3=(u32x4){PKW(pB1,8),PKW(pB1,10),PKW(pB1,12),PKW(pB1,14)};
    SBAR(); pv(o,vb0+sl_cur,PAF(0),PAF(1),PAF(2),PAF(3)); }
  #undef PKW
  #undef PAF
  #undef VFR
  #undef PIN
  #undef MX3
  #undef GAPA
  #undef GAPB
  #undef EX
  #undef VRD
  #undef KRD
  #undef STEP
  #undef ENDW
  {auto rr=__builtin_amdgcn_permlane32_swap(__float_as_uint(l_reg),__float_as_uint(l_reg),false,false);l_reg=__uint_as_float(rr[0])+__uint_as_float(rr[1]);}
  if(hi==0)wsf[32+r32]=l_reg;asm volatile("s_waitcnt lgkmcnt(0)":::"memory");
  float rli[16];
  #pragma unroll
  for(int r=0;r<16;++r)rli[r]=__builtin_amdgcn_rcpf(wsf[32+crow(r,hi)]);
  bf16*Ow=O+(rowbase+q0+wid*QBLK)*PO+h*D;
  { bf16*stg=(bf16*)(shm+LDS_OST)+wid*2048;
    #pragma unroll
    for(int r=0;r<16;++r){const int orow=crow(r,hi);
      #pragma unroll
      for(int d0=0;d0<2;++d0)stg[orow*64+d0*32+r32]=__float2bfloat16(o[d0][r]*rli[r]);}
    asm volatile("s_waitcnt lgkmcnt(0)":::"memory");
    #pragma unroll
    for(int i=0;i<4;++i){const int row=i*8+(lane>>3),ch=lane&7; const u32x4 v=*(const u32x4*)(stg+row*64+ch*8); ATTN_STORE16(Ow+(long)row*PO+ch*8,v);} }
  asm volatile("s_waitcnt lgkmcnt(0)\n\ts_barrier":::"memory");
  #undef DMA_K
  #undef DMA_V
  #undef CMASK
  #undef START
  #undef RESC
  #undef ROT
}
constexpr int ATTN_LDS_BYTES=LDS_BYTES;
#undef SBAR
#undef WAIT_BAR
}

DEV void phase_even_post(PPtr p, int li) {
    const int lane = tidx() & 63, gw = blockIdx.x * NWAVE + (tidx() >> 6), ngw = gridDim.x * NWAVE;
    u16* RAW = (u16*)(p->ws + OFF_RAW);
    const float* qg = p->in[10] + li * 64; const float* kg = p->in[11] + li * 64;
    const int half = lane >> 5, i = lane & 31;
    const float inv = powf(10000.f, -(float)(i & 15) / 16.f);
    for (int m = gw; m < MROWS; m += ngw) {
        const int b = m / RPB, q = m - b * RPB;
        float cs = 1.f, sn = 0.f;
        if (q < SEQ) { const float pos = (i < 16) ? (float)(q >> 6) : (float)(q & 63); const float ang = pos * inv; sn = sinf(ang); cs = cosf(ang); }
        u16* row = RAW + (size_t)m * 1536;
        for (int hs = 0; hs < 20; hs += 2) {
            const int s = hs + half; int c0; const float* gn = nullptr;
            if (s < 8) { c0 = s * 64; gn = qg; } else if (s < 10) { c0 = 512 + (s - 8) * 64; gn = kg; } else if (s < 18) { c0 = 768 + (s - 10) * 64; } else { c0 = 1280 + (s - 18) * 64; }
            float v1 = bf2f(row[c0 + i]), v2 = bf2f(row[c0 + i + 32]);
            if (hs < 10) {
                float ss = v1 * v1 + v2 * v2;
#pragma unroll
                for (int o = 1; o < 32; o <<= 1) ss += __shfl_xor(ss, o);
                const float rs = rsqrtf(ss * (1.f / 64.f) + 1e-6f);
                v1 *= rs * gn[i]; v2 *= rs * gn[i + 32];
            }
            float o1 = v1 * cs - v2 * sn, o2 = v1 * sn + v2 * cs;
            if (hs < 8 && q < SEQ) { o1 *= attn_body::C2; o2 *= attn_body::C2; }
            row[c0 + i] = (u16)f2bf(o1); row[c0 + i + 32] = (u16)f2bf(o2);
        }
    }
}

template <int mode, bool qctx>
DEV void attn_wave(const u16* QB, int pitch, int qcol, int kcol, int vcol, u16* AO, int ocol,
                   int b, int hk, int blk, const float* sinkp, const float* rpb, u16* sV) {
    const int lane = tidx() & 63, qi = lane & 15, quad = lane >> 4;
    const bool gqa = mode < 2;
    const size_t rowb = (size_t)b * RPB;
    const float SCL = 0.125f * LOG2E;
    int qtok[4], qhead[4]; bf16x8 qf[4][2];
#pragma unroll
    for (int i = 0; i < 4; ++i) {
        qtok[i] = gqa ? blk * 16 + qi : blk * 64 + i * 16 + qi; qhead[i] = gqa ? hk * 4 + i : hk;
        const size_t m = rowb + (qctx ? SEQ : 0) + qtok[i];
        const u16* qp = QB + m * pitch + qcol + qhead[i] * 64 + quad * 8;
        qf[i][0] = *(const bf16x8*)qp; qf[i][1] = *(const bf16x8*)(qp + 32);
    }
    f32x4 o[4][4]; float mrun[4], lrun[4];
#pragma unroll
    for (int i = 0; i < 4; ++i) {
#pragma unroll
        for (int d = 0; d < 4; ++d) o[i][d] = (f32x4){0.f, 0.f, 0.f, 0.f};
        if (mode == 1) { mrun[i] = sinkp[qhead[i]] * LOG2E; lrun[i] = (quad == 0) ? 1.f : 0.f; } else { mrun[i] = -1e30f; lrun[i] = 0.f; }
    }
    const u16* Kb = QB + kcol + hk * 64; const u16* Vb = QB + vcol + hk * 64;
    int n_local, ustart, rs = 0;
    if (qctx) { n_local = 0; ustart = 0; }
    else if (mode == 0) { n_local = RPB / 32; ustart = 0; }
    else if (mode == 1) { n_local = 9; ustart = blk * 16 - 128; }
    else { rs = min(max(blk - 4, 0), 248); n_local = 16; ustart = rs * 64; }
    const int n_ctx = (mode == 0 && !qctx) ? 0 : 8;
    for (int tt = 0; tt < n_local + n_ctx; ++tt) {
        const bool loc = tt < n_local;
        const int u0 = loc ? ustart + 32 * tt : SEQ + 32 * (tt - n_local);
        const bool masked = loc && mode != 0;
        bf16x8 kf[2][2];
#pragma unroll
        for (int kt = 0; kt < 2; ++kt) {
            const int u = min(max(u0 + kt * 16 + qi, 0), RPB - 1);
            const u16* kp = Kb + (rowb + u) * pitch + quad * 8;
            kf[kt][0] = *(const bf16x8*)kp; kf[kt][1] = *(const bf16x8*)(kp + 32);
        }
#pragma unroll
        for (int c = 0; c < 4; ++c) {
            const int idx = c * 64 + lane, key = idx >> 3, dc = idx & 7;
            const int u = min(max(u0 + key, 0), RPB - 1);
            const uint4 v = *(const uint4*)(Vb + (rowb + u) * pitch + dc * 8);
            *(uint4*)(sV + key * 72 + dc * 8) = v;
        }
        bf16x8 vf[4];
#pragma unroll
        for (int dt = 0; dt < 4; ++dt)
#pragma unroll
            for (int jj = 0; jj < 8; ++jj) {
                const int key = (jj < 4) ? quad * 4 + jj : 16 + quad * 4 + (jj - 4);
                vf[dt][jj] = (short)sV[key * 72 + dt * 16 + qi];
            }
#pragma unroll
        for (int i = 0; i < 4; ++i) {
            f32x4 s0 = (f32x4){0.f, 0.f, 0.f, 0.f}, s1 = (f32x4){0.f, 0.f, 0.f, 0.f};
            s0 = __builtin_amdgcn_mfma_f32_16x16x32_bf16(kf[0][0], qf[i][0], s0, 0, 0, 0);
            s0 = __builtin_amdgcn_mfma_f32_16x16x32_bf16(kf[0][1], qf[i][1], s0, 0, 0, 0);
            s1 = __builtin_amdgcn_mfma_f32_16x16x32_bf16(kf[1][0], qf[i][0], s1, 0, 0, 0);
            s1 = __builtin_amdgcn_mfma_f32_16x16x32_bf16(kf[1][1], qf[i][1], s1, 0, 0, 0);
            float sc[8];
#pragma unroll
            for (int j = 0; j < 4; ++j) { sc[j] = s0[j] * SCL; sc[4 + j] = s1[j] * SCL; }
            if (masked) {
                const int t = qtok[i];
#pragma unroll
                for (int e = 0; e < 8; ++e) {
                    const int u = u0 + (e >> 2) * 16 + quad * 4 + (e & 3);
                    if (mode == 1) {
                        const int dd = t - u;
                        const bool ok = (u >= 0) && (u < SEQ) && (dd <= 128) && (dd >= -128);
                        if (!ok) sc[e] = -INFINITY;
                    } else {
                        const int c = t & 63, r = t >> 6, ur = u >> 6, uc = u & 63;
                        const int cst = min(max(c - 8, 0), 48);
                        const bool ok = (uc >= cst) && (uc < cst + 16);
                        const int dr = min(max(ur - r + 7, 0), 14), dcx = min(max(uc - c + 15, 0), 30);
                        const float bias = rpb[(qhead[i] * 15 + dr) * 31 + dcx];
                        sc[e] = ok ? sc[e] + bias * LOG2E : -INFINITY;
                    }
                }
            }
            float mx = fmaxf(fmaxf(fmaxf(sc[0], sc[1]), fmaxf(sc[2], sc[3])), fmaxf(fmaxf(sc[4], sc[5]), fmaxf(sc[6], sc[7])));
            mx = fmaxf(mx, __shfl_xor(mx, 16)); mx = fmaxf(mx, __shfl_xor(mx, 32));
            const float mn = fmaxf(mrun[i], mx);
            const float al = __builtin_amdgcn_exp2f(mrun[i] - mn);
            mrun[i] = mn;
            float pe[8], ps = 0.f;
#pragma unroll
            for (int e = 0; e < 8; ++e) { pe[e] = __builtin_amdgcn_exp2f(sc[e] - mn); ps += pe[e]; }
            lrun[i] = lrun[i] * al + ps;
            union { unsigned u[4]; bf16x8 v; } pf;
            pf.u[0] = pk2(pe[0], pe[1]); pf.u[1] = pk2(pe[2], pe[3]); pf.u[2] = pk2(pe[4], pe[5]); pf.u[3] = pk2(pe[6], pe[7]);
#pragma unroll
            for (int dt = 0; dt < 4; ++dt) {
                o[i][dt] = o[i][dt] * al;
                o[i][dt] = __builtin_amdgcn_mfma_f32_16x16x32_bf16(vf[dt], pf.v, o[i][dt], 0, 0, 0);
            }
        }
    }
#pragma unroll
    for (int i = 0; i < 4; ++i) {
        float l = lrun[i]; l += __shfl_xor(l, 16); l += __shfl_xor(l, 32);
        const float inv = 1.f / l;
        const size_t m = rowb + (qctx ? SEQ : 0) + qtok[i];
        u16* op = AO + m * DM + ocol + qhead[i] * 64 + quad * 4;
#pragma unroll
        for (int dt = 0; dt < 4; ++dt) {
            uint2 w; w.x = pk2(o[i][dt][0] * inv, o[i][dt][1] * inv); w.y = pk2(o[i][dt][2] * inv, o[i][dt][3] * inv);
            *(uint2*)(op + dt * 16) = w;
        }
    }
}

DEV void phase_attn_even(PPtr p, int li, char* lds) {
    {
        const attn_body::bf16* RAWb = (const attn_body::bf16*)(p->ws + OFF_RAW); attn_body::bf16* AOb = (attn_body::bf16*)(p->ws + OFF_AO);
        const int G = gridDim.x, bx = blockIdx.x;
        if (G == 256) {
            const int vcu = (bx & 7) * 32 + (bx >> 3); const int x = vcu >> 5, combo = x >> 1, sub = (x & 1) * 32 + (vcu & 31);
            for (int i = 0; i < 4; ++i) attn_body::attn_unit<8>(combo >> 1, (combo & 1) * 4 + i, sub, RAWb, RAWb + 512, RAWb + 640, AOb, lds);
        } else {
            for (int u = bx; u < 1024; u += G) attn_body::attn_unit<8>(u >> 9, (u >> 6) & 7, u & 63, RAWb, RAWb + 512, RAWb + 640, AOb, lds);
        }
    }
    const int wave = tidx() >> 6, gw = blockIdx.x * NWAVE + wave, ngw = gridDim.x * NWAVE;
    u16* sV = (u16*)lds + wave * (32 * 72);
    const u16* RAW = (const u16*)(p->ws + OFF_RAW); u16* AO = (u16*)(p->ws + OFF_AO);
    const float* sink = p->in[12] + li * 8;
    for (int t = gw; t < 4224; t += ngw) {
        if (t < 4096) attn_wave<1, false>(RAW, 1536, 768, 1280, 1408, AO, 512, t >> 11, (t >> 10) & 1, t & 1023, sink, nullptr, sV);
        else if (t < 4160) { const int u = t - 4096; attn_wave<0, true>(RAW, 1536, 0, 512, 640, AO, 0, u >> 5, (u >> 4) & 1, u & 15, nullptr, nullptr, sV); }
        else { const int u = t - 4160; attn_wave<1, true>(RAW, 1536, 768, 1280, 1408, AO, 512, u >> 5, (u >> 4) & 1, u & 15, sink, nullptr, sV); }
    }
}
DEV void phase_attn_odd(PPtr p, int li, char* lds) {
    const int wave = tidx() >> 6, gw = blockIdx.x * NWAVE + wave, ngw = gridDim.x * NWAVE;
    u16* sV = (u16*)lds + wave * (32 * 72);
    const u16* QKV = (const u16*)(p->ws + OFF_RAW); u16* AO = (u16*)(p->ws + OFF_AO);
    const float* rpb = p->in[15] + li * 8 * 15 * 31;
    for (int t = gw; t < 4160; t += ngw) {
        if (t < 4096) attn_wave<2, false>(QKV, 1536, 0, 512, 1024, AO, 0, t >> 11, (t >> 8) & 7, t & 255, nullptr, rpb, sV);
        else { const int u = t - 4096; attn_wave<2, true>(QKV, 1536, 0, 512, 1024, AO, 0, u >> 5, (u >> 2) & 7, u & 3, nullptr, rpb, sV); }
    }
}

DEV float shiftmix_at(const u16* ZDb, int pp, int ch, float mu) {
    const bool lat = pp < SEQ; const int lo = lat ? 0 : SEQ, hi = lat ? SEQ : RPB;
    const u16* zc = ZDb + (size_t)pp * ZDW + ch;
    const float z = bf2f(zc[0]);
    const float a = (pp - 1 >= lo) ? bf2f(zc[-ZDW]) : 0.f, c = (pp + 1 < hi) ? bf2f(zc[ZDW]) : 0.f;
    return z + (0.5f * (a + c) - z) * mu;
}
DEV void phase_rwkv_prep(PPtr p, int li, int bb) {
    const int tid = tidx(), lane = tid & 63, gw = blockIdx.x * NWAVE + (tid >> 6), ngw = gridDim.x * NWAVE;
    const u16* ZDb = (const u16*)(p->ws + OFF_ZD) + (size_t)bb * RPB * ZDW;
    const float* mu = p->in[16] + li * ZDW; const float* kkw = p->in[22] + li * 512;
    u16* R = (u16*)(p->ws + OFF_R); u16* KK = (u16*)(p->ws + OFF_KK); u16* V = (u16*)(p->ws + OFF_V); u16* LA = (u16*)(p->ws + OFF_LA);
    {
        u16* LB = (u16*)(p->ws + OFF_PU);
        const float* w2 = p->in[18] + (size_t)li * 2 * 64 * 512; const float* a2 = p->in[20] + (size_t)li * 2 * 64 * 512; const float* g2 = p->in[21] + (size_t)li * 128 * 512;
        for (int idx = gw * 64 + lane; idx < 2560 * 32; idx += ngw * 64) {
            const int n = idx >> 5, kc = (idx & 31) * 8, type = n >> 9, nn = n & 511;
            float f[8];
#pragma unroll
            for (int e = 0; e < 8; ++e) {
                const int k = kc + e; float x = 0.f;
                if (type < 2) { if (k < 64) x = w2[((size_t)type * 64 + k) * 512 + nn]; }
                else if (type < 4) { if (k >= 64 && k < 128) x = a2[((size_t)(type - 2) * 64 + (k - 64)) * 512 + nn]; }
                else { if (k >= 128) x = g2[(size_t)(k - 128) * 512 + nn]; }
                f[e] = x;
            }
            *(uint4*)(LB + (size_t)n * 256 + kc) = pack8(f);
        }
    }
    {
        float4* Yz = (float4*)(p->ws + OFF_Y0); const float4 z = {0.f, 0.f, 0.f, 0.f};
        for (size_t i = (size_t)gw * 64 + lane; i < (size_t)RPB * 512 / 4; i += (size_t)ngw * 64) Yz[i] = z;
    }
    for (int pp = gw; pp < RPB; pp += ngw) {
        const bool lat = pp < SEQ; const int lo = lat ? 0 : SEQ, hi = lat ? SEQ : RPB;
        const bool hp = pp - 1 >= lo, hn = pp + 1 < hi;
        const u16* zc = ZDb + (size_t)pp * ZDW;
#pragma unroll
        for (int j = 0; j < 4; ++j) {
            const int c8 = lane + 64 * j;
            if (j == 3 && lane >= 32) break;
            const int ch = 8 * c8;
            float z[8], a[8], c[8], zs[8];
            unpack8(*(const uint4*)(zc + ch), z);
            if (hp) unpack8(*(const uint4*)(zc - ZDW + ch), a); else { for (int e = 0; e < 8; ++e) a[e] = 0.f; }
            if (hn) unpack8(*(const uint4*)(zc + ZDW + ch), c); else { for (int e = 0; e < 8; ++e) c[e] = 0.f; }
            const float4 m0 = *(const float4*)(mu + ch), m1 = *(const float4*)(mu + ch + 4);
            const float mm[8] = {m0.x, m0.y, m0.z, m0.w, m1.x, m1.y, m1.z, m1.w};
#pragma unroll
            for (int e = 0; e < 8; ++e) zs[e] = z[e] + (0.5f * (a[e] + c[e]) - z[e]) * mm[e];
            if (j == 0) *(uint4*)(R + (size_t)pp * 512 + ch) = pack8(zs);
            else if (j == 1) {
                const float4 k0 = *(const float4*)(kkw + ch - 512), k1 = *(const float4*)(kkw + ch - 512 + 4);
                const float kw[8] = {k0.x, k0.y, k0.z, k0.w, k1.x, k1.y, k1.z, k1.w};
                float t[8], ss = 0.f;
#pragma unroll
                for (int e = 0; e < 8; ++e) { t[e] = zs[e] * kw[e]; ss += t[e] * t[e]; }
                ss += __shfl_xor(ss, 1); ss += __shfl_xor(ss, 2); ss += __shfl_xor(ss, 4);
                const float inv = 1.f / fmaxf(sqrtf(ss), 1e-12f);
#pragma unroll
                for (int e = 0; e < 8; ++e) t[e] *= inv;
                *(uint4*)(KK + (size_t)pp * 512 + ch - 512) = pack8(t);
            } else if (j == 2) *(uint4*)(V + (size_t)pp * 512 + ch - 1024) = pack8(zs);
            else {
                float o[8];
#pragma unroll
                for (int e = 0; e < 8; ++e) o[e] = (lane < 8) ? tanhf(zs[e]) : (lane < 16) ? zs[e] : sigmoidf_(zs[e]);
                *(uint4*)(LA + (size_t)pp * 256 + ch - 1536) = pack8(o);
            }
        }
    }
}
struct EpiDecay { float* DEC; const float* w0; int d;
    DEV void operator()(int r, int c, float v, float) const {
        const float x = -(w0[c] + v); const float sp = x > 20.f ? x : log1pf(expf(x)); const float w = -sp - 0.5f;
        DEC[((size_t)r * 2 + d) * 512 + c] = expf(-expf(w)); } };
struct EpiIclr { u16* KD; u16* BQ; const u16* KK; const u16* ZDb; const float* a0; const float* ka; const float* muk; int d;
    DEV void operator()(int r, int c, float v, float) const {
        const float a = sigmoidf_(a0[c] + v);
        const float k = shiftmix_at(ZDb, r, 512 + c, muk[c]);
        KD[((size_t)r * 2 + d) * 512 + c] = (u16)f2bf(k * (1.f + (a - 1.f) * ka[c]));
        BQ[((size_t)r * 2 + d) * 512 + c] = (u16)f2bf(bf2f(KK[(size_t)r * 512 + c]) * a); } };
struct EpiGate { u16* G; DEV void operator()(int r, int c, float v, float) const { G[(size_t)r * 512 + c] = (u16)f2bf(v); } };

DEV int pos_to_pp(int s, int d) { return (s < NCTX) ? (d ? SEQ + NCTX - 1 - s : SEQ + s) : (d ? SEQ - 1 - (s - NCTX) : s - NCTX); }
struct StepV { float d; unsigned a; unsigned b; float v; };
DEV StepV load_step(const float* DEC, const u16* KD, const u16* BQ, const u16* KK, const u16* R, const u16* V, int pp, int h, int d, int lane) {
    const size_t e1 = (size_t)pp * 512 + h * 64, e2 = ((size_t)pp * 2 + d) * 512 + h * 64;
    StepV s;
    s.d = DEC[e2 + lane];
    s.a = (lane < 32) ? ((const unsigned*)(KD + e2))[lane] : ((const unsigned*)(BQ + e2))[lane - 32];
    s.b = (lane < 32) ? ((const unsigned*)(KK + e1))[lane] : ((const unsigned*)(R + e1))[lane - 32];
    s.v = bf2f(V[e1 + lane]);
    return s;
}
typedef float f32x2 __attribute__((ext_vector_type(2)));
constexpr int SSLOT = 320;
typedef __attribute__((address_space(3))) float* ldsf;
typedef const __attribute__((address_space(3))) f32x4* lds4;
DEV void stage_step(ldsf slot, const StepV& s, int lane) {
    slot[lane] = s.d;
    *(__attribute__((address_space(3))) f32x2*)(slot + 64 + 2 * lane) = (f32x2){bflo(s.a), bfhi(s.a)};
    *(__attribute__((address_space(3))) f32x2*)(slot + 192 + 2 * lane) = (f32x2){bflo(s.b), bfhi(s.b)};
}
#define LO2(v) ((f32x2){(v)[0], (v)[1]})
#define HI2(v) ((f32x2){(v)[2], (v)[3]})
template <int MODE>
DEV float scan_step(f32x2 (&S)[32], ldsf sl, float vv) {
    lds4 D = (lds4)sl;
    f32x2 sa = {0.f, 0.f};
#pragma unroll
    for (int q = 0; q < 16; ++q) { const f32x4 k4 = D[48 + q]; sa += S[2 * q] * LO2(k4); sa += S[2 * q + 1] * HI2(k4);
        if ((q & 3) == 3) asm volatile("" : "+v"(D), "+v"(sa)); }
    const float nsa = -(sa[0] + sa[1]);
    const f32x2 nsa2 = {nsa, nsa}, vv2 = {vv, vv};
    f32x2 y = {0.f, 0.f};
#pragma unroll
    for (int q = 0; q < 16; ++q) {
        const f32x4 d4 = D[q], b4 = D[32 + q];
        f32x2 t0 = nsa2 * LO2(b4), t1 = nsa2 * HI2(b4);
        if (MODE >= 1) { const f32x4 kd4 = D[16 + q]; t0 += vv2 * LO2(kd4); t1 += vv2 * HI2(kd4); }
        S[2 * q] = S[2 * q] * LO2(d4) + t0; S[2 * q + 1] = S[2 * q + 1] * HI2(d4) + t1;
        if (MODE == 2) { const f32x4 r4 = D[64 + q]; y += S[2 * q] * LO2(r4); y += S[2 * q + 1] * HI2(r4); }
        else y += S[2 * q + 1];
        if ((q & 1) == 1) asm volatile("" : "+v"(D), "+v"(y), "+v"(S[2 * q + 1]));
    }
    return y[0] + y[1];
}
template <int WHICH>
DEV void scan1_pass(PPtr p, char* lds) {
    const int tid = tidx(), lane = tid & 63, wv = __builtin_amdgcn_readfirstlane(tid >> 6), gw = blockIdx.x * NWAVE + wv, ngw = gridDim.x * NWAVE;
    const float* DEC = (const float*)(p->ws + OFF_DEC); const u16* KD = (const u16*)(p->ws + OFF_KD); const u16* BQ = (const u16*)(p->ws + OFF_BQ);
    const u16* KK = (const u16*)(p->ws + OFF_KK); const u16* R = (const u16*)(p->ws + OFF_R); const u16* V = (const u16*)(p->ws + OFF_V);
    float* PU = (float*)(p->ws + OFF_PU);
    ldsf ring = (ldsf)lds + wv * (3 * SSLOT);
    for (int task = gw; task < 16 * NCH; task += ngw) {
        const int seq = task >> 7, c = task & 127, h = seq >> 1, d = seq & 1;
#define LD(st) load_step(DEC, KD, BQ, KK, R, V, pos_to_pp(c * CLEN + min((st), CLEN - 1), d), h, d, lane)
        f32x2 X[32];
        int ln = lane; asm volatile("" : "+v"(ln));
#pragma unroll
        for (int j = 0; j < 32; ++j) X[j] = (f32x2){(WHICH == 0 && 2 * j == ln) ? 1.f : 0.f, (WHICH == 0 && 2 * j + 1 == ln) ? 1.f : 0.f};
        float vvA, vvB;
        { const StepV s0 = LD(0), s1 = LD(1); stage_step(ring, s0, lane); stage_step(ring + SSLOT, s1, lane); vvA = s0.v; vvB = s1.v; }
        StepV g0 = LD(2), g1 = LD(3), g2 = LD(4), g3 = LD(5);
        int cs = 0, ns = 2;
        float chain = 0.f;
#pragma unroll 1
        for (int st = 0; st < CLEN; ++st) {
            chain += scan_step<2>(X, ring + cs * SSLOT, WHICH ? vvA : 0.f);
            stage_step(ring + ns * SSLOT, g0, lane);
            vvA = vvB; vvB = g0.v; g0 = g1; g1 = g2; g2 = g3; g3 = LD(st + 6);
            cs = (cs == 2) ? 0 : cs + 1; ns = (ns == 2) ? 0 : ns + 1;
        }
#undef LD
        float4* o = (float4*)(PU + ((size_t)task * 2 + WHICH) * 4096 + lane * 64);
#pragma unroll
        for (int j = 0; j < 16; ++j) o[j] = (float4){X[2 * j][0], X[2 * j][1], X[2 * j + 1][0], X[2 * j + 1][1]};
        if (chain == 1.2345e38f) o[0] = (float4){chain, chain, chain, chain};
    }
}
DEV void phase_scan1(PPtr p, char* lds) { scan1_pass<0>(p, lds); scan1_pass<1>(p, lds); }
DEV void phase_scan2(PPtr p, char* lds) {
    if (blockIdx.x >= 16) return;
    const int tid = tidx(), lane = tid & 63, w = __builtin_amdgcn_readfirstlane(tid >> 6), seq = blockIdx.x;
    float* sS = (float*)lds;
    float* sP = sS + 2 * 64 * 68;
    float* PU = (float*)(p->ws + OFF_PU) + (size_t)seq * NCH * 2 * 4096;
    const int rt = w >> 1, ct0 = (w & 1) * 2, r = lane & 15, q = lane >> 4;
    for (int i = tid; i < 64 * 68; i += NTHR) sS[i] = 0.f;
    const int prow = tid >> 3, pcol = (tid & 7) * 8;
#define PLOAD(c_, lo, hi) do { const float4* s_ = (const float4*)(PU + (size_t)(c_) * 8192 + prow * 64 + pcol); lo = s_[0]; hi = s_[1]; } while (0)
#define ULOAD(c_, u_) do { const float* s_ = PU + (size_t)(c_) * 8192 + 4096; _Pragma("unroll") for (int t = 0; t < 2; ++t) _Pragma("unroll") for (int j = 0; j < 4; ++j) u_[t][j] = s_[(16 * rt + 4 * q + j) * 64 + 16 * (ct0 + t) + r]; } while (0)
    float4 pa0, pa1, pb0, pb1;
    { float4 t0, t1; PLOAD(0, t0, t1); *(float4*)(sP + prow * 68 + pcol) = t0; *(float4*)(sP + prow * 68 + pcol + 4) = t1; }
    PLOAD(1, pa0, pa1); PLOAD(2, pb0, pb1);
    float ua[2][4], ub[2][4], mine[2][4];
    ULOAD(0, ua); ULOAD(1, ub);
#pragma unroll
    for (int t = 0; t < 2; ++t)
#pragma unroll
        for (int j = 0; j < 4; ++j) mine[t][j] = 0.f;
    __syncthreads();
    for (int c = 0; c < NCH; ++c) {
        const int cur = c & 1;
        float* Um = PU + (size_t)c * 8192 + 4096;
#pragma unroll
        for (int t = 0; t < 2; ++t)
#pragma unroll
            for (int j = 0; j < 4; ++j) Um[(16 * rt + 4 * q + j) * 64 + 16 * (ct0 + t) + r] = mine[t][j];
        f32x4 a0 = {ua[0][0], ua[0][1], ua[0][2], ua[0][3]}, a1 = {ua[1][0], ua[1][1], ua[1][2], ua[1][3]};
        const float* Sc = sS + cur * (64 * 68); const float* Pc = sP + cur * (64 * 68);
#pragma unroll
        for (int ks = 0; ks < 16; ++ks) {
            const float av = Sc[(16 * rt + r) * 68 + 4 * ks + q];
            const float b0 = Pc[(4 * ks + q) * 68 + 16 * ct0 + r], b1 = Pc[(4 * ks + q) * 68 + 16 * ct0 + 16 + r];
            a0 = __builtin_amdgcn_mfma_f32_16x16x4f32(av, b0, a0, 0, 0, 0);
            a1 = __builtin_amdgcn_mfma_f32_16x16x4f32(av, b1, a1, 0, 0, 0);
        }
        float* Sn = sS + (cur ^ 1) * (64 * 68);
#pragma unroll
        for (int j = 0; j < 4; ++j) { Sn[(16 * rt + 4 * q + j) * 68 + 16 * ct0 + r] = a0[j]; Sn[(16 * rt + 4 * q + j) * 68 + 16 * ct0 + 16 + r] = a1[j]; mine[0][j] = a0[j]; mine[1][j] = a1[j]; }
        { float* Pn = sP + (cur ^ 1) * (64 * 68); *(float4*)(Pn + prow * 68 + pcol) = pa0; *(float4*)(Pn + prow * 68 + pcol + 4) = pa1; }
        pa0 = pb0; pa1 = pb1;
        { const int c3 = min(c + 3, NCH - 1); PLOAD(c3, pb0, pb1); }
#pragma unroll
        for (int t = 0; t < 2; ++t)
#pragma unroll
            for (int j = 0; j < 4; ++j) ua[t][j] = ub[t][j];
        { const int c2 = c + 2; if (c2 < NCH) ULOAD(c2, ub); }
        __syncthreads();
    }
#undef PLOAD
#undef ULOAD
}
DEV void phase_scan3(PPtr p, char* lds) {
    const int tid = tidx(), lane = tid & 63, wv = __builtin_amdgcn_readfirstlane(tid >> 6), gw = blockIdx.x * NWAVE + wv, ngw = gridDim.x * NWAVE;
    const float* DEC = (const float*)(p->ws + OFF_DEC); const u16* KD = (const u16*)(p->ws + OFF_KD); const u16* BQ = (const u16*)(p->ws + OFF_BQ);
    const u16* KK = (const u16*)(p->ws + OFF_KK); const u16* R = (const u16*)(p->ws + OFF_R); const u16* V = (const u16*)(p->ws + OFF_V);
    const float* PU = (const float*)(p->ws + OFF_PU);
    float* Y = (float*)(p->ws + OFF_Y0);
    ldsf ring = (ldsf)lds + wv * (3 * SSLOT);
    for (int task = gw; task < 16 * NCH; task += ngw) {
        const int seq = task >> 7, c = task & 127, h = seq >> 1, d = seq & 1;
        f32x2 S[32];
        {
            const float4* si = (const float4*)(PU + ((size_t)task * 2 + 1) * 4096 + lane * 64);
#pragma unroll
            for (int j = 0; j < 16; ++j) { const float4 t = si[j]; S[2 * j] = (f32x2){t.x, t.y}; S[2 * j + 1] = (f32x2){t.z, t.w}; }
        }
#define LD(st) load_step(DEC, KD, BQ, KK, R, V, pos_to_pp(c * CLEN + min((st), CLEN - 1), d), h, d, lane)
#define YADD(st, y) unsafeAtomicAdd(Y + (size_t)pos_to_pp(c * CLEN + (st), d) * 512 + h * 64 + lane, (y))
        float vvA, vvB;
        { const StepV s0 = LD(0), s1 = LD(1); stage_step(ring, s0, lane); stage_step(ring + SSLOT, s1, lane); vvA = s0.v; vvB = s1.v; }
        StepV g0 = LD(2), g1 = LD(3), g2 = LD(4), g3 = LD(5);
        int cs = 0, ns = 2;
#pragma unroll 1
        for (int st = 0; st < CLEN; ++st) {
            const float y = scan_step<2>(S, ring + cs * SSLOT, vvA); YADD(st, y);
            stage_step(ring + ns * SSLOT, g0, lane);
            vvA = vvB; vvB = g0.v; g0 = g1; g1 = g2; g2 = g3; g3 = LD(st + 6);
            cs = (cs == 2) ? 0 : cs + 1; ns = (ns == 2) ? 0 : ns + 1;
        }
#undef LD
#undef YADD
    }
}
DEV void phase_readout(PPtr p, int li, int bb) {
    const int tid = tidx(), lane = tid & 63, gw = blockIdx.x * NWAVE + (tid >> 6), ngw = gridDim.x * NWAVE;
    const float* Y0 = (const float*)(p->ws + OFF_Y0);
    const u16* KD = (const u16*)(p->ws + OFF_KD); const u16* R = (const u16*)(p->ws + OFF_R); const u16* V = (const u16*)(p->ws + OFF_V); const u16* G = (const u16*)(p->ws + OFF_G);
    const float* rk = p->in[24] + li * 512; const float* lnw = p->in[25] + li * 512; const float* lnb = p->in[26] + li * 512;
    u16* AO = (u16*)(p->ws + OFF_AO);
    const int c = 8 * lane;
    float rkv[8], lw[8], lb[8];
    { const float4 a = *(const float4*)(rk + c), b = *(const float4*)(rk + c + 4); rkv[0] = a.x; rkv[1] = a.y; rkv[2] = a.z; rkv[3] = a.w; rkv[4] = b.x; rkv[5] = b.y; rkv[6] = b.z; rkv[7] = b.w; }
    { const float4 a = *(const float4*)(lnw + c), b = *(const float4*)(lnw + c + 4); lw[0] = a.x; lw[1] = a.y; lw[2] = a.z; lw[3] = a.w; lw[4] = b.x; lw[5] = b.y; lw[6] = b.z; lw[7] = b.w; }
    { const float4 a = *(const float4*)(lnb + c), b = *(const float4*)(lnb + c + 4); lb[0] = a.x; lb[1] = a.y; lb[2] = a.z; lb[3] = a.w; lb[4] = b.x; lb[5] = b.y; lb[6] = b.z; lb[7] = b.w; }
    for (int pp = gw; pp < RPB; pp += ngw) {
        const size_t m = (size_t)bb * RPB + pp, e = (size_t)pp * 512 + c;
        const float4 ya = *(const float4*)(Y0 + e), yb = *(const float4*)(Y0 + e + 4);
        const float y[8] = {ya.x, ya.y, ya.z, ya.w, yb.x, yb.y, yb.z, yb.w};
        float r[8], k0[8], k1[8], v[8], g[8];
        unpack8(*(const uint4*)(R + e), r); unpack8(*(const uint4*)(KD + ((size_t)pp * 2) * 512 + c), k0); unpack8(*(const uint4*)(KD + ((size_t)pp * 2 + 1) * 512 + c), k1);
        unpack8(*(const uint4*)(V + e), v); unpack8(*(const uint4*)(G + e), g);
        float sm = 0.f, bs = 0.f;
#pragma unroll
        for (int j = 0; j < 8; ++j) { sm += y[j]; bs += r[j] * (k0[j] + k1[j]) * rkv[j]; }
        sm += __shfl_xor(sm, 1); sm += __shfl_xor(sm, 2); sm += __shfl_xor(sm, 4);
        bs += __shfl_xor(bs, 1); bs += __shfl_xor(bs, 2); bs += __shfl_xor(bs, 4);
        const float mean = sm * (1.f / 64.f);
        float vs = 0.f;
#pragma unroll
        for (int j = 0; j < 8; ++j) { const float dv = y[j] - mean; vs += dv * dv; }
        vs += __shfl_xor(vs, 1); vs += __shfl_xor(vs, 2); vs += __shfl_xor(vs, 4);
        const float rstd = rsqrtf(vs * (1.f / 64.f) + 64e-5f);
        float o[8];
#pragma unroll
        for (int j = 0; j < 8; ++j) o[j] = ((y[j] - mean) * rstd * lw[j] + lb[j] + bs * v[j]) * g[j];
        *(uint4*)(AO + m * DM + 512 + c) = pack8(o);
    }
}
DEV void phase_final(PPtr p) {
    const int lane = tidx() & 63, gw = blockIdx.x * NWAVE + (tidx() >> 6), ngw = gridDim.x * NWAVE;
    const float* gain = p->in[29];
    for (int m = gw; m < NB * SEQ; m += ngw) {
        float4* xr = (float4*)(p->out + (size_t)m * DM);
        float4 v[4]; float ss = 0.f;
#pragma unroll
        for (int j = 0; j < 4; ++j) { v[j] = xr[lane + 64 * j]; ss += v[j].x * v[j].x + v[j].y * v[j].y + v[j].z * v[j].z + v[j].w * v[j].w; }
        ss = wave_sum(ss);
        const float rstd = rsqrtf(ss * (1.f / DM) + 1e-6f);
#pragma unroll
        for (int j = 0; j < 4; ++j) {
            const float4 g = *(const float4*)(gain + (lane + 64 * j) * 4);
            float4 o; o.x = v[j].x * rstd * g.x; o.y = v[j].y * rstd * g.y; o.z = v[j].z * rstd * g.z; o.w = v[j].w * rstd * g.w;
            xr[lane + 64 * j] = o;
        }
    }
}

constexpr size_t OFF_BAR = 768 * 1024;
DEV void gbar(PPtr kp_, unsigned& nbar) {
    asm volatile("s_waitcnt vmcnt(0)" ::: "memory");
    __syncthreads();
    if (threadIdx.x == 0) {
        unsigned* ctr = (unsigned*)(kp_->ws + OFF_BAR);
        __builtin_amdgcn_fence(__ATOMIC_RELEASE, "agent");
        asm volatile("s_waitcnt vmcnt(0)" ::: "memory");
        ++nbar;
        __hip_atomic_fetch_add(ctr, 1u, __ATOMIC_RELAXED, __HIP_MEMORY_SCOPE_AGENT);
        const unsigned target = nbar * gridDim.x;
        while (__hip_atomic_load(ctr, __ATOMIC_RELAXED, __HIP_MEMORY_SCOPE_AGENT) < target) __builtin_amdgcn_s_sleep(1);
        __builtin_amdgcn_fence(__ATOMIC_ACQUIRE, "agent");
        asm volatile("s_waitcnt vmcnt(0)" ::: "memory");
    }
    __syncthreads();
}
#define p launder(kp)
#define SYNC() gbar(launder(kp), nbar)
template <int bb>
DEV void do_rwkv_batch(PPtr kp, unsigned& nbar, char* lds, int li) {
    unsigned char* ws = launder(kp)->ws;
    u16* ZD = (u16*)(ws + OFF_ZD);
                phase_rwkv_prep(p, li, bb); SYNC();
                const u16* LA = (const u16*)(ws + OFF_LA); const u16* ZDb = ZD + (size_t)bb * RPB * ZDW;
                { pg8::EpiLoraT e{(float*)(ws + OFF_DEC), (u16*)(ws + OFF_KD), (u16*)(ws + OFF_BQ), (u16*)(ws + OFF_G), (const u16*)(ws + OFF_KK), ZDb,
                                  p->in[17] + (size_t)li * 1024, p->in[19] + (size_t)li * 1024, p->in[23] + li * 512, p->in[16] + li * ZDW + 512};
                  int kl_ = 256; asm volatile("" : "+s"(kl_));
                  pg8::Gemm g_{(const pg8::bf16_t*)LA, (const pg8::bf16_t*)(ws + OFF_PU), RPB, 2560, kl_}; pg8::StaticOrder S_; S_.init(RPB, 2560, (int)gridDim.x, (int)blockIdx.x);
                  pg8::gemm_phase<pg8::EpiLoraT, pg8::StaticOrder, true, true>((PG8_LAS unsigned char*)lds, g_, S_, e); }
                SYNC();
                phase_scan1(p, lds); SYNC();
                phase_scan2(p, lds); SYNC();
                phase_scan3(p, lds); SYNC();
                phase_readout(p, li, bb); SYNC();
            }
template <int layer>
DEV void do_layer(PPtr kp, unsigned& nbar, char* lds) {
    unsigned char* ws = launder(kp)->ws;
    const float* mod = (const float*)(ws + OFF_MOD);
    u16* HN = (u16*)(ws + OFF_HN); u16* AO = (u16*)(ws + OFF_AO); u16* RAW = (u16*)(ws + OFF_RAW); u16* ZD = (u16*)(ws + OFF_ZD);
        const int li = layer >> 1;
        const float* lmod = mod + (size_t)layer * 3 * 6144;
        phase_wprep(p, layer, lds); phase_normmod(p, layer, 0); SYNC();
        const pg8::bf16_t* WB = (const pg8::bf16_t*)(ws + OFF_WB);
#define GEMM8(A_, B_, N_, K_, E_) do { pg8::Gemm g_{(const pg8::bf16_t*)(A_), (B_), MROWS, (N_), (K_)}; pg8::StaticOrder S_; S_.init(MROWS, (N_), (int)gridDim.x, (int)blockIdx.x); \
            pg8::gemm_phase<decltype(E_), pg8::StaticOrder, true, true>((PG8_LAS unsigned char*)lds, g_, S_, E_); } while (0)
        if (!(layer & 1)) {
            { pg8::EpiStoreT e{RAW, 1536, 1 << 30, RAW, 1536}; GEMM8(HN, WB + WB_IN, 1536, DM, e); } SYNC();
            phase_even_post(p, li); SYNC();
            phase_attn_even(p, li, lds); SYNC();
            { pg8::EpiResidT e{p, lmod + 2048}; GEMM8(AO, WB + WB_OUT, DM, DM, e); } SYNC();
        } else {
            { pg8::EpiStoreT e{RAW, 1536, 1536, ZD, ZDW}; GEMM8(HN, WB + WB_IN, 3328, DM, e); } SYNC();
            phase_attn_odd(p, li, lds); SYNC();
            do_rwkv_batch<0>(kp, nbar, lds, li);
            do_rwkv_batch<1>(kp, nbar, lds, li);
            { pg8::EpiResidT e{p, lmod + 2048}; GEMM8(AO, WB + WB_OUT, DM, DM, e); } SYNC();
        }
        phase_normmod(p, layer, 1); SYNC();
        { pg8::EpiSwigluT e{RAW}; GEMM8(HN, WB + WB_F1, 5632, DM, e); } SYNC();
        { pg8::EpiResidT e{p, lmod + 5120}; GEMM8(RAW, WB + WB_F2, DM, FFH, e); } SYNC();
    }
__global__ void __launch_bounds__(NTHR) mega(Params p_unused) {
    PPtr kp = (PPtr)__builtin_amdgcn_kernarg_segment_ptr();
    extern __shared__ __attribute__((aligned(16))) char lds[];
    cg::grid_group grid = cg::this_grid();
    unsigned nbar = 0;
    grid.sync();
    phase_init(p, lds); SYNC();
    do_layer<0>(kp, nbar, lds);
    do_layer<1>(kp, nbar, lds);
    do_layer<2>(kp, nbar, lds);
    do_layer<3>(kp, nbar, lds);
    phase_final(p);
}
#undef p
#undef SYNC

extern "C" void kernel_launch(void* const* d_in, const int* in_sizes, int n_in, void* d_out, int out_size, void* d_ws, size_t ws_size, hipStream_t stream) {
    static int grid = 0;
    if (grid == 0) {
        if (n_in != 30 || ws_size < WS_NEED || out_size != NB * SEQ * DM) { fprintf(stderr, "kernel_launch: unexpected problem shape (n_in %d ws %zu out %d)\n", n_in, ws_size, out_size); grid = -1; return; }
        int dev = 0, cus = 0, per_cu = 0;
        hipGetDevice(&dev);
        hipDeviceGetAttribute(&cus, hipDeviceAttributeMultiprocessorCount, dev);
        hipFuncSetAttribute((const void*)mega, hipFuncAttributeMaxDynamicSharedMemorySize, LDS_BYTES);
        hipOccupancyMaxActiveBlocksPerMultiprocessor(&per_cu, (const void*)mega, NTHR, LDS_BYTES);
        if (per_cu < 1) per_cu = 1;
        if (per_cu > 1) per_cu = 1;
        grid = cus * per_cu;
    }
    if (grid < 0) return;
    Params p{};
    for (int i = 0; i < 30; ++i) p.in[i] = (const float*)d_in[i];
    p.out = (float*)d_out; p.ws = (unsigned char*)d_ws;
    hipMemsetAsync((char*)d_ws + OFF_BAR, 0, 256, stream);
    void* args[] = {&p};
    hipError_t e = hipLaunchCooperativeKernel((const void*)mega, dim3(grid), dim3(NTHR), args, LDS_BYTES, stream);
    if (e != hipSuccess) fprintf(stderr, "cooperative launch failed: %s (grid %d)\n", hipGetErrorString(e), grid);
}
```

```cpp
#include <hip/hip_runtime.h>
#include <hip/hip_cooperative_groups.h>
#include <cstdio>
#include <cstdint>
namespace cg = cooperative_groups;

#define DEV __device__ __forceinline__
typedef unsigned short u16;
typedef short bf16x8 __attribute__((ext_vector_type(8)));
typedef float f32x4 __attribute__((ext_vector_type(4)));
typedef const __attribute__((address_space(4))) float* cfp;
typedef const __attribute__((address_space(4))) unsigned* cup;

constexpr int DM = 1024, NB = 2, SEQ = 16384, NCTX = 256, RPB = SEQ + NCTX, MROWS = NB * RPB;
constexpr int FFH = 2816, ZDW = 1792;
constexpr float LOG2E = 1.4426950408889634f;
constexpr int NTHR = 512, NWAVE = 8;
constexpr int LDS_BYTES = 132096;

constexpr size_t MiB = 1u << 20;
constexpr size_t OFF_MOD = 0;
constexpr size_t OFF_ROPE = 512 * 1024;
constexpr size_t OFF_XC = 1 * MiB;
constexpr size_t OFF_WB = 3 * MiB;
constexpr size_t OFF_AO = 29 * MiB;
constexpr size_t OFF_HN = 94 * MiB;
constexpr size_t OFF_RAW = 159 * MiB;
constexpr size_t OFF_ZD = 257 * MiB;
constexpr size_t SZ_H = (size_t)RPB * 512 * 2;
constexpr size_t OFF_DEC = 94 * MiB;
constexpr size_t OFF_KD = OFF_DEC + 4 * SZ_H;
constexpr size_t OFF_BQ = OFF_KD + 2 * SZ_H;
constexpr size_t OFF_KK = OFF_BQ + 2 * SZ_H;
constexpr size_t OFF_R = OFF_KK + SZ_H;
constexpr size_t OFF_V = 371 * MiB;
constexpr size_t OFF_G = OFF_V + SZ_H;
constexpr size_t OFF_LA = OFF_G + SZ_H;
constexpr size_t OFF_Y0 = 412 * MiB;
constexpr size_t OFF_PU = OFF_Y0 + 2 * SZ_H;
constexpr size_t WS_NEED = 509 * MiB;
constexpr int NCH = 128, CLEN = 130;
static_assert(OFF_R + SZ_H <= OFF_ZD, "scan map");
static_assert(OFF_LA + SZ_H / 2 <= OFF_Y0, "scan map 2");
static_assert(OFF_PU + 64 * MiB <= WS_NEED, "scan map 3");
static_assert(OFF_RAW + (size_t)MROWS * FFH * 2 <= WS_NEED, "ffn hidden");

struct Params { const float* in[30]; float* out; unsigned char* ws; };
typedef const __attribute__((address_space(4))) Params* PPtr;
DEV int tidx() { int t = threadIdx.x; asm volatile("" : "+v"(t)); return t; }
DEV PPtr launder(PPtr p) { asm volatile("" : "+s"(p)); return p; }

DEV unsigned f2bf(float f) { unsigned u = __float_as_uint(f); return (u + 0x7fffu + ((u >> 16) & 1u)) >> 16; }
DEV float bf2f(u16 h) { return __uint_as_float(((unsigned)h) << 16); }
DEV float bflo(unsigned u) { return __uint_as_float(u << 16); }
DEV float bfhi(unsigned u) { return __uint_as_float(u & 0xffff0000u); }
DEV unsigned pk2(float lo, float hi) { return f2bf(lo) | (f2bf(hi) << 16); }
DEV void unpack8(const uint4 u, float (&f)[8]) {
    f[0] = bflo(u.x); f[1] = bfhi(u.x); f[2] = bflo(u.y); f[3] = bfhi(u.y); f[4] = bflo(u.z); f[5] = bfhi(u.z); f[6] = bflo(u.w); f[7] = bfhi(u.w);
}
DEV uint4 pack8(const float (&f)[8]) { uint4 o; o.x = pk2(f[0], f[1]); o.y = pk2(f[2], f[3]); o.z = pk2(f[4], f[5]); o.w = pk2(f[6], f[7]); return o; }
DEV float wave_sum(float v) {
#pragma unroll
    for (int o = 1; o < 64; o <<= 1) v += __shfl_xor(v, o);
    return v;
}
DEV float* xrow_ptr(PPtr p, int m) {
    int b = m / RPB, q = m - b * RPB;
    return q < SEQ ? p->out + (size_t)(b * SEQ + q) * DM : (float*)(p->ws + OFF_XC) + (size_t)(b * NCTX + (q - SEQ)) * DM;
}
DEV int mod_idx(int m) { int b = m / RPB, q = m - b * RPB; return q < SEQ ? b : 2; }
DEV float sigmoidf_(float x) { return 1.f / (1.f + __expf(-x)); }

DEV void phase_init(PPtr p, char* lds) {
    const int tid = tidx();
    const size_t gt = (size_t)blockIdx.x * NTHR + tid, ng = (size_t)gridDim.x * NTHR;
    {
        const float4* s = (const float4*)p->in[0]; float4* d = (float4*)p->out;
        const size_t n = (size_t)NB * SEQ * DM / 4;
        for (size_t i = gt; i < n; i += ng) d[i] = s[i];
        const float4* s2 = (const float4*)p->in[2]; float4* d2 = (float4*)(p->ws + OFF_XC);
        const size_t n2 = (size_t)NB * NCTX * DM / 4;
        for (size_t i = gt; i < n2; i += ng) d2[i] = s2[i];
    }
    {
        float* T = (float*)(p->ws + OFF_ROPE);
        for (size_t i = gt; i < 5120; i += ng) {
            const int pos = (int)(i >> 4), f = (int)(i & 15);
            const float inv = powf(10000.f, -(float)f / 16.f);
            if (pos < 256) { const float ang = (float)pos * inv; T[pos * 16 + f] = cosf(ang); T[4096 + pos * 16 + f] = sinf(ang); }
            else { const float ang = (float)(pos - 256) * inv; T[8192 + (pos - 256) * 16 + f] = cosf(ang); T[9216 + (pos - 256) * 16 + f] = sinf(ang); }
        }
    }
    float* red = (float*)lds;
    float* mod = (float*)(p->ws + OFF_MOD);
    const float* c = p->in[1]; const float* cc = p->in[3];
    for (int item = blockIdx.x; item < 192; item += gridDim.x) {
        const int l = item / 48, n0 = (item % 48) * 128, col = tid & 127, kp = tid >> 7;
        const float* w = p->in[4] + (size_t)l * DM * 6144 + n0 + col;
        float a0 = 0.f, a1 = 0.f, a2 = 0.f;
        for (int k = kp * 256; k < kp * 256 + 256; ++k) {
            const float wv = w[(size_t)k * 6144];
            const float c0 = c[k], c1 = c[DM + k], c2 = cc[k];
            a0 += c0 * sigmoidf_(c0) * wv; a1 += c1 * sigmoidf_(c1) * wv; a2 += c2 * sigmoidf_(c2) * wv;
        }
        red[(kp * 3 + 0) * 128 + col] = a0; red[(kp * 3 + 1) * 128 + col] = a1; red[(kp * 3 + 2) * 128 + col] = a2;
        __syncthreads();
        if (tid < 384) {
            const int mb = tid >> 7, cl = tid & 127;
            float s = red[(0 * 3 + mb) * 128 + cl] + red[(1 * 3 + mb) * 128 + cl] + red[(2 * 3 + mb) * 128 + cl] + red[(3 * 3 + mb) * 128 + cl];
            mod[(size_t)(l * 3 + mb) * 6144 + n0 + cl] = s + p->in[5][l * 6144 + n0 + cl];
        }
        __syncthreads();
    }
}

DEV void phase_normmod(PPtr p, int layer, int which) {
    const int lane = tidx() & 63, gw = blockIdx.x * NWAVE + (tidx() >> 6), ngw = gridDim.x * NWAVE;
    const float* gain = p->in[which ? 7 : 6] + layer * DM;
    const float* mod = (const float*)(p->ws + OFF_MOD) + (size_t)layer * 3 * 6144;
    u16* HN = (u16*)(p->ws + OFF_HN);
    for (int m = gw; m < MROWS; m += ngw) {
        const float* xr = xrow_ptr(p, m);
        const float* md = mod + mod_idx(m) * 6144 + (which ? 3072 : 0);
        float4 v[4]; float ss = 0.f;
#pragma unroll
        for (int j = 0; j < 4; ++j) { v[j] = ((const float4*)xr)[lane + 64 * j]; ss += v[j].x * v[j].x + v[j].y * v[j].y + v[j].z * v[j].z + v[j].w * v[j].w; }
        ss = wave_sum(ss);
        const float rstd = rsqrtf(ss * (1.f / DM) + 1e-6f);
#pragma unroll
        for (int j = 0; j < 4; ++j) {
            const int k = (lane + 64 * j) * 4;
            const float4 g = *(const float4*)(gain + k), sh = *(const float4*)(md + k), sc = *(const float4*)(md + 1024 + k);
            const float o0 = v[j].x * rstd * g.x * (1.f + sc.x) + sh.x, o1 = v[j].y * rstd * g.y * (1.f + sc.y) + sh.y;
            const float o2 = v[j].z * rstd * g.z * (1.f + sc.z) + sh.z, o3 = v[j].w * rstd * g.w * (1.f + sc.w) + sh.w;
            uint2 w; w.x = pk2(o0, o1); w.y = pk2(o2, o3);
            *(uint2*)(HN + (size_t)m * DM + k) = w;
        }
    }
}

template <int DUAL, class Epi>
DEV void gemm_simple(const u16* A, int lda, const float* W, int ldw, int dualoff, int M, int N, int K, const Epi& epi, char* lds) {
    u16* sA = (u16*)lds; u16* sB = sA + 128 * 40; u16* sB2 = sB + 128 * 40;
    const int tid = tidx(), lane = tid & 63, wave = tid >> 6, wm = wave >> 2, wn = wave & 3, r16 = lane & 15, quad = lane >> 4;
    const int mt = M / 128, nt = N / 128;
    for (int item = blockIdx.x; item < mt * nt; item += gridDim.x) {
        const int tn = item / mt, tm = item - tn * mt, m0 = tm * 128, n0 = tn * 128;
        f32x4 acc[4][2], acc2[4][2];
#pragma unroll
        for (int a = 0; a < 4; ++a)
#pragma unroll
            for (int b = 0; b < 2; ++b) { acc[a][b] = (f32x4){0.f, 0.f, 0.f, 0.f}; acc2[a][b] = (f32x4){0.f, 0.f, 0.f, 0.f}; }
        for (int k0 = 0; k0 < K; k0 += 32) {
            {
                const int row = tid >> 2, kc = (tid & 3) * 8;
                const uint4 v = *(const uint4*)(A + (size_t)(m0 + row) * lda + k0 + kc);
                *(uint4*)(sA + row * 40 + kc) = v;
            }
            {
                const int kk = tid >> 4, nc = (tid & 15) * 8;
                const float* wp = W + (size_t)(k0 + kk) * ldw + n0 + nc;
                const float4 a = *(const float4*)wp, b = *(const float4*)(wp + 4);
                sB[(nc + 0) * 40 + kk] = (u16)f2bf(a.x); sB[(nc + 1) * 40 + kk] = (u16)f2bf(a.y); sB[(nc + 2) * 40 + kk] = (u16)f2bf(a.z); sB[(nc + 3) * 40 + kk] = (u16)f2bf(a.w);
                sB[(nc + 4) * 40 + kk] = (u16)f2bf(b.x); sB[(nc + 5) * 40 + kk] = (u16)f2bf(b.y); sB[(nc + 6) * 40 + kk] = (u16)f2bf(b.z); sB[(nc + 7) * 40 + kk] = (u16)f2bf(b.w);
                if (DUAL) {
                    const float4 c = *(const float4*)(wp + dualoff), d = *(const float4*)(wp + dualoff + 4);
                    sB2[(nc + 0) * 40 + kk] = (u16)f2bf(c.x); sB2[(nc + 1) * 40 + kk] = (u16)f2bf(c.y); sB2[(nc + 2) * 40 + kk] = (u16)f2bf(c.z); sB2[(nc + 3) * 40 + kk] = (u16)f2bf(c.w);
                    sB2[(nc + 4) * 40 + kk] = (u16)f2bf(d.x); sB2[(nc + 5) * 40 + kk] = (u16)f2bf(d.y); sB2[(nc + 6) * 40 + kk] = (u16)f2bf(d.z); sB2[(nc + 7) * 40 + kk] = (u16)f2bf(d.w);
                }
            }
            __syncthreads();
            bf16x8 af[4], bfr[2], bfr2[2];
#pragma unroll
            for (int mi = 0; mi < 4; ++mi) af[mi] = *(const bf16x8*)(sA + (wm * 64 + mi * 16 + r16) * 40 + quad * 8);
#pragma unroll
            for (int ni = 0; ni < 2; ++ni) {
                bfr[ni] = *(const bf16x8*)(sB + (wn * 32 + ni * 16 + r16) * 40 + quad * 8);
                if (DUAL) bfr2[ni] = *(const bf16x8*)(sB2 + (wn * 32 + ni * 16 + r16) * 40 + quad * 8);
            }
#pragma unroll
            for (int mi = 0; mi < 4; ++mi)
#pragma unroll
                for (int ni = 0; ni < 2; ++ni) {
                    acc[mi][ni] = __builtin_amdgcn_mfma_f32_16x16x32_bf16(af[mi], bfr[ni], acc[mi][ni], 0, 0, 0);
                    if (DUAL) acc2[mi][ni] = __builtin_amdgcn_mfma_f32_16x16x32_bf16(af[mi], bfr2[ni], acc2[mi][ni], 0, 0, 0);
                }
            __syncthreads();
        }
#pragma unroll
        for (int mi = 0; mi < 4; ++mi)
#pragma unroll
            for (int ni = 0; ni < 2; ++ni)
#pragma unroll
                for (int j = 0; j < 4; ++j) {
                    const int row = m0 + wm * 64 + mi * 16 + quad * 4 + j, col = n0 + wn * 32 + ni * 16 + r16;
                    epi(row, col, acc[mi][ni][j], DUAL ? acc2[mi][ni][j] : 0.f);
                }
    }
}

struct EpiStore { u16* O; int ld; DEV void operator()(int r, int c, float v, float) const { O[(size_t)r * ld + c] = (u16)f2bf(v); } };
struct EpiStoreOdd { u16* Q; u16* Z;
    DEV void operator()(int r, int c, float v, float) const { if (c < 1536) Q[(size_t)r * 1536 + c] = (u16)f2bf(v); else Z[(size_t)r * ZDW + (c - 1536)] = (u16)f2bf(v); } };
struct EpiResid { PPtr p; const float* gate;
    DEV void operator()(int r, int c, float v, float) const { float* xr = xrow_ptr(p, r); xr[c] += gate[mod_idx(r) * 6144 + c] * v; } };
struct EpiSwiglu { u16* H;
    DEV void operator()(int r, int c, float g, float u) const { H[(size_t)r * FFH + c] = (u16)f2bf(g * sigmoidf_(g) * u); } };


namespace pg8 {
#define PG8_LAS __attribute__((address_space(3)))
typedef unsigned short bf16_t;
typedef short bf16x8 __attribute__((ext_vector_type(8)));
typedef float f32x4 __attribute__((ext_vector_type(4)));
typedef unsigned u32x4 __attribute__((ext_vector_type(4)));
constexpr int BM = 256, BK = 64, HALF = 128, HTB = HALF * BK * 2  , STAGE_BYTES = 8 * HTB, NXCD = 8, WGM = 8;

__host__ __device__ __forceinline__ int lds_byte(int r, int c) { const int st = (r >> 4) * 2 + (c >> 5), rr = r & 15, cc = c & 31, ob = rr * 64 + cc * 2; return st * 1024 + (ob ^ (((ob >> 9) & 1) << 5)); }
__host__ __device__ __forceinline__ void stage_rc(int b, int& R, int& C) { const int st = b / 1024, sb = b % 1024, swz = sb ^ (((sb >> 9) & 1) << 5); R = (st >> 1) * 16 + swz / 64; C = (st & 1) * 32 + (swz % 64) / 2; }
__host__ __device__ __forceinline__ int perm32(int rho) { const int n = rho >> 4, i = rho & 15; return 8 * (i >> 2) + 4 * n + (i & 3); }

struct Unit { int pm, pn; };
struct Gemm { const bf16_t* A; const bf16_t* Bt; int M, N, K; };

struct StaticOrder {
    int nM, nN, nwg, G, c;
    __host__ __device__ void init(int M, int N, int G_, int c_) { nM = M / BM; nN = N / BM; nwg = nM * nN; G = G_; c = c_; }
    __host__ __device__ bool next(int i, Unit& u) const {
        const long L = (long)i * G + c; if (L >= nwg) return false;
        int wgid = (int)L; { const int q = nwg / NXCD, r = nwg % NXCD, xcd = wgid % NXCD, off = wgid / NXCD; wgid = (xcd < r ? xcd * (q + 1) : r * (q + 1) + (xcd - r) * q) + off; }
        const int nig = WGM * nN, gid = wgid / nig, fm = gid * WGM, gsz = (nM - fm) < WGM ? (nM - fm) : WGM;
        u.pm = fm + ((wgid % nig) % gsz); u.pn = (wgid % nig) / gsz; return true;
    }
    __device__ __forceinline__ void a_ready(const Unit&) const {}
    __device__ __forceinline__ void done(const Unit&) const {}
};
__device__ __forceinline__ unsigned cvt_pk_bf16(float lo, float hi) { unsigned r; asm volatile("v_cvt_pk_bf16_f32 %0, %1, %2" : "=v"(r) : "v"(lo), "v"(hi)); return r; }
template <class Epi, class Sched, bool ALIGN_EPI = false, bool SP2 = false>
__device__ __forceinline__ void gemm_phase(PG8_LAS unsigned char* lds, const Gemm g, const Sched& S, const Epi& E) {
    const int tid = tidx(), wid = __builtin_amdgcn_readfirstlane(tid >> 6), lane = tid & 63, wr = wid >> 2, wc = wid & 3, fr = lane & 15, fq = lane >> 4;
    const int K = g.K, nt = K / BK;
    unsigned voffA[2], voffB[2];
#pragma unroll
    for (int i = 0; i < 2; ++i) { int R, C; stage_rc(tid * 16 + i * 8192, R, C); const int Rb = Epi::PERM ? ((R & ~31) + perm32(R & 31)) : R;
        voffA[i] = (unsigned)(R * K + C) * 2u; voffB[i] = (unsigned)(Rb * K + C) * 2u; }
    const size_t kstep = (size_t)(BK * 2);
    const size_t hstep = (size_t)HALF * K * 2;
    const size_t tstep = 2 * hstep;
    const unsigned ldsw = (unsigned)wid * 1024u;
    const int aoff = lds_byte(wr * 64 + fr, fq * 8), boff = lds_byte(wc * 32 + fr, fq * 8);
#define PG8_SA(b, h) (((b) * 2 + (h)) * HTB)
#define PG8_SB(b, h) ((4 + (b) * 2 + (h)) * HTB)
#define PG8_STAGE(bufoff, gbase, voff) do { _Pragma("unroll") for (int _i = 0; _i < 2; ++_i) \
        __builtin_amdgcn_global_load_lds((const unsigned*)((const char*)(gbase) + (voff)[_i]), (PG8_LAS unsigned*)(lds + (bufoff) + ldsw + _i * 8192), 16, 0, 0); } while (0)
#define PG8_LDA(dst, b, h) do { _Pragma("unroll") for (int m = 0; m < 4; ++m) _Pragma("unroll") for (int k = 0; k < 2; ++k) dst[m][k] = *(const PG8_LAS bf16x8*)(lds + PG8_SA(b, h) + aoff + m * 2048 + k * 1024); } while (0)
#define PG8_LDB(dst, b, h) do { _Pragma("unroll") for (int n = 0; n < 2; ++n) _Pragma("unroll") for (int k = 0; k < 2; ++k) dst[n][k] = *(const PG8_LAS bf16x8*)(lds + PG8_SB(b, h) + boff + n * 2048 + k * 1024); } while (0)
#define PG8_MMA(ai, bj, At, Bt) do { __builtin_amdgcn_s_setprio(1); _Pragma("unroll") for (int m = 0; m < 4; ++m) _Pragma("unroll") for (int n = 0; n < 2; ++n) _Pragma("unroll") for (int k = 0; k < 2; ++k) \
        acc[ai][bj][m][n] = __builtin_amdgcn_mfma_f32_16x16x32_bf16(Bt[n][k], At[m][k], acc[ai][bj][m][n], 0, 0, 0); __builtin_amdgcn_s_setprio(0); } while (0)
#define PG8_WAIT_V(n) asm volatile("s_waitcnt vmcnt(" #n ")" ::: "memory")
#define PG8_WAIT_L(n) asm volatile("s_waitcnt lgkmcnt(" #n ")" ::: "memory")
#define PG8_BAR __builtin_amdgcn_s_barrier()
#define PG8_SCHED __builtin_amdgcn_sched_barrier(0)
    Unit cur, nxt; int ui = 0;
    if (!S.next(0, cur)) return;
    f32x4 acc[2][2][4][2];
#pragma unroll
    for (int a = 0; a < 2; ++a)
#pragma unroll
        for (int b = 0; b < 2; ++b)
#pragma unroll
            for (int m = 0; m < 4; ++m)
#pragma unroll
                for (int n = 0; n < 2; ++n) acc[a][b][m][n] = (f32x4){0.f, 0.f, 0.f, 0.f};
    bf16x8 At[4][2], B0[2][2], B1[2][2];
    const char* cA = (const char*)g.A + (size_t)cur.pm * tstep; const char* cB = (const char*)g.Bt + (size_t)cur.pn * tstep;
    S.a_ready(cur);
    if constexpr (SP2) {
        PG8_STAGE(PG8_SB(0, 0), cB, voffB); PG8_STAGE(PG8_SB(0, 1), cB + hstep, voffB); PG8_STAGE(PG8_SA(0, 0), cA, voffA); PG8_STAGE(PG8_SA(0, 1), cA + hstep, voffA);
        if (wr == 1) PG8_BAR;
        PG8_WAIT_V(2); PG8_BAR;
        PG8_STAGE(PG8_SB(1, 0), cB + kstep, voffB); PG8_STAGE(PG8_SA(1, 0), cA + kstep, voffA); PG8_STAGE(PG8_SB(1, 1), cB + hstep + kstep, voffB);
        PG8_WAIT_V(6); PG8_BAR;
    } else {
        PG8_STAGE(PG8_SB(0, 0), cB, voffB); PG8_STAGE(PG8_SA(0, 0), cA, voffA); PG8_STAGE(PG8_SB(0, 1), cB + hstep, voffB); PG8_STAGE(PG8_SA(0, 1), cA + hstep, voffA);
        if (wr == 1) PG8_BAR;
        PG8_WAIT_V(4); PG8_BAR;
        PG8_STAGE(PG8_SB(1, 0), cB + kstep, voffB); PG8_STAGE(PG8_SA(1, 0), cA + kstep, voffA); PG8_STAGE(PG8_SB(1, 1), cB + hstep + kstep, voffB);
        PG8_WAIT_V(6); PG8_BAR;
    }
    for (;;) {
        const bool has_next = S.next(ui + 1, nxt);
        const char* nA = has_next ? (const char*)g.A + (size_t)nxt.pm * tstep : cA; const char* nB = has_next ? (const char*)g.Bt + (size_t)nxt.pn * tstep : cB;
        for (int t = 0; t < nt; t += 2) {
            const bool last = (t == nt - 2);
            const char* a1 = cA + (size_t)(t + 1) * kstep;
            const char* a2 = last ? nA : cA + (size_t)(t + 2) * kstep; const char* b2 = last ? nB : cB + (size_t)(t + 2) * kstep;
            const char* a3 = a2 + kstep; const char* b3 = b2 + kstep;
            if (last && has_next) S.a_ready(nxt);
            if constexpr (SP2) {
            PG8_LDB(B0, 0, 0); PG8_LDB(B1, 0, 1); PG8_SCHED; PG8_LDA(At, 0, 0); PG8_STAGE(PG8_SA(1, 1), a1 + hstep, voffA);
            PG8_WAIT_V(8); PG8_WAIT_L(0); PG8_BAR; PG8_MMA(0, 0, At, B0); PG8_MMA(0, 1, At, B1); PG8_BAR; PG8_SCHED;
            PG8_LDA(At, 0, 1); PG8_STAGE(PG8_SB(0, 0), b2, voffB); PG8_STAGE(PG8_SB(0, 1), b2 + hstep, voffB); PG8_STAGE(PG8_SA(0, 0), a2, voffA);
            PG8_WAIT_V(8); PG8_WAIT_L(0); PG8_BAR; PG8_MMA(1, 0, At, B0); PG8_MMA(1, 1, At, B1); PG8_BAR; PG8_SCHED;
            PG8_LDB(B0, 1, 0); PG8_LDB(B1, 1, 1); PG8_SCHED; PG8_LDA(At, 1, 0); PG8_STAGE(PG8_SA(0, 1), a2 + hstep, voffA);
            PG8_WAIT_V(8); PG8_WAIT_L(0); PG8_BAR; PG8_MMA(0, 0, At, B0); PG8_MMA(0, 1, At, B1); PG8_BAR; PG8_SCHED;
            PG8_LDA(At, 1, 1); PG8_STAGE(PG8_SB(1, 0), b3, voffB); PG8_STAGE(PG8_SB(1, 1), b3 + hstep, voffB); PG8_STAGE(PG8_SA(1, 0), a3, voffA);
            PG8_WAIT_V(8); PG8_WAIT_L(0); PG8_BAR; PG8_MMA(1, 0, At, B0); PG8_MMA(1, 1, At, B1); PG8_BAR; PG8_SCHED;
            } else {
            PG8_LDB(B0, 0, 0); PG8_SCHED; PG8_LDA(At, 0, 0); PG8_STAGE(PG8_SA(1, 1), a1 + hstep, voffA);
            PG8_WAIT_L(8); PG8_BAR; PG8_WAIT_L(0); PG8_MMA(0, 0, At, B0); PG8_BAR; PG8_SCHED;
            PG8_LDB(B1, 0, 1); PG8_STAGE(PG8_SB(0, 0), b2, voffB);
            PG8_BAR; PG8_WAIT_L(0); PG8_MMA(0, 1, At, B1); PG8_BAR;
            PG8_LDA(At, 0, 1); PG8_STAGE(PG8_SA(0, 0), a2, voffA);
            PG8_BAR; PG8_WAIT_L(0); PG8_MMA(1, 0, At, B0); PG8_BAR; PG8_SCHED;
            PG8_STAGE(PG8_SB(0, 1), b2 + hstep, voffB);
            PG8_WAIT_V(6); PG8_BAR; PG8_MMA(1, 1, At, B1); PG8_BAR;
            PG8_LDB(B0, 1, 0); PG8_SCHED; PG8_LDA(At, 1, 0); PG8_STAGE(PG8_SA(0, 1), a2 + hstep, voffA);
            PG8_WAIT_L(8); PG8_BAR; PG8_WAIT_L(0); PG8_MMA(0, 0, At, B0); PG8_BAR; PG8_SCHED;
            PG8_LDB(B1, 1, 1); PG8_STAGE(PG8_SB(1, 0), b3, voffB);
            PG8_BAR; PG8_WAIT_L(0); PG8_MMA(0, 1, At, B1); PG8_BAR;
            PG8_LDA(At, 1, 1); PG8_STAGE(PG8_SA(1, 0), a3, voffA);
            PG8_BAR; PG8_WAIT_L(0); PG8_MMA(1, 0, At, B0); PG8_BAR; PG8_SCHED;
            PG8_STAGE(PG8_SB(1, 1), b3 + hstep, voffB);
            PG8_WAIT_V(6); PG8_BAR; PG8_MMA(1, 1, At, B1); PG8_BAR;
            }
        }
        if constexpr (ALIGN_EPI) { if (wr == 0) PG8_BAR; }
        if constexpr (!Epi::AFTER_DRAIN) { E(acc, cur, wr, wc, fr, fq); S.done(cur); }
        if (!has_next) break;
#pragma unroll
        for (int a = 0; a < 2; ++a)
#pragma unroll
            for (int b = 0; b < 2; ++b)
#pragma unroll
                for (int m = 0; m < 4; ++m)
#pragma unroll
                    for (int n = 0; n < 2; ++n) acc[a][b][m][n] = (f32x4){0.f, 0.f, 0.f, 0.f};
        cur = nxt; cA = nA; cB = nB; ++ui;
        if constexpr (ALIGN_EPI) { if (wr == 1) PG8_BAR; }
    }
    PG8_WAIT_V(0);
    if constexpr (!ALIGN_EPI) { if (wr == 0) PG8_BAR; }
    PG8_BAR;
    if constexpr (Epi::AFTER_DRAIN) { E.fused(acc, cur, wr, wc, fr, fq, lds, wid, lane); S.done(cur); }
#undef PG8_SA
#undef PG8_SB
#undef PG8_STAGE
#undef PG8_LDA
#undef PG8_LDB
#undef PG8_MMA
#undef PG8_WAIT_V
#undef PG8_WAIT_L
#undef PG8_BAR
#undef PG8_SCHED
}

struct EpiStoreT {
    static constexpr bool PERM = true, AFTER_DRAIN = false;
    bf16_t* O0; int ld0; int split; bf16_t* O1; int ld1;
    __device__ __forceinline__ void operator()(const f32x4 (&acc)[2][2][4][2], const Unit& u, int wr, int wc, int fr, int fq) const {
        const int row0 = u.pm * BM + wr * 64 + fr; int colt = u.pn * BM; bf16_t* base = O0; int ld = ld0;
        if (colt >= split) { base = O1; ld = ld1; colt -= split; }
        const int col0 = colt + wc * 32 + 8 * fq;
#pragma unroll
        for (int ai = 0; ai < 2; ++ai)
#pragma unroll
            for (int m = 0; m < 4; ++m) { bf16_t* rowp = base + (size_t)(row0 + ai * HALF + m * 16) * ld + col0;
#pragma unroll
                for (int bj = 0; bj < 2; ++bj) { const f32x4 v0 = acc[ai][bj][m][0], v1 = acc[ai][bj][m][1];
                    u32x4 w; w.x = cvt_pk_bf16(v0[0], v0[1]); w.y = cvt_pk_bf16(v0[2], v0[3]); w.z = cvt_pk_bf16(v1[0], v1[1]); w.w = cvt_pk_bf16(v1[2], v1[3]);
                    *(u32x4*)(rowp + bj * HALF) = w; } }
    }
};
struct EpiResidT {
    static constexpr bool PERM = true, AFTER_DRAIN = false;
    PPtr p; const float* gate;
    __device__ __forceinline__ void operator()(const f32x4 (&acc)[2][2][4][2], const Unit& u, int wr, int wc, int fr, int fq) const {
        float* xb = xrow_ptr(p, u.pm * BM); const float* g = gate + mod_idx(u.pm * BM) * 6144;
        const int col0 = u.pn * BM + wc * 32 + 8 * fq;
#pragma unroll
        for (int ai = 0; ai < 2; ++ai)
#pragma unroll
            for (int m = 0; m < 4; ++m) { float* xr = xb + (size_t)(ai * HALF + wr * 64 + m * 16 + fr) * DM;
#pragma unroll
                for (int bj = 0; bj < 2; ++bj) { const int col = col0 + bj * HALF; const f32x4 v0 = acc[ai][bj][m][0], v1 = acc[ai][bj][m][1];
                    const f32x4 g0 = *(const f32x4*)(g + col), g1 = *(const f32x4*)(g + col + 4);
                    f32x4 x0 = *(const f32x4*)(xr + col), x1 = *(const f32x4*)(xr + col + 4);
                    x0 += g0 * v0; x1 += g1 * v1;
                    *(f32x4*)(xr + col) = x0; *(f32x4*)(xr + col + 4) = x1; } }
    }
};
struct EpiSwigluT {
    static constexpr bool PERM = true, AFTER_DRAIN = false;
    bf16_t* H;
    __device__ __forceinline__ void operator()(const f32x4 (&acc)[2][2][4][2], const Unit& u, int wr, int wc, int fr, int fq) const {
        const int row0 = u.pm * BM + wr * 64 + fr; const int col0 = u.pn * BM + wc * 32 + 8 * fq;
#pragma unroll
        for (int ai = 0; ai < 2; ++ai)
#pragma unroll
            for (int m = 0; m < 4; ++m) { bf16_t* rowp = H + (size_t)(row0 + ai * HALF + m * 16) * FFH;
#pragma unroll
                for (int bj = 0; bj < 2; ++bj) { const f32x4 gt = acc[ai][bj][m][0], up = acc[ai][bj][m][1];
                    float h[4];
#pragma unroll
                    for (int j = 0; j < 4; ++j) h[j] = gt[j] * sigmoidf_(gt[j]) * up[j];
                    uint2 w; w.x = cvt_pk_bf16(h[0], h[1]); w.y = cvt_pk_bf16(h[2], h[3]);
                    *(uint2*)(rowp + ((col0 + bj * HALF) >> 1)) = w; } }
    }
};

struct EpiLoraT {
    static constexpr bool PERM = true, AFTER_DRAIN = false;
    float* DEC; bf16_t* KD; bf16_t* BQ; bf16_t* G; const bf16_t* KK; const bf16_t* ZDb;
    const float* w0; const float* a0; const float* ka; const float* muk;
    template <int TYPE>
    __device__ __forceinline__ void one(const f32x4 v, int r, int c, int d) const {
        if (TYPE == 0) {
            const float4 wa = *(const float4*)(w0 + d * 512 + c);
            const float ww[4] = {wa.x, wa.y, wa.z, wa.w};
            float o[4];
#pragma unroll
            for (int e = 0; e < 4; ++e) { const float x = -(ww[e] + v[e]); const float sp = x > 20.f ? x : __logf(1.f + __expf(x)); o[e] = __expf(-__expf(-sp - 0.5f)); }
            *(float4*)(DEC + ((size_t)r * 2 + d) * 512 + c) = (float4){o[0], o[1], o[2], o[3]};
        } else if (TYPE == 1) {
            const float4 aa = *(const float4*)(a0 + d * 512 + c), ka0 = *(const float4*)(ka + c), m0 = *(const float4*)(muk + c);
            const float a0v[4] = {aa.x, aa.y, aa.z, aa.w}, kav[4] = {ka0.x, ka0.y, ka0.z, ka0.w}, mm[4] = {m0.x, m0.y, m0.z, m0.w};
            const bool lat = r < SEQ; const int lo = lat ? 0 : SEQ, hi = lat ? SEQ : RPB;
            const bf16_t* zc = ZDb + (size_t)r * ZDW + 512 + c;
            const bool hp = r - 1 >= lo, hn = r + 1 < hi;
            const uint2 uz = *(const uint2*)zc, up = *(const uint2*)(hp ? zc - ZDW : zc), un = *(const uint2*)(hn ? zc + ZDW : zc), uk = *(const uint2*)(KK + (size_t)r * 512 + c);
            const float z[4] = {bflo(uz.x), bfhi(uz.x), bflo(uz.y), bfhi(uz.y)}, zp[4] = {bflo(up.x), bfhi(up.x), bflo(up.y), bfhi(up.y)};
            const float zn[4] = {bflo(un.x), bfhi(un.x), bflo(un.y), bfhi(un.y)}, kk[4] = {bflo(uk.x), bfhi(uk.x), bflo(uk.y), bfhi(uk.y)};
            const float fp = hp ? 0.5f : 0.f, fn = hn ? 0.5f : 0.f;
            float okd[4], obq[4];
#pragma unroll
            for (int e = 0; e < 4; ++e) {
                const float a = sigmoidf_(a0v[e] + v[e]);
                const float k = z[e] + ((fp * zp[e] + fn * zn[e]) - z[e]) * mm[e];
                okd[e] = k * (1.f + (a - 1.f) * kav[e]); obq[e] = kk[e] * a;
            }
            uint2 w1; w1.x = pk2(okd[0], okd[1]); w1.y = pk2(okd[2], okd[3]); *(uint2*)(KD + ((size_t)r * 2 + d) * 512 + c) = w1;
            uint2 w2; w2.x = pk2(obq[0], obq[1]); w2.y = pk2(obq[2], obq[3]); *(uint2*)(BQ + ((size_t)r * 2 + d) * 512 + c) = w2;
        } else {
            uint2 w; w.x = pk2(v[0], v[1]); w.y = pk2(v[2], v[3]); *(uint2*)(G + (size_t)r * 512 + c) = w;
        }
    }
    template <int TYPE>
    __device__ __forceinline__ void all(const f32x4 (&acc)[2][2][4][2], const Unit& u, int wr, int wc, int fr, int fq) const {
        const int d = (u.pn >> 1) & 1, cb = (u.pn & 1) * 256 + wc * 32 + 8 * fq;
#pragma unroll
        for (int ai = 0; ai < 2; ++ai)
#pragma unroll
            for (int m = 0; m < 4; ++m)
#pragma unroll
                for (int bj = 0; bj < 2; ++bj)
                {   const int r = u.pm * BM + ai * HALF + wr * 64 + m * 16 + fr, c = cb + bj * HALF;
                    one<TYPE>(acc[ai][bj][m][0], r, c, d); one<TYPE>(acc[ai][bj][m][1], r, c + 4, d); }
    }
    __device__ __forceinline__ void operator()(const f32x4 (&acc)[2][2][4][2], const Unit& u, int wr, int wc, int fr, int fq) const {
        const int type = u.pn >> 1;
        if (type < 2) all<0>(acc, u, wr, wc, fr, fq); else if (type < 4) all<1>(acc, u, wr, wc, fr, fq); else all<2>(acc, u, wr, wc, fr, fq);
    }
};
}

DEV void transpose_item(const float* W, int K, int N, u16* WT, int mode, float* scr, int item, int lane) {
    const int nblk = N / 32, kb = item / nblk, nb = item - kb * nblk, k0 = 64 * kb, n0 = 32 * nb;
#pragma unroll 8
    for (int i = 0; i < 32; ++i) { const int kk = 2 * i + (lane >> 5); scr[kk * 33 + (lane & 31)] = W[(size_t)(k0 + kk) * N + n0 + (lane & 31)]; }
    asm volatile("s_waitcnt lgkmcnt(0)" ::: "memory");
    const int c = lane & 7;
#pragma unroll
    for (int j = 0; j < 4; ++j) {
        const int n = (lane >> 3) + 8 * j; const float* sp = scr + (8 * c) * 33 + n;
        uint4 o; o.x = pk2(sp[0 * 33], sp[1 * 33]); o.y = pk2(sp[2 * 33], sp[3 * 33]); o.z = pk2(sp[4 * 33], sp[5 * 33]); o.w = pk2(sp[6 * 33], sp[7 * 33]);
        const int ns = n0 + n;
        int drow = ns;
        if (mode) { const int nn = ns >= FFH ? 1 : 0; const int g = ns - nn * FFH; drow = 8 * (g >> 2) + 4 * nn + (g & 3); }
        *(uint4*)(WT + (size_t)drow * K + k0 + 8 * c) = o;
    }
    asm volatile("s_waitcnt lgkmcnt(0)" ::: "memory");
}
constexpr size_t WB_IN = 0, WB_OUT = (size_t)3328 * 1024, WB_F1 = WB_OUT + (size_t)1024 * 1024, WB_F2 = WB_F1 + (size_t)5632 * 1024;
DEV void phase_wprep(PPtr p, int layer, char* lds) {
    const int tid = tidx(), lane = tid & 63, wave = tid >> 6, gw = blockIdx.x * NWAVE + wave, ngw = gridDim.x * NWAVE;
    float* scr = (float*)lds + wave * (64 * 33);
    u16* WB = (u16*)(p->ws + OFF_WB);
    const int li = layer >> 1, odd = layer & 1;
    const int nin = odd ? 3328 : 1536;
    const float* win = odd ? p->in[13] + (size_t)li * DM * 3328 : p->in[8] + (size_t)li * DM * 1536;
    const float* wout = (odd ? p->in[14] : p->in[9]) + (size_t)li * DM * DM;
    const float* wf1 = p->in[27] + (size_t)layer * DM * 5632; const float* wf2 = p->in[28] + (size_t)layer * FFH * DM;
    const int i0 = 16 * (nin / 32), i1 = i0 + 16 * 32, i2 = i1 + 16 * 176, i3 = i2 + 44 * 32;
    for (int it = gw; it < i3; it += ngw) {
        if (it < i0) transpose_item(win, DM, nin, WB + WB_IN, 0, scr, it, lane);
        else if (it < i1) transpose_item(wout, DM, DM, WB + WB_OUT, 0, scr, it - i0, lane);
        else if (it < i2) transpose_item(wf1, DM, 5632, WB + WB_F1, 1, scr, it - i1, lane);
        else transpose_item(wf2, FFH, DM, WB + WB_F2, 0, scr, it - i2, lane);
    }
}

#include <hip/hip_bf16.h>
#include <cmath>
namespace attn_body {
using bf16=__hip_bfloat16;
using bf16x8=__attribute__((ext_vector_type(8)))short;
using s16x4=__attribute__((ext_vector_type(4)))short;
using f32x16=__attribute__((ext_vector_type(16)))float;
using u32x4=__attribute__((ext_vector_type(4)))unsigned;
constexpr int D=64,PQ=1536,PO=1024,KROWS=16640,RPBA=16640;
constexpr int NW=8,QBLK=32,QB=QBLK*NW,KVBLK=64;
constexpr int ATTN_UNIT_ROWS=QB;
__device__ __forceinline__ int crow(int r,int hi){return (r&3)+8*(r>>2)+4*hi;}
#define SBAR() __builtin_amdgcn_sched_barrier(0)
__device__ __forceinline__ void cmask(f32x16&p0,f32x16&p1,int jb,int qrel,int hi){
  const float NEG=-INFINITY; int kb=64*jb+4*hi;
  #pragma unroll
  for(int r=0;r<16;++r){int kv=kb+(r&3)+8*(r>>2); if(kv>qrel)p0[r]=NEG; if(kv+32>qrel)p1[r]=NEG;}
}

constexpr int NSLOT=3, SLOTB=8192;
constexpr int LDS_K=0, LDS_V=NSLOT*SLOTB, LDS_WS=2*NSLOT*SLOTB, LDS_OST=LDS_WS+NW*64*4, LDS_BYTES=LDS_OST+NW*4096;
constexpr float C2=0.125f*1.4426950408889634f;
__device__ __forceinline__ void glds16(const void*gsrc,unsigned lds_dst){unsigned keep;
  asm volatile("s_mov_b32 %0, m0\n\ts_mov_b32 m0, %2\n\ts_nop 0\n\tglobal_load_lds_dwordx4 %1, off\n\ts_mov_b32 m0, %0":"=&s"(keep):"v"(gsrc),"s"(lds_dst):"memory");}
__device__ __forceinline__ float max3f(float a,float b,float c){float r;asm("v_max3_f32 %0, %1, %2, %3":"=v"(r):"v"(a),"v"(b),"v"(c));return r;}
__device__ __forceinline__ float max2f(float a,float b){float r;asm("v_max_f32_e32 %0, %1, %2":"=v"(r):"v"(a),"v"(b));return r;}
__device__ __forceinline__ float fadd_s(float a,float b){float r;asm("v_add_f32_e32 %0, %1, %2":"=v"(r):"v"(a),"v"(b));return r;}
__device__ __forceinline__ float fsub_s(float a,float b){float r;asm("v_sub_f32_e32 %0, %1, %2":"=v"(r):"v"(a),"v"(b));return r;}
typedef float f32x2_t __attribute__((ext_vector_type(2))); typedef __bf16 bf16x2_t __attribute__((ext_vector_type(2)));
__device__ __forceinline__ unsigned cvtpk_s(float lo,float hi){f32x2_t v={lo,hi};bf16x2_t b=__builtin_convertvector(v,bf16x2_t);return __builtin_bit_cast(unsigned,b);}
#define WAIT_BAR(N) asm volatile("s_waitcnt vmcnt(" #N ") lgkmcnt(0)\n\ts_barrier":::"memory")

__device__ __forceinline__ void qkt(f32x16&p0,f32x16&p1,const char*Kslot,const bf16x8*qr,const f32x16&negm,int r32,int hi){
  const char*kb=Kslot+hi*1024+r32*16;
  #pragma unroll
  for(int d0=0;d0<4;++d0){
    const bf16x8 b0=*reinterpret_cast<const bf16x8*>(kb+d0*2048);
    const bf16x8 b1=*reinterpret_cast<const bf16x8*>(kb+d0*2048+512);
    if(d0==0){p0=__builtin_amdgcn_mfma_f32_32x32x16_bf16(b0,qr[0],negm,0,0,0);p1=__builtin_amdgcn_mfma_f32_32x32x16_bf16(b1,qr[0],negm,0,0,0);}
    else{p0=__builtin_amdgcn_mfma_f32_32x32x16_bf16(b0,qr[d0],p0,0,0,0);p1=__builtin_amdgcn_mfma_f32_32x32x16_bf16(b1,qr[d0],p1,0,0,0);}}
}
typedef __attribute__((address_space(3))) const char* lds_cptr;
typedef short v4i16_t __attribute__((ext_vector_type(4)));
__device__ __forceinline__ void kload8(bf16x8*kf,lds_cptr kp){
  kf[0]=*(const __attribute__((address_space(3))) bf16x8*)(kp);      kf[1]=*(const __attribute__((address_space(3))) bf16x8*)(kp+512);
  kf[2]=*(const __attribute__((address_space(3))) bf16x8*)(kp+2048); kf[3]=*(const __attribute__((address_space(3))) bf16x8*)(kp+2560);
  kf[4]=*(const __attribute__((address_space(3))) bf16x8*)(kp+4096); kf[5]=*(const __attribute__((address_space(3))) bf16x8*)(kp+4608);
  kf[6]=*(const __attribute__((address_space(3))) bf16x8*)(kp+6144); kf[7]=*(const __attribute__((address_space(3))) bf16x8*)(kp+6656);
}
__device__ __forceinline__ void kload2(bf16x8*kf,lds_cptr kp,int j){ kf[2*j]=*(const __attribute__((address_space(3))) bf16x8*)(kp+j*2048); kf[2*j+1]=*(const __attribute__((address_space(3))) bf16x8*)(kp+j*2048+512); }
__device__ __forceinline__ s16x4 vtr(lds_cptr p){ return __builtin_bit_cast(s16x4,__builtin_amdgcn_ds_read_tr16_b64_v4i16((__attribute__((address_space(3))) v4i16_t*)p)); }
__device__ __forceinline__ float rowmax(const f32x16&p0,const f32x16&p1){
  float a=max3f(p0[0],p0[1],p1[0]),b=max3f(p0[2],p0[3],p1[1]);a=max3f(a,p1[2],p1[3]);
  #pragma unroll
  for(int r=4;r<16;r+=4){a=max3f(a,p0[r],p0[r+1]);b=max3f(b,p0[r+2],p0[r+3]);a=max3f(a,p1[r],p1[r+1]);b=max3f(b,p1[r+2],p1[r+3]);}
  const float m=max2f(a,b);
  auto rr=__builtin_amdgcn_permlane32_swap(__float_as_uint(m),__float_as_uint(m),false,false);
  return max2f(__uint_as_float(rr[0]),__uint_as_float(rr[1]));
}
__device__ __forceinline__ void pv(f32x16*o,int vb,bf16x8 pa0,bf16x8 pa1,bf16x8 pa2,bf16x8 pa3){
  #pragma unroll
  for(int d0=0;d0<2;++d0){s16x4 lo[4],hi[4];
    #pragma unroll
    for(int ks=0;ks<4;++ks){
      asm volatile("ds_read_b64_tr_b16 %0,%1 offset:%c2":"=&v"(lo[ks]):"v"(vb),"i"(d0*4096+ks*1024):"memory");
      asm volatile("ds_read_b64_tr_b16 %0,%1 offset:%c2":"=&v"(hi[ks]):"v"(vb),"i"(d0*4096+ks*1024+512):"memory");}
    asm volatile("s_waitcnt lgkmcnt(0)":::"memory");SBAR();
    #define PK(k) (bf16x8){lo[k][0],lo[k][1],lo[k][2],lo[k][3],hi[k][0],hi[k][1],hi[k][2],hi[k][3]}
    o[d0]=__builtin_amdgcn_mfma_f32_32x32x16_bf16(pa0,PK(0),o[d0],0,0,0);
    o[d0]=__builtin_amdgcn_mfma_f32_32x32x16_bf16(pa1,PK(1),o[d0],0,0,0);
    o[d0]=__builtin_amdgcn_mfma_f32_32x32x16_bf16(pa2,PK(2),o[d0],0,0,0);
    o[d0]=__builtin_amdgcn_mfma_f32_32x32x16_bf16(pa3,PK(3),o[d0],0,0,0);
    #undef PK
  }
}

#ifndef ATTN_STORE16
#define ATTN_STORE16(p,v) (*(u32x4*)(p)=(v))
#endif
template<int THRL> __device__ __forceinline__ void attn_unit(int b,int h,int qb,const bf16*Q,const bf16*__restrict__ K,const bf16*__restrict__ V,bf16*O,char*shm){
  const int tid=tidx(),lane=tid&63,r32=lane&31,hi=lane>>5; const int wid=__builtin_amdgcn_readfirstlane(tid>>6);
  const long rowbase=(long)b*RPBA; const int q0=qb*QB;
  const bf16*Qw=Q+(rowbase+q0+wid*QBLK)*PQ+h*D;
  const bf16*Kh=K+rowbase*PQ+(h>>2)*D,*Vh=V+rowbase*PQ+(h>>2)*D;
  const unsigned lds0=(unsigned)(uintptr_t)shm;
  float*wsf=(float*)(shm+LDS_WS)+wid*64;
  const bf16*ksrc=Kh+(long)lane*PQ+wid*8;
  const bf16*vsrc=Vh+(long)(16*(wid&3)+(lane>>2))*PQ+(wid>>2)*32+(lane&3)*8;
  const unsigned kdst=lds0+LDS_K+wid*1024, vdst=lds0+LDS_V+wid*1024;
  #define DMA_K(t,slot) glds16(ksrc+(long)(t)*KVBLK*PQ,(unsigned)__builtin_amdgcn_readfirstlane(kdst+(slot)))
  #define DMA_V(t,slot) glds16(vsrc+(long)(t)*KVBLK*PQ,(unsigned)__builtin_amdgcn_readfirstlane(vdst+(slot)))
  const int vb0=(int)(lds0+LDS_V)+((lane>>4)&1)*32+(lane&3)*8+(4*hi+((lane&15)>>2))*64;
  const char*Kbase=shm+LDS_K; bf16x8 kf[8];
  const lds_cptr shm3=(lds_cptr)shm; const lds_cptr kp0=shm3+LDS_K+hi*1024+r32*16; const lds_cptr vp0=shm3+LDS_V+((lane>>4)&1)*32+(lane&3)*8+(4*hi+((lane&15)>>2))*64;
  const int NT=KROWS/KVBLK;
  DMA_K(0,0);DMA_V(0,0);DMA_K(1,SLOTB);
  bf16x8 qr[4];
  #pragma unroll
  for(int d0=0;d0<4;++d0)qr[d0]=*reinterpret_cast<const bf16x8*>(&Qw[(long)r32*PQ+d0*16+hi*8]);
  float mhat=0.f,l_reg=0.f;f32x16 o[2];o[0]=f32x16{};o[1]=f32x16{};f32x16 negm=f32x16{};asm volatile("":"+v"(negm));
  const int qrel=wid*QBLK+r32;
  #define CMASK(P0,P1,t) do{}while(0)
  bool resc=false;
  #define START(P0,P1) do{ const float rm=rowmax(P0,P1); resc=false; \
    { const float dl=rm; mhat=fadd_s(mhat,dl); \
      _Pragma("unroll") for(int r=0;r<16;++r){P0[r]=fsub_s(P0[r],dl);P1[r]=fsub_s(P1[r],dl);} \
      _Pragma("unroll") for(int r=0;r<16;++r)negm[r]=-mhat; asm volatile("":"+v"(negm)); } \
    _Pragma("unroll") for(int r=0;r<16;++r)P0[r]=__builtin_amdgcn_exp2f(P0[r]); }while(0)
  #define RESC() do{ if(resc){ asm volatile("s_waitcnt lgkmcnt(0)":::"memory"); \
      _Pragma("unroll") for(int d_=0;d_<2;++d_) _Pragma("unroll") for(int r=0;r<16;++r)o[d_][r]*=wsf[crow(r,hi)]; } }while(0)
  f32x16 pA0,pA1,pB0,pB1;
  int sl_prev=0,sl_cur=0,sl_next=SLOTB;
  #define ROT() do{sl_prev=sl_cur;sl_cur=sl_next;sl_next=(sl_next==(NSLOT-1)*SLOTB)?0:sl_next+SLOTB;}while(0)
  DMA_K(2,2*SLOTB);
  WAIT_BAR(3);
  qkt(pA0,pA1,Kbase,qr,negm,r32,hi);asm volatile("s_nop 15\n\ts_nop 7":"+v"(pA0),"+v"(pA1));CMASK(pA0,pA1,0);
  START(pA0,pA1);
  _Pragma("unroll") for(int r=0;r<16;++r)pA1[r]=__builtin_amdgcn_exp2f(pA1[r]);
  WAIT_BAR(0);
  DMA_K(3,0);DMA_V(1,SLOTB);
  ROT();
  kload8(kf,kp0+sl_cur);
  WAIT_BAR(2);
  s16x4 vlo[8],vhi[8]; u32x4 pw0,pw1,pw2,pw3;
  #define PKW(P,B) cvtpk_s(P[B],P[B+1])
  #define PAF(k) __builtin_bit_cast(bf16x8,pw##k)
  #define VFR(i) (bf16x8){vlo[i][0],vlo[i][1],vlo[i][2],vlo[i][3],vhi[i][0],vhi[i][1],vhi[i][2],vhi[i][3]}
  #define PIN(x) asm volatile("":"+v"(x))
  #define MX3(a,b,c) __builtin_fmaxf(__builtin_fmaxf((a),(b)),(c))
  #define GAPA(MF,A0,A1,A2,A3,W0,W1,PW) do{ MF; sacc+=A0; sacc+=A1; sacc+=A2; sacc+=A3; PIN(sacc); W0; W1; PIN(PW); SBAR(); }while(0)
  #define EX(v) __builtin_amdgcn_exp2f(v)
  #define GAPB(MF,X,B) do{ MF; X[B]=EX(X[B]); X[B+1]=EX(X[B+1]); X[B+2]=EX(X[B+2]); X[B+3]=EX(X[B+3]); PIN(X); SBAR(); }while(0)
  #define VRD(i) do{ vlo[i]=vtr(vp_+(((i)>>2)*4096+((i)&3)*1024)); vhi[i]=vtr(vp_+(((i)>>2)*4096+((i)&3)*1024+512)); }while(0)
  #define KRD(G,j) do{ if(G){ kload2(kf,kp0+sl_next,j); SBAR(); } }while(0)
  #define STEP(C0,C1,P0,P1,t,GK,GV,GL) do{ SBAR(); \
    const lds_cptr vp_=vp0+sl_prev; \
    VRD(0); SBAR(); float sacc=(P0[0]+P0[1]); \
    GAPA(C0=__builtin_amdgcn_mfma_f32_32x32x16_bf16(kf[0],qr[0],negm,0,0,0), P0[2],P0[3],P0[4],P0[5],     pw0[0]=PKW(P0,0), pw0[1]=PKW(P0,2), pw0); \
    VRD(4); SBAR(); GAPA(C1=__builtin_amdgcn_mfma_f32_32x32x16_bf16(kf[1],qr[0],negm,0,0,0), P0[6],P0[7],P0[8],P0[9],     pw0[2]=PKW(P0,4), pw0[3]=PKW(P0,6), pw0); \
    VRD(1); SBAR(); GAPA(C0=__builtin_amdgcn_mfma_f32_32x32x16_bf16(kf[2],qr[1],C0,0,0,0),   P0[10],P0[11],P0[12],P0[13], pw1[0]=PKW(P0,8), pw1[1]=PKW(P0,10), pw1); \
    VRD(5); SBAR(); GAPA(C1=__builtin_amdgcn_mfma_f32_32x32x16_bf16(kf[3],qr[1],C1,0,0,0),   P0[14],P0[15],P1[0],P1[1],   pw1[2]=PKW(P0,12),pw1[3]=PKW(P0,14), pw1); \
    VRD(2); SBAR(); GAPA(C0=__builtin_amdgcn_mfma_f32_32x32x16_bf16(kf[4],qr[2],C0,0,0,0),   P1[2],P1[3],P1[4],P1[5],     pw2[0]=PKW(P1,0), pw2[1]=PKW(P1,2), pw2); \
    VRD(6); SBAR(); GAPA(C1=__builtin_amdgcn_mfma_f32_32x32x16_bf16(kf[5],qr[2],C1,0,0,0),   P1[6],P1[7],P1[8],P1[9],     pw2[2]=PKW(P1,4), pw2[3]=PKW(P1,6), pw2); \
    VRD(3); SBAR(); GAPA(C0=__builtin_amdgcn_mfma_f32_32x32x16_bf16(kf[6],qr[3],C0,0,0,0),   P1[10],P1[11],P1[12],P1[13], pw3[0]=PKW(P1,8), pw3[1]=PKW(P1,10), pw3); \
    VRD(7); SBAR(); GAPA(C1=__builtin_amdgcn_mfma_f32_32x32x16_bf16(kf[7],qr[3],C1,0,0,0),   P1[14],P1[15],0.f,0.f,       pw3[2]=PKW(P1,12),pw3[3]=PKW(P1,14), pw3); \
    l_reg+=sacc; \
    if(GK){DMA_K((t)+3,sl_cur);} if(GV){DMA_V((t)+1,sl_next);} \
    CMASK(C0,C1,t); \
    { float a=MX3(C0[0],C0[1],C1[0]),b=MX3(C0[2],C0[3],C1[1]); a=MX3(a,C1[2],C1[3]); \
      _Pragma("unroll") for(int r=4;r<16;r+=4){a=MX3(a,C0[r],C0[r+1]);b=MX3(b,C0[r+2],C0[r+3]);a=MX3(a,C1[r],C1[r+1]);b=MX3(b,C1[r+2],C1[r+3]);} \
      float rm=__builtin_fmaxf(a,b); { auto rr=__builtin_amdgcn_permlane32_swap(__float_as_uint(rm),__float_as_uint(rm),false,false); rm=__builtin_fmaxf(__uint_as_float(rr[0]),__uint_as_float(rr[1])); } \
      resc=false; \
      if(__builtin_expect(__any(rm>(float)THRL),0)){ const float dl=__builtin_fmaxf(rm,0.f); mhat+=dl; \
        _Pragma("unroll") for(int r=0;r<16;++r){C0[r]-=dl;C1[r]-=dl;} \
        _Pragma("unroll") for(int r=0;r<16;++r)negm[r]=-mhat; asm volatile("":"+v"(negm)); \
        const float f=__builtin_amdgcn_exp2f(-dl); l_reg*=f; if(hi==0)wsf[r32]=f; resc=true; } } \
    SBAR(); \
    GAPB(o[0]=__builtin_amdgcn_mfma_f32_32x32x16_bf16(PAF(0),VFR(0),o[0],0,0,0), C0,0); \
    GAPB(o[1]=__builtin_amdgcn_mfma_f32_32x32x16_bf16(PAF(0),VFR(4),o[1],0,0,0), C0,4); \
    KRD(GL,0); GAPB(o[0]=__builtin_amdgcn_mfma_f32_32x32x16_bf16(PAF(1),VFR(1),o[0],0,0,0), C0,8); \
    KRD(GL,1); GAPB(o[1]=__builtin_amdgcn_mfma_f32_32x32x16_bf16(PAF(1),VFR(5),o[1],0,0,0), C0,12); \
    KRD(GL,2); GAPB(o[0]=__builtin_amdgcn_mfma_f32_32x32x16_bf16(PAF(2),VFR(2),o[0],0,0,0), C1,0); \
    KRD(GL,3); GAPB(o[1]=__builtin_amdgcn_mfma_f32_32x32x16_bf16(PAF(2),VFR(6),o[1],0,0,0), C1,4); \
    GAPB(o[0]=__builtin_amdgcn_mfma_f32_32x32x16_bf16(PAF(3),VFR(3),o[0],0,0,0), C1,8); \
    GAPB(o[1]=__builtin_amdgcn_mfma_f32_32x32x16_bf16(PAF(3),VFR(7),o[1],0,0,0), C1,12); \
    }while(0)
  int t=1;
  #undef CMASK
  #define CMASK(P0,P1,t) do{}while(0)
  for(;t+5<NT;t+=2){
    STEP(pB0,pB1,pA0,pA1,t,true,true,true);     WAIT_BAR(2); RESC(); ROT();
    STEP(pA0,pA1,pB0,pB1,t+1,true,true,true);   WAIT_BAR(2); RESC(); ROT();
  }
  #undef CMASK
  #define CMASK(P0,P1,t) do{}while(0)
  #define ENDW(tt) do{ if((tt)+3<NT){WAIT_BAR(2);} else if((tt)+2<NT){WAIT_BAR(1);} else {WAIT_BAR(0);} }while(0)
  for(;t+1<NT;t+=2){
    STEP(pB0,pB1,pA0,pA1,t,(t+3<NT),(t+1<NT),(t+1<NT));       ENDW(t);   RESC(); ROT();
    STEP(pA0,pA1,pB0,pB1,t+1,(t+4<NT),(t+2<NT),(t+2<NT));     ENDW(t+1); RESC(); ROT();
  }
  STEP(pB0,pB1,pA0,pA1,NT-1,false,false,false); RESC();
  { float sacc=pB0[0]+pB0[1]; _Pragma("unroll") for(int r=2;r<16;++r)sacc+=pB0[r]; _Pragma("unroll") for(int r=0;r<16;++r)sacc+=pB1[r]; l_reg+=sacc;
    pw0=(u32x4){PKW(pB0,0),PKW(pB0,2),PKW(pB0,4),PKW(pB0,6)};pw1=(u32x4){PKW(pB0,8),PKW(pB0,10),PKW(pB0,12),PKW(pB0,14)};pw2=(u32x4){PKW(pB1,0),PKW(pB1,2),PKW(pB1,4),PKW(pB1,6)};pw3=(u32x4){PKW(pB1,8),PKW(pB1,10),PKW(pB1,12),PKW(pB1,14)};
    SBAR(); pv(o,vb0+sl_cur,PAF(0),PAF(1),PAF(2),PAF(3)); }
  #undef PKW
  #undef PAF
  #undef VFR
  #undef PIN
  #undef MX3
  #undef GAPA
  #undef GAPB
  #undef EX
  #undef VRD
  #undef KRD
  #undef STEP
  #undef ENDW
  {auto rr=__builtin_amdgcn_permlane32_swap(__float_as_uint(l_reg),__float_as_uint(l_reg),false,false);l_reg=__uint_as_float(rr[0])+__uint_as_float(rr[1]);}
  if(hi==0)wsf[32+r32]=l_reg;asm volatile("s_waitcnt lgkmcnt(0)":::"memory");
  float rli[16];
  #pragma unroll
  for(int r=0;r<16;++r)rli[r]=__builtin_amdgcn_rcpf(wsf[32+crow(r,hi)]);
  bf16*Ow=O+(rowbase+q0+wid*QBLK)*PO+h*D;
  { bf16*stg=(bf16*)(shm+LDS_OST)+wid*2048;
    #pragma unroll
    for(int r=0;r<16;++r){const int orow=crow(r,hi);
      #pragma unroll
      for(int d0=0;d0<2;++d0)stg[orow*64+d0*32+r32]=__float2bfloat16(o[d0][r]*rli[r]);}
    asm volatile("s_waitcnt lgkmcnt(0)":::"memory");
    #pragma unroll
    for(int i=0;i<4;++i){const int row=i*8+(lane>>3),ch=lane&7; const u32x4 v=*(const u32x4*)(stg+row*64+ch*8); ATTN_STORE16(Ow+(long)row*PO+ch*8,v);} }
  asm volatile("s_waitcnt lgkmcnt(0)\n\ts_barrier":::"memory");
  #undef DMA_K
  #undef DMA_V
  #undef CMASK
  #undef START
  #undef RESC
  #undef ROT
}
constexpr int ATTN_LDS_BYTES=LDS_BYTES;
#undef SBAR
#undef WAIT_BAR
}

DEV void phase_even_post(PPtr p, int li) {
    const int tid = tidx(), lane = tid & 63, gw = blockIdx.x * NWAVE + (tid >> 6), ngw = gridDim.x * NWAVE;
    u16* RAW = (u16*)(p->ws + OFF_RAW);
    const float* qg = p->in[10] + li * 64; const float* kg = p->in[11] + li * 64;
    const float* T = (const float*)(p->ws + OFF_ROPE);
    const int w8 = (lane & 7) * 8, i0 = w8 & 31; const bool second = (lane & 4) != 0;
    for (int item = gw; item < MROWS * 3; item += ngw) {
        const int m = item / 3, pass = item - 3 * m;
        if (pass == 2 && lane >= 32) continue;
        const int b = m / RPB, q = m - b * RPB;
        const int sl = pass * 8 + (lane >> 3);
        const int c0 = sl < 8 ? sl * 64 : sl < 10 ? 512 + (sl - 8) * 64 : sl < 18 ? 768 + (sl - 10) * 64 : 1280 + (sl - 18) * 64;
        u16* ptr = RAW + (size_t)m * 1536 + c0 + w8;
        float x[8]; unpack8(*(const uint4*)ptr, x);
        if (sl < 10) {
            const float* gn = (sl < 8 ? qg : kg) + w8;
            float ss = 0.f;
#pragma unroll
            for (int e = 0; e < 8; ++e) ss += x[e] * x[e];
            ss += __shfl_xor(ss, 1); ss += __shfl_xor(ss, 2); ss += __shfl_xor(ss, 4);
            const float rs = rsqrtf(ss * (1.f / 64.f) + 1e-6f);
            const float4 g0 = *(const float4*)gn, g1 = *(const float4*)(gn + 4);
            x[0] *= rs * g0.x; x[1] *= rs * g0.y; x[2] *= rs * g0.z; x[3] *= rs * g0.w; x[4] *= rs * g1.x; x[5] *= rs * g1.y; x[6] *= rs * g1.z; x[7] *= rs * g1.w;
        }
        if (q < SEQ) {
            const float* ct = (i0 < 16) ? T + (q >> 6) * 16 + i0 : T + 8192 + (q & 63) * 16 + (i0 - 16);
            const float* st = ct + ((i0 < 16) ? 4096 : 1024);
            const float4 c0v = *(const float4*)ct, c1v = *(const float4*)(ct + 4), s0v = *(const float4*)st, s1v = *(const float4*)(st + 4);
            const float cs[8] = {c0v.x, c0v.y, c0v.z, c0v.w, c1v.x, c1v.y, c1v.z, c1v.w}, sn[8] = {s0v.x, s0v.y, s0v.z, s0v.w, s1v.x, s1v.y, s1v.z, s1v.w};
            const float sc = (sl < 8) ? attn_body::C2 : 1.f;
#pragma unroll
            for (int e = 0; e < 8; ++e) {
                const float other = __shfl_xor(x[e], 4);
                const float o = second ? (other * sn[e] + x[e] * cs[e]) : (x[e] * cs[e] - other * sn[e]);
                x[e] = o * sc;
            }
        }
        *(uint4*)ptr = pack8(x);
    }
}

template <int mode, bool qctx>
DEV void attn_wave(const u16* QB, int pitch, int qcol, int kcol, int vcol, u16* AO, int ocol,
                   int b, int hk, int blk, const float* sinkp, const float* rpb, u16* sV) {
    const int lane = tidx() & 63, qi = lane & 15, quad = lane >> 4;
    const bool gqa = mode < 2;
    const size_t rowb = (size_t)b * RPB;
    const float SCL = 0.125f * LOG2E;
    int qtok[4], qhead[4]; bf16x8 qf[4][2];
#pragma unroll
    for (int i = 0; i < 4; ++i) {
        qtok[i] = gqa ? blk * 16 + qi : blk * 64 + i * 16 + qi; qhead[i] = gqa ? hk * 4 + i : hk;
        const size_t m = rowb + (qctx ? SEQ : 0) + qtok[i];
        const u16* qp = QB + m * pitch + qcol + qhead[i] * 64 + quad * 8;
        qf[i][0] = *(const bf16x8*)qp; qf[i][1] = *(const bf16x8*)(qp + 32);
    }
    f32x4 o[4][4]; float mrun[4], lrun[4];
#pragma unroll
    for (int i = 0; i < 4; ++i) {
#pragma unroll
        for (int d = 0; d < 4; ++d) o[i][d] = (f32x4){0.f, 0.f, 0.f, 0.f};
        if (mode == 1) { mrun[i] = sinkp[qhead[i]] * LOG2E; lrun[i] = (quad == 0) ? 1.f : 0.f; } else { mrun[i] = -1e30f; lrun[i] = 0.f; }
    }
    const u16* Kb = QB + kcol + hk * 64; const u16* Vb = QB + vcol + hk * 64;
    int n_local, ustart, rs = 0;
    if (qctx) { n_local = 0; ustart = 0; }
    else if (mode == 0) { n_local = RPB / 32; ustart = 0; }
    else if (mode == 1) { n_local = 9; ustart = blk * 16 - 128; }
    else { rs = min(max(blk - 4, 0), 248); n_local = 16; ustart = rs * 64; }
    const int n_ctx = (mode == 0 && !qctx) ? 0 : 8;
    for (int tt = 0; tt < n_local + n_ctx; ++tt) {
        const bool loc = tt < n_local;
        const int u0 = loc ? ustart + 32 * tt : SEQ + 32 * (tt - n_local);
        const bool masked = loc && mode != 0;
        bf16x8 kf[2][2];
#pragma unroll
        for (int kt = 0; kt < 2; ++kt) {
            const int u = min(max(u0 + kt * 16 + qi, 0), RPB - 1);
            const u16* kp = Kb + (rowb + u) * pitch + quad * 8;
            kf[kt][0] = *(const bf16x8*)kp; kf[kt][1] = *(const bf16x8*)(kp + 32);
        }
#pragma unroll
        for (int c = 0; c < 4; ++c) {
            const int idx = c * 64 + lane, key = idx >> 3, dc = idx & 7;
            const int u = min(max(u0 + key, 0), RPB - 1);
            const uint4 v = *(const uint4*)(Vb + (rowb + u) * pitch + dc * 8);
            *(uint4*)(sV + key * 72 + dc * 8) = v;
        }
        bf16x8 vf[4];
#pragma unroll
        for (int dt = 0; dt < 4; ++dt)
#pragma unroll
            for (int jj = 0; jj < 8; ++jj) {
                const int key = (jj < 4) ? quad * 4 + jj : 16 + quad * 4 + (jj - 4);
                vf[dt][jj] = (short)sV[key * 72 + dt * 16 + qi];
            }
#pragma unroll
        for (int i = 0; i < 4; ++i) {
            f32x4 s0 = (f32x4){0.f, 0.f, 0.f, 0.f}, s1 = (f32x4){0.f, 0.f, 0.f, 0.f};
            s0 = __builtin_amdgcn_mfma_f32_16x16x32_bf16(kf[0][0], qf[i][0], s0, 0, 0, 0);
            s0 = __builtin_amdgcn_mfma_f32_16x16x32_bf16(kf[0][1], qf[i][1], s0, 0, 0, 0);
            s1 = __builtin_amdgcn_mfma_f32_16x16x32_bf16(kf[1][0], qf[i][0], s1, 0, 0, 0);
            s1 = __builtin_amdgcn_mfma_f32_16x16x32_bf16(kf[1][1], qf[i][1], s1, 0, 0, 0);
            float sc[8];
#pragma unroll
            for (int j = 0; j < 4; ++j) { sc[j] = s0[j] * SCL; sc[4 + j] = s1[j] * SCL; }
            if (masked) {
                const int t = qtok[i];
#pragma unroll
                for (int e = 0; e < 8; ++e) {
                    const int u = u0 + (e >> 2) * 16 + quad * 4 + (e & 3);
                    if (mode == 1) {
                        const int dd = t - u;
                        const bool ok = (u >= 0) && (u < SEQ) && (dd <= 128) && (dd >= -128);
                        if (!ok) sc[e] = -INFINITY;
                    } else {
                        const int c = t & 63, r = t >> 6, ur = u >> 6, uc = u & 63;
                        const int cst = min(max(c - 8, 0), 48);
                        const bool ok = (uc >= cst) && (uc < cst + 16);
                        const int dr = min(max(ur - r + 7, 0), 14), dcx = min(max(uc - c + 15, 0), 30);
                        const float bias = rpb[(qhead[i] * 15 + dr) * 31 + dcx];
                        sc[e] = ok ? sc[e] + bias * LOG2E : -INFINITY;
                    }
                }
            }
            float mx = fmaxf(fmaxf(fmaxf(sc[0], sc[1]), fmaxf(sc[2], sc[3])), fmaxf(fmaxf(sc[4], sc[5]), fmaxf(sc[6], sc[7])));
            mx = fmaxf(mx, __shfl_xor(mx, 16)); mx = fmaxf(mx, __shfl_xor(mx, 32));
            const float mn = fmaxf(mrun[i], mx);
            const float al = __builtin_amdgcn_exp2f(mrun[i] - mn);
            mrun[i] = mn;
            float pe[8], ps = 0.f;
#pragma unroll
            for (int e = 0; e < 8; ++e) { pe[e] = __builtin_amdgcn_exp2f(sc[e] - mn); ps += pe[e]; }
            lrun[i] = lrun[i] * al + ps;
            union { unsigned u[4]; bf16x8 v; } pf;
            pf.u[0] = pk2(pe[0], pe[1]); pf.u[1] = pk2(pe[2], pe[3]); pf.u[2] = pk2(pe[4], pe[5]); pf.u[3] = pk2(pe[6], pe[7]);
#pragma unroll
            for (int dt = 0; dt < 4; ++dt) {
                o[i][dt] = o[i][dt] * al;
                o[i][dt] = __builtin_amdgcn_mfma_f32_16x16x32_bf16(vf[dt], pf.v, o[i][dt], 0, 0, 0);
            }
        }
    }
#pragma unroll
    for (int i = 0; i < 4; ++i) {
        float l = lrun[i]; l += __shfl_xor(l, 16); l += __shfl_xor(l, 32);
        const float inv = 1.f / l;
        const size_t m = rowb + (qctx ? SEQ : 0) + qtok[i];
        u16* op = AO + m * DM + ocol + qhead[i] * 64 + quad * 4;
#pragma unroll
        for (int dt = 0; dt < 4; ++dt) {
            uint2 w; w.x = pk2(o[i][dt][0] * inv, o[i][dt][1] * inv); w.y = pk2(o[i][dt][2] * inv, o[i][dt][3] * inv);
            *(uint2*)(op + dt * 16) = w;
        }
    }
}

DEV void phase_attn_even(PPtr p, int li, char* lds) {
    {
        const attn_body::bf16* RAWb = (const attn_body::bf16*)(p->ws + OFF_RAW); attn_body::bf16* AOb = (attn_body::bf16*)(p->ws + OFF_AO);
        const int G = gridDim.x, bx = blockIdx.x;
        if (G == 256) {
            const int vcu = (bx & 7) * 32 + (bx >> 3); const int x = vcu >> 5, combo = x >> 1, sub = (x & 1) * 32 + (vcu & 31);
            for (int i = 0; i < 4; ++i) attn_body::attn_unit<8>(combo >> 1, (combo & 1) * 4 + i, sub, RAWb, RAWb + 512, RAWb + 640, AOb, lds);
        } else {
            for (int u = bx; u < 1024; u += G) attn_body::attn_unit<8>(u >> 9, (u >> 6) & 7, u & 63, RAWb, RAWb + 512, RAWb + 640, AOb, lds);
        }
    }
    const int wave = tidx() >> 6, gw = blockIdx.x * NWAVE + wave, ngw = gridDim.x * NWAVE;
    u16* sV = (u16*)lds + wave * (32 * 72);
    const u16* RAW = (const u16*)(p->ws + OFF_RAW); u16* AO = (u16*)(p->ws + OFF_AO);
    const float* sink = p->in[12] + li * 8;
    for (int t = gw; t < 4224; t += ngw) {
        if (t < 4096) attn_wave<1, false>(RAW, 1536, 768, 1280, 1408, AO, 512, t >> 11, (t >> 10) & 1, t & 1023, sink, nullptr, sV);
        else if (t < 4160) { const int u = t - 4096; attn_wave<0, true>(RAW, 1536, 0, 512, 640, AO, 0, u >> 5, (u >> 4) & 1, u & 15, nullptr, nullptr, sV); }
        else { const int u = t - 4160; attn_wave<1, true>(RAW, 1536, 768, 1280, 1408, AO, 512, u >> 5, (u >> 4) & 1, u & 15, sink, nullptr, sV); }
    }
}
DEV void phase_attn_odd(PPtr p, int li, char* lds) {
    const int wave = tidx() >> 6, gw = blockIdx.x * NWAVE + wave, ngw = gridDim.x * NWAVE;
    u16* sV = (u16*)lds + wave * (32 * 72);
    const u16* QKV = (const u16*)(p->ws + OFF_RAW); u16* AO = (u16*)(p->ws + OFF_AO);
    const float* rpb = p->in[15] + li * 8 * 15 * 31;
    for (int t = gw; t < 4160; t += ngw) {
        if (t < 4096) attn_wave<2, false>(QKV, 1536, 0, 512, 1024, AO, 0, t >> 11, (t >> 8) & 7, t & 255, nullptr, rpb, sV);
        else { const int u = t - 4096; attn_wave<2, true>(QKV, 1536, 0, 512, 1024, AO, 0, u >> 5, (u >> 2) & 7, u & 3, nullptr, rpb, sV); }
    }
}

DEV float shiftmix_at(const u16* ZDb, int pp, int ch, float mu) {
    const bool lat = pp < SEQ; const int lo = lat ? 0 : SEQ, hi = lat ? SEQ : RPB;
    const u16* zc = ZDb + (size_t)pp * ZDW + ch;
    const float z = bf2f(zc[0]);
    const float a = (pp - 1 >= lo) ? bf2f(zc[-ZDW]) : 0.f, c = (pp + 1 < hi) ? bf2f(zc[ZDW]) : 0.f;
    return z + (0.5f * (a + c) - z) * mu;
}
DEV void phase_rwkv_prep(PPtr p, int li, int bb) {
    const int tid = tidx(), lane = tid & 63, gw = blockIdx.x * NWAVE + (tid >> 6), ngw = gridDim.x * NWAVE;
    const u16* ZDb = (const u16*)(p->ws + OFF_ZD) + (size_t)bb * RPB * ZDW;
    const float* mu = p->in[16] + li * ZDW; const float* kkw = p->in[22] + li * 512;
    u16* R = (u16*)(p->ws + OFF_R); u16* KK = (u16*)(p->ws + OFF_KK); u16* V = (u16*)(p->ws + OFF_V); u16* LA = (u16*)(p->ws + OFF_LA);
    {
        u16* LB = (u16*)(p->ws + OFF_PU);
        const float* w2 = p->in[18] + (size_t)li * 2 * 64 * 512; const float* a2 = p->in[20] + (size_t)li * 2 * 64 * 512; const float* g2 = p->in[21] + (size_t)li * 128 * 512;
        for (int idx = gw * 64 + lane; idx < 2560 * 32; idx += ngw * 64) {
            const int n = idx >> 5, kc = (idx & 31) * 8, type = n >> 9, nn = n & 511;
            float f[8];
#pragma unroll
            for (int e = 0; e < 8; ++e) {
                const int k = kc + e; float x = 0.f;
                if (type < 2) { if (k < 64) x = w2[((size_t)type * 64 + k) * 512 + nn]; }
                else if (type < 4) { if (k >= 64 && k < 128) x = a2[((size_t)(type - 2) * 64 + (k - 64)) * 512 + nn]; }
                else { if (k >= 128) x = g2[(size_t)(k - 128) * 512 + nn]; }
                f[e] = x;
            }
            *(uint4*)(LB + (size_t)n * 256 + kc) = pack8(f);
        }
    }
    {
        float4* Yz = (float4*)(p->ws + OFF_Y0); const float4 z = {0.f, 0.f, 0.f, 0.f};
        for (size_t i = (size_t)gw * 64 + lane; i < (size_t)RPB * 512 / 4; i += (size_t)ngw * 64) Yz[i] = z;
    }
    for (int pp = gw; pp < RPB; pp += ngw) {
        const bool lat = pp < SEQ; const int lo = lat ? 0 : SEQ, hi = lat ? SEQ : RPB;
        const bool hp = pp - 1 >= lo, hn = pp + 1 < hi;
        const u16* zc = ZDb + (size_t)pp * ZDW;
#pragma unroll
        for (int j = 0; j < 4; ++j) {
            const int c8 = lane + 64 * j;
            if (j == 3 && lane >= 32) break;
            const int ch = 8 * c8;
            float z[8], a[8], c[8], zs[8];
            unpack8(*(const uint4*)(zc + ch), z);
            if (hp) unpack8(*(const uint4*)(zc - ZDW + ch), a); else { for (int e = 0; e < 8; ++e) a[e] = 0.f; }
            if (hn) unpack8(*(const uint4*)(zc + ZDW + ch), c); else { for (int e = 0; e < 8; ++e) c[e] = 0.f; }
            const float4 m0 = *(const float4*)(mu + ch), m1 = *(const float4*)(mu + ch + 4);
            const float mm[8] = {m0.x, m0.y, m0.z, m0.w, m1.x, m1.y, m1.z, m1.w};
#pragma unroll
            for (int e = 0; e < 8; ++e) zs[e] = z[e] + (0.5f * (a[e] + c[e]) - z[e]) * mm[e];
            if (j == 0) *(uint4*)(R + (size_t)pp * 512 + ch) = pack8(zs);
            else if (j == 1) {
                const float4 k0 = *(const float4*)(kkw + ch - 512), k1 = *(const float4*)(kkw + ch - 512 + 4);
                const float kw[8] = {k0.x, k0.y, k0.z, k0.w, k1.x, k1.y, k1.z, k1.w};
                float t[8], ss = 0.f;
#pragma unroll
                for (int e = 0; e < 8; ++e) { t[e] = zs[e] * kw[e]; ss += t[e] * t[e]; }
                ss += __shfl_xor(ss, 1); ss += __shfl_xor(ss, 2); ss += __shfl_xor(ss, 4);
                const float inv = 1.f / fmaxf(sqrtf(ss), 1e-12f);
#pragma unroll
                for (int e = 0; e < 8; ++e) t[e] *= inv;
                *(uint4*)(KK + (size_t)pp * 512 + ch - 512) = pack8(t);
            } else if (j == 2) *(uint4*)(V + (size_t)pp * 512 + ch - 1024) = pack8(zs);
            else {
                float o[8];
#pragma unroll
                for (int e = 0; e < 8; ++e) o[e] = (lane < 8) ? tanhf(zs[e]) : (lane < 16) ? zs[e] : sigmoidf_(zs[e]);
                *(uint4*)(LA + (size_t)pp * 256 + ch - 1536) = pack8(o);
            }
        }
    }
}
struct EpiDecay { float* DEC; const float* w0; int d;
    DEV void operator()(int r, int c, float v, float) const {
        const float x = -(w0[c] + v); const float sp = x > 20.f ? x : log1pf(expf(x)); const float w = -sp - 0.5f;
        DEC[((size_t)r * 2 + d) * 512 + c] = expf(-expf(w)); } };
struct EpiIclr { u16* KD; u16* BQ; const u16* KK; const u16* ZDb; const float* a0; const float* ka; const float* muk; int d;
    DEV void operator()(int r, int c, float v, float) const {
        const float a = sigmoidf_(a0[c] + v);
        const float k = shiftmix_at(ZDb, r, 512 + c, muk[c]);
        KD[((size_t)r * 2 + d) * 512 + c] = (u16)f2bf(k * (1.f + (a - 1.f) * ka[c]));
        BQ[((size_t)r * 2 + d) * 512 + c] = (u16)f2bf(bf2f(KK[(size_t)r * 512 + c]) * a); } };
struct EpiGate { u16* G; DEV void operator()(int r, int c, float v, float) const { G[(size_t)r * 512 + c] = (u16)f2bf(v); } };

DEV int pos_to_pp(int s, int d) { return (s < NCTX) ? (d ? SEQ + NCTX - 1 - s : SEQ + s) : (d ? SEQ - 1 - (s - NCTX) : s - NCTX); }
struct StepV { float d; unsigned a; unsigned b; float v; };
DEV StepV load_step(const float* DEC, const u16* KD, const u16* BQ, const u16* KK, const u16* R, const u16* V, int pp, int h, int d, int lane) {
    const size_t e1 = (size_t)pp * 512 + h * 64, e2 = ((size_t)pp * 2 + d) * 512 + h * 64;
    StepV s;
    s.d = DEC[e2 + lane];
    s.a = (lane < 32) ? ((const unsigned*)(KD + e2))[lane] : ((const unsigned*)(BQ + e2))[lane - 32];
    s.b = (lane < 32) ? ((const unsigned*)(KK + e1))[lane] : ((const unsigned*)(R + e1))[lane - 32];
    s.v = bf2f(V[e1 + lane]);
    return s;
}
typedef float f32x2 __attribute__((ext_vector_type(2)));
constexpr int SSLOT = 320;
typedef __attribute__((address_space(3))) float* ldsf;
typedef const __attribute__((address_space(3))) f32x4* lds4;
DEV void stage_step(ldsf slot, const StepV& s, int lane) {
    slot[lane] = s.d;
    *(__attribute__((address_space(3))) f32x2*)(slot + 64 + 2 * lane) = (f32x2){bflo(s.a), bfhi(s.a)};
    *(__attribute__((address_space(3))) f32x2*)(slot + 192 + 2 * lane) = (f32x2){bflo(s.b), bfhi(s.b)};
}
#define LO2(v) ((f32x2){(v)[0], (v)[1]})
#define HI2(v) ((f32x2){(v)[2], (v)[3]})
template <int MODE>
DEV float scan_step(f32x2 (&S)[32], ldsf sl, float vv) {
    lds4 D = (lds4)sl;
    f32x2 sa = {0.f, 0.f}, sb = {0.f, 0.f};
#pragma unroll
    for (int q = 0; q < 16; ++q) { const f32x4 k4 = D[48 + q]; sa += S[2 * q] * LO2(k4); sb += S[2 * q + 1] * HI2(k4);
        if ((q & 3) == 3) asm volatile("" : "+v"(D), "+v"(sa), "+v"(sb)); }
    const float nsa = -((sa[0] + sa[1]) + (sb[0] + sb[1]));
    const f32x2 nsa2 = {nsa, nsa}, vv2 = {vv, vv};
    f32x2 y = {0.f, 0.f}, z = {0.f, 0.f};
#pragma unroll
    for (int q = 0; q < 16; ++q) {
        const f32x4 d4 = D[q], b4 = D[32 + q];
        f32x2 t0 = nsa2 * LO2(b4), t1 = nsa2 * HI2(b4);
        if (MODE >= 1) { const f32x4 kd4 = D[16 + q]; t0 += vv2 * LO2(kd4); t1 += vv2 * HI2(kd4); }
        S[2 * q] = S[2 * q] * LO2(d4) + t0; S[2 * q + 1] = S[2 * q + 1] * HI2(d4) + t1;
        if (MODE == 2) { const f32x4 r4 = D[64 + q]; y += S[2 * q] * LO2(r4); z += S[2 * q + 1] * HI2(r4); }
        else y += S[2 * q + 1];
        if ((q & 1) == 1) asm volatile("" : "+v"(D), "+v"(y), "+v"(z), "+v"(S[2 * q + 1]));
    }
    return (y[0] + y[1]) + (z[0] + z[1]);
}
template <int WHICH>
DEV void scan1_pass(PPtr p, char* lds) {
    const int tid = tidx(), lane = tid & 63, wv = __builtin_amdgcn_readfirstlane(tid >> 6), gw = blockIdx.x * NWAVE + wv, ngw = gridDim.x * NWAVE;
    const float* DEC = (const float*)(p->ws + OFF_DEC); const u16* KD = (const u16*)(p->ws + OFF_KD); const u16* BQ = (const u16*)(p->ws + OFF_BQ);
    const u16* KK = (const u16*)(p->ws + OFF_KK); const u16* R = (const u16*)(p->ws + OFF_R); const u16* V = (const u16*)(p->ws + OFF_V);
    float* PU = (float*)(p->ws + OFF_PU);
    ldsf ring = (ldsf)lds + wv * (3 * SSLOT);
    for (int task = gw; task < 16 * NCH; task += ngw) {
        const int seq = task >> 7, c = task & 127, h = seq >> 1, d = seq & 1;
#define LD(st) load_step(DEC, KD, BQ, KK, R, V, pos_to_pp(c * CLEN + min((st), CLEN - 1), d), h, d, lane)
        f32x2 X[32];
        int ln = lane; asm volatile("" : "+v"(ln));
#pragma unroll
        for (int j = 0; j < 32; ++j) X[j] = (f32x2){(WHICH == 0 && 2 * j == ln) ? 1.f : 0.f, (WHICH == 0 && 2 * j + 1 == ln) ? 1.f : 0.f};
        float vvA, vvB;
        { const StepV s0 = LD(0), s1 = LD(1); stage_step(ring, s0, lane); stage_step(ring + SSLOT, s1, lane); vvA = s0.v; vvB = s1.v; }
        StepV g0 = LD(2), g1 = LD(3), g2 = LD(4), g3 = LD(5);
        int cs = 0, ns = 2;
        float chain = 0.f;
#pragma unroll 1
        for (int st = 0; st < CLEN; ++st) {
            chain += scan_step<2>(X, ring + cs * SSLOT, WHICH ? vvA : 0.f);
            stage_step(ring + ns * SSLOT, g0, lane);
            vvA = vvB; vvB = g0.v; g0 = g1; g1 = g2; g2 = g3; g3 = LD(st + 6);
            cs = (cs == 2) ? 0 : cs + 1; ns = (ns == 2) ? 0 : ns + 1;
        }
#undef LD
        float4* o = (float4*)(PU + ((size_t)task * 2 + WHICH) * 4096 + lane * 64);
#pragma unroll
        for (int j = 0; j < 16; ++j) o[j] = (float4){X[2 * j][0], X[2 * j][1], X[2 * j + 1][0], X[2 * j + 1][1]};
        if (chain == 1.2345e38f) o[0] = (float4){chain, chain, chain, chain};
    }
}
DEV void phase_scan1(PPtr p, char* lds) { scan1_pass<0>(p, lds); scan1_pass<1>(p, lds); }
DEV void phase_scan2(PPtr p, char* lds) {
    if (blockIdx.x >= 16) return;
    const int tid = tidx(), lane = tid & 63, w = __builtin_amdgcn_readfirstlane(tid >> 6), seq = blockIdx.x;
    float* sS = (float*)lds;
    float* sP = sS + 2 * 64 * 68;
    float* PU = (float*)(p->ws + OFF_PU) + (size_t)seq * NCH * 2 * 4096;
    const int rt = w >> 1, ct0 = (w & 1) * 2, r = lane & 15, q = lane >> 4;
    for (int i = tid; i < 64 * 68; i += NTHR) sS[i] = 0.f;
    const int prow = tid >> 3, pcol = (tid & 7) * 8;
#define PLOAD(c_, lo, hi) do { const float4* s_ = (const float4*)(PU + (size_t)(c_) * 8192 + prow * 64 + pcol); lo = s_[0]; hi = s_[1]; } while (0)
#define ULOAD(c_, u_) do { const float* s_ = PU + (size_t)(c_) * 8192 + 4096; _Pragma("unroll") for (int t = 0; t < 2; ++t) _Pragma("unroll") for (int j = 0; j < 4; ++j) u_[t][j] = s_[(16 * rt + 4 * q + j) * 64 + 16 * (ct0 + t) + r]; } while (0)
    float4 pa0, pa1, pb0, pb1;
    { float4 t0, t1; PLOAD(0, t0, t1); *(float4*)(sP + prow * 68 + pcol) = t0; *(float4*)(sP + prow * 68 + pcol + 4) = t1; }
    PLOAD(1, pa0, pa1); PLOAD(2, pb0, pb1);
    float ua[2][4], ub[2][4], mine[2][4];
    ULOAD(0, ua); ULOAD(1, ub);
#pragma unroll
    for (int t = 0; t < 2; ++t)
#pragma unroll
        for (int j = 0; j < 4; ++j) mine[t][j] = 0.f;
    __syncthreads();
    for (int c = 0; c < NCH; ++c) {
        const int cur = c & 1;
        float* Um = PU + (size_t)c * 8192 + 4096;
#pragma unroll
        for (int t = 0; t < 2; ++t)
#pragma unroll
            for (int j = 0; j < 4; ++j) Um[(16 * rt + 4 * q + j) * 64 + 16 * (ct0 + t) + r] = mine[t][j];
        f32x4 a0 = {ua[0][0], ua[0][1], ua[0][2], ua[0][3]}, a1 = {ua[1][0], ua[1][1], ua[1][2], ua[1][3]};
        const float* Sc = sS + cur * (64 * 68); const float* Pc = sP + cur * (64 * 68);
#pragma unroll
        for (int ks = 0; ks < 16; ++ks) {
            const float av = Sc[(16 * rt + r) * 68 + 4 * ks + q];
            const float b0 = Pc[(4 * ks + q) * 68 + 16 * ct0 + r], b1 = Pc[(4 * ks + q) * 68 + 16 * ct0 + 16 + r];
            a0 = __builtin_amdgcn_mfma_f32_16x16x4f32(av, b0, a0, 0, 0, 0);
            a1 = __builtin_amdgcn_mfma_f32_16x16x4f32(av, b1, a1, 0, 0, 0);
        }
        float* Sn = sS + (cur ^ 1) * (64 * 68);
#pragma unroll
        for (int j = 0; j < 4; ++j) { Sn[(16 * rt + 4 * q + j) * 68 + 16 * ct0 + r] = a0[j]; Sn[(16 * rt + 4 * q + j) * 68 + 16 * ct0 + 16 + r] = a1[j]; mine[0][j] = a0[j]; mine[1][j] = a1[j]; }
        { float* Pn = sP + (cur ^ 1) * (64 * 68); *(float4*)(Pn + prow * 68 + pcol) = pa0; *(float4*)(Pn + prow * 68 + pcol + 4) = pa1; }
        pa0 = pb0; pa1 = pb1;
        { const int c3 = min(c + 3, NCH - 1); PLOAD(c3, pb0, pb1); }
#pragma unroll
        for (int t = 0; t < 2; ++t)
#pragma unroll
            for (int j = 0; j < 4; ++j) ua[t][j] = ub[t][j];
        { const int c2 = c + 2; if (c2 < NCH) ULOAD(c2, ub); }
        __syncthreads();
    }
#undef PLOAD
#undef ULOAD
}
DEV void phase_scan3(PPtr p, char* lds) {
    const int tid = tidx(), lane = tid & 63, wv = __builtin_amdgcn_readfirstlane(tid >> 6), gw = blockIdx.x * NWAVE + wv, ngw = gridDim.x * NWAVE;
    const float* DEC = (const float*)(p->ws + OFF_DEC); const u16* KD = (const u16*)(p->ws + OFF_KD); const u16* BQ = (const u16*)(p->ws + OFF_BQ);
    const u16* KK = (const u16*)(p->ws + OFF_KK); const u16* R = (const u16*)(p->ws + OFF_R); const u16* V = (const u16*)(p->ws + OFF_V);
    const float* PU = (const float*)(p->ws + OFF_PU);
    float* Y = (float*)(p->ws + OFF_Y0);
    ldsf ring = (ldsf)lds + wv * (3 * SSLOT);
    for (int task = gw; task < 16 * NCH; task += ngw) {
        const int seq = task >> 7, c = task & 127, h = seq >> 1, d = seq & 1;
        f32x2 S[32];
        {
            const float4* si = (const float4*)(PU + ((size_t)task * 2 + 1) * 4096 + lane * 64);
#pragma unroll
            for (int j = 0; j < 16; ++j) { const float4 t = si[j]; S[2 * j] = (f32x2){t.x, t.y}; S[2 * j + 1] = (f32x2){t.z, t.w}; }
        }
#define LD(st) load_step(DEC, KD, BQ, KK, R, V, pos_to_pp(c * CLEN + min((st), CLEN - 1), d), h, d, lane)
#define YADD(st, y) unsafeAtomicAdd(Y + (size_t)pos_to_pp(c * CLEN + (st), d) * 512 + h * 64 + lane, (y))
        float vvA, vvB;
        { const StepV s0 = LD(0), s1 = LD(1); stage_step(ring, s0, lane); stage_step(ring + SSLOT, s1, lane); vvA = s0.v; vvB = s1.v; }
        StepV g0 = LD(2), g1 = LD(3), g2 = LD(4), g3 = LD(5);
        int cs = 0, ns = 2;
#pragma unroll 1
        for (int st = 0; st < CLEN; ++st) {
            const float y = scan_step<2>(S, ring + cs * SSLOT, vvA); YADD(st, y);
            stage_step(ring + ns * SSLOT, g0, lane);
            vvA = vvB; vvB = g0.v; g0 = g1; g1 = g2; g2 = g3; g3 = LD(st + 6);
            cs = (cs == 2) ? 0 : cs + 1; ns = (ns == 2) ? 0 : ns + 1;
        }
#undef LD
#undef YADD
    }
}
DEV void phase_readout(PPtr p, int li, int bb) {
    const int tid = tidx(), lane = tid & 63, gw = blockIdx.x * NWAVE + (tid >> 6), ngw = gridDim.x * NWAVE;
    const float* Y0 = (const float*)(p->ws + OFF_Y0);
    const u16* KD = (const u16*)(p->ws + OFF_KD); const u16* R = (const u16*)(p->ws + OFF_R); const u16* V = (const u16*)(p->ws + OFF_V); const u16* G = (const u16*)(p->ws + OFF_G);
    const float* rk = p->in[24] + li * 512; const float* lnw = p->in[25] + li * 512; const float* lnb = p->in[26] + li * 512;
    u16* AO = (u16*)(p->ws + OFF_AO);
    const int c = 8 * lane;
    float rkv[8], lw[8], lb[8];
    { const float4 a = *(const float4*)(rk + c), b = *(const float4*)(rk + c + 4); rkv[0] = a.x; rkv[1] = a.y; rkv[2] = a.z; rkv[3] = a.w; rkv[4] = b.x; rkv[5] = b.y; rkv[6] = b.z; rkv[7] = b.w; }
    { const float4 a = *(const float4*)(lnw + c), b = *(const float4*)(lnw + c + 4); lw[0] = a.x; lw[1] = a.y; lw[2] = a.z; lw[3] = a.w; lw[4] = b.x; lw[5] = b.y; lw[6] = b.z; lw[7] = b.w; }
    { const float4 a = *(const float4*)(lnb + c), b = *(const float4*)(lnb + c + 4); lb[0] = a.x; lb[1] = a.y; lb[2] = a.z; lb[3] = a.w; lb[4] = b.x; lb[5] = b.y; lb[6] = b.z; lb[7] = b.w; }
    for (int pp = gw; pp < RPB; pp += ngw) {
        const size_t m = (size_t)bb * RPB + pp, e = (size_t)pp * 512 + c;
        const float4 ya = *(const float4*)(Y0 + e), yb = *(const float4*)(Y0 + e + 4);
        const float y[8] = {ya.x, ya.y, ya.z, ya.w, yb.x, yb.y, yb.z, yb.w};
        float r[8], k0[8], k1[8], v[8], g[8];
        unpack8(*(const uint4*)(R + e), r); unpack8(*(const uint4*)(KD + ((size_t)pp * 2) * 512 + c), k0); unpack8(*(const uint4*)(KD + ((size_t)pp * 2 + 1) * 512 + c), k1);
        unpack8(*(const uint4*)(V + e), v); unpack8(*(const uint4*)(G + e), g);
        float sm = 0.f, bs = 0.f;
#pragma unroll
        for (int j = 0; j < 8; ++j) { sm += y[j]; bs += r[j] * (k0[j] + k1[j]) * rkv[j]; }
        sm += __shfl_xor(sm, 1); sm += __shfl_xor(sm, 2); sm += __shfl_xor(sm, 4);
        bs += __shfl_xor(bs, 1); bs += __shfl_xor(bs, 2); bs += __shfl_xor(bs, 4);
        const float mean = sm * (1.f / 64.f);
        float vs = 0.f;
#pragma unroll
        for (int j = 0; j < 8; ++j) { const float dv = y[j] - mean; vs += dv * dv; }
        vs += __shfl_xor(vs, 1); vs += __shfl_xor(vs, 2); vs += __shfl_xor(vs, 4);
        const float rstd = rsqrtf(vs * (1.f / 64.f) + 64e-5f);
        float o[8];
#pragma unroll
        for (int j = 0; j < 8; ++j) o[j] = ((y[j] - mean) * rstd * lw[j] + lb[j] + bs * v[j]) * g[j];
        *(uint4*)(AO + m * DM + 512 + c) = pack8(o);
    }
}
DEV void phase_final(PPtr p) {
    const int lane = tidx() & 63, gw = blockIdx.x * NWAVE + (tidx() >> 6), ngw = gridDim.x * NWAVE;
    const float* gain = p->in[29];
    for (int m = gw; m < NB * SEQ; m += ngw) {
        float4* xr = (float4*)(p->out + (size_t)m * DM);
        float4 v[4]; float ss = 0.f;
#pragma unroll
        for (int j = 0; j < 4; ++j) { v[j] = xr[lane + 64 * j]; ss += v[j].x * v[j].x + v[j].y * v[j].y + v[j].z * v[j].z + v[j].w * v[j].w; }
        ss = wave_sum(ss);
        const float rstd = rsqrtf(ss * (1.f / DM) + 1e-6f);
#pragma unroll
        for (int j = 0; j < 4; ++j) {
            const float4 g = *(const float4*)(gain + (lane + 64 * j) * 4);
            float4 o; o.x = v[j].x * rstd * g.x; o.y = v[j].y * rstd * g.y; o.z = v[j].z * rstd * g.z; o.w = v[j].w * rstd * g.w;
            xr[lane + 64 * j] = o;
        }
    }
}

constexpr size_t OFF_BAR = 768 * 1024;
DEV void gbar(PPtr kp_, unsigned& nbar) {
    asm volatile("s_waitcnt vmcnt(0)" ::: "memory");
    __syncthreads();
    if (threadIdx.x == 0) {
        unsigned* ctr = (unsigned*)(kp_->ws + OFF_BAR);
        __builtin_amdgcn_fence(__ATOMIC_RELEASE, "agent");
        asm volatile("s_waitcnt vmcnt(0)" ::: "memory");
        ++nbar;
        __hip_atomic_fetch_add(ctr, 1u, __ATOMIC_RELAXED, __HIP_MEMORY_SCOPE_AGENT);
        const unsigned target = nbar * gridDim.x;
        while (__hip_atomic_load(ctr, __ATOMIC_RELAXED, __HIP_MEMORY_SCOPE_AGENT) < target) __builtin_amdgcn_s_sleep(1);
        __builtin_amdgcn_fence(__ATOMIC_ACQUIRE, "agent");
        asm volatile("s_waitcnt vmcnt(0)" ::: "memory");
    }
    __syncthreads();
}
#define p launder(kp)
#define SYNC() gbar(launder(kp), nbar)
template <int bb>
DEV void do_rwkv_batch(PPtr kp, unsigned& nbar, char* lds, int li) {
    unsigned char* ws = launder(kp)->ws;
    u16* ZD = (u16*)(ws + OFF_ZD);
                phase_rwkv_prep(p, li, bb); SYNC();
                const u16* LA = (const u16*)(ws + OFF_LA); const u16* ZDb = ZD + (size_t)bb * RPB * ZDW;
                { pg8::EpiLoraT e{(float*)(ws + OFF_DEC), (u16*)(ws + OFF_KD), (u16*)(ws + OFF_BQ), (u16*)(ws + OFF_G), (const u16*)(ws + OFF_KK), ZDb,
                                  p->in[17] + (size_t)li * 1024, p->in[19] + (size_t)li * 1024, p->in[23] + li * 512, p->in[16] + li * ZDW + 512};
                  int kl_ = 256; asm volatile("" : "+s"(kl_));
                  pg8::Gemm g_{(const pg8::bf16_t*)LA, (const pg8::bf16_t*)(ws + OFF_PU), RPB, 2560, kl_}; pg8::StaticOrder S_; S_.init(RPB, 2560, (int)gridDim.x, (int)blockIdx.x);
                  pg8::gemm_phase<pg8::EpiLoraT, pg8::StaticOrder, true, true>((PG8_LAS unsigned char*)lds, g_, S_, e); }
                SYNC();
                phase_scan1(p, lds); SYNC();
                phase_scan2(p, lds); SYNC();
                phase_scan3(p, lds); SYNC();
                phase_readout(p, li, bb); SYNC();
            }
template <int layer>
DEV void do_layer(PPtr kp, unsigned& nbar, char* lds) {
    unsigned char* ws = launder(kp)->ws;
    const float* mod = (const float*)(ws + OFF_MOD);
    u16* HN = (u16*)(ws + OFF_HN); u16* AO = (u16*)(ws + OFF_AO); u16* RAW = (u16*)(ws + OFF_RAW); u16* ZD = (u16*)(ws + OFF_ZD);
        const int li = layer >> 1;
        const float* lmod = mod + (size_t)layer * 3 * 6144;
        phase_wprep(p, layer, lds); phase_normmod(p, layer, 0); SYNC();
        const pg8::bf16_t* WB = (const pg8::bf16_t*)(ws + OFF_WB);
#define GEMM8(A_, B_, N_, K_, E_) do { pg8::Gemm g_{(const pg8::bf16_t*)(A_), (B_), MROWS, (N_), (K_)}; pg8::StaticOrder S_; S_.init(MROWS, (N_), (int)gridDim.x, (int)blockIdx.x); \
            pg8::gemm_phase<decltype(E_), pg8::StaticOrder, true, true>((PG8_LAS unsigned char*)lds, g_, S_, E_); } while (0)
        if (!(layer & 1)) {
            { pg8::EpiStoreT e{RAW, 1536, 1 << 30, RAW, 1536}; GEMM8(HN, WB + WB_IN, 1536, DM, e); } SYNC();
            phase_even_post(p, li); SYNC();
            phase_attn_even(p, li, lds); SYNC();
            { pg8::EpiResidT e{p, lmod + 2048}; GEMM8(AO, WB + WB_OUT, DM, DM, e); } SYNC();
        } else {
            { pg8::EpiStoreT e{RAW, 1536, 1536, ZD, ZDW}; GEMM8(HN, WB + WB_IN, 3328, DM, e); } SYNC();
            phase_attn_odd(p, li, lds); SYNC();
            do_rwkv_batch<0>(kp, nbar, lds, li);
            do_rwkv_batch<1>(kp, nbar, lds, li);
            { pg8::EpiResidT e{p, lmod + 2048}; GEMM8(AO, WB + WB_OUT, DM, DM, e); } SYNC();
        }
        phase_normmod(p, layer, 1); SYNC();
        { pg8::EpiSwigluT e{RAW}; GEMM8(HN, WB + WB_F1, 5632, DM, e); } SYNC();
        { pg8::EpiResidT e{p, lmod + 5120}; GEMM8(RAW, WB + WB_F2, DM, FFH, e); } SYNC();
    }
__global__ void __launch_bounds__(NTHR) mega(Params p_unused) {
    PPtr kp = (PPtr)__builtin_amdgcn_kernarg_segment_ptr();
    extern __shared__ __attribute__((aligned(16))) char lds[];
    cg::grid_group grid = cg::this_grid();
    unsigned nbar = 0;
    grid.sync();
    phase_init(p, lds); SYNC();
    do_layer<0>(kp, nbar, lds);
    do_layer<1>(kp, nbar, lds);
    do_layer<2>(kp, nbar, lds);
    do_layer<3>(kp, nbar, lds);
    phase_final(p);
}
#undef p
#undef SYNC

extern "C" void kernel_launch(void* const* d_in, const int* in_sizes, int n_in, void* d_out, int out_size, void* d_ws, size_t ws_size, hipStream_t stream) {
    static int grid = 0;
    if (grid == 0) {
        if (n_in != 30 || ws_size < WS_NEED || out_size != NB * SEQ * DM) { fprintf(stderr, "kernel_launch: unexpected problem shape (n_in %d ws %zu out %d)\n", n_in, ws_size, out_size); grid = -1; return; }
        int dev = 0, cus = 0, per_cu = 0;
        hipGetDevice(&dev);
        hipDeviceGetAttribute(&cus, hipDeviceAttributeMultiprocessorCount, dev);
        hipFuncSetAttribute((const void*)mega, hipFuncAttributeMaxDynamicSharedMemorySize, LDS_BYTES);
        hipOccupancyMaxActiveBlocksPerMultiprocessor(&per_cu, (const void*)mega, NTHR, LDS_BYTES);
        if (per_cu < 1) per_cu = 1;
        if (per_cu > 1) per_cu = 1;
        grid = cus * per_cu;
    }
    if (grid < 0) return;
    Params p{};
    for (int i = 0; i < 30; ++i) p.in[i] = (const float*)d_in[i];
    p.out = (float*)d_out; p.ws = (unsigned char*)d_ws;
    hipMemsetAsync((char*)d_ws + OFF_BAR, 0, 256, stream);
    void* args[] = {&p};
    hipError_t e = hipLaunchCooperativeKernel((const void*)mega, dim3(grid), dim3(NTHR), args, LDS_BYTES, stream);
    if (e != hipSuccess) fprintf(stderr, "cooperative launch failed: %s (grid %d)\n", hipGetErrorString(e), grid);
}
```

```cpp
#include <hip/hip_runtime.h>
#include <hip/hip_cooperative_groups.h>
#include <cstdio>
#include <cstdint>
namespace cg = cooperative_groups;

#define DEV __device__ __forceinline__
typedef unsigned short u16;
typedef short bf16x8 __attribute__((ext_vector_type(8)));
typedef float f32x4 __attribute__((ext_vector_type(4)));
typedef const __attribute__((address_space(4))) float* cfp;
typedef const __attribute__((address_space(4))) unsigned* cup;

constexpr int DM = 1024, NB = 2, SEQ = 16384, NCTX = 256, RPB = SEQ + NCTX, MROWS = NB * RPB;
constexpr int FFH = 2816, ZDW = 1792;
constexpr float LOG2E = 1.4426950408889634f;
constexpr int NTHR = 512, NWAVE = 8;
constexpr int LDS_BYTES = 132096;

constexpr size_t MiB = 1u << 20;
constexpr size_t OFF_MOD = 0;
constexpr size_t OFF_ROPE = 512 * 1024;
constexpr size_t OFF_XC = 1 * MiB;
constexpr size_t OFF_WB = 3 * MiB;
constexpr size_t OFF_AO = 29 * MiB;
constexpr size_t OFF_HN = 94 * MiB;
constexpr size_t OFF_RAW = 159 * MiB;
constexpr size_t OFF_ZD = 257 * MiB;
constexpr size_t SZ_H = (size_t)RPB * 512 * 2;
constexpr size_t OFF_DEC = 94 * MiB;
constexpr size_t OFF_KD = OFF_DEC + 4 * SZ_H;
constexpr size_t OFF_BQ = OFF_KD + 2 * SZ_H;
constexpr size_t OFF_KK = OFF_BQ + 2 * SZ_H;
constexpr size_t OFF_R = OFF_KK + SZ_H;
constexpr size_t OFF_V = 371 * MiB;
constexpr size_t OFF_G = OFF_V + SZ_H;
constexpr size_t OFF_LA = OFF_G + SZ_H;
constexpr size_t OFF_Y0 = 412 * MiB;
constexpr size_t OFF_PU = OFF_Y0 + 2 * SZ_H;
constexpr size_t WS_NEED = 509 * MiB;
constexpr int NCH = 128, CLEN = 130;
static_assert(OFF_R + SZ_H <= OFF_ZD, "scan map");
static_assert(OFF_LA + SZ_H / 2 <= OFF_Y0, "scan map 2");
static_assert(OFF_PU + 64 * MiB <= WS_NEED, "scan map 3");
static_assert(OFF_RAW + (size_t)MROWS * FFH * 2 <= WS_NEED, "ffn hidden");

struct Params { const float* in[30]; float* out; unsigned char* ws; };
typedef const __attribute__((address_space(4))) Params* PPtr;
DEV int tidx() { int t = threadIdx.x; asm volatile("" : "+v"(t)); return t; }
DEV PPtr launder(PPtr p) { asm volatile("" : "+s"(p)); return p; }

DEV unsigned f2bf(float f) { unsigned u = __float_as_uint(f); return (u + 0x7fffu + ((u >> 16) & 1u)) >> 16; }
DEV float bf2f(u16 h) { return __uint_as_float(((unsigned)h) << 16); }
DEV float bflo(unsigned u) { return __uint_as_float(u << 16); }
DEV float bfhi(unsigned u) { return __uint_as_float(u & 0xffff0000u); }
DEV unsigned pk2(float lo, float hi) { return f2bf(lo) | (f2bf(hi) << 16); }
DEV void unpack8(const uint4 u, float (&f)[8]) {
    f[0] = bflo(u.x); f[1] = bfhi(u.x); f[2] = bflo(u.y); f[3] = bfhi(u.y); f[4] = bflo(u.z); f[5] = bfhi(u.z); f[6] = bflo(u.w); f[7] = bfhi(u.w);
}
DEV uint4 pack8(const float (&f)[8]) { uint4 o; o.x = pk2(f[0], f[1]); o.y = pk2(f[2], f[3]); o.z = pk2(f[4], f[5]); o.w = pk2(f[6], f[7]); return o; }
DEV float wave_sum(float v) {
#pragma unroll
    for (int o = 1; o < 64; o <<= 1) v += __shfl_xor(v, o);
    return v;
}
DEV float* xrow_ptr(PPtr p, int m) {
    int b = m / RPB, q = m - b * RPB;
    return q < SEQ ? p->out + (size_t)(b * SEQ + q) * DM : (float*)(p->ws + OFF_XC) + (size_t)(b * NCTX + (q - SEQ)) * DM;
}
DEV int mod_idx(int m) { int b = m / RPB, q = m - b * RPB; return q < SEQ ? b : 2; }
DEV float sigmoidf_(float x) { return 1.f / (1.f + __expf(-x)); }

DEV void phase_init(PPtr p, char* lds) {
    const int tid = tidx();
    const size_t gt = (size_t)blockIdx.x * NTHR + tid, ng = (size_t)gridDim.x * NTHR;
    {
        const float4* s = (const float4*)p->in[0]; float4* d = (float4*)p->out;
        const size_t n = (size_t)NB * SEQ * DM / 4;
        for (size_t i = gt; i < n; i += ng) d[i] = s[i];
        const float4* s2 = (const float4*)p->in[2]; float4* d2 = (float4*)(p->ws + OFF_XC);
        const size_t n2 = (size_t)NB * NCTX * DM / 4;
        for (size_t i = gt; i < n2; i += ng) d2[i] = s2[i];
    }
    {
        float* T = (float*)(p->ws + OFF_ROPE);
        for (size_t i = gt; i < 5120; i += ng) {
            const int pos = (int)(i >> 4), f = (int)(i & 15);
            const float inv = powf(10000.f, -(float)f / 16.f);
            if (pos < 256) { const float ang = (float)pos * inv; T[pos * 16 + f] = cosf(ang); T[4096 + pos * 16 + f] = sinf(ang); }
            else { const float ang = (float)(pos - 256) * inv; T[8192 + (pos - 256) * 16 + f] = cosf(ang); T[9216 + (pos - 256) * 16 + f] = sinf(ang); }
        }
    }
    float* red = (float*)lds;
    float* mod = (float*)(p->ws + OFF_MOD);
    const float* c = p->in[1]; const float* cc = p->in[3];
    for (int item = blockIdx.x; item < 192; item += gridDim.x) {
        const int l = item / 48, n0 = (item % 48) * 128, col = tid & 127, kp = tid >> 7;
        const float* w = p->in[4] + (size_t)l * DM * 6144 + n0 + col;
        float a0 = 0.f, a1 = 0.f, a2 = 0.f;
        for (int k = kp * 256; k < kp * 256 + 256; ++k) {
            const float wv = w[(size_t)k * 6144];
            const float c0 = c[k], c1 = c[DM + k], c2 = cc[k];
            a0 += c0 * sigmoidf_(c0) * wv; a1 += c1 * sigmoidf_(c1) * wv; a2 += c2 * sigmoidf_(c2) * wv;
        }
        red[(kp * 3 + 0) * 128 + col] = a0; red[(kp * 3 + 1) * 128 + col] = a1; red[(kp * 3 + 2) * 128 + col] = a2;
        __syncthreads();
        if (tid < 384) {
            const int mb = tid >> 7, cl = tid & 127;
            float s = red[(0 * 3 + mb) * 128 + cl] + red[(1 * 3 + mb) * 128 + cl] + red[(2 * 3 + mb) * 128 + cl] + red[(3 * 3 + mb) * 128 + cl];
            mod[(size_t)(l * 3 + mb) * 6144 + n0 + cl] = s + p->in[5][l * 6144 + n0 + cl];
        }
        __syncthreads();
    }
}

DEV void phase_normmod(PPtr p, int layer, int which) {
    const int lane = tidx() & 63, gw = blockIdx.x * NWAVE + (tidx() >> 6), ngw = gridDim.x * NWAVE;
    const float* gain = p->in[which ? 7 : 6] + layer * DM;
    const float* mod = (const float*)(p->ws + OFF_MOD) + (size_t)layer * 3 * 6144;
    u16* HN = (u16*)(p->ws + OFF_HN);
    for (int m = gw; m < MROWS; m += ngw) {
        const float* xr = xrow_ptr(p, m);
        const float* md = mod + mod_idx(m) * 6144 + (which ? 3072 : 0);
        float4 v[4]; float ss = 0.f;
#pragma unroll
        for (int j = 0; j < 4; ++j) { v[j] = ((const float4*)xr)[lane + 64 * j]; ss += v[j].x * v[j].x + v[j].y * v[j].y + v[j].z * v[j].z + v[j].w * v[j].w; }
        ss = wave_sum(ss);
        const float rstd = rsqrtf(ss * (1.f / DM) + 1e-6f);
#pragma unroll
        for (int j = 0; j < 4; ++j) {
            const int k = (lane + 64 * j) * 4;
            const float4 g = *(const float4*)(gain + k), sh = *(const float4*)(md + k), sc = *(const float4*)(md + 1024 + k);
            const float o0 = v[j].x * rstd * g.x * (1.f + sc.x) + sh.x, o1 = v[j].y * rstd * g.y * (1.f + sc.y) + sh.y;
            const float o2 = v[j].z * rstd * g.z * (1.f + sc.z) + sh.z, o3 = v[j].w * rstd * g.w * (1.f + sc.w) + sh.w;
            uint2 w; w.x = pk2(o0, o1); w.y = pk2(o2, o3);
            *(uint2*)(HN + (size_t)m * DM + k) = w;
        }
    }
}

template <int DUAL, class Epi>
DEV void gemm_simple(const u16* A, int lda, const float* W, int ldw, int dualoff, int M, int N, int K, const Epi& epi, char* lds) {
    u16* sA = (u16*)lds; u16* sB = sA + 128 * 40; u16* sB2 = sB + 128 * 40;
    const int tid = tidx(), lane = tid & 63, wave = tid >> 6, wm = wave >> 2, wn = wave & 3, r16 = lane & 15, quad = lane >> 4;
    const int mt = M / 128, nt = N / 128;
    for (int item = blockIdx.x; item < mt * nt; item += gridDim.x) {
        const int tn = item / mt, tm = item - tn * mt, m0 = tm * 128, n0 = tn * 128;
        f32x4 acc[4][2], acc2[4][2];
#pragma unroll
        for (int a = 0; a < 4; ++a)
#pragma unroll
            for (int b = 0; b < 2; ++b) { acc[a][b] = (f32x4){0.f, 0.f, 0.f, 0.f}; acc2[a][b] = (f32x4){0.f, 0.f, 0.f, 0.f}; }
        for (int k0 = 0; k0 < K; k0 += 32) {
            {
                const int row = tid >> 2, kc = (tid & 3) * 8;
                const uint4 v = *(const uint4*)(A + (size_t)(m0 + row) * lda + k0 + kc);
                *(uint4*)(sA + row * 40 + kc) = v;
            }
            {
                const int kk = tid >> 4, nc = (tid & 15) * 8;
                const float* wp = W + (size_t)(k0 + kk) * ldw + n0 + nc;
                const float4 a = *(const float4*)wp, b = *(const float4*)(wp + 4);
                sB[(nc + 0) * 40 + kk] = (u16)f2bf(a.x); sB[(nc + 1) * 40 + kk] = (u16)f2bf(a.y); sB[(nc + 2) * 40 + kk] = (u16)f2bf(a.z); sB[(nc + 3) * 40 + kk] = (u16)f2bf(a.w);
                sB[(nc + 4) * 40 + kk] = (u16)f2bf(b.x); sB[(nc + 5) * 40 + kk] = (u16)f2bf(b.y); sB[(nc + 6) * 40 + kk] = (u16)f2bf(b.z); sB[(nc + 7) * 40 + kk] = (u16)f2bf(b.w);
                if (DUAL) {
                    const float4 c = *(const float4*)(wp + dualoff), d = *(const float4*)(wp + dualoff + 4);
                    sB2[(nc + 0) * 40 + kk] = (u16)f2bf(c.x); sB2[(nc + 1) * 40 + kk] = (u16)f2bf(c.y); sB2[(nc + 2) * 40 + kk] = (u16)f2bf(c.z); sB2[(nc + 3) * 40 + kk] = (u16)f2bf(c.w);
                    sB2[(nc + 4) * 40 + kk] = (u16)f2bf(d.x); sB2[(nc + 5) * 40 + kk] = (u16)f2bf(d.y); sB2[(nc + 6) * 40 + kk] = (u16)f2bf(d.z); sB2[(nc + 7) * 40 + kk] = (u16)f2bf(d.w);
                }
            }
            __syncthreads();
            bf16x8 af[4], bfr[2], bfr2[2];
#pragma unroll
            for (int mi = 0; mi < 4; ++mi) af[mi] = *(const bf16x8*)(sA + (wm * 64 + mi * 16 + r16) * 40 + quad * 8);
#pragma unroll
            for (int ni = 0; ni < 2; ++ni) {
                bfr[ni] = *(const bf16x8*)(sB + (wn * 32 + ni * 16 + r16) * 40 + quad * 8);
                if (DUAL) bfr2[ni] = *(const bf16x8*)(sB2 + (wn * 32 + ni * 16 + r16) * 40 + quad * 8);
            }
#pragma unroll
            for (int mi = 0; mi < 4; ++mi)
#pragma unroll
                for (int ni = 0; ni < 2; ++ni) {
                    acc[mi][ni] = __builtin_amdgcn_mfma_f32_16x16x32_bf16(af[mi], bfr[ni], acc[mi][ni], 0, 0, 0);
                    if (DUAL) acc2[mi][ni] = __builtin_amdgcn_mfma_f32_16x16x32_bf16(af[mi], bfr2[ni], acc2[mi][ni], 0, 0, 0);
                }
            __syncthreads();
        }
#pragma unroll
        for (int mi = 0; mi < 4; ++mi)
#pragma unroll
            for (int ni = 0; ni < 2; ++ni)
#pragma unroll
                for (int j = 0; j < 4; ++j) {
                    const int row = m0 + wm * 64 + mi * 16 + quad * 4 + j, col = n0 + wn * 32 + ni * 16 + r16;
                    epi(row, col, acc[mi][ni][j], DUAL ? acc2[mi][ni][j] : 0.f);
                }
    }
}

struct EpiStore { u16* O; int ld; DEV void operator()(int r, int c, float v, float) const { O[(size_t)r * ld + c] = (u16)f2bf(v); } };
struct EpiStoreOdd { u16* Q; u16* Z;
    DEV void operator()(int r, int c, float v, float) const { if (c < 1536) Q[(size_t)r * 1536 + c] = (u16)f2bf(v); else Z[(size_t)r * ZDW + (c - 1536)] = (u16)f2bf(v); } };
struct EpiResid { PPtr p; const float* gate;
    DEV void operator()(int r, int c, float v, float) const { float* xr = xrow_ptr(p, r); xr[c] += gate[mod_idx(r) * 6144 + c] * v; } };
struct EpiSwiglu { u16* H;
    DEV void operator()(int r, int c, float g, float u) const { H[(size_t)r * FFH + c] = (u16)f2bf(g * sigmoidf_(g) * u); } };


namespace pg8 {
#define PG8_LAS __attribute__((address_space(3)))
typedef unsigned short bf16_t;
typedef short bf16x8 __attribute__((ext_vector_type(8)));
typedef float f32x4 __attribute__((ext_vector_type(4)));
typedef unsigned u32x4 __attribute__((ext_vector_type(4)));
constexpr int BM = 256, BK = 64, HALF = 128, HTB = HALF * BK * 2  , STAGE_BYTES = 8 * HTB, NXCD = 8, WGM = 8;

__host__ __device__ __forceinline__ int lds_byte(int r, int c) { const int st = (r >> 4) * 2 + (c >> 5), rr = r & 15, cc = c & 31, ob = rr * 64 + cc * 2; return st * 1024 + (ob ^ (((ob >> 9) & 1) << 5)); }
__host__ __device__ __forceinline__ void stage_rc(int b, int& R, int& C) { const int st = b / 1024, sb = b % 1024, swz = sb ^ (((sb >> 9) & 1) << 5); R = (st >> 1) * 16 + swz / 64; C = (st & 1) * 32 + (swz % 64) / 2; }
__host__ __device__ __forceinline__ int perm32(int rho) { const int n = rho >> 4, i = rho & 15; return 8 * (i >> 2) + 4 * n + (i & 3); }

struct Unit { int pm, pn; };
struct Gemm { const bf16_t* A; const bf16_t* Bt; int M, N, K; };

struct StaticOrder {
    int nM, nN, nwg, G, c;
    __host__ __device__ void init(int M, int N, int G_, int c_) { nM = M / BM; nN = N / BM; nwg = nM * nN; G = G_; c = c_; }
    __host__ __device__ bool next(int i, Unit& u) const {
        const long L = (long)i * G + c; if (L >= nwg) return false;
        int wgid = (int)L; { const int q = nwg / NXCD, r = nwg % NXCD, xcd = wgid % NXCD, off = wgid / NXCD; wgid = (xcd < r ? xcd * (q + 1) : r * (q + 1) + (xcd - r) * q) + off; }
        const int nig = WGM * nN, gid = wgid / nig, fm = gid * WGM, gsz = (nM - fm) < WGM ? (nM - fm) : WGM;
        u.pm = fm + ((wgid % nig) % gsz); u.pn = (wgid % nig) / gsz; return true;
    }
    __device__ __forceinline__ void a_ready(const Unit&) const {}
    __device__ __forceinline__ void done(const Unit&) const {}
};
__device__ __forceinline__ unsigned cvt_pk_bf16(float lo, float hi) { unsigned r; asm volatile("v_cvt_pk_bf16_f32 %0, %1, %2" : "=v"(r) : "v"(lo), "v"(hi)); return r; }
template <class Epi, class Sched, bool ALIGN_EPI = false, bool SP2 = false>
__device__ __forceinline__ void gemm_phase(PG8_LAS unsigned char* lds, const Gemm g, const Sched& S, const Epi& E) {
    const int tid = tidx(), wid = __builtin_amdgcn_readfirstlane(tid >> 6), lane = tid & 63, wr = wid >> 2, wc = wid & 3, fr = lane & 15, fq = lane >> 4;
    const int K = g.K, nt = K / BK;
    unsigned voffA[2], voffB[2];
#pragma unroll
    for (int i = 0; i < 2; ++i) { int R, C; stage_rc(tid * 16 + i * 8192, R, C); const int Rb = Epi::PERM ? ((R & ~31) + perm32(R & 31)) : R;
        voffA[i] = (unsigned)(R * K + C) * 2u; voffB[i] = (unsigned)(Rb * K + C) * 2u; }
    const size_t kstep = (size_t)(BK * 2);
    const size_t hstep = (size_t)HALF * K * 2;
    const size_t tstep = 2 * hstep;
    const unsigned ldsw = (unsigned)wid * 1024u;
    const int aoff = lds_byte(wr * 64 + fr, fq * 8), boff = lds_byte(wc * 32 + fr, fq * 8);
#define PG8_SA(b, h) (((b) * 2 + (h)) * HTB)
#define PG8_SB(b, h) ((4 + (b) * 2 + (h)) * HTB)
#define PG8_STAGE(bufoff, gbase, voff) do { _Pragma("unroll") for (int _i = 0; _i < 2; ++_i) \
        __builtin_amdgcn_global_load_lds((const unsigned*)((const char*)(gbase) + (voff)[_i]), (PG8_LAS unsigned*)(lds + (bufoff) + ldsw + _i * 8192), 16, 0, 0); } while (0)
#define PG8_LDA(dst, b, h) do { _Pragma("unroll") for (int m = 0; m < 4; ++m) _Pragma("unroll") for (int k = 0; k < 2; ++k) dst[m][k] = *(const PG8_LAS bf16x8*)(lds + PG8_SA(b, h) + aoff + m * 2048 + k * 1024); } while (0)
#define PG8_LDB(dst, b, h) do { _Pragma("unroll") for (int n = 0; n < 2; ++n) _Pragma("unroll") for (int k = 0; k < 2; ++k) dst[n][k] = *(const PG8_LAS bf16x8*)(lds + PG8_SB(b, h) + boff + n * 2048 + k * 1024); } while (0)
#define PG8_MMA(ai, bj, At, Bt) do { __builtin_amdgcn_s_setprio(1); _Pragma("unroll") for (int m = 0; m < 4; ++m) _Pragma("unroll") for (int n = 0; n < 2; ++n) _Pragma("unroll") for (int k = 0; k < 2; ++k) \
        acc[ai][bj][m][n] = __builtin_amdgcn_mfma_f32_16x16x32_bf16(Bt[n][k], At[m][k], acc[ai][bj][m][n], 0, 0, 0); __builtin_amdgcn_s_setprio(0); } while (0)
#define PG8_WAIT_V(n) asm volatile("s_waitcnt vmcnt(" #n ")" ::: "memory")
#define PG8_WAIT_L(n) asm volatile("s_waitcnt lgkmcnt(" #n ")" ::: "memory")
#define PG8_BAR __builtin_amdgcn_s_barrier()
#define PG8_SCHED __builtin_amdgcn_sched_barrier(0)
    Unit cur, nxt; int ui = 0;
    if (!S.next(0, cur)) return;
    f32x4 acc[2][2][4][2];
#pragma unroll
    for (int a = 0; a < 2; ++a)
#pragma unroll
        for (int b = 0; b < 2; ++b)
#pragma unroll
            for (int m = 0; m < 4; ++m)
#pragma unroll
                for (int n = 0; n < 2; ++n) acc[a][b][m][n] = (f32x4){0.f, 0.f, 0.f, 0.f};
    bf16x8 At[4][2], B0[2][2], B1[2][2];
    const char* cA = (const char*)g.A + (size_t)cur.pm * tstep; const char* cB = (const char*)g.Bt + (size_t)cur.pn * tstep;
    S.a_ready(cur);
    if constexpr (SP2) {
        PG8_STAGE(PG8_SB(0, 0), cB, voffB); PG8_STAGE(PG8_SB(0, 1), cB + hstep, voffB); PG8_STAGE(PG8_SA(0, 0), cA, voffA); PG8_STAGE(PG8_SA(0, 1), cA + hstep, voffA);
        if (wr == 1) PG8_BAR;
        PG8_WAIT_V(2); PG8_BAR;
        PG8_STAGE(PG8_SB(1, 0), cB + kstep, voffB); PG8_STAGE(PG8_SA(1, 0), cA + kstep, voffA); PG8_STAGE(PG8_SB(1, 1), cB + hstep + kstep, voffB);
        PG8_WAIT_V(6); PG8_BAR;
    } else {
        PG8_STAGE(PG8_SB(0, 0), cB, voffB); PG8_STAGE(PG8_SA(0, 0), cA, voffA); PG8_STAGE(PG8_SB(0, 1), cB + hstep, voffB); PG8_STAGE(PG8_SA(0, 1), cA + hstep, voffA);
        if (wr == 1) PG8_BAR;
        PG8_WAIT_V(4); PG8_BAR;
        PG8_STAGE(PG8_SB(1, 0), cB + kstep, voffB); PG8_STAGE(PG8_SA(1, 0), cA + kstep, voffA); PG8_STAGE(PG8_SB(1, 1), cB + hstep + kstep, voffB);
        PG8_WAIT_V(6); PG8_BAR;
    }
    for (;;) {
        const bool has_next = S.next(ui + 1, nxt);
        const char* nA = has_next ? (const char*)g.A + (size_t)nxt.pm * tstep : cA; const char* nB = has_next ? (const char*)g.Bt + (size_t)nxt.pn * tstep : cB;
        for (int t = 0; t < nt; t += 2) {
            const bool last = (t == nt - 2);
            const char* a1 = cA + (size_t)(t + 1) * kstep;
            const char* a2 = last ? nA : cA + (size_t)(t + 2) * kstep; const char* b2 = last ? nB : cB + (size_t)(t + 2) * kstep;
            const char* a3 = a2 + kstep; const char* b3 = b2 + kstep;
            if (last && has_next) S.a_ready(nxt);
            if constexpr (SP2) {
            PG8_LDB(B0, 0, 0); PG8_LDB(B1, 0, 1); PG8_SCHED; PG8_LDA(At, 0, 0); PG8_STAGE(PG8_SA(1, 1), a1 + hstep, voffA);
            PG8_WAIT_V(8); PG8_WAIT_L(0); PG8_BAR; PG8_MMA(0, 0, At, B0); PG8_MMA(0, 1, At, B1); PG8_BAR; PG8_SCHED;
            PG8_LDA(At, 0, 1); PG8_STAGE(PG8_SB(0, 0), b2, voffB); PG8_STAGE(PG8_SB(0, 1), b2 + hstep, voffB); PG8_STAGE(PG8_SA(0, 0), a2, voffA);
            PG8_WAIT_V(8); PG8_WAIT_L(0); PG8_BAR; PG8_MMA(1, 0, At, B0); PG8_MMA(1, 1, At, B1); PG8_BAR; PG8_SCHED;
            PG8_LDB(B0, 1, 0); PG8_LDB(B1, 1, 1); PG8_SCHED; PG8_LDA(At, 1, 0); PG8_STAGE(PG8_SA(0, 1), a2 + hstep, voffA);
            PG8_WAIT_V(8); PG8_WAIT_L(0); PG8_BAR; PG8_MMA(0, 0, At, B0); PG8_MMA(0, 1, At, B1); PG8_BAR; PG8_SCHED;
            PG8_LDA(At, 1, 1); PG8_STAGE(PG8_SB(1, 0), b3, voffB); PG8_STAGE(PG8_SB(1, 1), b3 + hstep, voffB); PG8_STAGE(PG8_SA(1, 0), a3, voffA);
            PG8_WAIT_V(8); PG8_WAIT_L(0); PG8_BAR; PG8_MMA(1, 0, At, B0); PG8_MMA(1, 1, At, B1); PG8_BAR; PG8_SCHED;
            } else {
            PG8_LDB(B0, 0, 0); PG8_SCHED; PG8_LDA(At, 0, 0); PG8_STAGE(PG8_SA(1, 1), a1 + hstep, voffA);
            PG8_WAIT_L(8); PG8_BAR; PG8_WAIT_L(0); PG8_MMA(0, 0, At, B0); PG8_BAR; PG8_SCHED;
            PG8_LDB(B1, 0, 1); PG8_STAGE(PG8_SB(0, 0), b2, voffB);
            PG8_BAR; PG8_WAIT_L(0); PG8_MMA(0, 1, At, B1); PG8_BAR;
            PG8_LDA(At, 0, 1); PG8_STAGE(PG8_SA(0, 0), a2, voffA);
            PG8_BAR; PG8_WAIT_L(0); PG8_MMA(1, 0, At, B0); PG8_BAR; PG8_SCHED;
            PG8_STAGE(PG8_SB(0, 1), b2 + hstep, voffB);
            PG8_WAIT_V(6); PG8_BAR; PG8_MMA(1, 1, At, B1); PG8_BAR;
            PG8_LDB(B0, 1, 0); PG8_SCHED; PG8_LDA(At, 1, 0); PG8_STAGE(PG8_SA(0, 1), a2 + hstep, voffA);
            PG8_WAIT_L(8); PG8_BAR; PG8_WAIT_L(0); PG8_MMA(0, 0, At, B0); PG8_BAR; PG8_SCHED;
            PG8_LDB(B1, 1, 1); PG8_STAGE(PG8_SB(1, 0), b3, voffB);
            PG8_BAR; PG8_WAIT_L(0); PG8_MMA(0, 1, At, B1); PG8_BAR;
            PG8_LDA(At, 1, 1); PG8_STAGE(PG8_SA(1, 0), a3, voffA);
            PG8_BAR; PG8_WAIT_L(0); PG8_MMA(1, 0, At, B0); PG8_BAR; PG8_SCHED;
            PG8_STAGE(PG8_SB(1, 1), b3 + hstep, voffB);
            PG8_WAIT_V(6); PG8_BAR; PG8_MMA(1, 1, At, B1); PG8_BAR;
            }
        }
        if constexpr (ALIGN_EPI) { if (wr == 0) PG8_BAR; }
        if constexpr (!Epi::AFTER_DRAIN) { E(acc, cur, wr, wc, fr, fq); S.done(cur); }
        if (!has_next) break;
#pragma unroll
        for (int a = 0; a < 2; ++a)
#pragma unroll
            for (int b = 0; b < 2; ++b)
#pragma unroll
                for (int m = 0; m < 4; ++m)
#pragma unroll
                    for (int n = 0; n < 2; ++n) acc[a][b][m][n] = (f32x4){0.f, 0.f, 0.f, 0.f};
        cur = nxt; cA = nA; cB = nB; ++ui;
        if constexpr (ALIGN_EPI) { if (wr == 1) PG8_BAR; }
    }
    PG8_WAIT_V(0);
    if constexpr (!ALIGN_EPI) { if (wr == 0) PG8_BAR; }
    PG8_BAR;
    if constexpr (Epi::AFTER_DRAIN) { E.fused(acc, cur, wr, wc, fr, fq, lds, wid, lane); S.done(cur); }
#undef PG8_SA
#undef PG8_SB
#undef PG8_STAGE
#undef PG8_LDA
#undef PG8_LDB
#undef PG8_MMA
#undef PG8_WAIT_V
#undef PG8_WAIT_L
#undef PG8_BAR
#undef PG8_SCHED
}

struct EpiStoreT {
    static constexpr bool PERM = true, AFTER_DRAIN = false;
    bf16_t* O0; int ld0; int split; bf16_t* O1; int ld1;
    __device__ __forceinline__ void operator()(const f32x4 (&acc)[2][2][4][2], const Unit& u, int wr, int wc, int fr, int fq) const {
        const int row0 = u.pm * BM + wr * 64 + fr; int colt = u.pn * BM; bf16_t* base = O0; int ld = ld0;
        if (colt >= split) { base = O1; ld = ld1; colt -= split; }
        const int col0 = colt + wc * 32 + 8 * fq;
#pragma unroll
        for (int ai = 0; ai < 2; ++ai)
#pragma unroll
            for (int m = 0; m < 4; ++m) { bf16_t* rowp = base + (size_t)(row0 + ai * HALF + m * 16) * ld + col0;
#pragma unroll
                for (int bj = 0; bj < 2; ++bj) { const f32x4 v0 = acc[ai][bj][m][0], v1 = acc[ai][bj][m][1];
                    u32x4 w; w.x = cvt_pk_bf16(v0[0], v0[1]); w.y = cvt_pk_bf16(v0[2], v0[3]); w.z = cvt_pk_bf16(v1[0], v1[1]); w.w = cvt_pk_bf16(v1[2], v1[3]);
                    *(u32x4*)(rowp + bj * HALF) = w; } }
    }
};
struct EpiResidT {
    static constexpr bool PERM = true, AFTER_DRAIN = false;
    PPtr p; const float* gate;
    __device__ __forceinline__ void operator()(const f32x4 (&acc)[2][2][4][2], const Unit& u, int wr, int wc, int fr, int fq) const {
        float* xb = xrow_ptr(p, u.pm * BM); const float* g = gate + mod_idx(u.pm * BM) * 6144;
        const int col0 = u.pn * BM + wc * 32 + 8 * fq;
#pragma unroll
        for (int ai = 0; ai < 2; ++ai)
#pragma unroll
            for (int m = 0; m < 4; ++m) { float* xr = xb + (size_t)(ai * HALF + wr * 64 + m * 16 + fr) * DM;
#pragma unroll
                for (int bj = 0; bj < 2; ++bj) { const int col = col0 + bj * HALF; const f32x4 v0 = acc[ai][bj][m][0], v1 = acc[ai][bj][m][1];
                    const f32x4 g0 = *(const f32x4*)(g + col), g1 = *(const f32x4*)(g + col + 4);
                    f32x4 x0 = *(const f32x4*)(xr + col), x1 = *(const f32x4*)(xr + col + 4);
                    x0 += g0 * v0; x1 += g1 * v1;
                    *(f32x4*)(xr + col) = x0; *(f32x4*)(xr + col + 4) = x1; } }
    }
};
struct EpiSwigluT {
    static constexpr bool PERM = true, AFTER_DRAIN = false;
    bf16_t* H;
    __device__ __forceinline__ void operator()(const f32x4 (&acc)[2][2][4][2], const Unit& u, int wr, int wc, int fr, int fq) const {
        const int row0 = u.pm * BM + wr * 64 + fr; const int col0 = u.pn * BM + wc * 32 + 8 * fq;
#pragma unroll
        for (int ai = 0; ai < 2; ++ai)
#pragma unroll
            for (int m = 0; m < 4; ++m) { bf16_t* rowp = H + (size_t)(row0 + ai * HALF + m * 16) * FFH;
#pragma unroll
                for (int bj = 0; bj < 2; ++bj) { const f32x4 gt = acc[ai][bj][m][0], up = acc[ai][bj][m][1];
                    float h[4];
#pragma unroll
                    for (int j = 0; j < 4; ++j) h[j] = gt[j] * sigmoidf_(gt[j]) * up[j];
                    uint2 w; w.x = cvt_pk_bf16(h[0], h[1]); w.y = cvt_pk_bf16(h[2], h[3]);
                    *(uint2*)(rowp + ((col0 + bj * HALF) >> 1)) = w; } }
    }
};

struct EpiLoraT {
    static constexpr bool PERM = true, AFTER_DRAIN = false;
    float* DEC; bf16_t* KD; bf16_t* BQ; bf16_t* G; const bf16_t* KK; const bf16_t* ZDb;
    const float* w0; const float* a0; const float* ka; const float* muk;
    template <int TYPE>
    __device__ __forceinline__ void one(const f32x4 v, int r, int c, int d) const {
        if (TYPE == 0) {
            const float4 wa = *(const float4*)(w0 + d * 512 + c);
            const float ww[4] = {wa.x, wa.y, wa.z, wa.w};
            float o[4];
#pragma unroll
            for (int e = 0; e < 4; ++e) { const float x = -(ww[e] + v[e]); const float sp = x > 20.f ? x : __logf(1.f + __expf(x)); o[e] = __expf(-__expf(-sp - 0.5f)); }
            *(float4*)(DEC + ((size_t)r * 2 + d) * 512 + c) = (float4){o[0], o[1], o[2], o[3]};
        } else if (TYPE == 1) {
            const float4 aa = *(const float4*)(a0 + d * 512 + c), ka0 = *(const float4*)(ka + c), m0 = *(const float4*)(muk + c);
            const float a0v[4] = {aa.x, aa.y, aa.z, aa.w}, kav[4] = {ka0.x, ka0.y, ka0.z, ka0.w}, mm[4] = {m0.x, m0.y, m0.z, m0.w};
            const bool lat = r < SEQ; const int lo = lat ? 0 : SEQ, hi = lat ? SEQ : RPB;
            const bf16_t* zc = ZDb + (size_t)r * ZDW + 512 + c;
            const bool hp = r - 1 >= lo, hn = r + 1 < hi;
            const uint2 uz = *(const uint2*)zc, up = *(const uint2*)(hp ? zc - ZDW : zc), un = *(const uint2*)(hn ? zc + ZDW : zc), uk = *(const uint2*)(KK + (size_t)r * 512 + c);
            const float z[4] = {bflo(uz.x), bfhi(uz.x), bflo(uz.y), bfhi(uz.y)}, zp[4] = {bflo(up.x), bfhi(up.x), bflo(up.y), bfhi(up.y)};
            const float zn[4] = {bflo(un.x), bfhi(un.x), bflo(un.y), bfhi(un.y)}, kk[4] = {bflo(uk.x), bfhi(uk.x), bflo(uk.y), bfhi(uk.y)};
            const float fp = hp ? 0.5f : 0.f, fn = hn ? 0.5f : 0.f;
            float okd[4], obq[4];
#pragma unroll
            for (int e = 0; e < 4; ++e) {
                const float a = sigmoidf_(a0v[e] + v[e]);
                const float k = z[e] + ((fp * zp[e] + fn * zn[e]) - z[e]) * mm[e];
                okd[e] = k * (1.f + (a - 1.f) * kav[e]); obq[e] = kk[e] * a;
            }
            uint2 w1; w1.x = pk2(okd[0], okd[1]); w1.y = pk2(okd[2], okd[3]); *(uint2*)(KD + ((size_t)r * 2 + d) * 512 + c) = w1;
            uint2 w2; w2.x = pk2(obq[0], obq[1]); w2.y = pk2(obq[2], obq[3]); *(uint2*)(BQ + ((size_t)r * 2 + d) * 512 + c) = w2;
        } else {
            uint2 w; w.x = pk2(v[0], v[1]); w.y = pk2(v[2], v[3]); *(uint2*)(G + (size_t)r * 512 + c) = w;
        }
    }
    template <int TYPE>
    __device__ __forceinline__ void all(const f32x4 (&acc)[2][2][4][2], const Unit& u, int wr, int wc, int fr, int fq) const {
        const int d = (u.pn >> 1) & 1, cb = (u.pn & 1) * 256 + wc * 32 + 8 * fq;
#pragma unroll
        for (int ai = 0; ai < 2; ++ai)
#pragma unroll
            for (int m = 0; m < 4; ++m)
#pragma unroll
                for (int bj = 0; bj < 2; ++bj)
                {   const int r = u.pm * BM + ai * HALF + wr * 64 + m * 16 + fr, c = cb + bj * HALF;
                    one<TYPE>(acc[ai][bj][m][0], r, c, d); one<TYPE>(acc[ai][bj][m][1], r, c + 4, d); }
    }
    __device__ __forceinline__ void operator()(const f32x4 (&acc)[2][2][4][2], const Unit& u, int wr, int wc, int fr, int fq) const {
        const int type = u.pn >> 1;
        if (type < 2) all<0>(acc, u, wr, wc, fr, fq); else if (type < 4) all<1>(acc, u, wr, wc, fr, fq); else all<2>(acc, u, wr, wc, fr, fq);
    }
};
}

DEV void transpose_item(const float* W, int K, int N, u16* WT, int mode, float* scr, int item, int lane) {
    const int nblk = N / 32, kb = item / nblk, nb = item - kb * nblk, k0 = 64 * kb, n0 = 32 * nb;
#pragma unroll 8
    for (int i = 0; i < 32; ++i) { const int kk = 2 * i + (lane >> 5); scr[kk * 33 + (lane & 31)] = W[(size_t)(k0 + kk) * N + n0 + (lane & 31)]; }
    asm volatile("s_waitcnt lgkmcnt(0)" ::: "memory");
    const int c = lane & 7;
#pragma unroll
    for (int j = 0; j < 4; ++j) {
        const int n = (lane >> 3) + 8 * j; const float* sp = scr + (8 * c) * 33 + n;
        uint4 o; o.x = pk2(sp[0 * 33], sp[1 * 33]); o.y = pk2(sp[2 * 33], sp[3 * 33]); o.z = pk2(sp[4 * 33], sp[5 * 33]); o.w = pk2(sp[6 * 33], sp[7 * 33]);
        const int ns = n0 + n;
        int drow = ns;
        if (mode) { const int nn = ns >= FFH ? 1 : 0; const int g = ns - nn * FFH; drow = 8 * (g >> 2) + 4 * nn + (g & 3); }
        *(uint4*)(WT + (size_t)drow * K + k0 + 8 * c) = o;
    }
    asm volatile("s_waitcnt lgkmcnt(0)" ::: "memory");
}
constexpr size_t WB_IN = 0, WB_OUT = (size_t)3328 * 1024, WB_F1 = WB_OUT + (size_t)1024 * 1024, WB_F2 = WB_F1 + (size_t)5632 * 1024;
DEV void phase_wprep(PPtr p, int layer, char* lds) {
    const int tid = tidx(), lane = tid & 63, wave = tid >> 6, gw = blockIdx.x * NWAVE + wave, ngw = gridDim.x * NWAVE;
    float* scr = (float*)lds + wave * (64 * 33);
    u16* WB = (u16*)(p->ws + OFF_WB);
    const int li = layer >> 1, odd = layer & 1;
    const int nin = odd ? 3328 : 1536;
    const float* win = odd ? p->in[13] + (size_t)li * DM * 3328 : p->in[8] + (size_t)li * DM * 1536;
    const float* wout = (odd ? p->in[14] : p->in[9]) + (size_t)li * DM * DM;
    const float* wf1 = p->in[27] + (size_t)layer * DM * 5632; const float* wf2 = p->in[28] + (size_t)layer * FFH * DM;
    const int i0 = 16 * (nin / 32), i1 = i0 + 16 * 32, i2 = i1 + 16 * 176, i3 = i2 + 44 * 32;
    for (int it = gw; it < i3; it += ngw) {
        if (it < i0) transpose_item(win, DM, nin, WB + WB_IN, 0, scr, it, lane);
        else if (it < i1) transpose_item(wout, DM, DM, WB + WB_OUT, 0, scr, it - i0, lane);
        else if (it < i2) transpose_item(wf1, DM, 5632, WB + WB_F1, 1, scr, it - i1, lane);
        else transpose_item(wf2, FFH, DM, WB + WB_F2, 0, scr, it - i2, lane);
    }
}

#include <hip/hip_bf16.h>
#include <cmath>
namespace attn_body {
using bf16=__hip_bfloat16;
using bf16x8=__attribute__((ext_vector_type(8)))short;
using s16x4=__attribute__((ext_vector_type(4)))short;
using f32x16=__attribute__((ext_vector_type(16)))float;
using u32x4=__attribute__((ext_vector_type(4)))unsigned;
constexpr int D=64,PQ=1536,PO=1024,KROWS=16640,RPBA=16640;
constexpr int NW=8,QBLK=32,QB=QBLK*NW,KVBLK=64;
constexpr int ATTN_UNIT_ROWS=QB;
__device__ __forceinline__ int crow(int r,int hi){return (r&3)+8*(r>>2)+4*hi;}
#define SBAR() __builtin_amdgcn_sched_barrier(0)
__device__ __forceinline__ void cmask(f32x16&p0,f32x16&p1,int jb,int qrel,int hi){
  const float NEG=-INFINITY; int kb=64*jb+4*hi;
  #pragma unroll
  for(int r=0;r<16;++r){int kv=kb+(r&3)+8*(r>>2); if(kv>qrel)p0[r]=NEG; if(kv+32>qrel)p1[r]=NEG;}
}

constexpr int NSLOT=3, SLOTB=8192;
constexpr int LDS_K=0, LDS_V=NSLOT*SLOTB, LDS_WS=2*NSLOT*SLOTB, LDS_OST=LDS_WS+NW*64*4, LDS_BYTES=LDS_OST+NW*4096;
constexpr float C2=0.125f*1.4426950408889634f;
__device__ __forceinline__ void glds16(const void*gsrc,unsigned lds_dst){unsigned keep;
  asm volatile("s_mov_b32 %0, m0\n\ts_mov_b32 m0, %2\n\ts_nop 0\n\tglobal_load_lds_dwordx4 %1, off\n\ts_mov_b32 m0, %0":"=&s"(keep):"v"(gsrc),"s"(lds_dst):"memory");}
__device__ __forceinline__ float max3f(float a,float b,float c){float r;asm("v_max3_f32 %0, %1, %2, %3":"=v"(r):"v"(a),"v"(b),"v"(c));return r;}
__device__ __forceinline__ float max2f(float a,float b){float r;asm("v_max_f32_e32 %0, %1, %2":"=v"(r):"v"(a),"v"(b));return r;}
__device__ __forceinline__ float fadd_s(float a,float b){float r;asm("v_add_f32_e32 %0, %1, %2":"=v"(r):"v"(a),"v"(b));return r;}
__device__ __forceinline__ float fsub_s(float a,float b){float r;asm("v_sub_f32_e32 %0, %1, %2":"=v"(r):"v"(a),"v"(b));return r;}
typedef float f32x2_t __attribute__((ext_vector_type(2))); typedef __bf16 bf16x2_t __attribute__((ext_vector_type(2)));
__device__ __forceinline__ unsigned cvtpk_s(float lo,float hi){f32x2_t v={lo,hi};bf16x2_t b=__builtin_convertvector(v,bf16x2_t);return __builtin_bit_cast(unsigned,b);}
#define WAIT_BAR(N) asm volatile("s_waitcnt vmcnt(" #N ") lgkmcnt(0)\n\ts_barrier":::"memory")

__device__ __forceinline__ void qkt(f32x16&p0,f32x16&p1,const char*Kslot,const bf16x8*qr,const f32x16&negm,int r32,int hi){
  const char*kb=Kslot+hi*1024+r32*16;
  #pragma unroll
  for(int d0=0;d0<4;++d0){
    const bf16x8 b0=*reinterpret_cast<const bf16x8*>(kb+d0*2048);
    const bf16x8 b1=*reinterpret_cast<const bf16x8*>(kb+d0*2048+512);
    if(d0==0){p0=__builtin_amdgcn_mfma_f32_32x32x16_bf16(b0,qr[0],negm,0,0,0);p1=__builtin_amdgcn_mfma_f32_32x32x16_bf16(b1,qr[0],negm,0,0,0);}
    else{p0=__builtin_amdgcn_mfma_f32_32x32x16_bf16(b0,qr[d0],p0,0,0,0);p1=__builtin_amdgcn_mfma_f32_32x32x16_bf16(b1,qr[d0],p1,0,0,0);}}
}
typedef __attribute__((address_space(3))) const char* lds_cptr;
typedef short v4i16_t __attribute__((ext_vector_type(4)));
__device__ __forceinline__ void kload8(bf16x8*kf,lds_cptr kp){
  kf[0]=*(const __attribute__((address_space(3))) bf16x8*)(kp);      kf[1]=*(const __attribute__((address_space(3))) bf16x8*)(kp+512);
  kf[2]=*(const __attribute__((address_space(3))) bf16x8*)(kp+2048); kf[3]=*(const __attribute__((address_space(3))) bf16x8*)(kp+2560);
  kf[4]=*(const __attribute__((address_space(3))) bf16x8*)(kp+4096); kf[5]=*(const __attribute__((address_space(3))) bf16x8*)(kp+4608);
  kf[6]=*(const __attribute__((address_space(3))) bf16x8*)(kp+6144); kf[7]=*(const __attribute__((address_space(3))) bf16x8*)(kp+6656);
}
__device__ __forceinline__ void kload2(bf16x8*kf,lds_cptr kp,int j){ kf[2*j]=*(const __attribute__((address_space(3))) bf16x8*)(kp+j*2048); kf[2*j+1]=*(const __attribute__((address_space(3))) bf16x8*)(kp+j*2048+512); }
__device__ __forceinline__ s16x4 vtr(lds_cptr p){ return __builtin_bit_cast(s16x4,__builtin_amdgcn_ds_read_tr16_b64_v4i16((__attribute__((address_space(3))) v4i16_t*)p)); }
__device__ __forceinline__ float rowmax(const f32x16&p0,const f32x16&p1){
  float a=max3f(p0[0],p0[1],p1[0]),b=max3f(p0[2],p0[3],p1[1]);a=max3f(a,p1[2],p1[3]);
  #pragma unroll
  for(int r=4;r<16;r+=4){a=max3f(a,p0[r],p0[r+1]);b=max3f(b,p0[r+2],p0[r+3]);a=max3f(a,p1[r],p1[r+1]);b=max3f(b,p1[r+2],p1[r+3]);}
  const float m=max2f(a,b);
  auto rr=__builtin_amdgcn_permlane32_swap(__float_as_uint(m),__float_as_uint(m),false,false);
  return max2f(__uint_as_float(rr[0]),__uint_as_float(rr[1]));
}
__device__ __forceinline__ void pv(f32x16*o,int vb,bf16x8 pa0,bf16x8 pa1,bf16x8 pa2,bf16x8 pa3){
  #pragma unroll
  for(int d0=0;d0<2;++d0){s16x4 lo[4],hi[4];
    #pragma unroll
    for(int ks=0;ks<4;++ks){
      asm volatile("ds_read_b64_tr_b16 %0,%1 offset:%c2":"=&v"(lo[ks]):"v"(vb),"i"(d0*4096+ks*1024):"memory");
      asm volatile("ds_read_b64_tr_b16 %0,%1 offset:%c2":"=&v"(hi[ks]):"v"(vb),"i"(d0*4096+ks*1024+512):"memory");}
    asm volatile("s_waitcnt lgkmcnt(0)":::"memory");SBAR();
    #define PK(k) (bf16x8){lo[k][0],lo[k][1],lo[k][2],lo[k][3],hi[k][0],hi[k][1],hi[k][2],hi[k][3]}
    o[d0]=__builtin_amdgcn_mfma_f32_32x32x16_bf16(pa0,PK(0),o[d0],0,0,0);
    o[d0]=__builtin_amdgcn_mfma_f32_32x32x16_bf16(pa1,PK(1),o[d0],0,0,0);
    o[d0]=__builtin_amdgcn_mfma_f32_32x32x16_bf16(pa2,PK(2),o[d0],0,0,0);
    o[d0]=__builtin_amdgcn_mfma_f32_32x32x16_bf16(pa3,PK(3),o[d0],0,0,0);
    #undef PK
  }
}

#ifndef ATTN_STORE16
#define ATTN_STORE16(p,v) (*(u32x4*)(p)=(v))
#endif
template<int THRL> __device__ __forceinline__ void attn_unit(int b,int h,int qb,const bf16*Q,const bf16*__restrict__ K,const bf16*__restrict__ V,bf16*O,char*shm){
  const int tid=tidx(),lane=tid&63,r32=lane&31,hi=lane>>5; const int wid=__builtin_amdgcn_readfirstlane(tid>>6);
  const long rowbase=(long)b*RPBA; const int q0=qb*QB;
  const bf16*Qw=Q+(rowbase+q0+wid*QBLK)*PQ+h*D;
  const bf16*Kh=K+rowbase*PQ+(h>>2)*D,*Vh=V+rowbase*PQ+(h>>2)*D;
  const unsigned lds0=(unsigned)(uintptr_t)shm;
  float*wsf=(float*)(shm+LDS_WS)+wid*64;
  const bf16*ksrc=Kh+(long)lane*PQ+wid*8;
  const bf16*vsrc=Vh+(long)(16*(wid&3)+(lane>>2))*PQ+(wid>>2)*32+(lane&3)*8;
  const unsigned kdst=lds0+LDS_K+wid*1024, vdst=lds0+LDS_V+wid*1024;
  #define DMA_K(t,slot) glds16(ksrc+(long)(t)*KVBLK*PQ,(unsigned)__builtin_amdgcn_readfirstlane(kdst+(slot)))
  #define DMA_V(t,slot) glds16(vsrc+(long)(t)*KVBLK*PQ,(unsigned)__builtin_amdgcn_readfirstlane(vdst+(slot)))
  const int vb0=(int)(lds0+LDS_V)+((lane>>4)&1)*32+(lane&3)*8+(4*hi+((lane&15)>>2))*64;
  const char*Kbase=shm+LDS_K; bf16x8 kf[8];
  const lds_cptr shm3=(lds_cptr)shm; const lds_cptr kp0=shm3+LDS_K+hi*1024+r32*16; const lds_cptr vp0=shm3+LDS_V+((lane>>4)&1)*32+(lane&3)*8+(4*hi+((lane&15)>>2))*64;
  const int NT=KROWS/KVBLK;
  DMA_K(0,0);DMA_V(0,0);DMA_K(1,SLOTB);
  bf16x8 qr[4];
  #pragma unroll
  for(int d0=0;d0<4;++d0)qr[d0]=*reinterpret_cast<const bf16x8*>(&Qw[(long)r32*PQ+d0*16+hi*8]);
  float mhat=0.f,l_reg=0.f;f32x16 o[2];o[0]=f32x16{};o[1]=f32x16{};f32x16 negm=f32x16{};asm volatile("":"+v"(negm));
  const int qrel=wid*QBLK+r32;
  #define CMASK(P0,P1,t) do{}while(0)
  bool resc=false;
  #define START(P0,P1) do{ const float rm=rowmax(P0,P1); resc=false; \
    { const float dl=rm; mhat=fadd_s(mhat,dl); \
      _Pragma("unroll") for(int r=0;r<16;++r){P0[r]=fsub_s(P0[r],dl);P1[r]=fsub_s(P1[r],dl);} \
      _Pragma("unroll") for(int r=0;r<16;++r)negm[r]=-mhat; asm volatile("":"+v"(negm)); } \
    _Pragma("unroll") for(int r=0;r<16;++r)P0[r]=__builtin_amdgcn_exp2f(P0[r]); }while(0)
  #define RESC() do{ if(resc){ asm volatile("s_waitcnt lgkmcnt(0)":::"memory"); \
      _Pragma("unroll") for(int d_=0;d_<2;++d_) _Pragma("unroll") for(int r=0;r<16;++r)o[d_][r]*=wsf[crow(r,hi)]; } }while(0)
  f32x16 pA0,pA1,pB0,pB1;
  int sl_prev=0,sl_cur=0,sl_next=SLOTB;
  #define ROT() do{sl_prev=sl_cur;sl_cur=sl_next;sl_next=(sl_next==(NSLOT-1)*SLOTB)?0:sl_next+SLOTB;}while(0)
  DMA_K(2,2*SLOTB);
  WAIT_BAR(3);
  qkt(pA0,pA1,Kbase,qr,negm,r32,hi);asm volatile("s_nop 15\n\ts_nop 7":"+v"(pA0),"+v"(pA1));CMASK(pA0,pA1,0);
  START(pA0,pA1);
  _Pragma("unroll") for(int r=0;r<16;++r)pA1[r]=__builtin_amdgcn_exp2f(pA1[r]);
  WAIT_BAR(0);
  DMA_K(3,0);DMA_V(1,SLOTB);
  ROT();
  kload8(kf,kp0+sl_cur);
  WAIT_BAR(2);
  s16x4 vlo[8],vhi[8]; u32x4 pw0,pw1,pw2,pw3;
  #define PKW(P,B) cvtpk_s(P[B],P[B+1])
  #define PAF(k) __builtin_bit_cast(bf16x8,pw##k)
  #define VFR(i) (bf16x8){vlo[i][0],vlo[i][1],vlo[i][2],vlo[i][3],vhi[i][0],vhi[i][1],vhi[i][2],vhi[i][3]}
  #define PIN(x) asm volatile("":"+v"(x))
  #define MX3(a,b,c) __builtin_fmaxf(__builtin_fmaxf((a),(b)),(c))
  #define GAPA(MF,A0,A1,A2,A3,W0,W1,PW) do{ MF; sacc+=A0; sacc+=A1; sacc+=A2; sacc+=A3; PIN(sacc); W0; W1; PIN(PW); SBAR(); }while(0)
  #define EX(v) __builtin_amdgcn_exp2f(v)
  #define GAPB(MF,X,B) do{ MF; X[B]=EX(X[B]); X[B+1]=EX(X[B+1]); X[B+2]=EX(X[B+2]); X[B+3]=EX(X[B+3]); PIN(X); SBAR(); }while(0)
  #define VRD(i) do{ vlo[i]=vtr(vp_+(((i)>>2)*4096+((i)&3)*1024)); vhi[i]=vtr(vp_+(((i)>>2)*4096+((i)&3)*1024+512)); }while(0)
  #define KRD(G,j) do{ if(G){ kload2(kf,kp0+sl_next,j); SBAR(); } }while(0)
  #define STEP(C0,C1,P0,P1,t,GK,GV,GL) do{ SBAR(); \
    const lds_cptr vp_=vp0+sl_prev; \
    VRD(0); SBAR(); float sacc=(P0[0]+P0[1]); \
    GAPA(C0=__builtin_amdgcn_mfma_f32_32x32x16_bf16(kf[0],qr[0],negm,0,0,0), P0[2],P0[3],P0[4],P0[5],     pw0[0]=PKW(P0,0), pw0[1]=PKW(P0,2), pw0); \
    VRD(4); SBAR(); GAPA(C1=__builtin_amdgcn_mfma_f32_32x32x16_bf16(kf[1],qr[0],negm,0,0,0), P0[6],P0[7],P0[8],P0[9],     pw0[2]=PKW(P0,4), pw0[3]=PKW(P0,6), pw0); \
    VRD(1); SBAR(); GAPA(C0=__builtin_amdgcn_mfma_f32_32x32x16_bf16(kf[2],qr[1],C0,0,0,0),   P0[10],P0[11],P0[12],P0[13], pw1[0]=PKW(P0,8), pw1[1]=PKW(P0,10), pw1); \
    VRD(5); SBAR(); GAPA(C1=__builtin_amdgcn_mfma_f32_32x32x16_bf16(kf[3],qr[1],C1,0,0,0),   P0[14],P0[15],P1[0],P1[1],   pw1[2]=PKW(P0,12),pw1[3]=PKW(P0,14), pw1); \
    VRD(2); SBAR(); GAPA(C0=__builtin_amdgcn_mfma_f32_32x32x16_bf16(kf[4],qr[2],C0,0,0,0),   P1[2],P1[3],P1[4],P1[5],     pw2[0]=PKW(P1,0), pw2[1]=PKW(P1,2), pw2); \
    VRD(6); SBAR(); GAPA(C1=__builtin_amdgcn_mfma_f32_32x32x16_bf16(kf[5],qr[2],C1,0,0,0),   P1[6],P1[7],P1[8],P1[9],     pw2[2]=PKW(P1,4), pw2[3]=PKW(P1,6), pw2); \
    VRD(3); SBAR(); GAPA(C0=__builtin_amdgcn_mfma_f32_32x32x16_bf16(kf[6],qr[3],C0,0,0,0),   P1[10],P1[11],P1[12],P1[13], pw3[0]=PKW(P1,8), pw3[1]=PKW(P1,10), pw3); \
    VRD(7); SBAR(); GAPA(C1=__builtin_amdgcn_mfma_f32_32x32x16_bf16(kf[7],qr[3],C1,0,0,0),   P1[14],P1[15],0.f,0.f,       pw3[2]=PKW(P1,12),pw3[3]=PKW(P1,14), pw3); \
    l_reg+=sacc; \
    if(GK){DMA_K((t)+3,sl_cur);} if(GV){DMA_V((t)+1,sl_next);} \
    CMASK(C0,C1,t); \
    { float a=MX3(C0[0],C0[1],C1[0]),b=MX3(C0[2],C0[3],C1[1]); a=MX3(a,C1[2],C1[3]); \
      _Pragma("unroll") for(int r=4;r<16;r+=4){a=MX3(a,C0[r],C0[r+1]);b=MX3(b,C0[r+2],C0[r+3]);a=MX3(a,C1[r],C1[r+1]);b=MX3(b,C1[r+2],C1[r+3]);} \
      float rm=__builtin_fmaxf(a,b); { auto rr=__builtin_amdgcn_permlane32_swap(__float_as_uint(rm),__float_as_uint(rm),false,false); rm=__builtin_fmaxf(__uint_as_float(rr[0]),__uint_as_float(rr[1])); } \
      resc=false; \
      if(__builtin_expect(__any(rm>(float)THRL),0)){ const float dl=__builtin_fmaxf(rm,0.f); mhat+=dl; \
        _Pragma("unroll") for(int r=0;r<16;++r){C0[r]-=dl;C1[r]-=dl;} \
        _Pragma("unroll") for(int r=0;r<16;++r)negm[r]=-mhat; asm volatile("":"+v"(negm)); \
        const float f=__builtin_amdgcn_exp2f(-dl); l_reg*=f; if(hi==0)wsf[r32]=f; resc=true; } } \
    SBAR(); \
    GAPB(o[0]=__builtin_amdgcn_mfma_f32_32x32x16_bf16(PAF(0),VFR(0),o[0],0,0,0), C0,0); \
    GAPB(o[1]=__builtin_amdgcn_mfma_f32_32x32x16_bf16(PAF(0),VFR(4),o[1],0,0,0), C0,4); \
    KRD(GL,0); GAPB(o[0]=__builtin_amdgcn_mfma_f32_32x32x16_bf16(PAF(1),VFR(1),o[0],0,0,0), C0,8); \
    KRD(GL,1); GAPB(o[1]=__builtin_amdgcn_mfma_f32_32x32x16_bf16(PAF(1),VFR(5),o[1],0,0,0), C0,12); \
    KRD(GL,2); GAPB(o[0]=__builtin_amdgcn_mfma_f32_32x32x16_bf16(PAF(2),VFR(2),o[0],0,0,0), C1,0); \
    KRD(GL,3); GAPB(o[1]=__builtin_amdgcn_mfma_f32_32x32x16_bf16(PAF(2),VFR(6),o[1],0,0,0), C1,4); \
    GAPB(o[0]=__builtin_amdgcn_mfma_f32_32x32x16_bf16(PAF(3),VFR(3),o[0],0,0,0), C1,8); \
    GAPB(o[1]=__builtin_amdgcn_mfma_f32_32x32x16_bf16(PAF(3),VFR(7),o[1],0,0,0), C1,12); \
    }while(0)
  int t=1;
  #undef CMASK
  #define CMASK(P0,P1,t) do{}while(0)
  for(;t+5<NT;t+=2){
    STEP(pB0,pB1,pA0,pA1,t,true,true,true);     WAIT_BAR(2); RESC(); ROT();
    STEP(pA0,pA1,pB0,pB1,t+1,true,true,true);   WAIT_BAR(2); RESC(); ROT();
  }
  #undef CMASK
  #define CMASK(P0,P1,t) do{}while(0)
  #define ENDW(tt) do{ if((tt)+3<NT){WAIT_BAR(2);} else if((tt)+2<NT){WAIT_BAR(1);} else {WAIT_BAR(0);} }while(0)
  for(;t+1<NT;t+=2){
    STEP(pB0,pB1,pA0,pA1,t,(t+3<NT),(t+1<NT),(t+1<NT));       ENDW(t);   RESC(); ROT();
    STEP(pA0,pA1,pB0,pB1,t+1,(t+4<NT),(t+2<NT),(t+2<NT));     ENDW(t+1); RESC(); ROT();
  }
  STEP(pB0,pB1,pA0,pA1,NT-1,false,false,false); RESC();
  { float sacc=pB0[0]+pB0[1]; _Pragma("unroll") for(int r=2;r<16;++r)sacc+=pB0[r]; _Pragma("unroll") for(int r=0;r<16;++r)sacc+=pB1[r]; l_reg+=sacc;
    pw0=(u32x4){PKW(pB0,0),PKW(pB0,2),PKW(pB0,4),PKW(pB0,6)};pw1=(u32x4){PKW(pB0,8),PKW(pB0,10),PKW(pB0,12),PKW(pB0,14)};pw2=(u32x4){PKW(pB1,0),PKW(pB1,2),PKW(pB1,4),PKW(pB1,6)};pw3=(u32x4){PKW(pB1,8),PKW(pB1,10),PKW(pB1,12),PKW(pB1,14)};
    SBAR(); pv(o,vb0+sl_cur,PAF(0),PAF(1),PAF(2),PAF(3)); }
  #undef PKW
  #undef PAF
  #undef VFR
  #undef PIN
  #undef MX3
  #undef GAPA
  #undef GAPB
  #undef EX
  #undef VRD
  #undef KRD
  #undef STEP
  #undef ENDW
  {auto rr=__builtin_amdgcn_permlane32_swap(__float_as_uint(l_reg),__float_as_uint(l_reg),false,false);l_reg=__uint_as_float(rr[0])+__uint_as_float(rr[1]);}
  if(hi==0)wsf[32+r32]=l_reg;asm volatile("s_waitcnt lgkmcnt(0)":::"memory");
  float rli[16];
  #pragma unroll
  for(int r=0;r<16;++r)rli[r]=__builtin_amdgcn_rcpf(wsf[32+crow(r,hi)]);
  bf16*Ow=O+(rowbase+q0+wid*QBLK)*PO+h*D;
  { bf16*stg=(bf16*)(shm+LDS_OST)+wid*2048;
    #pragma unroll
    for(int r=0;r<16;++r){const int orow=crow(r,hi);
      #pragma unroll
      for(int d0=0;d0<2;++d0)stg[orow*64+d0*32+r32]=__float2bfloat16(o[d0][r]*rli[r]);}
    asm volatile("s_waitcnt lgkmcnt(0)":::"memory");
    #pragma unroll
    for(int i=0;i<4;++i){const int row=i*8+(lane>>3),ch=lane&7; const u32x4 v=*(const u32x4*)(stg+row*64+ch*8); ATTN_STORE16(Ow+(long)row*PO+ch*8,v);} }
  asm volatile("s_waitcnt lgkmcnt(0)\n\ts_barrier":::"memory");
  #undef DMA_K
  #undef DMA_V
  #undef CMASK
  #undef START
  #undef RESC
  #undef ROT
}
constexpr int ATTN_LDS_BYTES=LDS_BYTES;
#undef SBAR
#undef WAIT_BAR
}

DEV void phase_even_post(PPtr p, int li) {
    const int tid = tidx(), lane = tid & 63, gw = blockIdx.x * NWAVE + (tid >> 6), ngw = gridDim.x * NWAVE;
    u16* RAW = (u16*)(p->ws + OFF_RAW);
    const float* qg = p->in[10] + li * 64; const float* kg = p->in[11] + li * 64;
    const float* T = (const float*)(p->ws + OFF_ROPE);
    const int w8 = (lane & 7) * 8, i0 = w8 & 31; const bool second = (lane & 4) != 0;
    for (int item = gw; item < MROWS * 3; item += ngw) {
        const int m = item / 3, pass = item - 3 * m;
        if (pass == 2 && lane >= 32) continue;
        const int b = m / RPB, q = m - b * RPB;
        const int sl = pass * 8 + (lane >> 3);
        const int c0 = sl < 8 ? sl * 64 : sl < 10 ? 512 + (sl - 8) * 64 : sl < 18 ? 768 + (sl - 10) * 64 : 1280 + (sl - 18) * 64;
        u16* ptr = RAW + (size_t)m * 1536 + c0 + w8;
        float x[8]; unpack8(*(const uint4*)ptr, x);
        if (sl < 10) {
            const float* gn = (sl < 8 ? qg : kg) + w8;
            float ss = 0.f;
#pragma unroll
            for (int e = 0; e < 8; ++e) ss += x[e] * x[e];
            ss += __shfl_xor(ss, 1); ss += __shfl_xor(ss, 2); ss += __shfl_xor(ss, 4);
            const float rs = rsqrtf(ss * (1.f / 64.f) + 1e-6f);
            const float4 g0 = *(const float4*)gn, g1 = *(const float4*)(gn + 4);
            x[0] *= rs * g0.x; x[1] *= rs * g0.y; x[2] *= rs * g0.z; x[3] *= rs * g0.w; x[4] *= rs * g1.x; x[5] *= rs * g1.y; x[6] *= rs * g1.z; x[7] *= rs * g1.w;
        }
        if (q < SEQ) {
            const float* ct = (i0 < 16) ? T + (q >> 6) * 16 + i0 : T + 8192 + (q & 63) * 16 + (i0 - 16);
            const float* st = ct + ((i0 < 16) ? 4096 : 1024);
            const float4 c0v = *(const float4*)ct, c1v = *(const float4*)(ct + 4), s0v = *(const float4*)st, s1v = *(const float4*)(st + 4);
            const float cs[8] = {c0v.x, c0v.y, c0v.z, c0v.w, c1v.x, c1v.y, c1v.z, c1v.w}, sn[8] = {s0v.x, s0v.y, s0v.z, s0v.w, s1v.x, s1v.y, s1v.z, s1v.w};
            const float sc = (sl < 8) ? attn_body::C2 : 1.f;
#pragma unroll
            for (int e = 0; e < 8; ++e) {
                const float other = __shfl_xor(x[e], 4);
                const float o = second ? (other * sn[e] + x[e] * cs[e]) : (x[e] * cs[e] - other * sn[e]);
                x[e] = o * sc;
            }
        }
        *(uint4*)ptr = pack8(x);
    }
}

template <int mode, bool qctx>
DEV void attn_wave(const u16* QB, int pitch, int qcol, int kcol, int vcol, u16* AO, int ocol,
                   int b, int hk, int blk, const float* sinkp, const float* rpb, u16* sV) {
    const int lane = tidx() & 63, qi = lane & 15, quad = lane >> 4;
    const bool gqa = mode < 2;
    const size_t rowb = (size_t)b * RPB;
    const float SCL = 0.125f * LOG2E;
    int qtok[4], qhead[4]; bf16x8 qf[4][2];
#pragma unroll
    for (int i = 0; i < 4; ++i) {
        qtok[i] = gqa ? blk * 16 + qi : blk * 64 + i * 16 + qi; qhead[i] = gqa ? hk * 4 + i : hk;
        const size_t m = rowb + (qctx ? SEQ : 0) + qtok[i];
        const u16* qp = QB + m * pitch + qcol + qhead[i] * 64 + quad * 8;
        qf[i][0] = *(const bf16x8*)qp; qf[i][1] = *(const bf16x8*)(qp + 32);
    }
    f32x4 o[4][4]; float mrun[4], lrun[4];
#pragma unroll
    for (int i = 0; i < 4; ++i) {
#pragma unroll
        for (int d = 0; d < 4; ++d) o[i][d] = (f32x4){0.f, 0.f, 0.f, 0.f};
        if (mode == 1) { mrun[i] = sinkp[qhead[i]] * LOG2E; lrun[i] = (quad == 0) ? 1.f : 0.f; } else { mrun[i] = -1e30f; lrun[i] = 0.f; }
    }
    const u16* Kb = QB + kcol + hk * 64; const u16* Vb = QB + vcol + hk * 64;
    int n_local, ustart, rs = 0;
    if (qctx) { n_local = 0; ustart = 0; }
    else if (mode == 0) { n_local = RPB / 32; ustart = 0; }
    else if (mode == 1) { n_local = 9; ustart = blk * 16 - 128; }
    else { rs = min(max(blk - 4, 0), 248); n_local = 16; ustart = rs * 64; }
    const int n_ctx = (mode == 0 && !qctx) ? 0 : 8;
    for (int tt = 0; tt < n_local + n_ctx; ++tt) {
        const bool loc = tt < n_local;
        const int u0 = loc ? ustart + 32 * tt : SEQ + 32 * (tt - n_local);
        const bool masked = loc && mode != 0;
        bf16x8 kf[2][2];
#pragma unroll
        for (int kt = 0; kt < 2; ++kt) {
            const int u = min(max(u0 + kt * 16 + qi, 0), RPB - 1);
            const u16* kp = Kb + (rowb + u) * pitch + quad * 8;
            kf[kt][0] = *(const bf16x8*)kp; kf[kt][1] = *(const bf16x8*)(kp + 32);
        }
#pragma unroll
        for (int c = 0; c < 4; ++c) {
            const int idx = c * 64 + lane, key = idx >> 3, dc = idx & 7;
            const int u = min(max(u0 + key, 0), RPB - 1);
            const uint4 v = *(const uint4*)(Vb + (rowb + u) * pitch + dc * 8);
            *(uint4*)(sV + key * 72 + dc * 8) = v;
        }
        bf16x8 vf[4];
#pragma unroll
        for (int dt = 0; dt < 4; ++dt)
#pragma unroll
            for (int jj = 0; jj < 8; ++jj) {
                const int key = (jj < 4) ? quad * 4 + jj : 16 + quad * 4 + (jj - 4);
                vf[dt][jj] = (short)sV[key * 72 + dt * 16 + qi];
            }
#pragma unroll
        for (int i = 0; i < 4; ++i) {
            f32x4 s0 = (f32x4){0.f, 0.f, 0.f, 0.f}, s1 = (f32x4){0.f, 0.f, 0.f, 0.f};
            s0 = __builtin_amdgcn_mfma_f32_16x16x32_bf16(kf[0][0], qf[i][0], s0, 0, 0, 0);
            s0 = __builtin_amdgcn_mfma_f32_16x16x32_bf16(kf[0][1], qf[i][1], s0, 0, 0, 0);
            s1 = __builtin_amdgcn_mfma_f32_16x16x32_bf16(kf[1][0], qf[i][0], s1, 0, 0, 0);
            s1 = __builtin_amdgcn_mfma_f32_16x16x32_bf16(kf[1][1], qf[i][1], s1, 0, 0, 0);
            float sc[8];
#pragma unroll
            for (int j = 0; j < 4; ++j) { sc[j] = s0[j] * SCL; sc[4 + j] = s1[j] * SCL; }
            if (masked) {
                const int t = qtok[i];
#pragma unroll
                for (int e = 0; e < 8; ++e) {
                    const int u = u0 + (e >> 2) * 16 + quad * 4 + (e & 3);
                    if (mode == 1) {
                        const int dd = t - u;
                        const bool ok = (u >= 0) && (u < SEQ) && (dd <= 128) && (dd >= -128);
                        if (!ok) sc[e] = -INFINITY;
                    } else {
                        const int c = t & 63, r = t >> 6, ur = u >> 6, uc = u & 63;
                        const int cst = min(max(c - 8, 0), 48);
                        const bool ok = (uc >= cst) && (uc < cst + 16);
                        const int dr = min(max(ur - r + 7, 0), 14), dcx = min(max(uc - c + 15, 0), 30);
                        const float bias = rpb[(qhead[i] * 15 + dr) * 31 + dcx];
                        sc[e] = ok ? sc[e] + bias * LOG2E : -INFINITY;
                    }
                }
            }
            float mx = fmaxf(fmaxf(fmaxf(sc[0], sc[1]), fmaxf(sc[2], sc[3])), fmaxf(fmaxf(sc[4], sc[5]), fmaxf(sc[6], sc[7])));
            mx = fmaxf(mx, __shfl_xor(mx, 16)); mx = fmaxf(mx, __shfl_xor(mx, 32));
            const float mn = fmaxf(mrun[i], mx);
            const float al = __builtin_amdgcn_exp2f(mrun[i] - mn);
            mrun[i] = mn;
            float pe[8], ps = 0.f;
#pragma unroll
            for (int e = 0; e < 8; ++e) { pe[e] = __builtin_amdgcn_exp2f(sc[e] - mn); ps += pe[e]; }
            lrun[i] = lrun[i] * al + ps;
            union { unsigned u[4]; bf16x8 v; } pf;
            pf.u[0] = pk2(pe[0], pe[1]); pf.u[1] = pk2(pe[2], pe[3]); pf.u[2] = pk2(pe[4], pe[5]); pf.u[3] = pk2(pe[6], pe[7]);
#pragma unroll
            for (int dt = 0; dt < 4; ++dt) {
                o[i][dt] = o[i][dt] * al;
                o[i][dt] = __builtin_amdgcn_mfma_f32_16x16x32_bf16(vf[dt], pf.v, o[i][dt], 0, 0, 0);
            }
        }
    }
#pragma unroll
    for (int i = 0; i < 4; ++i) {
        float l = lrun[i]; l += __shfl_xor(l, 16); l += __shfl_xor(l, 32);
        const float inv = 1.f / l;
        const size_t m = rowb + (qctx ? SEQ : 0) + qtok[i];
        u16* op = AO + m * DM + ocol + qhead[i] * 64 + quad * 4;
#pragma unroll
        for (int dt = 0; dt < 4; ++dt) {
            uint2 w; w.x = pk2(o[i][dt][0] * inv, o[i][dt][1] * inv); w.y = pk2(o[i][dt][2] * inv, o[i][dt][3] * inv);
            *(uint2*)(op + dt * 16) = w;
        }
    }
}

DEV void phase_attn_even(PPtr p, int li, char* lds) {
    {
        const attn_body::bf16* RAWb = (const attn_body::bf16*)(p->ws + OFF_RAW); attn_body::bf16* AOb = (attn_body::bf16*)(p->ws + OFF_AO);
        const int G = gridDim.x, bx = blockIdx.x;
        if (G == 256) {
            const int vcu = (bx & 7) * 32 + (bx >> 3); const int x = vcu >> 5, combo = x >> 1, sub = (x & 1) * 32 + (vcu & 31);
            for (int i = 0; i < 4; ++i) attn_body::attn_unit<8>(combo >> 1, (combo & 1) * 4 + i, sub, RAWb, RAWb + 512, RAWb + 640, AOb, lds);
        } else {
            for (int u = bx; u < 1024; u += G) attn_body::attn_unit<8>(u >> 9, (u >> 6) & 7, u & 63, RAWb, RAWb + 512, RAWb + 640, AOb, lds);
        }
    }
    const int wave = tidx() >> 6, gw = blockIdx.x * NWAVE + wave, ngw = gridDim.x * NWAVE;
    u16* sV = (u16*)lds + wave * (32 * 72);
    const u16* RAW = (const u16*)(p->ws + OFF_RAW); u16* AO = (u16*)(p->ws + OFF_AO);
    const float* sink = p->in[12] + li * 8;
    for (int t = gw; t < 4224; t += ngw) {
        if (t < 4096) attn_wave<1, false>(RAW, 1536, 768, 1280, 1408, AO, 512, t >> 11, (t >> 10) & 1, t & 1023, sink, nullptr, sV);
        else if (t < 4160) { const int u = t - 4096; attn_wave<0, true>(RAW, 1536, 0, 512, 640, AO, 0, u >> 5, (u >> 4) & 1, u & 15, nullptr, nullptr, sV); }
        else { const int u = t - 4160; attn_wave<1, true>(RAW, 1536, 768, 1280, 1408, AO, 512, u >> 5, (u >> 4) & 1, u & 15, sink, nullptr, sV); }
    }
}
DEV void phase_attn_odd(PPtr p, int li, char* lds) {
    const int wave = tidx() >> 6, gw = blockIdx.x * NWAVE + wave, ngw = gridDim.x * NWAVE;
    u16* sV = (u16*)lds + wave * (32 * 72);
    const u16* QKV = (const u16*)(p->ws + OFF_RAW); u16* AO = (u16*)(p->ws + OFF_AO);
    const float* rpb = p->in[15] + li * 8 * 15 * 31;
    for (int t = gw; t < 4160; t += ngw) {
        if (t < 4096) attn_wave<2, false>(QKV, 1536, 0, 512, 1024, AO, 0, t >> 11, (t >> 8) & 7, t & 255, nullptr, rpb, sV);
        else { const int u = t - 4096; attn_wave<2, true>(QKV, 1536, 0, 512, 1024, AO, 0, u >> 5, (u >> 2) & 7, u & 3, nullptr, rpb, sV); }
    }
}

DEV float shiftmix_at(const u16* ZDb, int pp, int ch, float mu) {
    const bool lat = pp < SEQ; const int lo = lat ? 0 : SEQ, hi = lat ? SEQ : RPB;
    const u16* zc = ZDb + (size_t)pp * ZDW + ch;
    const float z = bf2f(zc[0]);
    const float a = (pp - 1 >= lo) ? bf2f(zc[-ZDW]) : 0.f, c = (pp + 1 < hi) ? bf2f(zc[ZDW]) : 0.f;
    return z + (0.5f * (a + c) - z) * mu;
}
DEV void phase_rwkv_prep(PPtr p, int li, int bb) {
    const int tid = tidx(), lane = tid & 63, gw = blockIdx.x * NWAVE + (tid >> 6), ngw = gridDim.x * NWAVE;
    const u16* ZDb = (const u16*)(p->ws + OFF_ZD) + (size_t)bb * RPB * ZDW;
    const float* mu = p->in[16] + li * ZDW; const float* kkw = p->in[22] + li * 512;
    u16* R = (u16*)(p->ws + OFF_R); u16* KK = (u16*)(p->ws + OFF_KK); u16* V = (u16*)(p->ws + OFF_V); u16* LA = (u16*)(p->ws + OFF_LA);
    {
        u16* LB = (u16*)(p->ws + OFF_PU);
        const float* w2 = p->in[18] + (size_t)li * 2 * 64 * 512; const float* a2 = p->in[20] + (size_t)li * 2 * 64 * 512; const float* g2 = p->in[21] + (size_t)li * 128 * 512;
        for (int idx = gw * 64 + lane; idx < 2560 * 32; idx += ngw * 64) {
            const int n = idx >> 5, kc = (idx & 31) * 8, type = n >> 9, nn = n & 511;
            float f[8];
#pragma unroll
            for (int e = 0; e < 8; ++e) {
                const int k = kc + e; float x = 0.f;
                if (type < 2) { if (k < 64) x = w2[((size_t)type * 64 + k) * 512 + nn]; }
                else if (type < 4) { if (k >= 64 && k < 128) x = a2[((size_t)(type - 2) * 64 + (k - 64)) * 512 + nn]; }
                else { if (k >= 128) x = g2[(size_t)(k - 128) * 512 + nn]; }
                f[e] = x;
            }
            *(uint4*)(LB + (size_t)n * 256 + kc) = pack8(f);
        }
    }
    {
        float4* Yz = (float4*)(p->ws + OFF_Y0); const float4 z = {0.f, 0.f, 0.f, 0.f};
        for (size_t i = (size_t)gw * 64 + lane; i < (size_t)RPB * 512 / 4; i += (size_t)ngw * 64) Yz[i] = z;
    }
    for (int pp = gw; pp < RPB; pp += ngw) {
        const bool lat = pp < SEQ; const int lo = lat ? 0 : SEQ, hi = lat ? SEQ : RPB;
        const bool hp = pp - 1 >= lo, hn = pp + 1 < hi;
        const u16* zc = ZDb + (size_t)pp * ZDW;
#pragma unroll
        for (int j = 0; j < 4; ++j) {
            const int c8 = lane + 64 * j;
            if (j == 3 && lane >= 32) break;
            const int ch = 8 * c8;
            float z[8], a[8], c[8], zs[8];
            unpack8(*(const uint4*)(zc + ch), z);
            if (hp) unpack8(*(const uint4*)(zc - ZDW + ch), a); else { for (int e = 0; e < 8; ++e) a[e] = 0.f; }
            if (hn) unpack8(*(const uint4*)(zc + ZDW + ch), c); else { for (int e = 0; e < 8; ++e) c[e] = 0.f; }
            const float4 m0 = *(const float4*)(mu + ch), m1 = *(const float4*)(mu + ch + 4);
            const float mm[8] = {m0.x, m0.y, m0.z, m0.w, m1.x, m1.y, m1.z, m1.w};
#pragma unroll
            for (int e = 0; e < 8; ++e) zs[e] = z[e] + (0.5f * (a[e] + c[e]) - z[e]) * mm[e];
            if (j == 0) *(uint4*)(R + (size_t)pp * 512 + ch) = pack8(zs);
            else if (j == 1) {
                const float4 k0 = *(const float4*)(kkw + ch - 512), k1 = *(const float4*)(kkw + ch - 512 + 4);
                const float kw[8] = {k0.x, k0.y, k0.z, k0.w, k1.x, k1.y, k1.z, k1.w};
                float t[8], ss = 0.f;
#pragma unroll
                for (int e = 0; e < 8; ++e) { t[e] = zs[e] * kw[e]; ss += t[e] * t[e]; }
                ss += __shfl_xor(ss, 1); ss += __shfl_xor(ss, 2); ss += __shfl_xor(ss, 4);
                const float inv = 1.f / fmaxf(sqrtf(ss), 1e-12f);
#pragma unroll
                for (int e = 0; e < 8; ++e) t[e] *= inv;
                *(uint4*)(KK + (size_t)pp * 512 + ch - 512) = pack8(t);
            } else if (j == 2) *(uint4*)(V + (size_t)pp * 512 + ch - 1024) = pack8(zs);
            else {
                float o[8];
#pragma unroll
                for (int e = 0; e < 8; ++e) o[e] = (lane < 8) ? tanhf(zs[e]) : (lane < 16) ? zs[e] : sigmoidf_(zs[e]);
                *(uint4*)(LA + (size_t)pp * 256 + ch - 1536) = pack8(o);
            }
        }
    }
}
struct EpiDecay { float* DEC; const float* w0; int d;
    DEV void operator()(int r, int c, float v, float) const {
        const float x = -(w0[c] + v); const float sp = x > 20.f ? x : log1pf(expf(x)); const float w = -sp - 0.5f;
        DEC[((size_t)r * 2 + d) * 512 + c] = expf(-expf(w)); } };
struct EpiIclr { u16* KD; u16* BQ; const u16* KK; const u16* ZDb; const float* a0; const float* ka; const float* muk; int d;
    DEV void operator()(int r, int c, float v, float) const {
        const float a = sigmoidf_(a0[c] + v);
        const float k = shiftmix_at(ZDb, r, 512 + c, muk[c]);
        KD[((size_t)r * 2 + d) * 512 + c] = (u16)f2bf(k * (1.f + (a - 1.f) * ka[c]));
        BQ[((size_t)r * 2 + d) * 512 + c] = (u16)f2bf(bf2f(KK[(size_t)r * 512 + c]) * a); } };
struct EpiGate { u16* G; DEV void operator()(int r, int c, float v, float) const { G[(size_t)r * 512 + c] = (u16)f2bf(v); } };

DEV int pos_to_pp(int s, int d) { return (s < NCTX) ? (d ? SEQ + NCTX - 1 - s : SEQ + s) : (d ? SEQ - 1 - (s - NCTX) : s - NCTX); }
struct StepV { float d; unsigned a; unsigned b; float v; };
DEV StepV load_step(const float* DEC, const u16* KD, const u16* BQ, const u16* KK, const u16* R, const u16* V, int pp, int h, int d, int lane) {
    const size_t e1 = (size_t)pp * 512 + h * 64, e2 = ((size_t)pp * 2 + d) * 512 + h * 64;
    StepV s;
    s.d = DEC[e2 + lane];
    s.a = (lane < 32) ? ((const unsigned*)(KD + e2))[lane] : ((const unsigned*)(BQ + e2))[lane - 32];
    s.b = (lane < 32) ? ((const unsigned*)(KK + e1))[lane] : ((const unsigned*)(R + e1))[lane - 32];
    s.v = bf2f(V[e1 + lane]);
    return s;
}
typedef float f32x2 __attribute__((ext_vector_type(2)));
constexpr int SSLOT = 320;
typedef __attribute__((address_space(3))) float* ldsf;
typedef const __attribute__((address_space(3))) f32x4* lds4;
DEV void stage_step(ldsf slot, const StepV& s, int lane) {
    slot[lane] = s.d;
    *(__attribute__((address_space(3))) f32x2*)(slot + 64 + 2 * lane) = (f32x2){bflo(s.a), bfhi(s.a)};
    *(__attribute__((address_space(3))) f32x2*)(slot + 192 + 2 * lane) = (f32x2){bflo(s.b), bfhi(s.b)};
}
#define LO2(v) ((f32x2){(v)[0], (v)[1]})
#define HI2(v) ((f32x2){(v)[2], (v)[3]})
template <int MODE>
DEV float scan_step(f32x2 (&S)[32], ldsf sl, float vv) {
    lds4 D = (lds4)sl;
    f32x2 sa = {0.f, 0.f}, sb = {0.f, 0.f};
#pragma unroll
    for (int q = 0; q < 16; ++q) { const f32x4 k4 = D[48 + q]; sa += S[2 * q] * LO2(k4); sb += S[2 * q + 1] * HI2(k4);
        if ((q & 3) == 3) asm volatile("" : "+v"(D), "+v"(sa), "+v"(sb)); }
    const float nsa = -((sa[0] + sa[1]) + (sb[0] + sb[1]));
    const f32x2 nsa2 = {nsa, nsa}, vv2 = {vv, vv};
    f32x2 y = {0.f, 0.f}, z = {0.f, 0.f};
#pragma unroll
    for (int q = 0; q < 16; ++q) {
        const f32x4 d4 = D[q], b4 = D[32 + q];
        f32x2 t0 = nsa2 * LO2(b4), t1 = nsa2 * HI2(b4);
        if (MODE >= 1) { const f32x4 kd4 = D[16 + q]; t0 += vv2 * LO2(kd4); t1 += vv2 * HI2(kd4); }
        S[2 * q] = S[2 * q] * LO2(d4) + t0; S[2 * q + 1] = S[2 * q + 1] * HI2(d4) + t1;
        if (MODE == 2) { const f32x4 r4 = D[64 + q]; y += S[2 * q] * LO2(r4); z += S[2 * q + 1] * HI2(r4); }
        else y += S[2 * q + 1];
        if ((q & 1) == 1) asm volatile("" : "+v"(D), "+v"(y), "+v"(z), "+v"(S[2 * q + 1]));
    }
    return (y[0] + y[1]) + (z[0] + z[1]);
}
template <int WHICH>
DEV void scan1_pass(PPtr p, char* lds) {
    const int tid = tidx(), lane = tid & 63, wv = __builtin_amdgcn_readfirstlane(tid >> 6), gw = blockIdx.x * NWAVE + wv, ngw = gridDim.x * NWAVE;
    const float* DEC = (const float*)(p->ws + OFF_DEC); const u16* KD = (const u16*)(p->ws + OFF_KD); const u16* BQ = (const u16*)(p->ws + OFF_BQ);
    const u16* KK = (const u16*)(p->ws + OFF_KK); const u16* R = (const u16*)(p->ws + OFF_R); const u16* V = (const u16*)(p->ws + OFF_V);
    float* PU = (float*)(p->ws + OFF_PU);
    ldsf ring = (ldsf)lds + wv * (3 * SSLOT);
    for (int task = gw; task < 16 * NCH; task += ngw) {
        const int seq = task >> 7, c = task & 127, h = seq >> 1, d = seq & 1;
#define LD(st) load_step(DEC, KD, BQ, KK, R, V, pos_to_pp(c * CLEN + min((st), CLEN - 1), d), h, d, lane)
        f32x2 X[32];
        int ln = lane; asm volatile("" : "+v"(ln));
#pragma unroll
        for (int j = 0; j < 32; ++j) X[j] = (f32x2){(WHICH == 0 && 2 * j == ln) ? 1.f : 0.f, (WHICH == 0 && 2 * j + 1 == ln) ? 1.f : 0.f};
        float vvA, vvB;
        { const StepV s0 = LD(0), s1 = LD(1); stage_step(ring, s0, lane); stage_step(ring + SSLOT, s1, lane); vvA = s0.v; vvB = s1.v; }
        StepV g0 = LD(2), g1 = LD(3), g2 = LD(4), g3 = LD(5);
        int cs = 0, ns = 2;
        float chain = 0.f;
#pragma unroll 1
        for (int st = 0; st < CLEN; ++st) {
            chain += scan_step<2>(X, ring + cs * SSLOT, WHICH ? vvA : 0.f);
            stage_step(ring + ns * SSLOT, g0, lane);
            vvA = vvB; vvB = g0.v; g0 = g1; g1 = g2; g2 = g3; g3 = LD(st + 6);
            cs = (cs == 2) ? 0 : cs + 1; ns = (ns == 2) ? 0 : ns + 1;
        }
#undef LD
        float4* o = (float4*)(PU + ((size_t)task * 2 + WHICH) * 4096 + lane * 64);
#pragma unroll
        for (int j = 0; j < 16; ++j) o[j] = (float4){X[2 * j][0], X[2 * j][1], X[2 * j + 1][0], X[2 * j + 1][1]};
        if (chain == 1.2345e38f) o[0] = (float4){chain, chain, chain, chain};
    }
}
DEV void phase_scan1(PPtr p, char* lds) { scan1_pass<0>(p, lds); scan1_pass<1>(p, lds); }
#define S2_PLOAD(ent_, lo, hi) do { const float4* s_ = (const float4*)((ent_) + prow * 64 + pcol); lo = s_[0]; hi = s_[1]; } while (0)
#define S2_ULOAD(ent_, u_) do { const float* s_ = (ent_) + 4096; _Pragma("unroll") for (int t_ = 0; t_ < 2; ++t_) _Pragma("unroll") for (int j_ = 0; j_ < 4; ++j_) u_[t_][j_] = s_[(16 * rt + 4 * q + j_) * 64 + 16 * (ct0 + t_) + r]; } while (0)
#define S2_CSTORE(dst_, a0_, a1_) do { float* d_ = (dst_); _Pragma("unroll") for (int j_ = 0; j_ < 4; ++j_) { d_[(16 * rt + 4 * q + j_) * 64 + 16 * ct0 + r] = a0_[j_]; d_[(16 * rt + 4 * q + j_) * 64 + 16 * ct0 + 16 + r] = a1_[j_]; } } while (0)
#define S2_LSTORE(dst_, a0_, a1_) do { float* d_ = (dst_); _Pragma("unroll") for (int j_ = 0; j_ < 4; ++j_) { d_[(16 * rt + 4 * q + j_) * 68 + 16 * ct0 + r] = a0_[j_]; d_[(16 * rt + 4 * q + j_) * 68 + 16 * ct0 + 16 + r] = a1_[j_]; } } while (0)
DEV void phase_scan2a(PPtr p, char* lds) {
    if (blockIdx.x >= 128) return;
    const int tid = tidx(), lane = tid & 63, w = __builtin_amdgcn_readfirstlane(tid >> 6), seq = blockIdx.x >> 3, g = blockIdx.x & 7;
    float* sX = (float*)lds; float* sZ = sX + 2 * 64 * 68; float* sP = sZ + 2 * 64 * 68;
    float* PUg = (float*)(p->ws + OFF_PU) + (size_t)(seq * NCH + 16 * g) * 8192;
    float* TOT = (float*)(p->ws + OFF_LA) + (size_t)(seq * 8 + g) * 8192;
    const int rt = w >> 1, ct0 = (w & 1) * 2, r = lane & 15, q = lane >> 4;
    const int prow = tid >> 3, pcol = (tid & 7) * 8;
    for (int i = tid; i < 64 * 68; i += NTHR) { const int row = i / 68, col = i - row * 68; sX[i] = (row == col) ? 1.f : 0.f; sZ[i] = 0.f; }
    float4 pa0, pa1, pb0, pb1;
    { float4 t0, t1; S2_PLOAD(PUg, t0, t1); *(float4*)(sP + prow * 68 + pcol) = t0; *(float4*)(sP + prow * 68 + pcol + 4) = t1; }
    S2_PLOAD(PUg + 8192, pa0, pa1); S2_PLOAD(PUg + 2 * 8192, pb0, pb1);
    float ua[2][4], ub[2][4];
    S2_ULOAD(PUg, ua); S2_ULOAD(PUg + 8192, ub);
    __syncthreads();
    for (int jj = 0; jj < 16; ++jj) {
        const int cur = jj & 1;
        f32x4 x0 = {0.f, 0.f, 0.f, 0.f}, x1 = {0.f, 0.f, 0.f, 0.f};
        f32x4 z0 = {ua[0][0], ua[0][1], ua[0][2], ua[0][3]}, z1 = {ua[1][0], ua[1][1], ua[1][2], ua[1][3]};
        const float* Xc = sX + cur * (64 * 68); const float* Zc = sZ + cur * (64 * 68); const float* Pc = sP + cur * (64 * 68);
#pragma unroll
        for (int ks = 0; ks < 16; ++ks) {
            const float ax = Xc[(16 * rt + r) * 68 + 4 * ks + q], az = Zc[(16 * rt + r) * 68 + 4 * ks + q];
            const float b0 = Pc[(4 * ks + q) * 68 + 16 * ct0 + r], b1 = Pc[(4 * ks + q) * 68 + 16 * ct0 + 16 + r];
            x0 = __builtin_amdgcn_mfma_f32_16x16x4f32(ax, b0, x0, 0, 0, 0); x1 = __builtin_amdgcn_mfma_f32_16x16x4f32(ax, b1, x1, 0, 0, 0);
            z0 = __builtin_amdgcn_mfma_f32_16x16x4f32(az, b0, z0, 0, 0, 0); z1 = __builtin_amdgcn_mfma_f32_16x16x4f32(az, b1, z1, 0, 0, 0);
        }
        S2_LSTORE(sX + (cur ^ 1) * (64 * 68), x0, x1); S2_LSTORE(sZ + (cur ^ 1) * (64 * 68), z0, z1);
        S2_CSTORE(PUg + (size_t)jj * 8192, x0, x1); S2_CSTORE(PUg + (size_t)jj * 8192 + 4096, z0, z1);
        if (jj == 15) { S2_CSTORE(TOT, x0, x1); S2_CSTORE(TOT + 4096, z0, z1); }
        { float* Pn = sP + (cur ^ 1) * (64 * 68); *(float4*)(Pn + prow * 68 + pcol) = pa0; *(float4*)(Pn + prow * 68 + pcol + 4) = pa1; }
        pa0 = pb0; pa1 = pb1;
        S2_PLOAD(PUg + (size_t)min(jj + 3, 15) * 8192, pb0, pb1);
#pragma unroll
        for (int t = 0; t < 2; ++t)
#pragma unroll
            for (int j = 0; j < 4; ++j) ua[t][j] = ub[t][j];
        if (jj + 2 < 16) S2_ULOAD(PUg + (size_t)(jj + 2) * 8192, ub);
        __syncthreads();
    }
}
DEV void phase_scan2b(PPtr p, char* lds) {
    if (blockIdx.x >= 128) return;
    const int tid = tidx(), lane = tid & 63, w = __builtin_amdgcn_readfirstlane(tid >> 6), seq = blockIdx.x >> 3, g = blockIdx.x & 7;
    float* sS = (float*)lds; float* sP = sS + 2 * 64 * 68;
    float* PUg = (float*)(p->ws + OFF_PU) + (size_t)(seq * NCH + 16 * g) * 8192;
    float* TOTs = (float*)(p->ws + OFF_LA) + (size_t)(seq * 8) * 8192;
    const int rt = w >> 1, ct0 = (w & 1) * 2, r = lane & 15, q = lane >> 4;
    const int prow = tid >> 3, pcol = (tid & 7) * 8;
    const int T = g + 16;
#define S2_ENT(t_) ((min((t_), T - 1) < g) ? TOTs + (size_t)min((t_), T - 1) * 8192 : PUg + (size_t)(min((t_), T - 1) - g) * 8192)
    for (int i = tid; i < 64 * 68; i += NTHR) sS[i] = 0.f;
    float4 pa0, pa1, pb0, pb1;
    { float4 t0, t1; S2_PLOAD(S2_ENT(0), t0, t1); *(float4*)(sP + prow * 68 + pcol) = t0; *(float4*)(sP + prow * 68 + pcol + 4) = t1; }
    S2_PLOAD(S2_ENT(1), pa0, pa1); S2_PLOAD(S2_ENT(2), pb0, pb1);
    float ua[2][4], ub[2][4];
    S2_ULOAD(S2_ENT(0), ua); S2_ULOAD(S2_ENT(1), ub);
    f32x4 m0 = {0.f, 0.f, 0.f, 0.f}, m1 = {0.f, 0.f, 0.f, 0.f};
    int sb = 0;
    __syncthreads();
    for (int t = 0; t < T; ++t) {
        const int cur = t & 1; const bool chain = t < g;
        if (!chain) S2_CSTORE(PUg + (size_t)(t - g) * 8192 + 4096, m0, m1);
        f32x4 a0 = {ua[0][0], ua[0][1], ua[0][2], ua[0][3]}, a1 = {ua[1][0], ua[1][1], ua[1][2], ua[1][3]};
        const float* Sc = sS + sb * (64 * 68); const float* Pc = sP + cur * (64 * 68);
#pragma unroll
        for (int ks = 0; ks < 16; ++ks) {
            const float av = Sc[(16 * rt + r) * 68 + 4 * ks + q];
            const float b0 = Pc[(4 * ks + q) * 68 + 16 * ct0 + r], b1 = Pc[(4 * ks + q) * 68 + 16 * ct0 + 16 + r];
            a0 = __builtin_amdgcn_mfma_f32_16x16x4f32(av, b0, a0, 0, 0, 0);
            a1 = __builtin_amdgcn_mfma_f32_16x16x4f32(av, b1, a1, 0, 0, 0);
        }
        m0 = a0; m1 = a1;
        if (chain) { S2_LSTORE(sS + (sb ^ 1) * (64 * 68), a0, a1); sb ^= 1; }
        { float* Pn = sP + (cur ^ 1) * (64 * 68); *(float4*)(Pn + prow * 68 + pcol) = pa0; *(float4*)(Pn + prow * 68 + pcol + 4) = pa1; }
        pa0 = pb0; pa1 = pb1;
        S2_PLOAD(S2_ENT(t + 3), pb0, pb1);
#pragma unroll
        for (int u = 0; u < 2; ++u)
#pragma unroll
            for (int j = 0; j < 4; ++j) ua[u][j] = ub[u][j];
        if (t + 2 < T) S2_ULOAD(S2_ENT(t + 2), ub);
        __syncthreads();
    }
#undef S2_ENT
}
DEV void phase_scan3(PPtr p, char* lds) {
    const int tid = tidx(), lane = tid & 63, wv = __builtin_amdgcn_readfirstlane(tid >> 6), gw = blockIdx.x * NWAVE + wv, ngw = gridDim.x * NWAVE;
    const float* DEC = (const float*)(p->ws + OFF_DEC); const u16* KD = (const u16*)(p->ws + OFF_KD); const u16* BQ = (const u16*)(p->ws + OFF_BQ);
    const u16* KK = (const u16*)(p->ws + OFF_KK); const u16* R = (const u16*)(p->ws + OFF_R); const u16* V = (const u16*)(p->ws + OFF_V);
    const float* PU = (const float*)(p->ws + OFF_PU);
    float* Y = (float*)(p->ws + OFF_Y0);
    ldsf ring = (ldsf)lds + wv * (3 * SSLOT);
    for (int task = gw; task < 16 * NCH; task += ngw) {
        const int seq = task >> 7, c = task & 127, h = seq >> 1, d = seq & 1;
        f32x2 S[32];
        {
            const float4* si = (const float4*)(PU + ((size_t)task * 2 + 1) * 4096 + lane * 64);
#pragma unroll
            for (int j = 0; j < 16; ++j) { const float4 t = si[j]; S[2 * j] = (f32x2){t.x, t.y}; S[2 * j + 1] = (f32x2){t.z, t.w}; }
        }
#define LD(st) load_step(DEC, KD, BQ, KK, R, V, pos_to_pp(c * CLEN + min((st), CLEN - 1), d), h, d, lane)
#define YADD(st, y) unsafeAtomicAdd(Y + (size_t)pos_to_pp(c * CLEN + (st), d) * 512 + h * 64 + lane, (y))
        float vvA, vvB;
        { const StepV s0 = LD(0), s1 = LD(1); stage_step(ring, s0, lane); stage_step(ring + SSLOT, s1, lane); vvA = s0.v; vvB = s1.v; }
        StepV g0 = LD(2), g1 = LD(3), g2 = LD(4), g3 = LD(5);
        int cs = 0, ns = 2;
#pragma unroll 1
        for (int st = 0; st < CLEN; ++st) {
            const float y = scan_step<2>(S, ring + cs * SSLOT, vvA); YADD(st, y);
            stage_step(ring + ns * SSLOT, g0, lane);
            vvA = vvB; vvB = g0.v; g0 = g1; g1 = g2; g2 = g3; g3 = LD(st + 6);
            cs = (cs == 2) ? 0 : cs + 1; ns = (ns == 2) ? 0 : ns + 1;
        }
#undef LD
#undef YADD
    }
}
DEV void phase_readout(PPtr p, int li, int bb) {
    const int tid = tidx(), lane = tid & 63, gw = blockIdx.x * NWAVE + (tid >> 6), ngw = gridDim.x * NWAVE;
    const float* Y0 = (const float*)(p->ws + OFF_Y0);
    const u16* KD = (const u16*)(p->ws + OFF_KD); const u16* R = (const u16*)(p->ws + OFF_R); const u16* V = (const u16*)(p->ws + OFF_V); const u16* G = (const u16*)(p->ws + OFF_G);
    const float* rk = p->in[24] + li * 512; const float* lnw = p->in[25] + li * 512; const float* lnb = p->in[26] + li * 512;
    u16* AO = (u16*)(p->ws + OFF_AO);
    const int c = 8 * lane;
    float rkv[8], lw[8], lb[8];
    { const float4 a = *(const float4*)(rk + c), b = *(const float4*)(rk + c + 4); rkv[0] = a.x; rkv[1] = a.y; rkv[2] = a.z; rkv[3] = a.w; rkv[4] = b.x; rkv[5] = b.y; rkv[6] = b.z; rkv[7] = b.w; }
    { const float4 a = *(const float4*)(lnw + c), b = *(const float4*)(lnw + c + 4); lw[0] = a.x; lw[1] = a.y; lw[2] = a.z; lw[3] = a.w; lw[4] = b.x; lw[5] = b.y; lw[6] = b.z; lw[7] = b.w; }
    { const float4 a = *(const float4*)(lnb + c), b = *(const float4*)(lnb + c + 4); lb[0] = a.x; lb[1] = a.y; lb[2] = a.z; lb[3] = a.w; lb[4] = b.x; lb[5] = b.y; lb[6] = b.z; lb[7] = b.w; }
    for (int pp = gw; pp < RPB; pp += ngw) {
        const size_t m = (size_t)bb * RPB + pp, e = (size_t)pp * 512 + c;
        const float4 ya = *(const float4*)(Y0 + e), yb = *(const float4*)(Y0 + e + 4);
        const float y[8] = {ya.x, ya.y, ya.z, ya.w, yb.x, yb.y, yb.z, yb.w};
        float r[8], k0[8], k1[8], v[8], g[8];
        unpack8(*(const uint4*)(R + e), r); unpack8(*(const uint4*)(KD + ((size_t)pp * 2) * 512 + c), k0); unpack8(*(const uint4*)(KD + ((size_t)pp * 2 + 1) * 512 + c), k1);
        unpack8(*(const uint4*)(V + e), v); unpack8(*(const uint4*)(G + e), g);
        float sm = 0.f, bs = 0.f;
#pragma unroll
        for (int j = 0; j < 8; ++j) { sm += y[j]; bs += r[j] * (k0[j] + k1[j]) * rkv[j]; }
        sm += __shfl_xor(sm, 1); sm += __shfl_xor(sm, 2); sm += __shfl_xor(sm, 4);
        bs += __shfl_xor(bs, 1); bs += __shfl_xor(bs, 2); bs += __shfl_xor(bs, 4);
        const float mean = sm * (1.f / 64.f);
        float vs = 0.f;
#pragma unroll
        for (int j = 0; j < 8; ++j) { const float dv = y[j] - mean; vs += dv * dv; }
        vs += __shfl_xor(vs, 1); vs += __shfl_xor(vs, 2); vs += __shfl_xor(vs, 4);
        const float rstd = rsqrtf(vs * (1.f / 64.f) + 64e-5f);
        float o[8];
#pragma unroll
        for (int j = 0; j < 8; ++j) o[j] = ((y[j] - mean) * rstd * lw[j] + lb[j] + bs * v[j]) * g[j];
        *(uint4*)(AO + m * DM + 512 + c) = pack8(o);
    }
}
DEV void phase_final(PPtr p) {
    const int lane = tidx() & 63, gw = blockIdx.x * NWAVE + (tidx() >> 6), ngw = gridDim.x * NWAVE;
    const float* gain = p->in[29];
    for (int m = gw; m < NB * SEQ; m += ngw) {
        float4* xr = (float4*)(p->out + (size_t)m * DM);
        float4 v[4]; float ss = 0.f;
#pragma unroll
        for (int j = 0; j < 4; ++j) { v[j] = xr[lane + 64 * j]; ss += v[j].x * v[j].x + v[j].y * v[j].y + v[j].z * v[j].z + v[j].w * v[j].w; }
        ss = wave_sum(ss);
        const float rstd = rsqrtf(ss * (1.f / DM) + 1e-6f);
#pragma unroll
        for (int j = 0; j < 4; ++j) {
            const float4 g = *(const float4*)(gain + (lane + 64 * j) * 4);
            float4 o; o.x = v[j].x * rstd * g.x; o.y = v[j].y * rstd * g.y; o.z = v[j].z * rstd * g.z; o.w = v[j].w * rstd * g.w;
            xr[lane + 64 * j] = o;
        }
    }
}

constexpr size_t OFF_BAR = 768 * 1024;
DEV void gbar(PPtr kp_, unsigned& nbar) {
    asm volatile("s_waitcnt vmcnt(0)" ::: "memory");
    __syncthreads();
    if (threadIdx.x == 0) {
        unsigned* ctr = (unsigned*)(kp_->ws + OFF_BAR);
        __builtin_amdgcn_fence(__ATOMIC_RELEASE, "agent");
        asm volatile("s_waitcnt vmcnt(0)" ::: "memory");
        ++nbar;
        __hip_atomic_fetch_add(ctr, 1u, __ATOMIC_RELAXED, __HIP_MEMORY_SCOPE_AGENT);
        const unsigned target = nbar * gridDim.x;
        while (__hip_atomic_load(ctr, __ATOMIC_RELAXED, __HIP_MEMORY_SCOPE_AGENT) < target) __builtin_amdgcn_s_sleep(1);
        __builtin_amdgcn_fence(__ATOMIC_ACQUIRE, "agent");
        asm volatile("s_waitcnt vmcnt(0)" ::: "memory");
    }
    __syncthreads();
}
#define p launder(kp)
#define SYNC() gbar(launder(kp), nbar)
template <int bb>
DEV void do_rwkv_batch(PPtr kp, unsigned& nbar, char* lds, int li) {
    unsigned char* ws = launder(kp)->ws;
    u16* ZD = (u16*)(ws + OFF_ZD);
                phase_rwkv_prep(p, li, bb); SYNC();
                const u16* LA = (const u16*)(ws + OFF_LA); const u16* ZDb = ZD + (size_t)bb * RPB * ZDW;
                { pg8::EpiLoraT e{(float*)(ws + OFF_DEC), (u16*)(ws + OFF_KD), (u16*)(ws + OFF_BQ), (u16*)(ws + OFF_G), (const u16*)(ws + OFF_KK), ZDb,
                                  p->in[17] + (size_t)li * 1024, p->in[19] + (size_t)li * 1024, p->in[23] + li * 512, p->in[16] + li * ZDW + 512};
                  int kl_ = 256; asm volatile("" : "+s"(kl_));
                  pg8::Gemm g_{(const pg8::bf16_t*)LA, (const pg8::bf16_t*)(ws + OFF_PU), RPB, 2560, kl_}; pg8::StaticOrder S_; S_.init(RPB, 2560, (int)gridDim.x, (int)blockIdx.x);
                  pg8::gemm_phase<pg8::EpiLoraT, pg8::StaticOrder, true, true>((PG8_LAS unsigned char*)lds, g_, S_, e); }
                SYNC();
                phase_scan1(p, lds); SYNC();
                phase_scan2a(p, lds); SYNC();
                phase_scan2b(p, lds); SYNC();
                phase_scan3(p, lds); SYNC();
                phase_readout(p, li, bb); SYNC();
            }
template <int layer>
DEV void do_layer(PPtr kp, unsigned& nbar, char* lds) {
    unsigned char* ws = launder(kp)->ws;
    const float* mod = (const float*)(ws + OFF_MOD);
    u16* HN = (u16*)(ws + OFF_HN); u16* AO = (u16*)(ws + OFF_AO); u16* RAW = (u16*)(ws + OFF_RAW); u16* ZD = (u16*)(ws + OFF_ZD);
        const int li = layer >> 1;
        const float* lmod = mod + (size_t)layer * 3 * 6144;
        phase_wprep(p, layer, lds); phase_normmod(p, layer, 0); SYNC();
        const pg8::bf16_t* WB = (const pg8::bf16_t*)(ws + OFF_WB);
#define GEMM8(A_, B_, N_, K_, E_) do { pg8::Gemm g_{(const pg8::bf16_t*)(A_), (B_), MROWS, (N_), (K_)}; pg8::StaticOrder S_; S_.init(MROWS, (N_), (int)gridDim.x, (int)blockIdx.x); \
            pg8::gemm_phase<decltype(E_), pg8::StaticOrder, true, true>((PG8_LAS unsigned char*)lds, g_, S_, E_); } while (0)
        if (!(layer & 1)) {
            { pg8::EpiStoreT e{RAW, 1536, 1 << 30, RAW, 1536}; GEMM8(HN, WB + WB_IN, 1536, DM, e); } SYNC();
            phase_even_post(p, li); SYNC();
            phase_attn_even(p, li, lds); SYNC();
            { pg8::EpiResidT e{p, lmod + 2048}; GEMM8(AO, WB + WB_OUT, DM, DM, e); } SYNC();
        } else {
            { pg8::EpiStoreT e{RAW, 1536, 1536, ZD, ZDW}; GEMM8(HN, WB + WB_IN, 3328, DM, e); } SYNC();
            phase_attn_odd(p, li, lds); SYNC();
            do_rwkv_batch<0>(kp, nbar, lds, li);
            do_rwkv_batch<1>(kp, nbar, lds, li);
            { pg8::EpiResidT e{p, lmod + 2048}; GEMM8(AO, WB + WB_OUT, DM, DM, e); } SYNC();
        }
        phase_normmod(p, layer, 1); SYNC();
        { pg8::EpiSwigluT e{RAW}; GEMM8(HN, WB + WB_F1, 5632, DM, e); } SYNC();
        { pg8::EpiResidT e{p, lmod + 5120}; GEMM8(RAW, WB + WB_F2, DM, FFH, e); } SYNC();
    }
__global__ void __launch_bounds__(NTHR) mega(Params p_unused) {
    PPtr kp = (PPtr)__builtin_amdgcn_kernarg_segment_ptr();
    extern __shared__ __attribute__((aligned(16))) char lds[];
    cg::grid_group grid = cg::this_grid();
    unsigned nbar = 0;
    grid.sync();
    phase_init(p, lds); SYNC();
    do_layer<0>(kp, nbar, lds);
    do_layer<1>(kp, nbar, lds);
    do_layer<2>(kp, nbar, lds);
    do_layer<3>(kp, nbar, lds);
    phase_final(p);
}
#undef p
#undef SYNC

extern "C" void kernel_launch(void* const* d_in, const int* in_sizes, int n_in, void* d_out, int out_size, void* d_ws, size_t ws_size, hipStream_t stream) {
    static int grid = 0;
    if (grid == 0) {
        if (n_in != 30 || ws_size < WS_NEED || out_size != NB * SEQ * DM) { fprintf(stderr, "kernel_launch: unexpected problem shape (n_in %d ws %zu out %d)\n", n_in, ws_size, out_size); grid = -1; return; }
        int dev = 0, cus = 0, per_cu = 0;
        hipGetDevice(&dev);
        hipDeviceGetAttribute(&cus, hipDeviceAttributeMultiprocessorCount, dev);
        hipFuncSetAttribute((const void*)mega, hipFuncAttributeMaxDynamicSharedMemorySize, LDS_BYTES);
        hipOccupancyMaxActiveBlocksPerMultiprocessor(&per_cu, (const void*)mega, NTHR, LDS_BYTES);
        if (per_cu < 1) per_cu = 1;
        if (per_cu > 1) per_cu = 1;
        grid = cus * per_cu;
    }
    if (grid < 0) return;
    Params p{};
    for (int i = 0; i < 30; ++i) p.in[i] = (const float*)d_in[i];
    p.out = (float*)d_out; p.ws = (unsigned char*)d_ws;
    hipMemsetAsync((char*)d_ws + OFF_BAR, 0, 256, stream);
    void* args[] = {&p};
    hipError_t e = hipLaunchCooperativeKernel((const void*)mega, dim3(grid), dim3(NTHR), args, LDS_BYTES, stream);
    if (e != hipSuccess) fprintf(stderr, "cooperative launch failed: %s (grid %d)\n", hipGetErrorString(e), grid);
}
```

```cpp
#include <hip/hip_runtime.h>
#include <hip/hip_cooperative_groups.h>
#include <cstdio>
#include <cstdint>
namespace cg = cooperative_groups;

#define DEV __device__ __forceinline__
typedef unsigned short u16;
typedef short bf16x8 __attribute__((ext_vector_type(8)));
typedef float f32x4 __attribute__((ext_vector_type(4)));
typedef const __attribute__((address_space(4))) float* cfp;
typedef const __attribute__((address_space(4))) unsigned* cup;

constexpr int DM = 1024, NB = 2, SEQ = 16384, NCTX = 256, RPB = SEQ + NCTX, MROWS = NB * RPB;
constexpr int FFH = 2816, ZDW = 1792;
constexpr float LOG2E = 1.4426950408889634f;
constexpr int NTHR = 512, NWAVE = 8;
constexpr int LDS_BYTES = 132096;

constexpr size_t MiB = 1u << 20;
constexpr size_t OFF_MOD = 0;
constexpr size_t OFF_ROPE = 512 * 1024;
constexpr size_t OFF_XC = 1 * MiB;
constexpr size_t OFF_WB = 3 * MiB;
constexpr size_t OFF_AO = 29 * MiB;
constexpr size_t OFF_HN = 94 * MiB;
constexpr size_t OFF_RAW = 159 * MiB;
constexpr size_t OFF_ZD = 257 * MiB;
constexpr size_t SZ_H = (size_t)RPB * 512 * 2;
constexpr size_t OFF_DEC = 94 * MiB;
constexpr size_t OFF_KD = OFF_DEC + 4 * SZ_H;
constexpr size_t OFF_BQ = OFF_KD + 2 * SZ_H;
constexpr size_t OFF_KK = OFF_BQ + 2 * SZ_H;
constexpr size_t OFF_R = OFF_KK + SZ_H;
constexpr size_t OFF_V = 371 * MiB;
constexpr size_t OFF_G = OFF_V + SZ_H;
constexpr size_t OFF_LA = OFF_G + SZ_H;
constexpr size_t OFF_Y0 = 412 * MiB;
constexpr size_t OFF_PU = OFF_Y0 + 2 * SZ_H;
constexpr size_t WS_NEED = 509 * MiB;
constexpr int NCH = 128, CLEN = 130;
static_assert(OFF_R + SZ_H <= OFF_ZD, "scan map");
static_assert(OFF_LA + SZ_H / 2 <= OFF_Y0, "scan map 2");
static_assert(OFF_PU + 64 * MiB <= WS_NEED, "scan map 3");
static_assert(OFF_RAW + (size_t)MROWS * FFH * 2 <= WS_NEED, "ffn hidden");

struct Params { const float* in[30]; float* out; unsigned char* ws; };
typedef const __attribute__((address_space(4))) Params* PPtr;
DEV int tidx() { int t = threadIdx.x; asm volatile("" : "+v"(t)); return t; }
DEV PPtr launder(PPtr p) { asm volatile("" : "+s"(p)); return p; }

DEV unsigned f2bf(float f) { unsigned u = __float_as_uint(f); return (u + 0x7fffu + ((u >> 16) & 1u)) >> 16; }
DEV float bf2f(u16 h) { return __uint_as_float(((unsigned)h) << 16); }
DEV float bflo(unsigned u) { return __uint_as_float(u << 16); }
DEV float bfhi(unsigned u) { return __uint_as_float(u & 0xffff0000u); }
DEV unsigned pk2(float lo, float hi) { return f2bf(lo) | (f2bf(hi) << 16); }
DEV void unpack8(const uint4 u, float (&f)[8]) {
    f[0] = bflo(u.x); f[1] = bfhi(u.x); f[2] = bflo(u.y); f[3] = bfhi(u.y); f[4] = bflo(u.z); f[5] = bfhi(u.z); f[6] = bflo(u.w); f[7] = bfhi(u.w);
}
DEV uint4 pack8(const float (&f)[8]) { uint4 o; o.x = pk2(f[0], f[1]); o.y = pk2(f[2], f[3]); o.z = pk2(f[4], f[5]); o.w = pk2(f[6], f[7]); return o; }
DEV float wave_sum(float v) {
#pragma unroll
    for (int o = 1; o < 64; o <<= 1) v += __shfl_xor(v, o);
    return v;
}
DEV float* xrow_ptr(PPtr p, int m) {
    int b = m / RPB, q = m - b * RPB;
    return q < SEQ ? p->out + (size_t)(b * SEQ + q) * DM : (float*)(p->ws + OFF_XC) + (size_t)(b * NCTX + (q - SEQ)) * DM;
}
DEV int mod_idx(int m) { int b = m / RPB, q = m - b * RPB; return q < SEQ ? b : 2; }
DEV float sigmoidf_(float x) { return 1.f / (1.f + __expf(-x)); }

DEV void phase_init(PPtr p, char* lds) {
    const int tid = tidx();
    const size_t gt = (size_t)blockIdx.x * NTHR + tid, ng = (size_t)gridDim.x * NTHR;
    {
        const float4* s = (const float4*)p->in[0]; float4* d = (float4*)p->out;
        const size_t n = (size_t)NB * SEQ * DM / 4;
        for (size_t i = gt; i < n; i += ng) d[i] = s[i];
        const float4* s2 = (const float4*)p->in[2]; float4* d2 = (float4*)(p->ws + OFF_XC);
        const size_t n2 = (size_t)NB * NCTX * DM / 4;
        for (size_t i = gt; i < n2; i += ng) d2[i] = s2[i];
    }
    {
        float* T = (float*)(p->ws + OFF_ROPE);
        for (size_t i = gt; i < 5120; i += ng) {
            const int pos = (int)(i >> 4), f = (int)(i & 15);
            const float inv = powf(10000.f, -(float)f / 16.f);
            if (pos < 256) { const float ang = (float)pos * inv; T[pos * 16 + f] = cosf(ang); T[4096 + pos * 16 + f] = sinf(ang); }
            else { const float ang = (float)(pos - 256) * inv; T[8192 + (pos - 256) * 16 + f] = cosf(ang); T[9216 + (pos - 256) * 16 + f] = sinf(ang); }
        }
    }
    float* red = (float*)lds;
    float* mod = (float*)(p->ws + OFF_MOD);
    const float* c = p->in[1]; const float* cc = p->in[3];
    for (int item = blockIdx.x; item < 192; item += gridDim.x) {
        const int l = item / 48, n0 = (item % 48) * 128, col = tid & 127, kp = tid >> 7;
        const float* w = p->in[4] + (size_t)l * DM * 6144 + n0 + col;
        float a0 = 0.f, a1 = 0.f, a2 = 0.f;
        for (int k = kp * 256; k < kp * 256 + 256; ++k) {
            const float wv = w[(size_t)k * 6144];
            const float c0 = c[k], c1 = c[DM + k], c2 = cc[k];
            a0 += c0 * sigmoidf_(c0) * wv; a1 += c1 * sigmoidf_(c1) * wv; a2 += c2 * sigmoidf_(c2) * wv;
        }
        red[(kp * 3 + 0) * 128 + col] = a0; red[(kp * 3 + 1) * 128 + col] = a1; red[(kp * 3 + 2) * 128 + col] = a2;
        __syncthreads();
        if (tid < 384) {
            const int mb = tid >> 7, cl = tid & 127;
            float s = red[(0 * 3 + mb) * 128 + cl] + red[(1 * 3 + mb) * 128 + cl] + red[(2 * 3 + mb) * 128 + cl] + red[(3 * 3 + mb) * 128 + cl];
            mod[(size_t)(l * 3 + mb) * 6144 + n0 + cl] = s + p->in[5][l * 6144 + n0 + cl];
        }
        __syncthreads();
    }
}

DEV void phase_normmod(PPtr p, int layer, int which) {
    const int lane = tidx() & 63, gw = blockIdx.x * NWAVE + (tidx() >> 6), ngw = gridDim.x * NWAVE;
    const float* gain = p->in[which ? 7 : 6] + layer * DM;
    const float* mod = (const float*)(p->ws + OFF_MOD) + (size_t)layer * 3 * 6144;
    u16* HN = (u16*)(p->ws + OFF_HN);
    for (int m = gw; m < MROWS; m += ngw) {
        const float* xr = xrow_ptr(p, m);
        const float* md = mod + mod_idx(m) * 6144 + (which ? 3072 : 0);
        float4 v[4]; float ss = 0.f;
#pragma unroll
        for (int j = 0; j < 4; ++j) { v[j] = ((const float4*)xr)[lane + 64 * j]; ss += v[j].x * v[j].x + v[j].y * v[j].y + v[j].z * v[j].z + v[j].w * v[j].w; }
        ss = wave_sum(ss);
        const float rstd = rsqrtf(ss * (1.f / DM) + 1e-6f);
#pragma unroll
        for (int j = 0; j < 4; ++j) {
            const int k = (lane + 64 * j) * 4;
            const float4 g = *(const float4*)(gain + k), sh = *(const float4*)(md + k), sc = *(const float4*)(md + 1024 + k);
            const float o0 = v[j].x * rstd * g.x * (1.f + sc.x) + sh.x, o1 = v[j].y * rstd * g.y * (1.f + sc.y) + sh.y;
            const float o2 = v[j].z * rstd * g.z * (1.f + sc.z) + sh.z, o3 = v[j].w * rstd * g.w * (1.f + sc.w) + sh.w;
            uint2 w; w.x = pk2(o0, o1); w.y = pk2(o2, o3);
            *(uint2*)(HN + (size_t)m * DM + k) = w;
        }
    }
}

template <int DUAL, class Epi>
DEV void gemm_simple(const u16* A, int lda, const float* W, int ldw, int dualoff, int M, int N, int K, const Epi& epi, char* lds) {
    u16* sA = (u16*)lds; u16* sB = sA + 128 * 40; u16* sB2 = sB + 128 * 40;
    const int tid = tidx(), lane = tid & 63, wave = tid >> 6, wm = wave >> 2, wn = wave & 3, r16 = lane & 15, quad = lane >> 4;
    const int mt = M / 128, nt = N / 128;
    for (int item = blockIdx.x; item < mt * nt; item += gridDim.x) {
        const int tn = item / mt, tm = item - tn * mt, m0 = tm * 128, n0 = tn * 128;
        f32x4 acc[4][2], acc2[4][2];
#pragma unroll
        for (int a = 0; a < 4; ++a)
#pragma unroll
            for (int b = 0; b < 2; ++b) { acc[a][b] = (f32x4){0.f, 0.f, 0.f, 0.f}; acc2[a][b] = (f32x4){0.f, 0.f, 0.f, 0.f}; }
        for (int k0 = 0; k0 < K; k0 += 32) {
            {
                const int row = tid >> 2, kc = (tid & 3) * 8;
                const uint4 v = *(const uint4*)(A + (size_t)(m0 + row) * lda + k0 + kc);
                *(uint4*)(sA + row * 40 + kc) = v;
            }
            {
                const int kk = tid >> 4, nc = (tid & 15) * 8;
                const float* wp = W + (size_t)(k0 + kk) * ldw + n0 + nc;
                const float4 a = *(const float4*)wp, b = *(const float4*)(wp + 4);
                sB[(nc + 0) * 40 + kk] = (u16)f2bf(a.x); sB[(nc + 1) * 40 + kk] = (u16)f2bf(a.y); sB[(nc + 2) * 40 + kk] = (u16)f2bf(a.z); sB[(nc + 3) * 40 + kk] = (u16)f2bf(a.w);
                sB[(nc + 4) * 40 + kk] = (u16)f2bf(b.x); sB[(nc + 5) * 40 + kk] = (u16)f2bf(b.y); sB[(nc + 6) * 40 + kk] = (u16)f2bf(b.z); sB[(nc + 7) * 40 + kk] = (u16)f2bf(b.w);
                if (DUAL) {
                    const float4 c = *(const float4*)(wp + dualoff), d = *(const float4*)(wp + dualoff + 4);
                    sB2[(nc + 0) * 40 + kk] = (u16)f2bf(c.x); sB2[(nc + 1) * 40 + kk] = (u16)f2bf(c.y); sB2[(nc + 2) * 40 + kk] = (u16)f2bf(c.z); sB2[(nc + 3) * 40 + kk] = (u16)f2bf(c.w);
                    sB2[(nc + 4) * 40 + kk] = (u16)f2bf(d.x); sB2[(nc + 5) * 40 + kk] = (u16)f2bf(d.y); sB2[(nc + 6) * 40 + kk] = (u16)f2bf(d.z); sB2[(nc + 7) * 40 + kk] = (u16)f2bf(d.w);
                }
            }
            __syncthreads();
            bf16x8 af[4], bfr[2], bfr2[2];
#pragma unroll
            for (int mi = 0; mi < 4; ++mi) af[mi] = *(const bf16x8*)(sA + (wm * 64 + mi * 16 + r16) * 40 + quad * 8);
#pragma unroll
            for (int ni = 0; ni < 2; ++ni) {
                bfr[ni] = *(const bf16x8*)(sB + (wn * 32 + ni * 16 + r16) * 40 + quad * 8);
                if (DUAL) bfr2[ni] = *(const bf16x8*)(sB2 + (wn * 32 + ni * 16 + r16) * 40 + quad * 8);
            }
#pragma unroll
            for (int mi = 0; mi < 4; ++mi)
#pragma unroll
                for (int ni = 0; ni < 2; ++ni) {
                    acc[mi][ni] = __builtin_amdgcn_mfma_f32_16x16x32_bf16(af[mi], bfr[ni], acc[mi][ni], 0, 0, 0);
                    if (DUAL) acc2[mi][ni] = __builtin_amdgcn_mfma_f32_16x16x32_bf16(af[mi], bfr2[ni], acc2[mi][ni], 0, 0, 0);
                }
            __syncthreads();
        }
#pragma unroll
        for (int mi = 0; mi < 4; ++mi)
#pragma unroll
            for (int ni = 0; ni < 2; ++ni)
#pragma unroll
                for (int j = 0; j < 4; ++j) {
                    const int row = m0 + wm * 64 + mi * 16 + quad * 4 + j, col = n0 + wn * 32 + ni * 16 + r16;
                    epi(row, col, acc[mi][ni][j], DUAL ? acc2[mi][ni][j] : 0.f);
                }
    }
}

struct EpiStore { u16* O; int ld; DEV void operator()(int r, int c, float v, float) const { O[(size_t)r * ld + c] = (u16)f2bf(v); } };
struct EpiStoreOdd { u16* Q; u16* Z;
    DEV void operator()(int r, int c, float v, float) const { if (c < 1536) Q[(size_t)r * 1536 + c] = (u16)f2bf(v); else Z[(size_t)r * ZDW + (c - 1536)] = (u16)f2bf(v); } };
struct EpiResid { PPtr p; const float* gate;
    DEV void operator()(int r, int c, float v, float) const { float* xr = xrow_ptr(p, r); xr[c] += gate[mod_idx(r) * 6144 + c] * v; } };
struct EpiSwiglu { u16* H;
    DEV void operator()(int r, int c, float g, float u) const { H[(size_t)r * FFH + c] = (u16)f2bf(g * sigmoidf_(g) * u); } };


namespace pg8 {
#define PG8_LAS __attribute__((address_space(3)))
typedef unsigned short bf16_t;
typedef short bf16x8 __attribute__((ext_vector_type(8)));
typedef float f32x4 __attribute__((ext_vector_type(4)));
typedef unsigned u32x4 __attribute__((ext_vector_type(4)));
constexpr int BM = 256, BK = 64, HALF = 128, HTB = HALF * BK * 2  , STAGE_BYTES = 8 * HTB, NXCD = 8, WGM = 8;

__host__ __device__ __forceinline__ int lds_byte(int r, int c) { const int st = (r >> 4) * 2 + (c >> 5), rr = r & 15, cc = c & 31, ob = rr * 64 + cc * 2; return st * 1024 + (ob ^ (((ob >> 9) & 1) << 5)); }
__host__ __device__ __forceinline__ void stage_rc(int b, int& R, int& C) { const int st = b / 1024, sb = b % 1024, swz = sb ^ (((sb >> 9) & 1) << 5); R = (st >> 1) * 16 + swz / 64; C = (st & 1) * 32 + (swz % 64) / 2; }
__host__ __device__ __forceinline__ int perm32(int rho) { const int n = rho >> 4, i = rho & 15; return 8 * (i >> 2) + 4 * n + (i & 3); }

struct Unit { int pm, pn; };
struct Gemm { const bf16_t* A; const bf16_t* Bt; int M, N, K; };

struct StaticOrder {
    int nM, nN, nwg, G, c;
    __host__ __device__ void init(int M, int N, int G_, int c_) { nM = M / BM; nN = N / BM; nwg = nM * nN; G = G_; c = c_; }
    __host__ __device__ bool next(int i, Unit& u) const {
        const long L = (long)i * G + c; if (L >= nwg) return false;
        int wgid = (int)L; { const int q = nwg / NXCD, r = nwg % NXCD, xcd = wgid % NXCD, off = wgid / NXCD; wgid = (xcd < r ? xcd * (q + 1) : r * (q + 1) + (xcd - r) * q) + off; }
        const int nig = WGM * nN, gid = wgid / nig, fm = gid * WGM, gsz = (nM - fm) < WGM ? (nM - fm) : WGM;
        u.pm = fm + ((wgid % nig) % gsz); u.pn = (wgid % nig) / gsz; return true;
    }
    __device__ __forceinline__ void a_ready(const Unit&) const {}
    __device__ __forceinline__ void done(const Unit&) const {}
};
struct LatentOrder {
    StaticOrder S;
    __host__ __device__ void init(int N, int G_, int c_) { S.init(32768, N, G_, c_); }
    __host__ __device__ bool next(int i, Unit& u) const { if (!S.next(i, u)) return false; u.pm = u.pm < 64 ? u.pm : u.pm + 1; return true; }
    __device__ __forceinline__ void a_ready(const Unit&) const {}
    __device__ __forceinline__ void done(const Unit&) const {}
};

__device__ __forceinline__ unsigned cvt_pk_bf16(float lo, float hi) { unsigned r; asm volatile("v_cvt_pk_bf16_f32 %0, %1, %2" : "=v"(r) : "v"(lo), "v"(hi)); return r; }
template <class Epi, class Sched, bool ALIGN_EPI = false, bool SP2 = false>
__device__ __forceinline__ void gemm_phase(PG8_LAS unsigned char* lds, const Gemm g, const Sched& S, const Epi& E) {
    const int tid = tidx(), wid = __builtin_amdgcn_readfirstlane(tid >> 6), lane = tid & 63, wr = wid >> 2, wc = wid & 3, fr = lane & 15, fq = lane >> 4;
    const int K = g.K, nt = K / BK;
    unsigned voffA[2], voffB[2];
#pragma unroll
    for (int i = 0; i < 2; ++i) { int R, C; stage_rc(tid * 16 + i * 8192, R, C); const int Rb = Epi::PERM ? ((R & ~31) + perm32(R & 31)) : R;
        voffA[i] = (unsigned)(R * K + C) * 2u; voffB[i] = (unsigned)(Rb * K + C) * 2u; }
    const size_t kstep = (size_t)(BK * 2);
    const size_t hstep = (size_t)HALF * K * 2;
    const size_t tstep = 2 * hstep;
    const unsigned ldsw = (unsigned)wid * 1024u;
    const int aoff = lds_byte(wr * 64 + fr, fq * 8), boff = lds_byte(wc * 32 + fr, fq * 8);
#define PG8_SA(b, h) (((b) * 2 + (h)) * HTB)
#define PG8_SB(b, h) ((4 + (b) * 2 + (h)) * HTB)
#define PG8_STAGE(bufoff, gbase, voff) do { _Pragma("unroll") for (int _i = 0; _i < 2; ++_i) \
        __builtin_amdgcn_global_load_lds((const unsigned*)((const char*)(gbase) + (voff)[_i]), (PG8_LAS unsigned*)(lds + (bufoff) + ldsw + _i * 8192), 16, 0, 0); } while (0)
#define PG8_LDA(dst, b, h) do { _Pragma("unroll") for (int m = 0; m < 4; ++m) _Pragma("unroll") for (int k = 0; k < 2; ++k) dst[m][k] = *(const PG8_LAS bf16x8*)(lds + PG8_SA(b, h) + aoff + m * 2048 + k * 1024); } while (0)
#define PG8_LDB(dst, b, h) do { _Pragma("unroll") for (int n = 0; n < 2; ++n) _Pragma("unroll") for (int k = 0; k < 2; ++k) dst[n][k] = *(const PG8_LAS bf16x8*)(lds + PG8_SB(b, h) + boff + n * 2048 + k * 1024); } while (0)
#define PG8_MMA(ai, bj, At, Bt) do { __builtin_amdgcn_s_setprio(1); _Pragma("unroll") for (int m = 0; m < 4; ++m) _Pragma("unroll") for (int n = 0; n < 2; ++n) _Pragma("unroll") for (int k = 0; k < 2; ++k) \
        acc[ai][bj][m][n] = __builtin_amdgcn_mfma_f32_16x16x32_bf16(Bt[n][k], At[m][k], acc[ai][bj][m][n], 0, 0, 0); __builtin_amdgcn_s_setprio(0); } while (0)
#define PG8_WAIT_V(n) asm volatile("s_waitcnt vmcnt(" #n ")" ::: "memory")
#define PG8_WAIT_L(n) asm volatile("s_waitcnt lgkmcnt(" #n ")" ::: "memory")
#define PG8_BAR __builtin_amdgcn_s_barrier()
#define PG8_SCHED __builtin_amdgcn_sched_barrier(0)
    Unit cur, nxt; int ui = 0;
    if (!S.next(0, cur)) return;
    f32x4 acc[2][2][4][2];
#pragma unroll
    for (int a = 0; a < 2; ++a)
#pragma unroll
        for (int b = 0; b < 2; ++b)
#pragma unroll
            for (int m = 0; m < 4; ++m)
#pragma unroll
                for (int n = 0; n < 2; ++n) acc[a][b][m][n] = (f32x4){0.f, 0.f, 0.f, 0.f};
    bf16x8 At[4][2], B0[2][2], B1[2][2];
    const char* cA = (const char*)g.A + (size_t)cur.pm * tstep; const char* cB = (const char*)g.Bt + (size_t)cur.pn * tstep;
    S.a_ready(cur);
    if constexpr (SP2) {
        PG8_STAGE(PG8_SB(0, 0), cB, voffB); PG8_STAGE(PG8_SB(0, 1), cB + hstep, voffB); PG8_STAGE(PG8_SA(0, 0), cA, voffA); PG8_STAGE(PG8_SA(0, 1), cA + hstep, voffA);
        if (wr == 1) PG8_BAR;
        PG8_WAIT_V(2); PG8_BAR;
        PG8_STAGE(PG8_SB(1, 0), cB + kstep, voffB); PG8_STAGE(PG8_SA(1, 0), cA + kstep, voffA); PG8_STAGE(PG8_SB(1, 1), cB + hstep + kstep, voffB);
        PG8_WAIT_V(6); PG8_BAR;
    } else {
        PG8_STAGE(PG8_SB(0, 0), cB, voffB); PG8_STAGE(PG8_SA(0, 0), cA, voffA); PG8_STAGE(PG8_SB(0, 1), cB + hstep, voffB); PG8_STAGE(PG8_SA(0, 1), cA + hstep, voffA);
        if (wr == 1) PG8_BAR;
        PG8_WAIT_V(4); PG8_BAR;
        PG8_STAGE(PG8_SB(1, 0), cB + kstep, voffB); PG8_STAGE(PG8_SA(1, 0), cA + kstep, voffA); PG8_STAGE(PG8_SB(1, 1), cB + hstep + kstep, voffB);
        PG8_WAIT_V(6); PG8_BAR;
    }
    for (;;) {
        const bool has_next = S.next(ui + 1, nxt);
        const char* nA = has_next ? (const char*)g.A + (size_t)nxt.pm * tstep : cA; const char* nB = has_next ? (const char*)g.Bt + (size_t)nxt.pn * tstep : cB;
        for (int t = 0; t < nt; t += 2) {
            const bool last = (t == nt - 2);
            const char* a1 = cA + (size_t)(t + 1) * kstep;
            const char* a2 = last ? nA : cA + (size_t)(t + 2) * kstep; const char* b2 = last ? nB : cB + (size_t)(t + 2) * kstep;
            const char* a3 = a2 + kstep; const char* b3 = b2 + kstep;
            if (last && has_next) S.a_ready(nxt);
            if constexpr (SP2) {
            PG8_LDB(B0, 0, 0); PG8_LDB(B1, 0, 1); PG8_SCHED; PG8_LDA(At, 0, 0); PG8_STAGE(PG8_SA(1, 1), a1 + hstep, voffA);
            PG8_WAIT_V(8); PG8_WAIT_L(0); PG8_BAR; PG8_MMA(0, 0, At, B0); PG8_MMA(0, 1, At, B1); PG8_BAR; PG8_SCHED;
            PG8_LDA(At, 0, 1); PG8_STAGE(PG8_SB(0, 0), b2, voffB); PG8_STAGE(PG8_SB(0, 1), b2 + hstep, voffB); PG8_STAGE(PG8_SA(0, 0), a2, voffA);
            PG8_WAIT_V(8); PG8_WAIT_L(0); PG8_BAR; PG8_MMA(1, 0, At, B0); PG8_MMA(1, 1, At, B1); PG8_BAR; PG8_SCHED;
            PG8_LDB(B0, 1, 0); PG8_LDB(B1, 1, 1); PG8_SCHED; PG8_LDA(At, 1, 0); PG8_STAGE(PG8_SA(0, 1), a2 + hstep, voffA);
            PG8_WAIT_V(8); PG8_WAIT_L(0); PG8_BAR; PG8_MMA(0, 0, At, B0); PG8_MMA(0, 1, At, B1); PG8_BAR; PG8_SCHED;
            PG8_LDA(At, 1, 1); PG8_STAGE(PG8_SB(1, 0), b3, voffB); PG8_STAGE(PG8_SB(1, 1), b3 + hstep, voffB); PG8_STAGE(PG8_SA(1, 0), a3, voffA);
            PG8_WAIT_V(8); PG8_WAIT_L(0); PG8_BAR; PG8_MMA(1, 0, At, B0); PG8_MMA(1, 1, At, B1); PG8_BAR; PG8_SCHED;
            } else {
            PG8_LDB(B0, 0, 0); PG8_SCHED; PG8_LDA(At, 0, 0); PG8_STAGE(PG8_SA(1, 1), a1 + hstep, voffA);
            PG8_WAIT_L(8); PG8_BAR; PG8_WAIT_L(0); PG8_MMA(0, 0, At, B0); PG8_BAR; PG8_SCHED;
            PG8_LDB(B1, 0, 1); PG8_STAGE(PG8_SB(0, 0), b2, voffB);
            PG8_BAR; PG8_WAIT_L(0); PG8_MMA(0, 1, At, B1); PG8_BAR;
            PG8_LDA(At, 0, 1); PG8_STAGE(PG8_SA(0, 0), a2, voffA);
            PG8_BAR; PG8_WAIT_L(0); PG8_MMA(1, 0, At, B0); PG8_BAR; PG8_SCHED;
            PG8_STAGE(PG8_SB(0, 1), b2 + hstep, voffB);
            PG8_WAIT_V(6); PG8_BAR; PG8_MMA(1, 1, At, B1); PG8_BAR;
            PG8_LDB(B0, 1, 0); PG8_SCHED; PG8_LDA(At, 1, 0); PG8_STAGE(PG8_SA(0, 1), a2 + hstep, voffA);
            PG8_WAIT_L(8); PG8_BAR; PG8_WAIT_L(0); PG8_MMA(0, 0, At, B0); PG8_BAR; PG8_SCHED;
            PG8_LDB(B1, 1, 1); PG8_STAGE(PG8_SB(1, 0), b3, voffB);
            PG8_BAR; PG8_WAIT_L(0); PG8_MMA(0, 1, At, B1); PG8_BAR;
            PG8_LDA(At, 1, 1); PG8_STAGE(PG8_SA(1, 0), a3, voffA);
            PG8_BAR; PG8_WAIT_L(0); PG8_MMA(1, 0, At, B0); PG8_BAR; PG8_SCHED;
            PG8_STAGE(PG8_SB(1, 1), b3 + hstep, voffB);
            PG8_WAIT_V(6); PG8_BAR; PG8_MMA(1, 1, At, B1); PG8_BAR;
            }
        }
        if constexpr (ALIGN_EPI) { if (wr == 0) PG8_BAR; }
        if constexpr (!Epi::AFTER_DRAIN) { E(acc, cur, wr, wc, fr, fq); S.done(cur); }
        if (!has_next) break;
#pragma unroll
        for (int a = 0; a < 2; ++a)
#pragma unroll
            for (int b = 0; b < 2; ++b)
#pragma unroll
                for (int m = 0; m < 4; ++m)
#pragma unroll
                    for (int n = 0; n < 2; ++n) acc[a][b][m][n] = (f32x4){0.f, 0.f, 0.f, 0.f};
        cur = nxt; cA = nA; cB = nB; ++ui;
        if constexpr (ALIGN_EPI) { if (wr == 1) PG8_BAR; }
    }
    PG8_WAIT_V(0);
    if constexpr (!ALIGN_EPI) { if (wr == 0) PG8_BAR; }
    PG8_BAR;
    if constexpr (Epi::AFTER_DRAIN) { E.fused(acc, cur, wr, wc, fr, fq, lds, wid, lane); S.done(cur); }
#undef PG8_SA
#undef PG8_SB
#undef PG8_STAGE
#undef PG8_LDA
#undef PG8_LDB
#undef PG8_MMA
#undef PG8_WAIT_V
#undef PG8_WAIT_L
#undef PG8_BAR
#undef PG8_SCHED
}

struct EpiStoreT {
    static constexpr bool PERM = true, AFTER_DRAIN = false;
    bf16_t* O0; int ld0; int split; bf16_t* O1; int ld1;
    __device__ __forceinline__ void operator()(const f32x4 (&acc)[2][2][4][2], const Unit& u, int wr, int wc, int fr, int fq) const {
        const int row0 = u.pm * BM + wr * 64 + fr; int colt = u.pn * BM; bf16_t* base = O0; int ld = ld0;
        if (colt >= split) { base = O1; ld = ld1; colt -= split; }
        const int col0 = colt + wc * 32 + 8 * fq;
#pragma unroll
        for (int ai = 0; ai < 2; ++ai)
#pragma unroll
            for (int m = 0; m < 4; ++m) { bf16_t* rowp = base + (size_t)(row0 + ai * HALF + m * 16) * ld + col0;
#pragma unroll
                for (int bj = 0; bj < 2; ++bj) { const f32x4 v0 = acc[ai][bj][m][0], v1 = acc[ai][bj][m][1];
                    u32x4 w; w.x = cvt_pk_bf16(v0[0], v0[1]); w.y = cvt_pk_bf16(v0[2], v0[3]); w.z = cvt_pk_bf16(v1[0], v1[1]); w.w = cvt_pk_bf16(v1[2], v1[3]);
                    *(u32x4*)(rowp + bj * HALF) = w; } }
    }
};
struct EpiResidT {
    static constexpr bool PERM = true, AFTER_DRAIN = false;
    PPtr p; const float* gate;
    __device__ __forceinline__ void operator()(const f32x4 (&acc)[2][2][4][2], const Unit& u, int wr, int wc, int fr, int fq) const {
        float* xb = xrow_ptr(p, u.pm * BM); const float* g = gate + mod_idx(u.pm * BM) * 6144;
        const int col0 = u.pn * BM + wc * 32 + 8 * fq;
#pragma unroll
        for (int ai = 0; ai < 2; ++ai)
#pragma unroll
            for (int m = 0; m < 4; ++m) { float* xr = xb + (size_t)(ai * HALF + wr * 64 + m * 16 + fr) * DM;
#pragma unroll
                for (int bj = 0; bj < 2; ++bj) { const int col = col0 + bj * HALF; const f32x4 v0 = acc[ai][bj][m][0], v1 = acc[ai][bj][m][1];
                    const f32x4 g0 = *(const f32x4*)(g + col), g1 = *(const f32x4*)(g + col + 4);
                    f32x4 x0 = *(const f32x4*)(xr + col), x1 = *(const f32x4*)(xr + col + 4);
                    x0 += g0 * v0; x1 += g1 * v1;
                    *(f32x4*)(xr + col) = x0; *(f32x4*)(xr + col + 4) = x1; } }
    }
};
struct EpiSwigluT {
    static constexpr bool PERM = true, AFTER_DRAIN = false;
    bf16_t* H;
    __device__ __forceinline__ void operator()(const f32x4 (&acc)[2][2][4][2], const Unit& u, int wr, int wc, int fr, int fq) const {
        const int row0 = u.pm * BM + wr * 64 + fr; const int col0 = u.pn * BM + wc * 32 + 8 * fq;
#pragma unroll
        for (int ai = 0; ai < 2; ++ai)
#pragma unroll
            for (int m = 0; m < 4; ++m) { bf16_t* rowp = H + (size_t)(row0 + ai * HALF + m * 16) * FFH;
#pragma unroll
                for (int bj = 0; bj < 2; ++bj) { const f32x4 gt = acc[ai][bj][m][0], up = acc[ai][bj][m][1];
                    float h[4];
#pragma unroll
                    for (int j = 0; j < 4; ++j) h[j] = gt[j] * sigmoidf_(gt[j]) * up[j];
                    uint2 w; w.x = cvt_pk_bf16(h[0], h[1]); w.y = cvt_pk_bf16(h[2], h[3]);
                    *(uint2*)(rowp + ((col0 + bj * HALF) >> 1)) = w; } }
    }
};

struct EpiLoraT {
    static constexpr bool PERM = true, AFTER_DRAIN = false;
    float* DEC; bf16_t* KD; bf16_t* BQ; bf16_t* G; const bf16_t* KK; const bf16_t* ZDb;
    const float* w0; const float* a0; const float* ka; const float* muk;
    template <int TYPE>
    __device__ __forceinline__ void one(const f32x4 v, int r, int c, int d) const {
        if (TYPE == 0) {
            const float4 wa = *(const float4*)(w0 + d * 512 + c);
            const float ww[4] = {wa.x, wa.y, wa.z, wa.w};
            float o[4];
#pragma unroll
            for (int e = 0; e < 4; ++e) { const float x = -(ww[e] + v[e]); const float sp = x > 20.f ? x : __logf(1.f + __expf(x)); o[e] = __expf(-__expf(-sp - 0.5f)); }
            *(float4*)(DEC + ((size_t)r * 2 + d) * 512 + c) = (float4){o[0], o[1], o[2], o[3]};
        } else if (TYPE == 1) {
            const float4 aa = *(const float4*)(a0 + d * 512 + c), ka0 = *(const float4*)(ka + c), m0 = *(const float4*)(muk + c);
            const float a0v[4] = {aa.x, aa.y, aa.z, aa.w}, kav[4] = {ka0.x, ka0.y, ka0.z, ka0.w}, mm[4] = {m0.x, m0.y, m0.z, m0.w};
            const bool lat = r < SEQ; const int lo = lat ? 0 : SEQ, hi = lat ? SEQ : RPB;
            const bf16_t* zc = ZDb + (size_t)r * ZDW + 512 + c;
            const bool hp = r - 1 >= lo, hn = r + 1 < hi;
            const uint2 uz = *(const uint2*)zc, up = *(const uint2*)(hp ? zc - ZDW : zc), un = *(const uint2*)(hn ? zc + ZDW : zc), uk = *(const uint2*)(KK + (size_t)r * 512 + c);
            const float z[4] = {bflo(uz.x), bfhi(uz.x), bflo(uz.y), bfhi(uz.y)}, zp[4] = {bflo(up.x), bfhi(up.x), bflo(up.y), bfhi(up.y)};
            const float zn[4] = {bflo(un.x), bfhi(un.x), bflo(un.y), bfhi(un.y)}, kk[4] = {bflo(uk.x), bfhi(uk.x), bflo(uk.y), bfhi(uk.y)};
            const float fp = hp ? 0.5f : 0.f, fn = hn ? 0.5f : 0.f;
            float okd[4], obq[4];
#pragma unroll
            for (int e = 0; e < 4; ++e) {
                const float a = sigmoidf_(a0v[e] + v[e]);
                const float k = z[e] + ((fp * zp[e] + fn * zn[e]) - z[e]) * mm[e];
                okd[e] = k * (1.f + (a - 1.f) * kav[e]); obq[e] = kk[e] * a;
            }
            uint2 w1; w1.x = pk2(okd[0], okd[1]); w1.y = pk2(okd[2], okd[3]); *(uint2*)(KD + ((size_t)r * 2 + d) * 512 + c) = w1;
            uint2 w2; w2.x = pk2(obq[0], obq[1]); w2.y = pk2(obq[2], obq[3]); *(uint2*)(BQ + ((size_t)r * 2 + d) * 512 + c) = w2;
        } else {
            uint2 w; w.x = pk2(v[0], v[1]); w.y = pk2(v[2], v[3]); *(uint2*)(G + (size_t)r * 512 + c) = w;
        }
    }
    template <int TYPE>
    __device__ __forceinline__ void all(const f32x4 (&acc)[2][2][4][2], const Unit& u, int wr, int wc, int fr, int fq) const {
        const int d = (u.pn >> 1) & 1, cb = (u.pn & 1) * 256 + wc * 32 + 8 * fq;
#pragma unroll
        for (int ai = 0; ai < 2; ++ai)
#pragma unroll
            for (int m = 0; m < 4; ++m)
#pragma unroll
                for (int bj = 0; bj < 2; ++bj)
                {   const int r = u.pm * BM + ai * HALF + wr * 64 + m * 16 + fr, c = cb + bj * HALF;
                    one<TYPE>(acc[ai][bj][m][0], r, c, d); one<TYPE>(acc[ai][bj][m][1], r, c + 4, d); }
    }
    __device__ __forceinline__ void operator()(const f32x4 (&acc)[2][2][4][2], const Unit& u, int wr, int wc, int fr, int fq) const {
        const int type = u.pn >> 1;
        if (type < 2) all<0>(acc, u, wr, wc, fr, fq); else if (type < 4) all<1>(acc, u, wr, wc, fr, fq); else all<2>(acc, u, wr, wc, fr, fq);
    }
};
}

DEV void transpose_item(const float* W, int K, int N, u16* WT, int mode, float* scr, int item, int lane) {
    const int nblk = N / 32, kb = item / nblk, nb = item - kb * nblk, k0 = 64 * kb, n0 = 32 * nb;
#pragma unroll 8
    for (int i = 0; i < 32; ++i) { const int kk = 2 * i + (lane >> 5); scr[kk * 33 + (lane & 31)] = W[(size_t)(k0 + kk) * N + n0 + (lane & 31)]; }
    asm volatile("s_waitcnt lgkmcnt(0)" ::: "memory");
    const int c = lane & 7;
#pragma unroll
    for (int j = 0; j < 4; ++j) {
        const int n = (lane >> 3) + 8 * j; const float* sp = scr + (8 * c) * 33 + n;
        uint4 o; o.x = pk2(sp[0 * 33], sp[1 * 33]); o.y = pk2(sp[2 * 33], sp[3 * 33]); o.z = pk2(sp[4 * 33], sp[5 * 33]); o.w = pk2(sp[6 * 33], sp[7 * 33]);
        const int ns = n0 + n;
        int drow = ns;
        if (mode) { const int nn = ns >= FFH ? 1 : 0; const int g = ns - nn * FFH; drow = 8 * (g >> 2) + 4 * nn + (g & 3); }
        *(uint4*)(WT + (size_t)drow * K + k0 + 8 * c) = o;
    }
    asm volatile("s_waitcnt lgkmcnt(0)" ::: "memory");
}
constexpr size_t WB_IN = 0, WB_OUT = (size_t)3328 * 1024, WB_F1 = WB_OUT + (size_t)1024 * 1024, WB_F2 = WB_F1 + (size_t)5632 * 1024;
DEV void phase_wprep(PPtr p, int layer, char* lds) {
    const int tid = tidx(), lane = tid & 63, wave = tid >> 6, gw = blockIdx.x * NWAVE + wave, ngw = gridDim.x * NWAVE;
    float* scr = (float*)lds + wave * (64 * 33);
    u16* WB = (u16*)(p->ws + OFF_WB);
    const int li = layer >> 1, odd = layer & 1;
    const int nin = odd ? 3328 : 1536;
    const float* win = odd ? p->in[13] + (size_t)li * DM * 3328 : p->in[8] + (size_t)li * DM * 1536;
    const float* wout = (odd ? p->in[14] : p->in[9]) + (size_t)li * DM * DM;
    const float* wf1 = p->in[27] + (size_t)layer * DM * 5632; const float* wf2 = p->in[28] + (size_t)layer * FFH * DM;
    const int i0 = 16 * (nin / 32), i1 = i0 + 16 * 32, i2 = i1 + 16 * 176, i3 = i2 + 44 * 32;
    for (int it = gw; it < i3; it += ngw) {
        if (it < i0) transpose_item(win, DM, nin, WB + WB_IN, 0, scr, it, lane);
        else if (it < i1) transpose_item(wout, DM, DM, WB + WB_OUT, 0, scr, it - i0, lane);
        else if (it < i2) transpose_item(wf1, DM, 5632, WB + WB_F1, 1, scr, it - i1, lane);
        else transpose_item(wf2, FFH, DM, WB + WB_F2, 0, scr, it - i2, lane);
    }
}

#include <hip/hip_bf16.h>
#include <cmath>
namespace attn_body {
using bf16=__hip_bfloat16;
using bf16x8=__attribute__((ext_vector_type(8)))short;
using s16x4=__attribute__((ext_vector_type(4)))short;
using f32x16=__attribute__((ext_vector_type(16)))float;
using u32x4=__attribute__((ext_vector_type(4)))unsigned;
constexpr int D=64,PQ=1536,PO=1024,KROWS=16640,RPBA=16640;
constexpr int NW=8,QBLK=32,QB=QBLK*NW,KVBLK=64;
constexpr int ATTN_UNIT_ROWS=QB;
__device__ __forceinline__ int crow(int r,int hi){return (r&3)+8*(r>>2)+4*hi;}
#define SBAR() __builtin_amdgcn_sched_barrier(0)
__device__ __forceinline__ void cmask(f32x16&p0,f32x16&p1,int jb,int qrel,int hi){
  const float NEG=-INFINITY; int kb=64*jb+4*hi;
  #pragma unroll
  for(int r=0;r<16;++r){int kv=kb+(r&3)+8*(r>>2); if(kv>qrel)p0[r]=NEG; if(kv+32>qrel)p1[r]=NEG;}
}

constexpr int NSLOT=3, SLOTB=8192;
constexpr int LDS_K=0, LDS_V=NSLOT*SLOTB, LDS_WS=2*NSLOT*SLOTB, LDS_OST=LDS_WS+NW*64*4, LDS_BYTES=LDS_OST+NW*4096;
constexpr float C2=0.125f*1.4426950408889634f;
__device__ __forceinline__ void glds16(const void*gsrc,unsigned lds_dst){unsigned keep;
  asm volatile("s_mov_b32 %0, m0\n\ts_mov_b32 m0, %2\n\ts_nop 0\n\tglobal_load_lds_dwordx4 %1, off\n\ts_mov_b32 m0, %0":"=&s"(keep):"v"(gsrc),"s"(lds_dst):"memory");}
__device__ __forceinline__ float max3f(float a,float b,float c){float r;asm("v_max3_f32 %0, %1, %2, %3":"=v"(r):"v"(a),"v"(b),"v"(c));return r;}
__device__ __forceinline__ float max2f(float a,float b){float r;asm("v_max_f32_e32 %0, %1, %2":"=v"(r):"v"(a),"v"(b));return r;}
__device__ __forceinline__ float fadd_s(float a,float b){float r;asm("v_add_f32_e32 %0, %1, %2":"=v"(r):"v"(a),"v"(b));return r;}
__device__ __forceinline__ float fsub_s(float a,float b){float r;asm("v_sub_f32_e32 %0, %1, %2":"=v"(r):"v"(a),"v"(b));return r;}
typedef float f32x2_t __attribute__((ext_vector_type(2))); typedef __bf16 bf16x2_t __attribute__((ext_vector_type(2)));
__device__ __forceinline__ unsigned cvtpk_s(float lo,float hi){f32x2_t v={lo,hi};bf16x2_t b=__builtin_convertvector(v,bf16x2_t);return __builtin_bit_cast(unsigned,b);}
#define WAIT_BAR(N) asm volatile("s_waitcnt vmcnt(" #N ") lgkmcnt(0)\n\ts_barrier":::"memory")

__device__ __forceinline__ void qkt(f32x16&p0,f32x16&p1,const char*Kslot,const bf16x8*qr,const f32x16&negm,int r32,int hi){
  const char*kb=Kslot+hi*1024+r32*16;
  #pragma unroll
  for(int d0=0;d0<4;++d0){
    const bf16x8 b0=*reinterpret_cast<const bf16x8*>(kb+d0*2048);
    const bf16x8 b1=*reinterpret_cast<const bf16x8*>(kb+d0*2048+512);
    if(d0==0){p0=__builtin_amdgcn_mfma_f32_32x32x16_bf16(b0,qr[0],negm,0,0,0);p1=__builtin_amdgcn_mfma_f32_32x32x16_bf16(b1,qr[0],negm,0,0,0);}
    else{p0=__builtin_amdgcn_mfma_f32_32x32x16_bf16(b0,qr[d0],p0,0,0,0);p1=__builtin_amdgcn_mfma_f32_32x32x16_bf16(b1,qr[d0],p1,0,0,0);}}
}
typedef __attribute__((address_space(3))) const char* lds_cptr;
typedef short v4i16_t __attribute__((ext_vector_type(4)));
__device__ __forceinline__ void kload8(bf16x8*kf,lds_cptr kp){
  kf[0]=*(const __attribute__((address_space(3))) bf16x8*)(kp);      kf[1]=*(const __attribute__((address_space(3))) bf16x8*)(kp+512);
  kf[2]=*(const __attribute__((address_space(3))) bf16x8*)(kp+2048); kf[3]=*(const __attribute__((address_space(3))) bf16x8*)(kp+2560);
  kf[4]=*(const __attribute__((address_space(3))) bf16x8*)(kp+4096); kf[5]=*(const __attribute__((address_space(3))) bf16x8*)(kp+4608);
  kf[6]=*(const __attribute__((address_space(3))) bf16x8*)(kp+6144); kf[7]=*(const __attribute__((address_space(3))) bf16x8*)(kp+6656);
}
__device__ __forceinline__ void kload2(bf16x8*kf,lds_cptr kp,int j){ kf[2*j]=*(const __attribute__((address_space(3))) bf16x8*)(kp+j*2048); kf[2*j+1]=*(const __attribute__((address_space(3))) bf16x8*)(kp+j*2048+512); }
__device__ __forceinline__ s16x4 vtr(lds_cptr p){ return __builtin_bit_cast(s16x4,__builtin_amdgcn_ds_read_tr16_b64_v4i16((__attribute__((address_space(3))) v4i16_t*)p)); }
__device__ __forceinline__ float rowmax(const f32x16&p0,const f32x16&p1){
  float a=max3f(p0[0],p0[1],p1[0]),b=max3f(p0[2],p0[3],p1[1]);a=max3f(a,p1[2],p1[3]);
  #pragma unroll
  for(int r=4;r<16;r+=4){a=max3f(a,p0[r],p0[r+1]);b=max3f(b,p0[r+2],p0[r+3]);a=max3f(a,p1[r],p1[r+1]);b=max3f(b,p1[r+2],p1[r+3]);}
  const float m=max2f(a,b);
  auto rr=__builtin_amdgcn_permlane32_swap(__float_as_uint(m),__float_as_uint(m),false,false);
  return max2f(__uint_as_float(rr[0]),__uint_as_float(rr[1]));
}
__device__ __forceinline__ void pv(f32x16*o,int vb,bf16x8 pa0,bf16x8 pa1,bf16x8 pa2,bf16x8 pa3){
  #pragma unroll
  for(int d0=0;d0<2;++d0){s16x4 lo[4],hi[4];
    #pragma unroll
    for(int ks=0;ks<4;++ks){
      asm volatile("ds_read_b64_tr_b16 %0,%1 offset:%c2":"=&v"(lo[ks]):"v"(vb),"i"(d0*4096+ks*1024):"memory");
      asm volatile("ds_read_b64_tr_b16 %0,%1 offset:%c2":"=&v"(hi[ks]):"v"(vb),"i"(d0*4096+ks*1024+512):"memory");}
    asm volatile("s_waitcnt lgkmcnt(0)":::"memory");SBAR();
    #define PK(k) (bf16x8){lo[k][0],lo[k][1],lo[k][2],lo[k][3],hi[k][0],hi[k][1],hi[k][2],hi[k][3]}
    o[d0]=__builtin_amdgcn_mfma_f32_32x32x16_bf16(pa0,PK(0),o[d0],0,0,0);
    o[d0]=__builtin_amdgcn_mfma_f32_32x32x16_bf16(pa1,PK(1),o[d0],0,0,0);
    o[d0]=__builtin_amdgcn_mfma_f32_32x32x16_bf16(pa2,PK(2),o[d0],0,0,0);
    o[d0]=__builtin_amdgcn_mfma_f32_32x32x16_bf16(pa3,PK(3),o[d0],0,0,0);
    #undef PK
  }
}

#ifndef ATTN_STORE16
#define ATTN_STORE16(p,v) (*(u32x4*)(p)=(v))
#endif
template<int THRL> __device__ __forceinline__ void attn_unit(int b,int h,int qb,const bf16*Q,const bf16*__restrict__ K,const bf16*__restrict__ V,bf16*O,char*shm){
  const int tid=tidx(),lane=tid&63,r32=lane&31,hi=lane>>5; const int wid=__builtin_amdgcn_readfirstlane(tid>>6);
  const long rowbase=(long)b*RPBA; const int q0=qb*QB;
  const bf16*Qw=Q+(rowbase+q0+wid*QBLK)*PQ+h*D;
  const bf16*Kh=K+rowbase*PQ+(h>>2)*D,*Vh=V+rowbase*PQ+(h>>2)*D;
  const unsigned lds0=(unsigned)(uintptr_t)shm;
  float*wsf=(float*)(shm+LDS_WS)+wid*64;
  const bf16*ksrc=Kh+(long)lane*PQ+wid*8;
  const bf16*vsrc=Vh+(long)(16*(wid&3)+(lane>>2))*PQ+(wid>>2)*32+(lane&3)*8;
  const unsigned kdst=lds0+LDS_K+wid*1024, vdst=lds0+LDS_V+wid*1024;
  #define DMA_K(t,slot) glds16(ksrc+(long)(t)*KVBLK*PQ,(unsigned)__builtin_amdgcn_readfirstlane(kdst+(slot)))
  #define DMA_V(t,slot) glds16(vsrc+(long)(t)*KVBLK*PQ,(unsigned)__builtin_amdgcn_readfirstlane(vdst+(slot)))
  const int vb0=(int)(lds0+LDS_V)+((lane>>4)&1)*32+(lane&3)*8+(4*hi+((lane&15)>>2))*64;
  const char*Kbase=shm+LDS_K; bf16x8 kf[8];
  const lds_cptr shm3=(lds_cptr)shm; const lds_cptr kp0=shm3+LDS_K+hi*1024+r32*16; const lds_cptr vp0=shm3+LDS_V+((lane>>4)&1)*32+(lane&3)*8+(4*hi+((lane&15)>>2))*64;
  const int NT=KROWS/KVBLK;
  DMA_K(0,0);DMA_V(0,0);DMA_K(1,SLOTB);
  bf16x8 qr[4];
  #pragma unroll
  for(int d0=0;d0<4;++d0)qr[d0]=*reinterpret_cast<const bf16x8*>(&Qw[(long)r32*PQ+d0*16+hi*8]);
  float mhat=0.f,l_reg=0.f;f32x16 o[2];o[0]=f32x16{};o[1]=f32x16{};f32x16 negm=f32x16{};asm volatile("":"+v"(negm));
  const int qrel=wid*QBLK+r32;
  #define CMASK(P0,P1,t) do{}while(0)
  bool resc=false;
  #define START(P0,P1) do{ const float rm=rowmax(P0,P1); resc=false; \
    { const float dl=rm; mhat=fadd_s(mhat,dl); \
      _Pragma("unroll") for(int r=0;r<16;++r){P0[r]=fsub_s(P0[r],dl);P1[r]=fsub_s(P1[r],dl);} \
      _Pragma("unroll") for(int r=0;r<16;++r)negm[r]=-mhat; asm volatile("":"+v"(negm)); } \
    _Pragma("unroll") for(int r=0;r<16;++r)P0[r]=__builtin_amdgcn_exp2f(P0[r]); }while(0)
  #define RESC() do{ if(resc){ asm volatile("s_waitcnt lgkmcnt(0)":::"memory"); \
      _Pragma("unroll") for(int d_=0;d_<2;++d_) _Pragma("unroll") for(int r=0;r<16;++r)o[d_][r]*=wsf[crow(r,hi)]; } }while(0)
  f32x16 pA0,pA1,pB0,pB1;
  int sl_prev=0,sl_cur=0,sl_next=SLOTB;
  #define ROT() do{sl_prev=sl_cur;sl_cur=sl_next;sl_next=(sl_next==(NSLOT-1)*SLOTB)?0:sl_next+SLOTB;}while(0)
  DMA_K(2,2*SLOTB);
  WAIT_BAR(3);
  qkt(pA0,pA1,Kbase,qr,negm,r32,hi);asm volatile("s_nop 15\n\ts_nop 7":"+v"(pA0),"+v"(pA1));CMASK(pA0,pA1,0);
  START(pA0,pA1);
  _Pragma("unroll") for(int r=0;r<16;++r)pA1[r]=__builtin_amdgcn_exp2f(pA1[r]);
  WAIT_BAR(0);
  DMA_K(3,0);DMA_V(1,SLOTB);
  ROT();
  kload8(kf,kp0+sl_cur);
  WAIT_BAR(2);
  s16x4 vlo[8],vhi[8]; u32x4 pw0,pw1,pw2,pw3;
  #define PKW(P,B) cvtpk_s(P[B],P[B+1])
  #define PAF(k) __builtin_bit_cast(bf16x8,pw##k)
  #define VFR(i) (bf16x8){vlo[i][0],vlo[i][1],vlo[i][2],vlo[i][3],vhi[i][0],vhi[i][1],vhi[i][2],vhi[i][3]}
  #define PIN(x) asm volatile("":"+v"(x))
  #define MX3(a,b,c) __builtin_fmaxf(__builtin_fmaxf((a),(b)),(c))
  #define GAPA(MF,A0,A1,A2,A3,W0,W1,PW) do{ MF; sacc+=A0; sacc+=A1; sacc+=A2; sacc+=A3; PIN(sacc); W0; W1; PIN(PW); SBAR(); }while(0)
  #define EX(v) __builtin_amdgcn_exp2f(v)
  #define GAPB(MF,X,B) do{ MF; X[B]=EX(X[B]); X[B+1]=EX(X[B+1]); X[B+2]=EX(X[B+2]); X[B+3]=EX(X[B+3]); PIN(X); SBAR(); }while(0)
  #define VRD(i) do{ vlo[i]=vtr(vp_+(((i)>>2)*4096+((i)&3)*1024)); vhi[i]=vtr(vp_+(((i)>>2)*4096+((i)&3)*1024+512)); }while(0)
  #define KRD(G,j) do{ if(G){ kload2(kf,kp0+sl_next,j); SBAR(); } }while(0)
  #define STEP(C0,C1,P0,P1,t,GK,GV,GL) do{ SBAR(); \
    const lds_cptr vp_=vp0+sl_prev; \
    VRD(0); SBAR(); float sacc=(P0[0]+P0[1]); \
    GAPA(C0=__builtin_amdgcn_mfma_f32_32x32x16_bf16(kf[0],qr[0],negm,0,0,0), P0[2],P0[3],P0[4],P0[5],     pw0[0]=PKW(P0,0), pw0[1]=PKW(P0,2), pw0); \
    VRD(4); SBAR(); GAPA(C1=__builtin_amdgcn_mfma_f32_32x32x16_bf16(kf[1],qr[0],negm,0,0,0), P0[6],P0[7],P0[8],P0[9],     pw0[2]=PKW(P0,4), pw0[3]=PKW(P0,6), pw0); \
    VRD(1); SBAR(); GAPA(C0=__builtin_amdgcn_mfma_f32_32x32x16_bf16(kf[2],qr[1],C0,0,0,0),   P0[10],P0[11],P0[12],P0[13], pw1[0]=PKW(P0,8), pw1[1]=PKW(P0,10), pw1); \
    VRD(5); SBAR(); GAPA(C1=__builtin_amdgcn_mfma_f32_32x32x16_bf16(kf[3],qr[1],C1,0,0,0),   P0[14],P0[15],P1[0],P1[1],   pw1[2]=PKW(P0,12),pw1[3]=PKW(P0,14), pw1); \
    VRD(2); SBAR(); GAPA(C0=__builtin_amdgcn_mfma_f32_32x32x16_bf16(kf[4],qr[2],C0,0,0,0),   P1[2],P1[3],P1[4],P1[5],     pw2[0]=PKW(P1,0), pw2[1]=PKW(P1,2), pw2); \
    VRD(6); SBAR(); GAPA(C1=__builtin_amdgcn_mfma_f32_32x32x16_bf16(kf[5],qr[2],C1,0,0,0),   P1[6],P1[7],P1[8],P1[9],     pw2[2]=PKW(P1,4), pw2[3]=PKW(P1,6), pw2); \
    VRD(3); SBAR(); GAPA(C0=__builtin_amdgcn_mfma_f32_32x32x16_bf16(kf[6],qr[3],C0,0,0,0),   P1[10],P1[11],P1[12],P1[13], pw3[0]=PKW(P1,8), pw3[1]=PKW(P1,10), pw3); \
    VRD(7); SBAR(); GAPA(C1=__builtin_amdgcn_mfma_f32_32x32x16_bf16(kf[7],qr[3],C1,0,0,0),   P1[14],P1[15],0.f,0.f,       pw3[2]=PKW(P1,12),pw3[3]=PKW(P1,14), pw3); \
    l_reg+=sacc; \
    if(GK){DMA_K((t)+3,sl_cur);} if(GV){DMA_V((t)+1,sl_next);} \
    CMASK(C0,C1,t); \
    { float a=MX3(C0[0],C0[1],C1[0]),b=MX3(C0[2],C0[3],C1[1]); a=MX3(a,C1[2],C1[3]); \
      _Pragma("unroll") for(int r=4;r<16;r+=4){a=MX3(a,C0[r],C0[r+1]);b=MX3(b,C0[r+2],C0[r+3]);a=MX3(a,C1[r],C1[r+1]);b=MX3(b,C1[r+2],C1[r+3]);} \
      float rm=__builtin_fmaxf(a,b); { auto rr=__builtin_amdgcn_permlane32_swap(__float_as_uint(rm),__float_as_uint(rm),false,false); rm=__builtin_fmaxf(__uint_as_float(rr[0]),__uint_as_float(rr[1])); } \
      resc=false; \
      if(__builtin_expect(__any(rm>(float)THRL),0)){ const float dl=__builtin_fmaxf(rm,0.f); mhat+=dl; \
        _Pragma("unroll") for(int r=0;r<16;++r){C0[r]-=dl;C1[r]-=dl;} \
        _Pragma("unroll") for(int r=0;r<16;++r)negm[r]=-mhat; asm volatile("":"+v"(negm)); \
        const float f=__builtin_amdgcn_exp2f(-dl); l_reg*=f; if(hi==0)wsf[r32]=f; resc=true; } } \
    SBAR(); \
    GAPB(o[0]=__builtin_amdgcn_mfma_f32_32x32x16_bf16(PAF(0),VFR(0),o[0],0,0,0), C0,0); \
    GAPB(o[1]=__builtin_amdgcn_mfma_f32_32x32x16_bf16(PAF(0),VFR(4),o[1],0,0,0), C0,4); \
    KRD(GL,0); GAPB(o[0]=__builtin_amdgcn_mfma_f32_32x32x16_bf16(PAF(1),VFR(1),o[0],0,0,0), C0,8); \
    KRD(GL,1); GAPB(o[1]=__builtin_amdgcn_mfma_f32_32x32x16_bf16(PAF(1),VFR(5),o[1],0,0,0), C0,12); \
    KRD(GL,2); GAPB(o[0]=__builtin_amdgcn_mfma_f32_32x32x16_bf16(PAF(2),VFR(2),o[0],0,0,0), C1,0); \
    KRD(GL,3); GAPB(o[1]=__builtin_amdgcn_mfma_f32_32x32x16_bf16(PAF(2),VFR(6),o[1],0,0,0), C1,4); \
    GAPB(o[0]=__builtin_amdgcn_mfma_f32_32x32x16_bf16(PAF(3),VFR(3),o[0],0,0,0), C1,8); \
    GAPB(o[1]=__builtin_amdgcn_mfma_f32_32x32x16_bf16(PAF(3),VFR(7),o[1],0,0,0), C1,12); \
    }while(0)
  int t=1;
  #undef CMASK
  #define CMASK(P0,P1,t) do{}while(0)
  for(;t+5<NT;t+=2){
    STEP(pB0,pB1,pA0,pA1,t,true,true,true);     WAIT_BAR(2); RESC(); ROT();
    STEP(pA0,pA1,pB0,pB1,t+1,true,true,true);   WAIT_BAR(2); RESC(); ROT();
  }
  #undef CMASK
  #define CMASK(P0,P1,t) do{}while(0)
  #define ENDW(tt) do{ if((tt)+3<NT){WAIT_BAR(2);} else if((tt)+2<NT){WAIT_BAR(1);} else {WAIT_BAR(0);} }while(0)
  for(;t+1<NT;t+=2){
    STEP(pB0,pB1,pA0,pA1,t,(t+3<NT),(t+1<NT),(t+1<NT));       ENDW(t);   RESC(); ROT();
    STEP(pA0,pA1,pB0,pB1,t+1,(t+4<NT),(t+2<NT),(t+2<NT));     ENDW(t+1); RESC(); ROT();
  }
  STEP(pB0,pB1,pA0,pA1,NT-1,false,false,false); RESC();
  { float sacc=pB0[0]+pB0[1]; _Pragma("unroll") for(int r=2;r<16;++r)sacc+=pB0[r]; _Pragma("unroll") for(int r=0;r<16;++r)sacc+=pB1[r]; l_reg+=sacc;
    pw0=(u32x4){PKW(pB0,0),PKW(pB0,2),PKW(pB0,4),PKW(pB0,6)};pw1=(u32x4){PKW(pB0,8),PKW(pB0,10),PKW(pB0,12),PKW(pB0,14)};pw2=(u32x4){PKW(pB1,0),PKW(pB1,2),PKW(pB1,4),PKW(pB1,6)};pw3=(u32x4){PKW(pB1,8),PKW(pB1,10),PKW(pB1,12),PKW(pB1,14)};
    SBAR(); pv(o,vb0+sl_cur,PAF(0),PAF(1),PAF(2),PAF(3)); }
  #undef PKW
  #undef PAF
  #undef VFR
  #undef PIN
  #undef MX3
  #undef GAPA
  #undef GAPB
  #undef EX
  #undef VRD
  #undef KRD
  #undef STEP
  #undef ENDW
  {auto rr=__builtin_amdgcn_permlane32_swap(__float_as_uint(l_reg),__float_as_uint(l_reg),false,false);l_reg=__uint_as_float(rr[0])+__uint_as_float(rr[1]);}
  if(hi==0)wsf[32+r32]=l_reg;asm volatile("s_waitcnt lgkmcnt(0)":::"memory");
  float rli[16];
  #pragma unroll
  for(int r=0;r<16;++r)rli[r]=__builtin_amdgcn_rcpf(wsf[32+crow(r,hi)]);
  bf16*Ow=O+(rowbase+q0+wid*QBLK)*PO+h*D;
  { bf16*stg=(bf16*)(shm+LDS_OST)+wid*2048;
    #pragma unroll
    for(int r=0;r<16;++r){const int orow=crow(r,hi);
      #pragma unroll
      for(int d0=0;d0<2;++d0)stg[orow*64+d0*32+r32]=__float2bfloat16(o[d0][r]*rli[r]);}
    asm volatile("s_waitcnt lgkmcnt(0)":::"memory");
    #pragma unroll
    for(int i=0;i<4;++i){const int row=i*8+(lane>>3),ch=lane&7; const u32x4 v=*(const u32x4*)(stg+row*64+ch*8); ATTN_STORE16(Ow+(long)row*PO+ch*8,v);} }
  asm volatile("s_waitcnt lgkmcnt(0)\n\ts_barrier":::"memory");
  #undef DMA_K
  #undef DMA_V
  #undef CMASK
  #undef START
  #undef RESC
  #undef ROT
}
constexpr int ATTN_LDS_BYTES=LDS_BYTES;
#undef SBAR
#undef WAIT_BAR
}

DEV void phase_even_post(PPtr p, int li) {
    const int tid = tidx(), lane = tid & 63, gw = blockIdx.x * NWAVE + (tid >> 6), ngw = gridDim.x * NWAVE;
    u16* RAW = (u16*)(p->ws + OFF_RAW);
    const float* qg = p->in[10] + li * 64; const float* kg = p->in[11] + li * 64;
    const float* T = (const float*)(p->ws + OFF_ROPE);
    const int w8 = (lane & 7) * 8, i0 = w8 & 31; const bool second = (lane & 4) != 0;
    for (int item = gw; item < MROWS * 3; item += ngw) {
        const int m = item / 3, pass = item - 3 * m;
        if (pass == 2 && lane >= 32) continue;
        const int b = m / RPB, q = m - b * RPB;
        const int sl = pass * 8 + (lane >> 3);
        const int c0 = sl < 8 ? sl * 64 : sl < 10 ? 512 + (sl - 8) * 64 : sl < 18 ? 768 + (sl - 10) * 64 : 1280 + (sl - 18) * 64;
        u16* ptr = RAW + (size_t)m * 1536 + c0 + w8;
        float x[8]; unpack8(*(const uint4*)ptr, x);
        if (sl < 10) {
            const float* gn = (sl < 8 ? qg : kg) + w8;
            float ss = 0.f;
#pragma unroll
            for (int e = 0; e < 8; ++e) ss += x[e] * x[e];
            ss += __shfl_xor(ss, 1); ss += __shfl_xor(ss, 2); ss += __shfl_xor(ss, 4);
            const float rs = rsqrtf(ss * (1.f / 64.f) + 1e-6f);
            const float4 g0 = *(const float4*)gn, g1 = *(const float4*)(gn + 4);
            x[0] *= rs * g0.x; x[1] *= rs * g0.y; x[2] *= rs * g0.z; x[3] *= rs * g0.w; x[4] *= rs * g1.x; x[5] *= rs * g1.y; x[6] *= rs * g1.z; x[7] *= rs * g1.w;
        }
        if (q < SEQ) {
            const float* ct = (i0 < 16) ? T + (q >> 6) * 16 + i0 : T + 8192 + (q & 63) * 16 + (i0 - 16);
            const float* st = ct + ((i0 < 16) ? 4096 : 1024);
            const float4 c0v = *(const float4*)ct, c1v = *(const float4*)(ct + 4), s0v = *(const float4*)st, s1v = *(const float4*)(st + 4);
            const float cs[8] = {c0v.x, c0v.y, c0v.z, c0v.w, c1v.x, c1v.y, c1v.z, c1v.w}, sn[8] = {s0v.x, s0v.y, s0v.z, s0v.w, s1v.x, s1v.y, s1v.z, s1v.w};
            const float sc = (sl < 8) ? attn_body::C2 : 1.f;
#pragma unroll
            for (int e = 0; e < 8; ++e) {
                const float other = __shfl_xor(x[e], 4);
                const float o = second ? (other * sn[e] + x[e] * cs[e]) : (x[e] * cs[e] - other * sn[e]);
                x[e] = o * sc;
            }
        }
        *(uint4*)ptr = pack8(x);
    }
}

template <int mode, bool qctx>
DEV void attn_wave(const u16* QB, int pitch, int qcol, int kcol, int vcol, u16* AO, int ocol,
                   int b, int hk, int blk, const float* sinkp, const float* rpb, u16* sV) {
    const int lane = tidx() & 63, qi = lane & 15, quad = lane >> 4;
    const bool gqa = mode < 2;
    const size_t rowb = (size_t)b * RPB;
    const float SCL = 0.125f * LOG2E;
    int qtok[4], qhead[4]; bf16x8 qf[4][2];
#pragma unroll
    for (int i = 0; i < 4; ++i) {
        qtok[i] = gqa ? blk * 16 + qi : blk * 64 + i * 16 + qi; qhead[i] = gqa ? hk * 4 + i : hk;
        const size_t m = rowb + (qctx ? SEQ : 0) + qtok[i];
        const u16* qp = QB + m * pitch + qcol + qhead[i] * 64 + quad * 8;
        qf[i][0] = *(const bf16x8*)qp; qf[i][1] = *(const bf16x8*)(qp + 32);
    }
    f32x4 o[4][4]; float mrun[4], lrun[4];
#pragma unroll
    for (int i = 0; i < 4; ++i) {
#pragma unroll
        for (int d = 0; d < 4; ++d) o[i][d] = (f32x4){0.f, 0.f, 0.f, 0.f};
        if (mode == 1) { mrun[i] = sinkp[qhead[i]] * LOG2E; lrun[i] = (quad == 0) ? 1.f : 0.f; } else { mrun[i] = -1e30f; lrun[i] = 0.f; }
    }
    const u16* Kb = QB + kcol + hk * 64; const u16* Vb = QB + vcol + hk * 64;
    int n_local, ustart, rs = 0;
    if (qctx) { n_local = 0; ustart = 0; }
    else if (mode == 0) { n_local = RPB / 32; ustart = 0; }
    else if (mode == 1) { n_local = 9; ustart = blk * 16 - 128; }
    else { rs = min(max(blk - 4, 0), 248); n_local = 16; ustart = rs * 64; }
    const int n_ctx = (mode == 0 && !qctx) ? 0 : 8;
    for (int tt = 0; tt < n_local + n_ctx; ++tt) {
        const bool loc = tt < n_local;
        const int u0 = loc ? ustart + 32 * tt : SEQ + 32 * (tt - n_local);
        const bool masked = loc && mode != 0;
        bf16x8 kf[2][2];
#pragma unroll
        for (int kt = 0; kt < 2; ++kt) {
            const int u = min(max(u0 + kt * 16 + qi, 0), RPB - 1);
            const u16* kp = Kb + (rowb + u) * pitch + quad * 8;
            kf[kt][0] = *(const bf16x8*)kp; kf[kt][1] = *(const bf16x8*)(kp + 32);
        }
#pragma unroll
        for (int c = 0; c < 4; ++c) {
            const int idx = c * 64 + lane, key = idx >> 3, dc = idx & 7;
            const int u = min(max(u0 + key, 0), RPB - 1);
            const uint4 v = *(const uint4*)(Vb + (rowb + u) * pitch + dc * 8);
            *(uint4*)(sV + key * 72 + dc * 8) = v;
        }
        bf16x8 vf[4];
#pragma unroll
        for (int dt = 0; dt < 4; ++dt)
#pragma unroll
            for (int jj = 0; jj < 8; ++jj) {
                const int key = (jj < 4) ? quad * 4 + jj : 16 + quad * 4 + (jj - 4);
                vf[dt][jj] = (short)sV[key * 72 + dt * 16 + qi];
            }
#pragma unroll
        for (int i = 0; i < 4; ++i) {
            f32x4 s0 = (f32x4){0.f, 0.f, 0.f, 0.f}, s1 = (f32x4){0.f, 0.f, 0.f, 0.f};
            s0 = __builtin_amdgcn_mfma_f32_16x16x32_bf16(kf[0][0], qf[i][0], s0, 0, 0, 0);
            s0 = __builtin_amdgcn_mfma_f32_16x16x32_bf16(kf[0][1], qf[i][1], s0, 0, 0, 0);
            s1 = __builtin_amdgcn_mfma_f32_16x16x32_bf16(kf[1][0], qf[i][0], s1, 0, 0, 0);
            s1 = __builtin_amdgcn_mfma_f32_16x16x32_bf16(kf[1][1], qf[i][1], s1, 0, 0, 0);
            float sc[8];
#pragma unroll
            for (int j = 0; j < 4; ++j) { sc[j] = s0[j] * SCL; sc[4 + j] = s1[j] * SCL; }
            if (masked) {
                const int t = qtok[i];
#pragma unroll
                for (int e = 0; e < 8; ++e) {
                    const int u = u0 + (e >> 2) * 16 + quad * 4 + (e & 3);
                    if (mode == 1) {
                        const int dd = t - u;
                        const bool ok = (u >= 0) && (u < SEQ) && (dd <= 128) && (dd >= -128);
                        if (!ok) sc[e] = -INFINITY;
                    } else {
                        const int c = t & 63, r = t >> 6, ur = u >> 6, uc = u & 63;
                        const int cst = min(max(c - 8, 0), 48);
                        const bool ok = (uc >= cst) && (uc < cst + 16);
                        const int dr = min(max(ur - r + 7, 0), 14), dcx = min(max(uc - c + 15, 0), 30);
                        const float bias = rpb[(qhead[i] * 15 + dr) * 31 + dcx];
                        sc[e] = ok ? sc[e] + bias * LOG2E : -INFINITY;
                    }
                }
            }
            float mx = fmaxf(fmaxf(fmaxf(sc[0], sc[1]), fmaxf(sc[2], sc[3])), fmaxf(fmaxf(sc[4], sc[5]), fmaxf(sc[6], sc[7])));
            mx = fmaxf(mx, __shfl_xor(mx, 16)); mx = fmaxf(mx, __shfl_xor(mx, 32));
            const float mn = fmaxf(mrun[i], mx);
            const float al = __builtin_amdgcn_exp2f(mrun[i] - mn);
            mrun[i] = mn;
            float pe[8], ps = 0.f;
#pragma unroll
            for (int e = 0; e < 8; ++e) { pe[e] = __builtin_amdgcn_exp2f(sc[e] - mn); ps += pe[e]; }
            lrun[i] = lrun[i] * al + ps;
            union { unsigned u[4]; bf16x8 v; } pf;
            pf.u[0] = pk2(pe[0], pe[1]); pf.u[1] = pk2(pe[2], pe[3]); pf.u[2] = pk2(pe[4], pe[5]); pf.u[3] = pk2(pe[6], pe[7]);
#pragma unroll
            for (int dt = 0; dt < 4; ++dt) {
                o[i][dt] = o[i][dt] * al;
                o[i][dt] = __builtin_amdgcn_mfma_f32_16x16x32_bf16(vf[dt], pf.v, o[i][dt], 0, 0, 0);
            }
        }
    }
#pragma unroll
    for (int i = 0; i < 4; ++i) {
        float l = lrun[i]; l += __shfl_xor(l, 16); l += __shfl_xor(l, 32);
        const float inv = 1.f / l;
        const size_t m = rowb + (qctx ? SEQ : 0) + qtok[i];
        u16* op = AO + m * DM + ocol + qhead[i] * 64 + quad * 4;
#pragma unroll
        for (int dt = 0; dt < 4; ++dt) {
            uint2 w; w.x = pk2(o[i][dt][0] * inv, o[i][dt][1] * inv); w.y = pk2(o[i][dt][2] * inv, o[i][dt][3] * inv);
            *(uint2*)(op + dt * 16) = w;
        }
    }
}

DEV void phase_attn_even(PPtr p, int li, char* lds) {
    {
        const attn_body::bf16* RAWb = (const attn_body::bf16*)(p->ws + OFF_RAW); attn_body::bf16* AOb = (attn_body::bf16*)(p->ws + OFF_AO);
        const int G = gridDim.x, bx = blockIdx.x;
        if (G == 256) {
            const int vcu = (bx & 7) * 32 + (bx >> 3); const int x = vcu >> 5, combo = x >> 1, sub = (x & 1) * 32 + (vcu & 31);
            for (int i = 0; i < 4; ++i) attn_body::attn_unit<8>(combo >> 1, (combo & 1) * 4 + i, sub, RAWb, RAWb + 512, RAWb + 640, AOb, lds);
        } else {
            for (int u = bx; u < 1024; u += G) attn_body::attn_unit<8>(u >> 9, (u >> 6) & 7, u & 63, RAWb, RAWb + 512, RAWb + 640, AOb, lds);
        }
    }
    const int wave = tidx() >> 6, gw = blockIdx.x * NWAVE + wave, ngw = gridDim.x * NWAVE;
    u16* sV = (u16*)lds + wave * (32 * 72);
    const u16* RAW = (const u16*)(p->ws + OFF_RAW); u16* AO = (u16*)(p->ws + OFF_AO);
    const float* sink = p->in[12] + li * 8;
    for (int t = gw; t < 4224; t += ngw) {
        if (t < 4096) attn_wave<1, false>(RAW, 1536, 768, 1280, 1408, AO, 512, t >> 11, (t >> 10) & 1, t & 1023, sink, nullptr, sV);
        else if (t < 4160) { const int u = t - 4096; attn_wave<0, true>(RAW, 1536, 0, 512, 640, AO, 0, u >> 5, (u >> 4) & 1, u & 15, nullptr, nullptr, sV); }
        else { const int u = t - 4160; attn_wave<1, true>(RAW, 1536, 768, 1280, 1408, AO, 512, u >> 5, (u >> 4) & 1, u & 15, sink, nullptr, sV); }
    }
}
DEV void phase_attn_odd(PPtr p, int li, char* lds) {
    const int wave = tidx() >> 6, gw = blockIdx.x * NWAVE + wave, ngw = gridDim.x * NWAVE;
    u16* sV = (u16*)lds + wave * (32 * 72);
    const u16* QKV = (const u16*)(p->ws + OFF_RAW); u16* AO = (u16*)(p->ws + OFF_AO);
    const float* rpb = p->in[15] + li * 8 * 15 * 31;
    for (int t = gw; t < 4160; t += ngw) {
        if (t < 4096) attn_wave<2, false>(QKV, 1536, 0, 512, 1024, AO, 0, t >> 11, (t >> 8) & 7, t & 255, nullptr, rpb, sV);
        else { const int u = t - 4096; attn_wave<2, true>(QKV, 1536, 0, 512, 1024, AO, 0, u >> 5, (u >> 2) & 7, u & 3, nullptr, rpb, sV); }
    }
}

DEV float shiftmix_at(const u16* ZDb, int pp, int ch, float mu) {
    const bool lat = pp < SEQ; const int lo = lat ? 0 : SEQ, hi = lat ? SEQ : RPB;
    const u16* zc = ZDb + (size_t)pp * ZDW + ch;
    const float z = bf2f(zc[0]);
    const float a = (pp - 1 >= lo) ? bf2f(zc[-ZDW]) : 0.f, c = (pp + 1 < hi) ? bf2f(zc[ZDW]) : 0.f;
    return z + (0.5f * (a + c) - z) * mu;
}
DEV void phase_rwkv_prep(PPtr p, int li, int bb) {
    const int tid = tidx(), lane = tid & 63, gw = blockIdx.x * NWAVE + (tid >> 6), ngw = gridDim.x * NWAVE;
    const u16* ZDb = (const u16*)(p->ws + OFF_ZD) + (size_t)bb * RPB * ZDW;
    const float* mu = p->in[16] + li * ZDW; const float* kkw = p->in[22] + li * 512;
    u16* R = (u16*)(p->ws + OFF_R); u16* KK = (u16*)(p->ws + OFF_KK); u16* V = (u16*)(p->ws + OFF_V); u16* LA = (u16*)(p->ws + OFF_LA);
    {
        u16* LB = (u16*)(p->ws + OFF_PU);
        const float* w2 = p->in[18] + (size_t)li * 2 * 64 * 512; const float* a2 = p->in[20] + (size_t)li * 2 * 64 * 512; const float* g2 = p->in[21] + (size_t)li * 128 * 512;
        for (int idx = gw * 64 + lane; idx < 2560 * 32; idx += ngw * 64) {
            const int n = idx >> 5, kc = (idx & 31) * 8, type = n >> 9, nn = n & 511;
            float f[8];
#pragma unroll
            for (int e = 0; e < 8; ++e) {
                const int k = kc + e; float x = 0.f;
                if (type < 2) { if (k < 64) x = w2[((size_t)type * 64 + k) * 512 + nn]; }
                else if (type < 4) { if (k >= 64 && k < 128) x = a2[((size_t)(type - 2) * 64 + (k - 64)) * 512 + nn]; }
                else { if (k >= 128) x = g2[(size_t)(k - 128) * 512 + nn]; }
                f[e] = x;
            }
            *(uint4*)(LB + (size_t)n * 256 + kc) = pack8(f);
        }
    }
    {
        float4* Yz = (float4*)(p->ws + OFF_Y0); const float4 z = {0.f, 0.f, 0.f, 0.f};
        for (size_t i = (size_t)gw * 64 + lane; i < (size_t)RPB * 512 / 4; i += (size_t)ngw * 64) Yz[i] = z;
    }
    for (int pp = gw; pp < RPB; pp += ngw) {
        const bool lat = pp < SEQ; const int lo = lat ? 0 : SEQ, hi = lat ? SEQ : RPB;
        const bool hp = pp - 1 >= lo, hn = pp + 1 < hi;
        const u16* zc = ZDb + (size_t)pp * ZDW;
#pragma unroll
        for (int j = 0; j < 4; ++j) {
            const int c8 = lane + 64 * j;
            if (j == 3 && lane >= 32) break;
            const int ch = 8 * c8;
            float z[8], a[8], c[8], zs[8];
            unpack8(*(const uint4*)(zc + ch), z);
            if (hp) unpack8(*(const uint4*)(zc - ZDW + ch), a); else { for (int e = 0; e < 8; ++e) a[e] = 0.f; }
            if (hn) unpack8(*(const uint4*)(zc + ZDW + ch), c); else { for (int e = 0; e < 8; ++e) c[e] = 0.f; }
            const float4 m0 = *(const float4*)(mu + ch), m1 = *(const float4*)(mu + ch + 4);
            const float mm[8] = {m0.x, m0.y, m0.z, m0.w, m1.x, m1.y, m1.z, m1.w};
#pragma unroll
            for (int e = 0; e < 8; ++e) zs[e] = z[e] + (0.5f * (a[e] + c[e]) - z[e]) * mm[e];
            if (j == 0) *(uint4*)(R + (size_t)pp * 512 + ch) = pack8(zs);
            else if (j == 1) {
                const float4 k0 = *(const float4*)(kkw + ch - 512), k1 = *(const float4*)(kkw + ch - 512 + 4);
                const float kw[8] = {k0.x, k0.y, k0.z, k0.w, k1.x, k1.y, k1.z, k1.w};
                float t[8], ss = 0.f;
#pragma unroll
                for (int e = 0; e < 8; ++e) { t[e] = zs[e] * kw[e]; ss += t[e] * t[e]; }
                ss += __shfl_xor(ss, 1); ss += __shfl_xor(ss, 2); ss += __shfl_xor(ss, 4);
                const float inv = 1.f / fmaxf(sqrtf(ss), 1e-12f);
#pragma unroll
                for (int e = 0; e < 8; ++e) t[e] *= inv;
                *(uint4*)(KK + (size_t)pp * 512 + ch - 512) = pack8(t);
            } else if (j == 2) *(uint4*)(V + (size_t)pp * 512 + ch - 1024) = pack8(zs);
            else {
                float o[8];
#pragma unroll
                for (int e = 0; e < 8; ++e) o[e] = (lane < 8) ? tanhf(zs[e]) : (lane < 16) ? zs[e] : sigmoidf_(zs[e]);
                *(uint4*)(LA + (size_t)pp * 256 + ch - 1536) = pack8(o);
            }
        }
    }
}
struct EpiDecay { float* DEC; const float* w0; int d;
    DEV void operator()(int r, int c, float v, float) const {
        const float x = -(w0[c] + v); const float sp = x > 20.f ? x : log1pf(expf(x)); const float w = -sp - 0.5f;
        DEC[((size_t)r * 2 + d) * 512 + c] = expf(-expf(w)); } };
struct EpiIclr { u16* KD; u16* BQ; const u16* KK; const u16* ZDb; const float* a0; const float* ka; const float* muk; int d;
    DEV void operator()(int r, int c, float v, float) const {
        const float a = sigmoidf_(a0[c] + v);
        const float k = shiftmix_at(ZDb, r, 512 + c, muk[c]);
        KD[((size_t)r * 2 + d) * 512 + c] = (u16)f2bf(k * (1.f + (a - 1.f) * ka[c]));
        BQ[((size_t)r * 2 + d) * 512 + c] = (u16)f2bf(bf2f(KK[(size_t)r * 512 + c]) * a); } };
struct EpiGate { u16* G; DEV void operator()(int r, int c, float v, float) const { G[(size_t)r * 512 + c] = (u16)f2bf(v); } };

DEV int pos_to_pp(int s, int d) { return (s < NCTX) ? (d ? SEQ + NCTX - 1 - s : SEQ + s) : (d ? SEQ - 1 - (s - NCTX) : s - NCTX); }
struct StepV { float d; unsigned a; unsigned b; float v; };
DEV StepV load_step(const float* DEC, const u16* KD, const u16* BQ, const u16* KK, const u16* R, const u16* V, int pp, int h, int d, int lane) {
    const size_t e1 = (size_t)pp * 512 + h * 64, e2 = ((size_t)pp * 2 + d) * 512 + h * 64;
    StepV s;
    s.d = DEC[e2 + lane];
    s.a = (lane < 32) ? ((const unsigned*)(KD + e2))[lane] : ((const unsigned*)(BQ + e2))[lane - 32];
    s.b = (lane < 32) ? ((const unsigned*)(KK + e1))[lane] : ((const unsigned*)(R + e1))[lane - 32];
    s.v = bf2f(V[e1 + lane]);
    return s;
}
typedef float f32x2 __attribute__((ext_vector_type(2)));
constexpr int SSLOT = 320;
typedef __attribute__((address_space(3))) float* ldsf;
typedef const __attribute__((address_space(3))) f32x4* lds4;
DEV void stage_step(ldsf slot, const StepV& s, int lane) {
    slot[lane] = s.d;
    *(__attribute__((address_space(3))) f32x2*)(slot + 64 + 2 * lane) = (f32x2){bflo(s.a), bfhi(s.a)};
    *(__attribute__((address_space(3))) f32x2*)(slot + 192 + 2 * lane) = (f32x2){bflo(s.b), bfhi(s.b)};
}
#define LO2(v) ((f32x2){(v)[0], (v)[1]})
#define HI2(v) ((f32x2){(v)[2], (v)[3]})
template <int MODE>
DEV float scan_step(f32x2 (&S)[32], ldsf sl, float vv) {
    lds4 D = (lds4)sl;
    f32x2 sa = {0.f, 0.f}, sb = {0.f, 0.f};
#pragma unroll
    for (int q = 0; q < 16; ++q) { const f32x4 k4 = D[48 + q]; sa += S[2 * q] * LO2(k4); sb += S[2 * q + 1] * HI2(k4);
        if ((q & 3) == 3) asm volatile("" : "+v"(D), "+v"(sa), "+v"(sb)); }
    const float nsa = -((sa[0] + sa[1]) + (sb[0] + sb[1]));
    const f32x2 nsa2 = {nsa, nsa}, vv2 = {vv, vv};
    f32x2 y = {0.f, 0.f}, z = {0.f, 0.f};
#pragma unroll
    for (int q = 0; q < 16; ++q) {
        const f32x4 d4 = D[q], b4 = D[32 + q];
        f32x2 t0 = nsa2 * LO2(b4), t1 = nsa2 * HI2(b4);
        if (MODE >= 1) { const f32x4 kd4 = D[16 + q]; t0 += vv2 * LO2(kd4); t1 += vv2 * HI2(kd4); }
        S[2 * q] = S[2 * q] * LO2(d4) + t0; S[2 * q + 1] = S[2 * q + 1] * HI2(d4) + t1;
        if (MODE == 2) { const f32x4 r4 = D[64 + q]; y += S[2 * q] * LO2(r4); z += S[2 * q + 1] * HI2(r4); }
        else y += S[2 * q + 1];
        if ((q & 1) == 1) asm volatile("" : "+v"(D), "+v"(y), "+v"(z), "+v"(S[2 * q + 1]));
    }
    return (y[0] + y[1]) + (z[0] + z[1]);
}
template <int WHICH>
DEV void scan1_pass(PPtr p, char* lds) {
    const int tid = tidx(), lane = tid & 63, wv = __builtin_amdgcn_readfirstlane(tid >> 6), gw = blockIdx.x * NWAVE + wv, ngw = gridDim.x * NWAVE;
    const float* DEC = (const float*)(p->ws + OFF_DEC); const u16* KD = (const u16*)(p->ws + OFF_KD); const u16* BQ = (const u16*)(p->ws + OFF_BQ);
    const u16* KK = (const u16*)(p->ws + OFF_KK); const u16* R = (const u16*)(p->ws + OFF_R); const u16* V = (const u16*)(p->ws + OFF_V);
    float* PU = (float*)(p->ws + OFF_PU);
    ldsf ring = (ldsf)lds + wv * (3 * SSLOT);
    for (int task = gw; task < 16 * NCH; task += ngw) {
        const int seq = task >> 7, c = task & 127, h = seq >> 1, d = seq & 1;
#define LD(st) load_step(DEC, KD, BQ, KK, R, V, pos_to_pp(c * CLEN + min((st), CLEN - 1), d), h, d, lane)
        f32x2 X[32];
        int ln = lane; asm volatile("" : "+v"(ln));
#pragma unroll
        for (int j = 0; j < 32; ++j) X[j] = (f32x2){(WHICH == 0 && 2 * j == ln) ? 1.f : 0.f, (WHICH == 0 && 2 * j + 1 == ln) ? 1.f : 0.f};
        float vvA, vvB;
        { const StepV s0 = LD(0), s1 = LD(1); stage_step(ring, s0, lane); stage_step(ring + SSLOT, s1, lane); vvA = s0.v; vvB = s1.v; }
        StepV g0 = LD(2), g1 = LD(3), g2 = LD(4), g3 = LD(5);
        int cs = 0, ns = 2;
        float chain = 0.f;
#pragma unroll 1
        for (int st = 0; st < CLEN; ++st) {
            chain += scan_step<2>(X, ring + cs * SSLOT, WHICH ? vvA : 0.f);
            stage_step(ring + ns * SSLOT, g0, lane);
            vvA = vvB; vvB = g0.v; g0 = g1; g1 = g2; g2 = g3; g3 = LD(st + 6);
            cs = (cs == 2) ? 0 : cs + 1; ns = (ns == 2) ? 0 : ns + 1;
        }
#undef LD
        float4* o = (float4*)(PU + ((size_t)task * 2 + WHICH) * 4096 + lane * 64);
#pragma unroll
        for (int j = 0; j < 16; ++j) o[j] = (float4){X[2 * j][0], X[2 * j][1], X[2 * j + 1][0], X[2 * j + 1][1]};
        if (chain == 1.2345e38f) o[0] = (float4){chain, chain, chain, chain};
    }
}
DEV void phase_scan1(PPtr p, char* lds) { scan1_pass<0>(p, lds); scan1_pass<1>(p, lds); }
#define S2_PLOAD(ent_, lo, hi) do { const float4* s_ = (const float4*)((ent_) + prow * 64 + pcol); lo = s_[0]; hi = s_[1]; } while (0)
#define S2_ULOAD(ent_, u_) do { const float* s_ = (ent_) + 4096; _Pragma("unroll") for (int t_ = 0; t_ < 2; ++t_) _Pragma("unroll") for (int j_ = 0; j_ < 4; ++j_) u_[t_][j_] = s_[(16 * rt + 4 * q + j_) * 64 + 16 * (ct0 + t_) + r]; } while (0)
#define S2_CSTORE(dst_, a0_, a1_) do { float* d_ = (dst_); _Pragma("unroll") for (int j_ = 0; j_ < 4; ++j_) { d_[(16 * rt + 4 * q + j_) * 64 + 16 * ct0 + r] = a0_[j_]; d_[(16 * rt + 4 * q + j_) * 64 + 16 * ct0 + 16 + r] = a1_[j_]; } } while (0)
#define S2_LSTORE(dst_, a0_, a1_) do { float* d_ = (dst_); _Pragma("unroll") for (int j_ = 0; j_ < 4; ++j_) { d_[(16 * rt + 4 * q + j_) * 68 + 16 * ct0 + r] = a0_[j_]; d_[(16 * rt + 4 * q + j_) * 68 + 16 * ct0 + 16 + r] = a1_[j_]; } } while (0)
DEV void phase_scan2a(PPtr p, char* lds) {
    if (blockIdx.x >= 128) return;
    const int tid = tidx(), lane = tid & 63, w = __builtin_amdgcn_readfirstlane(tid >> 6), seq = blockIdx.x >> 3, g = blockIdx.x & 7;
    float* sX = (float*)lds; float* sZ = sX + 2 * 64 * 68; float* sP = sZ + 2 * 64 * 68;
    float* PUg = (float*)(p->ws + OFF_PU) + (size_t)(seq * NCH + 16 * g) * 8192;
    float* TOT = (float*)(p->ws + OFF_LA) + (size_t)(seq * 8 + g) * 8192;
    const int rt = w >> 1, ct0 = (w & 1) * 2, r = lane & 15, q = lane >> 4;
    const int prow = tid >> 3, pcol = (tid & 7) * 8;
    for (int i = tid; i < 64 * 68; i += NTHR) { const int row = i / 68, col = i - row * 68; sX[i] = (row == col) ? 1.f : 0.f; sZ[i] = 0.f; }
    float4 pa0, pa1, pb0, pb1;
    { float4 t0, t1; S2_PLOAD(PUg, t0, t1); *(float4*)(sP + prow * 68 + pcol) = t0; *(float4*)(sP + prow * 68 + pcol + 4) = t1; }
    S2_PLOAD(PUg + 8192, pa0, pa1); S2_PLOAD(PUg + 2 * 8192, pb0, pb1);
    float ua[2][4], ub[2][4];
    S2_ULOAD(PUg, ua); S2_ULOAD(PUg + 8192, ub);
    __syncthreads();
    for (int jj = 0; jj < 16; ++jj) {
        const int cur = jj & 1;
        f32x4 x0 = {0.f, 0.f, 0.f, 0.f}, x1 = {0.f, 0.f, 0.f, 0.f};
        f32x4 z0 = {ua[0][0], ua[0][1], ua[0][2], ua[0][3]}, z1 = {ua[1][0], ua[1][1], ua[1][2], ua[1][3]};
        const float* Xc = sX + cur * (64 * 68); const float* Zc = sZ + cur * (64 * 68); const float* Pc = sP + cur * (64 * 68);
#pragma unroll
        for (int ks = 0; ks < 16; ++ks) {
            const float ax = Xc[(16 * rt + r) * 68 + 4 * ks + q], az = Zc[(16 * rt + r) * 68 + 4 * ks + q];
            const float b0 = Pc[(4 * ks + q) * 68 + 16 * ct0 + r], b1 = Pc[(4 * ks + q) * 68 + 16 * ct0 + 16 + r];
            x0 = __builtin_amdgcn_mfma_f32_16x16x4f32(ax, b0, x0, 0, 0, 0); x1 = __builtin_amdgcn_mfma_f32_16x16x4f32(ax, b1, x1, 0, 0, 0);
            z0 = __builtin_amdgcn_mfma_f32_16x16x4f32(az, b0, z0, 0, 0, 0); z1 = __builtin_amdgcn_mfma_f32_16x16x4f32(az, b1, z1, 0, 0, 0);
        }
        S2_LSTORE(sX + (cur ^ 1) * (64 * 68), x0, x1); S2_LSTORE(sZ + (cur ^ 1) * (64 * 68), z0, z1);
        S2_CSTORE(PUg + (size_t)jj * 8192, x0, x1); S2_CSTORE(PUg + (size_t)jj * 8192 + 4096, z0, z1);
        if (jj == 15) { S2_CSTORE(TOT, x0, x1); S2_CSTORE(TOT + 4096, z0, z1); }
        { float* Pn = sP + (cur ^ 1) * (64 * 68); *(float4*)(Pn + prow * 68 + pcol) = pa0; *(float4*)(Pn + prow * 68 + pcol + 4) = pa1; }
        pa0 = pb0; pa1 = pb1;
        S2_PLOAD(PUg + (size_t)min(jj + 3, 15) * 8192, pb0, pb1);
#pragma unroll
        for (int t = 0; t < 2; ++t)
#pragma unroll
            for (int j = 0; j < 4; ++j) ua[t][j] = ub[t][j];
        if (jj + 2 < 16) S2_ULOAD(PUg + (size_t)(jj + 2) * 8192, ub);
        __syncthreads();
    }
}
DEV void phase_scan2b(PPtr p, char* lds) {
    if (blockIdx.x >= 128) return;
    const int tid = tidx(), lane = tid & 63, w = __builtin_amdgcn_readfirstlane(tid >> 6), seq = blockIdx.x >> 3, g = blockIdx.x & 7;
    float* sS = (float*)lds; float* sP = sS + 2 * 64 * 68;
    float* PUg = (float*)(p->ws + OFF_PU) + (size_t)(seq * NCH + 16 * g) * 8192;
    float* TOTs = (float*)(p->ws + OFF_LA) + (size_t)(seq * 8) * 8192;
    const int rt = w >> 1, ct0 = (w & 1) * 2, r = lane & 15, q = lane >> 4;
    const int prow = tid >> 3, pcol = (tid & 7) * 8;
    const int T = g + 16;
#define S2_ENT(t_) ((min((t_), T - 1) < g) ? TOTs + (size_t)min((t_), T - 1) * 8192 : PUg + (size_t)(min((t_), T - 1) - g) * 8192)
    for (int i = tid; i < 64 * 68; i += NTHR) sS[i] = 0.f;
    float4 pa0, pa1, pb0, pb1;
    { float4 t0, t1; S2_PLOAD(S2_ENT(0), t0, t1); *(float4*)(sP + prow * 68 + pcol) = t0; *(float4*)(sP + prow * 68 + pcol + 4) = t1; }
    S2_PLOAD(S2_ENT(1), pa0, pa1); S2_PLOAD(S2_ENT(2), pb0, pb1);
    float ua[2][4], ub[2][4];
    S2_ULOAD(S2_ENT(0), ua); S2_ULOAD(S2_ENT(1), ub);
    f32x4 m0 = {0.f, 0.f, 0.f, 0.f}, m1 = {0.f, 0.f, 0.f, 0.f};
    int sb = 0;
    __syncthreads();
    for (int t = 0; t < T; ++t) {
        const int cur = t & 1; const bool chain = t < g;
        if (!chain) S2_CSTORE(PUg + (size_t)(t - g) * 8192 + 4096, m0, m1);
        f32x4 a0 = {ua[0][0], ua[0][1], ua[0][2], ua[0][3]}, a1 = {ua[1][0], ua[1][1], ua[1][2], ua[1][3]};
        const float* Sc = sS + sb * (64 * 68); const float* Pc = sP + cur * (64 * 68);
#pragma unroll
        for (int ks = 0; ks < 16; ++ks) {
            const float av = Sc[(16 * rt + r) * 68 + 4 * ks + q];
            const float b0 = Pc[(4 * ks + q) * 68 + 16 * ct0 + r], b1 = Pc[(4 * ks + q) * 68 + 16 * ct0 + 16 + r];
            a0 = __builtin_amdgcn_mfma_f32_16x16x4f32(av, b0, a0, 0, 0, 0);
            a1 = __builtin_amdgcn_mfma_f32_16x16x4f32(av, b1, a1, 0, 0, 0);
        }
        m0 = a0; m1 = a1;
        if (chain) { S2_LSTORE(sS + (sb ^ 1) * (64 * 68), a0, a1); sb ^= 1; }
        { float* Pn = sP + (cur ^ 1) * (64 * 68); *(float4*)(Pn + prow * 68 + pcol) = pa0; *(float4*)(Pn + prow * 68 + pcol + 4) = pa1; }
        pa0 = pb0; pa1 = pb1;
        S2_PLOAD(S2_ENT(t + 3), pb0, pb1);
#pragma unroll
        for (int u = 0; u < 2; ++u)
#pragma unroll
            for (int j = 0; j < 4; ++j) ua[u][j] = ub[u][j];
        if (t + 2 < T) S2_ULOAD(S2_ENT(t + 2), ub);
        __syncthreads();
    }
#undef S2_ENT
}
DEV void phase_scan3(PPtr p, char* lds) {
    const int tid = tidx(), lane = tid & 63, wv = __builtin_amdgcn_readfirstlane(tid >> 6), gw = blockIdx.x * NWAVE + wv, ngw = gridDim.x * NWAVE;
    const float* DEC = (const float*)(p->ws + OFF_DEC); const u16* KD = (const u16*)(p->ws + OFF_KD); const u16* BQ = (const u16*)(p->ws + OFF_BQ);
    const u16* KK = (const u16*)(p->ws + OFF_KK); const u16* R = (const u16*)(p->ws + OFF_R); const u16* V = (const u16*)(p->ws + OFF_V);
    const float* PU = (const float*)(p->ws + OFF_PU);
    float* Y = (float*)(p->ws + OFF_Y0);
    ldsf ring = (ldsf)lds + wv * (3 * SSLOT);
    for (int task = gw; task < 16 * NCH; task += ngw) {
        const int seq = task >> 7, c = task & 127, h = seq >> 1, d = seq & 1;
        f32x2 S[32];
        {
            const float4* si = (const float4*)(PU + ((size_t)task * 2 + 1) * 4096 + lane * 64);
#pragma unroll
            for (int j = 0; j < 16; ++j) { const float4 t = si[j]; S[2 * j] = (f32x2){t.x, t.y}; S[2 * j + 1] = (f32x2){t.z, t.w}; }
        }
#define LD(st) load_step(DEC, KD, BQ, KK, R, V, pos_to_pp(c * CLEN + min((st), CLEN - 1), d), h, d, lane)
#define YADD(st, y) unsafeAtomicAdd(Y + (size_t)pos_to_pp(c * CLEN + (st), d) * 512 + h * 64 + lane, (y))
        float vvA, vvB;
        { const StepV s0 = LD(0), s1 = LD(1); stage_step(ring, s0, lane); stage_step(ring + SSLOT, s1, lane); vvA = s0.v; vvB = s1.v; }
        StepV g0 = LD(2), g1 = LD(3), g2 = LD(4), g3 = LD(5);
        int cs = 0, ns = 2;
#pragma unroll 1
        for (int st = 0; st < CLEN; ++st) {
            const float y = scan_step<2>(S, ring + cs * SSLOT, vvA); YADD(st, y);
            stage_step(ring + ns * SSLOT, g0, lane);
            vvA = vvB; vvB = g0.v; g0 = g1; g1 = g2; g2 = g3; g3 = LD(st + 6);
            cs = (cs == 2) ? 0 : cs + 1; ns = (ns == 2) ? 0 : ns + 1;
        }
#undef LD
#undef YADD
    }
}
DEV void phase_readout(PPtr p, int li, int bb) {
    const int tid = tidx(), lane = tid & 63, gw = blockIdx.x * NWAVE + (tid >> 6), ngw = gridDim.x * NWAVE;
    const float* Y0 = (const float*)(p->ws + OFF_Y0);
    const u16* KD = (const u16*)(p->ws + OFF_KD); const u16* R = (const u16*)(p->ws + OFF_R); const u16* V = (const u16*)(p->ws + OFF_V); const u16* G = (const u16*)(p->ws + OFF_G);
    const float* rk = p->in[24] + li * 512; const float* lnw = p->in[25] + li * 512; const float* lnb = p->in[26] + li * 512;
    u16* AO = (u16*)(p->ws + OFF_AO);
    const int c = 8 * lane;
    float rkv[8], lw[8], lb[8];
    { const float4 a = *(const float4*)(rk + c), b = *(const float4*)(rk + c + 4); rkv[0] = a.x; rkv[1] = a.y; rkv[2] = a.z; rkv[3] = a.w; rkv[4] = b.x; rkv[5] = b.y; rkv[6] = b.z; rkv[7] = b.w; }
    { const float4 a = *(const float4*)(lnw + c), b = *(const float4*)(lnw + c + 4); lw[0] = a.x; lw[1] = a.y; lw[2] = a.z; lw[3] = a.w; lw[4] = b.x; lw[5] = b.y; lw[6] = b.z; lw[7] = b.w; }
    { const float4 a = *(const float4*)(lnb + c), b = *(const float4*)(lnb + c + 4); lb[0] = a.x; lb[1] = a.y; lb[2] = a.z; lb[3] = a.w; lb[4] = b.x; lb[5] = b.y; lb[6] = b.z; lb[7] = b.w; }
    for (int pp = gw; pp < RPB; pp += ngw) {
        const size_t m = (size_t)bb * RPB + pp, e = (size_t)pp * 512 + c;
        const float4 ya = *(const float4*)(Y0 + e), yb = *(const float4*)(Y0 + e + 4);
        const float y[8] = {ya.x, ya.y, ya.z, ya.w, yb.x, yb.y, yb.z, yb.w};
        float r[8], k0[8], k1[8], v[8], g[8];
        unpack8(*(const uint4*)(R + e), r); unpack8(*(const uint4*)(KD + ((size_t)pp * 2) * 512 + c), k0); unpack8(*(const uint4*)(KD + ((size_t)pp * 2 + 1) * 512 + c), k1);
        unpack8(*(const uint4*)(V + e), v); unpack8(*(const uint4*)(G + e), g);
        float sm = 0.f, bs = 0.f;
#pragma unroll
        for (int j = 0; j < 8; ++j) { sm += y[j]; bs += r[j] * (k0[j] + k1[j]) * rkv[j]; }
        sm += __shfl_xor(sm, 1); sm += __shfl_xor(sm, 2); sm += __shfl_xor(sm, 4);
        bs += __shfl_xor(bs, 1); bs += __shfl_xor(bs, 2); bs += __shfl_xor(bs, 4);
        const float mean = sm * (1.f / 64.f);
        float vs = 0.f;
#pragma unroll
        for (int j = 0; j < 8; ++j) { const float dv = y[j] - mean; vs += dv * dv; }
        vs += __shfl_xor(vs, 1); vs += __shfl_xor(vs, 2); vs += __shfl_xor(vs, 4);
        const float rstd = rsqrtf(vs * (1.f / 64.f) + 64e-5f);
        float o[8];
#pragma unroll
        for (int j = 0; j < 8; ++j) o[j] = ((y[j] - mean) * rstd * lw[j] + lb[j] + bs * v[j]) * g[j];
        *(uint4*)(AO + m * DM + 512 + c) = pack8(o);
    }
}
DEV void phase_final(PPtr p) {
    const int lane = tidx() & 63, gw = blockIdx.x * NWAVE + (tidx() >> 6), ngw = gridDim.x * NWAVE;
    const float* gain = p->in[29];
    for (int m = gw; m < NB * SEQ; m += ngw) {
        float4* xr = (float4*)(p->out + (size_t)m * DM);
        float4 v[4]; float ss = 0.f;
#pragma unroll
        for (int j = 0; j < 4; ++j) { v[j] = xr[lane + 64 * j]; ss += v[j].x * v[j].x + v[j].y * v[j].y + v[j].z * v[j].z + v[j].w * v[j].w; }
        ss = wave_sum(ss);
        const float rstd = rsqrtf(ss * (1.f / DM) + 1e-6f);
#pragma unroll
        for (int j = 0; j < 4; ++j) {
            const float4 g = *(const float4*)(gain + (lane + 64 * j) * 4);
            float4 o; o.x = v[j].x * rstd * g.x; o.y = v[j].y * rstd * g.y; o.z = v[j].z * rstd * g.z; o.w = v[j].w * rstd * g.w;
            xr[lane + 64 * j] = o;
        }
    }
}

constexpr size_t OFF_BAR = 768 * 1024;
DEV void gbar(PPtr kp_, unsigned& nbar) {
    asm volatile("s_waitcnt vmcnt(0)" ::: "memory");
    __syncthreads();
    if (threadIdx.x == 0) {
        unsigned* ctr = (unsigned*)(kp_->ws + OFF_BAR);
        __builtin_amdgcn_fence(__ATOMIC_RELEASE, "agent");
        asm volatile("s_waitcnt vmcnt(0)" ::: "memory");
        ++nbar;
        __hip_atomic_fetch_add(ctr, 1u, __ATOMIC_RELAXED, __HIP_MEMORY_SCOPE_AGENT);
        const unsigned target = nbar * gridDim.x;
        while (__hip_atomic_load(ctr, __ATOMIC_RELAXED, __HIP_MEMORY_SCOPE_AGENT) < target) __builtin_amdgcn_s_sleep(1);
        __builtin_amdgcn_fence(__ATOMIC_ACQUIRE, "agent");
        asm volatile("s_waitcnt vmcnt(0)" ::: "memory");
    }
    __syncthreads();
}
#define p launder(kp)
#define SYNC() gbar(launder(kp), nbar)
template <int bb>
DEV void do_rwkv_batch(PPtr kp, unsigned& nbar, char* lds, int li) {
    unsigned char* ws = launder(kp)->ws;
    u16* ZD = (u16*)(ws + OFF_ZD);
                phase_rwkv_prep(p, li, bb); SYNC();
                const u16* LA = (const u16*)(ws + OFF_LA); const u16* ZDb = ZD + (size_t)bb * RPB * ZDW;
                { pg8::EpiLoraT e{(float*)(ws + OFF_DEC), (u16*)(ws + OFF_KD), (u16*)(ws + OFF_BQ), (u16*)(ws + OFF_G), (const u16*)(ws + OFF_KK), ZDb,
                                  p->in[17] + (size_t)li * 1024, p->in[19] + (size_t)li * 1024, p->in[23] + li * 512, p->in[16] + li * ZDW + 512};
                  int kl_ = 256; asm volatile("" : "+s"(kl_));
                  pg8::Gemm g_{(const pg8::bf16_t*)LA, (const pg8::bf16_t*)(ws + OFF_PU), RPB, 2560, kl_}; pg8::StaticOrder S_; S_.init(RPB, 2560, (int)gridDim.x, (int)blockIdx.x);
                  pg8::gemm_phase<pg8::EpiLoraT, pg8::StaticOrder, true, true>((PG8_LAS unsigned char*)lds, g_, S_, e); }
                SYNC();
                phase_scan1(p, lds); SYNC();
                phase_scan2a(p, lds); SYNC();
                phase_scan2b(p, lds); SYNC();
                phase_scan3(p, lds); SYNC();
                phase_readout(p, li, bb); SYNC();
            }
template <int layer>
DEV void do_layer(PPtr kp, unsigned& nbar, char* lds) {
    unsigned char* ws = launder(kp)->ws;
    const float* mod = (const float*)(ws + OFF_MOD);
    u16* HN = (u16*)(ws + OFF_HN); u16* AO = (u16*)(ws + OFF_AO); u16* RAW = (u16*)(ws + OFF_RAW); u16* ZD = (u16*)(ws + OFF_ZD);
        const int li = layer >> 1;
        const float* lmod = mod + (size_t)layer * 3 * 6144;
        phase_wprep(p, layer, lds); phase_normmod(p, layer, 0); SYNC();
        const pg8::bf16_t* WB = (const pg8::bf16_t*)(ws + OFF_WB);
#define GEMM8(A_, B_, N_, K_, E_) do { pg8::Gemm g_{(const pg8::bf16_t*)(A_), (B_), MROWS, (N_), (K_)}; pg8::StaticOrder S_; S_.init(MROWS, (N_), (int)gridDim.x, (int)blockIdx.x); \
            pg8::gemm_phase<decltype(E_), pg8::StaticOrder, true, true>((PG8_LAS unsigned char*)lds, g_, S_, E_); } while (0)
#define GEMM8L(A_, B_, N_, K_, E_) do { pg8::Gemm g_{(const pg8::bf16_t*)(A_), (B_), MROWS, (N_), (K_)}; pg8::LatentOrder S_; S_.init((N_), (int)gridDim.x, (int)blockIdx.x); \
            pg8::gemm_phase<decltype(E_), pg8::LatentOrder, true, true>((PG8_LAS unsigned char*)lds, g_, S_, E_); } while (0)
        if (!(layer & 1)) {
            { pg8::EpiStoreT e{RAW, 1536, 1 << 30, RAW, 1536}; GEMM8(HN, WB + WB_IN, 1536, DM, e); } SYNC();
            phase_even_post(p, li); SYNC();
            phase_attn_even(p, li, lds); SYNC();
            { pg8::EpiResidT e{p, lmod + 2048}; GEMM8(AO, WB + WB_OUT, DM, DM, e); } SYNC();
        } else {
            { pg8::EpiStoreT e{RAW, 1536, 1536, ZD, ZDW}; GEMM8(HN, WB + WB_IN, 3328, DM, e); } SYNC();
            phase_attn_odd(p, li, lds); SYNC();
            do_rwkv_batch<0>(kp, nbar, lds, li);
            do_rwkv_batch<1>(kp, nbar, lds, li);
            if (layer == 3) { pg8::EpiResidT e{p, lmod + 2048}; GEMM8L(AO, WB + WB_OUT, DM, DM, e); }
            else { pg8::EpiResidT e{p, lmod + 2048}; GEMM8(AO, WB + WB_OUT, DM, DM, e); }
            SYNC();
        }
        phase_normmod(p, layer, 1); SYNC();
        if (layer == 3) { pg8::EpiSwigluT e{RAW}; GEMM8L(HN, WB + WB_F1, 5632, DM, e); }
        else { pg8::EpiSwigluT e{RAW}; GEMM8(HN, WB + WB_F1, 5632, DM, e); }
        SYNC();
        if (layer == 3) { pg8::EpiResidT e{p, lmod + 5120}; GEMM8L(RAW, WB + WB_F2, DM, FFH, e); }
        else { pg8::EpiResidT e{p, lmod + 5120}; GEMM8(RAW, WB + WB_F2, DM, FFH, e); }
        SYNC();
    }
__global__ void __launch_bounds__(NTHR) mega(Params p_unused) {
    PPtr kp = (PPtr)__builtin_amdgcn_kernarg_segment_ptr();
    extern __shared__ __attribute__((aligned(16))) char lds[];
    cg::grid_group grid = cg::this_grid();
    unsigned nbar = 0;
    grid.sync();
    phase_init(p, lds); SYNC();
    do_layer<0>(kp, nbar, lds);
    do_layer<1>(kp, nbar, lds);
    do_layer<2>(kp, nbar, lds);
    do_layer<3>(kp, nbar, lds);
    phase_final(p);
}
#undef p
#undef SYNC

extern "C" void kernel_launch(void* const* d_in, const int* in_sizes, int n_in, void* d_out, int out_size, void* d_ws, size_t ws_size, hipStream_t stream) {
    static int grid = 0;
    if (grid == 0) {
        if (n_in != 30 || ws_size < WS_NEED || out_size != NB * SEQ * DM) { fprintf(stderr, "kernel_launch: unexpected problem shape (n_in %d ws %zu out %d)\n", n_in, ws_size, out_size); grid = -1; return; }
        int dev = 0, cus = 0, per_cu = 0;
        hipGetDevice(&dev);
        hipDeviceGetAttribute(&cus, hipDeviceAttributeMultiprocessorCount, dev);
        hipFuncSetAttribute((const void*)mega, hipFuncAttributeMaxDynamicSharedMemorySize, LDS_BYTES);
        hipOccupancyMaxActiveBlocksPerMultiprocessor(&per_cu, (const void*)mega, NTHR, LDS_BYTES);
        if (per_cu < 1) per_cu = 1;
        if (per_cu > 1) per_cu = 1;
        grid = cus * per_cu;
    }
    if (grid < 0) return;
    Params p{};
    for (int i = 0; i < 30; ++i) p.in[i] = (const float*)d_in[i];
    p.out = (float*)d_out; p.ws = (unsigned char*)d_ws;
    hipMemsetAsync((char*)d_ws + OFF_BAR, 0, 256, stream);
    void* args[] = {&p};
    hipError_t e = hipLaunchCooperativeKernel((const void*)mega, dim3(grid), dim3(NTHR), args, LDS_BYTES, stream);
    if (e != hipSuccess) fprintf(stderr, "cooperative launch failed: %s (grid %d)\n", hipGetErrorString(e), grid);
}
```

```cpp
#include <hip/hip_runtime.h>
#include <hip/hip_cooperative_groups.h>
#include <cstdio>
#include <cstdint>
namespace cg = cooperative_groups;

#define DEV __device__ __forceinline__
typedef unsigned short u16;
typedef short bf16x8 __attribute__((ext_vector_type(8)));
typedef float f32x4 __attribute__((ext_vector_type(4)));
typedef const __attribute__((address_space(4))) float* cfp;
typedef const __attribute__((address_space(4))) unsigned* cup;

constexpr int DM = 1024, NB = 2, SEQ = 16384, NCTX = 256, RPB = SEQ + NCTX, MROWS = NB * RPB;
constexpr int FFH = 2816, ZDW = 1792;
constexpr float LOG2E = 1.4426950408889634f;
constexpr int NTHR = 512, NWAVE = 8;
constexpr int LDS_BYTES = 132096;

constexpr size_t MiB = 1u << 20;
constexpr size_t OFF_MOD = 0;
constexpr size_t OFF_ROPE = 512 * 1024;
constexpr size_t OFF_XC = 1 * MiB;
constexpr size_t OFF_WB = 3 * MiB;
constexpr size_t OFF_AO = 29 * MiB;
constexpr size_t OFF_HN = 94 * MiB;
constexpr size_t OFF_RAW = 159 * MiB;
constexpr size_t OFF_ZD = 257 * MiB;
constexpr size_t SZ_H = (size_t)RPB * 512 * 2;
constexpr size_t OFF_DEC = 94 * MiB;
constexpr size_t OFF_KD = OFF_DEC + 4 * SZ_H;
constexpr size_t OFF_BQ = OFF_KD + 2 * SZ_H;
constexpr size_t OFF_KK = OFF_BQ + 2 * SZ_H;
constexpr size_t OFF_R = OFF_KK + SZ_H;
constexpr size_t OFF_V = 371 * MiB;
constexpr size_t OFF_G = OFF_V + SZ_H;
constexpr size_t OFF_LA = OFF_G + SZ_H;
constexpr size_t OFF_Y0 = 412 * MiB;
constexpr size_t OFF_PU = OFF_Y0 + 2 * SZ_H;
constexpr size_t WS_NEED = 509 * MiB;
constexpr int NCH = 128, CLEN = 130;
static_assert(OFF_R + SZ_H <= OFF_ZD, "scan map");
static_assert(OFF_LA + SZ_H / 2 <= OFF_Y0, "scan map 2");
static_assert(OFF_PU + 64 * MiB <= WS_NEED, "scan map 3");
static_assert(OFF_RAW + (size_t)MROWS * FFH * 2 <= WS_NEED, "ffn hidden");

struct Params { const float* in[30]; float* out; unsigned char* ws; };
typedef const __attribute__((address_space(4))) Params* PPtr;
DEV int tidx() { int t = threadIdx.x; asm volatile("" : "+v"(t)); return t; }
DEV PPtr launder(PPtr p) { asm volatile("" : "+s"(p)); return p; }

DEV unsigned f2bf(float f) { unsigned u = __float_as_uint(f); return (u + 0x7fffu + ((u >> 16) & 1u)) >> 16; }
DEV float bf2f(u16 h) { return __uint_as_float(((unsigned)h) << 16); }
DEV float bflo(unsigned u) { return __uint_as_float(u << 16); }
DEV float bfhi(unsigned u) { return __uint_as_float(u & 0xffff0000u); }
DEV unsigned pk2(float lo, float hi) { return f2bf(lo) | (f2bf(hi) << 16); }
DEV void unpack8(const uint4 u, float (&f)[8]) {
    f[0] = bflo(u.x); f[1] = bfhi(u.x); f[2] = bflo(u.y); f[3] = bfhi(u.y); f[4] = bflo(u.z); f[5] = bfhi(u.z); f[6] = bflo(u.w); f[7] = bfhi(u.w);
}
DEV uint4 pack8(const float (&f)[8]) { uint4 o; o.x = pk2(f[0], f[1]); o.y = pk2(f[2], f[3]); o.z = pk2(f[4], f[5]); o.w = pk2(f[6], f[7]); return o; }
DEV float wave_sum(float v) {
#pragma unroll
    for (int o = 1; o < 64; o <<= 1) v += __shfl_xor(v, o);
    return v;
}
DEV float* xrow_ptr(PPtr p, int m) {
    int b = m / RPB, q = m - b * RPB;
    return q < SEQ ? p->out + (size_t)(b * SEQ + q) * DM : (float*)(p->ws + OFF_XC) + (size_t)(b * NCTX + (q - SEQ)) * DM;
}
DEV int mod_idx(int m) { int b = m / RPB, q = m - b * RPB; return q < SEQ ? b : 2; }
DEV float sigmoidf_(float x) { return 1.f / (1.f + __expf(-x)); }

DEV void phase_init(PPtr p, char* lds) {
    const int tid = tidx();
    const size_t gt = (size_t)blockIdx.x * NTHR + tid, ng = (size_t)gridDim.x * NTHR;
    {
        const float4* s = (const float4*)p->in[0]; float4* d = (float4*)p->out;
        const size_t n = (size_t)NB * SEQ * DM / 4;
        for (size_t i = gt; i < n; i += ng) d[i] = s[i];
        const float4* s2 = (const float4*)p->in[2]; float4* d2 = (float4*)(p->ws + OFF_XC);
        const size_t n2 = (size_t)NB * NCTX * DM / 4;
        for (size_t i = gt; i < n2; i += ng) d2[i] = s2[i];
    }
    {
        float* T = (float*)(p->ws + OFF_ROPE);
        for (size_t i = gt; i < 5120; i += ng) {
            const int pos = (int)(i >> 4), f = (int)(i & 15);
            const float inv = powf(10000.f, -(float)f / 16.f);
            if (pos < 256) { const float ang = (float)pos * inv; T[pos * 16 + f] = cosf(ang); T[4096 + pos * 16 + f] = sinf(ang); }
            else { const float ang = (float)(pos - 256) * inv; T[8192 + (pos - 256) * 16 + f] = cosf(ang); T[9216 + (pos - 256) * 16 + f] = sinf(ang); }
        }
    }
    float* red = (float*)lds;
    float* mod = (float*)(p->ws + OFF_MOD);
    const float* c = p->in[1]; const float* cc = p->in[3];
    for (int item = blockIdx.x; item < 192; item += gridDim.x) {
        const int l = item / 48, n0 = (item % 48) * 128, col = tid & 127, kp = tid >> 7;
        const float* w = p->in[4] + (size_t)l * DM * 6144 + n0 + col;
        float a0 = 0.f, a1 = 0.f, a2 = 0.f;
        for (int k = kp * 256; k < kp * 256 + 256; ++k) {
            const float wv = w[(size_t)k * 6144];
            const float c0 = c[k], c1 = c[DM + k], c2 = cc[k];
            a0 += c0 * sigmoidf_(c0) * wv; a1 += c1 * sigmoidf_(c1) * wv; a2 += c2 * sigmoidf_(c2) * wv;
        }
        red[(kp * 3 + 0) * 128 + col] = a0; red[(kp * 3 + 1) * 128 + col] = a1; red[(kp * 3 + 2) * 128 + col] = a2;
        __syncthreads();
        if (tid < 384) {
            const int mb = tid >> 7, cl = tid & 127;
            float s = red[(0 * 3 + mb) * 128 + cl] + red[(1 * 3 + mb) * 128 + cl] + red[(2 * 3 + mb) * 128 + cl] + red[(3 * 3 + mb) * 128 + cl];
            mod[(size_t)(l * 3 + mb) * 6144 + n0 + cl] = s + p->in[5][l * 6144 + n0 + cl];
        }
        __syncthreads();
    }
}

DEV void phase_normmod(PPtr p, int layer, int which) {
    const int lane = tidx() & 63, gw = blockIdx.x * NWAVE + (tidx() >> 6), ngw = gridDim.x * NWAVE;
    const float* gain = p->in[which ? 7 : 6] + layer * DM;
    const float* mod = (const float*)(p->ws + OFF_MOD) + (size_t)layer * 3 * 6144;
    u16* HN = (u16*)(p->ws + OFF_HN);
    for (int m = gw; m < MROWS; m += ngw) {
        const float* xr = xrow_ptr(p, m);
        const float* md = mod + mod_idx(m) * 6144 + (which ? 3072 : 0);
        float4 v[4]; float ss = 0.f;
#pragma unroll
        for (int j = 0; j < 4; ++j) { v[j] = ((const float4*)xr)[lane + 64 * j]; ss += v[j].x * v[j].x + v[j].y * v[j].y + v[j].z * v[j].z + v[j].w * v[j].w; }
        ss = wave_sum(ss);
        const float rstd = rsqrtf(ss * (1.f / DM) + 1e-6f);
#pragma unroll
        for (int j = 0; j < 4; ++j) {
            const int k = (lane + 64 * j) * 4;
            const float4 g = *(const float4*)(gain + k), sh = *(const float4*)(md + k), sc = *(const float4*)(md + 1024 + k);
            const float o0 = v[j].x * rstd * g.x * (1.f + sc.x) + sh.x, o1 = v[j].y * rstd * g.y * (1.f + sc.y) + sh.y;
            const float o2 = v[j].z * rstd * g.z * (1.f + sc.z) + sh.z, o3 = v[j].w * rstd * g.w * (1.f + sc.w) + sh.w;
            uint2 w; w.x = pk2(o0, o1); w.y = pk2(o2, o3);
            *(uint2*)(HN + (size_t)m * DM + k) = w;
        }
    }
}

template <int DUAL, class Epi>
DEV void gemm_simple(const u16* A, int lda, const float* W, int ldw, int dualoff, int M, int N, int K, const Epi& epi, char* lds) {
    u16* sA = (u16*)lds; u16* sB = sA + 128 * 40; u16* sB2 = sB + 128 * 40;
    const int tid = tidx(), lane = tid & 63, wave = tid >> 6, wm = wave >> 2, wn = wave & 3, r16 = lane & 15, quad = lane >> 4;
    const int mt = M / 128, nt = N / 128;
    for (int item = blockIdx.x; item < mt * nt; item += gridDim.x) {
        const int tn = item / mt, tm = item - tn * mt, m0 = tm * 128, n0 = tn * 128;
        f32x4 acc[4][2], acc2[4][2];
#pragma unroll
        for (int a = 0; a < 4; ++a)
#pragma unroll
            for (int b = 0; b < 2; ++b) { acc[a][b] = (f32x4){0.f, 0.f, 0.f, 0.f}; acc2[a][b] = (f32x4){0.f, 0.f, 0.f, 0.f}; }
        for (int k0 = 0; k0 < K; k0 += 32) {
            {
                const int row = tid >> 2, kc = (tid & 3) * 8;
                const uint4 v = *(const uint4*)(A + (size_t)(m0 + row) * lda + k0 + kc);
                *(uint4*)(sA + row * 40 + kc) = v;
            }
            {
                const int kk = tid >> 4, nc = (tid & 15) * 8;
                const float* wp = W + (size_t)(k0 + kk) * ldw + n0 + nc;
                const float4 a = *(const float4*)wp, b = *(const float4*)(wp + 4);
                sB[(nc + 0) * 40 + kk] = (u16)f2bf(a.x); sB[(nc + 1) * 40 + kk] = (u16)f2bf(a.y); sB[(nc + 2) * 40 + kk] = (u16)f2bf(a.z); sB[(nc + 3) * 40 + kk] = (u16)f2bf(a.w);
                sB[(nc + 4) * 40 + kk] = (u16)f2bf(b.x); sB[(nc + 5) * 40 + kk] = (u16)f2bf(b.y); sB[(nc + 6) * 40 + kk] = (u16)f2bf(b.z); sB[(nc + 7) * 40 + kk] = (u16)f2bf(b.w);
                if (DUAL) {
                    const float4 c = *(const float4*)(wp + dualoff), d = *(const float4*)(wp + dualoff + 4);
                    sB2[(nc + 0) * 40 + kk] = (u16)f2bf(c.x); sB2[(nc + 1) * 40 + kk] = (u16)f2bf(c.y); sB2[(nc + 2) * 40 + kk] = (u16)f2bf(c.z); sB2[(nc + 3) * 40 + kk] = (u16)f2bf(c.w);
                    sB2[(nc + 4) * 40 + kk] = (u16)f2bf(d.x); sB2[(nc + 5) * 40 + kk] = (u16)f2bf(d.y); sB2[(nc + 6) * 40 + kk] = (u16)f2bf(d.z); sB2[(nc + 7) * 40 + kk] = (u16)f2bf(d.w);
                }
            }
            __syncthreads();
            bf16x8 af[4], bfr[2], bfr2[2];
#pragma unroll
            for (int mi = 0; mi < 4; ++mi) af[mi] = *(const bf16x8*)(sA + (wm * 64 + mi * 16 + r16) * 40 + quad * 8);
#pragma unroll
            for (int ni = 0; ni < 2; ++ni) {
                bfr[ni] = *(const bf16x8*)(sB + (wn * 32 + ni * 16 + r16) * 40 + quad * 8);
                if (DUAL) bfr2[ni] = *(const bf16x8*)(sB2 + (wn * 32 + ni * 16 + r16) * 40 + quad * 8);
            }
#pragma unroll
            for (int mi = 0; mi < 4; ++mi)
#pragma unroll
                for (int ni = 0; ni < 2; ++ni) {
                    acc[mi][ni] = __builtin_amdgcn_mfma_f32_16x16x32_bf16(af[mi], bfr[ni], acc[mi][ni], 0, 0, 0);
                    if (DUAL) acc2[mi][ni] = __builtin_amdgcn_mfma_f32_16x16x32_bf16(af[mi], bfr2[ni], acc2[mi][ni], 0, 0, 0);
                }
            __syncthreads();
        }
#pragma unroll
        for (int mi = 0; mi < 4; ++mi)
#pragma unroll
            for (int ni = 0; ni < 2; ++ni)
#pragma unroll
                for (int j = 0; j < 4; ++j) {
                    const int row = m0 + wm * 64 + mi * 16 + quad * 4 + j, col = n0 + wn * 32 + ni * 16 + r16;
                    epi(row, col, acc[mi][ni][j], DUAL ? acc2[mi][ni][j] : 0.f);
                }
    }
}

struct EpiStore { u16* O; int ld; DEV void operator()(int r, int c, float v, float) const { O[(size_t)r * ld + c] = (u16)f2bf(v); } };
struct EpiStoreOdd { u16* Q; u16* Z;
    DEV void operator()(int r, int c, float v, float) const { if (c < 1536) Q[(size_t)r * 1536 + c] = (u16)f2bf(v); else Z[(size_t)r * ZDW + (c - 1536)] = (u16)f2bf(v); } };
struct EpiResid { PPtr p; const float* gate;
    DEV void operator()(int r, int c, float v, float) const { float* xr = xrow_ptr(p, r); xr[c] += gate[mod_idx(r) * 6144 + c] * v; } };
struct EpiSwiglu { u16* H;
    DEV void operator()(int r, int c, float g, float u) const { H[(size_t)r * FFH + c] = (u16)f2bf(g * sigmoidf_(g) * u); } };


namespace pg8 {
#define PG8_LAS __attribute__((address_space(3)))
typedef unsigned short bf16_t;
typedef short bf16x8 __attribute__((ext_vector_type(8)));
typedef float f32x4 __attribute__((ext_vector_type(4)));
typedef unsigned u32x4 __attribute__((ext_vector_type(4)));
constexpr int BM = 256, BK = 64, HALF = 128, HTB = HALF * BK * 2  , STAGE_BYTES = 8 * HTB, NXCD = 8, WGM = 8;

__host__ __device__ __forceinline__ int lds_byte(int r, int c) { const int st = (r >> 4) * 2 + (c >> 5), rr = r & 15, cc = c & 31, ob = rr * 64 + cc * 2; return st * 1024 + (ob ^ (((ob >> 9) & 1) << 5)); }
__host__ __device__ __forceinline__ void stage_rc(int b, int& R, int& C) { const int st = b / 1024, sb = b % 1024, swz = sb ^ (((sb >> 9) & 1) << 5); R = (st >> 1) * 16 + swz / 64; C = (st & 1) * 32 + (swz % 64) / 2; }
__host__ __device__ __forceinline__ int perm32(int rho) { const int n = rho >> 4, i = rho & 15; return 8 * (i >> 2) + 4 * n + (i & 3); }

struct Unit { int pm, pn; };
struct Gemm { const bf16_t* A; const bf16_t* Bt; int M, N, K; };

struct StaticOrder {
    int nM, nN, nwg, G, c;
    __host__ __device__ void init(int M, int N, int G_, int c_) { nM = M / BM; nN = N / BM; nwg = nM * nN; G = G_; c = c_; }
    __host__ __device__ bool next(int i, Unit& u) const {
        const long L = (long)i * G + c; if (L >= nwg) return false;
        int wgid = (int)L; { const int q = nwg / NXCD, r = nwg % NXCD, xcd = wgid % NXCD, off = wgid / NXCD; wgid = (xcd < r ? xcd * (q + 1) : r * (q + 1) + (xcd - r) * q) + off; }
        const int nig = WGM * nN, gid = wgid / nig, fm = gid * WGM, gsz = (nM - fm) < WGM ? (nM - fm) : WGM;
        u.pm = fm + ((wgid % nig) % gsz); u.pn = (wgid % nig) / gsz; return true;
    }
    __device__ __forceinline__ void a_ready(const Unit&) const {}
    __device__ __forceinline__ void done(const Unit&) const {}
};
struct LatentOrder {
    StaticOrder S;
    __host__ __device__ void init(int N, int G_, int c_) { S.init(32768, N, G_, c_); }
    __host__ __device__ bool next(int i, Unit& u) const { if (!S.next(i, u)) return false; u.pm = u.pm < 64 ? u.pm : u.pm + 1; return true; }
    __device__ __forceinline__ void a_ready(const Unit&) const {}
    __device__ __forceinline__ void done(const Unit&) const {}
};

__device__ __forceinline__ unsigned cvt_pk_bf16(float lo, float hi) { unsigned r; asm volatile("v_cvt_pk_bf16_f32 %0, %1, %2" : "=v"(r) : "v"(lo), "v"(hi)); return r; }
template <class Epi, class Sched, bool ALIGN_EPI = false, bool SP2 = false>
__device__ __forceinline__ void gemm_phase(PG8_LAS unsigned char* lds, const Gemm g, const Sched& S, const Epi& E) {
    const int tid = tidx(), wid = __builtin_amdgcn_readfirstlane(tid >> 6), lane = tid & 63, wr = wid >> 2, wc = wid & 3, fr = lane & 15, fq = lane >> 4;
    const int K = g.K, nt = K / BK;
    unsigned voffA[2], voffB[2];
#pragma unroll
    for (int i = 0; i < 2; ++i) { int R, C; stage_rc(tid * 16 + i * 8192, R, C); const int Rb = Epi::PERM ? ((R & ~31) + perm32(R & 31)) : R;
        voffA[i] = (unsigned)(R * K + C) * 2u; voffB[i] = (unsigned)(Rb * K + C) * 2u; }
    const size_t kstep = (size_t)(BK * 2);
    const size_t hstep = (size_t)HALF * K * 2;
    const size_t tstep = 2 * hstep;
    const unsigned ldsw = (unsigned)wid * 1024u;
    const int aoff = lds_byte(wr * 64 + fr, fq * 8), boff = lds_byte(wc * 32 + fr, fq * 8);
#define PG8_SA(b, h) (((b) * 2 + (h)) * HTB)
#define PG8_SB(b, h) ((4 + (b) * 2 + (h)) * HTB)
#define PG8_STAGE(bufoff, gbase, voff) do { _Pragma("unroll") for (int _i = 0; _i < 2; ++_i) \
        __builtin_amdgcn_global_load_lds((const unsigned*)((const char*)(gbase) + (voff)[_i]), (PG8_LAS unsigned*)(lds + (bufoff) + ldsw + _i * 8192), 16, 0, 0); } while (0)
#define PG8_LDA(dst, b, h) do { _Pragma("unroll") for (int m = 0; m < 4; ++m) _Pragma("unroll") for (int k = 0; k < 2; ++k) dst[m][k] = *(const PG8_LAS bf16x8*)(lds + PG8_SA(b, h) + aoff + m * 2048 + k * 1024); } while (0)
#define PG8_LDB(dst, b, h) do { _Pragma("unroll") for (int n = 0; n < 2; ++n) _Pragma("unroll") for (int k = 0; k < 2; ++k) dst[n][k] = *(const PG8_LAS bf16x8*)(lds + PG8_SB(b, h) + boff + n * 2048 + k * 1024); } while (0)
#define PG8_MMA(ai, bj, At, Bt) do { __builtin_amdgcn_s_setprio(1); _Pragma("unroll") for (int m = 0; m < 4; ++m) _Pragma("unroll") for (int n = 0; n < 2; ++n) _Pragma("unroll") for (int k = 0; k < 2; ++k) \
        acc[ai][bj][m][n] = __builtin_amdgcn_mfma_f32_16x16x32_bf16(Bt[n][k], At[m][k], acc[ai][bj][m][n], 0, 0, 0); __builtin_amdgcn_s_setprio(0); } while (0)
#define PG8_WAIT_V(n) asm volatile("s_waitcnt vmcnt(" #n ")" ::: "memory")
#define PG8_WAIT_L(n) asm volatile("s_waitcnt lgkmcnt(" #n ")" ::: "memory")
#define PG8_BAR __builtin_amdgcn_s_barrier()
#define PG8_SCHED __builtin_amdgcn_sched_barrier(0)
    Unit cur, nxt; int ui = 0;
    if (!S.next(0, cur)) return;
    f32x4 acc[2][2][4][2];
#pragma unroll
    for (int a = 0; a < 2; ++a)
#pragma unroll
        for (int b = 0; b < 2; ++b)
#pragma unroll
            for (int m = 0; m < 4; ++m)
#pragma unroll
                for (int n = 0; n < 2; ++n) acc[a][b][m][n] = (f32x4){0.f, 0.f, 0.f, 0.f};
    bf16x8 At[4][2], B0[2][2], B1[2][2];
    const char* cA = (const char*)g.A + (size_t)cur.pm * tstep; const char* cB = (const char*)g.Bt + (size_t)cur.pn * tstep;
    S.a_ready(cur);
    if constexpr (SP2) {
        PG8_STAGE(PG8_SB(0, 0), cB, voffB); PG8_STAGE(PG8_SB(0, 1), cB + hstep, voffB); PG8_STAGE(PG8_SA(0, 0), cA, voffA); PG8_STAGE(PG8_SA(0, 1), cA + hstep, voffA);
        if (wr == 1) PG8_BAR;
        PG8_WAIT_V(2); PG8_BAR;
        PG8_STAGE(PG8_SB(1, 0), cB + kstep, voffB); PG8_STAGE(PG8_SA(1, 0), cA + kstep, voffA); PG8_STAGE(PG8_SB(1, 1), cB + hstep + kstep, voffB);
        PG8_WAIT_V(6); PG8_BAR;
    } else {
        PG8_STAGE(PG8_SB(0, 0), cB, voffB); PG8_STAGE(PG8_SA(0, 0), cA, voffA); PG8_STAGE(PG8_SB(0, 1), cB + hstep, voffB); PG8_STAGE(PG8_SA(0, 1), cA + hstep, voffA);
        if (wr == 1) PG8_BAR;
        PG8_WAIT_V(4); PG8_BAR;
        PG8_STAGE(PG8_SB(1, 0), cB + kstep, voffB); PG8_STAGE(PG8_SA(1, 0), cA + kstep, voffA); PG8_STAGE(PG8_SB(1, 1), cB + hstep + kstep, voffB);
        PG8_WAIT_V(6); PG8_BAR;
    }
    for (;;) {
        const bool has_next = S.next(ui + 1, nxt);
        const char* nA = has_next ? (const char*)g.A + (size_t)nxt.pm * tstep : cA; const char* nB = has_next ? (const char*)g.Bt + (size_t)nxt.pn * tstep : cB;
        for (int t = 0; t < nt; t += 2) {
            const bool last = (t == nt - 2);
            const char* a1 = cA + (size_t)(t + 1) * kstep;
            const char* a2 = last ? nA : cA + (size_t)(t + 2) * kstep; const char* b2 = last ? nB : cB + (size_t)(t + 2) * kstep;
            const char* a3 = a2 + kstep; const char* b3 = b2 + kstep;
            if (last && has_next) S.a_ready(nxt);
            if constexpr (SP2) {
            PG8_LDB(B0, 0, 0); PG8_LDB(B1, 0, 1); PG8_SCHED; PG8_LDA(At, 0, 0); PG8_STAGE(PG8_SA(1, 1), a1 + hstep, voffA);
            PG8_WAIT_V(8); PG8_WAIT_L(0); PG8_BAR; PG8_MMA(0, 0, At, B0); PG8_MMA(0, 1, At, B1); PG8_BAR; PG8_SCHED;
            PG8_LDA(At, 0, 1); PG8_STAGE(PG8_SB(0, 0), b2, voffB); PG8_STAGE(PG8_SB(0, 1), b2 + hstep, voffB); PG8_STAGE(PG8_SA(0, 0), a2, voffA);
            PG8_WAIT_V(8); PG8_WAIT_L(0); PG8_BAR; PG8_MMA(1, 0, At, B0); PG8_MMA(1, 1, At, B1); PG8_BAR; PG8_SCHED;
            PG8_LDB(B0, 1, 0); PG8_LDB(B1, 1, 1); PG8_SCHED; PG8_LDA(At, 1, 0); PG8_STAGE(PG8_SA(0, 1), a2 + hstep, voffA);
            PG8_WAIT_V(8); PG8_WAIT_L(0); PG8_BAR; PG8_MMA(0, 0, At, B0); PG8_MMA(0, 1, At, B1); PG8_BAR; PG8_SCHED;
            PG8_LDA(At, 1, 1); PG8_STAGE(PG8_SB(1, 0), b3, voffB); PG8_STAGE(PG8_SB(1, 1), b3 + hstep, voffB); PG8_STAGE(PG8_SA(1, 0), a3, voffA);
            PG8_WAIT_V(8); PG8_WAIT_L(0); PG8_BAR; PG8_MMA(1, 0, At, B0); PG8_MMA(1, 1, At, B1); PG8_BAR; PG8_SCHED;
            } else {
            PG8_LDB(B0, 0, 0); PG8_SCHED; PG8_LDA(At, 0, 0); PG8_STAGE(PG8_SA(1, 1), a1 + hstep, voffA);
            PG8_WAIT_L(8); PG8_BAR; PG8_WAIT_L(0); PG8_MMA(0, 0, At, B0); PG8_BAR; PG8_SCHED;
            PG8_LDB(B1, 0, 1); PG8_STAGE(PG8_SB(0, 0), b2, voffB);
            PG8_BAR; PG8_WAIT_L(0); PG8_MMA(0, 1, At, B1); PG8_BAR;
            PG8_LDA(At, 0, 1); PG8_STAGE(PG8_SA(0, 0), a2, voffA);
            PG8_BAR; PG8_WAIT_L(0); PG8_MMA(1, 0, At, B0); PG8_BAR; PG8_SCHED;
            PG8_STAGE(PG8_SB(0, 1), b2 + hstep, voffB);
            PG8_WAIT_V(6); PG8_BAR; PG8_MMA(1, 1, At, B1); PG8_BAR;
            PG8_LDB(B0, 1, 0); PG8_SCHED; PG8_LDA(At, 1, 0); PG8_STAGE(PG8_SA(0, 1), a2 + hstep, voffA);
            PG8_WAIT_L(8); PG8_BAR; PG8_WAIT_L(0); PG8_MMA(0, 0, At, B0); PG8_BAR; PG8_SCHED;
            PG8_LDB(B1, 1, 1); PG8_STAGE(PG8_SB(1, 0), b3, voffB);
            PG8_BAR; PG8_WAIT_L(0); PG8_MMA(0, 1, At, B1); PG8_BAR;
            PG8_LDA(At, 1, 1); PG8_STAGE(PG8_SA(1, 0), a3, voffA);
            PG8_BAR; PG8_WAIT_L(0); PG8_MMA(1, 0, At, B0); PG8_BAR; PG8_SCHED;
            PG8_STAGE(PG8_SB(1, 1), b3 + hstep, voffB);
            PG8_WAIT_V(6); PG8_BAR; PG8_MMA(1, 1, At, B1); PG8_BAR;
            }
        }
        if constexpr (ALIGN_EPI) { if (wr == 0) PG8_BAR; }
        if constexpr (!Epi::AFTER_DRAIN) { E(acc, cur, wr, wc, fr, fq); S.done(cur); }
        if (!has_next) break;
#pragma unroll
        for (int a = 0; a < 2; ++a)
#pragma unroll
            for (int b = 0; b < 2; ++b)
#pragma unroll
                for (int m = 0; m < 4; ++m)
#pragma unroll
                    for (int n = 0; n < 2; ++n) acc[a][b][m][n] = (f32x4){0.f, 0.f, 0.f, 0.f};
        cur = nxt; cA = nA; cB = nB; ++ui;
        if constexpr (ALIGN_EPI) { if (wr == 1) PG8_BAR; }
    }
    PG8_WAIT_V(0);
    if constexpr (!ALIGN_EPI) { if (wr == 0) PG8_BAR; }
    PG8_BAR;
    if constexpr (Epi::AFTER_DRAIN) { E.fused(acc, cur, wr, wc, fr, fq, lds, wid, lane); S.done(cur); }
#undef PG8_SA
#undef PG8_SB
#undef PG8_STAGE
#undef PG8_LDA
#undef PG8_LDB
#undef PG8_MMA
#undef PG8_WAIT_V
#undef PG8_WAIT_L
#undef PG8_BAR
#undef PG8_SCHED
}

struct EpiStoreT {
    static constexpr bool PERM = true, AFTER_DRAIN = false;
    bf16_t* O0; int ld0; int split; bf16_t* O1; int ld1;
    __device__ __forceinline__ void operator()(const f32x4 (&acc)[2][2][4][2], const Unit& u, int wr, int wc, int fr, int fq) const {
        const int row0 = u.pm * BM + wr * 64 + fr; int colt = u.pn * BM; bf16_t* base = O0; int ld = ld0;
        if (colt >= split) { base = O1; ld = ld1; colt -= split; }
        const int col0 = colt + wc * 32 + 8 * fq;
#pragma unroll
        for (int ai = 0; ai < 2; ++ai)
#pragma unroll
            for (int m = 0; m < 4; ++m) { bf16_t* rowp = base + (size_t)(row0 + ai * HALF + m * 16) * ld + col0;
#pragma unroll
                for (int bj = 0; bj < 2; ++bj) { const f32x4 v0 = acc[ai][bj][m][0], v1 = acc[ai][bj][m][1];
                    u32x4 w; w.x = cvt_pk_bf16(v0[0], v0[1]); w.y = cvt_pk_bf16(v0[2], v0[3]); w.z = cvt_pk_bf16(v1[0], v1[1]); w.w = cvt_pk_bf16(v1[2], v1[3]);
                    *(u32x4*)(rowp + bj * HALF) = w; } }
    }
};
struct EpiResidT {
    static constexpr bool PERM = true, AFTER_DRAIN = false;
    PPtr p; const float* gate;
    __device__ __forceinline__ void operator()(const f32x4 (&acc)[2][2][4][2], const Unit& u, int wr, int wc, int fr, int fq) const {
        float* xb = xrow_ptr(p, u.pm * BM); const float* g = gate + mod_idx(u.pm * BM) * 6144;
        const int col0 = u.pn * BM + wc * 32 + 8 * fq;
#pragma unroll
        for (int ai = 0; ai < 2; ++ai)
#pragma unroll
            for (int m = 0; m < 4; ++m) { float* xr = xb + (size_t)(ai * HALF + wr * 64 + m * 16 + fr) * DM;
#pragma unroll
                for (int bj = 0; bj < 2; ++bj) { const int col = col0 + bj * HALF; const f32x4 v0 = acc[ai][bj][m][0], v1 = acc[ai][bj][m][1];
                    const f32x4 g0 = *(const f32x4*)(g + col), g1 = *(const f32x4*)(g + col + 4);
                    f32x4 x0 = *(const f32x4*)(xr + col), x1 = *(const f32x4*)(xr + col + 4);
                    x0 += g0 * v0; x1 += g1 * v1;
                    *(f32x4*)(xr + col) = x0; *(f32x4*)(xr + col + 4) = x1; } }
    }
};
struct EpiSwigluT {
    static constexpr bool PERM = true, AFTER_DRAIN = false;
    bf16_t* H;
    __device__ __forceinline__ void operator()(const f32x4 (&acc)[2][2][4][2], const Unit& u, int wr, int wc, int fr, int fq) const {
        const int row0 = u.pm * BM + wr * 64 + fr; const int col0 = u.pn * BM + wc * 32 + 8 * fq;
#pragma unroll
        for (int ai = 0; ai < 2; ++ai)
#pragma unroll
            for (int m = 0; m < 4; ++m) { bf16_t* rowp = H + (size_t)(row0 + ai * HALF + m * 16) * FFH;
#pragma unroll
                for (int bj = 0; bj < 2; ++bj) { const f32x4 gt = acc[ai][bj][m][0], up = acc[ai][bj][m][1];
                    float h[4];
#pragma unroll
                    for (int j = 0; j < 4; ++j) h[j] = gt[j] * sigmoidf_(gt[j]) * up[j];
                    uint2 w; w.x = cvt_pk_bf16(h[0], h[1]); w.y = cvt_pk_bf16(h[2], h[3]);
                    *(uint2*)(rowp + ((col0 + bj * HALF) >> 1)) = w; } }
    }
};

struct EpiLoraT {
    static constexpr bool PERM = true, AFTER_DRAIN = false;
    float* DEC; bf16_t* KD; bf16_t* BQ; bf16_t* G; const bf16_t* KK; const bf16_t* ZDb;
    const float* w0; const float* a0; const float* ka; const float* muk;
    template <int TYPE>
    __device__ __forceinline__ void one(const f32x4 v, int r, int c, int d) const {
        if (TYPE == 0) {
            const float4 wa = *(const float4*)(w0 + d * 512 + c);
            const float ww[4] = {wa.x, wa.y, wa.z, wa.w};
            float o[4];
#pragma unroll
            for (int e = 0; e < 4; ++e) { const float x = -(ww[e] + v[e]); const float sp = x > 20.f ? x : __logf(1.f + __expf(x)); o[e] = __expf(-__expf(-sp - 0.5f)); }
            *(float4*)(DEC + ((size_t)r * 2 + d) * 512 + c) = (float4){o[0], o[1], o[2], o[3]};
        } else if (TYPE == 1) {
            const float4 aa = *(const float4*)(a0 + d * 512 + c), ka0 = *(const float4*)(ka + c), m0 = *(const float4*)(muk + c);
            const float a0v[4] = {aa.x, aa.y, aa.z, aa.w}, kav[4] = {ka0.x, ka0.y, ka0.z, ka0.w}, mm[4] = {m0.x, m0.y, m0.z, m0.w};
            const bool lat = r < SEQ; const int lo = lat ? 0 : SEQ, hi = lat ? SEQ : RPB;
            const bf16_t* zc = ZDb + (size_t)r * ZDW + 512 + c;
            const bool hp = r - 1 >= lo, hn = r + 1 < hi;
            const uint2 uz = *(const uint2*)zc, up = *(const uint2*)(hp ? zc - ZDW : zc), un = *(const uint2*)(hn ? zc + ZDW : zc), uk = *(const uint2*)(KK + (size_t)r * 512 + c);
            const float z[4] = {bflo(uz.x), bfhi(uz.x), bflo(uz.y), bfhi(uz.y)}, zp[4] = {bflo(up.x), bfhi(up.x), bflo(up.y), bfhi(up.y)};
            const float zn[4] = {bflo(un.x), bfhi(un.x), bflo(un.y), bfhi(un.y)}, kk[4] = {bflo(uk.x), bfhi(uk.x), bflo(uk.y), bfhi(uk.y)};
            const float fp = hp ? 0.5f : 0.f, fn = hn ? 0.5f : 0.f;
            float okd[4], obq[4];
#pragma unroll
            for (int e = 0; e < 4; ++e) {
                const float a = sigmoidf_(a0v[e] + v[e]);
                const float k = z[e] + ((fp * zp[e] + fn * zn[e]) - z[e]) * mm[e];
                okd[e] = k * (1.f + (a - 1.f) * kav[e]); obq[e] = kk[e] * a;
            }
            uint2 w1; w1.x = pk2(okd[0], okd[1]); w1.y = pk2(okd[2], okd[3]); *(uint2*)(KD + ((size_t)r * 2 + d) * 512 + c) = w1;
            uint2 w2; w2.x = pk2(obq[0], obq[1]); w2.y = pk2(obq[2], obq[3]); *(uint2*)(BQ + ((size_t)r * 2 + d) * 512 + c) = w2;
        } else {
            uint2 w; w.x = pk2(v[0], v[1]); w.y = pk2(v[2], v[3]); *(uint2*)(G + (size_t)r * 512 + c) = w;
        }
    }
    template <int TYPE>
    __device__ __forceinline__ void all(const f32x4 (&acc)[2][2][4][2], const Unit& u, int wr, int wc, int fr, int fq) const {
        const int d = (u.pn >> 1) & 1, cb = (u.pn & 1) * 256 + wc * 32 + 8 * fq;
#pragma unroll
        for (int ai = 0; ai < 2; ++ai)
#pragma unroll
            for (int m = 0; m < 4; ++m)
#pragma unroll
                for (int bj = 0; bj < 2; ++bj)
                {   const int r = u.pm * BM + ai * HALF + wr * 64 + m * 16 + fr, c = cb + bj * HALF;
                    one<TYPE>(acc[ai][bj][m][0], r, c, d); one<TYPE>(acc[ai][bj][m][1], r, c + 4, d); }
    }
    __device__ __forceinline__ void operator()(const f32x4 (&acc)[2][2][4][2], const Unit& u, int wr, int wc, int fr, int fq) const {
        const int type = u.pn >> 1;
        if (type < 2) all<0>(acc, u, wr, wc, fr, fq); else if (type < 4) all<1>(acc, u, wr, wc, fr, fq); else all<2>(acc, u, wr, wc, fr, fq);
    }
};
}

DEV void transpose_item(const float* W, int K, int N, u16* WT, int mode, float* scr, int item, int lane) {
    const int nblk = N / 32, kb = item / nblk, nb = item - kb * nblk, k0 = 64 * kb, n0 = 32 * nb;
#pragma unroll 8
    for (int i = 0; i < 32; ++i) { const int kk = 2 * i + (lane >> 5); scr[kk * 33 + (lane & 31)] = W[(size_t)(k0 + kk) * N + n0 + (lane & 31)]; }
    asm volatile("s_waitcnt lgkmcnt(0)" ::: "memory");
    const int c = lane & 7;
#pragma unroll
    for (int j = 0; j < 4; ++j) {
        const int n = (lane >> 3) + 8 * j; const float* sp = scr + (8 * c) * 33 + n;
        uint4 o; o.x = pk2(sp[0 * 33], sp[1 * 33]); o.y = pk2(sp[2 * 33], sp[3 * 33]); o.z = pk2(sp[4 * 33], sp[5 * 33]); o.w = pk2(sp[6 * 33], sp[7 * 33]);
        const int ns = n0 + n;
        int drow = ns;
        if (mode) { const int nn = ns >= FFH ? 1 : 0; const int g = ns - nn * FFH; drow = 8 * (g >> 2) + 4 * nn + (g & 3); }
        *(uint4*)(WT + (size_t)drow * K + k0 + 8 * c) = o;
    }
    asm volatile("s_waitcnt lgkmcnt(0)" ::: "memory");
}
constexpr size_t WB_IN = 0, WB_OUT = (size_t)3328 * 1024, WB_F1 = WB_OUT + (size_t)1024 * 1024, WB_F2 = WB_F1 + (size_t)5632 * 1024;
DEV void phase_wprep(PPtr p, int layer, char* lds) {
    const int tid = tidx(), lane = tid & 63, wave = tid >> 6, gw = blockIdx.x * NWAVE + wave, ngw = gridDim.x * NWAVE;
    float* scr = (float*)lds + wave * (64 * 33);
    u16* WB = (u16*)(p->ws + OFF_WB);
    const int li = layer >> 1, odd = layer & 1;
    const int nin = odd ? 3328 : 1536;
    const float* win = odd ? p->in[13] + (size_t)li * DM * 3328 : p->in[8] + (size_t)li * DM * 1536;
    const float* wout = (odd ? p->in[14] : p->in[9]) + (size_t)li * DM * DM;
    const float* wf1 = p->in[27] + (size_t)layer * DM * 5632; const float* wf2 = p->in[28] + (size_t)layer * FFH * DM;
    const int i0 = 16 * (nin / 32), i1 = i0 + 16 * 32, i2 = i1 + 16 * 176, i3 = i2 + 44 * 32;
    for (int it = gw; it < i3; it += ngw) {
        if (it < i0) transpose_item(win, DM, nin, WB + WB_IN, 0, scr, it, lane);
        else if (it < i1) transpose_item(wout, DM, DM, WB + WB_OUT, 0, scr, it - i0, lane);
        else if (it < i2) transpose_item(wf1, DM, 5632, WB + WB_F1, 1, scr, it - i1, lane);
        else transpose_item(wf2, FFH, DM, WB + WB_F2, 0, scr, it - i2, lane);
    }
}

#include <hip/hip_bf16.h>
#include <cmath>
namespace attn_body {
using bf16=__hip_bfloat16;
using bf16x8=__attribute__((ext_vector_type(8)))short;
using s16x4=__attribute__((ext_vector_type(4)))short;
using f32x16=__attribute__((ext_vector_type(16)))float;
using u32x4=__attribute__((ext_vector_type(4)))unsigned;
constexpr int D=64,PQ=1536,PO=1024,KROWS=16640,RPBA=16640;
constexpr int NW=8,QBLK=32,QB=QBLK*NW,KVBLK=64;
constexpr int ATTN_UNIT_ROWS=QB;
__device__ __forceinline__ int crow(int r,int hi){return (r&3)+8*(r>>2)+4*hi;}
#define SBAR() __builtin_amdgcn_sched_barrier(0)
__device__ __forceinline__ void cmask(f32x16&p0,f32x16&p1,int jb,int qrel,int hi){
  const float NEG=-INFINITY; int kb=64*jb+4*hi;
  #pragma unroll
  for(int r=0;r<16;++r){int kv=kb+(r&3)+8*(r>>2); if(kv>qrel)p0[r]=NEG; if(kv+32>qrel)p1[r]=NEG;}
}

constexpr int NSLOT=3, SLOTB=8192;
constexpr int LDS_K=0, LDS_V=NSLOT*SLOTB, LDS_WS=2*NSLOT*SLOTB, LDS_OST=LDS_WS+NW*64*4, LDS_BYTES=LDS_OST+NW*4096;
constexpr float C2=0.125f*1.4426950408889634f;
__device__ __forceinline__ void glds16(const void*gsrc,unsigned lds_dst){unsigned keep;
  asm volatile("s_mov_b32 %0, m0\n\ts_mov_b32 m0, %2\n\ts_nop 0\n\tglobal_load_lds_dwordx4 %1, off\n\ts_mov_b32 m0, %0":"=&s"(keep):"v"(gsrc),"s"(lds_dst):"memory");}
__device__ __forceinline__ float max3f(float a,float b,float c){float r;asm("v_max3_f32 %0, %1, %2, %3":"=v"(r):"v"(a),"v"(b),"v"(c));return r;}
__device__ __forceinline__ float max2f(float a,float b){float r;asm("v_max_f32_e32 %0, %1, %2":"=v"(r):"v"(a),"v"(b));return r;}
__device__ __forceinline__ float fadd_s(float a,float b){float r;asm("v_add_f32_e32 %0, %1, %2":"=v"(r):"v"(a),"v"(b));return r;}
__device__ __forceinline__ float fsub_s(float a,float b){float r;asm("v_sub_f32_e32 %0, %1, %2":"=v"(r):"v"(a),"v"(b));return r;}
typedef float f32x2_t __attribute__((ext_vector_type(2))); typedef __bf16 bf16x2_t __attribute__((ext_vector_type(2)));
__device__ __forceinline__ unsigned cvtpk_s(float lo,float hi){f32x2_t v={lo,hi};bf16x2_t b=__builtin_convertvector(v,bf16x2_t);return __builtin_bit_cast(unsigned,b);}
#define WAIT_BAR(N) asm volatile("s_waitcnt vmcnt(" #N ") lgkmcnt(0)\n\ts_barrier":::"memory")

__device__ __forceinline__ void qkt(f32x16&p0,f32x16&p1,const char*Kslot,const bf16x8*qr,const f32x16&negm,int r32,int hi){
  const char*kb=Kslot+hi*1024+r32*16;
  #pragma unroll
  for(int d0=0;d0<4;++d0){
    const bf16x8 b0=*reinterpret_cast<const bf16x8*>(kb+d0*2048);
    const bf16x8 b1=*reinterpret_cast<const bf16x8*>(kb+d0*2048+512);
    if(d0==0){p0=__builtin_amdgcn_mfma_f32_32x32x16_bf16(b0,qr[0],negm,0,0,0);p1=__builtin_amdgcn_mfma_f32_32x32x16_bf16(b1,qr[0],negm,0,0,0);}
    else{p0=__builtin_amdgcn_mfma_f32_32x32x16_bf16(b0,qr[d0],p0,0,0,0);p1=__builtin_amdgcn_mfma_f32_32x32x16_bf16(b1,qr[d0],p1,0,0,0);}}
}
typedef __attribute__((address_space(3))) const char* lds_cptr;
typedef short v4i16_t __attribute__((ext_vector_type(4)));
__device__ __forceinline__ void kload8(bf16x8*kf,lds_cptr kp){
  kf[0]=*(const __attribute__((address_space(3))) bf16x8*)(kp);      kf[1]=*(const __attribute__((address_space(3))) bf16x8*)(kp+512);
  kf[2]=*(const __attribute__((address_space(3))) bf16x8*)(kp+2048); kf[3]=*(const __attribute__((address_space(3))) bf16x8*)(kp+2560);
  kf[4]=*(const __attribute__((address_space(3))) bf16x8*)(kp+4096); kf[5]=*(const __attribute__((address_space(3))) bf16x8*)(kp+4608);
  kf[6]=*(const __attribute__((address_space(3))) bf16x8*)(kp+6144); kf[7]=*(const __attribute__((address_space(3))) bf16x8*)(kp+6656);
}
__device__ __forceinline__ void kload2(bf16x8*kf,lds_cptr kp,int j){ kf[2*j]=*(const __attribute__((address_space(3))) bf16x8*)(kp+j*2048); kf[2*j+1]=*(const __attribute__((address_space(3))) bf16x8*)(kp+j*2048+512); }
__device__ __forceinline__ s16x4 vtr(lds_cptr p){ return __builtin_bit_cast(s16x4,__builtin_amdgcn_ds_read_tr16_b64_v4i16((__attribute__((address_space(3))) v4i16_t*)p)); }
__device__ __forceinline__ float rowmax(const f32x16&p0,const f32x16&p1){
  float a=max3f(p0[0],p0[1],p1[0]),b=max3f(p0[2],p0[3],p1[1]);a=max3f(a,p1[2],p1[3]);
  #pragma unroll
  for(int r=4;r<16;r+=4){a=max3f(a,p0[r],p0[r+1]);b=max3f(b,p0[r+2],p0[r+3]);a=max3f(a,p1[r],p1[r+1]);b=max3f(b,p1[r+2],p1[r+3]);}
  const float m=max2f(a,b);
  auto rr=__builtin_amdgcn_permlane32_swap(__float_as_uint(m),__float_as_uint(m),false,false);
  return max2f(__uint_as_float(rr[0]),__uint_as_float(rr[1]));
}
__device__ __forceinline__ void pv(f32x16*o,int vb,bf16x8 pa0,bf16x8 pa1,bf16x8 pa2,bf16x8 pa3){
  #pragma unroll
  for(int d0=0;d0<2;++d0){s16x4 lo[4],hi[4];
    #pragma unroll
    for(int ks=0;ks<4;++ks){
      asm volatile("ds_read_b64_tr_b16 %0,%1 offset:%c2":"=&v"(lo[ks]):"v"(vb),"i"(d0*4096+ks*1024):"memory");
      asm volatile("ds_read_b64_tr_b16 %0,%1 offset:%c2":"=&v"(hi[ks]):"v"(vb),"i"(d0*4096+ks*1024+512):"memory");}
    asm volatile("s_waitcnt lgkmcnt(0)":::"memory");SBAR();
    #define PK(k) (bf16x8){lo[k][0],lo[k][1],lo[k][2],lo[k][3],hi[k][0],hi[k][1],hi[k][2],hi[k][3]}
    o[d0]=__builtin_amdgcn_mfma_f32_32x32x16_bf16(pa0,PK(0),o[d0],0,0,0);
    o[d0]=__builtin_amdgcn_mfma_f32_32x32x16_bf16(pa1,PK(1),o[d0],0,0,0);
    o[d0]=__builtin_amdgcn_mfma_f32_32x32x16_bf16(pa2,PK(2),o[d0],0,0,0);
    o[d0]=__builtin_amdgcn_mfma_f32_32x32x16_bf16(pa3,PK(3),o[d0],0,0,0);
    #undef PK
  }
}

#ifndef ATTN_STORE16
#define ATTN_STORE16(p,v) (*(u32x4*)(p)=(v))
#endif
template<int THRL> __device__ __forceinline__ void attn_unit(int b,int h,int qb,const bf16*Q,const bf16*__restrict__ K,const bf16*__restrict__ V,bf16*O,char*shm){
  const int tid=tidx(),lane=tid&63,r32=lane&31,hi=lane>>5; const int wid=__builtin_amdgcn_readfirstlane(tid>>6);
  const long rowbase=(long)b*RPBA; const int q0=qb*QB;
  const bf16*Qw=Q+(rowbase+q0+wid*QBLK)*PQ+h*D;
  const bf16*Kh=K+rowbase*PQ+(h>>2)*D,*Vh=V+rowbase*PQ+(h>>2)*D;
  const unsigned lds0=(unsigned)(uintptr_t)shm;
  float*wsf=(float*)(shm+LDS_WS)+wid*64;
  const bf16*ksrc=Kh+(long)lane*PQ+wid*8;
  const bf16*vsrc=Vh+(long)(16*(wid&3)+(lane>>2))*PQ+(wid>>2)*32+(lane&3)*8;
  const unsigned kdst=lds0+LDS_K+wid*1024, vdst=lds0+LDS_V+wid*1024;
  #define DMA_K(t,slot) glds16(ksrc+(long)(t)*KVBLK*PQ,(unsigned)__builtin_amdgcn_readfirstlane(kdst+(slot)))
  #define DMA_V(t,slot) glds16(vsrc+(long)(t)*KVBLK*PQ,(unsigned)__builtin_amdgcn_readfirstlane(vdst+(slot)))
  const int vb0=(int)(lds0+LDS_V)+((lane>>4)&1)*32+(lane&3)*8+(4*hi+((lane&15)>>2))*64;
  const char*Kbase=shm+LDS_K; bf16x8 kf[8];
  const lds_cptr shm3=(lds_cptr)shm; const lds_cptr kp0=shm3+LDS_K+hi*1024+r32*16; const lds_cptr vp0=shm3+LDS_V+((lane>>4)&1)*32+(lane&3)*8+(4*hi+((lane&15)>>2))*64;
  const int NT=KROWS/KVBLK;
  DMA_K(0,0);DMA_V(0,0);DMA_K(1,SLOTB);
  bf16x8 qr[4];
  #pragma unroll
  for(int d0=0;d0<4;++d0)qr[d0]=*reinterpret_cast<const bf16x8*>(&Qw[(long)r32*PQ+d0*16+hi*8]);
  float mhat=0.f,l_reg=0.f;f32x16 o[2];o[0]=f32x16{};o[1]=f32x16{};f32x16 negm=f32x16{};asm volatile("":"+v"(negm));
  const int qrel=wid*QBLK+r32;
  #define CMASK(P0,P1,t) do{}while(0)
  bool resc=false;
  #define START(P0,P1) do{ const float rm=rowmax(P0,P1); resc=false; \
    { const float dl=rm; mhat=fadd_s(mhat,dl); \
      _Pragma("unroll") for(int r=0;r<16;++r){P0[r]=fsub_s(P0[r],dl);P1[r]=fsub_s(P1[r],dl);} \
      _Pragma("unroll") for(int r=0;r<16;++r)negm[r]=-mhat; asm volatile("":"+v"(negm)); } \
    _Pragma("unroll") for(int r=0;r<16;++r)P0[r]=__builtin_amdgcn_exp2f(P0[r]); }while(0)
  #define RESC() do{ if(resc){ asm volatile("s_waitcnt lgkmcnt(0)":::"memory"); \
      _Pragma("unroll") for(int d_=0;d_<2;++d_) _Pragma("unroll") for(int r=0;r<16;++r)o[d_][r]*=wsf[crow(r,hi)]; } }while(0)
  f32x16 pA0,pA1,pB0,pB1;
  int sl_prev=0,sl_cur=0,sl_next=SLOTB;
  #define ROT() do{sl_prev=sl_cur;sl_cur=sl_next;sl_next=(sl_next==(NSLOT-1)*SLOTB)?0:sl_next+SLOTB;}while(0)
  DMA_K(2,2*SLOTB);
  WAIT_BAR(3);
  qkt(pA0,pA1,Kbase,qr,negm,r32,hi);asm volatile("s_nop 15\n\ts_nop 7":"+v"(pA0),"+v"(pA1));CMASK(pA0,pA1,0);
  START(pA0,pA1);
  _Pragma("unroll") for(int r=0;r<16;++r)pA1[r]=__builtin_amdgcn_exp2f(pA1[r]);
  WAIT_BAR(0);
  DMA_K(3,0);DMA_V(1,SLOTB);
  ROT();
  kload8(kf,kp0+sl_cur);
  WAIT_BAR(2);
  s16x4 vlo[8],vhi[8]; u32x4 pw0,pw1,pw2,pw3;
  #define PKW(P,B) cvtpk_s(P[B],P[B+1])
  #define PAF(k) __builtin_bit_cast(bf16x8,pw##k)
  #define VFR(i) (bf16x8){vlo[i][0],vlo[i][1],vlo[i][2],vlo[i][3],vhi[i][0],vhi[i][1],vhi[i][2],vhi[i][3]}
  #define PIN(x) asm volatile("":"+v"(x))
  #define MX3(a,b,c) __builtin_fmaxf(__builtin_fmaxf((a),(b)),(c))
  #define GAPA(MF,A0,A1,A2,A3,W0,W1,PW) do{ MF; sacc+=A0; sacc+=A1; sacc+=A2; sacc+=A3; PIN(sacc); W0; W1; PIN(PW); SBAR(); }while(0)
  #define EX(v) __builtin_amdgcn_exp2f(v)
  #define GAPB(MF,X,B) do{ MF; X[B]=EX(X[B]); X[B+1]=EX(X[B+1]); X[B+2]=EX(X[B+2]); X[B+3]=EX(X[B+3]); PIN(X); SBAR(); }while(0)
  #define VRD(i) do{ vlo[i]=vtr(vp_+(((i)>>2)*4096+((i)&3)*1024)); vhi[i]=vtr(vp_+(((i)>>2)*4096+((i)&3)*1024+512)); }while(0)
  #define KRD(G,j) do{ if(G){ kload2(kf,kp0+sl_next,j); SBAR(); } }while(0)
  #define STEP(C0,C1,P0,P1,t,GK,GV,GL) do{ SBAR(); \
    const lds_cptr vp_=vp0+sl_prev; \
    VRD(0); SBAR(); float sacc=(P0[0]+P0[1]); \
    GAPA(C0=__builtin_amdgcn_mfma_f32_32x32x16_bf16(kf[0],qr[0],negm,0,0,0), P0[2],P0[3],P0[4],P0[5],     pw0[0]=PKW(P0,0), pw0[1]=PKW(P0,2), pw0); \
    VRD(4); SBAR(); GAPA(C1=__builtin_amdgcn_mfma_f32_32x32x16_bf16(kf[1],qr[0],negm,0,0,0), P0[6],P0[7],P0[8],P0[9],     pw0[2]=PKW(P0,4), pw0[3]=PKW(P0,6), pw0); \
    VRD(1); SBAR(); GAPA(C0=__builtin_amdgcn_mfma_f32_32x32x16_bf16(kf[2],qr[1],C0,0,0,0),   P0[10],P0[11],P0[12],P0[13], pw1[0]=PKW(P0,8), pw1[1]=PKW(P0,10), pw1); \
    VRD(5); SBAR(); GAPA(C1=__builtin_amdgcn_mfma_f32_32x32x16_bf16(kf[3],qr[1],C1,0,0,0),   P0[14],P0[15],P1[0],P1[1],   pw1[2]=PKW(P0,12),pw1[3]=PKW(P0,14), pw1); \
    VRD(2); SBAR(); GAPA(C0=__builtin_amdgcn_mfma_f32_32x32x16_bf16(kf[4],qr[2],C0,0,0,0),   P1[2],P1[3],P1[4],P1[5],     pw2[0]=PKW(P1,0), pw2[1]=PKW(P1,2), pw2); \
    VRD(6); SBAR(); GAPA(C1=__builtin_amdgcn_mfma_f32_32x32x16_bf16(kf[5],qr[2],C1,0,0,0),   P1[6],P1[7],P1[8],P1[9],     pw2[2]=PKW(P1,4), pw2[3]=PKW(P1,6), pw2); \
    VRD(3); SBAR(); GAPA(C0=__builtin_amdgcn_mfma_f32_32x32x16_bf16(kf[6],qr[3],C0,0,0,0),   P1[10],P1[11],P1[12],P1[13], pw3[0]=PKW(P1,8), pw3[1]=PKW(P1,10), pw3); \
    VRD(7); SBAR(); GAPA(C1=__builtin_amdgcn_mfma_f32_32x32x16_bf16(kf[7],qr[3],C1,0,0,0),   P1[14],P1[15],0.f,0.f,       pw3[2]=PKW(P1,12),pw3[3]=PKW(P1,14), pw3); \
    l_reg+=sacc; \
    if(GK){DMA_K((t)+3,sl_cur);} if(GV){DMA_V((t)+1,sl_next);} \
    CMASK(C0,C1,t); \
    { float a=MX3(C0[0],C0[1],C1[0]),b=MX3(C0[2],C0[3],C1[1]); a=MX3(a,C1[2],C1[3]); \
      _Pragma("unroll") for(int r=4;r<16;r+=4){a=MX3(a,C0[r],C0[r+1]);b=MX3(b,C0[r+2],C0[r+3]);a=MX3(a,C1[r],C1[r+1]);b=MX3(b,C1[r+2],C1[r+3]);} \
      float rm=__builtin_fmaxf(a,b); { auto rr=__builtin_amdgcn_permlane32_swap(__float_as_uint(rm),__float_as_uint(rm),false,false); rm=__builtin_fmaxf(__uint_as_float(rr[0]),__uint_as_float(rr[1])); } \
      resc=false; \
      if(__builtin_expect(__any(rm>(float)THRL),0)){ const float dl=__builtin_fmaxf(rm,0.f); mhat+=dl; \
        _Pragma("unroll") for(int r=0;r<16;++r){C0[r]-=dl;C1[r]-=dl;} \
        _Pragma("unroll") for(int r=0;r<16;++r)negm[r]=-mhat; asm volatile("":"+v"(negm)); \
        const float f=__builtin_amdgcn_exp2f(-dl); l_reg*=f; if(hi==0)wsf[r32]=f; resc=true; } } \
    SBAR(); \
    GAPB(o[0]=__builtin_amdgcn_mfma_f32_32x32x16_bf16(PAF(0),VFR(0),o[0],0,0,0), C0,0); \
    GAPB(o[1]=__builtin_amdgcn_mfma_f32_32x32x16_bf16(PAF(0),VFR(4),o[1],0,0,0), C0,4); \
    KRD(GL,0); GAPB(o[0]=__builtin_amdgcn_mfma_f32_32x32x16_bf16(PAF(1),VFR(1),o[0],0,0,0), C0,8); \
    KRD(GL,1); GAPB(o[1]=__builtin_amdgcn_mfma_f32_32x32x16_bf16(PAF(1),VFR(5),o[1],0,0,0), C0,12); \
    KRD(GL,2); GAPB(o[0]=__builtin_amdgcn_mfma_f32_32x32x16_bf16(PAF(2),VFR(2),o[0],0,0,0), C1,0); \
    KRD(GL,3); GAPB(o[1]=__builtin_amdgcn_mfma_f32_32x32x16_bf16(PAF(2),VFR(6),o[1],0,0,0), C1,4); \
    GAPB(o[0]=__builtin_amdgcn_mfma_f32_32x32x16_bf16(PAF(3),VFR(3),o[0],0,0,0), C1,8); \
    GAPB(o[1]=__builtin_amdgcn_mfma_f32_32x32x16_bf16(PAF(3),VFR(7),o[1],0,0,0), C1,12); \
    }while(0)
  int t=1;
  #undef CMASK
  #define CMASK(P0,P1,t) do{}while(0)
  for(;t+5<NT;t+=2){
    STEP(pB0,pB1,pA0,pA1,t,true,true,true);     WAIT_BAR(2); RESC(); ROT();
    STEP(pA0,pA1,pB0,pB1,t+1,true,true,true);   WAIT_BAR(2); RESC(); ROT();
  }
  #undef CMASK
  #define CMASK(P0,P1,t) do{}while(0)
  #define ENDW(tt) do{ if((tt)+3<NT){WAIT_BAR(2);} else if((tt)+2<NT){WAIT_BAR(1);} else {WAIT_BAR(0);} }while(0)
  for(;t+1<NT;t+=2){
    STEP(pB0,pB1,pA0,pA1,t,(t+3<NT),(t+1<NT),(t+1<NT));       ENDW(t);   RESC(); ROT();
    STEP(pA0,pA1,pB0,pB1,t+1,(t+4<NT),(t+2<NT),(t+2<NT));     ENDW(t+1); RESC(); ROT();
  }
  STEP(pB0,pB1,pA0,pA1,NT-1,false,false,false); RESC();
  { float sacc=pB0[0]+pB0[1]; _Pragma("unroll") for(int r=2;r<16;++r)sacc+=pB0[r]; _Pragma("unroll") for(int r=0;r<16;++r)sacc+=pB1[r]; l_reg+=sacc;
    pw0=(u32x4){PKW(pB0,0),PKW(pB0,2),PKW(pB0,4),PKW(pB0,6)};pw1=(u32x4){PKW(pB0,8),PKW(pB0,10),PKW(pB0,12),PKW(pB0,14)};pw2=(u32x4){PKW(pB1,0),PKW(pB1,2),PKW(pB1,4),PKW(pB1,6)};pw3=(u32x4){PKW(pB1,8),PKW(pB1,10),PKW(pB1,12),PKW(pB1,14)};
    SBAR(); pv(o,vb0+sl_cur,PAF(0),PAF(1),PAF(2),PAF(3)); }
  #undef PKW
  #undef PAF
  #undef VFR
  #undef PIN
  #undef MX3
  #undef GAPA
  #undef GAPB
  #undef EX
  #undef VRD
  #undef KRD
  #undef STEP
  #undef ENDW
  {auto rr=__builtin_amdgcn_permlane32_swap(__float_as_uint(l_reg),__float_as_uint(l_reg),false,false);l_reg=__uint_as_float(rr[0])+__uint_as_float(rr[1]);}
  if(hi==0)wsf[32+r32]=l_reg;asm volatile("s_waitcnt lgkmcnt(0)":::"memory");
  float rli[16];
  #pragma unroll
  for(int r=0;r<16;++r)rli[r]=__builtin_amdgcn_rcpf(wsf[32+crow(r,hi)]);
  bf16*Ow=O+(rowbase+q0+wid*QBLK)*PO+h*D;
  { bf16*stg=(bf16*)(shm+LDS_OST)+wid*2048;
    #pragma unroll
    for(int r=0;r<16;++r){const int orow=crow(r,hi);
      #pragma unroll
      for(int d0=0;d0<2;++d0)stg[orow*64+d0*32+r32]=__float2bfloat16(o[d0][r]*rli[r]);}
    asm volatile("s_waitcnt lgkmcnt(0)":::"memory");
    #pragma unroll
    for(int i=0;i<4;++i){const int row=i*8+(lane>>3),ch=lane&7; const u32x4 v=*(const u32x4*)(stg+row*64+ch*8); ATTN_STORE16(Ow+(long)row*PO+ch*8,v);} }
  asm volatile("s_waitcnt lgkmcnt(0)\n\ts_barrier":::"memory");
  #undef DMA_K
  #undef DMA_V
  #undef CMASK
  #undef START
  #undef RESC
  #undef ROT
}
constexpr int ATTN_LDS_BYTES=LDS_BYTES;
#undef SBAR
#undef WAIT_BAR
}

DEV void phase_even_post(PPtr p, int li) {
    const int tid = tidx(), lane = tid & 63, gw = blockIdx.x * NWAVE + (tid >> 6), ngw = gridDim.x * NWAVE;
    u16* RAW = (u16*)(p->ws + OFF_RAW);
    const float* qg = p->in[10] + li * 64; const float* kg = p->in[11] + li * 64;
    const float* T = (const float*)(p->ws + OFF_ROPE);
    const int w8 = (lane & 7) * 8, i0 = w8 & 31; const bool second = (lane & 4) != 0;
    for (int item = gw; item < MROWS * 3; item += ngw) {
        const int m = item / 3, pass = item - 3 * m;
        if (pass == 2 && lane >= 32) continue;
        const int b = m / RPB, q = m - b * RPB;
        const int sl = pass * 8 + (lane >> 3);
        const int c0 = sl < 8 ? sl * 64 : sl < 10 ? 512 + (sl - 8) * 64 : sl < 18 ? 768 + (sl - 10) * 64 : 1280 + (sl - 18) * 64;
        u16* ptr = RAW + (size_t)m * 1536 + c0 + w8;
        float x[8]; unpack8(*(const uint4*)ptr, x);
        if (sl < 10) {
            const float* gn = (sl < 8 ? qg : kg) + w8;
            float ss = 0.f;
#pragma unroll
            for (int e = 0; e < 8; ++e) ss += x[e] * x[e];
            ss += __shfl_xor(ss, 1); ss += __shfl_xor(ss, 2); ss += __shfl_xor(ss, 4);
            const float rs = rsqrtf(ss * (1.f / 64.f) + 1e-6f);
            const float4 g0 = *(const float4*)gn, g1 = *(const float4*)(gn + 4);
            x[0] *= rs * g0.x; x[1] *= rs * g0.y; x[2] *= rs * g0.z; x[3] *= rs * g0.w; x[4] *= rs * g1.x; x[5] *= rs * g1.y; x[6] *= rs * g1.z; x[7] *= rs * g1.w;
        }
        if (q < SEQ) {
            const float* ct = (i0 < 16) ? T + (q >> 6) * 16 + i0 : T + 8192 + (q & 63) * 16 + (i0 - 16);
            const float* st = ct + ((i0 < 16) ? 4096 : 1024);
            const float4 c0v = *(const float4*)ct, c1v = *(const float4*)(ct + 4), s0v = *(const float4*)st, s1v = *(const float4*)(st + 4);
            const float cs[8] = {c0v.x, c0v.y, c0v.z, c0v.w, c1v.x, c1v.y, c1v.z, c1v.w}, sn[8] = {s0v.x, s0v.y, s0v.z, s0v.w, s1v.x, s1v.y, s1v.z, s1v.w};
            const float sc = (sl < 8) ? attn_body::C2 : 1.f;
#pragma unroll
            for (int e = 0; e < 8; ++e) {
                const float other = __shfl_xor(x[e], 4);
                const float o = second ? (other * sn[e] + x[e] * cs[e]) : (x[e] * cs[e] - other * sn[e]);
                x[e] = o * sc;
            }
        }
        *(uint4*)ptr = pack8(x);
    }
}

template <int mode, bool qctx>
DEV void attn_wave(const u16* QB, int pitch, int qcol, int kcol, int vcol, u16* AO, int ocol,
                   int b, int hk, int blk, const float* sinkp, const float* rpb, u16* sV) {
    const int lane = tidx() & 63, qi = lane & 15, quad = lane >> 4;
    const bool gqa = mode < 2;
    const size_t rowb = (size_t)b * RPB;
    const float SCL = 0.125f * LOG2E;
    int qtok[4], qhead[4]; bf16x8 qf[4][2];
#pragma unroll
    for (int i = 0; i < 4; ++i) {
        qtok[i] = gqa ? blk * 16 + qi : blk * 64 + i * 16 + qi; qhead[i] = gqa ? hk * 4 + i : hk;
        const size_t m = rowb + (qctx ? SEQ : 0) + qtok[i];
        const u16* qp = QB + m * pitch + qcol + qhead[i] * 64 + quad * 8;
        qf[i][0] = *(const bf16x8*)qp; qf[i][1] = *(const bf16x8*)(qp + 32);
    }
    f32x4 o[4][4]; float mrun[4], lrun[4];
#pragma unroll
    for (int i = 0; i < 4; ++i) {
#pragma unroll
        for (int d = 0; d < 4; ++d) o[i][d] = (f32x4){0.f, 0.f, 0.f, 0.f};
        if (mode == 1) { mrun[i] = sinkp[qhead[i]] * LOG2E; lrun[i] = (quad == 0) ? 1.f : 0.f; } else { mrun[i] = -1e30f; lrun[i] = 0.f; }
    }
    const u16* Kb = QB + kcol + hk * 64; const u16* Vb = QB + vcol + hk * 64;
    int n_local, ustart, rs = 0;
    if (qctx) { n_local = 0; ustart = 0; }
    else if (mode == 0) { n_local = RPB / 32; ustart = 0; }
    else if (mode == 1) { n_local = 9; ustart = blk * 16 - 128; }
    else { rs = min(max(blk - 4, 0), 248); n_local = 16; ustart = rs * 64; }
    const int n_ctx = (mode == 0 && !qctx) ? 0 : 8;
    for (int tt = 0; tt < n_local + n_ctx; ++tt) {
        const bool loc = tt < n_local;
        const int u0 = loc ? ustart + 32 * tt : SEQ + 32 * (tt - n_local);
        const bool masked = loc && mode != 0;
        bf16x8 kf[2][2];
#pragma unroll
        for (int kt = 0; kt < 2; ++kt) {
            const int u = min(max(u0 + kt * 16 + qi, 0), RPB - 1);
            const u16* kp = Kb + (rowb + u) * pitch + quad * 8;
            kf[kt][0] = *(const bf16x8*)kp; kf[kt][1] = *(const bf16x8*)(kp + 32);
        }
#pragma unroll
        for (int c = 0; c < 4; ++c) {
            const int idx = c * 64 + lane, key = idx >> 3, dc = idx & 7;
            const int u = min(max(u0 + key, 0), RPB - 1);
            const uint4 v = *(const uint4*)(Vb + (rowb + u) * pitch + dc * 8);
            *(uint4*)(sV + key * 72 + dc * 8) = v;
        }
        bf16x8 vf[4];
#pragma unroll
        for (int dt = 0; dt < 4; ++dt)
#pragma unroll
            for (int jj = 0; jj < 8; ++jj) {
                const int key = (jj < 4) ? quad * 4 + jj : 16 + quad * 4 + (jj - 4);
                vf[dt][jj] = (short)sV[key * 72 + dt * 16 + qi];
            }
#pragma unroll
        for (int i = 0; i < 4; ++i) {
            f32x4 s0 = (f32x4){0.f, 0.f, 0.f, 0.f}, s1 = (f32x4){0.f, 0.f, 0.f, 0.f};
            s0 = __builtin_amdgcn_mfma_f32_16x16x32_bf16(kf[0][0], qf[i][0], s0, 0, 0, 0);
            s0 = __builtin_amdgcn_mfma_f32_16x16x32_bf16(kf[0][1], qf[i][1], s0, 0, 0, 0);
            s1 = __builtin_amdgcn_mfma_f32_16x16x32_bf16(kf[1][0], qf[i][0], s1, 0, 0, 0);
            s1 = __builtin_amdgcn_mfma_f32_16x16x32_bf16(kf[1][1], qf[i][1], s1, 0, 0, 0);
            float sc[8];
#pragma unroll
            for (int j = 0; j < 4; ++j) { sc[j] = s0[j] * SCL; sc[4 + j] = s1[j] * SCL; }
            if (masked) {
                const int t = qtok[i];
#pragma unroll
                for (int e = 0; e < 8; ++e) {
                    const int u = u0 + (e >> 2) * 16 + quad * 4 + (e & 3);
                    if (mode == 1) {
                        const int dd = t - u;
                        const bool ok = (u >= 0) && (u < SEQ) && (dd <= 128) && (dd >= -128);
                        if (!ok) sc[e] = -INFINITY;
                    } else {
                        const int c = t & 63, r = t >> 6, ur = u >> 6, uc = u & 63;
                        const int cst = min(max(c - 8, 0), 48);
                        const bool ok = (uc >= cst) && (uc < cst + 16);
                        const int dr = min(max(ur - r + 7, 0), 14), dcx = min(max(uc - c + 15, 0), 30);
                        const float bias = rpb[(qhead[i] * 15 + dr) * 31 + dcx];
                        sc[e] = ok ? sc[e] + bias * LOG2E : -INFINITY;
                    }
                }
            }
            float mx = fmaxf(fmaxf(fmaxf(sc[0], sc[1]), fmaxf(sc[2], sc[3])), fmaxf(fmaxf(sc[4], sc[5]), fmaxf(sc[6], sc[7])));
            mx = fmaxf(mx, __shfl_xor(mx, 16)); mx = fmaxf(mx, __shfl_xor(mx, 32));
            const float mn = fmaxf(mrun[i], mx);
            const float al = __builtin_amdgcn_exp2f(mrun[i] - mn);
            mrun[i] = mn;
            float pe[8], ps = 0.f;
#pragma unroll
            for (int e = 0; e < 8; ++e) { pe[e] = __builtin_amdgcn_exp2f(sc[e] - mn); ps += pe[e]; }
            lrun[i] = lrun[i] * al + ps;
            union { unsigned u[4]; bf16x8 v; } pf;
            pf.u[0] = pk2(pe[0], pe[1]); pf.u[1] = pk2(pe[2], pe[3]); pf.u[2] = pk2(pe[4], pe[5]); pf.u[3] = pk2(pe[6], pe[7]);
#pragma unroll
            for (int dt = 0; dt < 4; ++dt) {
                o[i][dt] = o[i][dt] * al;
                o[i][dt] = __builtin_amdgcn_mfma_f32_16x16x32_bf16(vf[dt], pf.v, o[i][dt], 0, 0, 0);
            }
        }
    }
#pragma unroll
    for (int i = 0; i < 4; ++i) {
        float l = lrun[i]; l += __shfl_xor(l, 16); l += __shfl_xor(l, 32);
        const float inv = 1.f / l;
        const size_t m = rowb + (qctx ? SEQ : 0) + qtok[i];
        u16* op = AO + m * DM + ocol + qhead[i] * 64 + quad * 4;
#pragma unroll
        for (int dt = 0; dt < 4; ++dt) {
            uint2 w; w.x = pk2(o[i][dt][0] * inv, o[i][dt][1] * inv); w.y = pk2(o[i][dt][2] * inv, o[i][dt][3] * inv);
            *(uint2*)(op + dt * 16) = w;
        }
    }
}

DEV void phase_attn_even(PPtr p, int li, char* lds) {
    {
        const attn_body::bf16* RAWb = (const attn_body::bf16*)(p->ws + OFF_RAW); attn_body::bf16* AOb = (attn_body::bf16*)(p->ws + OFF_AO);
        const int G = gridDim.x, bx = blockIdx.x;
        if (G == 256) {
            const int vcu = (bx & 7) * 32 + (bx >> 3); const int x = vcu >> 5, combo = x >> 1, sub = (x & 1) * 32 + (vcu & 31);
            for (int i = 0; i < 4; ++i) attn_body::attn_unit<8>(combo >> 1, (combo & 1) * 4 + i, sub, RAWb, RAWb + 512, RAWb + 640, AOb, lds);
        } else {
            for (int u = bx; u < 1024; u += G) attn_body::attn_unit<8>(u >> 9, (u >> 6) & 7, u & 63, RAWb, RAWb + 512, RAWb + 640, AOb, lds);
        }
    }
    const int wave = tidx() >> 6, gw = blockIdx.x * NWAVE + wave, ngw = gridDim.x * NWAVE;
    u16* sV = (u16*)lds + wave * (32 * 72);
    const u16* RAW = (const u16*)(p->ws + OFF_RAW); u16* AO = (u16*)(p->ws + OFF_AO);
    const float* sink = p->in[12] + li * 8;
    for (int t = gw; t < 4224; t += ngw) {
        if (t < 4096) attn_wave<1, false>(RAW, 1536, 768, 1280, 1408, AO, 512, t >> 11, (t >> 10) & 1, t & 1023, sink, nullptr, sV);
        else if (t < 4160) { const int u = t - 4096; attn_wave<0, true>(RAW, 1536, 0, 512, 640, AO, 0, u >> 5, (u >> 4) & 1, u & 15, nullptr, nullptr, sV); }
        else { const int u = t - 4160; attn_wave<1, true>(RAW, 1536, 768, 1280, 1408, AO, 512, u >> 5, (u >> 4) & 1, u & 15, sink, nullptr, sV); }
    }
}
DEV void phase_attn_odd(PPtr p, int li, char* lds) {
    const int wave = tidx() >> 6, gw = blockIdx.x * NWAVE + wave, ngw = gridDim.x * NWAVE;
    u16* sV = (u16*)lds + wave * (32 * 72);
    const u16* QKV = (const u16*)(p->ws + OFF_RAW); u16* AO = (u16*)(p->ws + OFF_AO);
    const float* rpb = p->in[15] + li * 8 * 15 * 31;
    for (int t = gw; t < 4160; t += ngw) {
        if (t < 4096) attn_wave<2, false>(QKV, 1536, 0, 512, 1024, AO, 0, t >> 11, (t >> 8) & 7, t & 255, nullptr, rpb, sV);
        else { const int u = t - 4096; attn_wave<2, true>(QKV, 1536, 0, 512, 1024, AO, 0, u >> 5, (u >> 2) & 7, u & 3, nullptr, rpb, sV); }
    }
}

DEV float shiftmix_at(const u16* ZDb, int pp, int ch, float mu) {
    const bool lat = pp < SEQ; const int lo = lat ? 0 : SEQ, hi = lat ? SEQ : RPB;
    const u16* zc = ZDb + (size_t)pp * ZDW + ch;
    const float z = bf2f(zc[0]);
    const float a = (pp - 1 >= lo) ? bf2f(zc[-ZDW]) : 0.f, c = (pp + 1 < hi) ? bf2f(zc[ZDW]) : 0.f;
    return z + (0.5f * (a + c) - z) * mu;
}
DEV void phase_rwkv_prep(PPtr p, int li, int bb) {
    const int tid = tidx(), lane = tid & 63, gw = blockIdx.x * NWAVE + (tid >> 6), ngw = gridDim.x * NWAVE;
    const u16* ZDb = (const u16*)(p->ws + OFF_ZD) + (size_t)bb * RPB * ZDW;
    const float* mu = p->in[16] + li * ZDW; const float* kkw = p->in[22] + li * 512;
    u16* R = (u16*)(p->ws + OFF_R); u16* KK = (u16*)(p->ws + OFF_KK); u16* V = (u16*)(p->ws + OFF_V); u16* LA = (u16*)(p->ws + OFF_LA);
    {
        u16* LB = (u16*)(p->ws + OFF_PU);
        const float* w2 = p->in[18] + (size_t)li * 2 * 64 * 512; const float* a2 = p->in[20] + (size_t)li * 2 * 64 * 512; const float* g2 = p->in[21] + (size_t)li * 128 * 512;
        for (int idx = gw * 64 + lane; idx < 2560 * 32; idx += ngw * 64) {
            const int n = idx >> 5, kc = (idx & 31) * 8, type = n >> 9, nn = n & 511;
            float f[8];
#pragma unroll
            for (int e = 0; e < 8; ++e) {
                const int k = kc + e; float x = 0.f;
                if (type < 2) { if (k < 64) x = w2[((size_t)type * 64 + k) * 512 + nn]; }
                else if (type < 4) { if (k >= 64 && k < 128) x = a2[((size_t)(type - 2) * 64 + (k - 64)) * 512 + nn]; }
                else { if (k >= 128) x = g2[(size_t)(k - 128) * 512 + nn]; }
                f[e] = x;
            }
            *(uint4*)(LB + (size_t)n * 256 + kc) = pack8(f);
        }
    }
    {
        float4* Yz = (float4*)(p->ws + OFF_Y0); const float4 z = {0.f, 0.f, 0.f, 0.f};
        for (size_t i = (size_t)gw * 64 + lane; i < (size_t)RPB * 512 / 4; i += (size_t)ngw * 64) Yz[i] = z;
    }
    for (int pp = gw; pp < RPB; pp += ngw) {
        const bool lat = pp < SEQ; const int lo = lat ? 0 : SEQ, hi = lat ? SEQ : RPB;
        const bool hp = pp - 1 >= lo, hn = pp + 1 < hi;
        const u16* zc = ZDb + (size_t)pp * ZDW;
#pragma unroll
        for (int j = 0; j < 4; ++j) {
            const int c8 = lane + 64 * j;
            if (j == 3 && lane >= 32) break;
            const int ch = 8 * c8;
            float z[8], a[8], c[8], zs[8];
            unpack8(*(const uint4*)(zc + ch), z);
            if (hp) unpack8(*(const uint4*)(zc - ZDW + ch), a); else { for (int e = 0; e < 8; ++e) a[e] = 0.f; }
            if (hn) unpack8(*(const uint4*)(zc + ZDW + ch), c); else { for (int e = 0; e < 8; ++e) c[e] = 0.f; }
            const float4 m0 = *(const float4*)(mu + ch), m1 = *(const float4*)(mu + ch + 4);
            const float mm[8] = {m0.x, m0.y, m0.z, m0.w, m1.x, m1.y, m1.z, m1.w};
#pragma unroll
            for (int e = 0; e < 8; ++e) zs[e] = z[e] + (0.5f * (a[e] + c[e]) - z[e]) * mm[e];
            if (j == 0) *(uint4*)(R + (size_t)pp * 512 + ch) = pack8(zs);
            else if (j == 1) {
                const float4 k0 = *(const float4*)(kkw + ch - 512), k1 = *(const float4*)(kkw + ch - 512 + 4);
                const float kw[8] = {k0.x, k0.y, k0.z, k0.w, k1.x, k1.y, k1.z, k1.w};
                float t[8], ss = 0.f;
#pragma unroll
                for (int e = 0; e < 8; ++e) { t[e] = zs[e] * kw[e]; ss += t[e] * t[e]; }
                ss += __shfl_xor(ss, 1); ss += __shfl_xor(ss, 2); ss += __shfl_xor(ss, 4);
                const float inv = 1.f / fmaxf(sqrtf(ss), 1e-12f);
#pragma unroll
                for (int e = 0; e < 8; ++e) t[e] *= inv;
                *(uint4*)(KK + (size_t)pp * 512 + ch - 512) = pack8(t);
            } else if (j == 2) *(uint4*)(V + (size_t)pp * 512 + ch - 1024) = pack8(zs);
            else {
                float o[8];
#pragma unroll
                for (int e = 0; e < 8; ++e) o[e] = (lane < 8) ? tanhf(zs[e]) : (lane < 16) ? zs[e] : sigmoidf_(zs[e]);
                *(uint4*)(LA + (size_t)pp * 256 + ch - 1536) = pack8(o);
            }
        }
    }
}
struct EpiDecay { float* DEC; const float* w0; int d;
    DEV void operator()(int r, int c, float v, float) const {
        const float x = -(w0[c] + v); const float sp = x > 20.f ? x : log1pf(expf(x)); const float w = -sp - 0.5f;
        DEC[((size_t)r * 2 + d) * 512 + c] = expf(-expf(w)); } };
struct EpiIclr { u16* KD; u16* BQ; const u16* KK; const u16* ZDb; const float* a0; const float* ka; const float* muk; int d;
    DEV void operator()(int r, int c, float v, float) const {
        const float a = sigmoidf_(a0[c] + v);
        const float k = shiftmix_at(ZDb, r, 512 + c, muk[c]);
        KD[((size_t)r * 2 + d) * 512 + c] = (u16)f2bf(k * (1.f + (a - 1.f) * ka[c]));
        BQ[((size_t)r * 2 + d) * 512 + c] = (u16)f2bf(bf2f(KK[(size_t)r * 512 + c]) * a); } };
struct EpiGate { u16* G; DEV void operator()(int r, int c, float v, float) const { G[(size_t)r * 512 + c] = (u16)f2bf(v); } };

DEV int pos_to_pp(int s, int d) { return (s < NCTX) ? (d ? SEQ + NCTX - 1 - s : SEQ + s) : (d ? SEQ - 1 - (s - NCTX) : s - NCTX); }
struct StepV { float d; unsigned a; unsigned b; float v; };
DEV StepV load_step(const float* DEC, const u16* KD, const u16* BQ, const u16* KK, const u16* R, const u16* V, int pp, int h, int d, int lane) {
    const size_t e1 = (size_t)pp * 512 + h * 64, e2 = ((size_t)pp * 2 + d) * 512 + h * 64;
    StepV s;
    s.d = DEC[e2 + lane];
    s.a = (lane < 32) ? ((const unsigned*)(KD + e2))[lane] : ((const unsigned*)(BQ + e2))[lane - 32];
    s.b = (lane < 32) ? ((const unsigned*)(KK + e1))[lane] : ((const unsigned*)(R + e1))[lane - 32];
    s.v = bf2f(V[e1 + lane]);
    return s;
}
typedef float f32x2 __attribute__((ext_vector_type(2)));
constexpr int SSLOT = 320;
typedef __attribute__((address_space(3))) float* ldsf;
typedef const __attribute__((address_space(3))) f32x4* lds4;
DEV void stage_step(ldsf slot, const StepV& s, int lane) {
    slot[lane] = s.d;
    *(__attribute__((address_space(3))) f32x2*)(slot + 64 + 2 * lane) = (f32x2){bflo(s.a), bfhi(s.a)};
    *(__attribute__((address_space(3))) f32x2*)(slot + 192 + 2 * lane) = (f32x2){bflo(s.b), bfhi(s.b)};
}
#define LO2(v) ((f32x2){(v)[0], (v)[1]})
#define HI2(v) ((f32x2){(v)[2], (v)[3]})
template <int MODE>
DEV float scan_step(f32x2 (&S)[32], ldsf sl, float vv) {
    lds4 D = (lds4)sl;
    f32x2 sa = {0.f, 0.f}, sb = {0.f, 0.f};
#pragma unroll
    for (int q = 0; q < 16; ++q) { const f32x4 k4 = D[48 + q]; sa += S[2 * q] * LO2(k4); sb += S[2 * q + 1] * HI2(k4);
        if ((q & 3) == 3) asm volatile("" : "+v"(D), "+v"(sa), "+v"(sb)); }
    const float nsa = -((sa[0] + sa[1]) + (sb[0] + sb[1]));
    const f32x2 nsa2 = {nsa, nsa}, vv2 = {vv, vv};
    f32x2 y = {0.f, 0.f}, z = {0.f, 0.f};
#pragma unroll
    for (int q = 0; q < 16; ++q) {
        const f32x4 d4 = D[q], b4 = D[32 + q];
        f32x2 t0 = nsa2 * LO2(b4), t1 = nsa2 * HI2(b4);
        if (MODE >= 1) { const f32x4 kd4 = D[16 + q]; t0 += vv2 * LO2(kd4); t1 += vv2 * HI2(kd4); }
        S[2 * q] = S[2 * q] * LO2(d4) + t0; S[2 * q + 1] = S[2 * q + 1] * HI2(d4) + t1;
        if (MODE == 2) { const f32x4 r4 = D[64 + q]; y += S[2 * q] * LO2(r4); z += S[2 * q + 1] * HI2(r4); }
        else y += S[2 * q + 1];
        if ((q & 1) == 1) asm volatile("" : "+v"(D), "+v"(y), "+v"(z), "+v"(S[2 * q + 1]));
    }
    return (y[0] + y[1]) + (z[0] + z[1]);
}
DEV void scan_step_pu(f32x2 (&P)[32], f32x2 (&U)[32], ldsf sl, float vv) {
    lds4 D = (lds4)sl;
    f32x2 pa = {0.f, 0.f}, pb = {0.f, 0.f}, ua = {0.f, 0.f}, ub = {0.f, 0.f};
#pragma unroll
    for (int q = 0; q < 16; ++q) { const f32x4 k4 = D[48 + q];
        pa += P[2 * q] * LO2(k4); pb += P[2 * q + 1] * HI2(k4); ua += U[2 * q] * LO2(k4); ub += U[2 * q + 1] * HI2(k4);
        if ((q & 3) == 3) asm volatile("" : "+v"(D), "+v"(pa), "+v"(pb), "+v"(ua), "+v"(ub)); }
    const float nsp = -((pa[0] + pa[1]) + (pb[0] + pb[1])), nsu = -((ua[0] + ua[1]) + (ub[0] + ub[1]));
    const f32x2 nsp2 = {nsp, nsp}, nsu2 = {nsu, nsu}, vv2 = {vv, vv};
#pragma unroll
    for (int q = 0; q < 16; ++q) {
        const f32x4 d4 = D[q], b4 = D[32 + q], kd4 = D[16 + q];
        P[2 * q] = P[2 * q] * LO2(d4) + nsp2 * LO2(b4); P[2 * q + 1] = P[2 * q + 1] * HI2(d4) + nsp2 * HI2(b4);
        U[2 * q] = U[2 * q] * LO2(d4) + (vv2 * LO2(kd4) + nsu2 * LO2(b4)); U[2 * q + 1] = U[2 * q + 1] * HI2(d4) + (vv2 * HI2(kd4) + nsu2 * HI2(b4));
        asm volatile("" : "+v"(D), "+v"(P[2 * q]), "+v"(P[2 * q + 1]), "+v"(U[2 * q]), "+v"(U[2 * q + 1]));
    }
}
DEV void phase_scan1(PPtr p, char* lds) {
    const int tid = tidx(), lane = tid & 63, wv = __builtin_amdgcn_readfirstlane(tid >> 6), gw = blockIdx.x * NWAVE + wv, ngw = gridDim.x * NWAVE;
    const float* DEC = (const float*)(p->ws + OFF_DEC); const u16* KD = (const u16*)(p->ws + OFF_KD); const u16* BQ = (const u16*)(p->ws + OFF_BQ);
    const u16* KK = (const u16*)(p->ws + OFF_KK); const u16* R = (const u16*)(p->ws + OFF_R); const u16* V = (const u16*)(p->ws + OFF_V);
    float* PU = (float*)(p->ws + OFF_PU);
    ldsf ring = (ldsf)lds + wv * (3 * SSLOT);
    for (int task = gw; task < 16 * NCH; task += ngw) {
        const int seq = task >> 7, c = task & 127, h = seq >> 1, d = seq & 1;
#define LD(st) load_step(DEC, KD, BQ, KK, R, V, pos_to_pp(c * CLEN + min((st), CLEN - 1), d), h, d, lane)
        f32x2 P[32], U[32];
        float lnf = (float)lane; asm volatile("" : "+v"(lnf));
#pragma unroll
        for (int j = 0; j < 32; ++j) { P[j] = (f32x2){fmaxf(1.f - fabsf(lnf - (float)(2 * j)), 0.f), fmaxf(1.f - fabsf(lnf - (float)(2 * j + 1)), 0.f)}; U[j] = (f32x2){0.f, 0.f}; }
        float vvA, vvB;
        { const StepV s0 = LD(0), s1 = LD(1); stage_step(ring, s0, lane); stage_step(ring + SSLOT, s1, lane); vvA = s0.v; vvB = s1.v; }
        StepV g0 = LD(2), g1 = LD(3), g2 = LD(4), g3 = LD(5);
        int cs = 0, ns = 2;
#pragma unroll 1
        for (int st = 0; st < CLEN; ++st) {
            scan_step_pu(P, U, ring + cs * SSLOT, vvA);
            stage_step(ring + ns * SSLOT, g0, lane);
            vvA = vvB; vvB = g0.v; g0 = g1; g1 = g2; g2 = g3; g3 = LD(st + 6);
            cs = (cs == 2) ? 0 : cs + 1; ns = (ns == 2) ? 0 : ns + 1;
        }
#undef LD
        float4* o = (float4*)(PU + ((size_t)task * 2) * 4096 + lane * 64);
#pragma unroll
        for (int j = 0; j < 16; ++j) { o[j] = (float4){P[2 * j][0], P[2 * j][1], P[2 * j + 1][0], P[2 * j + 1][1]}; o[1024 + j] = (float4){U[2 * j][0], U[2 * j][1], U[2 * j + 1][0], U[2 * j + 1][1]}; }
    }
}
#define S2_PLOAD(ent_, lo, hi) do { const float4* s_ = (const float4*)((ent_) + prow * 64 + pcol); lo = s_[0]; hi = s_[1]; } while (0)
#define S2_ULOAD(ent_, u_) do { const float* s_ = (ent_) + 4096; _Pragma("unroll") for (int t_ = 0; t_ < 2; ++t_) _Pragma("unroll") for (int j_ = 0; j_ < 4; ++j_) u_[t_][j_] = s_[(16 * rt + 4 * q + j_) * 64 + 16 * (ct0 + t_) + r]; } while (0)
#define S2_CSTORE(dst_, a0_, a1_) do { float* d_ = (dst_); _Pragma("unroll") for (int j_ = 0; j_ < 4; ++j_) { d_[(16 * rt + 4 * q + j_) * 64 + 16 * ct0 + r] = a0_[j_]; d_[(16 * rt + 4 * q + j_) * 64 + 16 * ct0 + 16 + r] = a1_[j_]; } } while (0)
#define S2_LSTORE(dst_, a0_, a1_) do { float* d_ = (dst_); _Pragma("unroll") for (int j_ = 0; j_ < 4; ++j_) { d_[(16 * rt + 4 * q + j_) * 68 + 16 * ct0 + r] = a0_[j_]; d_[(16 * rt + 4 * q + j_) * 68 + 16 * ct0 + 16 + r] = a1_[j_]; } } while (0)
DEV void phase_scan2a(PPtr p, char* lds) {
    if (blockIdx.x >= 128) return;
    const int tid = tidx(), lane = tid & 63, w = __builtin_amdgcn_readfirstlane(tid >> 6), seq = blockIdx.x >> 3, g = blockIdx.x & 7;
    float* sX = (float*)lds; float* sZ = sX + 2 * 64 * 68; float* sP = sZ + 2 * 64 * 68;
    float* PUg = (float*)(p->ws + OFF_PU) + (size_t)(seq * NCH + 16 * g) * 8192;
    float* TOT = (float*)(p->ws + OFF_LA) + (size_t)(seq * 8 + g) * 8192;
    const int rt = w >> 1, ct0 = (w & 1) * 2, r = lane & 15, q = lane >> 4;
    const int prow = tid >> 3, pcol = (tid & 7) * 8;
    for (int i = tid; i < 64 * 68; i += NTHR) { const int row = i / 68, col = i - row * 68; sX[i] = (row == col) ? 1.f : 0.f; sZ[i] = 0.f; }
    float4 pa0, pa1, pb0, pb1;
    { float4 t0, t1; S2_PLOAD(PUg, t0, t1); *(float4*)(sP + prow * 68 + pcol) = t0; *(float4*)(sP + prow * 68 + pcol + 4) = t1; }
    S2_PLOAD(PUg + 8192, pa0, pa1); S2_PLOAD(PUg + 2 * 8192, pb0, pb1);
    float ua[2][4], ub[2][4];
    S2_ULOAD(PUg, ua); S2_ULOAD(PUg + 8192, ub);
    __syncthreads();
    for (int jj = 0; jj < 16; ++jj) {
        const int cur = jj & 1;
        f32x4 x0 = {0.f, 0.f, 0.f, 0.f}, x1 = {0.f, 0.f, 0.f, 0.f};
        f32x4 z0 = {ua[0][0], ua[0][1], ua[0][2], ua[0][3]}, z1 = {ua[1][0], ua[1][1], ua[1][2], ua[1][3]};
        const float* Xc = sX + cur * (64 * 68); const float* Zc = sZ + cur * (64 * 68); const float* Pc = sP + cur * (64 * 68);
#pragma unroll
        for (int ks = 0; ks < 16; ++ks) {
            const float ax = Xc[(16 * rt + r) * 68 + 4 * ks + q], az = Zc[(16 * rt + r) * 68 + 4 * ks + q];
            const float b0 = Pc[(4 * ks + q) * 68 + 16 * ct0 + r], b1 = Pc[(4 * ks + q) * 68 + 16 * ct0 + 16 + r];
            x0 = __builtin_amdgcn_mfma_f32_16x16x4f32(ax, b0, x0, 0, 0, 0); x1 = __builtin_amdgcn_mfma_f32_16x16x4f32(ax, b1, x1, 0, 0, 0);
            z0 = __builtin_amdgcn_mfma_f32_16x16x4f32(az, b0, z0, 0, 0, 0); z1 = __builtin_amdgcn_mfma_f32_16x16x4f32(az, b1, z1, 0, 0, 0);
        }
        S2_LSTORE(sX + (cur ^ 1) * (64 * 68), x0, x1); S2_LSTORE(sZ + (cur ^ 1) * (64 * 68), z0, z1);
        S2_CSTORE(PUg + (size_t)jj * 8192, x0, x1); S2_CSTORE(PUg + (size_t)jj * 8192 + 4096, z0, z1);
        if (jj == 15) { S2_CSTORE(TOT, x0, x1); S2_CSTORE(TOT + 4096, z0, z1); }
        { float* Pn = sP + (cur ^ 1) * (64 * 68); *(float4*)(Pn + prow * 68 + pcol) = pa0; *(float4*)(Pn + prow * 68 + pcol + 4) = pa1; }
        pa0 = pb0; pa1 = pb1;
        S2_PLOAD(PUg + (size_t)min(jj + 3, 15) * 8192, pb0, pb1);
#pragma unroll
        for (int t = 0; t < 2; ++t)
#pragma unroll
            for (int j = 0; j < 4; ++j) ua[t][j] = ub[t][j];
        if (jj + 2 < 16) S2_ULOAD(PUg + (size_t)(jj + 2) * 8192, ub);
        __syncthreads();
    }
}
DEV void phase_scan2b(PPtr p, char* lds) {
    if (blockIdx.x >= 128) return;
    const int tid = tidx(), lane = tid & 63, w = __builtin_amdgcn_readfirstlane(tid >> 6), seq = blockIdx.x >> 3, g = blockIdx.x & 7;
    float* sS = (float*)lds; float* sP = sS + 2 * 64 * 68;
    float* PUg = (float*)(p->ws + OFF_PU) + (size_t)(seq * NCH + 16 * g) * 8192;
    float* TOTs = (float*)(p->ws + OFF_LA) + (size_t)(seq * 8) * 8192;
    const int rt = w >> 1, ct0 = (w & 1) * 2, r = lane & 15, q = lane >> 4;
    const int prow = tid >> 3, pcol = (tid & 7) * 8;
    const int T = g + 16;
#define S2_ENT(t_) ((min((t_), T - 1) < g) ? TOTs + (size_t)min((t_), T - 1) * 8192 : PUg + (size_t)(min((t_), T - 1) - g) * 8192)
    for (int i = tid; i < 64 * 68; i += NTHR) sS[i] = 0.f;
    float4 pa0, pa1, pb0, pb1;
    { float4 t0, t1; S2_PLOAD(S2_ENT(0), t0, t1); *(float4*)(sP + prow * 68 + pcol) = t0; *(float4*)(sP + prow * 68 + pcol + 4) = t1; }
    S2_PLOAD(S2_ENT(1), pa0, pa1); S2_PLOAD(S2_ENT(2), pb0, pb1);
    float ua[2][4], ub[2][4];
    S2_ULOAD(S2_ENT(0), ua); S2_ULOAD(S2_ENT(1), ub);
    f32x4 m0 = {0.f, 0.f, 0.f, 0.f}, m1 = {0.f, 0.f, 0.f, 0.f};
    int sb = 0;
    __syncthreads();
    for (int t = 0; t < T; ++t) {
        const int cur = t & 1; const bool chain = t < g;
        if (!chain) S2_CSTORE(PUg + (size_t)(t - g) * 8192 + 4096, m0, m1);
        f32x4 a0 = {ua[0][0], ua[0][1], ua[0][2], ua[0][3]}, a1 = {ua[1][0], ua[1][1], ua[1][2], ua[1][3]};
        const float* Sc = sS + sb * (64 * 68); const float* Pc = sP + cur * (64 * 68);
#pragma unroll
        for (int ks = 0; ks < 16; ++ks) {
            const float av = Sc[(16 * rt + r) * 68 + 4 * ks + q];
            const float b0 = Pc[(4 * ks + q) * 68 + 16 * ct0 + r], b1 = Pc[(4 * ks + q) * 68 + 16 * ct0 + 16 + r];
            a0 = __builtin_amdgcn_mfma_f32_16x16x4f32(av, b0, a0, 0, 0, 0);
            a1 = __builtin_amdgcn_mfma_f32_16x16x4f32(av, b1, a1, 0, 0, 0);
        }
        m0 = a0; m1 = a1;
        if (chain) { S2_LSTORE(sS + (sb ^ 1) * (64 * 68), a0, a1); sb ^= 1; }
        { float* Pn = sP + (cur ^ 1) * (64 * 68); *(float4*)(Pn + prow * 68 + pcol) = pa0; *(float4*)(Pn + prow * 68 + pcol + 4) = pa1; }
        pa0 = pb0; pa1 = pb1;
        S2_PLOAD(S2_ENT(t + 3), pb0, pb1);
#pragma unroll
        for (int u = 0; u < 2; ++u)
#pragma unroll
            for (int j = 0; j < 4; ++j) ua[u][j] = ub[u][j];
        if (t + 2 < T) S2_ULOAD(S2_ENT(t + 2), ub);
        __syncthreads();
    }
#undef S2_ENT
}
DEV void phase_scan3(PPtr p, char* lds) {
    const int tid = tidx(), lane = tid & 63, wv = __builtin_amdgcn_readfirstlane(tid >> 6), gw = blockIdx.x * NWAVE + wv, ngw = gridDim.x * NWAVE;
    const float* DEC = (const float*)(p->ws + OFF_DEC); const u16* KD = (const u16*)(p->ws + OFF_KD); const u16* BQ = (const u16*)(p->ws + OFF_BQ);
    const u16* KK = (const u16*)(p->ws + OFF_KK); const u16* R = (const u16*)(p->ws + OFF_R); const u16* V = (const u16*)(p->ws + OFF_V);
    const float* PU = (const float*)(p->ws + OFF_PU);
    float* Y = (float*)(p->ws + OFF_Y0);
    ldsf ring = (ldsf)lds + wv * (3 * SSLOT);
    for (int task = gw; task < 16 * NCH; task += ngw) {
        const int seq = task >> 7, c = task & 127, h = seq >> 1, d = seq & 1;
        f32x2 S[32];
        {
            const float4* si = (const float4*)(PU + ((size_t)task * 2 + 1) * 4096 + lane * 64);
#pragma unroll
            for (int j = 0; j < 16; ++j) { const float4 t = si[j]; S[2 * j] = (f32x2){t.x, t.y}; S[2 * j + 1] = (f32x2){t.z, t.w}; }
        }
#define LD(st) load_step(DEC, KD, BQ, KK, R, V, pos_to_pp(c * CLEN + min((st), CLEN - 1), d), h, d, lane)
#define YADD(st, y) unsafeAtomicAdd(Y + (size_t)pos_to_pp(c * CLEN + (st), d) * 512 + h * 64 + lane, (y))
        float vvA, vvB;
        { const StepV s0 = LD(0), s1 = LD(1); stage_step(ring, s0, lane); stage_step(ring + SSLOT, s1, lane); vvA = s0.v; vvB = s1.v; }
        StepV g0 = LD(2), g1 = LD(3), g2 = LD(4), g3 = LD(5);
        int cs = 0, ns = 2;
#pragma unroll 1
        for (int st = 0; st < CLEN; ++st) {
            const float y = scan_step<2>(S, ring + cs * SSLOT, vvA); YADD(st, y);
            stage_step(ring + ns * SSLOT, g0, lane);
            vvA = vvB; vvB = g0.v; g0 = g1; g1 = g2; g2 = g3; g3 = LD(st + 6);
            cs = (cs == 2) ? 0 : cs + 1; ns = (ns == 2) ? 0 : ns + 1;
        }
#undef LD
#undef YADD
    }
}
DEV void phase_readout(PPtr p, int li, int bb) {
    const int tid = tidx(), lane = tid & 63, gw = blockIdx.x * NWAVE + (tid >> 6), ngw = gridDim.x * NWAVE;
    const float* Y0 = (const float*)(p->ws + OFF_Y0);
    const u16* KD = (const u16*)(p->ws + OFF_KD); const u16* R = (const u16*)(p->ws + OFF_R); const u16* V = (const u16*)(p->ws + OFF_V); const u16* G = (const u16*)(p->ws + OFF_G);
    const float* rk = p->in[24] + li * 512; const float* lnw = p->in[25] + li * 512; const float* lnb = p->in[26] + li * 512;
    u16* AO = (u16*)(p->ws + OFF_AO);
    const int c = 8 * lane;
    float rkv[8], lw[8], lb[8];
    { const float4 a = *(const float4*)(rk + c), b = *(const float4*)(rk + c + 4); rkv[0] = a.x; rkv[1] = a.y; rkv[2] = a.z; rkv[3] = a.w; rkv[4] = b.x; rkv[5] = b.y; rkv[6] = b.z; rkv[7] = b.w; }
    { const float4 a = *(const float4*)(lnw + c), b = *(const float4*)(lnw + c + 4); lw[0] = a.x; lw[1] = a.y; lw[2] = a.z; lw[3] = a.w; lw[4] = b.x; lw[5] = b.y; lw[6] = b.z; lw[7] = b.w; }
    { const float4 a = *(const float4*)(lnb + c), b = *(const float4*)(lnb + c + 4); lb[0] = a.x; lb[1] = a.y; lb[2] = a.z; lb[3] = a.w; lb[4] = b.x; lb[5] = b.y; lb[6] = b.z; lb[7] = b.w; }
    for (int pp = gw; pp < RPB; pp += ngw) {
        const size_t m = (size_t)bb * RPB + pp, e = (size_t)pp * 512 + c;
        const float4 ya = *(const float4*)(Y0 + e), yb = *(const float4*)(Y0 + e + 4);
        const float y[8] = {ya.x, ya.y, ya.z, ya.w, yb.x, yb.y, yb.z, yb.w};
        float r[8], k0[8], k1[8], v[8], g[8];
        unpack8(*(const uint4*)(R + e), r); unpack8(*(const uint4*)(KD + ((size_t)pp * 2) * 512 + c), k0); unpack8(*(const uint4*)(KD + ((size_t)pp * 2 + 1) * 512 + c), k1);
        unpack8(*(const uint4*)(V + e), v); unpack8(*(const uint4*)(G + e), g);
        float sm = 0.f, bs = 0.f;
#pragma unroll
        for (int j = 0; j < 8; ++j) { sm += y[j]; bs += r[j] * (k0[j] + k1[j]) * rkv[j]; }
        sm += __shfl_xor(sm, 1); sm += __shfl_xor(sm, 2); sm += __shfl_xor(sm, 4);
        bs += __shfl_xor(bs, 1); bs += __shfl_xor(bs, 2); bs += __shfl_xor(bs, 4);
        const float mean = sm * (1.f / 64.f);
        float vs = 0.f;
#pragma unroll
        for (int j = 0; j < 8; ++j) { const float dv = y[j] - mean; vs += dv * dv; }
        vs += __shfl_xor(vs, 1); vs += __shfl_xor(vs, 2); vs += __shfl_xor(vs, 4);
        const float rstd = rsqrtf(vs * (1.f / 64.f) + 64e-5f);
        float o[8];
#pragma unroll
        for (int j = 0; j < 8; ++j) o[j] = ((y[j] - mean) * rstd * lw[j] + lb[j] + bs * v[j]) * g[j];
        *(uint4*)(AO + m * DM + 512 + c) = pack8(o);
    }
}
DEV void phase_final(PPtr p) {
    const int lane = tidx() & 63, gw = blockIdx.x * NWAVE + (tidx() >> 6), ngw = gridDim.x * NWAVE;
    const float* gain = p->in[29];
    for (int m = gw; m < NB * SEQ; m += ngw) {
        float4* xr = (float4*)(p->out + (size_t)m * DM);
        float4 v[4]; float ss = 0.f;
#pragma unroll
        for (int j = 0; j < 4; ++j) { v[j] = xr[lane + 64 * j]; ss += v[j].x * v[j].x + v[j].y * v[j].y + v[j].z * v[j].z + v[j].w * v[j].w; }
        ss = wave_sum(ss);
        const float rstd = rsqrtf(ss * (1.f / DM) + 1e-6f);
#pragma unroll
        for (int j = 0; j < 4; ++j) {
            const float4 g = *(const float4*)(gain + (lane + 64 * j) * 4);
            float4 o; o.x = v[j].x * rstd * g.x; o.y = v[j].y * rstd * g.y; o.z = v[j].z * rstd * g.z; o.w = v[j].w * rstd * g.w;
            xr[lane + 64 * j] = o;
        }
    }
}

constexpr size_t OFF_BAR = 768 * 1024;
DEV void gbar(PPtr kp_, unsigned& nbar) {
    asm volatile("s_waitcnt vmcnt(0)" ::: "memory");
    __syncthreads();
    if (threadIdx.x == 0) {
        unsigned* ctr = (unsigned*)(kp_->ws + OFF_BAR);
        __builtin_amdgcn_fence(__ATOMIC_RELEASE, "agent");
        asm volatile("s_waitcnt vmcnt(0)" ::: "memory");
        ++nbar;
        __hip_atomic_fetch_add(ctr, 1u, __ATOMIC_RELAXED, __HIP_MEMORY_SCOPE_AGENT);
        const unsigned target = nbar * gridDim.x;
        while (__hip_atomic_load(ctr, __ATOMIC_RELAXED, __HIP_MEMORY_SCOPE_AGENT) < target) __builtin_amdgcn_s_sleep(1);
        __builtin_amdgcn_fence(__ATOMIC_ACQUIRE, "agent");
        asm volatile("s_waitcnt vmcnt(0)" ::: "memory");
    }
    __syncthreads();
}
#define p launder(kp)
#define SYNC() gbar(launder(kp), nbar)
template <int bb>
DEV void do_rwkv_batch(PPtr kp, unsigned& nbar, char* lds, int li) {
    unsigned char* ws = launder(kp)->ws;
    u16* ZD = (u16*)(ws + OFF_ZD);
                phase_rwkv_prep(p, li, bb); SYNC();
                const u16* LA = (const u16*)(ws + OFF_LA); const u16* ZDb = ZD + (size_t)bb * RPB * ZDW;
                { pg8::EpiLoraT e{(float*)(ws + OFF_DEC), (u16*)(ws + OFF_KD), (u16*)(ws + OFF_BQ), (u16*)(ws + OFF_G), (const u16*)(ws + OFF_KK), ZDb,
                                  p->in[17] + (size_t)li * 1024, p->in[19] + (size_t)li * 1024, p->in[23] + li * 512, p->in[16] + li * ZDW + 512};
                  int kl_ = 256; asm volatile("" : "+s"(kl_));
                  pg8::Gemm g_{(const pg8::bf16_t*)LA, (const pg8::bf16_t*)(ws + OFF_PU), RPB, 2560, kl_}; pg8::StaticOrder S_; S_.init(RPB, 2560, (int)gridDim.x, (int)blockIdx.x);
                  pg8::gemm_phase<pg8::EpiLoraT, pg8::StaticOrder, true, true>((PG8_LAS unsigned char*)lds, g_, S_, e); }
                SYNC();
                phase_scan1(p, lds); SYNC();
                phase_scan2a(p, lds); SYNC();
                phase_scan2b(p, lds); SYNC();
                phase_scan3(p, lds); SYNC();
                phase_readout(p, li, bb); SYNC();
            }
template <int layer>
DEV void do_layer(PPtr kp, unsigned& nbar, char* lds) {
    unsigned char* ws = launder(kp)->ws;
    const float* mod = (const float*)(ws + OFF_MOD);
    u16* HN = (u16*)(ws + OFF_HN); u16* AO = (u16*)(ws + OFF_AO); u16* RAW = (u16*)(ws + OFF_RAW); u16* ZD = (u16*)(ws + OFF_ZD);
        const int li = layer >> 1;
        const float* lmod = mod + (size_t)layer * 3 * 6144;
        phase_wprep(p, layer, lds); phase_normmod(p, layer, 0); SYNC();
        const pg8::bf16_t* WB = (const pg8::bf16_t*)(ws + OFF_WB);
#define GEMM8(A_, B_, N_, K_, E_) do { pg8::Gemm g_{(const pg8::bf16_t*)(A_), (B_), MROWS, (N_), (K_)}; pg8::StaticOrder S_; S_.init(MROWS, (N_), (int)gridDim.x, (int)blockIdx.x); \
            pg8::gemm_phase<decltype(E_), pg8::StaticOrder, true, true>((PG8_LAS unsigned char*)lds, g_, S_, E_); } while (0)
#define GEMM8L(A_, B_, N_, K_, E_) do { pg8::Gemm g_{(const pg8::bf16_t*)(A_), (B_), MROWS, (N_), (K_)}; pg8::LatentOrder S_; S_.init((N_), (int)gridDim.x, (int)blockIdx.x); \
            pg8::gemm_phase<decltype(E_), pg8::LatentOrder, true, true>((PG8_LAS unsigned char*)lds, g_, S_, E_); } while (0)
        if (!(layer & 1)) {
            { pg8::EpiStoreT e{RAW, 1536, 1 << 30, RAW, 1536}; GEMM8(HN, WB + WB_IN, 1536, DM, e); } SYNC();
            phase_even_post(p, li); SYNC();
            phase_attn_even(p, li, lds); SYNC();
            { pg8::EpiResidT e{p, lmod + 2048}; GEMM8(AO, WB + WB_OUT, DM, DM, e); } SYNC();
        } else {
            { pg8::EpiStoreT e{RAW, 1536, 1536, ZD, ZDW}; GEMM8(HN, WB + WB_IN, 3328, DM, e); } SYNC();
            phase_attn_odd(p, li, lds); SYNC();
            do_rwkv_batch<0>(kp, nbar, lds, li);
            do_rwkv_batch<1>(kp, nbar, lds, li);
            if (layer == 3) { pg8::EpiResidT e{p, lmod + 2048}; GEMM8L(AO, WB + WB_OUT, DM, DM, e); }
            else { pg8::EpiResidT e{p, lmod + 2048}; GEMM8(AO, WB + WB_OUT, DM, DM, e); }
            SYNC();
        }
        phase_normmod(p, layer, 1); SYNC();
        if (layer == 3) { pg8::EpiSwigluT e{RAW}; GEMM8L(HN, WB + WB_F1, 5632, DM, e); }
        else { pg8::EpiSwigluT e{RAW}; GEMM8(HN, WB + WB_F1, 5632, DM, e); }
        SYNC();
        if (layer == 3) { pg8::EpiResidT e{p, lmod + 5120}; GEMM8L(RAW, WB + WB_F2, DM, FFH, e); }
        else { pg8::EpiResidT e{p, lmod + 5120}; GEMM8(RAW, WB + WB_F2, DM, FFH, e); }
        SYNC();
    }
__global__ void __launch_bounds__(NTHR) mega(Params p_unused) {
    PPtr kp = (PPtr)__builtin_amdgcn_kernarg_segment_ptr();
    extern __shared__ __attribute__((aligned(16))) char lds[];
    cg::grid_group grid = cg::this_grid();
    unsigned nbar = 0;
    grid.sync();
    phase_init(p, lds); SYNC();
    do_layer<0>(kp, nbar, lds);
    do_layer<1>(kp, nbar, lds);
    do_layer<2>(kp, nbar, lds);
    do_layer<3>(kp, nbar, lds);
    phase_final(p);
}
#undef p
#undef SYNC

extern "C" void kernel_launch(void* const* d_in, const int* in_sizes, int n_in, void* d_out, int out_size, void* d_ws, size_t ws_size, hipStream_t stream) {
    static int grid = 0;
    if (grid == 0) {
        if (n_in != 30 || ws_size < WS_NEED || out_size != NB * SEQ * DM) { fprintf(stderr, "kernel_launch: unexpected problem shape (n_in %d ws %zu out %d)\n", n_in, ws_size, out_size); grid = -1; return; }
        int dev = 0, cus = 0, per_cu = 0;
        hipGetDevice(&dev);
        hipDeviceGetAttribute(&cus, hipDeviceAttributeMultiprocessorCount, dev);
        hipFuncSetAttribute((const void*)mega, hipFuncAttributeMaxDynamicSharedMemorySize, LDS_BYTES);
        hipOccupancyMaxActiveBlocksPerMultiprocessor(&per_cu, (const void*)mega, NTHR, LDS_BYTES);
        if (per_cu < 1) per_cu = 1;
        if (per_cu > 1) per_cu = 1;
        grid = cus * per_cu;
    }
    if (grid < 0) return;
    Params p{};
    for (int i = 0; i < 30; ++i) p.in[i] = (const float*)d_in[i];
    p.out = (float*)d_out; p.ws = (unsigned char*)d_ws;
    hipMemsetAsync((char*)d_ws + OFF_BAR, 0, 256, stream);
    void* args[] = {&p};
    hipError_t e = hipLaunchCooperativeKernel((const void*)mega, dim3(grid), dim3(NTHR), args, LDS_BYTES, stream);
    if (e != hipSuccess) fprintf(stderr, "cooperative launch failed: %s (grid %d)\n", hipGetErrorString(e), grid);
}
```

```cpp
#include <hip/hip_runtime.h>
#include <hip/hip_cooperative_groups.h>
#include <cstdio>
#include <cstdint>
namespace cg = cooperative_groups;

#define DEV __device__ __forceinline__
typedef unsigned short u16;
typedef short bf16x8 __attribute__((ext_vector_type(8)));
typedef float f32x4 __attribute__((ext_vector_type(4)));
typedef const __attribute__((address_space(4))) float* cfp;
typedef const __attribute__((address_space(4))) unsigned* cup;

constexpr int DM = 1024, NB = 2, SEQ = 16384, NCTX = 256, RPB = SEQ + NCTX, MROWS = NB * RPB;
constexpr int FFH = 2816, ZDW = 1792;
constexpr float LOG2E = 1.4426950408889634f;
constexpr int NTHR = 512, NWAVE = 8;
constexpr int LDS_BYTES = 132096;

constexpr size_t MiB = 1u << 20;
constexpr size_t OFF_MOD = 0;
constexpr size_t OFF_ROPE = 512 * 1024;
constexpr size_t OFF_XC = 1 * MiB;
constexpr size_t OFF_WB = 3 * MiB;
constexpr size_t OFF_AO = 29 * MiB;
constexpr size_t OFF_HN = 94 * MiB;
constexpr size_t OFF_RAW = 159 * MiB;
constexpr size_t OFF_ZD = 257 * MiB;
constexpr size_t SZ_H = (size_t)RPB * 512 * 2;
constexpr size_t OFF_DEC = 94 * MiB;
constexpr size_t OFF_KD = OFF_DEC + 4 * SZ_H;
constexpr size_t OFF_BQ = OFF_KD + 2 * SZ_H;
constexpr size_t OFF_KK = OFF_BQ + 2 * SZ_H;
constexpr size_t OFF_R = OFF_KK + SZ_H;
constexpr size_t OFF_V = 371 * MiB;
constexpr size_t OFF_G = OFF_V + SZ_H;
constexpr size_t OFF_LA = OFF_G + SZ_H;
constexpr size_t OFF_Y0 = 412 * MiB;
constexpr size_t OFF_PU = OFF_Y0 + 2 * SZ_H;
constexpr size_t WS_NEED = 509 * MiB;
constexpr int NCH = 128, CLEN = 130;
static_assert(OFF_R + SZ_H <= OFF_ZD, "scan map");
static_assert(OFF_LA + SZ_H / 2 <= OFF_Y0, "scan map 2");
static_assert(OFF_PU + 64 * MiB <= WS_NEED, "scan map 3");
static_assert(OFF_RAW + (size_t)MROWS * FFH * 2 <= WS_NEED, "ffn hidden");

struct Params { const float* in[30]; float* out; unsigned char* ws; };
typedef const __attribute__((address_space(4))) Params* PPtr;
DEV int tidx() { int t = threadIdx.x; asm volatile("" : "+v"(t)); return t; }
DEV PPtr launder(PPtr p) { asm volatile("" : "+s"(p)); return p; }

DEV unsigned f2bf(float f) { unsigned u = __float_as_uint(f); return (u + 0x7fffu + ((u >> 16) & 1u)) >> 16; }
DEV float bf2f(u16 h) { return __uint_as_float(((unsigned)h) << 16); }
DEV float bflo(unsigned u) { return __uint_as_float(u << 16); }
DEV float bfhi(unsigned u) { return __uint_as_float(u & 0xffff0000u); }
DEV unsigned pk2(float lo, float hi) { return f2bf(lo) | (f2bf(hi) << 16); }
DEV void unpack8(const uint4 u, float (&f)[8]) {
    f[0] = bflo(u.x); f[1] = bfhi(u.x); f[2] = bflo(u.y); f[3] = bfhi(u.y); f[4] = bflo(u.z); f[5] = bfhi(u.z); f[6] = bflo(u.w); f[7] = bfhi(u.w);
}
DEV uint4 pack8(const float (&f)[8]) { uint4 o; o.x = pk2(f[0], f[1]); o.y = pk2(f[2], f[3]); o.z = pk2(f[4], f[5]); o.w = pk2(f[6], f[7]); return o; }
DEV float wave_sum(float v) {
#pragma unroll
    for (int o = 1; o < 64; o <<= 1) v += __shfl_xor(v, o);
    return v;
}
DEV float* xrow_ptr(PPtr p, int m) {
    int b = m / RPB, q = m - b * RPB;
    return q < SEQ ? p->out + (size_t)(b * SEQ + q) * DM : (float*)(p->ws + OFF_XC) + (size_t)(b * NCTX + (q - SEQ)) * DM;
}
DEV int mod_idx(int m) { int b = m / RPB, q = m - b * RPB; return q < SEQ ? b : 2; }
DEV float sigmoidf_(float x) { return 1.f / (1.f + __expf(-x)); }

DEV void phase_init(PPtr p, char* lds) {
    const int tid = tidx();
    const size_t gt = (size_t)blockIdx.x * NTHR + tid, ng = (size_t)gridDim.x * NTHR;
    {
        const float4* s = (const float4*)p->in[0]; float4* d = (float4*)p->out;
        const size_t n = (size_t)NB * SEQ * DM / 4;
        for (size_t i = gt; i < n; i += ng) d[i] = s[i];
        const float4* s2 = (const float4*)p->in[2]; float4* d2 = (float4*)(p->ws + OFF_XC);
        const size_t n2 = (size_t)NB * NCTX * DM / 4;
        for (size_t i = gt; i < n2; i += ng) d2[i] = s2[i];
    }
    {
        float* T = (float*)(p->ws + OFF_ROPE);
        for (size_t i = gt; i < 5120; i += ng) {
            const int pos = (int)(i >> 4), f = (int)(i & 15);
            const float inv = powf(10000.f, -(float)f / 16.f);
            if (pos < 256) { const float ang = (float)pos * inv; T[pos * 16 + f] = cosf(ang); T[4096 + pos * 16 + f] = sinf(ang); }
            else { const float ang = (float)(pos - 256) * inv; T[8192 + (pos - 256) * 16 + f] = cosf(ang); T[9216 + (pos - 256) * 16 + f] = sinf(ang); }
        }
    }
    float* red = (float*)lds;
    float* mod = (float*)(p->ws + OFF_MOD);
    const float* c = p->in[1]; const float* cc = p->in[3];
    for (int item = blockIdx.x; item < 192; item += gridDim.x) {
        const int l = item / 48, n0 = (item % 48) * 128, col = tid & 127, kp = tid >> 7;
        const float* w = p->in[4] + (size_t)l * DM * 6144 + n0 + col;
        float a0 = 0.f, a1 = 0.f, a2 = 0.f;
        for (int k = kp * 256; k < kp * 256 + 256; ++k) {
            const float wv = w[(size_t)k * 6144];
            const float c0 = c[k], c1 = c[DM + k], c2 = cc[k];
            a0 += c0 * sigmoidf_(c0) * wv; a1 += c1 * sigmoidf_(c1) * wv; a2 += c2 * sigmoidf_(c2) * wv;
        }
        red[(kp * 3 + 0) * 128 + col] = a0; red[(kp * 3 + 1) * 128 + col] = a1; red[(kp * 3 + 2) * 128 + col] = a2;
        __syncthreads();
        if (tid < 384) {
            const int mb = tid >> 7, cl = tid & 127;
            float s = red[(0 * 3 + mb) * 128 + cl] + red[(1 * 3 + mb) * 128 + cl] + red[(2 * 3 + mb) * 128 + cl] + red[(3 * 3 + mb) * 128 + cl];
            mod[(size_t)(l * 3 + mb) * 6144 + n0 + cl] = s + p->in[5][l * 6144 + n0 + cl];
        }
        __syncthreads();
    }
}

DEV void phase_normmod(PPtr p, int layer, int which) {
    const int lane = tidx() & 63, gw = blockIdx.x * NWAVE + (tidx() >> 6), ngw = gridDim.x * NWAVE;
    const float* gain = p->in[which ? 7 : 6] + layer * DM;
    const float* mod = (const float*)(p->ws + OFF_MOD) + (size_t)layer * 3 * 6144;
    u16* HN = (u16*)(p->ws + OFF_HN);
    for (int m = gw; m < MROWS; m += ngw) {
        const float* xr = xrow_ptr(p, m);
        const float* md = mod + mod_idx(m) * 6144 + (which ? 3072 : 0);
        float4 v[4]; float ss = 0.f;
#pragma unroll
        for (int j = 0; j < 4; ++j) { v[j] = ((const float4*)xr)[lane + 64 * j]; ss += v[j].x * v[j].x + v[j].y * v[j].y + v[j].z * v[j].z + v[j].w * v[j].w; }
        ss = wave_sum(ss);
        const float rstd = rsqrtf(ss * (1.f / DM) + 1e-6f);
#pragma unroll
        for (int j = 0; j < 4; ++j) {
            const int k = (lane + 64 * j) * 4;
            const float4 g = *(const float4*)(gain + k), sh = *(const float4*)(md + k), sc = *(const float4*)(md + 1024 + k);
            const float o0 = v[j].x * rstd * g.x * (1.f + sc.x) + sh.x, o1 = v[j].y * rstd * g.y * (1.f + sc.y) + sh.y;
            const float o2 = v[j].z * rstd * g.z * (1.f + sc.z) + sh.z, o3 = v[j].w * rstd * g.w * (1.f + sc.w) + sh.w;
            uint2 w; w.x = pk2(o0, o1); w.y = pk2(o2, o3);
            *(uint2*)(HN + (size_t)m * DM + k) = w;
        }
    }
}

template <int DUAL, class Epi>
DEV void gemm_simple(const u16* A, int lda, const float* W, int ldw, int dualoff, int M, int N, int K, const Epi& epi, char* lds) {
    u16* sA = (u16*)lds; u16* sB = sA + 128 * 40; u16* sB2 = sB + 128 * 40;
    const int tid = tidx(), lane = tid & 63, wave = tid >> 6, wm = wave >> 2, wn = wave & 3, r16 = lane & 15, quad = lane >> 4;
    const int mt = M / 128, nt = N / 128;
    for (int item = blockIdx.x; item < mt * nt; item += gridDim.x) {
        const int tn = item / mt, tm = item - tn * mt, m0 = tm * 128, n0 = tn * 128;
        f32x4 acc[4][2], acc2[4][2];
#pragma unroll
        for (int a = 0; a < 4; ++a)
#pragma unroll
            for (int b = 0; b < 2; ++b) { acc[a][b] = (f32x4){0.f, 0.f, 0.f, 0.f}; acc2[a][b] = (f32x4){0.f, 0.f, 0.f, 0.f}; }
        for (int k0 = 0; k0 < K; k0 += 32) {
            {
                const int row = tid >> 2, kc = (tid & 3) * 8;
                const uint4 v = *(const uint4*)(A + (size_t)(m0 + row) * lda + k0 + kc);
                *(uint4*)(sA + row * 40 + kc) = v;
            }
            {
                const int kk = tid >> 4, nc = (tid & 15) * 8;
                const float* wp = W + (size_t)(k0 + kk) * ldw + n0 + nc;
                const float4 a = *(const float4*)wp, b = *(const float4*)(wp + 4);
                sB[(nc + 0) * 40 + kk] = (u16)f2bf(a.x); sB[(nc + 1) * 40 + kk] = (u16)f2bf(a.y); sB[(nc + 2) * 40 + kk] = (u16)f2bf(a.z); sB[(nc + 3) * 40 + kk] = (u16)f2bf(a.w);
                sB[(nc + 4) * 40 + kk] = (u16)f2bf(b.x); sB[(nc + 5) * 40 + kk] = (u16)f2bf(b.y); sB[(nc + 6) * 40 + kk] = (u16)f2bf(b.z); sB[(nc + 7) * 40 + kk] = (u16)f2bf(b.w);
                if (DUAL) {
                    const float4 c = *(const float4*)(wp + dualoff), d = *(const float4*)(wp + dualoff + 4);
                    sB2[(nc + 0) * 40 + kk] = (u16)f2bf(c.x); sB2[(nc + 1) * 40 + kk] = (u16)f2bf(c.y); sB2[(nc + 2) * 40 + kk] = (u16)f2bf(c.z); sB2[(nc + 3) * 40 + kk] = (u16)f2bf(c.w);
                    sB2[(nc + 4) * 40 + kk] = (u16)f2bf(d.x); sB2[(nc + 5) * 40 + kk] = (u16)f2bf(d.y); sB2[(nc + 6) * 40 + kk] = (u16)f2bf(d.z); sB2[(nc + 7) * 40 + kk] = (u16)f2bf(d.w);
                }
            }
            __syncthreads();
            bf16x8 af[4], bfr[2], bfr2[2];
#pragma unroll
            for (int mi = 0; mi < 4; ++mi) af[mi] = *(const bf16x8*)(sA + (wm * 64 + mi * 16 + r16) * 40 + quad * 8);
#pragma unroll
            for (int ni = 0; ni < 2; ++ni) {
                bfr[ni] = *(const bf16x8*)(sB + (wn * 32 + ni * 16 + r16) * 40 + quad * 8);
                if (DUAL) bfr2[ni] = *(const bf16x8*)(sB2 + (wn * 32 + ni * 16 + r16) * 40 + quad * 8);
            }
#pragma unroll
            for (int mi = 0; mi < 4; ++mi)
#pragma unroll
                for (int ni = 0; ni < 2; ++ni) {
                    acc[mi][ni] = __builtin_amdgcn_mfma_f32_16x16x32_bf16(af[mi], bfr[ni], acc[mi][ni], 0, 0, 0);
                    if (DUAL) acc2[mi][ni] = __builtin_amdgcn_mfma_f32_16x16x32_bf16(af[mi], bfr2[ni], acc2[mi][ni], 0, 0, 0);
                }
            __syncthreads();
        }
#pragma unroll
        for (int mi = 0; mi < 4; ++mi)
#pragma unroll
            for (int ni = 0; ni < 2; ++ni)
#pragma unroll
                for (int j = 0; j < 4; ++j) {
                    const int row = m0 + wm * 64 + mi * 16 + quad * 4 + j, col = n0 + wn * 32 + ni * 16 + r16;
                    epi(row, col, acc[mi][ni][j], DUAL ? acc2[mi][ni][j] : 0.f);
                }
    }
}

struct EpiStore { u16* O; int ld; DEV void operator()(int r, int c, float v, float) const { O[(size_t)r * ld + c] = (u16)f2bf(v); } };
struct EpiStoreOdd { u16* Q; u16* Z;
    DEV void operator()(int r, int c, float v, float) const { if (c < 1536) Q[(size_t)r * 1536 + c] = (u16)f2bf(v); else Z[(size_t)r * ZDW + (c - 1536)] = (u16)f2bf(v); } };
struct EpiResid { PPtr p; const float* gate;
    DEV void operator()(int r, int c, float v, float) const { float* xr = xrow_ptr(p, r); xr[c] += gate[mod_idx(r) * 6144 + c] * v; } };
struct EpiSwiglu { u16* H;
    DEV void operator()(int r, int c, float g, float u) const { H[(size_t)r * FFH + c] = (u16)f2bf(g * sigmoidf_(g) * u); } };


namespace pg8 {
#define PG8_LAS __attribute__((address_space(3)))
typedef unsigned short bf16_t;
typedef short bf16x8 __attribute__((ext_vector_type(8)));
typedef float f32x4 __attribute__((ext_vector_type(4)));
typedef unsigned u32x4 __attribute__((ext_vector_type(4)));
constexpr int BM = 256, BK = 64, HALF = 128, HTB = HALF * BK * 2  , STAGE_BYTES = 8 * HTB, NXCD = 8, WGM = 8;

__host__ __device__ __forceinline__ int lds_byte(int r, int c) { const int st = (r >> 4) * 2 + (c >> 5), rr = r & 15, cc = c & 31, ob = rr * 64 + cc * 2; return st * 1024 + (ob ^ (((ob >> 9) & 1) << 5)); }
__host__ __device__ __forceinline__ void stage_rc(int b, int& R, int& C) { const int st = b / 1024, sb = b % 1024, swz = sb ^ (((sb >> 9) & 1) << 5); R = (st >> 1) * 16 + swz / 64; C = (st & 1) * 32 + (swz % 64) / 2; }
__host__ __device__ __forceinline__ int perm32(int rho) { const int n = rho >> 4, i = rho & 15; return 8 * (i >> 2) + 4 * n + (i & 3); }

struct Unit { int pm, pn; };
struct Gemm { const bf16_t* A; const bf16_t* Bt; int M, N, K; };

struct StaticOrder {
    int nM, nN, nwg, G, c;
    __host__ __device__ void init(int M, int N, int G_, int c_) { nM = M / BM; nN = N / BM; nwg = nM * nN; G = G_; c = c_; }
    __host__ __device__ bool next(int i, Unit& u) const {
        const long L = (long)i * G + c; if (L >= nwg) return false;
        int wgid = (int)L; { const int q = nwg / NXCD, r = nwg % NXCD, xcd = wgid % NXCD, off = wgid / NXCD; wgid = (xcd < r ? xcd * (q + 1) : r * (q + 1) + (xcd - r) * q) + off; }
        const int nig = WGM * nN, gid = wgid / nig, fm = gid * WGM, gsz = (nM - fm) < WGM ? (nM - fm) : WGM;
        u.pm = fm + ((wgid % nig) % gsz); u.pn = (wgid % nig) / gsz; return true;
    }
    __device__ __forceinline__ void a_ready(const Unit&) const {}
    __device__ __forceinline__ void done(const Unit&) const {}
};
struct LatentOrder {
    StaticOrder S;
    __host__ __device__ void init(int N, int G_, int c_) { S.init(32768, N, G_, c_); }
    __host__ __device__ bool next(int i, Unit& u) const { if (!S.next(i, u)) return false; u.pm = u.pm < 64 ? u.pm : u.pm + 1; return true; }
    __device__ __forceinline__ void a_ready(const Unit&) const {}
    __device__ __forceinline__ void done(const Unit&) const {}
};

__device__ __forceinline__ unsigned cvt_pk_bf16(float lo, float hi) { unsigned r; asm volatile("v_cvt_pk_bf16_f32 %0, %1, %2" : "=v"(r) : "v"(lo), "v"(hi)); return r; }
template <class Epi, class Sched, bool ALIGN_EPI = false, bool SP2 = false>
__device__ __forceinline__ void gemm_phase(PG8_LAS unsigned char* lds, const Gemm g, const Sched& S, const Epi& E) {
    const int tid = tidx(), wid = __builtin_amdgcn_readfirstlane(tid >> 6), lane = tid & 63, wr = wid >> 2, wc = wid & 3, fr = lane & 15, fq = lane >> 4;
    const int K = g.K, nt = K / BK;
    unsigned voffA[2], voffB[2];
#pragma unroll
    for (int i = 0; i < 2; ++i) { int R, C; stage_rc(tid * 16 + i * 8192, R, C); const int Rb = Epi::PERM ? ((R & ~31) + perm32(R & 31)) : R;
        voffA[i] = (unsigned)(R * K + C) * 2u; voffB[i] = (unsigned)(Rb * K + C) * 2u; }
    const size_t kstep = (size_t)(BK * 2);
    const size_t hstep = (size_t)HALF * K * 2;
    const size_t tstep = 2 * hstep;
    const unsigned ldsw = (unsigned)wid * 1024u;
    const int aoff = lds_byte(wr * 64 + fr, fq * 8), boff = lds_byte(wc * 32 + fr, fq * 8);
#define PG8_SA(b, h) (((b) * 2 + (h)) * HTB)
#define PG8_SB(b, h) ((4 + (b) * 2 + (h)) * HTB)
#define PG8_STAGE(bufoff, gbase, voff) do { _Pragma("unroll") for (int _i = 0; _i < 2; ++_i) \
        __builtin_amdgcn_global_load_lds((const unsigned*)((const char*)(gbase) + (voff)[_i]), (PG8_LAS unsigned*)(lds + (bufoff) + ldsw + _i * 8192), 16, 0, 0); } while (0)
#define PG8_LDA(dst, b, h) do { _Pragma("unroll") for (int m = 0; m < 4; ++m) _Pragma("unroll") for (int k = 0; k < 2; ++k) dst[m][k] = *(const PG8_LAS bf16x8*)(lds + PG8_SA(b, h) + aoff + m * 2048 + k * 1024); } while (0)
#define PG8_LDB(dst, b, h) do { _Pragma("unroll") for (int n = 0; n < 2; ++n) _Pragma("unroll") for (int k = 0; k < 2; ++k) dst[n][k] = *(const PG8_LAS bf16x8*)(lds + PG8_SB(b, h) + boff + n * 2048 + k * 1024); } while (0)
#define PG8_MMA(ai, bj, At, Bt) do { __builtin_amdgcn_s_setprio(1); _Pragma("unroll") for (int m = 0; m < 4; ++m) _Pragma("unroll") for (int n = 0; n < 2; ++n) _Pragma("unroll") for (int k = 0; k < 2; ++k) \
        acc[ai][bj][m][n] = __builtin_amdgcn_mfma_f32_16x16x32_bf16(Bt[n][k], At[m][k], acc[ai][bj][m][n], 0, 0, 0); __builtin_amdgcn_s_setprio(0); } while (0)
#define PG8_WAIT_V(n) asm volatile("s_waitcnt vmcnt(" #n ")" ::: "memory")
#define PG8_WAIT_L(n) asm volatile("s_waitcnt lgkmcnt(" #n ")" ::: "memory")
#define PG8_BAR __builtin_amdgcn_s_barrier()
#define PG8_SCHED __builtin_amdgcn_sched_barrier(0)
    Unit cur, nxt; int ui = 0;
    if (!S.next(0, cur)) return;
    f32x4 acc[2][2][4][2];
#pragma unroll
    for (int a = 0; a < 2; ++a)
#pragma unroll
        for (int b = 0; b < 2; ++b)
#pragma unroll
            for (int m = 0; m < 4; ++m)
#pragma unroll
                for (int n = 0; n < 2; ++n) acc[a][b][m][n] = (f32x4){0.f, 0.f, 0.f, 0.f};
    bf16x8 At[4][2], B0[2][2], B1[2][2];
    const char* cA = (const char*)g.A + (size_t)cur.pm * tstep; const char* cB = (const char*)g.Bt + (size_t)cur.pn * tstep;
    S.a_ready(cur);
    if constexpr (SP2) {
        PG8_STAGE(PG8_SB(0, 0), cB, voffB); PG8_STAGE(PG8_SB(0, 1), cB + hstep, voffB); PG8_STAGE(PG8_SA(0, 0), cA, voffA); PG8_STAGE(PG8_SA(0, 1), cA + hstep, voffA);
        if (wr == 1) PG8_BAR;
        PG8_WAIT_V(2); PG8_BAR;
        PG8_STAGE(PG8_SB(1, 0), cB + kstep, voffB); PG8_STAGE(PG8_SA(1, 0), cA + kstep, voffA); PG8_STAGE(PG8_SB(1, 1), cB + hstep + kstep, voffB);
        PG8_WAIT_V(6); PG8_BAR;
    } else {
        PG8_STAGE(PG8_SB(0, 0), cB, voffB); PG8_STAGE(PG8_SA(0, 0), cA, voffA); PG8_STAGE(PG8_SB(0, 1), cB + hstep, voffB); PG8_STAGE(PG8_SA(0, 1), cA + hstep, voffA);
        if (wr == 1) PG8_BAR;
        PG8_WAIT_V(4); PG8_BAR;
        PG8_STAGE(PG8_SB(1, 0), cB + kstep, voffB); PG8_STAGE(PG8_SA(1, 0), cA + kstep, voffA); PG8_STAGE(PG8_SB(1, 1), cB + hstep + kstep, voffB);
        PG8_WAIT_V(6); PG8_BAR;
    }
    for (;;) {
        const bool has_next = S.next(ui + 1, nxt);
        const char* nA = has_next ? (const char*)g.A + (size_t)nxt.pm * tstep : cA; const char* nB = has_next ? (const char*)g.Bt + (size_t)nxt.pn * tstep : cB;
        for (int t = 0; t < nt; t += 2) {
            const bool last = (t == nt - 2);
            const char* a1 = cA + (size_t)(t + 1) * kstep;
            const char* a2 = last ? nA : cA + (size_t)(t + 2) * kstep; const char* b2 = last ? nB : cB + (size_t)(t + 2) * kstep;
            const char* a3 = a2 + kstep; const char* b3 = b2 + kstep;
            if (last && has_next) S.a_ready(nxt);
            if constexpr (SP2) {
            PG8_LDB(B0, 0, 0); PG8_LDB(B1, 0, 1); PG8_SCHED; PG8_LDA(At, 0, 0); PG8_STAGE(PG8_SA(1, 1), a1 + hstep, voffA);
            PG8_WAIT_V(8); PG8_WAIT_L(0); PG8_BAR; PG8_MMA(0, 0, At, B0); PG8_MMA(0, 1, At, B1); PG8_BAR; PG8_SCHED;
            PG8_LDA(At, 0, 1); PG8_STAGE(PG8_SB(0, 0), b2, voffB); PG8_STAGE(PG8_SB(0, 1), b2 + hstep, voffB); PG8_STAGE(PG8_SA(0, 0), a2, voffA);
            PG8_WAIT_V(8); PG8_WAIT_L(0); PG8_BAR; PG8_MMA(1, 0, At, B0); PG8_MMA(1, 1, At, B1); PG8_BAR; PG8_SCHED;
            PG8_LDB(B0, 1, 0); PG8_LDB(B1, 1, 1); PG8_SCHED; PG8_LDA(At, 1, 0); PG8_STAGE(PG8_SA(0, 1), a2 + hstep, voffA);
            PG8_WAIT_V(8); PG8_WAIT_L(0); PG8_BAR; PG8_MMA(0, 0, At, B0); PG8_MMA(0, 1, At, B1); PG8_BAR; PG8_SCHED;
            PG8_LDA(At, 1, 1); PG8_STAGE(PG8_SB(1, 0), b3, voffB); PG8_STAGE(PG8_SB(1, 1), b3 + hstep, voffB); PG8_STAGE(PG8_SA(1, 0), a3, voffA);
            PG8_WAIT_V(8); PG8_WAIT_L(0); PG8_BAR; PG8_MMA(1, 0, At, B0); PG8_MMA(1, 1, At, B1); PG8_BAR; PG8_SCHED;
            } else {
            PG8_LDB(B0, 0, 0); PG8_SCHED; PG8_LDA(At, 0, 0); PG8_STAGE(PG8_SA(1, 1), a1 + hstep, voffA);
            PG8_WAIT_L(8); PG8_BAR; PG8_WAIT_L(0); PG8_MMA(0, 0, At, B0); PG8_BAR; PG8_SCHED;
            PG8_LDB(B1, 0, 1); PG8_STAGE(PG8_SB(0, 0), b2, voffB);
            PG8_BAR; PG8_WAIT_L(0); PG8_MMA(0, 1, At, B1); PG8_BAR;
            PG8_LDA(At, 0, 1); PG8_STAGE(PG8_SA(0, 0), a2, voffA);
            PG8_BAR; PG8_WAIT_L(0); PG8_MMA(1, 0, At, B0); PG8_BAR; PG8_SCHED;
            PG8_STAGE(PG8_SB(0, 1), b2 + hstep, voffB);
            PG8_WAIT_V(6); PG8_BAR; PG8_MMA(1, 1, At, B1); PG8_BAR;
            PG8_LDB(B0, 1, 0); PG8_SCHED; PG8_LDA(At, 1, 0); PG8_STAGE(PG8_SA(0, 1), a2 + hstep, voffA);
            PG8_WAIT_L(8); PG8_BAR; PG8_WAIT_L(0); PG8_MMA(0, 0, At, B0); PG8_BAR; PG8_SCHED;
            PG8_LDB(B1, 1, 1); PG8_STAGE(PG8_SB(1, 0), b3, voffB);
            PG8_BAR; PG8_WAIT_L(0); PG8_MMA(0, 1, At, B1); PG8_BAR;
            PG8_LDA(At, 1, 1); PG8_STAGE(PG8_SA(1, 0), a3, voffA);
            PG8_BAR; PG8_WAIT_L(0); PG8_MMA(1, 0, At, B0); PG8_BAR; PG8_SCHED;
            PG8_STAGE(PG8_SB(1, 1), b3 + hstep, voffB);
            PG8_WAIT_V(6); PG8_BAR; PG8_MMA(1, 1, At, B1); PG8_BAR;
            }
        }
        if constexpr (ALIGN_EPI) { if (wr == 0) PG8_BAR; }
        if constexpr (!Epi::AFTER_DRAIN) { E(acc, cur, wr, wc, fr, fq); S.done(cur); }
        if (!has_next) break;
#pragma unroll
        for (int a = 0; a < 2; ++a)
#pragma unroll
            for (int b = 0; b < 2; ++b)
#pragma unroll
                for (int m = 0; m < 4; ++m)
#pragma unroll
                    for (int n = 0; n < 2; ++n) acc[a][b][m][n] = (f32x4){0.f, 0.f, 0.f, 0.f};
        cur = nxt; cA = nA; cB = nB; ++ui;
        if constexpr (ALIGN_EPI) { if (wr == 1) PG8_BAR; }
    }
    PG8_WAIT_V(0);
    if constexpr (!ALIGN_EPI) { if (wr == 0) PG8_BAR; }
    PG8_BAR;
    if constexpr (Epi::AFTER_DRAIN) { E.fused(acc, cur, wr, wc, fr, fq, lds, wid, lane); S.done(cur); }
#undef PG8_SA
#undef PG8_SB
#undef PG8_STAGE
#undef PG8_LDA
#undef PG8_LDB
#undef PG8_MMA
#undef PG8_WAIT_V
#undef PG8_WAIT_L
#undef PG8_BAR
#undef PG8_SCHED
}

struct EpiStoreT {
    static constexpr bool PERM = true, AFTER_DRAIN = false;
    bf16_t* O0; int ld0; int split; bf16_t* O1; int ld1;
    __device__ __forceinline__ void operator()(const f32x4 (&acc)[2][2][4][2], const Unit& u, int wr, int wc, int fr, int fq) const {
        const int row0 = u.pm * BM + wr * 64 + fr; int colt = u.pn * BM; bf16_t* base = O0; int ld = ld0;
        if (colt >= split) { base = O1; ld = ld1; colt -= split; }
        const int col0 = colt + wc * 32 + 8 * fq;
#pragma unroll
        for (int ai = 0; ai < 2; ++ai)
#pragma unroll
            for (int m = 0; m < 4; ++m) { bf16_t* rowp = base + (size_t)(row0 + ai * HALF + m * 16) * ld + col0;
#pragma unroll
                for (int bj = 0; bj < 2; ++bj) { const f32x4 v0 = acc[ai][bj][m][0], v1 = acc[ai][bj][m][1];
                    u32x4 w; w.x = cvt_pk_bf16(v0[0], v0[1]); w.y = cvt_pk_bf16(v0[2], v0[3]); w.z = cvt_pk_bf16(v1[0], v1[1]); w.w = cvt_pk_bf16(v1[2], v1[3]);
                    *(u32x4*)(rowp + bj * HALF) = w; } }
    }
};
struct EpiResidT {
    static constexpr bool PERM = true, AFTER_DRAIN = false;
    PPtr p; const float* gate;
    __device__ __forceinline__ void operator()(const f32x4 (&acc)[2][2][4][2], const Unit& u, int wr, int wc, int fr, int fq) const {
        float* xb = xrow_ptr(p, u.pm * BM); const float* g = gate + mod_idx(u.pm * BM) * 6144;
        const int col0 = u.pn * BM + wc * 32 + 8 * fq;
#pragma unroll
        for (int ai = 0; ai < 2; ++ai)
#pragma unroll
            for (int m = 0; m < 4; ++m) { float* xr = xb + (size_t)(ai * HALF + wr * 64 + m * 16 + fr) * DM;
#pragma unroll
                for (int bj = 0; bj < 2; ++bj) { const int col = col0 + bj * HALF; const f32x4 v0 = acc[ai][bj][m][0], v1 = acc[ai][bj][m][1];
                    const f32x4 g0 = *(const f32x4*)(g + col), g1 = *(const f32x4*)(g + col + 4);
                    f32x4 x0 = *(const f32x4*)(xr + col), x1 = *(const f32x4*)(xr + col + 4);
                    x0 += g0 * v0; x1 += g1 * v1;
                    *(f32x4*)(xr + col) = x0; *(f32x4*)(xr + col + 4) = x1; } }
    }
};
struct EpiSwigluT {
    static constexpr bool PERM = true, AFTER_DRAIN = false;
    bf16_t* H;
    __device__ __forceinline__ void operator()(const f32x4 (&acc)[2][2][4][2], const Unit& u, int wr, int wc, int fr, int fq) const {
        const int row0 = u.pm * BM + wr * 64 + fr; const int col0 = u.pn * BM + wc * 32 + 8 * fq;
#pragma unroll
        for (int ai = 0; ai < 2; ++ai)
#pragma unroll
            for (int m = 0; m < 4; ++m) { bf16_t* rowp = H + (size_t)(row0 + ai * HALF + m * 16) * FFH;
#pragma unroll
                for (int bj = 0; bj < 2; ++bj) { const f32x4 gt = acc[ai][bj][m][0], up = acc[ai][bj][m][1];
                    float h[4];
#pragma unroll
                    for (int j = 0; j < 4; ++j) h[j] = gt[j] * sigmoidf_(gt[j]) * up[j];
                    uint2 w; w.x = cvt_pk_bf16(h[0], h[1]); w.y = cvt_pk_bf16(h[2], h[3]);
                    *(uint2*)(rowp + ((col0 + bj * HALF) >> 1)) = w; } }
    }
};

struct EpiLoraT {
    static constexpr bool PERM = true, AFTER_DRAIN = false;
    float* DEC; bf16_t* KD; bf16_t* BQ; bf16_t* G; const bf16_t* KK; const bf16_t* ZDb;
    const float* w0; const float* a0; const float* ka; const float* muk;
    template <int TYPE>
    __device__ __forceinline__ void one(const f32x4 v, int r, int c, int d) const {
        if (TYPE == 0) {
            const float4 wa = *(const float4*)(w0 + d * 512 + c);
            const float ww[4] = {wa.x, wa.y, wa.z, wa.w};
            float o[4];
#pragma unroll
            for (int e = 0; e < 4; ++e) { const float x = -(ww[e] + v[e]); const float sp = x > 20.f ? x : __logf(1.f + __expf(x)); o[e] = __expf(-__expf(-sp - 0.5f)); }
            *(float4*)(DEC + ((size_t)r * 2 + d) * 512 + c) = (float4){o[0], o[1], o[2], o[3]};
        } else if (TYPE == 1) {
            const float4 aa = *(const float4*)(a0 + d * 512 + c), ka0 = *(const float4*)(ka + c), m0 = *(const float4*)(muk + c);
            const float a0v[4] = {aa.x, aa.y, aa.z, aa.w}, kav[4] = {ka0.x, ka0.y, ka0.z, ka0.w}, mm[4] = {m0.x, m0.y, m0.z, m0.w};
            const bool lat = r < SEQ; const int lo = lat ? 0 : SEQ, hi = lat ? SEQ : RPB;
            const bf16_t* zc = ZDb + (size_t)r * ZDW + 512 + c;
            const bool hp = r - 1 >= lo, hn = r + 1 < hi;
            const uint2 uz = *(const uint2*)zc, up = *(const uint2*)(hp ? zc - ZDW : zc), un = *(const uint2*)(hn ? zc + ZDW : zc), uk = *(const uint2*)(KK + (size_t)r * 512 + c);
            const float z[4] = {bflo(uz.x), bfhi(uz.x), bflo(uz.y), bfhi(uz.y)}, zp[4] = {bflo(up.x), bfhi(up.x), bflo(up.y), bfhi(up.y)};
            const float zn[4] = {bflo(un.x), bfhi(un.x), bflo(un.y), bfhi(un.y)}, kk[4] = {bflo(uk.x), bfhi(uk.x), bflo(uk.y), bfhi(uk.y)};
            const float fp = hp ? 0.5f : 0.f, fn = hn ? 0.5f : 0.f;
            float okd[4], obq[4];
#pragma unroll
            for (int e = 0; e < 4; ++e) {
                const float a = sigmoidf_(a0v[e] + v[e]);
                const float k = z[e] + ((fp * zp[e] + fn * zn[e]) - z[e]) * mm[e];
                okd[e] = k * (1.f + (a - 1.f) * kav[e]); obq[e] = kk[e] * a;
            }
            uint2 w1; w1.x = pk2(okd[0], okd[1]); w1.y = pk2(okd[2], okd[3]); *(uint2*)(KD + ((size_t)r * 2 + d) * 512 + c) = w1;
            uint2 w2; w2.x = pk2(obq[0], obq[1]); w2.y = pk2(obq[2], obq[3]); *(uint2*)(BQ + ((size_t)r * 2 + d) * 512 + c) = w2;
        } else {
            uint2 w; w.x = pk2(v[0], v[1]); w.y = pk2(v[2], v[3]); *(uint2*)(G + (size_t)r * 512 + c) = w;
        }
    }
    template <int TYPE>
    __device__ __forceinline__ void all(const f32x4 (&acc)[2][2][4][2], const Unit& u, int wr, int wc, int fr, int fq) const {
        const int d = (u.pn >> 1) & 1, cb = (u.pn & 1) * 256 + wc * 32 + 8 * fq;
#pragma unroll
        for (int ai = 0; ai < 2; ++ai)
#pragma unroll
            for (int m = 0; m < 4; ++m)
#pragma unroll
                for (int bj = 0; bj < 2; ++bj)
                {   const int r = u.pm * BM + ai * HALF + wr * 64 + m * 16 + fr, c = cb + bj * HALF;
                    one<TYPE>(acc[ai][bj][m][0], r, c, d); one<TYPE>(acc[ai][bj][m][1], r, c + 4, d); }
    }
    __device__ __forceinline__ void operator()(const f32x4 (&acc)[2][2][4][2], const Unit& u, int wr, int wc, int fr, int fq) const {
        const int type = u.pn >> 1;
        if (type < 2) all<0>(acc, u, wr, wc, fr, fq); else if (type < 4) all<1>(acc, u, wr, wc, fr, fq); else all<2>(acc, u, wr, wc, fr, fq);
    }
};
}

DEV void transpose_item(const float* W, int K, int N, u16* WT, int mode, float* scr, int item, int lane) {
    const int nblk = N / 32, kb = item / nblk, nb = item - kb * nblk, k0 = 64 * kb, n0 = 32 * nb;
#pragma unroll 8
    for (int i = 0; i < 32; ++i) { const int kk = 2 * i + (lane >> 5); scr[kk * 33 + (lane & 31)] = W[(size_t)(k0 + kk) * N + n0 + (lane & 31)]; }
    asm volatile("s_waitcnt lgkmcnt(0)" ::: "memory");
    const int c = lane & 7;
#pragma unroll
    for (int j = 0; j < 4; ++j) {
        const int n = (lane >> 3) + 8 * j; const float* sp = scr + (8 * c) * 33 + n;
        uint4 o; o.x = pk2(sp[0 * 33], sp[1 * 33]); o.y = pk2(sp[2 * 33], sp[3 * 33]); o.z = pk2(sp[4 * 33], sp[5 * 33]); o.w = pk2(sp[6 * 33], sp[7 * 33]);
        const int ns = n0 + n;
        int drow = ns;
        if (mode) { const int nn = ns >= FFH ? 1 : 0; const int g = ns - nn * FFH; drow = 8 * (g >> 2) + 4 * nn + (g & 3); }
        *(uint4*)(WT + (size_t)drow * K + k0 + 8 * c) = o;
    }
    asm volatile("s_waitcnt lgkmcnt(0)" ::: "memory");
}
constexpr size_t WB_IN = 0, WB_OUT = (size_t)3328 * 1024, WB_F1 = WB_OUT + (size_t)1024 * 1024, WB_F2 = WB_F1 + (size_t)5632 * 1024;
DEV void phase_wprep(PPtr p, int layer, char* lds) {
    const int tid = tidx(), lane = tid & 63, wave = tid >> 6, gw = blockIdx.x * NWAVE + wave, ngw = gridDim.x * NWAVE;
    float* scr = (float*)lds + wave * (64 * 33);
    u16* WB = (u16*)(p->ws + OFF_WB);
    const int li = layer >> 1, odd = layer & 1;
    const int nin = odd ? 3328 : 1536;
    const float* win = odd ? p->in[13] + (size_t)li * DM * 3328 : p->in[8] + (size_t)li * DM * 1536;
    const float* wout = (odd ? p->in[14] : p->in[9]) + (size_t)li * DM * DM;
    const float* wf1 = p->in[27] + (size_t)layer * DM * 5632; const float* wf2 = p->in[28] + (size_t)layer * FFH * DM;
    const int i0 = 16 * (nin / 32), i1 = i0 + 16 * 32, i2 = i1 + 16 * 176, i3 = i2 + 44 * 32;
    for (int it = gw; it < i3; it += ngw) {
        if (it < i0) transpose_item(win, DM, nin, WB + WB_IN, 0, scr, it, lane);
        else if (it < i1) transpose_item(wout, DM, DM, WB + WB_OUT, 0, scr, it - i0, lane);
        else if (it < i2) transpose_item(wf1, DM, 5632, WB + WB_F1, 1, scr, it - i1, lane);
        else transpose_item(wf2, FFH, DM, WB + WB_F2, 0, scr, it - i2, lane);
    }
}

#include <hip/hip_bf16.h>
#include <cmath>
namespace attn_body {
using bf16=__hip_bfloat16;
using bf16x8=__attribute__((ext_vector_type(8)))short;
using s16x4=__attribute__((ext_vector_type(4)))short;
using f32x16=__attribute__((ext_vector_type(16)))float;
using u32x4=__attribute__((ext_vector_type(4)))unsigned;
constexpr int D=64,PQ=1536,PO=1024,KROWS=16640,RPBA=16640;
constexpr int NW=8,QBLK=32,QB=QBLK*NW,KVBLK=64;
constexpr int ATTN_UNIT_ROWS=QB;
__device__ __forceinline__ int crow(int r,int hi){return (r&3)+8*(r>>2)+4*hi;}
#define SBAR() __builtin_amdgcn_sched_barrier(0)
__device__ __forceinline__ void cmask(f32x16&p0,f32x16&p1,int jb,int qrel,int hi){
  const float NEG=-INFINITY; int kb=64*jb+4*hi;
  #pragma unroll
  for(int r=0;r<16;++r){int kv=kb+(r&3)+8*(r>>2); if(kv>qrel)p0[r]=NEG; if(kv+32>qrel)p1[r]=NEG;}
}

constexpr int NSLOT=3, SLOTB=8192;
constexpr int LDS_K=0, LDS_V=NSLOT*SLOTB, LDS_WS=2*NSLOT*SLOTB, LDS_OST=LDS_WS+NW*64*4, LDS_BYTES=LDS_OST+NW*4096;
constexpr float C2=0.125f*1.4426950408889634f;
__device__ __forceinline__ void glds16(const void*gsrc,unsigned lds_dst){unsigned keep;
  asm volatile("s_mov_b32 %0, m0\n\ts_mov_b32 m0, %2\n\ts_nop 0\n\tglobal_load_lds_dwordx4 %1, off\n\ts_mov_b32 m0, %0":"=&s"(keep):"v"(gsrc),"s"(lds_dst):"memory");}
__device__ __forceinline__ float max3f(float a,float b,float c){float r;asm("v_max3_f32 %0, %1, %2, %3":"=v"(r):"v"(a),"v"(b),"v"(c));return r;}
__device__ __forceinline__ float max2f(float a,float b){float r;asm("v_max_f32_e32 %0, %1, %2":"=v"(r):"v"(a),"v"(b));return r;}
__device__ __forceinline__ float fadd_s(float a,float b){float r;asm("v_add_f32_e32 %0, %1, %2":"=v"(r):"v"(a),"v"(b));return r;}
__device__ __forceinline__ float fsub_s(float a,float b){float r;asm("v_sub_f32_e32 %0, %1, %2":"=v"(r):"v"(a),"v"(b));return r;}
typedef float f32x2_t __attribute__((ext_vector_type(2))); typedef __bf16 bf16x2_t __attribute__((ext_vector_type(2)));
__device__ __forceinline__ unsigned cvtpk_s(float lo,float hi){f32x2_t v={lo,hi};bf16x2_t b=__builtin_convertvector(v,bf16x2_t);return __builtin_bit_cast(unsigned,b);}
#define WAIT_BAR(N) asm volatile("s_waitcnt vmcnt(" #N ") lgkmcnt(0)\n\ts_barrier":::"memory")

__device__ __forceinline__ void qkt(f32x16&p0,f32x16&p1,const char*Kslot,const bf16x8*qr,const f32x16&negm,int r32,int hi){
  const char*kb=Kslot+hi*1024+r32*16;
  #pragma unroll
  for(int d0=0;d0<4;++d0){
    const bf16x8 b0=*reinterpret_cast<const bf16x8*>(kb+d0*2048);
    const bf16x8 b1=*reinterpret_cast<const bf16x8*>(kb+d0*2048+512);
    if(d0==0){p0=__builtin_amdgcn_mfma_f32_32x32x16_bf16(b0,qr[0],negm,0,0,0);p1=__builtin_amdgcn_mfma_f32_32x32x16_bf16(b1,qr[0],negm,0,0,0);}
    else{p0=__builtin_amdgcn_mfma_f32_32x32x16_bf16(b0,qr[d0],p0,0,0,0);p1=__builtin_amdgcn_mfma_f32_32x32x16_bf16(b1,qr[d0],p1,0,0,0);}}
}
typedef __attribute__((address_space(3))) const char* lds_cptr;
typedef short v4i16_t __attribute__((ext_vector_type(4)));
__device__ __forceinline__ void kload8(bf16x8*kf,lds_cptr kp){
  kf[0]=*(const __attribute__((address_space(3))) bf16x8*)(kp);      kf[1]=*(const __attribute__((address_space(3))) bf16x8*)(kp+512);
  kf[2]=*(const __attribute__((address_space(3))) bf16x8*)(kp+2048); kf[3]=*(const __attribute__((address_space(3))) bf16x8*)(kp+2560);
  kf[4]=*(const __attribute__((address_space(3))) bf16x8*)(kp+4096); kf[5]=*(const __attribute__((address_space(3))) bf16x8*)(kp+4608);
  kf[6]=*(const __attribute__((address_space(3))) bf16x8*)(kp+6144); kf[7]=*(const __attribute__((address_space(3))) bf16x8*)(kp+6656);
}
__device__ __forceinline__ void kload2(bf16x8*kf,lds_cptr kp,int j){ kf[2*j]=*(const __attribute__((address_space(3))) bf16x8*)(kp+j*2048); kf[2*j+1]=*(const __attribute__((address_space(3))) bf16x8*)(kp+j*2048+512); }
__device__ __forceinline__ s16x4 vtr(lds_cptr p){ return __builtin_bit_cast(s16x4,__builtin_amdgcn_ds_read_tr16_b64_v4i16((__attribute__((address_space(3))) v4i16_t*)p)); }
__device__ __forceinline__ float rowmax(const f32x16&p0,const f32x16&p1){
  float a=max3f(p0[0],p0[1],p1[0]),b=max3f(p0[2],p0[3],p1[1]);a=max3f(a,p1[2],p1[3]);
  #pragma unroll
  for(int r=4;r<16;r+=4){a=max3f(a,p0[r],p0[r+1]);b=max3f(b,p0[r+2],p0[r+3]);a=max3f(a,p1[r],p1[r+1]);b=max3f(b,p1[r+2],p1[r+3]);}
  const float m=max2f(a,b);
  auto rr=__builtin_amdgcn_permlane32_swap(__float_as_uint(m),__float_as_uint(m),false,false);
  return max2f(__uint_as_float(rr[0]),__uint_as_float(rr[1]));
}
__device__ __forceinline__ void pv(f32x16*o,int vb,bf16x8 pa0,bf16x8 pa1,bf16x8 pa2,bf16x8 pa3){
  #pragma unroll
  for(int d0=0;d0<2;++d0){s16x4 lo[4],hi[4];
    #pragma unroll
    for(int ks=0;ks<4;++ks){
      asm volatile("ds_read_b64_tr_b16 %0,%1 offset:%c2":"=&v"(lo[ks]):"v"(vb),"i"(d0*4096+ks*1024):"memory");
      asm volatile("ds_read_b64_tr_b16 %0,%1 offset:%c2":"=&v"(hi[ks]):"v"(vb),"i"(d0*4096+ks*1024+512):"memory");}
    asm volatile("s_waitcnt lgkmcnt(0)":::"memory");SBAR();
    #define PK(k) (bf16x8){lo[k][0],lo[k][1],lo[k][2],lo[k][3],hi[k][0],hi[k][1],hi[k][2],hi[k][3]}
    o[d0]=__builtin_amdgcn_mfma_f32_32x32x16_bf16(pa0,PK(0),o[d0],0,0,0);
    o[d0]=__builtin_amdgcn_mfma_f32_32x32x16_bf16(pa1,PK(1),o[d0],0,0,0);
    o[d0]=__builtin_amdgcn_mfma_f32_32x32x16_bf16(pa2,PK(2),o[d0],0,0,0);
    o[d0]=__builtin_amdgcn_mfma_f32_32x32x16_bf16(pa3,PK(3),o[d0],0,0,0);
    #undef PK
  }
}

#ifndef ATTN_STORE16
#define ATTN_STORE16(p,v) (*(u32x4*)(p)=(v))
#endif
template<int THRL> __device__ __forceinline__ void attn_unit(int b,int h,int qb,const bf16*Q,const bf16*__restrict__ K,const bf16*__restrict__ V,bf16*O,char*shm){
  const int tid=tidx(),lane=tid&63,r32=lane&31,hi=lane>>5; const int wid=__builtin_amdgcn_readfirstlane(tid>>6);
  const long rowbase=(long)b*RPBA; const int q0=qb*QB;
  const bf16*Qw=Q+(rowbase+q0+wid*QBLK)*PQ+h*D;
  const bf16*Kh=K+rowbase*PQ+(h>>2)*D,*Vh=V+rowbase*PQ+(h>>2)*D;
  const unsigned lds0=(unsigned)(uintptr_t)shm;
  float*wsf=(float*)(shm+LDS_WS)+wid*64;
  const bf16*ksrc=Kh+(long)lane*PQ+wid*8;
  const bf16*vsrc=Vh+(long)(16*(wid&3)+(lane>>2))*PQ+(wid>>2)*32+(lane&3)*8;
  const unsigned kdst=lds0+LDS_K+wid*1024, vdst=lds0+LDS_V+wid*1024;
  #define DMA_K(t,slot) glds16(ksrc+(long)(t)*KVBLK*PQ,(unsigned)__builtin_amdgcn_readfirstlane(kdst+(slot)))
  #define DMA_V(t,slot) glds16(vsrc+(long)(t)*KVBLK*PQ,(unsigned)__builtin_amdgcn_readfirstlane(vdst+(slot)))
  const int vb0=(int)(lds0+LDS_V)+((lane>>4)&1)*32+(lane&3)*8+(4*hi+((lane&15)>>2))*64;
  const char*Kbase=shm+LDS_K; bf16x8 kf[8];
  const lds_cptr shm3=(lds_cptr)shm; const lds_cptr kp0=shm3+LDS_K+hi*1024+r32*16; const lds_cptr vp0=shm3+LDS_V+((lane>>4)&1)*32+(lane&3)*8+(4*hi+((lane&15)>>2))*64;
  const int NT=KROWS/KVBLK;
  DMA_K(0,0);DMA_V(0,0);DMA_K(1,SLOTB);
  bf16x8 qr[4];
  #pragma unroll
  for(int d0=0;d0<4;++d0)qr[d0]=*reinterpret_cast<const bf16x8*>(&Qw[(long)r32*PQ+d0*16+hi*8]);
  float mhat=0.f,l_reg=0.f;f32x16 o[2];o[0]=f32x16{};o[1]=f32x16{};f32x16 negm=f32x16{};asm volatile("":"+v"(negm));
  const int qrel=wid*QBLK+r32;
  #define CMASK(P0,P1,t) do{}while(0)
  bool resc=false;
  #define START(P0,P1) do{ const float rm=rowmax(P0,P1); resc=false; \
    { const float dl=rm; mhat=fadd_s(mhat,dl); \
      _Pragma("unroll") for(int r=0;r<16;++r){P0[r]=fsub_s(P0[r],dl);P1[r]=fsub_s(P1[r],dl);} \
      _Pragma("unroll") for(int r=0;r<16;++r)negm[r]=-mhat; asm volatile("":"+v"(negm)); } \
    _Pragma("unroll") for(int r=0;r<16;++r)P0[r]=__builtin_amdgcn_exp2f(P0[r]); }while(0)
  #define RESC() do{ if(resc){ asm volatile("s_waitcnt lgkmcnt(0)":::"memory"); \
      _Pragma("unroll") for(int d_=0;d_<2;++d_) _Pragma("unroll") for(int r=0;r<16;++r)o[d_][r]*=wsf[crow(r,hi)]; } }while(0)
  f32x16 pA0,pA1,pB0,pB1;
  int sl_prev=0,sl_cur=0,sl_next=SLOTB;
  #define ROT() do{sl_prev=sl_cur;sl_cur=sl_next;sl_next=(sl_next==(NSLOT-1)*SLOTB)?0:sl_next+SLOTB;}while(0)
  DMA_K(2,2*SLOTB);
  WAIT_BAR(3);
  qkt(pA0,pA1,Kbase,qr,negm,r32,hi);asm volatile("s_nop 15\n\ts_nop 7":"+v"(pA0),"+v"(pA1));CMASK(pA0,pA1,0);
  START(pA0,pA1);
  _Pragma("unroll") for(int r=0;r<16;++r)pA1[r]=__builtin_amdgcn_exp2f(pA1[r]);
  WAIT_BAR(0);
  DMA_K(3,0);DMA_V(1,SLOTB);
  ROT();
  kload8(kf,kp0+sl_cur);
  WAIT_BAR(2);
  s16x4 vlo[8],vhi[8]; u32x4 pw0,pw1,pw2,pw3;
  #define PKW(P,B) cvtpk_s(P[B],P[B+1])
  #define PAF(k) __builtin_bit_cast(bf16x8,pw##k)
  #define VFR(i) (bf16x8){vlo[i][0],vlo[i][1],vlo[i][2],vlo[i][3],vhi[i][0],vhi[i][1],vhi[i][2],vhi[i][3]}
  #define PIN(x) asm volatile("":"+v"(x))
  #define MX3(a,b,c) __builtin_fmaxf(__builtin_fmaxf((a),(b)),(c))
  #define GAPA(MF,A0,A1,A2,A3,W0,W1,PW) do{ MF; sacc+=A0; sacc+=A1; sacc+=A2; sacc+=A3; PIN(sacc); W0; W1; PIN(PW); SBAR(); }while(0)
  #define EX(v) __builtin_amdgcn_exp2f(v)
  #define GAPB(MF,X,B) do{ MF; X[B]=EX(X[B]); X[B+1]=EX(X[B+1]); X[B+2]=EX(X[B+2]); X[B+3]=EX(X[B+3]); PIN(X); SBAR(); }while(0)
  #define VRD(i) do{ vlo[i]=vtr(vp_+(((i)>>2)*4096+((i)&3)*1024)); vhi[i]=vtr(vp_+(((i)>>2)*4096+((i)&3)*1024+512)); }while(0)
  #define KRD(G,j) do{ if(G){ kload2(kf,kp0+sl_next,j); SBAR(); } }while(0)
  #define STEP(C0,C1,P0,P1,t,GK,GV,GL) do{ SBAR(); \
    const lds_cptr vp_=vp0+sl_prev; \
    VRD(0); SBAR(); float sacc=(P0[0]+P0[1]); \
    GAPA(C0=__builtin_amdgcn_mfma_f32_32x32x16_bf16(kf[0],qr[0],negm,0,0,0), P0[2],P0[3],P0[4],P0[5],     pw0[0]=PKW(P0,0), pw0[1]=PKW(P0,2), pw0); \
    VRD(4); SBAR(); GAPA(C1=__builtin_amdgcn_mfma_f32_32x32x16_bf16(kf[1],qr[0],negm,0,0,0), P0[6],P0[7],P0[8],P0[9],     pw0[2]=PKW(P0,4), pw0[3]=PKW(P0,6), pw0); \
    VRD(1); SBAR(); GAPA(C0=__builtin_amdgcn_mfma_f32_32x32x16_bf16(kf[2],qr[1],C0,0,0,0),   P0[10],P0[11],P0[12],P0[13], pw1[0]=PKW(P0,8), pw1[1]=PKW(P0,10), pw1); \
    VRD(5); SBAR(); GAPA(C1=__builtin_amdgcn_mfma_f32_32x32x16_bf16(kf[3],qr[1],C1,0,0,0),   P0[14],P0[15],P1[0],P1[1],   pw1[2]=PKW(P0,12),pw1[3]=PKW(P0,14), pw1); \
    VRD(2); SBAR(); GAPA(C0=__builtin_amdgcn_mfma_f32_32x32x16_bf16(kf[4],qr[2],C0,0,0,0),   P1[2],P1[3],P1[4],P1[5],     pw2[0]=PKW(P1,0), pw2[1]=PKW(P1,2), pw2); \
    VRD(6); SBAR(); GAPA(C1=__builtin_amdgcn_mfma_f32_32x32x16_bf16(kf[5],qr[2],C1,0,0,0),   P1[6],P1[7],P1[8],P1[9],     pw2[2]=PKW(P1,4), pw2[3]=PKW(P1,6), pw2); \
    VRD(3); SBAR(); GAPA(C0=__builtin_amdgcn_mfma_f32_32x32x16_bf16(kf[6],qr[3],C0,0,0,0),   P1[10],P1[11],P1[12],P1[13], pw3[0]=PKW(P1,8), pw3[1]=PKW(P1,10), pw3); \
    VRD(7); SBAR(); GAPA(C1=__builtin_amdgcn_mfma_f32_32x32x16_bf16(kf[7],qr[3],C1,0,0,0),   P1[14],P1[15],0.f,0.f,       pw3[2]=PKW(P1,12),pw3[3]=PKW(P1,14), pw3); \
    l_reg+=sacc; \
    if(GK){DMA_K((t)+3,sl_cur);} if(GV){DMA_V((t)+1,sl_next);} \
    CMASK(C0,C1,t); \
    { float a=MX3(C0[0],C0[1],C1[0]),b=MX3(C0[2],C0[3],C1[1]); a=MX3(a,C1[2],C1[3]); \
      _Pragma("unroll") for(int r=4;r<16;r+=4){a=MX3(a,C0[r],C0[r+1]);b=MX3(b,C0[r+2],C0[r+3]);a=MX3(a,C1[r],C1[r+1]);b=MX3(b,C1[r+2],C1[r+3]);} \
      float rm=__builtin_fmaxf(a,b); { auto rr=__builtin_amdgcn_permlane32_swap(__float_as_uint(rm),__float_as_uint(rm),false,false); rm=__builtin_fmaxf(__uint_as_float(rr[0]),__uint_as_float(rr[1])); } \
      resc=false; \
      if(__builtin_expect(__any(rm>(float)THRL),0)){ const float dl=__builtin_fmaxf(rm,0.f); mhat+=dl; \
        _Pragma("unroll") for(int r=0;r<16;++r){C0[r]-=dl;C1[r]-=dl;} \
        _Pragma("unroll") for(int r=0;r<16;++r)negm[r]=-mhat; asm volatile("":"+v"(negm)); \
        const float f=__builtin_amdgcn_exp2f(-dl); l_reg*=f; if(hi==0)wsf[r32]=f; resc=true; } } \
    SBAR(); \
    GAPB(o[0]=__builtin_amdgcn_mfma_f32_32x32x16_bf16(PAF(0),VFR(0),o[0],0,0,0), C0,0); \
    GAPB(o[1]=__builtin_amdgcn_mfma_f32_32x32x16_bf16(PAF(0),VFR(4),o[1],0,0,0), C0,4); \
    KRD(GL,0); GAPB(o[0]=__builtin_amdgcn_mfma_f32_32x32x16_bf16(PAF(1),VFR(1),o[0],0,0,0), C0,8); \
    KRD(GL,1); GAPB(o[1]=__builtin_amdgcn_mfma_f32_32x32x16_bf16(PAF(1),VFR(5),o[1],0,0,0), C0,12); \
    KRD(GL,2); GAPB(o[0]=__builtin_amdgcn_mfma_f32_32x32x16_bf16(PAF(2),VFR(2),o[0],0,0,0), C1,0); \
    KRD(GL,3); GAPB(o[1]=__builtin_amdgcn_mfma_f32_32x32x16_bf16(PAF(2),VFR(6),o[1],0,0,0), C1,4); \
    GAPB(o[0]=__builtin_amdgcn_mfma_f32_32x32x16_bf16(PAF(3),VFR(3),o[0],0,0,0), C1,8); \
    GAPB(o[1]=__builtin_amdgcn_mfma_f32_32x32x16_bf16(PAF(3),VFR(7),o[1],0,0,0), C1,12); \
    }while(0)
  int t=1;
  #undef CMASK
  #define CMASK(P0,P1,t) do{}while(0)
  for(;t+5<NT;t+=2){
    STEP(pB0,pB1,pA0,pA1,t,true,true,true);     WAIT_BAR(2); RESC(); ROT();
    STEP(pA0,pA1,pB0,pB1,t+1,true,true,true);   WAIT_BAR(2); RESC(); ROT();
  }
  #undef CMASK
  #define CMASK(P0,P1,t) do{}while(0)
  #define ENDW(tt) do{ if((tt)+3<NT){WAIT_BAR(2);} else if((tt)+2<NT){WAIT_BAR(1);} else {WAIT_BAR(0);} }while(0)
  for(;t+1<NT;t+=2){
    STEP(pB0,pB1,pA0,pA1,t,(t+3<NT),(t+1<NT),(t+1<NT));       ENDW(t);   RESC(); ROT();
    STEP(pA0,pA1,pB0,pB1,t+1,(t+4<NT),(t+2<NT),(t+2<NT));     ENDW(t+1); RESC(); ROT();
  }
  STEP(pB0,pB1,pA0,pA1,NT-1,false,false,false); RESC();
  { float sacc=pB0[0]+pB0[1]; _Pragma("unroll") for(int r=2;r<16;++r)sacc+=pB0[r]; _Pragma("unroll") for(int r=0;r<16;++r)sacc+=pB1[r]; l_reg+=sacc;
    pw0=(u32x4){PKW(pB0,0),PKW(pB0,2),PKW(pB0,4),PKW(pB0,6)};pw1=(u32x4){PKW(pB0,8),PKW(pB0,10),PKW(pB0,12),PKW(pB0,14)};pw2=(u32x4){PKW(pB1,0),PKW(pB1,2),PKW(pB1,4),PKW(pB1,6)};pw3=(u32x4){PKW(pB1,8),PKW(pB1,10),PKW(pB1,12),PKW(pB1,14)};
    SBAR(); pv(o,vb0+sl_cur,PAF(0),PAF(1),PAF(2),PAF(3)); }
  #undef PKW
  #undef PAF
  #undef VFR
  #undef PIN
  #undef MX3
  #undef GAPA
  #undef GAPB
  #undef EX
  #undef VRD
  #undef KRD
  #undef STEP
  #undef ENDW
  {auto rr=__builtin_amdgcn_permlane32_swap(__float_as_uint(l_reg),__float_as_uint(l_reg),false,false);l_reg=__uint_as_float(rr[0])+__uint_as_float(rr[1]);}
  if(hi==0)wsf[32+r32]=l_reg;asm volatile("s_waitcnt lgkmcnt(0)":::"memory");
  float rli[16];
  #pragma unroll
  for(int r=0;r<16;++r)rli[r]=__builtin_amdgcn_rcpf(wsf[32+crow(r,hi)]);
  bf16*Ow=O+(rowbase+q0+wid*QBLK)*PO+h*D;
  { bf16*stg=(bf16*)(shm+LDS_OST)+wid*2048;
    #pragma unroll
    for(int r=0;r<16;++r){const int orow=crow(r,hi);
      #pragma unroll
      for(int d0=0;d0<2;++d0)stg[orow*64+d0*32+r32]=__float2bfloat16(o[d0][r]*rli[r]);}
    asm volatile("s_waitcnt lgkmcnt(0)":::"memory");
    #pragma unroll
    for(int i=0;i<4;++i){const int row=i*8+(lane>>3),ch=lane&7; const u32x4 v=*(const u32x4*)(stg+row*64+ch*8); ATTN_STORE16(Ow+(long)row*PO+ch*8,v);} }
  asm volatile("s_waitcnt lgkmcnt(0)\n\ts_barrier":::"memory");
  #undef DMA_K
  #undef DMA_V
  #undef CMASK
  #undef START
  #undef RESC
  #undef ROT
}
constexpr int ATTN_LDS_BYTES=LDS_BYTES;
#undef SBAR
#undef WAIT_BAR
}

DEV void phase_even_post(PPtr p, int li) {
    const int tid = tidx(), lane = tid & 63, gw = blockIdx.x * NWAVE + (tid >> 6), ngw = gridDim.x * NWAVE;
    u16* RAW = (u16*)(p->ws + OFF_RAW);
    const float* qg = p->in[10] + li * 64; const float* kg = p->in[11] + li * 64;
    const float* T = (const float*)(p->ws + OFF_ROPE);
    const int w8 = (lane & 7) * 8, i0 = w8 & 31; const bool second = (lane & 4) != 0;
    for (int item = gw; item < MROWS * 3; item += ngw) {
        const int m = item / 3, pass = item - 3 * m;
        if (pass == 2 && lane >= 32) continue;
        const int b = m / RPB, q = m - b * RPB;
        const int sl = pass * 8 + (lane >> 3);
        const int c0 = sl < 8 ? sl * 64 : sl < 10 ? 512 + (sl - 8) * 64 : sl < 18 ? 768 + (sl - 10) * 64 : 1280 + (sl - 18) * 64;
        u16* ptr = RAW + (size_t)m * 1536 + c0 + w8;
        float x[8]; unpack8(*(const uint4*)ptr, x);
        if (sl < 10) {
            const float* gn = (sl < 8 ? qg : kg) + w8;
            float ss = 0.f;
#pragma unroll
            for (int e = 0; e < 8; ++e) ss += x[e] * x[e];
            ss += __shfl_xor(ss, 1); ss += __shfl_xor(ss, 2); ss += __shfl_xor(ss, 4);
            const float rs = rsqrtf(ss * (1.f / 64.f) + 1e-6f);
            const float4 g0 = *(const float4*)gn, g1 = *(const float4*)(gn + 4);
            x[0] *= rs * g0.x; x[1] *= rs * g0.y; x[2] *= rs * g0.z; x[3] *= rs * g0.w; x[4] *= rs * g1.x; x[5] *= rs * g1.y; x[6] *= rs * g1.z; x[7] *= rs * g1.w;
        }
        if (q < SEQ) {
            const float* ct = (i0 < 16) ? T + (q >> 6) * 16 + i0 : T + 8192 + (q & 63) * 16 + (i0 - 16);
            const float* st = ct + ((i0 < 16) ? 4096 : 1024);
            const float4 c0v = *(const float4*)ct, c1v = *(const float4*)(ct + 4), s0v = *(const float4*)st, s1v = *(const float4*)(st + 4);
            const float cs[8] = {c0v.x, c0v.y, c0v.z, c0v.w, c1v.x, c1v.y, c1v.z, c1v.w}, sn[8] = {s0v.x, s0v.y, s0v.z, s0v.w, s1v.x, s1v.y, s1v.z, s1v.w};
            const float sc = (sl < 8) ? attn_body::C2 : 1.f;
#pragma unroll
            for (int e = 0; e < 8; ++e) {
                const float other = __shfl_xor(x[e], 4);
                const float o = second ? (other * sn[e] + x[e] * cs[e]) : (x[e] * cs[e] - other * sn[e]);
                x[e] = o * sc;
            }
        }
        *(uint4*)ptr = pack8(x);
    }
}

template <int mode, bool qctx>
DEV void attn_wave(const u16* QB, int pitch, int qcol, int kcol, int vcol, u16* AO, int ocol,
                   int b, int hk, int blk, const float* sinkp, const float* rpb, u16* sV) {
    const int lane = tidx() & 63, qi = lane & 15, quad = lane >> 4;
    const bool gqa = mode < 2;
    const size_t rowb = (size_t)b * RPB;
    const float SCL = 0.125f * LOG2E;
    int qtok[4], qhead[4]; bf16x8 qf[4][2];
#pragma unroll
    for (int i = 0; i < 4; ++i) {
        qtok[i] = gqa ? blk * 16 + qi : blk * 64 + i * 16 + qi; qhead[i] = gqa ? hk * 4 + i : hk;
        const size_t m = rowb + (qctx ? SEQ : 0) + qtok[i];
        const u16* qp = QB + m * pitch + qcol + qhead[i] * 64 + quad * 8;
        qf[i][0] = *(const bf16x8*)qp; qf[i][1] = *(const bf16x8*)(qp + 32);
    }
    f32x4 o[4][4]; float mrun[4], lrun[4];
#pragma unroll
    for (int i = 0; i < 4; ++i) {
#pragma unroll
        for (int d = 0; d < 4; ++d) o[i][d] = (f32x4){0.f, 0.f, 0.f, 0.f};
        if (mode == 1) { mrun[i] = sinkp[qhead[i]] * LOG2E; lrun[i] = (quad == 0) ? 1.f : 0.f; } else { mrun[i] = -1e30f; lrun[i] = 0.f; }
    }
    const u16* Kb = QB + kcol + hk * 64; const u16* Vb = QB + vcol + hk * 64;
    int n_local, ustart, rs = 0;
    if (qctx) { n_local = 0; ustart = 0; }
    else if (mode == 0) { n_local = RPB / 32; ustart = 0; }
    else if (mode == 1) { n_local = 9; ustart = blk * 16 - 128; }
    else { rs = min(max(blk - 4, 0), 248); n_local = 16; ustart = rs * 64; }
    const int n_ctx = (mode == 0 && !qctx) ? 0 : 8;
    for (int tt = 0; tt < n_local + n_ctx; ++tt) {
        const bool loc = tt < n_local;
        const int u0 = loc ? ustart + 32 * tt : SEQ + 32 * (tt - n_local);
        const bool masked = loc && mode != 0;
        bf16x8 kf[2][2];
#pragma unroll
        for (int kt = 0; kt < 2; ++kt) {
            const int u = min(max(u0 + kt * 16 + qi, 0), RPB - 1);
            const u16* kp = Kb + (rowb + u) * pitch + quad * 8;
            kf[kt][0] = *(const bf16x8*)kp; kf[kt][1] = *(const bf16x8*)(kp + 32);
        }
#pragma unroll
        for (int c = 0; c < 4; ++c) {
            const int idx = c * 64 + lane, key = idx >> 3, dc = idx & 7;
            const int u = min(max(u0 + key, 0), RPB - 1);
            const uint4 v = *(const uint4*)(Vb + (rowb + u) * pitch + dc * 8);
            *(uint4*)(sV + key * 72 + dc * 8) = v;
        }
        bf16x8 vf[4];
#pragma unroll
        for (int dt = 0; dt < 4; ++dt)
#pragma unroll
            for (int jj = 0; jj < 8; ++jj) {
                const int key = (jj < 4) ? quad * 4 + jj : 16 + quad * 4 + (jj - 4);
                vf[dt][jj] = (short)sV[key * 72 + dt * 16 + qi];
            }
#pragma unroll
        for (int i = 0; i < 4; ++i) {
            f32x4 s0 = (f32x4){0.f, 0.f, 0.f, 0.f}, s1 = (f32x4){0.f, 0.f, 0.f, 0.f};
            s0 = __builtin_amdgcn_mfma_f32_16x16x32_bf16(kf[0][0], qf[i][0], s0, 0, 0, 0);
            s0 = __builtin_amdgcn_mfma_f32_16x16x32_bf16(kf[0][1], qf[i][1], s0, 0, 0, 0);
            s1 = __builtin_amdgcn_mfma_f32_16x16x32_bf16(kf[1][0], qf[i][0], s1, 0, 0, 0);
            s1 = __builtin_amdgcn_mfma_f32_16x16x32_bf16(kf[1][1], qf[i][1], s1, 0, 0, 0);
            float sc[8];
#pragma unroll
            for (int j = 0; j < 4; ++j) { sc[j] = s0[j] * SCL; sc[4 + j] = s1[j] * SCL; }
            if (masked) {
                const int t = qtok[i];
#pragma unroll
                for (int e = 0; e < 8; ++e) {
                    const int u = u0 + (e >> 2) * 16 + quad * 4 + (e & 3);
                    if (mode == 1) {
                        const int dd = t - u;
                        const bool ok = (u >= 0) && (u < SEQ) && (dd <= 128) && (dd >= -128);
                        if (!ok) sc[e] = -INFINITY;
                    } else {
                        const int c = t & 63, r = t >> 6, ur = u >> 6, uc = u & 63;
                        const int cst = min(max(c - 8, 0), 48);
                        const bool ok = (uc >= cst) && (uc < cst + 16);
                        const int dr = min(max(ur - r + 7, 0), 14), dcx = min(max(uc - c + 15, 0), 30);
                        const float bias = rpb[(qhead[i] * 15 + dr) * 31 + dcx];
                        sc[e] = ok ? sc[e] + bias * LOG2E : -INFINITY;
                    }
                }
            }
            float mx = fmaxf(fmaxf(fmaxf(sc[0], sc[1]), fmaxf(sc[2], sc[3])), fmaxf(fmaxf(sc[4], sc[5]), fmaxf(sc[6], sc[7])));
            mx = fmaxf(mx, __shfl_xor(mx, 16)); mx = fmaxf(mx, __shfl_xor(mx, 32));
            const float mn = fmaxf(mrun[i], mx);
            const float al = __builtin_amdgcn_exp2f(mrun[i] - mn);
            mrun[i] = mn;
            float pe[8], ps = 0.f;
#pragma unroll
            for (int e = 0; e < 8; ++e) { pe[e] = __builtin_amdgcn_exp2f(sc[e] - mn); ps += pe[e]; }
            lrun[i] = lrun[i] * al + ps;
            union { unsigned u[4]; bf16x8 v; } pf;
            pf.u[0] = pk2(pe[0], pe[1]); pf.u[1] = pk2(pe[2], pe[3]); pf.u[2] = pk2(pe[4], pe[5]); pf.u[3] = pk2(pe[6], pe[7]);
#pragma unroll
            for (int dt = 0; dt < 4; ++dt) {
                o[i][dt] = o[i][dt] * al;
                o[i][dt] = __builtin_amdgcn_mfma_f32_16x16x32_bf16(vf[dt], pf.v, o[i][dt], 0, 0, 0);
            }
        }
    }
#pragma unroll
    for (int i = 0; i < 4; ++i) {
        float l = lrun[i]; l += __shfl_xor(l, 16); l += __shfl_xor(l, 32);
        const float inv = 1.f / l;
        const size_t m = rowb + (qctx ? SEQ : 0) + qtok[i];
        u16* op = AO + m * DM + ocol + qhead[i] * 64 + quad * 4;
#pragma unroll
        for (int dt = 0; dt < 4; ++dt) {
            uint2 w; w.x = pk2(o[i][dt][0] * inv, o[i][dt][1] * inv); w.y = pk2(o[i][dt][2] * inv, o[i][dt][3] * inv);
            *(uint2*)(op + dt * 16) = w;
        }
    }
}

DEV void phase_attn_even(PPtr p, int li, char* lds) {
    {
        const attn_body::bf16* RAWb = (const attn_body::bf16*)(p->ws + OFF_RAW); attn_body::bf16* AOb = (attn_body::bf16*)(p->ws + OFF_AO);
        const int G = gridDim.x, bx = blockIdx.x;
        if (G == 256) {
            const int vcu = (bx & 7) * 32 + (bx >> 3); const int x = vcu >> 5, combo = x >> 1, sub = (x & 1) * 32 + (vcu & 31);
            for (int i = 0; i < 4; ++i) attn_body::attn_unit<8>(combo >> 1, (combo & 1) * 4 + i, sub, RAWb, RAWb + 512, RAWb + 640, AOb, lds);
        } else {
            for (int u = bx; u < 1024; u += G) attn_body::attn_unit<8>(u >> 9, (u >> 6) & 7, u & 63, RAWb, RAWb + 512, RAWb + 640, AOb, lds);
        }
    }
    const int wave = tidx() >> 6, gw = blockIdx.x * NWAVE + wave, ngw = gridDim.x * NWAVE;
    u16* sV = (u16*)lds + wave * (32 * 72);
    const u16* RAW = (const u16*)(p->ws + OFF_RAW); u16* AO = (u16*)(p->ws + OFF_AO);
    const float* sink = p->in[12] + li * 8;
    for (int t = gw; t < 4224; t += ngw) {
        if (t < 4096) attn_wave<1, false>(RAW, 1536, 768, 1280, 1408, AO, 512, t >> 11, (t >> 10) & 1, t & 1023, sink, nullptr, sV);
        else if (t < 4160) { const int u = t - 4096; attn_wave<0, true>(RAW, 1536, 0, 512, 640, AO, 0, u >> 5, (u >> 4) & 1, u & 15, nullptr, nullptr, sV); }
        else { const int u = t - 4160; attn_wave<1, true>(RAW, 1536, 768, 1280, 1408, AO, 512, u >> 5, (u >> 4) & 1, u & 15, sink, nullptr, sV); }
    }
}
DEV void phase_attn_odd(PPtr p, int li, char* lds) {
    const int wave = tidx() >> 6, gw = blockIdx.x * NWAVE + wave, ngw = gridDim.x * NWAVE;
    u16* sV = (u16*)lds + wave * (32 * 72);
    const u16* QKV = (const u16*)(p->ws + OFF_RAW); u16* AO = (u16*)(p->ws + OFF_AO);
    const float* rpb = p->in[15] + li * 8 * 15 * 31;
    for (int t = gw; t < 4160; t += ngw) {
        if (t < 4096) attn_wave<2, false>(QKV, 1536, 0, 512, 1024, AO, 0, t >> 11, (t >> 8) & 7, t & 255, nullptr, rpb, sV);
        else { const int u = t - 4096; attn_wave<2, true>(QKV, 1536, 0, 512, 1024, AO, 0, u >> 5, (u >> 2) & 7, u & 3, nullptr, rpb, sV); }
    }
}

DEV float shiftmix_at(const u16* ZDb, int pp, int ch, float mu) {
    const bool lat = pp < SEQ; const int lo = lat ? 0 : SEQ, hi = lat ? SEQ : RPB;
    const u16* zc = ZDb + (size_t)pp * ZDW + ch;
    const float z = bf2f(zc[0]);
    const float a = (pp - 1 >= lo) ? bf2f(zc[-ZDW]) : 0.f, c = (pp + 1 < hi) ? bf2f(zc[ZDW]) : 0.f;
    return z + (0.5f * (a + c) - z) * mu;
}
DEV void phase_rwkv_prep(PPtr p, int li, int bb) {
    const int tid = tidx(), lane = tid & 63, gw = blockIdx.x * NWAVE + (tid >> 6), ngw = gridDim.x * NWAVE;
    const u16* ZDb = (const u16*)(p->ws + OFF_ZD) + (size_t)bb * RPB * ZDW;
    const float* mu = p->in[16] + li * ZDW; const float* kkw = p->in[22] + li * 512;
    u16* R = (u16*)(p->ws + OFF_R); u16* KK = (u16*)(p->ws + OFF_KK); u16* V = (u16*)(p->ws + OFF_V); u16* LA = (u16*)(p->ws + OFF_LA);
    {
        u16* LB = (u16*)(p->ws + OFF_PU);
        const float* w2 = p->in[18] + (size_t)li * 2 * 64 * 512; const float* a2 = p->in[20] + (size_t)li * 2 * 64 * 512; const float* g2 = p->in[21] + (size_t)li * 128 * 512;
        for (int idx = gw * 64 + lane; idx < 2560 * 32; idx += ngw * 64) {
            const int n = idx >> 5, kc = (idx & 31) * 8, type = n >> 9, nn = n & 511;
            float f[8];
#pragma unroll
            for (int e = 0; e < 8; ++e) {
                const int k = kc + e; float x = 0.f;
                if (type < 2) { if (k < 64) x = w2[((size_t)type * 64 + k) * 512 + nn]; }
                else if (type < 4) { if (k >= 64 && k < 128) x = a2[((size_t)(type - 2) * 64 + (k - 64)) * 512 + nn]; }
                else { if (k >= 128) x = g2[(size_t)(k - 128) * 512 + nn]; }
                f[e] = x;
            }
            *(uint4*)(LB + (size_t)n * 256 + kc) = pack8(f);
        }
    }
    for (int pp = gw; pp < RPB; pp += ngw) {
        const bool lat = pp < SEQ; const int lo = lat ? 0 : SEQ, hi = lat ? SEQ : RPB;
        const bool hp = pp - 1 >= lo, hn = pp + 1 < hi;
        const u16* zc = ZDb + (size_t)pp * ZDW;
#pragma unroll
        for (int j = 0; j < 4; ++j) {
            const int c8 = lane + 64 * j;
            if (j == 3 && lane >= 32) break;
            const int ch = 8 * c8;
            float z[8], a[8], c[8], zs[8];
            unpack8(*(const uint4*)(zc + ch), z);
            if (hp) unpack8(*(const uint4*)(zc - ZDW + ch), a); else { for (int e = 0; e < 8; ++e) a[e] = 0.f; }
            if (hn) unpack8(*(const uint4*)(zc + ZDW + ch), c); else { for (int e = 0; e < 8; ++e) c[e] = 0.f; }
            const float4 m0 = *(const float4*)(mu + ch), m1 = *(const float4*)(mu + ch + 4);
            const float mm[8] = {m0.x, m0.y, m0.z, m0.w, m1.x, m1.y, m1.z, m1.w};
#pragma unroll
            for (int e = 0; e < 8; ++e) zs[e] = z[e] + (0.5f * (a[e] + c[e]) - z[e]) * mm[e];
            if (j == 0) *(uint4*)(R + (size_t)pp * 512 + ch) = pack8(zs);
            else if (j == 1) {
                const float4 k0 = *(const float4*)(kkw + ch - 512), k1 = *(const float4*)(kkw + ch - 512 + 4);
                const float kw[8] = {k0.x, k0.y, k0.z, k0.w, k1.x, k1.y, k1.z, k1.w};
                float t[8], ss = 0.f;
#pragma unroll
                for (int e = 0; e < 8; ++e) { t[e] = zs[e] * kw[e]; ss += t[e] * t[e]; }
                ss += __shfl_xor(ss, 1); ss += __shfl_xor(ss, 2); ss += __shfl_xor(ss, 4);
                const float inv = 1.f / fmaxf(sqrtf(ss), 1e-12f);
#pragma unroll
                for (int e = 0; e < 8; ++e) t[e] *= inv;
                *(uint4*)(KK + (size_t)pp * 512 + ch - 512) = pack8(t);
            } else if (j == 2) *(uint4*)(V + (size_t)pp * 512 + ch - 1024) = pack8(zs);
            else {
                float o[8];
#pragma unroll
                for (int e = 0; e < 8; ++e) o[e] = (lane < 8) ? tanhf(zs[e]) : (lane < 16) ? zs[e] : sigmoidf_(zs[e]);
                *(uint4*)(LA + (size_t)pp * 256 + ch - 1536) = pack8(o);
            }
        }
    }
}
struct EpiDecay { float* DEC; const float* w0; int d;
    DEV void operator()(int r, int c, float v, float) const {
        const float x = -(w0[c] + v); const float sp = x > 20.f ? x : log1pf(expf(x)); const float w = -sp - 0.5f;
        DEC[((size_t)r * 2 + d) * 512 + c] = expf(-expf(w)); } };
struct EpiIclr { u16* KD; u16* BQ; const u16* KK; const u16* ZDb; const float* a0; const float* ka; const float* muk; int d;
    DEV void operator()(int r, int c, float v, float) const {
        const float a = sigmoidf_(a0[c] + v);
        const float k = shiftmix_at(ZDb, r, 512 + c, muk[c]);
        KD[((size_t)r * 2 + d) * 512 + c] = (u16)f2bf(k * (1.f + (a - 1.f) * ka[c]));
        BQ[((size_t)r * 2 + d) * 512 + c] = (u16)f2bf(bf2f(KK[(size_t)r * 512 + c]) * a); } };
struct EpiGate { u16* G; DEV void operator()(int r, int c, float v, float) const { G[(size_t)r * 512 + c] = (u16)f2bf(v); } };

DEV int pos_to_pp(int s, int d) { return (s < NCTX) ? (d ? SEQ + NCTX - 1 - s : SEQ + s) : (d ? SEQ - 1 - (s - NCTX) : s - NCTX); }
struct StepV { float d; unsigned a; unsigned b; float v; };
DEV StepV load_step(const float* DEC, const u16* KD, const u16* BQ, const u16* KK, const u16* R, const u16* V, int pp, int h, int d, int lane) {
    const size_t e1 = (size_t)pp * 512 + h * 64, e2 = ((size_t)pp * 2 + d) * 512 + h * 64;
    StepV s;
    s.d = DEC[e2 + lane];
    s.a = (lane < 32) ? ((const unsigned*)(KD + e2))[lane] : ((const unsigned*)(BQ + e2))[lane - 32];
    s.b = (lane < 32) ? ((const unsigned*)(KK + e1))[lane] : ((const unsigned*)(R + e1))[lane - 32];
    s.v = bf2f(V[e1 + lane]);
    return s;
}
typedef float f32x2 __attribute__((ext_vector_type(2)));
constexpr int SSLOT = 320;
typedef __attribute__((address_space(3))) float* ldsf;
typedef const __attribute__((address_space(3))) f32x4* lds4;
DEV void stage_step(ldsf slot, const StepV& s, int lane) {
    slot[lane] = s.d;
    *(__attribute__((address_space(3))) f32x2*)(slot + 64 + 2 * lane) = (f32x2){bflo(s.a), bfhi(s.a)};
    *(__attribute__((address_space(3))) f32x2*)(slot + 192 + 2 * lane) = (f32x2){bflo(s.b), bfhi(s.b)};
}
#define LO2(v) ((f32x2){(v)[0], (v)[1]})
#define HI2(v) ((f32x2){(v)[2], (v)[3]})
template <int MODE>
DEV float scan_step(f32x2 (&S)[32], ldsf sl, float vv) {
    lds4 D = (lds4)sl;
    f32x2 sa = {0.f, 0.f}, sb = {0.f, 0.f};
#pragma unroll
    for (int q = 0; q < 16; ++q) { const f32x4 k4 = D[48 + q]; sa += S[2 * q] * LO2(k4); sb += S[2 * q + 1] * HI2(k4);
        if ((q & 3) == 3) asm volatile("" : "+v"(D), "+v"(sa), "+v"(sb)); }
    const float nsa = -((sa[0] + sa[1]) + (sb[0] + sb[1]));
    const f32x2 nsa2 = {nsa, nsa}, vv2 = {vv, vv};
    f32x2 y = {0.f, 0.f}, z = {0.f, 0.f};
#pragma unroll
    for (int q = 0; q < 16; ++q) {
        const f32x4 d4 = D[q], b4 = D[32 + q];
        f32x2 t0 = nsa2 * LO2(b4), t1 = nsa2 * HI2(b4);
        if (MODE >= 1) { const f32x4 kd4 = D[16 + q]; t0 += vv2 * LO2(kd4); t1 += vv2 * HI2(kd4); }
        S[2 * q] = S[2 * q] * LO2(d4) + t0; S[2 * q + 1] = S[2 * q + 1] * HI2(d4) + t1;
        if (MODE == 2) { const f32x4 r4 = D[64 + q]; y += S[2 * q] * LO2(r4); z += S[2 * q + 1] * HI2(r4); }
        else y += S[2 * q + 1];
        if ((q & 1) == 1) asm volatile("" : "+v"(D), "+v"(y), "+v"(z), "+v"(S[2 * q + 1]));
    }
    return (y[0] + y[1]) + (z[0] + z[1]);
}
DEV void scan_step_pu(f32x2 (&P)[32], f32x2 (&U)[32], ldsf sl, float vv) {
    lds4 D = (lds4)sl;
    f32x2 pa = {0.f, 0.f}, pb = {0.f, 0.f}, ua = {0.f, 0.f}, ub = {0.f, 0.f};
#pragma unroll
    for (int q = 0; q < 16; ++q) { const f32x4 k4 = D[48 + q];
        pa += P[2 * q] * LO2(k4); pb += P[2 * q + 1] * HI2(k4); ua += U[2 * q] * LO2(k4); ub += U[2 * q + 1] * HI2(k4);
        if ((q & 3) == 3) asm volatile("" : "+v"(D), "+v"(pa), "+v"(pb), "+v"(ua), "+v"(ub)); }
    const float nsp = -((pa[0] + pa[1]) + (pb[0] + pb[1])), nsu = -((ua[0] + ua[1]) + (ub[0] + ub[1]));
    const f32x2 nsp2 = {nsp, nsp}, nsu2 = {nsu, nsu}, vv2 = {vv, vv};
#pragma unroll
    for (int q = 0; q < 16; ++q) {
        const f32x4 d4 = D[q], b4 = D[32 + q], kd4 = D[16 + q];
        P[2 * q] = P[2 * q] * LO2(d4) + nsp2 * LO2(b4); P[2 * q + 1] = P[2 * q + 1] * HI2(d4) + nsp2 * HI2(b4);
        U[2 * q] = U[2 * q] * LO2(d4) + (vv2 * LO2(kd4) + nsu2 * LO2(b4)); U[2 * q + 1] = U[2 * q + 1] * HI2(d4) + (vv2 * HI2(kd4) + nsu2 * HI2(b4));
        asm volatile("" : "+v"(D), "+v"(P[2 * q]), "+v"(P[2 * q + 1]), "+v"(U[2 * q]), "+v"(U[2 * q + 1]));
    }
}
DEV void phase_scan1(PPtr p, char* lds) {
    const int tid = tidx(), lane = tid & 63, wv = __builtin_amdgcn_readfirstlane(tid >> 6), gw = blockIdx.x * NWAVE + wv, ngw = gridDim.x * NWAVE;
    const float* DEC = (const float*)(p->ws + OFF_DEC); const u16* KD = (const u16*)(p->ws + OFF_KD); const u16* BQ = (const u16*)(p->ws + OFF_BQ);
    const u16* KK = (const u16*)(p->ws + OFF_KK); const u16* R = (const u16*)(p->ws + OFF_R); const u16* V = (const u16*)(p->ws + OFF_V);
    float* PU = (float*)(p->ws + OFF_PU);
    ldsf ring = (ldsf)lds + wv * (3 * SSLOT);
    for (int task = gw; task < 16 * NCH; task += ngw) {
        const int seq = task >> 7, c = task & 127, h = seq >> 1, d = seq & 1;
#define LD(st) load_step(DEC, KD, BQ, KK, R, V, pos_to_pp(c * CLEN + min((st), CLEN - 1), d), h, d, lane)
        f32x2 P[32], U[32];
        float lnf = (float)lane; asm volatile("" : "+v"(lnf));
#pragma unroll
        for (int j = 0; j < 32; ++j) { P[j] = (f32x2){fmaxf(1.f - fabsf(lnf - (float)(2 * j)), 0.f), fmaxf(1.f - fabsf(lnf - (float)(2 * j + 1)), 0.f)}; U[j] = (f32x2){0.f, 0.f}; }
        float vvA, vvB;
        { const StepV s0 = LD(0), s1 = LD(1); stage_step(ring, s0, lane); stage_step(ring + SSLOT, s1, lane); vvA = s0.v; vvB = s1.v; }
        StepV g0 = LD(2), g1 = LD(3), g2 = LD(4), g3 = LD(5);
        int cs = 0, ns = 2;
#pragma unroll 1
        for (int st = 0; st < CLEN; ++st) {
            scan_step_pu(P, U, ring + cs * SSLOT, vvA);
            stage_step(ring + ns * SSLOT, g0, lane);
            vvA = vvB; vvB = g0.v; g0 = g1; g1 = g2; g2 = g3; g3 = LD(st + 6);
            cs = (cs == 2) ? 0 : cs + 1; ns = (ns == 2) ? 0 : ns + 1;
        }
#undef LD
        float4* o = (float4*)(PU + ((size_t)task * 2) * 4096 + lane * 64);
#pragma unroll
        for (int j = 0; j < 16; ++j) { o[j] = (float4){P[2 * j][0], P[2 * j][1], P[2 * j + 1][0], P[2 * j + 1][1]}; o[1024 + j] = (float4){U[2 * j][0], U[2 * j][1], U[2 * j + 1][0], U[2 * j + 1][1]}; }
    }
}
#define S2_PLOAD(ent_, lo, hi) do { const float4* s_ = (const float4*)((ent_) + prow * 64 + pcol); lo = s_[0]; hi = s_[1]; } while (0)
#define S2_ULOAD(ent_, u_) do { const float* s_ = (ent_) + 4096; _Pragma("unroll") for (int t_ = 0; t_ < 2; ++t_) _Pragma("unroll") for (int j_ = 0; j_ < 4; ++j_) u_[t_][j_] = s_[(16 * rt + 4 * q + j_) * 64 + 16 * (ct0 + t_) + r]; } while (0)
#define S2_CSTORE(dst_, a0_, a1_) do { float* d_ = (dst_); _Pragma("unroll") for (int j_ = 0; j_ < 4; ++j_) { d_[(16 * rt + 4 * q + j_) * 64 + 16 * ct0 + r] = a0_[j_]; d_[(16 * rt + 4 * q + j_) * 64 + 16 * ct0 + 16 + r] = a1_[j_]; } } while (0)
#define S2_LSTORE(dst_, a0_, a1_) do { float* d_ = (dst_); _Pragma("unroll") for (int j_ = 0; j_ < 4; ++j_) { d_[(16 * rt + 4 * q + j_) * 68 + 16 * ct0 + r] = a0_[j_]; d_[(16 * rt + 4 * q + j_) * 68 + 16 * ct0 + 16 + r] = a1_[j_]; } } while (0)
DEV void phase_scan2a(PPtr p, char* lds) {
    if (blockIdx.x >= 128) return;
    const int tid = tidx(), lane = tid & 63, w = __builtin_amdgcn_readfirstlane(tid >> 6), seq = blockIdx.x >> 3, g = blockIdx.x & 7;
    float* sX = (float*)lds; float* sZ = sX + 2 * 64 * 68; float* sP = sZ + 2 * 64 * 68;
    float* PUg = (float*)(p->ws + OFF_PU) + (size_t)(seq * NCH + 16 * g) * 8192;
    float* TOT = (float*)(p->ws + OFF_LA) + (size_t)(seq * 8 + g) * 8192;
    const int rt = w >> 1, ct0 = (w & 1) * 2, r = lane & 15, q = lane >> 4;
    const int prow = tid >> 3, pcol = (tid & 7) * 8;
    for (int i = tid; i < 64 * 68; i += NTHR) { const int row = i / 68, col = i - row * 68; sX[i] = (row == col) ? 1.f : 0.f; sZ[i] = 0.f; }
    float4 pa0, pa1, pb0, pb1;
    { float4 t0, t1; S2_PLOAD(PUg, t0, t1); *(float4*)(sP + prow * 68 + pcol) = t0; *(float4*)(sP + prow * 68 + pcol + 4) = t1; }
    S2_PLOAD(PUg + 8192, pa0, pa1); S2_PLOAD(PUg + 2 * 8192, pb0, pb1);
    float ua[2][4], ub[2][4];
    S2_ULOAD(PUg, ua); S2_ULOAD(PUg + 8192, ub);
    __syncthreads();
    for (int jj = 0; jj < 16; ++jj) {
        const int cur = jj & 1;
        f32x4 x0 = {0.f, 0.f, 0.f, 0.f}, x1 = {0.f, 0.f, 0.f, 0.f};
        f32x4 z0 = {ua[0][0], ua[0][1], ua[0][2], ua[0][3]}, z1 = {ua[1][0], ua[1][1], ua[1][2], ua[1][3]};
        const float* Xc = sX + cur * (64 * 68); const float* Zc = sZ + cur * (64 * 68); const float* Pc = sP + cur * (64 * 68);
#pragma unroll
        for (int ks = 0; ks < 16; ++ks) {
            const float ax = Xc[(16 * rt + r) * 68 + 4 * ks + q], az = Zc[(16 * rt + r) * 68 + 4 * ks + q];
            const float b0 = Pc[(4 * ks + q) * 68 + 16 * ct0 + r], b1 = Pc[(4 * ks + q) * 68 + 16 * ct0 + 16 + r];
            x0 = __builtin_amdgcn_mfma_f32_16x16x4f32(ax, b0, x0, 0, 0, 0); x1 = __builtin_amdgcn_mfma_f32_16x16x4f32(ax, b1, x1, 0, 0, 0);
            z0 = __builtin_amdgcn_mfma_f32_16x16x4f32(az, b0, z0, 0, 0, 0); z1 = __builtin_amdgcn_mfma_f32_16x16x4f32(az, b1, z1, 0, 0, 0);
        }
        S2_LSTORE(sX + (cur ^ 1) * (64 * 68), x0, x1); S2_LSTORE(sZ + (cur ^ 1) * (64 * 68), z0, z1);
        S2_CSTORE(PUg + (size_t)jj * 8192, x0, x1); S2_CSTORE(PUg + (size_t)jj * 8192 + 4096, z0, z1);
        if (jj == 15) { S2_CSTORE(TOT, x0, x1); S2_CSTORE(TOT + 4096, z0, z1); }
        { float* Pn = sP + (cur ^ 1) * (64 * 68); *(float4*)(Pn + prow * 68 + pcol) = pa0; *(float4*)(Pn + prow * 68 + pcol + 4) = pa1; }
        pa0 = pb0; pa1 = pb1;
        S2_PLOAD(PUg + (size_t)min(jj + 3, 15) * 8192, pb0, pb1);
#pragma unroll
        for (int t = 0; t < 2; ++t)
#pragma unroll
            for (int j = 0; j < 4; ++j) ua[t][j] = ub[t][j];
        if (jj + 2 < 16) S2_ULOAD(PUg + (size_t)(jj + 2) * 8192, ub);
        __syncthreads();
    }
}
DEV void phase_scan2b(PPtr p, char* lds) {
    if (blockIdx.x >= 128) return;
    const int tid = tidx(), lane = tid & 63, w = __builtin_amdgcn_readfirstlane(tid >> 6), seq = blockIdx.x >> 3, g = blockIdx.x & 7;
    float* sS = (float*)lds; float* sP = sS + 2 * 64 * 68;
    float* PUg = (float*)(p->ws + OFF_PU) + (size_t)(seq * NCH + 16 * g) * 8192;
    float* TOTs = (float*)(p->ws + OFF_LA) + (size_t)(seq * 8) * 8192;
    const int rt = w >> 1, ct0 = (w & 1) * 2, r = lane & 15, q = lane >> 4;
    const int prow = tid >> 3, pcol = (tid & 7) * 8;
    const int T = g + 16;
#define S2_ENT(t_) ((min((t_), T - 1) < g) ? TOTs + (size_t)min((t_), T - 1) * 8192 : PUg + (size_t)(min((t_), T - 1) - g) * 8192)
    for (int i = tid; i < 64 * 68; i += NTHR) sS[i] = 0.f;
    float4 pa0, pa1, pb0, pb1;
    { float4 t0, t1; S2_PLOAD(S2_ENT(0), t0, t1); *(float4*)(sP + prow * 68 + pcol) = t0; *(float4*)(sP + prow * 68 + pcol + 4) = t1; }
    S2_PLOAD(S2_ENT(1), pa0, pa1); S2_PLOAD(S2_ENT(2), pb0, pb1);
    float ua[2][4], ub[2][4];
    S2_ULOAD(S2_ENT(0), ua); S2_ULOAD(S2_ENT(1), ub);
    f32x4 m0 = {0.f, 0.f, 0.f, 0.f}, m1 = {0.f, 0.f, 0.f, 0.f};
    int sb = 0;
    __syncthreads();
    for (int t = 0; t < T; ++t) {
        const int cur = t & 1; const bool chain = t < g;
        if (!chain) S2_CSTORE(PUg + (size_t)(t - g) * 8192 + 4096, m0, m1);
        f32x4 a0 = {ua[0][0], ua[0][1], ua[0][2], ua[0][3]}, a1 = {ua[1][0], ua[1][1], ua[1][2], ua[1][3]};
        const float* Sc = sS + sb * (64 * 68); const float* Pc = sP + cur * (64 * 68);
#pragma unroll
        for (int ks = 0; ks < 16; ++ks) {
            const float av = Sc[(16 * rt + r) * 68 + 4 * ks + q];
            const float b0 = Pc[(4 * ks + q) * 68 + 16 * ct0 + r], b1 = Pc[(4 * ks + q) * 68 + 16 * ct0 + 16 + r];
            a0 = __builtin_amdgcn_mfma_f32_16x16x4f32(av, b0, a0, 0, 0, 0);
            a1 = __builtin_amdgcn_mfma_f32_16x16x4f32(av, b1, a1, 0, 0, 0);
        }
        m0 = a0; m1 = a1;
        if (chain) { S2_LSTORE(sS + (sb ^ 1) * (64 * 68), a0, a1); sb ^= 1; }
        { float* Pn = sP + (cur ^ 1) * (64 * 68); *(float4*)(Pn + prow * 68 + pcol) = pa0; *(float4*)(Pn + prow * 68 + pcol + 4) = pa1; }
        pa0 = pb0; pa1 = pb1;
        S2_PLOAD(S2_ENT(t + 3), pb0, pb1);
#pragma unroll
        for (int u = 0; u < 2; ++u)
#pragma unroll
            for (int j = 0; j < 4; ++j) ua[u][j] = ub[u][j];
        if (t + 2 < T) S2_ULOAD(S2_ENT(t + 2), ub);
        __syncthreads();
    }
#undef S2_ENT
}
DEV void phase_scan3(PPtr p, char* lds) {
    const int tid = tidx(), lane = tid & 63, wv = __builtin_amdgcn_readfirstlane(tid >> 6), gw = blockIdx.x * NWAVE + wv, ngw = gridDim.x * NWAVE;
    const float* DEC = (const float*)(p->ws + OFF_DEC); const u16* KD = (const u16*)(p->ws + OFF_KD); const u16* BQ = (const u16*)(p->ws + OFF_BQ);
    const u16* KK = (const u16*)(p->ws + OFF_KK); const u16* R = (const u16*)(p->ws + OFF_R); const u16* V = (const u16*)(p->ws + OFF_V);
    const float* PU = (const float*)(p->ws + OFF_PU);
    ldsf ring = (ldsf)lds + wv * (3 * SSLOT);
    for (int task = gw; task < 16 * NCH; task += ngw) {
        const int seq = task >> 7, c = task & 127, h = seq >> 1, d = seq & 1;
        float* Yd = (float*)(p->ws + (d ? OFF_ZD : OFF_Y0));
        f32x2 S[32];
        {
            const float4* si = (const float4*)(PU + ((size_t)task * 2 + 1) * 4096 + lane * 64);
#pragma unroll
            for (int j = 0; j < 16; ++j) { const float4 t = si[j]; S[2 * j] = (f32x2){t.x, t.y}; S[2 * j + 1] = (f32x2){t.z, t.w}; }
        }
#define LD(st) load_step(DEC, KD, BQ, KK, R, V, pos_to_pp(c * CLEN + min((st), CLEN - 1), d), h, d, lane)
#define YADD(st, y) (Yd[(size_t)pos_to_pp(c * CLEN + (st), d) * 512 + h * 64 + lane] = (y))
        float vvA, vvB;
        { const StepV s0 = LD(0), s1 = LD(1); stage_step(ring, s0, lane); stage_step(ring + SSLOT, s1, lane); vvA = s0.v; vvB = s1.v; }
        StepV g0 = LD(2), g1 = LD(3), g2 = LD(4), g3 = LD(5);
        int cs = 0, ns = 2;
#pragma unroll 1
        for (int st = 0; st < CLEN; ++st) {
            const float y = scan_step<2>(S, ring + cs * SSLOT, vvA); YADD(st, y);
            stage_step(ring + ns * SSLOT, g0, lane);
            vvA = vvB; vvB = g0.v; g0 = g1; g1 = g2; g2 = g3; g3 = LD(st + 6);
            cs = (cs == 2) ? 0 : cs + 1; ns = (ns == 2) ? 0 : ns + 1;
        }
#undef LD
#undef YADD
    }
}
DEV void phase_readout(PPtr p, int li, int bb) {
    const int tid = tidx(), lane = tid & 63, gw = blockIdx.x * NWAVE + (tid >> 6), ngw = gridDim.x * NWAVE;
    const float* Y0 = (const float*)(p->ws + OFF_Y0);
    const u16* KD = (const u16*)(p->ws + OFF_KD); const u16* R = (const u16*)(p->ws + OFF_R); const u16* V = (const u16*)(p->ws + OFF_V); const u16* G = (const u16*)(p->ws + OFF_G);
    const float* rk = p->in[24] + li * 512; const float* lnw = p->in[25] + li * 512; const float* lnb = p->in[26] + li * 512;
    u16* AO = (u16*)(p->ws + OFF_AO);
    const int c = 8 * lane;
    float rkv[8], lw[8], lb[8];
    { const float4 a = *(const float4*)(rk + c), b = *(const float4*)(rk + c + 4); rkv[0] = a.x; rkv[1] = a.y; rkv[2] = a.z; rkv[3] = a.w; rkv[4] = b.x; rkv[5] = b.y; rkv[6] = b.z; rkv[7] = b.w; }
    { const float4 a = *(const float4*)(lnw + c), b = *(const float4*)(lnw + c + 4); lw[0] = a.x; lw[1] = a.y; lw[2] = a.z; lw[3] = a.w; lw[4] = b.x; lw[5] = b.y; lw[6] = b.z; lw[7] = b.w; }
    { const float4 a = *(const float4*)(lnb + c), b = *(const float4*)(lnb + c + 4); lb[0] = a.x; lb[1] = a.y; lb[2] = a.z; lb[3] = a.w; lb[4] = b.x; lb[5] = b.y; lb[6] = b.z; lb[7] = b.w; }
    for (int pp = gw; pp < RPB; pp += ngw) {
        const size_t m = (size_t)bb * RPB + pp, e = (size_t)pp * 512 + c;
        const float* Y1 = (const float*)(p->ws + OFF_ZD);
        const float4 ya = *(const float4*)(Y0 + e), yb = *(const float4*)(Y0 + e + 4), yc = *(const float4*)(Y1 + e), yd = *(const float4*)(Y1 + e + 4);
        const float y[8] = {ya.x + yc.x, ya.y + yc.y, ya.z + yc.z, ya.w + yc.w, yb.x + yd.x, yb.y + yd.y, yb.z + yd.z, yb.w + yd.w};
        float r[8], k0[8], k1[8], v[8], g[8];
        unpack8(*(const uint4*)(R + e), r); unpack8(*(const uint4*)(KD + ((size_t)pp * 2) * 512 + c), k0); unpack8(*(const uint4*)(KD + ((size_t)pp * 2 + 1) * 512 + c), k1);
        unpack8(*(const uint4*)(V + e), v); unpack8(*(const uint4*)(G + e), g);
        float sm = 0.f, bs = 0.f;
#pragma unroll
        for (int j = 0; j < 8; ++j) { sm += y[j]; bs += r[j] * (k0[j] + k1[j]) * rkv[j]; }
        sm += __shfl_xor(sm, 1); sm += __shfl_xor(sm, 2); sm += __shfl_xor(sm, 4);
        bs += __shfl_xor(bs, 1); bs += __shfl_xor(bs, 2); bs += __shfl_xor(bs, 4);
        const float mean = sm * (1.f / 64.f);
        float vs = 0.f;
#pragma unroll
        for (int j = 0; j < 8; ++j) { const float dv = y[j] - mean; vs += dv * dv; }
        vs += __shfl_xor(vs, 1); vs += __shfl_xor(vs, 2); vs += __shfl_xor(vs, 4);
        const float rstd = rsqrtf(vs * (1.f / 64.f) + 64e-5f);
        float o[8];
#pragma unroll
        for (int j = 0; j < 8; ++j) o[j] = ((y[j] - mean) * rstd * lw[j] + lb[j] + bs * v[j]) * g[j];
        *(uint4*)(AO + m * DM + 512 + c) = pack8(o);
    }
}
DEV void phase_final(PPtr p) {
    const int lane = tidx() & 63, gw = blockIdx.x * NWAVE + (tidx() >> 6), ngw = gridDim.x * NWAVE;
    const float* gain = p->in[29];
    for (int m = gw; m < NB * SEQ; m += ngw) {
        float4* xr = (float4*)(p->out + (size_t)m * DM);
        float4 v[4]; float ss = 0.f;
#pragma unroll
        for (int j = 0; j < 4; ++j) { v[j] = xr[lane + 64 * j]; ss += v[j].x * v[j].x + v[j].y * v[j].y + v[j].z * v[j].z + v[j].w * v[j].w; }
        ss = wave_sum(ss);
        const float rstd = rsqrtf(ss * (1.f / DM) + 1e-6f);
#pragma unroll
        for (int j = 0; j < 4; ++j) {
            const float4 g = *(const float4*)(gain + (lane + 64 * j) * 4);
            float4 o; o.x = v[j].x * rstd * g.x; o.y = v[j].y * rstd * g.y; o.z = v[j].z * rstd * g.z; o.w = v[j].w * rstd * g.w;
            xr[lane + 64 * j] = o;
        }
    }
}

constexpr size_t OFF_BAR = 768 * 1024;
DEV void gbar(PPtr kp_, unsigned& nbar) {
    asm volatile("s_waitcnt vmcnt(0)" ::: "memory");
    __syncthreads();
    if (threadIdx.x == 0) {
        unsigned* ctr = (unsigned*)(kp_->ws + OFF_BAR);
        __builtin_amdgcn_fence(__ATOMIC_RELEASE, "agent");
        asm volatile("s_waitcnt vmcnt(0)" ::: "memory");
        ++nbar;
        __hip_atomic_fetch_add(ctr, 1u, __ATOMIC_RELAXED, __HIP_MEMORY_SCOPE_AGENT);
        const unsigned target = nbar * gridDim.x;
        while (__hip_atomic_load(ctr, __ATOMIC_RELAXED, __HIP_MEMORY_SCOPE_AGENT) < target) __builtin_amdgcn_s_sleep(1);
        __builtin_amdgcn_fence(__ATOMIC_ACQUIRE, "agent");
        asm volatile("s_waitcnt vmcnt(0)" ::: "memory");
    }
    __syncthreads();
}
#define p launder(kp)
#define SYNC() gbar(launder(kp), nbar)
template <int bb>
DEV void do_rwkv_batch(PPtr kp, unsigned& nbar, char* lds, int li) {
    unsigned char* ws = launder(kp)->ws;
    u16* ZD = (u16*)(ws + OFF_ZD);
                phase_rwkv_prep(p, li, bb); SYNC();
                const u16* LA = (const u16*)(ws + OFF_LA); const u16* ZDb = ZD + (size_t)bb * RPB * ZDW;
                { pg8::EpiLoraT e{(float*)(ws + OFF_DEC), (u16*)(ws + OFF_KD), (u16*)(ws + OFF_BQ), (u16*)(ws + OFF_G), (const u16*)(ws + OFF_KK), ZDb,
                                  p->in[17] + (size_t)li * 1024, p->in[19] + (size_t)li * 1024, p->in[23] + li * 512, p->in[16] + li * ZDW + 512};
                  int kl_ = 256; asm volatile("" : "+s"(kl_));
                  pg8::Gemm g_{(const pg8::bf16_t*)LA, (const pg8::bf16_t*)(ws + OFF_PU), RPB, 2560, kl_}; pg8::StaticOrder S_; S_.init(RPB, 2560, (int)gridDim.x, (int)blockIdx.x);
                  pg8::gemm_phase<pg8::EpiLoraT, pg8::StaticOrder, true, true>((PG8_LAS unsigned char*)lds, g_, S_, e); }
                SYNC();
                phase_scan1(p, lds); SYNC();
                phase_scan2a(p, lds); SYNC();
                phase_scan2b(p, lds); SYNC();
                phase_scan3(p, lds); SYNC();
                phase_readout(p, li, bb); SYNC();
            }
template <int layer>
DEV void do_layer(PPtr kp, unsigned& nbar, char* lds) {
    unsigned char* ws = launder(kp)->ws;
    const float* mod = (const float*)(ws + OFF_MOD);
    u16* HN = (u16*)(ws + OFF_HN); u16* AO = (u16*)(ws + OFF_AO); u16* RAW = (u16*)(ws + OFF_RAW); u16* ZD = (u16*)(ws + OFF_ZD);
        const int li = layer >> 1;
        const float* lmod = mod + (size_t)layer * 3 * 6144;
        phase_wprep(p, layer, lds); phase_normmod(p, layer, 0); SYNC();
        const pg8::bf16_t* WB = (const pg8::bf16_t*)(ws + OFF_WB);
#define GEMM8(A_, B_, N_, K_, E_) do { pg8::Gemm g_{(const pg8::bf16_t*)(A_), (B_), MROWS, (N_), (K_)}; pg8::StaticOrder S_; S_.init(MROWS, (N_), (int)gridDim.x, (int)blockIdx.x); \
            pg8::gemm_phase<decltype(E_), pg8::StaticOrder, true, true>((PG8_LAS unsigned char*)lds, g_, S_, E_); } while (0)
#define GEMM8L(A_, B_, N_, K_, E_) do { pg8::Gemm g_{(const pg8::bf16_t*)(A_), (B_), MROWS, (N_), (K_)}; pg8::LatentOrder S_; S_.init((N_), (int)gridDim.x, (int)blockIdx.x); \
            pg8::gemm_phase<decltype(E_), pg8::LatentOrder, true, true>((PG8_LAS unsigned char*)lds, g_, S_, E_); } while (0)
        if (!(layer & 1)) {
            { pg8::EpiStoreT e{RAW, 1536, 1 << 30, RAW, 1536}; GEMM8(HN, WB + WB_IN, 1536, DM, e); } SYNC();
            phase_even_post(p, li); SYNC();
            phase_attn_even(p, li, lds); SYNC();
            { pg8::EpiResidT e{p, lmod + 2048}; GEMM8(AO, WB + WB_OUT, DM, DM, e); } SYNC();
        } else {
            { pg8::EpiStoreT e{RAW, 1536, 1536, ZD, ZDW}; GEMM8(HN, WB + WB_IN, 3328, DM, e); } SYNC();
            phase_attn_odd(p, li, lds); SYNC();
            do_rwkv_batch<0>(kp, nbar, lds, li);
            do_rwkv_batch<1>(kp, nbar, lds, li);
            if (layer == 3) { pg8::EpiResidT e{p, lmod + 2048}; GEMM8L(AO, WB + WB_OUT, DM, DM, e); }
            else { pg8::EpiResidT e{p, lmod + 2048}; GEMM8(AO, WB + WB_OUT, DM, DM, e); }
            SYNC();
        }
        phase_normmod(p, layer, 1); SYNC();
        if (layer == 3) { pg8::EpiSwigluT e{RAW}; GEMM8L(HN, WB + WB_F1, 5632, DM, e); }
        else { pg8::EpiSwigluT e{RAW}; GEMM8(HN, WB + WB_F1, 5632, DM, e); }
        SYNC();
        if (layer == 3) { pg8::EpiResidT e{p, lmod + 5120}; GEMM8L(RAW, WB + WB_F2, DM, FFH, e); }
        else { pg8::EpiResidT e{p, lmod + 5120}; GEMM8(RAW, WB + WB_F2, DM, FFH, e); }
        SYNC();
    }
__global__ void __launch_bounds__(NTHR) mega(Params p_unused) {
    PPtr kp = (PPtr)__builtin_amdgcn_kernarg_segment_ptr();
    extern __shared__ __attribute__((aligned(16))) char lds[];
    cg::grid_group grid = cg::this_grid();
    unsigned nbar = 0;
    grid.sync();
    phase_init(p, lds); SYNC();
    do_layer<0>(kp, nbar, lds);
    do_layer<1>(kp, nbar, lds);
    do_layer<2>(kp, nbar, lds);
    do_layer<3>(kp, nbar, lds);
    phase_final(p);
}
#undef p
#undef SYNC

extern "C" void kernel_launch(void* const* d_in, const int* in_sizes, int n_in, void* d_out, int out_size, void* d_ws, size_t ws_size, hipStream_t stream) {
    static int grid = 0;
    if (grid == 0) {
        if (n_in != 30 || ws_size < WS_NEED || out_size != NB * SEQ * DM) { fprintf(stderr, "kernel_launch: unexpected problem shape (n_in %d ws %zu out %d)\n", n_in, ws_size, out_size); grid = -1; return; }
        int dev = 0, cus = 0, per_cu = 0;
        hipGetDevice(&dev);
        hipDeviceGetAttribute(&cus, hipDeviceAttributeMultiprocessorCount, dev);
        hipFuncSetAttribute((const void*)mega, hipFuncAttributeMaxDynamicSharedMemorySize, LDS_BYTES);
        hipOccupancyMaxActiveBlocksPerMultiprocessor(&per_cu, (const void*)mega, NTHR, LDS_BYTES);
        if (per_cu < 1) per_cu = 1;
        if (per_cu > 1) per_cu = 1;
        grid = cus * per_cu;
    }
    if (grid < 0) return;
    Params p{};
    for (int i = 0; i < 30; ++i) p.in[i] = (const float*)d_in[i];
    p.out = (float*)d_out; p.ws = (unsigned char*)d_ws;
    hipMemsetAsync((char*)d_ws + OFF_BAR, 0, 256, stream);
    void* args[] = {&p};
    hipError_t e = hipLaunchCooperativeKernel((const void*)mega, dim3(grid), dim3(NTHR), args, LDS_BYTES, stream);
    if (e != hipSuccess) fprintf(stderr, "cooperative launch failed: %s (grid %d)\n", hipGetErrorString(e), grid);
}
```

```cpp
#include <hip/hip_runtime.h>
#include <hip/hip_cooperative_groups.h>
#include <cstdio>
#include <cstdint>
namespace cg = cooperative_groups;

#define DEV __device__ __forceinline__
typedef unsigned short u16;
typedef short bf16x8 __attribute__((ext_vector_type(8)));
typedef float f32x4 __attribute__((ext_vector_type(4)));
typedef const __attribute__((address_space(4))) float* cfp;
typedef const __attribute__((address_space(4))) unsigned* cup;

constexpr int DM = 1024, NB = 2, SEQ = 16384, NCTX = 256, RPB = SEQ + NCTX, MROWS = NB * RPB;
constexpr int FFH = 2816, ZDW = 1792;
constexpr float LOG2E = 1.4426950408889634f;
constexpr int NTHR = 512, NWAVE = 8;
constexpr int LDS_BYTES = 132096;

constexpr size_t MiB = 1u << 20;
constexpr size_t OFF_MOD = 0;
constexpr size_t OFF_ROPE = 512 * 1024;
constexpr size_t OFF_XC = 1 * MiB;
constexpr size_t OFF_WB = 3 * MiB;
constexpr size_t OFF_AO = 29 * MiB;
constexpr size_t OFF_HN = 94 * MiB;
constexpr size_t OFF_RAW = 159 * MiB;
constexpr size_t OFF_ZD = 257 * MiB;
constexpr size_t SZ_H = (size_t)RPB * 512 * 2;
constexpr size_t OFF_DEC = 94 * MiB;
constexpr size_t OFF_KD = OFF_DEC + 4 * SZ_H;
constexpr size_t OFF_BQ = OFF_KD + 2 * SZ_H;
constexpr size_t OFF_KK = OFF_BQ + 2 * SZ_H;
constexpr size_t OFF_R = OFF_KK + SZ_H;
constexpr size_t OFF_V = 371 * MiB;
constexpr size_t OFF_G = OFF_V + SZ_H;
constexpr size_t OFF_LA = OFF_G + SZ_H;
constexpr size_t OFF_Y0 = 412 * MiB;
constexpr size_t OFF_PU = OFF_Y0 + 2 * SZ_H;
constexpr size_t WS_NEED = 509 * MiB;
constexpr int NCH = 128, CLEN = 130;
static_assert(OFF_R + SZ_H <= OFF_ZD, "scan map");
static_assert(OFF_LA + SZ_H / 2 <= OFF_Y0, "scan map 2");
static_assert(OFF_PU + 64 * MiB <= WS_NEED, "scan map 3");
static_assert(OFF_RAW + (size_t)MROWS * FFH * 2 <= WS_NEED, "ffn hidden");

struct Params { const float* in[30]; float* out; unsigned char* ws; };
typedef const __attribute__((address_space(4))) Params* PPtr;
DEV int tidx() { int t = threadIdx.x; asm volatile("" : "+v"(t)); return t; }
DEV PPtr launder(PPtr p) { asm volatile("" : "+s"(p)); return p; }

DEV unsigned f2bf(float f) { unsigned u = __float_as_uint(f); return (u + 0x7fffu + ((u >> 16) & 1u)) >> 16; }
DEV float bf2f(u16 h) { return __uint_as_float(((unsigned)h) << 16); }
DEV float bflo(unsigned u) { return __uint_as_float(u << 16); }
DEV float bfhi(unsigned u) { return __uint_as_float(u & 0xffff0000u); }
DEV unsigned pk2(float lo, float hi) { return f2bf(lo) | (f2bf(hi) << 16); }
DEV void unpack8(const uint4 u, float (&f)[8]) {
    f[0] = bflo(u.x); f[1] = bfhi(u.x); f[2] = bflo(u.y); f[3] = bfhi(u.y); f[4] = bflo(u.z); f[5] = bfhi(u.z); f[6] = bflo(u.w); f[7] = bfhi(u.w);
}
DEV uint4 pack8(const float (&f)[8]) { uint4 o; o.x = pk2(f[0], f[1]); o.y = pk2(f[2], f[3]); o.z = pk2(f[4], f[5]); o.w = pk2(f[6], f[7]); return o; }
DEV float wave_sum(float v) {
#pragma unroll
    for (int o = 1; o < 64; o <<= 1) v += __shfl_xor(v, o);
    return v;
}
DEV float* xrow_ptr(PPtr p, int m) {
    int b = m / RPB, q = m - b * RPB;
    return q < SEQ ? p->out + (size_t)(b * SEQ + q) * DM : (float*)(p->ws + OFF_XC) + (size_t)(b * NCTX + (q - SEQ)) * DM;
}
DEV int mod_idx(int m) { int b = m / RPB, q = m - b * RPB; return q < SEQ ? b : 2; }
DEV float sigmoidf_(float x) { return 1.f / (1.f + __expf(-x)); }

DEV void phase_init(PPtr p, char* lds) {
    const int tid = tidx();
    const size_t gt = (size_t)blockIdx.x * NTHR + tid, ng = (size_t)gridDim.x * NTHR;
    {
        const float4* s = (const float4*)p->in[0]; float4* d = (float4*)p->out;
        const size_t n = (size_t)NB * SEQ * DM / 4;
        for (size_t i = gt; i < n; i += ng) d[i] = s[i];
        const float4* s2 = (const float4*)p->in[2]; float4* d2 = (float4*)(p->ws + OFF_XC);
        const size_t n2 = (size_t)NB * NCTX * DM / 4;
        for (size_t i = gt; i < n2; i += ng) d2[i] = s2[i];
    }
    {
        float* T = (float*)(p->ws + OFF_ROPE);
        for (size_t i = gt; i < 5120; i += ng) {
            const int pos = (int)(i >> 4), f = (int)(i & 15);
            const float inv = powf(10000.f, -(float)f / 16.f);
            if (pos < 256) { const float ang = (float)pos * inv; T[pos * 16 + f] = cosf(ang); T[4096 + pos * 16 + f] = sinf(ang); }
            else { const float ang = (float)(pos - 256) * inv; T[8192 + (pos - 256) * 16 + f] = cosf(ang); T[9216 + (pos - 256) * 16 + f] = sinf(ang); }
        }
    }
    float* red = (float*)lds;
    float* mod = (float*)(p->ws + OFF_MOD);
    const float* c = p->in[1]; const float* cc = p->in[3];
    for (int item = blockIdx.x; item < 192; item += gridDim.x) {
        const int l = item / 48, n0 = (item % 48) * 128, col = tid & 127, kp = tid >> 7;
        const float* w = p->in[4] + (size_t)l * DM * 6144 + n0 + col;
        float a0 = 0.f, a1 = 0.f, a2 = 0.f;
        for (int k = kp * 256; k < kp * 256 + 256; ++k) {
            const float wv = w[(size_t)k * 6144];
            const float c0 = c[k], c1 = c[DM + k], c2 = cc[k];
            a0 += c0 * sigmoidf_(c0) * wv; a1 += c1 * sigmoidf_(c1) * wv; a2 += c2 * sigmoidf_(c2) * wv;
        }
        red[(kp * 3 + 0) * 128 + col] = a0; red[(kp * 3 + 1) * 128 + col] = a1; red[(kp * 3 + 2) * 128 + col] = a2;
        __syncthreads();
        if (tid < 384) {
            const int mb = tid >> 7, cl = tid & 127;
            float s = red[(0 * 3 + mb) * 128 + cl] + red[(1 * 3 + mb) * 128 + cl] + red[(2 * 3 + mb) * 128 + cl] + red[(3 * 3 + mb) * 128 + cl];
            mod[(size_t)(l * 3 + mb) * 6144 + n0 + cl] = s + p->in[5][l * 6144 + n0 + cl];
        }
        __syncthreads();
    }
}

DEV void phase_normmod(PPtr p, int layer, int which) {
    const int lane = tidx() & 63, gw = blockIdx.x * NWAVE + (tidx() >> 6), ngw = gridDim.x * NWAVE;
    const float* gain = p->in[which ? 7 : 6] + layer * DM;
    const float* mod = (const float*)(p->ws + OFF_MOD) + (size_t)layer * 3 * 6144;
    u16* HN = (u16*)(p->ws + OFF_HN);
    for (int m = gw; m < MROWS; m += ngw) {
        const float* xr = xrow_ptr(p, m);
        const float* md = mod + mod_idx(m) * 6144 + (which ? 3072 : 0);
        float4 v[4]; float ss = 0.f;
#pragma unroll
        for (int j = 0; j < 4; ++j) { v[j] = ((const float4*)xr)[lane + 64 * j]; ss += v[j].x * v[j].x + v[j].y * v[j].y + v[j].z * v[j].z + v[j].w * v[j].w; }
        ss = wave_sum(ss);
        const float rstd = rsqrtf(ss * (1.f / DM) + 1e-6f);
#pragma unroll
        for (int j = 0; j < 4; ++j) {
            const int k = (lane + 64 * j) * 4;
            const float4 g = *(const float4*)(gain + k), sh = *(const float4*)(md + k), sc = *(const float4*)(md + 1024 + k);
            const float o0 = v[j].x * rstd * g.x * (1.f + sc.x) + sh.x, o1 = v[j].y * rstd * g.y * (1.f + sc.y) + sh.y;
            const float o2 = v[j].z * rstd * g.z * (1.f + sc.z) + sh.z, o3 = v[j].w * rstd * g.w * (1.f + sc.w) + sh.w;
            uint2 w; w.x = pk2(o0, o1); w.y = pk2(o2, o3);
            *(uint2*)(HN + (size_t)m * DM + k) = w;
        }
    }
}

template <int DUAL, class Epi>
DEV void gemm_simple(const u16* A, int lda, const float* W, int ldw, int dualoff, int M, int N, int K, const Epi& epi, char* lds) {
    u16* sA = (u16*)lds; u16* sB = sA + 128 * 40; u16* sB2 = sB + 128 * 40;
    const int tid = tidx(), lane = tid & 63, wave = tid >> 6, wm = wave >> 2, wn = wave & 3, r16 = lane & 15, quad = lane >> 4;
    const int mt = M / 128, nt = N / 128;
    for (int item = blockIdx.x; item < mt * nt; item += gridDim.x) {
        const int tn = item / mt, tm = item - tn * mt, m0 = tm * 128, n0 = tn * 128;
        f32x4 acc[4][2], acc2[4][2];
#pragma unroll
        for (int a = 0; a < 4; ++a)
#pragma unroll
            for (int b = 0; b < 2; ++b) { acc[a][b] = (f32x4){0.f, 0.f, 0.f, 0.f}; acc2[a][b] = (f32x4){0.f, 0.f, 0.f, 0.f}; }
        for (int k0 = 0; k0 < K; k0 += 32) {
            {
                const int row = tid >> 2, kc = (tid & 3) * 8;
                const uint4 v = *(const uint4*)(A + (size_t)(m0 + row) * lda + k0 + kc);
                *(uint4*)(sA + row * 40 + kc) = v;
            }
            {
                const int kk = tid >> 4, nc = (tid & 15) * 8;
                const float* wp = W + (size_t)(k0 + kk) * ldw + n0 + nc;
                const float4 a = *(const float4*)wp, b = *(const float4*)(wp + 4);
                sB[(nc + 0) * 40 + kk] = (u16)f2bf(a.x); sB[(nc + 1) * 40 + kk] = (u16)f2bf(a.y); sB[(nc + 2) * 40 + kk] = (u16)f2bf(a.z); sB[(nc + 3) * 40 + kk] = (u16)f2bf(a.w);
                sB[(nc + 4) * 40 + kk] = (u16)f2bf(b.x); sB[(nc + 5) * 40 + kk] = (u16)f2bf(b.y); sB[(nc + 6) * 40 + kk] = (u16)f2bf(b.z); sB[(nc + 7) * 40 + kk] = (u16)f2bf(b.w);
                if (DUAL) {
                    const float4 c = *(const float4*)(wp + dualoff), d = *(const float4*)(wp + dualoff + 4);
                    sB2[(nc + 0) * 40 + kk] = (u16)f2bf(c.x); sB2[(nc + 1) * 40 + kk] = (u16)f2bf(c.y); sB2[(nc + 2) * 40 + kk] = (u16)f2bf(c.z); sB2[(nc + 3) * 40 + kk] = (u16)f2bf(c.w);
                    sB2[(nc + 4) * 40 + kk] = (u16)f2bf(d.x); sB2[(nc + 5) * 40 + kk] = (u16)f2bf(d.y); sB2[(nc + 6) * 40 + kk] = (u16)f2bf(d.z); sB2[(nc + 7) * 40 + kk] = (u16)f2bf(d.w);
                }
            }
            __syncthreads();
            bf16x8 af[4], bfr[2], bfr2[2];
#pragma unroll
            for (int mi = 0; mi < 4; ++mi) af[mi] = *(const bf16x8*)(sA + (wm * 64 + mi * 16 + r16) * 40 + quad * 8);
#pragma unroll
            for (int ni = 0; ni < 2; ++ni) {
                bfr[ni] = *(const bf16x8*)(sB + (wn * 32 + ni * 16 + r16) * 40 + quad * 8);
                if (DUAL) bfr2[ni] = *(const bf16x8*)(sB2 + (wn * 32 + ni * 16 + r16) * 40 + quad * 8);
            }
#pragma unroll
            for (int mi = 0; mi < 4; ++mi)
#pragma unroll
                for (int ni = 0; ni < 2; ++ni) {
                    acc[mi][ni] = __builtin_amdgcn_mfma_f32_16x16x32_bf16(af[mi], bfr[ni], acc[mi][ni], 0, 0, 0);
                    if (DUAL) acc2[mi][ni] = __builtin_amdgcn_mfma_f32_16x16x32_bf16(af[mi], bfr2[ni], acc2[mi][ni], 0, 0, 0);
                }
            __syncthreads();
        }
#pragma unroll
        for (int mi = 0; mi < 4; ++mi)
#pragma unroll
            for (int ni = 0; ni < 2; ++ni)
#pragma unroll
                for (int j = 0; j < 4; ++j) {
                    const int row = m0 + wm * 64 + mi * 16 + quad * 4 + j, col = n0 + wn * 32 + ni * 16 + r16;
                    epi(row, col, acc[mi][ni][j], DUAL ? acc2[mi][ni][j] : 0.f);
                }
    }
}

struct EpiStore { u16* O; int ld; DEV void operator()(int r, int c, float v, float) const { O[(size_t)r * ld + c] = (u16)f2bf(v); } };
struct EpiStoreOdd { u16* Q; u16* Z;
    DEV void operator()(int r, int c, float v, float) const { if (c < 1536) Q[(size_t)r * 1536 + c] = (u16)f2bf(v); else Z[(size_t)r * ZDW + (c - 1536)] = (u16)f2bf(v); } };
struct EpiResid { PPtr p; const float* gate;
    DEV void operator()(int r, int c, float v, float) const { float* xr = xrow_ptr(p, r); xr[c] += gate[mod_idx(r) * 6144 + c] * v; } };
struct EpiSwiglu { u16* H;
    DEV void operator()(int r, int c, float g, float u) const { H[(size_t)r * FFH + c] = (u16)f2bf(g * sigmoidf_(g) * u); } };


namespace pg8 {
#define PG8_LAS __attribute__((address_space(3)))
typedef unsigned short bf16_t;
typedef short bf16x8 __attribute__((ext_vector_type(8)));
typedef float f32x4 __attribute__((ext_vector_type(4)));
typedef unsigned u32x4 __attribute__((ext_vector_type(4)));
constexpr int BM = 256, BK = 64, HALF = 128, HTB = HALF * BK * 2  , STAGE_BYTES = 8 * HTB, NXCD = 8, WGM = 8;

__host__ __device__ __forceinline__ int lds_byte(int r, int c) { const int st = (r >> 4) * 2 + (c >> 5), rr = r & 15, cc = c & 31, ob = rr * 64 + cc * 2; return st * 1024 + (ob ^ (((ob >> 9) & 1) << 5)); }
__host__ __device__ __forceinline__ void stage_rc(int b, int& R, int& C) { const int st = b / 1024, sb = b % 1024, swz = sb ^ (((sb >> 9) & 1) << 5); R = (st >> 1) * 16 + swz / 64; C = (st & 1) * 32 + (swz % 64) / 2; }
__host__ __device__ __forceinline__ int perm32(int rho) { const int n = rho >> 4, i = rho & 15; return 8 * (i >> 2) + 4 * n + (i & 3); }

struct Unit { int pm, pn; };
struct Gemm { const bf16_t* A; const bf16_t* Bt; int M, N, K; };

struct StaticOrder {
    int nM, nN, nwg, G, c;
    __host__ __device__ void init(int M, int N, int G_, int c_) { nM = M / BM; nN = N / BM; nwg = nM * nN; G = G_; c = c_; }
    __host__ __device__ bool next(int i, Unit& u) const {
        const long L = (long)i * G + c; if (L >= nwg) return false;
        int wgid = (int)L; { const int q = nwg / NXCD, r = nwg % NXCD, xcd = wgid % NXCD, off = wgid / NXCD; wgid = (xcd < r ? xcd * (q + 1) : r * (q + 1) + (xcd - r) * q) + off; }
        const int nig = WGM * nN, gid = wgid / nig, fm = gid * WGM, gsz = (nM - fm) < WGM ? (nM - fm) : WGM;
        u.pm = fm + ((wgid % nig) % gsz); u.pn = (wgid % nig) / gsz; return true;
    }
    __device__ __forceinline__ void a_ready(const Unit&) const {}
    __device__ __forceinline__ void done(const Unit&) const {}
};
struct LatentOrder {
    StaticOrder S;
    __host__ __device__ void init(int N, int G_, int c_) { S.init(32768, N, G_, c_); }
    __host__ __device__ bool next(int i, Unit& u) const { if (!S.next(i, u)) return false; u.pm = u.pm < 64 ? u.pm : u.pm + 1; return true; }
    __device__ __forceinline__ void a_ready(const Unit&) const {}
    __device__ __forceinline__ void done(const Unit&) const {}
};

__device__ __forceinline__ unsigned cvt_pk_bf16(float lo, float hi) { unsigned r; asm volatile("v_cvt_pk_bf16_f32 %0, %1, %2" : "=v"(r) : "v"(lo), "v"(hi)); return r; }
template <class Epi, class Sched, bool ALIGN_EPI = false, bool SP2 = false>
__device__ __forceinline__ void gemm_phase(PG8_LAS unsigned char* lds, const Gemm g, const Sched& S, const Epi& E) {
    const int tid = tidx(), wid = __builtin_amdgcn_readfirstlane(tid >> 6), lane = tid & 63, wr = wid >> 2, wc = wid & 3, fr = lane & 15, fq = lane >> 4;
    const int K = g.K, nt = K / BK;
    unsigned voffA[2], voffB[2];
#pragma unroll
    for (int i = 0; i < 2; ++i) { int R, C; stage_rc(tid * 16 + i * 8192, R, C); const int Rb = Epi::PERM ? ((R & ~31) + perm32(R & 31)) : R;
        voffA[i] = (unsigned)(R * K + C) * 2u; voffB[i] = (unsigned)(Rb * K + C) * 2u; }
    const size_t kstep = (size_t)(BK * 2);
    const size_t hstep = (size_t)HALF * K * 2;
    const size_t tstep = 2 * hstep;
    const unsigned ldsw = (unsigned)wid * 1024u;
    const int aoff = lds_byte(wr * 64 + fr, fq * 8), boff = lds_byte(wc * 32 + fr, fq * 8);
#define PG8_SA(b, h) (((b) * 2 + (h)) * HTB)
#define PG8_SB(b, h) ((4 + (b) * 2 + (h)) * HTB)
#define PG8_STAGE(bufoff, gbase, voff) do { _Pragma("unroll") for (int _i = 0; _i < 2; ++_i) \
        __builtin_amdgcn_global_load_lds((const unsigned*)((const char*)(gbase) + (voff)[_i]), (PG8_LAS unsigned*)(lds + (bufoff) + ldsw + _i * 8192), 16, 0, 0); } while (0)
#define PG8_LDA(dst, b, h) do { _Pragma("unroll") for (int m = 0; m < 4; ++m) _Pragma("unroll") for (int k = 0; k < 2; ++k) dst[m][k] = *(const PG8_LAS bf16x8*)(lds + PG8_SA(b, h) + aoff + m * 2048 + k * 1024); } while (0)
#define PG8_LDB(dst, b, h) do { _Pragma("unroll") for (int n = 0; n < 2; ++n) _Pragma("unroll") for (int k = 0; k < 2; ++k) dst[n][k] = *(const PG8_LAS bf16x8*)(lds + PG8_SB(b, h) + boff + n * 2048 + k * 1024); } while (0)
#define PG8_MMA(ai, bj, At, Bt) do { __builtin_amdgcn_s_setprio(1); _Pragma("unroll") for (int m = 0; m < 4; ++m) _Pragma("unroll") for (int n = 0; n < 2; ++n) _Pragma("unroll") for (int k = 0; k < 2; ++k) \
        acc[ai][bj][m][n] = __builtin_amdgcn_mfma_f32_16x16x32_bf16(Bt[n][k], At[m][k], acc[ai][bj][m][n], 0, 0, 0); __builtin_amdgcn_s_setprio(0); } while (0)
#define PG8_WAIT_V(n) asm volatile("s_waitcnt vmcnt(" #n ")" ::: "memory")
#define PG8_WAIT_L(n) asm volatile("s_waitcnt lgkmcnt(" #n ")" ::: "memory")
#define PG8_BAR __builtin_amdgcn_s_barrier()
#define PG8_SCHED __builtin_amdgcn_sched_barrier(0)
    Unit cur, nxt; int ui = 0;
    if (!S.next(0, cur)) return;
    f32x4 acc[2][2][4][2];
#pragma unroll
    for (int a = 0; a < 2; ++a)
#pragma unroll
        for (int b = 0; b < 2; ++b)
#pragma unroll
            for (int m = 0; m < 4; ++m)
#pragma unroll
                for (int n = 0; n < 2; ++n) acc[a][b][m][n] = (f32x4){0.f, 0.f, 0.f, 0.f};
    bf16x8 At[4][2], B0[2][2], B1[2][2];
    const char* cA = (const char*)g.A + (size_t)cur.pm * tstep; const char* cB = (const char*)g.Bt + (size_t)cur.pn * tstep;
    S.a_ready(cur);
    if constexpr (SP2) {
        PG8_STAGE(PG8_SB(0, 0), cB, voffB); PG8_STAGE(PG8_SB(0, 1), cB + hstep, voffB); PG8_STAGE(PG8_SA(0, 0), cA, voffA); PG8_STAGE(PG8_SA(0, 1), cA + hstep, voffA);
        if (wr == 1) PG8_BAR;
        PG8_WAIT_V(2); PG8_BAR;
        PG8_STAGE(PG8_SB(1, 0), cB + kstep, voffB); PG8_STAGE(PG8_SA(1, 0), cA + kstep, voffA); PG8_STAGE(PG8_SB(1, 1), cB + hstep + kstep, voffB);
        PG8_WAIT_V(6); PG8_BAR;
    } else {
        PG8_STAGE(PG8_SB(0, 0), cB, voffB); PG8_STAGE(PG8_SA(0, 0), cA, voffA); PG8_STAGE(PG8_SB(0, 1), cB + hstep, voffB); PG8_STAGE(PG8_SA(0, 1), cA + hstep, voffA);
        if (wr == 1) PG8_BAR;
        PG8_WAIT_V(4); PG8_BAR;
        PG8_STAGE(PG8_SB(1, 0), cB + kstep, voffB); PG8_STAGE(PG8_SA(1, 0), cA + kstep, voffA); PG8_STAGE(PG8_SB(1, 1), cB + hstep + kstep, voffB);
        PG8_WAIT_V(6); PG8_BAR;
    }
    for (;;) {
        const bool has_next = S.next(ui + 1, nxt);
        const char* nA = has_next ? (const char*)g.A + (size_t)nxt.pm * tstep : cA; const char* nB = has_next ? (const char*)g.Bt + (size_t)nxt.pn * tstep : cB;
        for (int t = 0; t < nt; t += 2) {
            const bool last = (t == nt - 2);
            const char* a1 = cA + (size_t)(t + 1) * kstep;
            const char* a2 = last ? nA : cA + (size_t)(t + 2) * kstep; const char* b2 = last ? nB : cB + (size_t)(t + 2) * kstep;
            const char* a3 = a2 + kstep; const char* b3 = b2 + kstep;
            if (last && has_next) S.a_ready(nxt);
            if constexpr (SP2) {
            PG8_LDB(B0, 0, 0); PG8_LDB(B1, 0, 1); PG8_SCHED; PG8_LDA(At, 0, 0); PG8_STAGE(PG8_SA(1, 1), a1 + hstep, voffA);
            PG8_WAIT_V(8); PG8_WAIT_L(0); PG8_BAR; PG8_MMA(0, 0, At, B0); PG8_MMA(0, 1, At, B1); PG8_BAR; PG8_SCHED;
            PG8_LDA(At, 0, 1); PG8_STAGE(PG8_SB(0, 0), b2, voffB); PG8_STAGE(PG8_SB(0, 1), b2 + hstep, voffB); PG8_STAGE(PG8_SA(0, 0), a2, voffA);
            PG8_WAIT_V(8); PG8_WAIT_L(0); PG8_BAR; PG8_MMA(1, 0, At, B0); PG8_MMA(1, 1, At, B1); PG8_BAR; PG8_SCHED;
            PG8_LDB(B0, 1, 0); PG8_LDB(B1, 1, 1); PG8_SCHED; PG8_LDA(At, 1, 0); PG8_STAGE(PG8_SA(0, 1), a2 + hstep, voffA);
            PG8_WAIT_V(8); PG8_WAIT_L(0); PG8_BAR; PG8_MMA(0, 0, At, B0); PG8_MMA(0, 1, At, B1); PG8_BAR; PG8_SCHED;
            PG8_LDA(At, 1, 1); PG8_STAGE(PG8_SB(1, 0), b3, voffB); PG8_STAGE(PG8_SB(1, 1), b3 + hstep, voffB); PG8_STAGE(PG8_SA(1, 0), a3, voffA);
            PG8_WAIT_V(8); PG8_WAIT_L(0); PG8_BAR; PG8_MMA(1, 0, At, B0); PG8_MMA(1, 1, At, B1); PG8_BAR; PG8_SCHED;
            } else {
            PG8_LDB(B0, 0, 0); PG8_SCHED; PG8_LDA(At, 0, 0); PG8_STAGE(PG8_SA(1, 1), a1 + hstep, voffA);
            PG8_WAIT_L(8); PG8_BAR; PG8_WAIT_L(0); PG8_MMA(0, 0, At, B0); PG8_BAR; PG8_SCHED;
            PG8_LDB(B1, 0, 1); PG8_STAGE(PG8_SB(0, 0), b2, voffB);
            PG8_BAR; PG8_WAIT_L(0); PG8_MMA(0, 1, At, B1); PG8_BAR;
            PG8_LDA(At, 0, 1); PG8_STAGE(PG8_SA(0, 0), a2, voffA);
            PG8_BAR; PG8_WAIT_L(0); PG8_MMA(1, 0, At, B0); PG8_BAR; PG8_SCHED;
            PG8_STAGE(PG8_SB(0, 1), b2 + hstep, voffB);
            PG8_WAIT_V(6); PG8_BAR; PG8_MMA(1, 1, At, B1); PG8_BAR;
            PG8_LDB(B0, 1, 0); PG8_SCHED; PG8_LDA(At, 1, 0); PG8_STAGE(PG8_SA(0, 1), a2 + hstep, voffA);
            PG8_WAIT_L(8); PG8_BAR; PG8_WAIT_L(0); PG8_MMA(0, 0, At, B0); PG8_BAR; PG8_SCHED;
            PG8_LDB(B1, 1, 1); PG8_STAGE(PG8_SB(1, 0), b3, voffB);
            PG8_BAR; PG8_WAIT_L(0); PG8_MMA(0, 1, At, B1); PG8_BAR;
            PG8_LDA(At, 1, 1); PG8_STAGE(PG8_SA(1, 0), a3, voffA);
            PG8_BAR; PG8_WAIT_L(0); PG8_MMA(1, 0, At, B0); PG8_BAR; PG8_SCHED;
            PG8_STAGE(PG8_SB(1, 1), b3 + hstep, voffB);
            PG8_WAIT_V(6); PG8_BAR; PG8_MMA(1, 1, At, B1); PG8_BAR;
            }
        }
        if constexpr (ALIGN_EPI) { if (wr == 0) PG8_BAR; }
        if constexpr (!Epi::AFTER_DRAIN) { E(acc, cur, wr, wc, fr, fq); S.done(cur); }
        if (!has_next) break;
#pragma unroll
        for (int a = 0; a < 2; ++a)
#pragma unroll
            for (int b = 0; b < 2; ++b)
#pragma unroll
                for (int m = 0; m < 4; ++m)
#pragma unroll
                    for (int n = 0; n < 2; ++n) acc[a][b][m][n] = (f32x4){0.f, 0.f, 0.f, 0.f};
        cur = nxt; cA = nA; cB = nB; ++ui;
        if constexpr (ALIGN_EPI) { if (wr == 1) PG8_BAR; }
    }
    PG8_WAIT_V(0);
    if constexpr (!ALIGN_EPI) { if (wr == 0) PG8_BAR; }
    PG8_BAR;
    if constexpr (Epi::AFTER_DRAIN) { E.fused(acc, cur, wr, wc, fr, fq, lds, wid, lane); S.done(cur); }
#undef PG8_SA
#undef PG8_SB
#undef PG8_STAGE
#undef PG8_LDA
#undef PG8_LDB
#undef PG8_MMA
#undef PG8_WAIT_V
#undef PG8_WAIT_L
#undef PG8_BAR
#undef PG8_SCHED
}

struct EpiStoreT {
    static constexpr bool PERM = true, AFTER_DRAIN = false;
    bf16_t* O0; int ld0; int split; bf16_t* O1; int ld1;
    __device__ __forceinline__ void operator()(const f32x4 (&acc)[2][2][4][2], const Unit& u, int wr, int wc, int fr, int fq) const {
        const int row0 = u.pm * BM + wr * 64 + fr; int colt = u.pn * BM; bf16_t* base = O0; int ld = ld0;
        if (colt >= split) { base = O1; ld = ld1; colt -= split; }
        const int col0 = colt + wc * 32 + 8 * fq;
#pragma unroll
        for (int ai = 0; ai < 2; ++ai)
#pragma unroll
            for (int m = 0; m < 4; ++m) { bf16_t* rowp = base + (size_t)(row0 + ai * HALF + m * 16) * ld + col0;
#pragma unroll
                for (int bj = 0; bj < 2; ++bj) { const f32x4 v0 = acc[ai][bj][m][0], v1 = acc[ai][bj][m][1];
                    u32x4 w; w.x = cvt_pk_bf16(v0[0], v0[1]); w.y = cvt_pk_bf16(v0[2], v0[3]); w.z = cvt_pk_bf16(v1[0], v1[1]); w.w = cvt_pk_bf16(v1[2], v1[3]);
                    *(u32x4*)(rowp + bj * HALF) = w; } }
    }
};
struct EpiResidT {
    static constexpr bool PERM = true, AFTER_DRAIN = false;
    PPtr p; const float* gate;
    __device__ __forceinline__ void operator()(const f32x4 (&acc)[2][2][4][2], const Unit& u, int wr, int wc, int fr, int fq) const {
        float* xb = xrow_ptr(p, u.pm * BM); const float* g = gate + mod_idx(u.pm * BM) * 6144;
        const int col0 = u.pn * BM + wc * 32 + 8 * fq;
#pragma unroll
        for (int ai = 0; ai < 2; ++ai)
#pragma unroll
            for (int m = 0; m < 4; ++m) { float* xr = xb + (size_t)(ai * HALF + wr * 64 + m * 16 + fr) * DM;
#pragma unroll
                for (int bj = 0; bj < 2; ++bj) { const int col = col0 + bj * HALF; const f32x4 v0 = acc[ai][bj][m][0], v1 = acc[ai][bj][m][1];
                    const f32x4 g0 = *(const f32x4*)(g + col), g1 = *(const f32x4*)(g + col + 4);
                    f32x4 x0 = *(const f32x4*)(xr + col), x1 = *(const f32x4*)(xr + col + 4);
                    x0 += g0 * v0; x1 += g1 * v1;
                    *(f32x4*)(xr + col) = x0; *(f32x4*)(xr + col + 4) = x1; } }
    }
};
struct EpiSwigluT {
    static constexpr bool PERM = true, AFTER_DRAIN = false;
    bf16_t* H;
    __device__ __forceinline__ void operator()(const f32x4 (&acc)[2][2][4][2], const Unit& u, int wr, int wc, int fr, int fq) const {
        const int row0 = u.pm * BM + wr * 64 + fr; const int col0 = u.pn * BM + wc * 32 + 8 * fq;
#pragma unroll
        for (int ai = 0; ai < 2; ++ai)
#pragma unroll
            for (int m = 0; m < 4; ++m) { bf16_t* rowp = H + (size_t)(row0 + ai * HALF + m * 16) * FFH;
#pragma unroll
                for (int bj = 0; bj < 2; ++bj) { const f32x4 gt = acc[ai][bj][m][0], up = acc[ai][bj][m][1];
                    float h[4];
#pragma unroll
                    for (int j = 0; j < 4; ++j) h[j] = gt[j] * sigmoidf_(gt[j]) * up[j];
                    uint2 w; w.x = cvt_pk_bf16(h[0], h[1]); w.y = cvt_pk_bf16(h[2], h[3]);
                    *(uint2*)(rowp + ((col0 + bj * HALF) >> 1)) = w; } }
    }
};

struct EpiLoraT {
    static constexpr bool PERM = true, AFTER_DRAIN = false;
    float* DEC; bf16_t* KD; bf16_t* BQ; bf16_t* G; const bf16_t* KK; const bf16_t* ZDb;
    const float* w0; const float* a0; const float* ka; const float* muk;
    template <int TYPE>
    __device__ __forceinline__ void one(const f32x4 v, int r, int c, int d) const {
        if (TYPE == 0) {
            const float4 wa = *(const float4*)(w0 + d * 512 + c);
            const float ww[4] = {wa.x, wa.y, wa.z, wa.w};
            float o[4];
#pragma unroll
            for (int e = 0; e < 4; ++e) { const float x = -(ww[e] + v[e]); const float sp = x > 20.f ? x : __logf(1.f + __expf(x)); o[e] = __expf(-__expf(-sp - 0.5f)); }
            *(float4*)(DEC + ((size_t)r * 2 + d) * 512 + c) = (float4){o[0], o[1], o[2], o[3]};
        } else if (TYPE == 1) {
            const float4 aa = *(const float4*)(a0 + d * 512 + c), ka0 = *(const float4*)(ka + c), m0 = *(const float4*)(muk + c);
            const float a0v[4] = {aa.x, aa.y, aa.z, aa.w}, kav[4] = {ka0.x, ka0.y, ka0.z, ka0.w}, mm[4] = {m0.x, m0.y, m0.z, m0.w};
            const bool lat = r < SEQ; const int lo = lat ? 0 : SEQ, hi = lat ? SEQ : RPB;
            const bf16_t* zc = ZDb + (size_t)r * ZDW + 512 + c;
            const bool hp = r - 1 >= lo, hn = r + 1 < hi;
            const uint2 uz = *(const uint2*)zc, up = *(const uint2*)(hp ? zc - ZDW : zc), un = *(const uint2*)(hn ? zc + ZDW : zc), uk = *(const uint2*)(KK + (size_t)r * 512 + c);
            const float z[4] = {bflo(uz.x), bfhi(uz.x), bflo(uz.y), bfhi(uz.y)}, zp[4] = {bflo(up.x), bfhi(up.x), bflo(up.y), bfhi(up.y)};
            const float zn[4] = {bflo(un.x), bfhi(un.x), bflo(un.y), bfhi(un.y)}, kk[4] = {bflo(uk.x), bfhi(uk.x), bflo(uk.y), bfhi(uk.y)};
            const float fp = hp ? 0.5f : 0.f, fn = hn ? 0.5f : 0.f;
            float okd[4], obq[4];
#pragma unroll
            for (int e = 0; e < 4; ++e) {
                const float a = sigmoidf_(a0v[e] + v[e]);
                const float k = z[e] + ((fp * zp[e] + fn * zn[e]) - z[e]) * mm[e];
                okd[e] = k * (1.f + (a - 1.f) * kav[e]); obq[e] = kk[e] * a;
            }
            uint2 w1; w1.x = pk2(okd[0], okd[1]); w1.y = pk2(okd[2], okd[3]); *(uint2*)(KD + ((size_t)r * 2 + d) * 512 + c) = w1;
            uint2 w2; w2.x = pk2(obq[0], obq[1]); w2.y = pk2(obq[2], obq[3]); *(uint2*)(BQ + ((size_t)r * 2 + d) * 512 + c) = w2;
        } else {
            uint2 w; w.x = pk2(v[0], v[1]); w.y = pk2(v[2], v[3]); *(uint2*)(G + (size_t)r * 512 + c) = w;
        }
    }
    template <int TYPE>
    __device__ __forceinline__ void all(const f32x4 (&acc)[2][2][4][2], const Unit& u, int wr, int wc, int fr, int fq) const {
        const int d = (u.pn >> 1) & 1, cb = (u.pn & 1) * 256 + wc * 32 + 8 * fq;
#pragma unroll
        for (int ai = 0; ai < 2; ++ai)
#pragma unroll
            for (int m = 0; m < 4; ++m)
#pragma unroll
                for (int bj = 0; bj < 2; ++bj)
                {   const int r = u.pm * BM + ai * HALF + wr * 64 + m * 16 + fr, c = cb + bj * HALF;
                    one<TYPE>(acc[ai][bj][m][0], r, c, d); one<TYPE>(acc[ai][bj][m][1], r, c + 4, d); }
    }
    __device__ __forceinline__ void operator()(const f32x4 (&acc)[2][2][4][2], const Unit& u, int wr, int wc, int fr, int fq) const {
        const int type = u.pn >> 1;
        if (type < 2) all<0>(acc, u, wr, wc, fr, fq); else if (type < 4) all<1>(acc, u, wr, wc, fr, fq); else all<2>(acc, u, wr, wc, fr, fq);
    }
};
}

DEV void transpose_item(const float* W, int K, int N, u16* WT, int mode, float* scr, int item, int lane) {
    const int nblk = N / 32, kb = item / nblk, nb = item - kb * nblk, k0 = 64 * kb, n0 = 32 * nb;
#pragma unroll 8
    for (int i = 0; i < 32; ++i) { const int kk = 2 * i + (lane >> 5); scr[kk * 33 + (lane & 31)] = W[(size_t)(k0 + kk) * N + n0 + (lane & 31)]; }
    asm volatile("s_waitcnt lgkmcnt(0)" ::: "memory");
    const int c = lane & 7;
#pragma unroll
    for (int j = 0; j < 4; ++j) {
        const int n = (lane >> 3) + 8 * j; const float* sp = scr + (8 * c) * 33 + n;
        uint4 o; o.x = pk2(sp[0 * 33], sp[1 * 33]); o.y = pk2(sp[2 * 33], sp[3 * 33]); o.z = pk2(sp[4 * 33], sp[5 * 33]); o.w = pk2(sp[6 * 33], sp[7 * 33]);
        const int ns = n0 + n;
        int drow = ns;
        if (mode) { const int nn = ns >= FFH ? 1 : 0; const int g = ns - nn * FFH; drow = 8 * (g >> 2) + 4 * nn + (g & 3); }
        *(uint4*)(WT + (size_t)drow * K + k0 + 8 * c) = o;
    }
    asm volatile("s_waitcnt lgkmcnt(0)" ::: "memory");
}
constexpr size_t WB_IN = 0, WB_OUT = (size_t)3328 * 1024, WB_F1 = WB_OUT + (size_t)1024 * 1024, WB_F2 = WB_F1 + (size_t)5632 * 1024;
DEV void phase_wprep(PPtr p, int layer, char* lds) {
    const int tid = tidx(), lane = tid & 63, wave = tid >> 6, gw = blockIdx.x * NWAVE + wave, ngw = gridDim.x * NWAVE;
    float* scr = (float*)lds + wave * (64 * 33);
    u16* WB = (u16*)(p->ws + OFF_WB);
    const int li = layer >> 1, odd = layer & 1;
    const int nin = odd ? 3328 : 1536;
    const float* win = odd ? p->in[13] + (size_t)li * DM * 3328 : p->in[8] + (size_t)li * DM * 1536;
    const float* wout = (odd ? p->in[14] : p->in[9]) + (size_t)li * DM * DM;
    const float* wf1 = p->in[27] + (size_t)layer * DM * 5632; const float* wf2 = p->in[28] + (size_t)layer * FFH * DM;
    const int i0 = 16 * (nin / 32), i1 = i0 + 16 * 32, i2 = i1 + 16 * 176, i3 = i2 + 44 * 32;
    for (int it = gw; it < i3; it += ngw) {
        if (it < i0) transpose_item(win, DM, nin, WB + WB_IN, 0, scr, it, lane);
        else if (it < i1) transpose_item(wout, DM, DM, WB + WB_OUT, 0, scr, it - i0, lane);
        else if (it < i2) transpose_item(wf1, DM, 5632, WB + WB_F1, 1, scr, it - i1, lane);
        else transpose_item(wf2, FFH, DM, WB + WB_F2, 0, scr, it - i2, lane);
    }
}

#include <hip/hip_bf16.h>
#include <cmath>
namespace attn_body {
using bf16=__hip_bfloat16;
using bf16x8=__attribute__((ext_vector_type(8)))short;
using s16x4=__attribute__((ext_vector_type(4)))short;
using f32x16=__attribute__((ext_vector_type(16)))float;
using u32x4=__attribute__((ext_vector_type(4)))unsigned;
constexpr int D=64,PQ=1536,PO=1024,KROWS=16640,RPBA=16640;
constexpr int NW=8,QBLK=32,QB=QBLK*NW,KVBLK=64;
constexpr int ATTN_UNIT_ROWS=QB;
__device__ __forceinline__ int crow(int r,int hi){return (r&3)+8*(r>>2)+4*hi;}
#define SBAR() __builtin_amdgcn_sched_barrier(0)
__device__ __forceinline__ void cmask(f32x16&p0,f32x16&p1,int jb,int qrel,int hi){
  const float NEG=-INFINITY; int kb=64*jb+4*hi;
  #pragma unroll
  for(int r=0;r<16;++r){int kv=kb+(r&3)+8*(r>>2); if(kv>qrel)p0[r]=NEG; if(kv+32>qrel)p1[r]=NEG;}
}

constexpr int NSLOT=3, SLOTB=8192;
constexpr int LDS_K=0, LDS_V=NSLOT*SLOTB, LDS_WS=2*NSLOT*SLOTB, LDS_OST=LDS_WS+NW*64*4, LDS_BYTES=LDS_OST+NW*4096;
constexpr float C2=0.125f*1.4426950408889634f;
__device__ __forceinline__ void glds16(const void*gsrc,unsigned lds_dst){unsigned keep;
  asm volatile("s_mov_b32 %0, m0\n\ts_mov_b32 m0, %2\n\ts_nop 0\n\tglobal_load_lds_dwordx4 %1, off\n\ts_mov_b32 m0, %0":"=&s"(keep):"v"(gsrc),"s"(lds_dst):"memory");}
__device__ __forceinline__ float max3f(float a,float b,float c){float r;asm("v_max3_f32 %0, %1, %2, %3":"=v"(r):"v"(a),"v"(b),"v"(c));return r;}
__device__ __forceinline__ float max2f(float a,float b){float r;asm("v_max_f32_e32 %0, %1, %2":"=v"(r):"v"(a),"v"(b));return r;}
__device__ __forceinline__ float fadd_s(float a,float b){float r;asm("v_add_f32_e32 %0, %1, %2":"=v"(r):"v"(a),"v"(b));return r;}
__device__ __forceinline__ float fsub_s(float a,float b){float r;asm("v_sub_f32_e32 %0, %1, %2":"=v"(r):"v"(a),"v"(b));return r;}
typedef float f32x2_t __attribute__((ext_vector_type(2))); typedef __bf16 bf16x2_t __attribute__((ext_vector_type(2)));
__device__ __forceinline__ unsigned cvtpk_s(float lo,float hi){f32x2_t v={lo,hi};bf16x2_t b=__builtin_convertvector(v,bf16x2_t);return __builtin_bit_cast(unsigned,b);}
#define WAIT_BAR(N) asm volatile("s_waitcnt vmcnt(" #N ") lgkmcnt(0)\n\ts_barrier":::"memory")

__device__ __forceinline__ void qkt(f32x16&p0,f32x16&p1,const char*Kslot,const bf16x8*qr,const f32x16&negm,int r32,int hi){
  const char*kb=Kslot+hi*1024+r32*16;
  #pragma unroll
  for(int d0=0;d0<4;++d0){
    const bf16x8 b0=*reinterpret_cast<const bf16x8*>(kb+d0*2048);
    const bf16x8 b1=*reinterpret_cast<const bf16x8*>(kb+d0*2048+512);
    if(d0==0){p0=__builtin_amdgcn_mfma_f32_32x32x16_bf16(b0,qr[0],negm,0,0,0);p1=__builtin_amdgcn_mfma_f32_32x32x16_bf16(b1,qr[0],negm,0,0,0);}
    else{p0=__builtin_amdgcn_mfma_f32_32x32x16_bf16(b0,qr[d0],p0,0,0,0);p1=__builtin_amdgcn_mfma_f32_32x32x16_bf16(b1,qr[d0],p1,0,0,0);}}
}
typedef __attribute__((address_space(3))) const char* lds_cptr;
typedef short v4i16_t __attribute__((ext_vector_type(4)));
__device__ __forceinline__ void kload8(bf16x8*kf,lds_cptr kp){
  kf[0]=*(const __attribute__((address_space(3))) bf16x8*)(kp);      kf[1]=*(const __attribute__((address_space(3))) bf16x8*)(kp+512);
  kf[2]=*(const __attribute__((address_space(3))) bf16x8*)(kp+2048); kf[3]=*(const __attribute__((address_space(3))) bf16x8*)(kp+2560);
  kf[4]=*(const __attribute__((address_space(3))) bf16x8*)(kp+4096); kf[5]=*(const __attribute__((address_space(3))) bf16x8*)(kp+4608);
  kf[6]=*(const __attribute__((address_space(3))) bf16x8*)(kp+6144); kf[7]=*(const __attribute__((address_space(3))) bf16x8*)(kp+6656);
}
__device__ __forceinline__ void kload2(bf16x8*kf,lds_cptr kp,int j){ kf[2*j]=*(const __attribute__((address_space(3))) bf16x8*)(kp+j*2048); kf[2*j+1]=*(const __attribute__((address_space(3))) bf16x8*)(kp+j*2048+512); }
__device__ __forceinline__ s16x4 vtr(lds_cptr p){ return __builtin_bit_cast(s16x4,__builtin_amdgcn_ds_read_tr16_b64_v4i16((__attribute__((address_space(3))) v4i16_t*)p)); }
__device__ __forceinline__ float rowmax(const f32x16&p0,const f32x16&p1){
  float a=max3f(p0[0],p0[1],p1[0]),b=max3f(p0[2],p0[3],p1[1]);a=max3f(a,p1[2],p1[3]);
  #pragma unroll
  for(int r=4;r<16;r+=4){a=max3f(a,p0[r],p0[r+1]);b=max3f(b,p0[r+2],p0[r+3]);a=max3f(a,p1[r],p1[r+1]);b=max3f(b,p1[r+2],p1[r+3]);}
  const float m=max2f(a,b);
  auto rr=__builtin_amdgcn_permlane32_swap(__float_as_uint(m),__float_as_uint(m),false,false);
  return max2f(__uint_as_float(rr[0]),__uint_as_float(rr[1]));
}
__device__ __forceinline__ void pv(f32x16*o,int vb,bf16x8 pa0,bf16x8 pa1,bf16x8 pa2,bf16x8 pa3){
  #pragma unroll
  for(int d0=0;d0<2;++d0){s16x4 lo[4],hi[4];
    #pragma unroll
    for(int ks=0;ks<4;++ks){
      asm volatile("ds_read_b64_tr_b16 %0,%1 offset:%c2":"=&v"(lo[ks]):"v"(vb),"i"(d0*4096+ks*1024):"memory");
      asm volatile("ds_read_b64_tr_b16 %0,%1 offset:%c2":"=&v"(hi[ks]):"v"(vb),"i"(d0*4096+ks*1024+512):"memory");}
    asm volatile("s_waitcnt lgkmcnt(0)":::"memory");SBAR();
    #define PK(k) (bf16x8){lo[k][0],lo[k][1],lo[k][2],lo[k][3],hi[k][0],hi[k][1],hi[k][2],hi[k][3]}
    o[d0]=__builtin_amdgcn_mfma_f32_32x32x16_bf16(pa0,PK(0),o[d0],0,0,0);
    o[d0]=__builtin_amdgcn_mfma_f32_32x32x16_bf16(pa1,PK(1),o[d0],0,0,0);
    o[d0]=__builtin_amdgcn_mfma_f32_32x32x16_bf16(pa2,PK(2),o[d0],0,0,0);
    o[d0]=__builtin_amdgcn_mfma_f32_32x32x16_bf16(pa3,PK(3),o[d0],0,0,0);
    #undef PK
  }
}

#ifndef ATTN_STORE16
#define ATTN_STORE16(p,v) (*(u32x4*)(p)=(v))
#endif
template<int THRL> __device__ __forceinline__ void attn_unit(int b,int h,int qb,const bf16*Q,const bf16*__restrict__ K,const bf16*__restrict__ V,bf16*O,char*shm){
  const int tid=tidx(),lane=tid&63,r32=lane&31,hi=lane>>5; const int wid=__builtin_amdgcn_readfirstlane(tid>>6);
  const long rowbase=(long)b*RPBA; const int q0=qb*QB;
  const bf16*Qw=Q+(rowbase+q0+wid*QBLK)*PQ+h*D;
  const bf16*Kh=K+rowbase*PQ+(h>>2)*D,*Vh=V+rowbase*PQ+(h>>2)*D;
  const unsigned lds0=(unsigned)(uintptr_t)shm;
  float*wsf=(float*)(shm+LDS_WS)+wid*64;
  const bf16*ksrc=Kh+(long)lane*PQ+wid*8;
  const bf16*vsrc=Vh+(long)(16*(wid&3)+(lane>>2))*PQ+(wid>>2)*32+(lane&3)*8;
  const unsigned kdst=lds0+LDS_K+wid*1024, vdst=lds0+LDS_V+wid*1024;
  #define DMA_K(t,slot) glds16(ksrc+(long)(t)*KVBLK*PQ,(unsigned)__builtin_amdgcn_readfirstlane(kdst+(slot)))
  #define DMA_V(t,slot) glds16(vsrc+(long)(t)*KVBLK*PQ,(unsigned)__builtin_amdgcn_readfirstlane(vdst+(slot)))
  const int vb0=(int)(lds0+LDS_V)+((lane>>4)&1)*32+(lane&3)*8+(4*hi+((lane&15)>>2))*64;
  const char*Kbase=shm+LDS_K; bf16x8 kf[8];
  const lds_cptr shm3=(lds_cptr)shm; const lds_cptr kp0=shm3+LDS_K+hi*1024+r32*16; const lds_cptr vp0=shm3+LDS_V+((lane>>4)&1)*32+(lane&3)*8+(4*hi+((lane&15)>>2))*64;
  const int NT=KROWS/KVBLK;
  DMA_K(0,0);DMA_V(0,0);DMA_K(1,SLOTB);
  bf16x8 qr[4];
  #pragma unroll
  for(int d0=0;d0<4;++d0)qr[d0]=*reinterpret_cast<const bf16x8*>(&Qw[(long)r32*PQ+d0*16+hi*8]);
  float mhat=0.f,l_reg=0.f;f32x16 o[2];o[0]=f32x16{};o[1]=f32x16{};f32x16 negm=f32x16{};asm volatile("":"+v"(negm));
  const int qrel=wid*QBLK+r32;
  #define CMASK(P0,P1,t) do{}while(0)
  bool resc=false;
  #define START(P0,P1) do{ const float rm=rowmax(P0,P1); resc=false; \
    { const float dl=rm; mhat=fadd_s(mhat,dl); \
      _Pragma("unroll") for(int r=0;r<16;++r){P0[r]=fsub_s(P0[r],dl);P1[r]=fsub_s(P1[r],dl);} \
      _Pragma("unroll") for(int r=0;r<16;++r)negm[r]=-mhat; asm volatile("":"+v"(negm)); } \
    _Pragma("unroll") for(int r=0;r<16;++r)P0[r]=__builtin_amdgcn_exp2f(P0[r]); }while(0)
  #define RESC() do{ if(resc){ asm volatile("s_waitcnt lgkmcnt(0)":::"memory"); \
      _Pragma("unroll") for(int d_=0;d_<2;++d_) _Pragma("unroll") for(int r=0;r<16;++r)o[d_][r]*=wsf[crow(r,hi)]; } }while(0)
  f32x16 pA0,pA1,pB0,pB1;
  int sl_prev=0,sl_cur=0,sl_next=SLOTB;
  #define ROT() do{sl_prev=sl_cur;sl_cur=sl_next;sl_next=(sl_next==(NSLOT-1)*SLOTB)?0:sl_next+SLOTB;}while(0)
  DMA_K(2,2*SLOTB);
  WAIT_BAR(3);
  qkt(pA0,pA1,Kbase,qr,negm,r32,hi);asm volatile("s_nop 15\n\ts_nop 7":"+v"(pA0),"+v"(pA1));CMASK(pA0,pA1,0);
  START(pA0,pA1);
  _Pragma("unroll") for(int r=0;r<16;++r)pA1[r]=__builtin_amdgcn_exp2f(pA1[r]);
  WAIT_BAR(0);
  DMA_K(3,0);DMA_V(1,SLOTB);
  ROT();
  kload8(kf,kp0+sl_cur);
  WAIT_BAR(2);
  s16x4 vlo[8],vhi[8]; u32x4 pw0,pw1,pw2,pw3;
  #define PKW(P,B) cvtpk_s(P[B],P[B+1])
  #define PAF(k) __builtin_bit_cast(bf16x8,pw##k)
  #define VFR(i) (bf16x8){vlo[i][0],vlo[i][1],vlo[i][2],vlo[i][3],vhi[i][0],vhi[i][1],vhi[i][2],vhi[i][3]}
  #define PIN(x) asm volatile("":"+v"(x))
  #define MX3(a,b,c) __builtin_fmaxf(__builtin_fmaxf((a),(b)),(c))
  #define GAPA(MF,A0,A1,A2,A3,W0,W1,PW) do{ MF; sacc+=A0; sacc+=A1; sacc+=A2; sacc+=A3; PIN(sacc); W0; W1; PIN(PW); SBAR(); }while(0)
  #define EX(v) __builtin_amdgcn_exp2f(v)
  #define GAPB(MF,X,B) do{ MF; X[B]=EX(X[B]); X[B+1]=EX(X[B+1]); X[B+2]=EX(X[B+2]); X[B+3]=EX(X[B+3]); PIN(X); SBAR(); }while(0)
  #define VRD(i) do{ vlo[i]=vtr(vp_+(((i)>>2)*4096+((i)&3)*1024)); vhi[i]=vtr(vp_+(((i)>>2)*4096+((i)&3)*1024+512)); }while(0)
  #define KRD(G,j) do{ if(G){ kload2(kf,kp0+sl_next,j); SBAR(); } }while(0)
  #define STEP(C0,C1,P0,P1,t,GK,GV,GL) do{ SBAR(); \
    const lds_cptr vp_=vp0+sl_prev; \
    VRD(0); SBAR(); float sacc=(P0[0]+P0[1]); \
    GAPA(C0=__builtin_amdgcn_mfma_f32_32x32x16_bf16(kf[0],qr[0],negm,0,0,0), P0[2],P0[3],P0[4],P0[5],     pw0[0]=PKW(P0,0), pw0[1]=PKW(P0,2), pw0); \
    VRD(4); SBAR(); GAPA(C1=__builtin_amdgcn_mfma_f32_32x32x16_bf16(kf[1],qr[0],negm,0,0,0), P0[6],P0[7],P0[8],P0[9],     pw0[2]=PKW(P0,4), pw0[3]=PKW(P0,6), pw0); \
    VRD(1); SBAR(); GAPA(C0=__builtin_amdgcn_mfma_f32_32x32x16_bf16(kf[2],qr[1],C0,0,0,0),   P0[10],P0[11],P0[12],P0[13], pw1[0]=PKW(P0,8), pw1[1]=PKW(P0,10), pw1); \
    VRD(5); SBAR(); GAPA(C1=__builtin_amdgcn_mfma_f32_32x32x16_bf16(kf[3],qr[1],C1,0,0,0),   P0[14],P0[15],P1[0],P1[1],   pw1[2]=PKW(P0,12),pw1[3]=PKW(P0,14), pw1); \
    VRD(2); SBAR(); GAPA(C0=__builtin_amdgcn_mfma_f32_32x32x16_bf16(kf[4],qr[2],C0,0,0,0),   P1[2],P1[3],P1[4],P1[5],     pw2[0]=PKW(P1,0), pw2[1]=PKW(P1,2), pw2); \
    VRD(6); SBAR(); GAPA(C1=__builtin_amdgcn_mfma_f32_32x32x16_bf16(kf[5],qr[2],C1,0,0,0),   P1[6],P1[7],P1[8],P1[9],     pw2[2]=PKW(P1,4), pw2[3]=PKW(P1,6), pw2); \
    VRD(3); SBAR(); GAPA(C0=__builtin_amdgcn_mfma_f32_32x32x16_bf16(kf[6],qr[3],C0,0,0,0),   P1[10],P1[11],P1[12],P1[13], pw3[0]=PKW(P1,8), pw3[1]=PKW(P1,10), pw3); \
    VRD(7); SBAR(); GAPA(C1=__builtin_amdgcn_mfma_f32_32x32x16_bf16(kf[7],qr[3],C1,0,0,0),   P1[14],P1[15],0.f,0.f,       pw3[2]=PKW(P1,12),pw3[3]=PKW(P1,14), pw3); \
    l_reg+=sacc; \
    if(GK){DMA_K((t)+3,sl_cur);} if(GV){DMA_V((t)+1,sl_next);} \
    CMASK(C0,C1,t); \
    { float a=MX3(C0[0],C0[1],C1[0]),b=MX3(C0[2],C0[3],C1[1]); a=MX3(a,C1[2],C1[3]); \
      _Pragma("unroll") for(int r=4;r<16;r+=4){a=MX3(a,C0[r],C0[r+1]);b=MX3(b,C0[r+2],C0[r+3]);a=MX3(a,C1[r],C1[r+1]);b=MX3(b,C1[r+2],C1[r+3]);} \
      float rm=__builtin_fmaxf(a,b); { auto rr=__builtin_amdgcn_permlane32_swap(__float_as_uint(rm),__float_as_uint(rm),false,false); rm=__builtin_fmaxf(__uint_as_float(rr[0]),__uint_as_float(rr[1])); } \
      resc=false; \
      if(__builtin_expect(__any(rm>(float)THRL),0)){ const float dl=__builtin_fmaxf(rm,0.f); mhat+=dl; \
        _Pragma("unroll") for(int r=0;r<16;++r){C0[r]-=dl;C1[r]-=dl;} \
        _Pragma("unroll") for(int r=0;r<16;++r)negm[r]=-mhat; asm volatile("":"+v"(negm)); \
        const float f=__builtin_amdgcn_exp2f(-dl); l_reg*=f; if(hi==0)wsf[r32]=f; resc=true; } } \
    SBAR(); \
    GAPB(o[0]=__builtin_amdgcn_mfma_f32_32x32x16_bf16(PAF(0),VFR(0),o[0],0,0,0), C0,0); \
    GAPB(o[1]=__builtin_amdgcn_mfma_f32_32x32x16_bf16(PAF(0),VFR(4),o[1],0,0,0), C0,4); \
    KRD(GL,0); GAPB(o[0]=__builtin_amdgcn_mfma_f32_32x32x16_bf16(PAF(1),VFR(1),o[0],0,0,0), C0,8); \
    KRD(GL,1); GAPB(o[1]=__builtin_amdgcn_mfma_f32_32x32x16_bf16(PAF(1),VFR(5),o[1],0,0,0), C0,12); \
    KRD(GL,2); GAPB(o[0]=__builtin_amdgcn_mfma_f32_32x32x16_bf16(PAF(2),VFR(2),o[0],0,0,0), C1,0); \
    KRD(GL,3); GAPB(o[1]=__builtin_amdgcn_mfma_f32_32x32x16_bf16(PAF(2),VFR(6),o[1],0,0,0), C1,4); \
    GAPB(o[0]=__builtin_amdgcn_mfma_f32_32x32x16_bf16(PAF(3),VFR(3),o[0],0,0,0), C1,8); \
    GAPB(o[1]=__builtin_amdgcn_mfma_f32_32x32x16_bf16(PAF(3),VFR(7),o[1],0,0,0), C1,12); \
    }while(0)
  int t=1;
  #undef CMASK
  #define CMASK(P0,P1,t) do{}while(0)
  for(;t+5<NT;t+=2){
    STEP(pB0,pB1,pA0,pA1,t,true,true,true);     WAIT_BAR(2); RESC(); ROT();
    STEP(pA0,pA1,pB0,pB1,t+1,true,true,true);   WAIT_BAR(2); RESC(); ROT();
  }
  #undef CMASK
  #define CMASK(P0,P1,t) do{}while(0)
  #define ENDW(tt) do{ if((tt)+3<NT){WAIT_BAR(2);} else if((tt)+2<NT){WAIT_BAR(1);} else {WAIT_BAR(0);} }while(0)
  for(;t+1<NT;t+=2){
    STEP(pB0,pB1,pA0,pA1,t,(t+3<NT),(t+1<NT),(t+1<NT));       ENDW(t);   RESC(); ROT();
    STEP(pA0,pA1,pB0,pB1,t+1,(t+4<NT),(t+2<NT),(t+2<NT));     ENDW(t+1); RESC(); ROT();
  }
  STEP(pB0,pB1,pA0,pA1,NT-1,false,false,false); RESC();
  { float sacc=pB0[0]+pB0[1]; _Pragma("unroll") for(int r=2;r<16;++r)sacc+=pB0[r]; _Pragma("unroll") for(int r=0;r<16;++r)sacc+=pB1[r]; l_reg+=sacc;
    pw0=(u32x4){PKW(pB0,0),PKW(pB0,2),PKW(pB0,4),PKW(pB0,6)};pw1=(u32x4){PKW(pB0,8),PKW(pB0,10),PKW(pB0,12),PKW(pB0,14)};pw2=(u32x4){PKW(pB1,0),PKW(pB1,2),PKW(pB1,4),PKW(pB1,6)};pw3=(u32x4){PKW(pB1,8),PKW(pB1,10),PKW(pB1,12),PKW(pB1,14)};
    SBAR(); pv(o,vb0+sl_cur,PAF(0),PAF(1),PAF(2),PAF(3)); }
  #undef PKW
  #undef PAF
  #undef VFR
  #undef PIN
  #undef MX3
  #undef GAPA
  #undef GAPB
  #undef EX
  #undef VRD
  #undef KRD
  #undef STEP
  #undef ENDW
  {auto rr=__builtin_amdgcn_permlane32_swap(__float_as_uint(l_reg),__float_as_uint(l_reg),false,false);l_reg=__uint_as_float(rr[0])+__uint_as_float(rr[1]);}
  if(hi==0)wsf[32+r32]=l_reg;asm volatile("s_waitcnt lgkmcnt(0)":::"memory");
  float rli[16];
  #pragma unroll
  for(int r=0;r<16;++r)rli[r]=__builtin_amdgcn_rcpf(wsf[32+crow(r,hi)]);
  bf16*Ow=O+(rowbase+q0+wid*QBLK)*PO+h*D;
  { bf16*stg=(bf16*)(shm+LDS_OST)+wid*2048;
    #pragma unroll
    for(int r=0;r<16;++r){const int orow=crow(r,hi);
      #pragma unroll
      for(int d0=0;d0<2;++d0)stg[orow*64+d0*32+r32]=__float2bfloat16(o[d0][r]*rli[r]);}
    asm volatile("s_waitcnt lgkmcnt(0)":::"memory");
    #pragma unroll
    for(int i=0;i<4;++i){const int row=i*8+(lane>>3),ch=lane&7; const u32x4 v=*(const u32x4*)(stg+row*64+ch*8); ATTN_STORE16(Ow+(long)row*PO+ch*8,v);} }
  asm volatile("s_waitcnt lgkmcnt(0)\n\ts_barrier":::"memory");
  #undef DMA_K
  #undef DMA_V
  #undef CMASK
  #undef START
  #undef RESC
  #undef ROT
}
constexpr int ATTN_LDS_BYTES=LDS_BYTES;
#undef SBAR
#undef WAIT_BAR
}

DEV void phase_even_post(PPtr p, int li) {
    const int tid = tidx(), lane = tid & 63, gw = blockIdx.x * NWAVE + (tid >> 6), ngw = gridDim.x * NWAVE;
    u16* RAW = (u16*)(p->ws + OFF_RAW);
    const float* qg = p->in[10] + li * 64; const float* kg = p->in[11] + li * 64;
    const float* T = (const float*)(p->ws + OFF_ROPE);
    const int w8 = (lane & 7) * 8, i0 = w8 & 31; const bool second = (lane & 4) != 0;
    for (int item = gw; item < MROWS * 3; item += ngw) {
        const int m = item / 3, pass = item - 3 * m;
        if (pass == 2 && lane >= 32) continue;
        const int b = m / RPB, q = m - b * RPB;
        const int sl = pass * 8 + (lane >> 3);
        const int c0 = sl < 8 ? sl * 64 : sl < 10 ? 512 + (sl - 8) * 64 : sl < 18 ? 768 + (sl - 10) * 64 : 1280 + (sl - 18) * 64;
        u16* ptr = RAW + (size_t)m * 1536 + c0 + w8;
        float x[8]; unpack8(*(const uint4*)ptr, x);
        if (sl < 10) {
            const float* gn = (sl < 8 ? qg : kg) + w8;
            float ss = 0.f;
#pragma unroll
            for (int e = 0; e < 8; ++e) ss += x[e] * x[e];
            ss += __shfl_xor(ss, 1); ss += __shfl_xor(ss, 2); ss += __shfl_xor(ss, 4);
            const float rs = rsqrtf(ss * (1.f / 64.f) + 1e-6f);
            const float4 g0 = *(const float4*)gn, g1 = *(const float4*)(gn + 4);
            x[0] *= rs * g0.x; x[1] *= rs * g0.y; x[2] *= rs * g0.z; x[3] *= rs * g0.w; x[4] *= rs * g1.x; x[5] *= rs * g1.y; x[6] *= rs * g1.z; x[7] *= rs * g1.w;
        }
        if (q < SEQ) {
            const float* ct = (i0 < 16) ? T + (q >> 6) * 16 + i0 : T + 8192 + (q & 63) * 16 + (i0 - 16);
            const float* st = ct + ((i0 < 16) ? 4096 : 1024);
            const float4 c0v = *(const float4*)ct, c1v = *(const float4*)(ct + 4), s0v = *(const float4*)st, s1v = *(const float4*)(st + 4);
            const float cs[8] = {c0v.x, c0v.y, c0v.z, c0v.w, c1v.x, c1v.y, c1v.z, c1v.w}, sn[8] = {s0v.x, s0v.y, s0v.z, s0v.w, s1v.x, s1v.y, s1v.z, s1v.w};
            const float sc = (sl < 8) ? attn_body::C2 : 1.f;
#pragma unroll
            for (int e = 0; e < 8; ++e) {
                const float other = __shfl_xor(x[e], 4);
                const float o = second ? (other * sn[e] + x[e] * cs[e]) : (x[e] * cs[e] - other * sn[e]);
                x[e] = o * sc;
            }
        }
        *(uint4*)ptr = pack8(x);
    }
}

template <int mode, bool qctx>
DEV void attn_wave(const u16* QB, int pitch, int qcol, int kcol, int vcol, u16* AO, int ocol,
                   int b, int hk, int blk, const float* sinkp, const float* rpb, u16* sV) {
    const int lane = tidx() & 63, qi = lane & 15, quad = lane >> 4;
    const bool gqa = mode < 2;
    const size_t rowb = (size_t)b * RPB;
    const float SCL = 0.125f * LOG2E;
    int qtok[4], qhead[4]; bf16x8 qf[4][2];
#pragma unroll
    for (int i = 0; i < 4; ++i) {
        qtok[i] = gqa ? blk * 16 + qi : blk * 64 + i * 16 + qi; qhead[i] = gqa ? hk * 4 + i : hk;
        const size_t m = rowb + (qctx ? SEQ : 0) + qtok[i];
        const u16* qp = QB + m * pitch + qcol + qhead[i] * 64 + quad * 8;
        qf[i][0] = *(const bf16x8*)qp; qf[i][1] = *(const bf16x8*)(qp + 32);
    }
    f32x4 o[4][4]; float mrun[4], lrun[4];
#pragma unroll
    for (int i = 0; i < 4; ++i) {
#pragma unroll
        for (int d = 0; d < 4; ++d) o[i][d] = (f32x4){0.f, 0.f, 0.f, 0.f};
        if (mode == 1) { mrun[i] = sinkp[qhead[i]] * LOG2E; lrun[i] = (quad == 0) ? 1.f : 0.f; } else { mrun[i] = -1e30f; lrun[i] = 0.f; }
    }
    const u16* Kb = QB + kcol + hk * 64; const u16* Vb = QB + vcol + hk * 64;
    float* srpb = (float*)(sV + 32 * 72);
    if (mode == 2) { for (int t = lane; t < 15 * 31; t += 64) srpb[t] = rpb[hk * (15 * 31) + t]; }
    int n_local, ustart, rs = 0;
    if (qctx) { n_local = 0; ustart = 0; }
    else if (mode == 0) { n_local = RPB / 32; ustart = 0; }
    else if (mode == 1) { n_local = 9; ustart = blk * 16 - 128; }
    else { rs = min(max(blk - 4, 0), 248); n_local = 16; ustart = rs * 64; }
    const int n_ctx = (mode == 0 && !qctx) ? 0 : 8;
    for (int tt = 0; tt < n_local + n_ctx; ++tt) {
        const bool loc = tt < n_local;
        const int u0 = loc ? ustart + 32 * tt : SEQ + 32 * (tt - n_local);
        const bool masked = loc && mode != 0;
        bf16x8 kf[2][2];
#pragma unroll
        for (int kt = 0; kt < 2; ++kt) {
            const int u = min(max(u0 + kt * 16 + qi, 0), RPB - 1);
            const u16* kp = Kb + (rowb + u) * pitch + quad * 8;
            kf[kt][0] = *(const bf16x8*)kp; kf[kt][1] = *(const bf16x8*)(kp + 32);
        }
#pragma unroll
        for (int c = 0; c < 4; ++c) {
            const int idx = c * 64 + lane, key = idx >> 3, dc = idx & 7;
            const int u = min(max(u0 + key, 0), RPB - 1);
            const uint4 v = *(const uint4*)(Vb + (rowb + u) * pitch + dc * 8);
            *(uint4*)(sV + key * 72 + dc * 8) = v;
        }
        bf16x8 vf[4];
#pragma unroll
        for (int dt = 0; dt < 4; ++dt)
#pragma unroll
            for (int jj = 0; jj < 8; ++jj) {
                const int key = (jj < 4) ? quad * 4 + jj : 16 + quad * 4 + (jj - 4);
                vf[dt][jj] = (short)sV[key * 72 + dt * 16 + qi];
            }
#pragma unroll
        for (int i = 0; i < 4; ++i) {
            if (mode == 2 && loc && ((i == 0 && (tt & 1) == 1) || (i == 3 && (tt & 1) == 0))) continue;
            f32x4 s0 = (f32x4){0.f, 0.f, 0.f, 0.f}, s1 = (f32x4){0.f, 0.f, 0.f, 0.f};
            s0 = __builtin_amdgcn_mfma_f32_16x16x32_bf16(kf[0][0], qf[i][0], s0, 0, 0, 0);
            s0 = __builtin_amdgcn_mfma_f32_16x16x32_bf16(kf[0][1], qf[i][1], s0, 0, 0, 0);
            s1 = __builtin_amdgcn_mfma_f32_16x16x32_bf16(kf[1][0], qf[i][0], s1, 0, 0, 0);
            s1 = __builtin_amdgcn_mfma_f32_16x16x32_bf16(kf[1][1], qf[i][1], s1, 0, 0, 0);
            float sc[8];
#pragma unroll
            for (int j = 0; j < 4; ++j) { sc[j] = s0[j] * SCL; sc[4 + j] = s1[j] * SCL; }
            if (masked) {
                const int t = qtok[i];
#pragma unroll
                for (int e = 0; e < 8; ++e) {
                    const int u = u0 + (e >> 2) * 16 + quad * 4 + (e & 3);
                    if (mode == 1) {
                        const int dd = t - u;
                        const bool ok = (u >= 0) && (u < SEQ) && (dd <= 128) && (dd >= -128);
                        if (!ok) sc[e] = -INFINITY;
                    } else {
                        const int c = t & 63, r = t >> 6, ur = u >> 6, uc = u & 63;
                        const int cst = min(max(c - 8, 0), 48);
                        const bool ok = (uc >= cst) && (uc < cst + 16);
                        const int dr = min(max(ur - r + 7, 0), 14), dcx = min(max(uc - c + 15, 0), 30);
                        const float bias = srpb[dr * 31 + dcx];
                        sc[e] = ok ? sc[e] + bias * LOG2E : -INFINITY;
                    }
                }
            }
            float mx = fmaxf(fmaxf(fmaxf(sc[0], sc[1]), fmaxf(sc[2], sc[3])), fmaxf(fmaxf(sc[4], sc[5]), fmaxf(sc[6], sc[7])));
            mx = fmaxf(mx, __shfl_xor(mx, 16)); mx = fmaxf(mx, __shfl_xor(mx, 32));
            const float mn = fmaxf(mrun[i], mx);
            const float al = __builtin_amdgcn_exp2f(mrun[i] - mn);
            mrun[i] = mn;
            float pe[8], ps = 0.f;
#pragma unroll
            for (int e = 0; e < 8; ++e) { pe[e] = __builtin_amdgcn_exp2f(sc[e] - mn); ps += pe[e]; }
            lrun[i] = lrun[i] * al + ps;
            union { unsigned u[4]; bf16x8 v; } pf;
            pf.u[0] = pk2(pe[0], pe[1]); pf.u[1] = pk2(pe[2], pe[3]); pf.u[2] = pk2(pe[4], pe[5]); pf.u[3] = pk2(pe[6], pe[7]);
#pragma unroll
            for (int dt = 0; dt < 4; ++dt) {
                o[i][dt] = o[i][dt] * al;
                o[i][dt] = __builtin_amdgcn_mfma_f32_16x16x32_bf16(vf[dt], pf.v, o[i][dt], 0, 0, 0);
            }
        }
    }
#pragma unroll
    for (int i = 0; i < 4; ++i) {
        float l = lrun[i]; l += __shfl_xor(l, 16); l += __shfl_xor(l, 32);
        const float inv = 1.f / l;
        const size_t m = rowb + (qctx ? SEQ : 0) + qtok[i];
        u16* op = AO + m * DM + ocol + qhead[i] * 64 + quad * 4;
#pragma unroll
        for (int dt = 0; dt < 4; ++dt) {
            uint2 w; w.x = pk2(o[i][dt][0] * inv, o[i][dt][1] * inv); w.y = pk2(o[i][dt][2] * inv, o[i][dt][3] * inv);
            *(uint2*)(op + dt * 16) = w;
        }
    }
}

DEV void phase_attn_even(PPtr p, int li, char* lds) {
    {
        const attn_body::bf16* RAWb = (const attn_body::bf16*)(p->ws + OFF_RAW); attn_body::bf16* AOb = (attn_body::bf16*)(p->ws + OFF_AO);
        const int G = gridDim.x, bx = blockIdx.x;
        if (G == 256) {
            const int vcu = (bx & 7) * 32 + (bx >> 3); const int x = vcu >> 5, combo = x >> 1, sub = (x & 1) * 32 + (vcu & 31);
            for (int i = 0; i < 4; ++i) attn_body::attn_unit<8>(combo >> 1, (combo & 1) * 4 + i, sub, RAWb, RAWb + 512, RAWb + 640, AOb, lds);
        } else {
            for (int u = bx; u < 1024; u += G) attn_body::attn_unit<8>(u >> 9, (u >> 6) & 7, u & 63, RAWb, RAWb + 512, RAWb + 640, AOb, lds);
        }
    }
    const int wave = tidx() >> 6, gw = blockIdx.x * NWAVE + wave, ngw = gridDim.x * NWAVE;
    u16* sV = (u16*)lds + wave * 3328;
    const u16* RAW = (const u16*)(p->ws + OFF_RAW); u16* AO = (u16*)(p->ws + OFF_AO);
    const float* sink = p->in[12] + li * 8;
    for (int t = gw; t < 4224; t += ngw) {
        if (t < 4096) attn_wave<1, false>(RAW, 1536, 768, 1280, 1408, AO, 512, t >> 11, (t >> 10) & 1, t & 1023, sink, nullptr, sV);
        else if (t < 4160) { const int u = t - 4096; attn_wave<0, true>(RAW, 1536, 0, 512, 640, AO, 0, u >> 5, (u >> 4) & 1, u & 15, nullptr, nullptr, sV); }
        else { const int u = t - 4160; attn_wave<1, true>(RAW, 1536, 768, 1280, 1408, AO, 512, u >> 5, (u >> 4) & 1, u & 15, sink, nullptr, sV); }
    }
}
DEV void phase_attn_odd(PPtr p, int li, char* lds) {
    const int wave = tidx() >> 6, gw = blockIdx.x * NWAVE + wave, ngw = gridDim.x * NWAVE;
    u16* sV = (u16*)lds + wave * 3328;
    const u16* QKV = (const u16*)(p->ws + OFF_RAW); u16* AO = (u16*)(p->ws + OFF_AO);
    const float* rpb = p->in[15] + li * 8 * 15 * 31;
    for (int t = gw; t < 4160; t += ngw) {
        if (t < 4096) attn_wave<2, false>(QKV, 1536, 0, 512, 1024, AO, 0, t >> 11, (t >> 8) & 7, t & 255, nullptr, rpb, sV);
        else { const int u = t - 4096; attn_wave<2, true>(QKV, 1536, 0, 512, 1024, AO, 0, u >> 5, (u >> 2) & 7, u & 3, nullptr, rpb, sV); }
    }
}

DEV float shiftmix_at(const u16* ZDb, int pp, int ch, float mu) {
    const bool lat = pp < SEQ; const int lo = lat ? 0 : SEQ, hi = lat ? SEQ : RPB;
    const u16* zc = ZDb + (size_t)pp * ZDW + ch;
    const float z = bf2f(zc[0]);
    const float a = (pp - 1 >= lo) ? bf2f(zc[-ZDW]) : 0.f, c = (pp + 1 < hi) ? bf2f(zc[ZDW]) : 0.f;
    return z + (0.5f * (a + c) - z) * mu;
}
DEV void phase_rwkv_prep(PPtr p, int li, int bb) {
    const int tid = tidx(), lane = tid & 63, gw = blockIdx.x * NWAVE + (tid >> 6), ngw = gridDim.x * NWAVE;
    const u16* ZDb = (const u16*)(p->ws + OFF_ZD) + (size_t)bb * RPB * ZDW;
    const float* mu = p->in[16] + li * ZDW; const float* kkw = p->in[22] + li * 512;
    u16* R = (u16*)(p->ws + OFF_R); u16* KK = (u16*)(p->ws + OFF_KK); u16* V = (u16*)(p->ws + OFF_V); u16* LA = (u16*)(p->ws + OFF_LA);
    {
        u16* LB = (u16*)(p->ws + OFF_PU);
        const float* w2 = p->in[18] + (size_t)li * 2 * 64 * 512; const float* a2 = p->in[20] + (size_t)li * 2 * 64 * 512; const float* g2 = p->in[21] + (size_t)li * 128 * 512;
        for (int idx = gw * 64 + lane; idx < 2560 * 32; idx += ngw * 64) {
            const int n = idx >> 5, kc = (idx & 31) * 8, type = n >> 9, nn = n & 511;
            float f[8];
#pragma unroll
            for (int e = 0; e < 8; ++e) {
                const int k = kc + e; float x = 0.f;
                if (type < 2) { if (k < 64) x = w2[((size_t)type * 64 + k) * 512 + nn]; }
                else if (type < 4) { if (k >= 64 && k < 128) x = a2[((size_t)(type - 2) * 64 + (k - 64)) * 512 + nn]; }
                else { if (k >= 128) x = g2[(size_t)(k - 128) * 512 + nn]; }
                f[e] = x;
            }
            *(uint4*)(LB + (size_t)n * 256 + kc) = pack8(f);
        }
    }
    for (int pp = gw; pp < RPB; pp += ngw) {
        const bool lat = pp < SEQ; const int lo = lat ? 0 : SEQ, hi = lat ? SEQ : RPB;
        const bool hp = pp - 1 >= lo, hn = pp + 1 < hi;
        const u16* zc = ZDb + (size_t)pp * ZDW;
#pragma unroll
        for (int j = 0; j < 4; ++j) {
            const int c8 = lane + 64 * j;
            if (j == 3 && lane >= 32) break;
            const int ch = 8 * c8;
            float z[8], a[8], c[8], zs[8];
            unpack8(*(const uint4*)(zc + ch), z);
            if (hp) unpack8(*(const uint4*)(zc - ZDW + ch), a); else { for (int e = 0; e < 8; ++e) a[e] = 0.f; }
            if (hn) unpack8(*(const uint4*)(zc + ZDW + ch), c); else { for (int e = 0; e < 8; ++e) c[e] = 0.f; }
            const float4 m0 = *(const float4*)(mu + ch), m1 = *(const float4*)(mu + ch + 4);
            const float mm[8] = {m0.x, m0.y, m0.z, m0.w, m1.x, m1.y, m1.z, m1.w};
#pragma unroll
            for (int e = 0; e < 8; ++e) zs[e] = z[e] + (0.5f * (a[e] + c[e]) - z[e]) * mm[e];
            if (j == 0) *(uint4*)(R + (size_t)pp * 512 + ch) = pack8(zs);
            else if (j == 1) {
                const float4 k0 = *(const float4*)(kkw + ch - 512), k1 = *(const float4*)(kkw + ch - 512 + 4);
                const float kw[8] = {k0.x, k0.y, k0.z, k0.w, k1.x, k1.y, k1.z, k1.w};
                float t[8], ss = 0.f;
#pragma unroll
                for (int e = 0; e < 8; ++e) { t[e] = zs[e] * kw[e]; ss += t[e] * t[e]; }
                ss += __shfl_xor(ss, 1); ss += __shfl_xor(ss, 2); ss += __shfl_xor(ss, 4);
                const float inv = 1.f / fmaxf(sqrtf(ss), 1e-12f);
#pragma unroll
                for (int e = 0; e < 8; ++e) t[e] *= inv;
                *(uint4*)(KK + (size_t)pp * 512 + ch - 512) = pack8(t);
            } else if (j == 2) *(uint4*)(V + (size_t)pp * 512 + ch - 1024) = pack8(zs);
            else {
                float o[8];
#pragma unroll
                for (int e = 0; e < 8; ++e) o[e] = (lane < 8) ? tanhf(zs[e]) : (lane < 16) ? zs[e] : sigmoidf_(zs[e]);
                *(uint4*)(LA + (size_t)pp * 256 + ch - 1536) = pack8(o);
            }
        }
    }
}
struct EpiDecay { float* DEC; const float* w0; int d;
    DEV void operator()(int r, int c, float v, float) const {
        const float x = -(w0[c] + v); const float sp = x > 20.f ? x : log1pf(expf(x)); const float w = -sp - 0.5f;
        DEC[((size_t)r * 2 + d) * 512 + c] = expf(-expf(w)); } };
struct EpiIclr { u16* KD; u16* BQ; const u16* KK; const u16* ZDb; const float* a0; const float* ka; const float* muk; int d;
    DEV void operator()(int r, int c, float v, float) const {
        const float a = sigmoidf_(a0[c] + v);
        const float k = shiftmix_at(ZDb, r, 512 + c, muk[c]);
        KD[((size_t)r * 2 + d) * 512 + c] = (u16)f2bf(k * (1.f + (a - 1.f) * ka[c]));
        BQ[((size_t)r * 2 + d) * 512 + c] = (u16)f2bf(bf2f(KK[(size_t)r * 512 + c]) * a); } };
struct EpiGate { u16* G; DEV void operator()(int r, int c, float v, float) const { G[(size_t)r * 512 + c] = (u16)f2bf(v); } };

DEV int pos_to_pp(int s, int d) { return (s < NCTX) ? (d ? SEQ + NCTX - 1 - s : SEQ + s) : (d ? SEQ - 1 - (s - NCTX) : s - NCTX); }
struct StepV { float d; unsigned a; unsigned b; float v; };
DEV StepV load_step(const float* DEC, const u16* KD, const u16* BQ, const u16* KK, const u16* R, const u16* V, int pp, int h, int d, int lane) {
    const size_t e1 = (size_t)pp * 512 + h * 64, e2 = ((size_t)pp * 2 + d) * 512 + h * 64;
    StepV s;
    s.d = DEC[e2 + lane];
    s.a = (lane < 32) ? ((const unsigned*)(KD + e2))[lane] : ((const unsigned*)(BQ + e2))[lane - 32];
    s.b = (lane < 32) ? ((const unsigned*)(KK + e1))[lane] : ((const unsigned*)(R + e1))[lane - 32];
    s.v = bf2f(V[e1 + lane]);
    return s;
}
typedef float f32x2 __attribute__((ext_vector_type(2)));
constexpr int SSLOT = 320;
typedef __attribute__((address_space(3))) float* ldsf;
typedef const __attribute__((address_space(3))) f32x4* lds4;
DEV void stage_step(ldsf slot, const StepV& s, int lane) {
    slot[lane] = s.d;
    *(__attribute__((address_space(3))) f32x2*)(slot + 64 + 2 * lane) = (f32x2){bflo(s.a), bfhi(s.a)};
    *(__attribute__((address_space(3))) f32x2*)(slot + 192 + 2 * lane) = (f32x2){bflo(s.b), bfhi(s.b)};
}
#define LO2(v) ((f32x2){(v)[0], (v)[1]})
#define HI2(v) ((f32x2){(v)[2], (v)[3]})
template <int MODE>
DEV float scan_step(f32x2 (&S)[32], ldsf sl, float vv) {
    lds4 D = (lds4)sl;
    f32x2 sa = {0.f, 0.f}, sb = {0.f, 0.f};
#pragma unroll
    for (int q = 0; q < 16; ++q) { const f32x4 k4 = D[48 + q]; sa += S[2 * q] * LO2(k4); sb += S[2 * q + 1] * HI2(k4);
        if ((q & 3) == 3) asm volatile("" : "+v"(D), "+v"(sa), "+v"(sb)); }
    const float nsa = -((sa[0] + sa[1]) + (sb[0] + sb[1]));
    const f32x2 nsa2 = {nsa, nsa}, vv2 = {vv, vv};
    f32x2 y = {0.f, 0.f}, z = {0.f, 0.f};
#pragma unroll
    for (int q = 0; q < 16; ++q) {
        const f32x4 d4 = D[q], b4 = D[32 + q];
        f32x2 t0 = nsa2 * LO2(b4), t1 = nsa2 * HI2(b4);
        if (MODE >= 1) { const f32x4 kd4 = D[16 + q]; t0 += vv2 * LO2(kd4); t1 += vv2 * HI2(kd4); }
        S[2 * q] = S[2 * q] * LO2(d4) + t0; S[2 * q + 1] = S[2 * q + 1] * HI2(d4) + t1;
        if (MODE == 2) { const f32x4 r4 = D[64 + q]; y += S[2 * q] * LO2(r4); z += S[2 * q + 1] * HI2(r4); }
        else y += S[2 * q + 1];
        if ((q & 1) == 1) asm volatile("" : "+v"(D), "+v"(y), "+v"(z), "+v"(S[2 * q + 1]));
    }
    return (y[0] + y[1]) + (z[0] + z[1]);
}
DEV void scan_step_pu(f32x2 (&P)[32], f32x2 (&U)[32], ldsf sl, float vv) {
    lds4 D = (lds4)sl;
    f32x2 pa = {0.f, 0.f}, pb = {0.f, 0.f}, ua = {0.f, 0.f}, ub = {0.f, 0.f};
#pragma unroll
    for (int q = 0; q < 16; ++q) { const f32x4 k4 = D[48 + q];
        pa += P[2 * q] * LO2(k4); pb += P[2 * q + 1] * HI2(k4); ua += U[2 * q] * LO2(k4); ub += U[2 * q + 1] * HI2(k4);
        if ((q & 3) == 3) asm volatile("" : "+v"(D), "+v"(pa), "+v"(pb), "+v"(ua), "+v"(ub)); }
    const float nsp = -((pa[0] + pa[1]) + (pb[0] + pb[1])), nsu = -((ua[0] + ua[1]) + (ub[0] + ub[1]));
    const f32x2 nsp2 = {nsp, nsp}, nsu2 = {nsu, nsu}, vv2 = {vv, vv};
#pragma unroll
    for (int q = 0; q < 16; ++q) {
        const f32x4 d4 = D[q], b4 = D[32 + q], kd4 = D[16 + q];
        P[2 * q] = P[2 * q] * LO2(d4) + nsp2 * LO2(b4); P[2 * q + 1] = P[2 * q + 1] * HI2(d4) + nsp2 * HI2(b4);
        U[2 * q] = U[2 * q] * LO2(d4) + (vv2 * LO2(kd4) + nsu2 * LO2(b4)); U[2 * q + 1] = U[2 * q + 1] * HI2(d4) + (vv2 * HI2(kd4) + nsu2 * HI2(b4));
        asm volatile("" : "+v"(D), "+v"(P[2 * q]), "+v"(P[2 * q + 1]), "+v"(U[2 * q]), "+v"(U[2 * q + 1]));
    }
}
DEV void phase_scan1(PPtr p, char* lds) {
    const int tid = tidx(), lane = tid & 63, wv = __builtin_amdgcn_readfirstlane(tid >> 6), gw = blockIdx.x * NWAVE + wv, ngw = gridDim.x * NWAVE;
    const float* DEC = (const float*)(p->ws + OFF_DEC); const u16* KD = (const u16*)(p->ws + OFF_KD); const u16* BQ = (const u16*)(p->ws + OFF_BQ);
    const u16* KK = (const u16*)(p->ws + OFF_KK); const u16* R = (const u16*)(p->ws + OFF_R); const u16* V = (const u16*)(p->ws + OFF_V);
    float* PU = (float*)(p->ws + OFF_PU);
    ldsf ring = (ldsf)lds + wv * (3 * SSLOT);
    for (int task = gw; task < 16 * NCH; task += ngw) {
        const int seq = task >> 7, c = task & 127, h = seq >> 1, d = seq & 1;
#define LD(st) load_step(DEC, KD, BQ, KK, R, V, pos_to_pp(c * CLEN + min((st), CLEN - 1), d), h, d, lane)
        f32x2 P[32], U[32];
        float lnf = (float)lane; asm volatile("" : "+v"(lnf));
#pragma unroll
        for (int j = 0; j < 32; ++j) { P[j] = (f32x2){fmaxf(1.f - fabsf(lnf - (float)(2 * j)), 0.f), fmaxf(1.f - fabsf(lnf - (float)(2 * j + 1)), 0.f)}; U[j] = (f32x2){0.f, 0.f}; }
        float vvA, vvB;
        { const StepV s0 = LD(0), s1 = LD(1); stage_step(ring, s0, lane); stage_step(ring + SSLOT, s1, lane); vvA = s0.v; vvB = s1.v; }
        StepV g0 = LD(2), g1 = LD(3), g2 = LD(4), g3 = LD(5);
        int cs = 0, ns = 2;
#pragma unroll 1
        for (int st = 0; st < CLEN; ++st) {
            scan_step_pu(P, U, ring + cs * SSLOT, vvA);
            stage_step(ring + ns * SSLOT, g0, lane);
            vvA = vvB; vvB = g0.v; g0 = g1; g1 = g2; g2 = g3; g3 = LD(st + 6);
            cs = (cs == 2) ? 0 : cs + 1; ns = (ns == 2) ? 0 : ns + 1;
        }
#undef LD
        float4* o = (float4*)(PU + ((size_t)task * 2) * 4096 + lane * 64);
#pragma unroll
        for (int j = 0; j < 16; ++j) { o[j] = (float4){P[2 * j][0], P[2 * j][1], P[2 * j + 1][0], P[2 * j + 1][1]}; o[1024 + j] = (float4){U[2 * j][0], U[2 * j][1], U[2 * j + 1][0], U[2 * j + 1][1]}; }
    }
}
#define S2_PLOAD(ent_, lo, hi) do { const float4* s_ = (const float4*)((ent_) + prow * 64 + pcol); lo = s_[0]; hi = s_[1]; } while (0)
#define S2_ULOAD(ent_, u_) do { const float* s_ = (ent_) + 4096; _Pragma("unroll") for (int t_ = 0; t_ < 2; ++t_) _Pragma("unroll") for (int j_ = 0; j_ < 4; ++j_) u_[t_][j_] = s_[(16 * rt + 4 * q + j_) * 64 + 16 * (ct0 + t_) + r]; } while (0)
#define S2_CSTORE(dst_, a0_, a1_) do { float* d_ = (dst_); _Pragma("unroll") for (int j_ = 0; j_ < 4; ++j_) { d_[(16 * rt + 4 * q + j_) * 64 + 16 * ct0 + r] = a0_[j_]; d_[(16 * rt + 4 * q + j_) * 64 + 16 * ct0 + 16 + r] = a1_[j_]; } } while (0)
#define S2_LSTORE(dst_, a0_, a1_) do { float* d_ = (dst_); _Pragma("unroll") for (int j_ = 0; j_ < 4; ++j_) { d_[(16 * rt + 4 * q + j_) * 68 + 16 * ct0 + r] = a0_[j_]; d_[(16 * rt + 4 * q + j_) * 68 + 16 * ct0 + 16 + r] = a1_[j_]; } } while (0)
DEV void phase_scan2a(PPtr p, char* lds) {
    if (blockIdx.x >= 128) return;
    const int tid = tidx(), lane = tid & 63, w = __builtin_amdgcn_readfirstlane(tid >> 6), seq = blockIdx.x >> 3, g = blockIdx.x & 7;
    float* sX = (float*)lds; float* sZ = sX + 2 * 64 * 68; float* sP = sZ + 2 * 64 * 68;
    float* PUg = (float*)(p->ws + OFF_PU) + (size_t)(seq * NCH + 16 * g) * 8192;
    float* TOT = (float*)(p->ws + OFF_LA) + (size_t)(seq * 8 + g) * 8192;
    const int rt = w >> 1, ct0 = (w & 1) * 2, r = lane & 15, q = lane >> 4;
    const int prow = tid >> 3, pcol = (tid & 7) * 8;
    for (int i = tid; i < 64 * 68; i += NTHR) { const int row = i / 68, col = i - row * 68; sX[i] = (row == col) ? 1.f : 0.f; sZ[i] = 0.f; }
    float4 pa0, pa1, pb0, pb1;
    { float4 t0, t1; S2_PLOAD(PUg, t0, t1); *(float4*)(sP + prow * 68 + pcol) = t0; *(float4*)(sP + prow * 68 + pcol + 4) = t1; }
    S2_PLOAD(PUg + 8192, pa0, pa1); S2_PLOAD(PUg + 2 * 8192, pb0, pb1);
    float ua[2][4], ub[2][4];
    S2_ULOAD(PUg, ua); S2_ULOAD(PUg + 8192, ub);
    __syncthreads();
    for (int jj = 0; jj < 16; ++jj) {
        const int cur = jj & 1;
        f32x4 x0 = {0.f, 0.f, 0.f, 0.f}, x1 = {0.f, 0.f, 0.f, 0.f};
        f32x4 z0 = {ua[0][0], ua[0][1], ua[0][2], ua[0][3]}, z1 = {ua[1][0], ua[1][1], ua[1][2], ua[1][3]};
        const float* Xc = sX + cur * (64 * 68); const float* Zc = sZ + cur * (64 * 68); const float* Pc = sP + cur * (64 * 68);
#pragma unroll
        for (int ks = 0; ks < 16; ++ks) {
            const float ax = Xc[(16 * rt + r) * 68 + 4 * ks + q], az = Zc[(16 * rt + r) * 68 + 4 * ks + q];
            const float b0 = Pc[(4 * ks + q) * 68 + 16 * ct0 + r], b1 = Pc[(4 * ks + q) * 68 + 16 * ct0 + 16 + r];
            x0 = __builtin_amdgcn_mfma_f32_16x16x4f32(ax, b0, x0, 0, 0, 0); x1 = __builtin_amdgcn_mfma_f32_16x16x4f32(ax, b1, x1, 0, 0, 0);
            z0 = __builtin_amdgcn_mfma_f32_16x16x4f32(az, b0, z0, 0, 0, 0); z1 = __builtin_amdgcn_mfma_f32_16x16x4f32(az, b1, z1, 0, 0, 0);
        }
        S2_LSTORE(sX + (cur ^ 1) * (64 * 68), x0, x1); S2_LSTORE(sZ + (cur ^ 1) * (64 * 68), z0, z1);
        S2_CSTORE(PUg + (size_t)jj * 8192, x0, x1); S2_CSTORE(PUg + (size_t)jj * 8192 + 4096, z0, z1);
        if (jj == 15) { S2_CSTORE(TOT, x0, x1); S2_CSTORE(TOT + 4096, z0, z1); }
        { float* Pn = sP + (cur ^ 1) * (64 * 68); *(float4*)(Pn + prow * 68 + pcol) = pa0; *(float4*)(Pn + prow * 68 + pcol + 4) = pa1; }
        pa0 = pb0; pa1 = pb1;
        S2_PLOAD(PUg + (size_t)min(jj + 3, 15) * 8192, pb0, pb1);
#pragma unroll
        for (int t = 0; t < 2; ++t)
#pragma unroll
            for (int j = 0; j < 4; ++j) ua[t][j] = ub[t][j];
        if (jj + 2 < 16) S2_ULOAD(PUg + (size_t)(jj + 2) * 8192, ub);
        __syncthreads();
    }
}
DEV void phase_scan2b(PPtr p, char* lds) {
    if (blockIdx.x >= 128) return;
    const int tid = tidx(), lane = tid & 63, w = __builtin_amdgcn_readfirstlane(tid >> 6), seq = blockIdx.x >> 3, g = blockIdx.x & 7;
    float* sS = (float*)lds; float* sP = sS + 2 * 64 * 68;
    float* PUg = (float*)(p->ws + OFF_PU) + (size_t)(seq * NCH + 16 * g) * 8192;
    float* TOTs = (float*)(p->ws + OFF_LA) + (size_t)(seq * 8) * 8192;
    const int rt = w >> 1, ct0 = (w & 1) * 2, r = lane & 15, q = lane >> 4;
    const int prow = tid >> 3, pcol = (tid & 7) * 8;
    const int T = g + 16;
#define S2_ENT(t_) ((min((t_), T - 1) < g) ? TOTs + (size_t)min((t_), T - 1) * 8192 : PUg + (size_t)(min((t_), T - 1) - g) * 8192)
    for (int i = tid; i < 64 * 68; i += NTHR) sS[i] = 0.f;
    float4 pa0, pa1, pb0, pb1;
    { float4 t0, t1; S2_PLOAD(S2_ENT(0), t0, t1); *(float4*)(sP + prow * 68 + pcol) = t0; *(float4*)(sP + prow * 68 + pcol + 4) = t1; }
    S2_PLOAD(S2_ENT(1), pa0, pa1); S2_PLOAD(S2_ENT(2), pb0, pb1);
    float ua[2][4], ub[2][4];
    S2_ULOAD(S2_ENT(0), ua); S2_ULOAD(S2_ENT(1), ub);
    f32x4 m0 = {0.f, 0.f, 0.f, 0.f}, m1 = {0.f, 0.f, 0.f, 0.f};
    int sb = 0;
    __syncthreads();
    for (int t = 0; t < T; ++t) {
        const int cur = t & 1; const bool chain = t < g;
        if (!chain) S2_CSTORE(PUg + (size_t)(t - g) * 8192 + 4096, m0, m1);
        f32x4 a0 = {ua[0][0], ua[0][1], ua[0][2], ua[0][3]}, a1 = {ua[1][0], ua[1][1], ua[1][2], ua[1][3]};
        const float* Sc = sS + sb * (64 * 68); const float* Pc = sP + cur * (64 * 68);
#pragma unroll
        for (int ks = 0; ks < 16; ++ks) {
            const float av = Sc[(16 * rt + r) * 68 + 4 * ks + q];
            const float b0 = Pc[(4 * ks + q) * 68 + 16 * ct0 + r], b1 = Pc[(4 * ks + q) * 68 + 16 * ct0 + 16 + r];
            a0 = __builtin_amdgcn_mfma_f32_16x16x4f32(av, b0, a0, 0, 0, 0);
            a1 = __builtin_amdgcn_mfma_f32_16x16x4f32(av, b1, a1, 0, 0, 0);
        }
        m0 = a0; m1 = a1;
        if (chain) { S2_LSTORE(sS + (sb ^ 1) * (64 * 68), a0, a1); sb ^= 1; }
        { float* Pn = sP + (cur ^ 1) * (64 * 68); *(float4*)(Pn + prow * 68 + pcol) = pa0; *(float4*)(Pn + prow * 68 + pcol + 4) = pa1; }
        pa0 = pb0; pa1 = pb1;
        S2_PLOAD(S2_ENT(t + 3), pb0, pb1);
#pragma unroll
        for (int u = 0; u < 2; ++u)
#pragma unroll
            for (int j = 0; j < 4; ++j) ua[u][j] = ub[u][j];
        if (t + 2 < T) S2_ULOAD(S2_ENT(t + 2), ub);
        __syncthreads();
    }
#undef S2_ENT
}
DEV void phase_scan3(PPtr p, char* lds) {
    const int tid = tidx(), lane = tid & 63, wv = __builtin_amdgcn_readfirstlane(tid >> 6), gw = blockIdx.x * NWAVE + wv, ngw = gridDim.x * NWAVE;
    const float* DEC = (const float*)(p->ws + OFF_DEC); const u16* KD = (const u16*)(p->ws + OFF_KD); const u16* BQ = (const u16*)(p->ws + OFF_BQ);
    const u16* KK = (const u16*)(p->ws + OFF_KK); const u16* R = (const u16*)(p->ws + OFF_R); const u16* V = (const u16*)(p->ws + OFF_V);
    const float* PU = (const float*)(p->ws + OFF_PU);
    ldsf ring = (ldsf)lds + wv * (3 * SSLOT);
    for (int task = gw; task < 16 * NCH; task += ngw) {
        const int seq = task >> 7, c = task & 127, h = seq >> 1, d = seq & 1;
        float* Yd = (float*)(p->ws + (d ? OFF_ZD : OFF_Y0));
        f32x2 S[32];
        {
            const float4* si = (const float4*)(PU + ((size_t)task * 2 + 1) * 4096 + lane * 64);
#pragma unroll
            for (int j = 0; j < 16; ++j) { const float4 t = si[j]; S[2 * j] = (f32x2){t.x, t.y}; S[2 * j + 1] = (f32x2){t.z, t.w}; }
        }
#define LD(st) load_step(DEC, KD, BQ, KK, R, V, pos_to_pp(c * CLEN + min((st), CLEN - 1), d), h, d, lane)
#define YADD(st, y) (Yd[(size_t)pos_to_pp(c * CLEN + (st), d) * 512 + h * 64 + lane] = (y))
        float vvA, vvB;
        { const StepV s0 = LD(0), s1 = LD(1); stage_step(ring, s0, lane); stage_step(ring + SSLOT, s1, lane); vvA = s0.v; vvB = s1.v; }
        StepV g0 = LD(2), g1 = LD(3), g2 = LD(4), g3 = LD(5);
        int cs = 0, ns = 2;
#pragma unroll 1
        for (int st = 0; st < CLEN; ++st) {
            const float y = scan_step<2>(S, ring + cs * SSLOT, vvA); YADD(st, y);
            stage_step(ring + ns * SSLOT, g0, lane);
            vvA = vvB; vvB = g0.v; g0 = g1; g1 = g2; g2 = g3; g3 = LD(st + 6);
            cs = (cs == 2) ? 0 : cs + 1; ns = (ns == 2) ? 0 : ns + 1;
        }
#undef LD
#undef YADD
    }
}
DEV void phase_readout(PPtr p, int li, int bb) {
    const int tid = tidx(), lane = tid & 63, gw = blockIdx.x * NWAVE + (tid >> 6), ngw = gridDim.x * NWAVE;
    const float* Y0 = (const float*)(p->ws + OFF_Y0);
    const u16* KD = (const u16*)(p->ws + OFF_KD); const u16* R = (const u16*)(p->ws + OFF_R); const u16* V = (const u16*)(p->ws + OFF_V); const u16* G = (const u16*)(p->ws + OFF_G);
    const float* rk = p->in[24] + li * 512; const float* lnw = p->in[25] + li * 512; const float* lnb = p->in[26] + li * 512;
    u16* AO = (u16*)(p->ws + OFF_AO);
    const int c = 8 * lane;
    float rkv[8], lw[8], lb[8];
    { const float4 a = *(const float4*)(rk + c), b = *(const float4*)(rk + c + 4); rkv[0] = a.x; rkv[1] = a.y; rkv[2] = a.z; rkv[3] = a.w; rkv[4] = b.x; rkv[5] = b.y; rkv[6] = b.z; rkv[7] = b.w; }
    { const float4 a = *(const float4*)(lnw + c), b = *(const float4*)(lnw + c + 4); lw[0] = a.x; lw[1] = a.y; lw[2] = a.z; lw[3] = a.w; lw[4] = b.x; lw[5] = b.y; lw[6] = b.z; lw[7] = b.w; }
    { const float4 a = *(const float4*)(lnb + c), b = *(const float4*)(lnb + c + 4); lb[0] = a.x; lb[1] = a.y; lb[2] = a.z; lb[3] = a.w; lb[4] = b.x; lb[5] = b.y; lb[6] = b.z; lb[7] = b.w; }
    for (int pp = gw; pp < RPB; pp += ngw) {
        const size_t m = (size_t)bb * RPB + pp, e = (size_t)pp * 512 + c;
        const float* Y1 = (const float*)(p->ws + OFF_ZD);
        const float4 ya = *(const float4*)(Y0 + e), yb = *(const float4*)(Y0 + e + 4), yc = *(const float4*)(Y1 + e), yd = *(const float4*)(Y1 + e + 4);
        const float y[8] = {ya.x + yc.x, ya.y + yc.y, ya.z + yc.z, ya.w + yc.w, yb.x + yd.x, yb.y + yd.y, yb.z + yd.z, yb.w + yd.w};
        float r[8], k0[8], k1[8], v[8], g[8];
        unpack8(*(const uint4*)(R + e), r); unpack8(*(const uint4*)(KD + ((size_t)pp * 2) * 512 + c), k0); unpack8(*(const uint4*)(KD + ((size_t)pp * 2 + 1) * 512 + c), k1);
        unpack8(*(const uint4*)(V + e), v); unpack8(*(const uint4*)(G + e), g);
        float sm = 0.f, bs = 0.f;
#pragma unroll
        for (int j = 0; j < 8; ++j) { sm += y[j]; bs += r[j] * (k0[j] + k1[j]) * rkv[j]; }
        sm += __shfl_xor(sm, 1); sm += __shfl_xor(sm, 2); sm += __shfl_xor(sm, 4);
        bs += __shfl_xor(bs, 1); bs += __shfl_xor(bs, 2); bs += __shfl_xor(bs, 4);
        const float mean = sm * (1.f / 64.f);
        float vs = 0.f;
#pragma unroll
        for (int j = 0; j < 8; ++j) { const float dv = y[j] - mean; vs += dv * dv; }
        vs += __shfl_xor(vs, 1); vs += __shfl_xor(vs, 2); vs += __shfl_xor(vs, 4);
        const float rstd = rsqrtf(vs * (1.f / 64.f) + 64e-5f);
        float o[8];
#pragma unroll
        for (int j = 0; j < 8; ++j) o[j] = ((y[j] - mean) * rstd * lw[j] + lb[j] + bs * v[j]) * g[j];
        *(uint4*)(AO + m * DM + 512 + c) = pack8(o);
    }
}
DEV void phase_final(PPtr p) {
    const int lane = tidx() & 63, gw = blockIdx.x * NWAVE + (tidx() >> 6), ngw = gridDim.x * NWAVE;
    const float* gain = p->in[29];
    for (int m = gw; m < NB * SEQ; m += ngw) {
        float4* xr = (float4*)(p->out + (size_t)m * DM);
        float4 v[4]; float ss = 0.f;
#pragma unroll
        for (int j = 0; j < 4; ++j) { v[j] = xr[lane + 64 * j]; ss += v[j].x * v[j].x + v[j].y * v[j].y + v[j].z * v[j].z + v[j].w * v[j].w; }
        ss = wave_sum(ss);
        const float rstd = rsqrtf(ss * (1.f / DM) + 1e-6f);
#pragma unroll
        for (int j = 0; j < 4; ++j) {
            const float4 g = *(const float4*)(gain + (lane + 64 * j) * 4);
            float4 o; o.x = v[j].x * rstd * g.x; o.y = v[j].y * rstd * g.y; o.z = v[j].z * rstd * g.z; o.w = v[j].w * rstd * g.w;
            xr[lane + 64 * j] = o;
        }
    }
}

constexpr size_t OFF_BAR = 768 * 1024;
DEV void gbar(PPtr kp_, unsigned& nbar) {
    asm volatile("s_waitcnt vmcnt(0)" ::: "memory");
    __syncthreads();
    if (threadIdx.x == 0) {
        unsigned* ctr = (unsigned*)(kp_->ws + OFF_BAR);
        __builtin_amdgcn_fence(__ATOMIC_RELEASE, "agent");
        asm volatile("s_waitcnt vmcnt(0)" ::: "memory");
        ++nbar;
        __hip_atomic_fetch_add(ctr, 1u, __ATOMIC_RELAXED, __HIP_MEMORY_SCOPE_AGENT);
        const unsigned target = nbar * gridDim.x;
        while (__hip_atomic_load(ctr, __ATOMIC_RELAXED, __HIP_MEMORY_SCOPE_AGENT) < target) __builtin_amdgcn_s_sleep(1);
        __builtin_amdgcn_fence(__ATOMIC_ACQUIRE, "agent");
        asm volatile("s_waitcnt vmcnt(0)" ::: "memory");
    }
    __syncthreads();
}
#define p launder(kp)
#define SYNC() gbar(launder(kp), nbar)
template <int bb>
DEV void do_rwkv_batch(PPtr kp, unsigned& nbar, char* lds, int li) {
    unsigned char* ws = launder(kp)->ws;
    u16* ZD = (u16*)(ws + OFF_ZD);
                phase_rwkv_prep(p, li, bb); SYNC();
                const u16* LA = (const u16*)(ws + OFF_LA); const u16* ZDb = ZD + (size_t)bb * RPB * ZDW;
                { pg8::EpiLoraT e{(float*)(ws + OFF_DEC), (u16*)(ws + OFF_KD), (u16*)(ws + OFF_BQ), (u16*)(ws + OFF_G), (const u16*)(ws + OFF_KK), ZDb,
                                  p->in[17] + (size_t)li * 1024, p->in[19] + (size_t)li * 1024, p->in[23] + li * 512, p->in[16] + li * ZDW + 512};
                  int kl_ = 256; asm volatile("" : "+s"(kl_));
                  pg8::Gemm g_{(const pg8::bf16_t*)LA, (const pg8::bf16_t*)(ws + OFF_PU), RPB, 2560, kl_}; pg8::StaticOrder S_; S_.init(RPB, 2560, (int)gridDim.x, (int)blockIdx.x);
                  pg8::gemm_phase<pg8::EpiLoraT, pg8::StaticOrder, true, true>((PG8_LAS unsigned char*)lds, g_, S_, e); }
                SYNC();
                phase_scan1(p, lds); SYNC();
                phase_scan2a(p, lds); SYNC();
                phase_scan2b(p, lds); SYNC();
                phase_scan3(p, lds); SYNC();
                phase_readout(p, li, bb); SYNC();
            }
template <int layer>
DEV void do_layer(PPtr kp, unsigned& nbar, char* lds) {
    unsigned char* ws = launder(kp)->ws;
    const float* mod = (const float*)(ws + OFF_MOD);
    u16* HN = (u16*)(ws + OFF_HN); u16* AO = (u16*)(ws + OFF_AO); u16* RAW = (u16*)(ws + OFF_RAW); u16* ZD = (u16*)(ws + OFF_ZD);
        const int li = layer >> 1;
        const float* lmod = mod + (size_t)layer * 3 * 6144;
        phase_wprep(p, layer, lds); phase_normmod(p, layer, 0); SYNC();
        const pg8::bf16_t* WB = (const pg8::bf16_t*)(ws + OFF_WB);
#define GEMM8(A_, B_, N_, K_, E_) do { pg8::Gemm g_{(const pg8::bf16_t*)(A_), (B_), MROWS, (N_), (K_)}; pg8::StaticOrder S_; S_.init(MROWS, (N_), (int)gridDim.x, (int)blockIdx.x); \
            pg8::gemm_phase<decltype(E_), pg8::StaticOrder, true, true>((PG8_LAS unsigned char*)lds, g_, S_, E_); } while (0)
#define GEMM8L(A_, B_, N_, K_, E_) do { pg8::Gemm g_{(const pg8::bf16_t*)(A_), (B_), MROWS, (N_), (K_)}; pg8::LatentOrder S_; S_.init((N_), (int)gridDim.x, (int)blockIdx.x); \
            pg8::gemm_phase<decltype(E_), pg8::LatentOrder, true, true>((PG8_LAS unsigned char*)lds, g_, S_, E_); } while (0)
        if (!(layer & 1)) {
            { pg8::EpiStoreT e{RAW, 1536, 1 << 30, RAW, 1536}; GEMM8(HN, WB + WB_IN, 1536, DM, e); } SYNC();
            phase_even_post(p, li); SYNC();
            phase_attn_even(p, li, lds); SYNC();
            { pg8::EpiResidT e{p, lmod + 2048}; GEMM8(AO, WB + WB_OUT, DM, DM, e); } SYNC();
        } else {
            { pg8::EpiStoreT e{RAW, 1536, 1536, ZD, ZDW}; GEMM8(HN, WB + WB_IN, 3328, DM, e); } SYNC();
            phase_attn_odd(p, li, lds); SYNC();
            do_rwkv_batch<0>(kp, nbar, lds, li);
            do_rwkv_batch<1>(kp, nbar, lds, li);
            if (layer == 3) { pg8::EpiResidT e{p, lmod + 2048}; GEMM8L(AO, WB + WB_OUT, DM, DM, e); }
            else { pg8::EpiResidT e{p, lmod + 2048}; GEMM8(AO, WB + WB_OUT, DM, DM, e); }
            SYNC();
        }
        phase_normmod(p, layer, 1); SYNC();
        if (layer == 3) { pg8::EpiSwigluT e{RAW}; GEMM8L(HN, WB + WB_F1, 5632, DM, e); }
        else { pg8::EpiSwigluT e{RAW}; GEMM8(HN, WB + WB_F1, 5632, DM, e); }
        SYNC();
        if (layer == 3) { pg8::EpiResidT e{p, lmod + 5120}; GEMM8L(RAW, WB + WB_F2, DM, FFH, e); }
        else { pg8::EpiResidT e{p, lmod + 5120}; GEMM8(RAW, WB + WB_F2, DM, FFH, e); }
        SYNC();
    }
__global__ void __launch_bounds__(NTHR) mega(Params p_unused) {
    PPtr kp = (PPtr)__builtin_amdgcn_kernarg_segment_ptr();
    extern __shared__ __attribute__((aligned(16))) char lds[];
    cg::grid_group grid = cg::this_grid();
    unsigned nbar = 0;
    grid.sync();
    phase_init(p, lds); SYNC();
    do_layer<0>(kp, nbar, lds);
    do_layer<1>(kp, nbar, lds);
    do_layer<2>(kp, nbar, lds);
    do_layer<3>(kp, nbar, lds);
    phase_final(p);
}
#undef p
#undef SYNC

extern "C" void kernel_launch(void* const* d_in, const int* in_sizes, int n_in, void* d_out, int out_size, void* d_ws, size_t ws_size, hipStream_t stream) {
    static int grid = 0;
    if (grid == 0) {
        if (n_in != 30 || ws_size < WS_NEED || out_size != NB * SEQ * DM) { fprintf(stderr, "kernel_launch: unexpected problem shape (n_in %d ws %zu out %d)\n", n_in, ws_size, out_size); grid = -1; return; }
        int dev = 0, cus = 0, per_cu = 0;
        hipGetDevice(&dev);
        hipDeviceGetAttribute(&cus, hipDeviceAttributeMultiprocessorCount, dev);
        hipFuncSetAttribute((const void*)mega, hipFuncAttributeMaxDynamicSharedMemorySize, LDS_BYTES);
        hipOccupancyMaxActiveBlocksPerMultiprocessor(&per_cu, (const void*)mega, NTHR, LDS_BYTES);
        if (per_cu < 1) per_cu = 1;
        if (per_cu > 1) per_cu = 1;
        grid = cus * per_cu;
    }
    if (grid < 0) return;
    Params p{};
    for (int i = 0; i < 30; ++i) p.in[i] = (const float*)d_in[i];
    p.out = (float*)d_out; p.ws = (unsigned char*)d_ws;
    hipMemsetAsync((char*)d_ws + OFF_BAR, 0, 256, stream);
    void* args[] = {&p};
    hipError_t e = hipLaunchCooperativeKernel((const void*)mega, dim3(grid), dim3(NTHR), args, LDS_BYTES, stream);
    if (e != hipSuccess) fprintf(stderr, "cooperative launch failed: %s (grid %d)\n", hipGetErrorString(e), grid);
}
```

```cpp
#include <hip/hip_runtime.h>
#include <hip/hip_cooperative_groups.h>
#include <cstdio>
#include <cstdint>
namespace cg = cooperative_groups;

#define DEV __device__ __forceinline__
typedef unsigned short u16;
typedef short bf16x8 __attribute__((ext_vector_type(8)));
typedef float f32x4 __attribute__((ext_vector_type(4)));
typedef const __attribute__((address_space(4))) float* cfp;
typedef const __attribute__((address_space(4))) unsigned* cup;

constexpr int DM = 1024, NB = 2, SEQ = 16384, NCTX = 256, RPB = SEQ + NCTX, MROWS = NB * RPB;
constexpr int FFH = 2816, ZDW = 1792;
constexpr float LOG2E = 1.4426950408889634f;
constexpr int NTHR = 512, NWAVE = 8;
constexpr int LDS_BYTES = 132096;

constexpr size_t MiB = 1u << 20;
constexpr size_t OFF_MOD = 0;
constexpr size_t OFF_ROPE = 512 * 1024;
constexpr size_t OFF_XC = 1 * MiB;
constexpr size_t OFF_WB = 3 * MiB;
constexpr size_t OFF_AO = 29 * MiB;
constexpr size_t OFF_HN = 94 * MiB;
constexpr size_t OFF_RAW = 159 * MiB;
constexpr size_t OFF_ZD = 257 * MiB;
constexpr size_t SZ_H = (size_t)RPB * 512 * 2;
constexpr size_t OFF_DEC = 94 * MiB;
constexpr size_t OFF_KD = OFF_DEC + 4 * SZ_H;
constexpr size_t OFF_BQ = OFF_KD + 2 * SZ_H;
constexpr size_t OFF_KK = OFF_BQ + 2 * SZ_H;
constexpr size_t OFF_R = OFF_KK + SZ_H;
constexpr size_t OFF_V = 371 * MiB;
constexpr size_t OFF_G = OFF_V + SZ_H;
constexpr size_t OFF_LA = OFF_G + SZ_H;
constexpr size_t OFF_Y0 = 412 * MiB;
constexpr size_t OFF_PU = OFF_Y0 + 2 * SZ_H;
constexpr size_t WS_NEED = 509 * MiB;
constexpr int NCH = 128, CLEN = 130;
static_assert(OFF_R + SZ_H <= OFF_ZD, "scan map");
static_assert(OFF_LA + SZ_H / 2 <= OFF_Y0, "scan map 2");
static_assert(OFF_PU + 64 * MiB <= WS_NEED, "scan map 3");
static_assert(OFF_RAW + (size_t)MROWS * FFH * 2 <= WS_NEED, "ffn hidden");

struct Params { const float* in[30]; float* out; unsigned char* ws; };
typedef const __attribute__((address_space(4))) Params* PPtr;
DEV int tidx() { int t = threadIdx.x; asm volatile("" : "+v"(t)); return t; }
DEV PPtr launder(PPtr p) { asm volatile("" : "+s"(p)); return p; }

DEV unsigned f2bf(float f) { unsigned u = __float_as_uint(f); return (u + 0x7fffu + ((u >> 16) & 1u)) >> 16; }
DEV float bf2f(u16 h) { return __uint_as_float(((unsigned)h) << 16); }
DEV float bflo(unsigned u) { return __uint_as_float(u << 16); }
DEV float bfhi(unsigned u) { return __uint_as_float(u & 0xffff0000u); }
DEV unsigned pk2(float lo, float hi) { return f2bf(lo) | (f2bf(hi) << 16); }
DEV void unpack8(const uint4 u, float (&f)[8]) {
    f[0] = bflo(u.x); f[1] = bfhi(u.x); f[2] = bflo(u.y); f[3] = bfhi(u.y); f[4] = bflo(u.z); f[5] = bfhi(u.z); f[6] = bflo(u.w); f[7] = bfhi(u.w);
}
DEV uint4 pack8(const float (&f)[8]) { uint4 o; o.x = pk2(f[0], f[1]); o.y = pk2(f[2], f[3]); o.z = pk2(f[4], f[5]); o.w = pk2(f[6], f[7]); return o; }
DEV float wave_sum(float v) {
#pragma unroll
    for (int o = 1; o < 64; o <<= 1) v += __shfl_xor(v, o);
    return v;
}
DEV float* xrow_ptr(PPtr p, int m) {
    int b = m / RPB, q = m - b * RPB;
    return q < SEQ ? p->out + (size_t)(b * SEQ + q) * DM : (float*)(p->ws + OFF_XC) + (size_t)(b * NCTX + (q - SEQ)) * DM;
}
DEV int mod_idx(int m) { int b = m / RPB, q = m - b * RPB; return q < SEQ ? b : 2; }
DEV float sigmoidf_(float x) { return 1.f / (1.f + __expf(-x)); }

DEV void phase_init(PPtr p, char* lds) {
    const int tid = tidx();
    const size_t gt = (size_t)blockIdx.x * NTHR + tid, ng = (size_t)gridDim.x * NTHR;
    {
        const float4* s = (const float4*)p->in[0]; float4* d = (float4*)p->out;
        const size_t n = (size_t)NB * SEQ * DM / 4;
        for (size_t i = gt; i < n; i += ng) d[i] = s[i];
        const float4* s2 = (const float4*)p->in[2]; float4* d2 = (float4*)(p->ws + OFF_XC);
        const size_t n2 = (size_t)NB * NCTX * DM / 4;
        for (size_t i = gt; i < n2; i += ng) d2[i] = s2[i];
    }
    {
        float* T = (float*)(p->ws + OFF_ROPE);
        for (size_t i = gt; i < 5120; i += ng) {
            const int pos = (int)(i >> 4), f = (int)(i & 15);
            const float inv = powf(10000.f, -(float)f / 16.f);
            if (pos < 256) { const float ang = (float)pos * inv; T[pos * 16 + f] = cosf(ang); T[4096 + pos * 16 + f] = sinf(ang); }
            else { const float ang = (float)(pos - 256) * inv; T[8192 + (pos - 256) * 16 + f] = cosf(ang); T[9216 + (pos - 256) * 16 + f] = sinf(ang); }
        }
    }
    float* red = (float*)lds;
    float* mod = (float*)(p->ws + OFF_MOD);
    const float* c = p->in[1]; const float* cc = p->in[3];
    for (int item = blockIdx.x; item < 192; item += gridDim.x) {
        const int l = item / 48, n0 = (item % 48) * 128, col = tid & 127, kp = tid >> 7;
        const float* w = p->in[4] + (size_t)l * DM * 6144 + n0 + col;
        float a0 = 0.f, a1 = 0.f, a2 = 0.f;
        for (int k = kp * 256; k < kp * 256 + 256; ++k) {
            const float wv = w[(size_t)k * 6144];
            const float c0 = c[k], c1 = c[DM + k], c2 = cc[k];
            a0 += c0 * sigmoidf_(c0) * wv; a1 += c1 * sigmoidf_(c1) * wv; a2 += c2 * sigmoidf_(c2) * wv;
        }
        red[(kp * 3 + 0) * 128 + col] = a0; red[(kp * 3 + 1) * 128 + col] = a1; red[(kp * 3 + 2) * 128 + col] = a2;
        __syncthreads();
        if (tid < 384) {
            const int mb = tid >> 7, cl = tid & 127;
            float s = red[(0 * 3 + mb) * 128 + cl] + red[(1 * 3 + mb) * 128 + cl] + red[(2 * 3 + mb) * 128 + cl] + red[(3 * 3 + mb) * 128 + cl];
            mod[(size_t)(l * 3 + mb) * 6144 + n0 + cl] = s + p->in[5][l * 6144 + n0 + cl];
        }
        __syncthreads();
    }
}

DEV void phase_normmod(PPtr p, int layer, int which) {
    const int lane = tidx() & 63, gw = blockIdx.x * NWAVE + (tidx() >> 6), ngw = gridDim.x * NWAVE;
    const float* gain = p->in[which ? 7 : 6] + layer * DM;
    const float* mod = (const float*)(p->ws + OFF_MOD) + (size_t)layer * 3 * 6144;
    u16* HN = (u16*)(p->ws + OFF_HN);
    for (int m = gw; m < MROWS; m += ngw) {
        const float* xr = xrow_ptr(p, m);
        const float* md = mod + mod_idx(m) * 6144 + (which ? 3072 : 0);
        float4 v[4]; float ss = 0.f;
#pragma unroll
        for (int j = 0; j < 4; ++j) { v[j] = ((const float4*)xr)[lane + 64 * j]; ss += v[j].x * v[j].x + v[j].y * v[j].y + v[j].z * v[j].z + v[j].w * v[j].w; }
        ss = wave_sum(ss);
        const float rstd = rsqrtf(ss * (1.f / DM) + 1e-6f);
#pragma unroll
        for (int j = 0; j < 4; ++j) {
            const int k = (lane + 64 * j) * 4;
            const float4 g = *(const float4*)(gain + k), sh = *(const float4*)(md + k), sc = *(const float4*)(md + 1024 + k);
            const float o0 = v[j].x * rstd * g.x * (1.f + sc.x) + sh.x, o1 = v[j].y * rstd * g.y * (1.f + sc.y) + sh.y;
            const float o2 = v[j].z * rstd * g.z * (1.f + sc.z) + sh.z, o3 = v[j].w * rstd * g.w * (1.f + sc.w) + sh.w;
            uint2 w; w.x = pk2(o0, o1); w.y = pk2(o2, o3);
            *(uint2*)(HN + (size_t)m * DM + k) = w;
        }
    }
}

template <int DUAL, class Epi>
DEV void gemm_simple(const u16* A, int lda, const float* W, int ldw, int dualoff, int M, int N, int K, const Epi& epi, char* lds) {
    u16* sA = (u16*)lds; u16* sB = sA + 128 * 40; u16* sB2 = sB + 128 * 40;
    const int tid = tidx(), lane = tid & 63, wave = tid >> 6, wm = wave >> 2, wn = wave & 3, r16 = lane & 15, quad = lane >> 4;
    const int mt = M / 128, nt = N / 128;
    for (int item = blockIdx.x; item < mt * nt; item += gridDim.x) {
        const int tn = item / mt, tm = item - tn * mt, m0 = tm * 128, n0 = tn * 128;
        f32x4 acc[4][2], acc2[4][2];
#pragma unroll
        for (int a = 0; a < 4; ++a)
#pragma unroll
            for (int b = 0; b < 2; ++b) { acc[a][b] = (f32x4){0.f, 0.f, 0.f, 0.f}; acc2[a][b] = (f32x4){0.f, 0.f, 0.f, 0.f}; }
        for (int k0 = 0; k0 < K; k0 += 32) {
            {
                const int row = tid >> 2, kc = (tid & 3) * 8;
                const uint4 v = *(const uint4*)(A + (size_t)(m0 + row) * lda + k0 + kc);
                *(uint4*)(sA + row * 40 + kc) = v;
            }
            {
                const int kk = tid >> 4, nc = (tid & 15) * 8;
                const float* wp = W + (size_t)(k0 + kk) * ldw + n0 + nc;
                const float4 a = *(const float4*)wp, b = *(const float4*)(wp + 4);
                sB[(nc + 0) * 40 + kk] = (u16)f2bf(a.x); sB[(nc + 1) * 40 + kk] = (u16)f2bf(a.y); sB[(nc + 2) * 40 + kk] = (u16)f2bf(a.z); sB[(nc + 3) * 40 + kk] = (u16)f2bf(a.w);
                sB[(nc + 4) * 40 + kk] = (u16)f2bf(b.x); sB[(nc + 5) * 40 + kk] = (u16)f2bf(b.y); sB[(nc + 6) * 40 + kk] = (u16)f2bf(b.z); sB[(nc + 7) * 40 + kk] = (u16)f2bf(b.w);
                if (DUAL) {
                    const float4 c = *(const float4*)(wp + dualoff), d = *(const float4*)(wp + dualoff + 4);
                    sB2[(nc + 0) * 40 + kk] = (u16)f2bf(c.x); sB2[(nc + 1) * 40 + kk] = (u16)f2bf(c.y); sB2[(nc + 2) * 40 + kk] = (u16)f2bf(c.z); sB2[(nc + 3) * 40 + kk] = (u16)f2bf(c.w);
                    sB2[(nc + 4) * 40 + kk] = (u16)f2bf(d.x); sB2[(nc + 5) * 40 + kk] = (u16)f2bf(d.y); sB2[(nc + 6) * 40 + kk] = (u16)f2bf(d.z); sB2[(nc + 7) * 40 + kk] = (u16)f2bf(d.w);
                }
            }
            __syncthreads();
            bf16x8 af[4], bfr[2], bfr2[2];
#pragma unroll
            for (int mi = 0; mi < 4; ++mi) af[mi] = *(const bf16x8*)(sA + (wm * 64 + mi * 16 + r16) * 40 + quad * 8);
#pragma unroll
            for (int ni = 0; ni < 2; ++ni) {
                bfr[ni] = *(const bf16x8*)(sB + (wn * 32 + ni * 16 + r16) * 40 + quad * 8);
                if (DUAL) bfr2[ni] = *(const bf16x8*)(sB2 + (wn * 32 + ni * 16 + r16) * 40 + quad * 8);
            }
#pragma unroll
            for (int mi = 0; mi < 4; ++mi)
#pragma unroll
                for (int ni = 0; ni < 2; ++ni) {
                    acc[mi][ni] = __builtin_amdgcn_mfma_f32_16x16x32_bf16(af[mi], bfr[ni], acc[mi][ni], 0, 0, 0);
                    if (DUAL) acc2[mi][ni] = __builtin_amdgcn_mfma_f32_16x16x32_bf16(af[mi], bfr2[ni], acc2[mi][ni], 0, 0, 0);
                }
            __syncthreads();
        }
#pragma unroll
        for (int mi = 0; mi < 4; ++mi)
#pragma unroll
            for (int ni = 0; ni < 2; ++ni)
#pragma unroll
                for (int j = 0; j < 4; ++j) {
                    const int row = m0 + wm * 64 + mi * 16 + quad * 4 + j, col = n0 + wn * 32 + ni * 16 + r16;
                    epi(row, col, acc[mi][ni][j], DUAL ? acc2[mi][ni][j] : 0.f);
                }
    }
}

struct EpiStore { u16* O; int ld; DEV void operator()(int r, int c, float v, float) const { O[(size_t)r * ld + c] = (u16)f2bf(v); } };
struct EpiStoreOdd { u16* Q; u16* Z;
    DEV void operator()(int r, int c, float v, float) const { if (c < 1536) Q[(size_t)r * 1536 + c] = (u16)f2bf(v); else Z[(size_t)r * ZDW + (c - 1536)] = (u16)f2bf(v); } };
struct EpiResid { PPtr p; const float* gate;
    DEV void operator()(int r, int c, float v, float) const { float* xr = xrow_ptr(p, r); xr[c] += gate[mod_idx(r) * 6144 + c] * v; } };
struct EpiSwiglu { u16* H;
    DEV void operator()(int r, int c, float g, float u) const { H[(size_t)r * FFH + c] = (u16)f2bf(g * sigmoidf_(g) * u); } };


namespace pg8 {
#define PG8_LAS __attribute__((address_space(3)))
typedef unsigned short bf16_t;
typedef short bf16x8 __attribute__((ext_vector_type(8)));
typedef float f32x4 __attribute__((ext_vector_type(4)));
typedef unsigned u32x4 __attribute__((ext_vector_type(4)));
constexpr int BM = 256, BK = 64, HALF = 128, HTB = HALF * BK * 2  , STAGE_BYTES = 8 * HTB, NXCD = 8, WGM = 8;

__host__ __device__ __forceinline__ int lds_byte(int r, int c) { const int st = (r >> 4) * 2 + (c >> 5), rr = r & 15, cc = c & 31, ob = rr * 64 + cc * 2; return st * 1024 + (ob ^ (((ob >> 9) & 1) << 5)); }
__host__ __device__ __forceinline__ void stage_rc(int b, int& R, int& C) { const int st = b / 1024, sb = b % 1024, swz = sb ^ (((sb >> 9) & 1) << 5); R = (st >> 1) * 16 + swz / 64; C = (st & 1) * 32 + (swz % 64) / 2; }
__host__ __device__ __forceinline__ int perm32(int rho) { const int n = rho >> 4, i = rho & 15; return 8 * (i >> 2) + 4 * n + (i & 3); }

struct Unit { int pm, pn; };
struct Gemm { const bf16_t* A; const bf16_t* Bt; int M, N, K; };

struct StaticOrder {
    int nM, nN, nwg, G, c;
    __host__ __device__ void init(int M, int N, int G_, int c_) { nM = M / BM; nN = N / BM; nwg = nM * nN; G = G_; c = c_; }
    __host__ __device__ bool next(int i, Unit& u) const {
        const long L = (long)i * G + c; if (L >= nwg) return false;
        int wgid = (int)L; { const int q = nwg / NXCD, r = nwg % NXCD, xcd = wgid % NXCD, off = wgid / NXCD; wgid = (xcd < r ? xcd * (q + 1) : r * (q + 1) + (xcd - r) * q) + off; }
        const int nig = WGM * nN, gid = wgid / nig, fm = gid * WGM, gsz = (nM - fm) < WGM ? (nM - fm) : WGM;
        u.pm = fm + ((wgid % nig) % gsz); u.pn = (wgid % nig) / gsz; return true;
    }
    __device__ __forceinline__ void a_ready(const Unit&) const {}
    __device__ __forceinline__ void done(const Unit&) const {}
};
struct LatentOrder {
    StaticOrder S;
    __host__ __device__ void init(int N, int G_, int c_) { S.init(32768, N, G_, c_); }
    __host__ __device__ bool next(int i, Unit& u) const { if (!S.next(i, u)) return false; u.pm = u.pm < 64 ? u.pm : u.pm + 1; return true; }
    __device__ __forceinline__ void a_ready(const Unit&) const {}
    __device__ __forceinline__ void done(const Unit&) const {}
};

__device__ __forceinline__ unsigned cvt_pk_bf16(float lo, float hi) { unsigned r; asm volatile("v_cvt_pk_bf16_f32 %0, %1, %2" : "=v"(r) : "v"(lo), "v"(hi)); return r; }
template <class Epi, class Sched, bool ALIGN_EPI = false, bool SP2 = false>
__device__ __forceinline__ void gemm_phase(PG8_LAS unsigned char* lds, const Gemm g, const Sched& S, const Epi& E) {
    const int tid = tidx(), wid = __builtin_amdgcn_readfirstlane(tid >> 6), lane = tid & 63, wr = wid >> 2, wc = wid & 3, fr = lane & 15, fq = lane >> 4;
    const int K = g.K, nt = K / BK;
    unsigned voffA[2], voffB[2];
#pragma unroll
    for (int i = 0; i < 2; ++i) { int R, C; stage_rc(tid * 16 + i * 8192, R, C); const int Rb = Epi::PERM ? ((R & ~31) + perm32(R & 31)) : R;
        voffA[i] = (unsigned)(R * K + C) * 2u; voffB[i] = (unsigned)(Rb * K + C) * 2u; }
    const size_t kstep = (size_t)(BK * 2);
    const size_t hstep = (size_t)HALF * K * 2;
    const size_t tstep = 2 * hstep;
    const unsigned ldsw = (unsigned)wid * 1024u;
    const int aoff = lds_byte(wr * 64 + fr, fq * 8), boff = lds_byte(wc * 32 + fr, fq * 8);
#define PG8_SA(b, h) (((b) * 2 + (h)) * HTB)
#define PG8_SB(b, h) ((4 + (b) * 2 + (h)) * HTB)
#define PG8_STAGE(bufoff, gbase, voff) do { _Pragma("unroll") for (int _i = 0; _i < 2; ++_i) \
        __builtin_amdgcn_global_load_lds((const unsigned*)((const char*)(gbase) + (voff)[_i]), (PG8_LAS unsigned*)(lds + (bufoff) + ldsw + _i * 8192), 16, 0, 0); } while (0)
#define PG8_LDA(dst, b, h) do { _Pragma("unroll") for (int m = 0; m < 4; ++m) _Pragma("unroll") for (int k = 0; k < 2; ++k) dst[m][k] = *(const PG8_LAS bf16x8*)(lds + PG8_SA(b, h) + aoff + m * 2048 + k * 1024); } while (0)
#define PG8_LDB(dst, b, h) do { _Pragma("unroll") for (int n = 0; n < 2; ++n) _Pragma("unroll") for (int k = 0; k < 2; ++k) dst[n][k] = *(const PG8_LAS bf16x8*)(lds + PG8_SB(b, h) + boff + n * 2048 + k * 1024); } while (0)
#define PG8_MMA(ai, bj, At, Bt) do { __builtin_amdgcn_s_setprio(1); _Pragma("unroll") for (int m = 0; m < 4; ++m) _Pragma("unroll") for (int n = 0; n < 2; ++n) _Pragma("unroll") for (int k = 0; k < 2; ++k) \
        acc[ai][bj][m][n] = __builtin_amdgcn_mfma_f32_16x16x32_bf16(Bt[n][k], At[m][k], acc[ai][bj][m][n], 0, 0, 0); __builtin_amdgcn_s_setprio(0); } while (0)
#define PG8_WAIT_V(n) asm volatile("s_waitcnt vmcnt(" #n ")" ::: "memory")
#define PG8_WAIT_L(n) asm volatile("s_waitcnt lgkmcnt(" #n ")" ::: "memory")
#define PG8_BAR __builtin_amdgcn_s_barrier()
#define PG8_SCHED __builtin_amdgcn_sched_barrier(0)
    Unit cur, nxt; int ui = 0;
    if (!S.next(0, cur)) return;
    f32x4 acc[2][2][4][2];
#pragma unroll
    for (int a = 0; a < 2; ++a)
#pragma unroll
        for (int b = 0; b < 2; ++b)
#pragma unroll
            for (int m = 0; m < 4; ++m)
#pragma unroll
                for (int n = 0; n < 2; ++n) acc[a][b][m][n] = (f32x4){0.f, 0.f, 0.f, 0.f};
    bf16x8 At[4][2], B0[2][2], B1[2][2];
    const char* cA = (const char*)g.A + (size_t)cur.pm * tstep; const char* cB = (const char*)g.Bt + (size_t)cur.pn * tstep;
    S.a_ready(cur);
    if constexpr (SP2) {
        PG8_STAGE(PG8_SB(0, 0), cB, voffB); PG8_STAGE(PG8_SB(0, 1), cB + hstep, voffB); PG8_STAGE(PG8_SA(0, 0), cA, voffA); PG8_STAGE(PG8_SA(0, 1), cA + hstep, voffA);
        if (wr == 1) PG8_BAR;
        PG8_WAIT_V(2); PG8_BAR;
        PG8_STAGE(PG8_SB(1, 0), cB + kstep, voffB); PG8_STAGE(PG8_SA(1, 0), cA + kstep, voffA); PG8_STAGE(PG8_SB(1, 1), cB + hstep + kstep, voffB);
        PG8_WAIT_V(6); PG8_BAR;
    } else {
        PG8_STAGE(PG8_SB(0, 0), cB, voffB); PG8_STAGE(PG8_SA(0, 0), cA, voffA); PG8_STAGE(PG8_SB(0, 1), cB + hstep, voffB); PG8_STAGE(PG8_SA(0, 1), cA + hstep, voffA);
        if (wr == 1) PG8_BAR;
        PG8_WAIT_V(4); PG8_BAR;
        PG8_STAGE(PG8_SB(1, 0), cB + kstep, voffB); PG8_STAGE(PG8_SA(1, 0), cA + kstep, voffA); PG8_STAGE(PG8_SB(1, 1), cB + hstep + kstep, voffB);
        PG8_WAIT_V(6); PG8_BAR;
    }
    for (;;) {
        const bool has_next = S.next(ui + 1, nxt);
        const char* nA = has_next ? (const char*)g.A + (size_t)nxt.pm * tstep : cA; const char* nB = has_next ? (const char*)g.Bt + (size_t)nxt.pn * tstep : cB;
        for (int t = 0; t < nt; t += 2) {
            const bool last = (t == nt - 2);
            const char* a1 = cA + (size_t)(t + 1) * kstep;
            const char* a2 = last ? nA : cA + (size_t)(t + 2) * kstep; const char* b2 = last ? nB : cB + (size_t)(t + 2) * kstep;
            const char* a3 = a2 + kstep; const char* b3 = b2 + kstep;
            if (last && has_next) S.a_ready(nxt);
            if constexpr (SP2) {
            PG8_LDB(B0, 0, 0); PG8_LDB(B1, 0, 1); PG8_SCHED; PG8_LDA(At, 0, 0); PG8_STAGE(PG8_SA(1, 1), a1 + hstep, voffA);
            PG8_WAIT_V(8); PG8_WAIT_L(0); PG8_BAR; PG8_MMA(0, 0, At, B0); PG8_MMA(0, 1, At, B1); PG8_BAR; PG8_SCHED;
            PG8_LDA(At, 0, 1); PG8_STAGE(PG8_SB(0, 0), b2, voffB); PG8_STAGE(PG8_SB(0, 1), b2 + hstep, voffB); PG8_STAGE(PG8_SA(0, 0), a2, voffA);
            PG8_WAIT_V(8); PG8_WAIT_L(0); PG8_BAR; PG8_MMA(1, 0, At, B0); PG8_MMA(1, 1, At, B1); PG8_BAR; PG8_SCHED;
            PG8_LDB(B0, 1, 0); PG8_LDB(B1, 1, 1); PG8_SCHED; PG8_LDA(At, 1, 0); PG8_STAGE(PG8_SA(0, 1), a2 + hstep, voffA);
            PG8_WAIT_V(8); PG8_WAIT_L(0); PG8_BAR; PG8_MMA(0, 0, At, B0); PG8_MMA(0, 1, At, B1); PG8_BAR; PG8_SCHED;
            PG8_LDA(At, 1, 1); PG8_STAGE(PG8_SB(1, 0), b3, voffB); PG8_STAGE(PG8_SB(1, 1), b3 + hstep, voffB); PG8_STAGE(PG8_SA(1, 0), a3, voffA);
            PG8_WAIT_V(8); PG8_WAIT_L(0); PG8_BAR; PG8_MMA(1, 0, At, B0); PG8_MMA(1, 1, At, B1); PG8_BAR; PG8_SCHED;
            } else {
            PG8_LDB(B0, 0, 0); PG8_SCHED; PG8_LDA(At, 0, 0); PG8_STAGE(PG8_SA(1, 1), a1 + hstep, voffA);
            PG8_WAIT_L(8); PG8_BAR; PG8_WAIT_L(0); PG8_MMA(0, 0, At, B0); PG8_BAR; PG8_SCHED;
            PG8_LDB(B1, 0, 1); PG8_STAGE(PG8_SB(0, 0), b2, voffB);
            PG8_BAR; PG8_WAIT_L(0); PG8_MMA(0, 1, At, B1); PG8_BAR;
            PG8_LDA(At, 0, 1); PG8_STAGE(PG8_SA(0, 0), a2, voffA);
            PG8_BAR; PG8_WAIT_L(0); PG8_MMA(1, 0, At, B0); PG8_BAR; PG8_SCHED;
            PG8_STAGE(PG8_SB(0, 1), b2 + hstep, voffB);
            PG8_WAIT_V(6); PG8_BAR; PG8_MMA(1, 1, At, B1); PG8_BAR;
            PG8_LDB(B0, 1, 0); PG8_SCHED; PG8_LDA(At, 1, 0); PG8_STAGE(PG8_SA(0, 1), a2 + hstep, voffA);
            PG8_WAIT_L(8); PG8_BAR; PG8_WAIT_L(0); PG8_MMA(0, 0, At, B0); PG8_BAR; PG8_SCHED;
            PG8_LDB(B1, 1, 1); PG8_STAGE(PG8_SB(1, 0), b3, voffB);
            PG8_BAR; PG8_WAIT_L(0); PG8_MMA(0, 1, At, B1); PG8_BAR;
            PG8_LDA(At, 1, 1); PG8_STAGE(PG8_SA(1, 0), a3, voffA);
            PG8_BAR; PG8_WAIT_L(0); PG8_MMA(1, 0, At, B0); PG8_BAR; PG8_SCHED;
            PG8_STAGE(PG8_SB(1, 1), b3 + hstep, voffB);
            PG8_WAIT_V(6); PG8_BAR; PG8_MMA(1, 1, At, B1); PG8_BAR;
            }
        }
        if constexpr (ALIGN_EPI) { if (wr == 0) PG8_BAR; }
        if constexpr (!Epi::AFTER_DRAIN) { E(acc, cur, wr, wc, fr, fq); S.done(cur); }
        if (!has_next) break;
#pragma unroll
        for (int a = 0; a < 2; ++a)
#pragma unroll
            for (int b = 0; b < 2; ++b)
#pragma unroll
                for (int m = 0; m < 4; ++m)
#pragma unroll
                    for (int n = 0; n < 2; ++n) acc[a][b][m][n] = (f32x4){0.f, 0.f, 0.f, 0.f};
        cur = nxt; cA = nA; cB = nB; ++ui;
        if constexpr (ALIGN_EPI) { if (wr == 1) PG8_BAR; }
    }
    PG8_WAIT_V(0);
    if constexpr (!ALIGN_EPI) { if (wr == 0) PG8_BAR; }
    PG8_BAR;
    if constexpr (Epi::AFTER_DRAIN) { E.fused(acc, cur, wr, wc, fr, fq, lds, wid, lane); S.done(cur); }
#undef PG8_SA
#undef PG8_SB
#undef PG8_STAGE
#undef PG8_LDA
#undef PG8_LDB
#undef PG8_MMA
#undef PG8_WAIT_V
#undef PG8_WAIT_L
#undef PG8_BAR
#undef PG8_SCHED
}

struct EpiStoreT {
    static constexpr bool PERM = true, AFTER_DRAIN = false;
    bf16_t* O0; int ld0; int split; bf16_t* O1; int ld1;
    __device__ __forceinline__ void operator()(const f32x4 (&acc)[2][2][4][2], const Unit& u, int wr, int wc, int fr, int fq) const {
        const int row0 = u.pm * BM + wr * 64 + fr; int colt = u.pn * BM; bf16_t* base = O0; int ld = ld0;
        if (colt >= split) { base = O1; ld = ld1; colt -= split; }
        const int col0 = colt + wc * 32 + 8 * fq;
#pragma unroll
        for (int ai = 0; ai < 2; ++ai)
#pragma unroll
            for (int m = 0; m < 4; ++m) { bf16_t* rowp = base + (size_t)(row0 + ai * HALF + m * 16) * ld + col0;
#pragma unroll
                for (int bj = 0; bj < 2; ++bj) { const f32x4 v0 = acc[ai][bj][m][0], v1 = acc[ai][bj][m][1];
                    u32x4 w; w.x = cvt_pk_bf16(v0[0], v0[1]); w.y = cvt_pk_bf16(v0[2], v0[3]); w.z = cvt_pk_bf16(v1[0], v1[1]); w.w = cvt_pk_bf16(v1[2], v1[3]);
                    *(u32x4*)(rowp + bj * HALF) = w; } }
    }
};
struct EpiResidT {
    static constexpr bool PERM = true, AFTER_DRAIN = false;
    PPtr p; const float* gate;
    __device__ __forceinline__ void operator()(const f32x4 (&acc)[2][2][4][2], const Unit& u, int wr, int wc, int fr, int fq) const {
        float* xb = xrow_ptr(p, u.pm * BM); const float* g = gate + mod_idx(u.pm * BM) * 6144;
        const int col0 = u.pn * BM + wc * 32 + 8 * fq;
#pragma unroll
        for (int ai = 0; ai < 2; ++ai)
#pragma unroll
            for (int m = 0; m < 4; ++m) { float* xr = xb + (size_t)(ai * HALF + wr * 64 + m * 16 + fr) * DM;
#pragma unroll
                for (int bj = 0; bj < 2; ++bj) { const int col = col0 + bj * HALF; const f32x4 v0 = acc[ai][bj][m][0], v1 = acc[ai][bj][m][1];
                    const f32x4 g0 = *(const f32x4*)(g + col), g1 = *(const f32x4*)(g + col + 4);
                    f32x4 x0 = *(const f32x4*)(xr + col), x1 = *(const f32x4*)(xr + col + 4);
                    x0 += g0 * v0; x1 += g1 * v1;
                    *(f32x4*)(xr + col) = x0; *(f32x4*)(xr + col + 4) = x1; } }
    }
};
struct EpiSwigluT {
    static constexpr bool PERM = true, AFTER_DRAIN = false;
    bf16_t* H;
    __device__ __forceinline__ void operator()(const f32x4 (&acc)[2][2][4][2], const Unit& u, int wr, int wc, int fr, int fq) const {
        const int row0 = u.pm * BM + wr * 64 + fr; const int col0 = u.pn * BM + wc * 32 + 8 * fq;
#pragma unroll
        for (int ai = 0; ai < 2; ++ai)
#pragma unroll
            for (int m = 0; m < 4; ++m) { bf16_t* rowp = H + (size_t)(row0 + ai * HALF + m * 16) * FFH;
#pragma unroll
                for (int bj = 0; bj < 2; ++bj) { const f32x4 gt = acc[ai][bj][m][0], up = acc[ai][bj][m][1];
                    float h[4];
#pragma unroll
                    for (int j = 0; j < 4; ++j) h[j] = gt[j] * sigmoidf_(gt[j]) * up[j];
                    uint2 w; w.x = cvt_pk_bf16(h[0], h[1]); w.y = cvt_pk_bf16(h[2], h[3]);
                    *(uint2*)(rowp + ((col0 + bj * HALF) >> 1)) = w; } }
    }
};

struct EpiLoraT {
    static constexpr bool PERM = true, AFTER_DRAIN = false;
    float* DEC; bf16_t* KD; bf16_t* BQ; bf16_t* G; const bf16_t* KK; const bf16_t* ZDb;
    const float* w0; const float* a0; const float* ka; const float* muk;
    template <int TYPE>
    __device__ __forceinline__ void one(const f32x4 v, int r, int c, int d) const {
        if (TYPE == 0) {
            const float4 wa = *(const float4*)(w0 + d * 512 + c);
            const float ww[4] = {wa.x, wa.y, wa.z, wa.w};
            float o[4];
#pragma unroll
            for (int e = 0; e < 4; ++e) { const float x = -(ww[e] + v[e]); const float sp = x > 20.f ? x : __logf(1.f + __expf(x)); o[e] = __expf(-__expf(-sp - 0.5f)); }
            *(float4*)(DEC + ((size_t)r * 2 + d) * 512 + c) = (float4){o[0], o[1], o[2], o[3]};
        } else if (TYPE == 1) {
            const float4 aa = *(const float4*)(a0 + d * 512 + c), ka0 = *(const float4*)(ka + c), m0 = *(const float4*)(muk + c);
            const float a0v[4] = {aa.x, aa.y, aa.z, aa.w}, kav[4] = {ka0.x, ka0.y, ka0.z, ka0.w}, mm[4] = {m0.x, m0.y, m0.z, m0.w};
            const bool lat = r < SEQ; const int lo = lat ? 0 : SEQ, hi = lat ? SEQ : RPB;
            const bf16_t* zc = ZDb + (size_t)r * ZDW + 512 + c;
            const bool hp = r - 1 >= lo, hn = r + 1 < hi;
            const uint2 uz = *(const uint2*)zc, up = *(const uint2*)(hp ? zc - ZDW : zc), un = *(const uint2*)(hn ? zc + ZDW : zc), uk = *(const uint2*)(KK + (size_t)r * 512 + c);
            const float z[4] = {bflo(uz.x), bfhi(uz.x), bflo(uz.y), bfhi(uz.y)}, zp[4] = {bflo(up.x), bfhi(up.x), bflo(up.y), bfhi(up.y)};
            const float zn[4] = {bflo(un.x), bfhi(un.x), bflo(un.y), bfhi(un.y)}, kk[4] = {bflo(uk.x), bfhi(uk.x), bflo(uk.y), bfhi(uk.y)};
            const float fp = hp ? 0.5f : 0.f, fn = hn ? 0.5f : 0.f;
            float okd[4], obq[4];
#pragma unroll
            for (int e = 0; e < 4; ++e) {
                const float a = sigmoidf_(a0v[e] + v[e]);
                const float k = z[e] + ((fp * zp[e] + fn * zn[e]) - z[e]) * mm[e];
                okd[e] = k * (1.f + (a - 1.f) * kav[e]); obq[e] = kk[e] * a;
            }
            uint2 w1; w1.x = pk2(okd[0], okd[1]); w1.y = pk2(okd[2], okd[3]); *(uint2*)(KD + ((size_t)r * 2 + d) * 512 + c) = w1;
            uint2 w2; w2.x = pk2(obq[0], obq[1]); w2.y = pk2(obq[2], obq[3]); *(uint2*)(BQ + ((size_t)r * 2 + d) * 512 + c) = w2;
        } else {
            uint2 w; w.x = pk2(v[0], v[1]); w.y = pk2(v[2], v[3]); *(uint2*)(G + (size_t)r * 512 + c) = w;
        }
    }
    template <int TYPE>
    __device__ __forceinline__ void all(const f32x4 (&acc)[2][2][4][2], const Unit& u, int wr, int wc, int fr, int fq) const {
        const int d = (u.pn >> 1) & 1, cb = (u.pn & 1) * 256 + wc * 32 + 8 * fq;
#pragma unroll
        for (int ai = 0; ai < 2; ++ai)
#pragma unroll
            for (int m = 0; m < 4; ++m)
#pragma unroll
                for (int bj = 0; bj < 2; ++bj)
                {   const int r = u.pm * BM + ai * HALF + wr * 64 + m * 16 + fr, c = cb + bj * HALF;
                    one<TYPE>(acc[ai][bj][m][0], r, c, d); one<TYPE>(acc[ai][bj][m][1], r, c + 4, d); }
    }
    __device__ __forceinline__ void operator()(const f32x4 (&acc)[2][2][4][2], const Unit& u, int wr, int wc, int fr, int fq) const {
        const int type = u.pn >> 1;
        if (type < 2) all<0>(acc, u, wr, wc, fr, fq); else if (type < 4) all<1>(acc, u, wr, wc, fr, fq); else all<2>(acc, u, wr, wc, fr, fq);
    }
};
}

DEV void transpose_item(const float* W, int K, int N, u16* WT, int mode, float* scr, int item, int lane) {
    const int nblk = N / 32, kb = item / nblk, nb = item - kb * nblk, k0 = 64 * kb, n0 = 32 * nb;
#pragma unroll 8
    for (int i = 0; i < 32; ++i) { const int kk = 2 * i + (lane >> 5); scr[kk * 33 + (lane & 31)] = W[(size_t)(k0 + kk) * N + n0 + (lane & 31)]; }
    asm volatile("s_waitcnt lgkmcnt(0)" ::: "memory");
    const int c = lane & 7;
#pragma unroll
    for (int j = 0; j < 4; ++j) {
        const int n = (lane >> 3) + 8 * j; const float* sp = scr + (8 * c) * 33 + n;
        uint4 o; o.x = pk2(sp[0 * 33], sp[1 * 33]); o.y = pk2(sp[2 * 33], sp[3 * 33]); o.z = pk2(sp[4 * 33], sp[5 * 33]); o.w = pk2(sp[6 * 33], sp[7 * 33]);
        const int ns = n0 + n;
        int drow = ns;
        if (mode) { const int nn = ns >= FFH ? 1 : 0; const int g = ns - nn * FFH; drow = 8 * (g >> 2) + 4 * nn + (g & 3); }
        *(uint4*)(WT + (size_t)drow * K + k0 + 8 * c) = o;
    }
    asm volatile("s_waitcnt lgkmcnt(0)" ::: "memory");
}
constexpr size_t WB_IN = 0, WB_OUT = (size_t)3328 * 1024, WB_F1 = WB_OUT + (size_t)1024 * 1024, WB_F2 = WB_F1 + (size_t)5632 * 1024;
DEV void phase_wprep(PPtr p, int layer, char* lds) {
    const int tid = tidx(), lane = tid & 63, wave = tid >> 6, gw = blockIdx.x * NWAVE + wave, ngw = gridDim.x * NWAVE;
    float* scr = (float*)lds + wave * (64 * 33);
    u16* WB = (u16*)(p->ws + OFF_WB);
    const int li = layer >> 1, odd = layer & 1;
    const int nin = odd ? 3328 : 1536;
    const float* win = odd ? p->in[13] + (size_t)li * DM * 3328 : p->in[8] + (size_t)li * DM * 1536;
    const float* wout = (odd ? p->in[14] : p->in[9]) + (size_t)li * DM * DM;
    const float* wf1 = p->in[27] + (size_t)layer * DM * 5632; const float* wf2 = p->in[28] + (size_t)layer * FFH * DM;
    const int i0 = 16 * (nin / 32), i1 = i0 + 16 * 32, i2 = i1 + 16 * 176, i3 = i2 + 44 * 32;
    for (int it = gw; it < i3; it += ngw) {
        if (it < i0) transpose_item(win, DM, nin, WB + WB_IN, 0, scr, it, lane);
        else if (it < i1) transpose_item(wout, DM, DM, WB + WB_OUT, 0, scr, it - i0, lane);
        else if (it < i2) transpose_item(wf1, DM, 5632, WB + WB_F1, 1, scr, it - i1, lane);
        else transpose_item(wf2, FFH, DM, WB + WB_F2, 0, scr, it - i2, lane);
    }
}

#include <hip/hip_bf16.h>
#include <cmath>
namespace attn_body {
using bf16=__hip_bfloat16;
using bf16x8=__attribute__((ext_vector_type(8)))short;
using s16x4=__attribute__((ext_vector_type(4)))short;
using f32x16=__attribute__((ext_vector_type(16)))float;
using u32x4=__attribute__((ext_vector_type(4)))unsigned;
constexpr int D=64,PQ=1536,PO=1024,KROWS=16640,RPBA=16640;
constexpr int NW=8,QBLK=32,QB=QBLK*NW,KVBLK=64;
constexpr int ATTN_UNIT_ROWS=QB;
__device__ __forceinline__ int crow(int r,int hi){return (r&3)+8*(r>>2)+4*hi;}
#define SBAR() __builtin_amdgcn_sched_barrier(0)
__device__ __forceinline__ void cmask(f32x16&p0,f32x16&p1,int jb,int qrel,int hi){
  const float NEG=-INFINITY; int kb=64*jb+4*hi;
  #pragma unroll
  for(int r=0;r<16;++r){int kv=kb+(r&3)+8*(r>>2); if(kv>qrel)p0[r]=NEG; if(kv+32>qrel)p1[r]=NEG;}
}

constexpr int NSLOT=3, SLOTB=8192;
constexpr int LDS_K=0, LDS_V=NSLOT*SLOTB, LDS_WS=2*NSLOT*SLOTB, LDS_OST=LDS_WS+NW*64*4, LDS_BYTES=LDS_OST+NW*4096;
constexpr float C2=0.125f*1.4426950408889634f;
__device__ __forceinline__ void glds16(const void*gsrc,unsigned lds_dst){unsigned keep;
  asm volatile("s_mov_b32 %0, m0\n\ts_mov_b32 m0, %2\n\ts_nop 0\n\tglobal_load_lds_dwordx4 %1, off\n\ts_mov_b32 m0, %0":"=&s"(keep):"v"(gsrc),"s"(lds_dst):"memory");}
__device__ __forceinline__ float max3f(float a,float b,float c){float r;asm("v_max3_f32 %0, %1, %2, %3":"=v"(r):"v"(a),"v"(b),"v"(c));return r;}
__device__ __forceinline__ float max2f(float a,float b){float r;asm("v_max_f32_e32 %0, %1, %2":"=v"(r):"v"(a),"v"(b));return r;}
__device__ __forceinline__ float fadd_s(float a,float b){float r;asm("v_add_f32_e32 %0, %1, %2":"=v"(r):"v"(a),"v"(b));return r;}
__device__ __forceinline__ float fsub_s(float a,float b){float r;asm("v_sub_f32_e32 %0, %1, %2":"=v"(r):"v"(a),"v"(b));return r;}
typedef float f32x2_t __attribute__((ext_vector_type(2))); typedef __bf16 bf16x2_t __attribute__((ext_vector_type(2)));
__device__ __forceinline__ unsigned cvtpk_s(float lo,float hi){f32x2_t v={lo,hi};bf16x2_t b=__builtin_convertvector(v,bf16x2_t);return __builtin_bit_cast(unsigned,b);}
#define WAIT_BAR(N) asm volatile("s_waitcnt vmcnt(" #N ") lgkmcnt(0)\n\ts_barrier":::"memory")

__device__ __forceinline__ void qkt(f32x16&p0,f32x16&p1,const char*Kslot,const bf16x8*qr,const f32x16&negm,int r32,int hi){
  const char*kb=Kslot+hi*1024+r32*16;
  #pragma unroll
  for(int d0=0;d0<4;++d0){
    const bf16x8 b0=*reinterpret_cast<const bf16x8*>(kb+d0*2048);
    const bf16x8 b1=*reinterpret_cast<const bf16x8*>(kb+d0*2048+512);
    if(d0==0){p0=__builtin_amdgcn_mfma_f32_32x32x16_bf16(b0,qr[0],negm,0,0,0);p1=__builtin_amdgcn_mfma_f32_32x32x16_bf16(b1,qr[0],negm,0,0,0);}
    else{p0=__builtin_amdgcn_mfma_f32_32x32x16_bf16(b0,qr[d0],p0,0,0,0);p1=__builtin_amdgcn_mfma_f32_32x32x16_bf16(b1,qr[d0],p1,0,0,0);}}
}
typedef __attribute__((address_space(3))) const char* lds_cptr;
typedef short v4i16_t __attribute__((ext_vector_type(4)));
__device__ __forceinline__ void kload8(bf16x8*kf,lds_cptr kp){
  kf[0]=*(const __attribute__((address_space(3))) bf16x8*)(kp);      kf[1]=*(const __attribute__((address_space(3))) bf16x8*)(kp+512);
  kf[2]=*(const __attribute__((address_space(3))) bf16x8*)(kp+2048); kf[3]=*(const __attribute__((address_space(3))) bf16x8*)(kp+2560);
  kf[4]=*(const __attribute__((address_space(3))) bf16x8*)(kp+4096); kf[5]=*(const __attribute__((address_space(3))) bf16x8*)(kp+4608);
  kf[6]=*(const __attribute__((address_space(3))) bf16x8*)(kp+6144); kf[7]=*(const __attribute__((address_space(3))) bf16x8*)(kp+6656);
}
__device__ __forceinline__ void kload2(bf16x8*kf,lds_cptr kp,int j){ kf[2*j]=*(const __attribute__((address_space(3))) bf16x8*)(kp+j*2048); kf[2*j+1]=*(const __attribute__((address_space(3))) bf16x8*)(kp+j*2048+512); }
__device__ __forceinline__ s16x4 vtr(lds_cptr p){ return __builtin_bit_cast(s16x4,__builtin_amdgcn_ds_read_tr16_b64_v4i16((__attribute__((address_space(3))) v4i16_t*)p)); }
__device__ __forceinline__ float rowmax(const f32x16&p0,const f32x16&p1){
  float a=max3f(p0[0],p0[1],p1[0]),b=max3f(p0[2],p0[3],p1[1]);a=max3f(a,p1[2],p1[3]);
  #pragma unroll
  for(int r=4;r<16;r+=4){a=max3f(a,p0[r],p0[r+1]);b=max3f(b,p0[r+2],p0[r+3]);a=max3f(a,p1[r],p1[r+1]);b=max3f(b,p1[r+2],p1[r+3]);}
  const float m=max2f(a,b);
  auto rr=__builtin_amdgcn_permlane32_swap(__float_as_uint(m),__float_as_uint(m),false,false);
  return max2f(__uint_as_float(rr[0]),__uint_as_float(rr[1]));
}
__device__ __forceinline__ void pv(f32x16*o,int vb,bf16x8 pa0,bf16x8 pa1,bf16x8 pa2,bf16x8 pa3){
  #pragma unroll
  for(int d0=0;d0<2;++d0){s16x4 lo[4],hi[4];
    #pragma unroll
    for(int ks=0;ks<4;++ks){
      asm volatile("ds_read_b64_tr_b16 %0,%1 offset:%c2":"=&v"(lo[ks]):"v"(vb),"i"(d0*4096+ks*1024):"memory");
      asm volatile("ds_read_b64_tr_b16 %0,%1 offset:%c2":"=&v"(hi[ks]):"v"(vb),"i"(d0*4096+ks*1024+512):"memory");}
    asm volatile("s_waitcnt lgkmcnt(0)":::"memory");SBAR();
    #define PK(k) (bf16x8){lo[k][0],lo[k][1],lo[k][2],lo[k][3],hi[k][0],hi[k][1],hi[k][2],hi[k][3]}
    o[d0]=__builtin_amdgcn_mfma_f32_32x32x16_bf16(pa0,PK(0),o[d0],0,0,0);
    o[d0]=__builtin_amdgcn_mfma_f32_32x32x16_bf16(pa1,PK(1),o[d0],0,0,0);
    o[d0]=__builtin_amdgcn_mfma_f32_32x32x16_bf16(pa2,PK(2),o[d0],0,0,0);
    o[d0]=__builtin_amdgcn_mfma_f32_32x32x16_bf16(pa3,PK(3),o[d0],0,0,0);
    #undef PK
  }
}

#ifndef ATTN_STORE16
#define ATTN_STORE16(p,v) (*(u32x4*)(p)=(v))
#endif
template<int THRL> __device__ __forceinline__ void attn_unit(int b,int h,int qb,const bf16*Q,const bf16*__restrict__ K,const bf16*__restrict__ V,bf16*O,char*shm){
  const int tid=tidx(),lane=tid&63,r32=lane&31,hi=lane>>5; const int wid=__builtin_amdgcn_readfirstlane(tid>>6);
  const long rowbase=(long)b*RPBA; const int q0=qb*QB;
  const bf16*Qw=Q+(rowbase+q0+wid*QBLK)*PQ+h*D;
  const bf16*Kh=K+rowbase*PQ+(h>>2)*D,*Vh=V+rowbase*PQ+(h>>2)*D;
  const unsigned lds0=(unsigned)(uintptr_t)shm;
  float*wsf=(float*)(shm+LDS_WS)+wid*64;
  const bf16*ksrc=Kh+(long)lane*PQ+wid*8;
  const bf16*vsrc=Vh+(long)(16*(wid&3)+(lane>>2))*PQ+(wid>>2)*32+(lane&3)*8;
  const unsigned kdst=lds0+LDS_K+wid*1024, vdst=lds0+LDS_V+wid*1024;
  #define DMA_K(t,slot) glds16(ksrc+(long)(t)*KVBLK*PQ,(unsigned)__builtin_amdgcn_readfirstlane(kdst+(slot)))
  #define DMA_V(t,slot) glds16(vsrc+(long)(t)*KVBLK*PQ,(unsigned)__builtin_amdgcn_readfirstlane(vdst+(slot)))
  const int vb0=(int)(lds0+LDS_V)+((lane>>4)&1)*32+(lane&3)*8+(4*hi+((lane&15)>>2))*64;
  const char*Kbase=shm+LDS_K; bf16x8 kf[8];
  const lds_cptr shm3=(lds_cptr)shm; const lds_cptr kp0=shm3+LDS_K+hi*1024+r32*16; const lds_cptr vp0=shm3+LDS_V+((lane>>4)&1)*32+(lane&3)*8+(4*hi+((lane&15)>>2))*64;
  const int NT=KROWS/KVBLK;
  DMA_K(0,0);DMA_V(0,0);DMA_K(1,SLOTB);
  bf16x8 qr[4];
  #pragma unroll
  for(int d0=0;d0<4;++d0)qr[d0]=*reinterpret_cast<const bf16x8*>(&Qw[(long)r32*PQ+d0*16+hi*8]);
  float mhat=0.f,l_reg=0.f;f32x16 o[2];o[0]=f32x16{};o[1]=f32x16{};f32x16 negm=f32x16{};asm volatile("":"+v"(negm));
  const int qrel=wid*QBLK+r32;
  #define CMASK(P0,P1,t) do{}while(0)
  bool resc=false;
  #define START(P0,P1) do{ const float rm=rowmax(P0,P1); resc=false; \
    { const float dl=rm; mhat=fadd_s(mhat,dl); \
      _Pragma("unroll") for(int r=0;r<16;++r){P0[r]=fsub_s(P0[r],dl);P1[r]=fsub_s(P1[r],dl);} \
      _Pragma("unroll") for(int r=0;r<16;++r)negm[r]=-mhat; asm volatile("":"+v"(negm)); } \
    _Pragma("unroll") for(int r=0;r<16;++r)P0[r]=__builtin_amdgcn_exp2f(P0[r]); }while(0)
  #define RESC() do{ if(resc){ asm volatile("s_waitcnt lgkmcnt(0)":::"memory"); \
      _Pragma("unroll") for(int d_=0;d_<2;++d_) _Pragma("unroll") for(int r=0;r<16;++r)o[d_][r]*=wsf[crow(r,hi)]; } }while(0)
  f32x16 pA0,pA1,pB0,pB1;
  int sl_prev=0,sl_cur=0,sl_next=SLOTB;
  #define ROT() do{sl_prev=sl_cur;sl_cur=sl_next;sl_next=(sl_next==(NSLOT-1)*SLOTB)?0:sl_next+SLOTB;}while(0)
  DMA_K(2,2*SLOTB);
  WAIT_BAR(3);
  qkt(pA0,pA1,Kbase,qr,negm,r32,hi);asm volatile("s_nop 15\n\ts_nop 7":"+v"(pA0),"+v"(pA1));CMASK(pA0,pA1,0);
  START(pA0,pA1);
  _Pragma("unroll") for(int r=0;r<16;++r)pA1[r]=__builtin_amdgcn_exp2f(pA1[r]);
  WAIT_BAR(0);
  DMA_K(3,0);DMA_V(1,SLOTB);
  ROT();
  kload8(kf,kp0+sl_cur);
  WAIT_BAR(2);
  s16x4 vlo[8],vhi[8]; u32x4 pw0,pw1,pw2,pw3;
  #define PKW(P,B) cvtpk_s(P[B],P[B+1])
  #define PAF(k) __builtin_bit_cast(bf16x8,pw##k)
  #define VFR(i) (bf16x8){vlo[i][0],vlo[i][1],vlo[i][2],vlo[i][3],vhi[i][0],vhi[i][1],vhi[i][2],vhi[i][3]}
  #define PIN(x) asm volatile("":"+v"(x))
  #define MX3(a,b,c) __builtin_fmaxf(__builtin_fmaxf((a),(b)),(c))
  #define GAPA(MF,A0,A1,A2,A3,W0,W1,PW) do{ MF; sacc+=A0; sacc+=A1; sacc+=A2; sacc+=A3; PIN(sacc); W0; W1; PIN(PW); SBAR(); }while(0)
  #define EX(v) __builtin_amdgcn_exp2f(v)
  #define GAPB(MF,X,B) do{ MF; X[B]=EX(X[B]); X[B+1]=EX(X[B+1]); X[B+2]=EX(X[B+2]); X[B+3]=EX(X[B+3]); PIN(X); SBAR(); }while(0)
  #define VRD(i) do{ vlo[i]=vtr(vp_+(((i)>>2)*4096+((i)&3)*1024)); vhi[i]=vtr(vp_+(((i)>>2)*4096+((i)&3)*1024+512)); }while(0)
  #define KRD(G,j) do{ if(G){ kload2(kf,kp0+sl_next,j); SBAR(); } }while(0)
  #define STEP(C0,C1,P0,P1,t,GK,GV,GL) do{ SBAR(); \
    const lds_cptr vp_=vp0+sl_prev; \
    VRD(0); SBAR(); float sacc=(P0[0]+P0[1]); \
    GAPA(C0=__builtin_amdgcn_mfma_f32_32x32x16_bf16(kf[0],qr[0],negm,0,0,0), P0[2],P0[3],P0[4],P0[5],     pw0[0]=PKW(P0,0), pw0[1]=PKW(P0,2), pw0); \
    VRD(4); SBAR(); GAPA(C1=__builtin_amdgcn_mfma_f32_32x32x16_bf16(kf[1],qr[0],negm,0,0,0), P0[6],P0[7],P0[8],P0[9],     pw0[2]=PKW(P0,4), pw0[3]=PKW(P0,6), pw0); \
    VRD(1); SBAR(); GAPA(C0=__builtin_amdgcn_mfma_f32_32x32x16_bf16(kf[2],qr[1],C0,0,0,0),   P0[10],P0[11],P0[12],P0[13], pw1[0]=PKW(P0,8), pw1[1]=PKW(P0,10), pw1); \
    VRD(5); SBAR(); GAPA(C1=__builtin_amdgcn_mfma_f32_32x32x16_bf16(kf[3],qr[1],C1,0,0,0),   P0[14],P0[15],P1[0],P1[1],   pw1[2]=PKW(P0,12),pw1[3]=PKW(P0,14), pw1); \
    VRD(2); SBAR(); GAPA(C0=__builtin_amdgcn_mfma_f32_32x32x16_bf16(kf[4],qr[2],C0,0,0,0),   P1[2],P1[3],P1[4],P1[5],     pw2[0]=PKW(P1,0), pw2[1]=PKW(P1,2), pw2); \
    VRD(6); SBAR(); GAPA(C1=__builtin_amdgcn_mfma_f32_32x32x16_bf16(kf[5],qr[2],C1,0,0,0),   P1[6],P1[7],P1[8],P1[9],     pw2[2]=PKW(P1,4), pw2[3]=PKW(P1,6), pw2); \
    VRD(3); SBAR(); GAPA(C0=__builtin_amdgcn_mfma_f32_32x32x16_bf16(kf[6],qr[3],C0,0,0,0),   P1[10],P1[11],P1[12],P1[13], pw3[0]=PKW(P1,8), pw3[1]=PKW(P1,10), pw3); \
    VRD(7); SBAR(); GAPA(C1=__builtin_amdgcn_mfma_f32_32x32x16_bf16(kf[7],qr[3],C1,0,0,0),   P1[14],P1[15],0.f,0.f,       pw3[2]=PKW(P1,12),pw3[3]=PKW(P1,14), pw3); \
    l_reg+=sacc; \
    if(GK){DMA_K((t)+3,sl_cur);} if(GV){DMA_V((t)+1,sl_next);} \
    CMASK(C0,C1,t); \
    { float a=MX3(C0[0],C0[1],C1[0]),b=MX3(C0[2],C0[3],C1[1]); a=MX3(a,C1[2],C1[3]); \
      _Pragma("unroll") for(int r=4;r<16;r+=4){a=MX3(a,C0[r],C0[r+1]);b=MX3(b,C0[r+2],C0[r+3]);a=MX3(a,C1[r],C1[r+1]);b=MX3(b,C1[r+2],C1[r+3]);} \
      float rm=__builtin_fmaxf(a,b); { auto rr=__builtin_amdgcn_permlane32_swap(__float_as_uint(rm),__float_as_uint(rm),false,false); rm=__builtin_fmaxf(__uint_as_float(rr[0]),__uint_as_float(rr[1])); } \
      resc=false; \
      if(__builtin_expect(__any(rm>(float)THRL),0)){ const float dl=__builtin_fmaxf(rm,0.f); mhat+=dl; \
        _Pragma("unroll") for(int r=0;r<16;++r){C0[r]-=dl;C1[r]-=dl;} \
        _Pragma("unroll") for(int r=0;r<16;++r)negm[r]=-mhat; asm volatile("":"+v"(negm)); \
        const float f=__builtin_amdgcn_exp2f(-dl); l_reg*=f; if(hi==0)wsf[r32]=f; resc=true; } } \
    SBAR(); \
    GAPB(o[0]=__builtin_amdgcn_mfma_f32_32x32x16_bf16(PAF(0),VFR(0),o[0],0,0,0), C0,0); \
    GAPB(o[1]=__builtin_amdgcn_mfma_f32_32x32x16_bf16(PAF(0),VFR(4),o[1],0,0,0), C0,4); \
    KRD(GL,0); GAPB(o[0]=__builtin_amdgcn_mfma_f32_32x32x16_bf16(PAF(1),VFR(1),o[0],0,0,0), C0,8); \
    KRD(GL,1); GAPB(o[1]=__builtin_amdgcn_mfma_f32_32x32x16_bf16(PAF(1),VFR(5),o[1],0,0,0), C0,12); \
    KRD(GL,2); GAPB(o[0]=__builtin_amdgcn_mfma_f32_32x32x16_bf16(PAF(2),VFR(2),o[0],0,0,0), C1,0); \
    KRD(GL,3); GAPB(o[1]=__builtin_amdgcn_mfma_f32_32x32x16_bf16(PAF(2),VFR(6),o[1],0,0,0), C1,4); \
    GAPB(o[0]=__builtin_amdgcn_mfma_f32_32x32x16_bf16(PAF(3),VFR(3),o[0],0,0,0), C1,8); \
    GAPB(o[1]=__builtin_amdgcn_mfma_f32_32x32x16_bf16(PAF(3),VFR(7),o[1],0,0,0), C1,12); \
    }while(0)
  int t=1;
  #undef CMASK
  #define CMASK(P0,P1,t) do{}while(0)
  for(;t+5<NT;t+=2){
    STEP(pB0,pB1,pA0,pA1,t,true,true,true);     WAIT_BAR(2); RESC(); ROT();
    STEP(pA0,pA1,pB0,pB1,t+1,true,true,true);   WAIT_BAR(2); RESC(); ROT();
  }
  #undef CMASK
  #define CMASK(P0,P1,t) do{}while(0)
  #define ENDW(tt) do{ if((tt)+3<NT){WAIT_BAR(2);} else if((tt)+2<NT){WAIT_BAR(1);} else {WAIT_BAR(0);} }while(0)
  for(;t+1<NT;t+=2){
    STEP(pB0,pB1,pA0,pA1,t,(t+3<NT),(t+1<NT),(t+1<NT));       ENDW(t);   RESC(); ROT();
    STEP(pA0,pA1,pB0,pB1,t+1,(t+4<NT),(t+2<NT),(t+2<NT));     ENDW(t+1); RESC(); ROT();
  }
  STEP(pB0,pB1,pA0,pA1,NT-1,false,false,false); RESC();
  { float sacc=pB0[0]+pB0[1]; _Pragma("unroll") for(int r=2;r<16;++r)sacc+=pB0[r]; _Pragma("unroll") for(int r=0;r<16;++r)sacc+=pB1[r]; l_reg+=sacc;
    pw0=(u32x4){PKW(pB0,0),PKW(pB0,2),PKW(pB0,4),PKW(pB0,6)};pw1=(u32x4){PKW(pB0,8),PKW(pB0,10),PKW(pB0,12),PKW(pB0,14)};pw2=(u32x4){PKW(pB1,0),PKW(pB1,2),PKW(pB1,4),PKW(pB1,6)};pw3=(u32x4){PKW(pB1,8),PKW(pB1,10),PKW(pB1,12),PKW(pB1,14)};
    SBAR(); pv(o,vb0+sl_cur,PAF(0),PAF(1),PAF(2),PAF(3)); }
  #undef PKW
  #undef PAF
  #undef VFR
  #undef PIN
  #undef MX3
  #undef GAPA
  #undef GAPB
  #undef EX
  #undef VRD
  #undef KRD
  #undef STEP
  #undef ENDW
  {auto rr=__builtin_amdgcn_permlane32_swap(__float_as_uint(l_reg),__float_as_uint(l_reg),false,false);l_reg=__uint_as_float(rr[0])+__uint_as_float(rr[1]);}
  if(hi==0)wsf[32+r32]=l_reg;asm volatile("s_waitcnt lgkmcnt(0)":::"memory");
  float rli[16];
  #pragma unroll
  for(int r=0;r<16;++r)rli[r]=__builtin_amdgcn_rcpf(wsf[32+crow(r,hi)]);
  bf16*Ow=O+(rowbase+q0+wid*QBLK)*PO+h*D;
  { bf16*stg=(bf16*)(shm+LDS_OST)+wid*2048;
    #pragma unroll
    for(int r=0;r<16;++r){const int orow=crow(r,hi);
      #pragma unroll
      for(int d0=0;d0<2;++d0)stg[orow*64+d0*32+r32]=__float2bfloat16(o[d0][r]*rli[r]);}
    asm volatile("s_waitcnt lgkmcnt(0)":::"memory");
    #pragma unroll
    for(int i=0;i<4;++i){const int row=i*8+(lane>>3),ch=lane&7; const u32x4 v=*(const u32x4*)(stg+row*64+ch*8); ATTN_STORE16(Ow+(long)row*PO+ch*8,v);} }
  asm volatile("s_waitcnt lgkmcnt(0)\n\ts_barrier":::"memory");
  #undef DMA_K
  #undef DMA_V
  #undef CMASK
  #undef START
  #undef RESC
  #undef ROT
}
constexpr int ATTN_LDS_BYTES=LDS_BYTES;
#undef SBAR
#undef WAIT_BAR
}

DEV void phase_even_post(PPtr p, int li) {
    const int tid = tidx(), lane = tid & 63, gw = blockIdx.x * NWAVE + (tid >> 6), ngw = gridDim.x * NWAVE;
    u16* RAW = (u16*)(p->ws + OFF_RAW);
    const float* qg = p->in[10] + li * 64; const float* kg = p->in[11] + li * 64;
    const float* T = (const float*)(p->ws + OFF_ROPE);
    const int w8 = (lane & 7) * 8, i0 = w8 & 31; const bool second = (lane & 4) != 0;
    for (int item = gw; item < MROWS * 3; item += ngw) {
        const int m = item / 3, pass = item - 3 * m;
        if (pass == 2 && lane >= 32) continue;
        const int b = m / RPB, q = m - b * RPB;
        const int sl = pass * 8 + (lane >> 3);
        const int c0 = sl < 8 ? sl * 64 : sl < 10 ? 512 + (sl - 8) * 64 : sl < 18 ? 768 + (sl - 10) * 64 : 1280 + (sl - 18) * 64;
        u16* ptr = RAW + (size_t)m * 1536 + c0 + w8;
        float x[8]; unpack8(*(const uint4*)ptr, x);
        if (sl < 10) {
            const float* gn = (sl < 8 ? qg : kg) + w8;
            float ss = 0.f;
#pragma unroll
            for (int e = 0; e < 8; ++e) ss += x[e] * x[e];
            ss += __shfl_xor(ss, 1); ss += __shfl_xor(ss, 2); ss += __shfl_xor(ss, 4);
            const float rs = rsqrtf(ss * (1.f / 64.f) + 1e-6f);
            const float4 g0 = *(const float4*)gn, g1 = *(const float4*)(gn + 4);
            x[0] *= rs * g0.x; x[1] *= rs * g0.y; x[2] *= rs * g0.z; x[3] *= rs * g0.w; x[4] *= rs * g1.x; x[5] *= rs * g1.y; x[6] *= rs * g1.z; x[7] *= rs * g1.w;
        }
        if (q < SEQ) {
            const float* ct = (i0 < 16) ? T + (q >> 6) * 16 + i0 : T + 8192 + (q & 63) * 16 + (i0 - 16);
            const float* st = ct + ((i0 < 16) ? 4096 : 1024);
            const float4 c0v = *(const float4*)ct, c1v = *(const float4*)(ct + 4), s0v = *(const float4*)st, s1v = *(const float4*)(st + 4);
            const float cs[8] = {c0v.x, c0v.y, c0v.z, c0v.w, c1v.x, c1v.y, c1v.z, c1v.w}, sn[8] = {s0v.x, s0v.y, s0v.z, s0v.w, s1v.x, s1v.y, s1v.z, s1v.w};
            const float sc = (sl < 8) ? attn_body::C2 : 1.f;
#pragma unroll
            for (int e = 0; e < 8; ++e) {
                const float other = __shfl_xor(x[e], 4);
                const float o = second ? (other * sn[e] + x[e] * cs[e]) : (x[e] * cs[e] - other * sn[e]);
                x[e] = o * sc;
            }
        }
        *(uint4*)ptr = pack8(x);
    }
}

template <int mode, bool qctx>
DEV void attn_wave(const u16* QB, int pitch, int qcol, int kcol, int vcol, u16* AO, int ocol,
                   int b, int hk, int blk, const float* sinkp, const float* rpb, u16* sV) {
    const int lane = tidx() & 63, qi = lane & 15, quad = lane >> 4;
    const bool gqa = mode < 2;
    const size_t rowb = (size_t)b * RPB;
    const float SCL = 0.125f * LOG2E;
    int qtok[4], qhead[4]; bf16x8 qf[4][2];
#pragma unroll
    for (int i = 0; i < 4; ++i) {
        qtok[i] = gqa ? blk * 16 + qi : blk * 64 + i * 16 + qi; qhead[i] = gqa ? hk * 4 + i : hk;
        const size_t m = rowb + (qctx ? SEQ : 0) + qtok[i];
        const u16* qp = QB + m * pitch + qcol + qhead[i] * 64 + quad * 8;
        qf[i][0] = *(const bf16x8*)qp; qf[i][1] = *(const bf16x8*)(qp + 32);
    }
    f32x4 o[4][4]; float mrun[4], lrun[4];
#pragma unroll
    for (int i = 0; i < 4; ++i) {
#pragma unroll
        for (int d = 0; d < 4; ++d) o[i][d] = (f32x4){0.f, 0.f, 0.f, 0.f};
        if (mode == 1) { mrun[i] = sinkp[qhead[i]] * LOG2E; lrun[i] = (quad == 0) ? 1.f : 0.f; } else { mrun[i] = -1e30f; lrun[i] = 0.f; }
    }
    const u16* Kb = QB + kcol + hk * 64; const u16* Vb = QB + vcol + hk * 64;
    float* srpb = (float*)(sV + 32 * 72);
    if (mode == 2) { for (int t = lane; t < 15 * 31; t += 64) srpb[t] = rpb[hk * (15 * 31) + t]; }
    int n_local, ustart, rs = 0;
    if (qctx) { n_local = 0; ustart = 0; }
    else if (mode == 0) { n_local = RPB / 32; ustart = 0; }
    else if (mode == 1) { n_local = 9; ustart = blk * 16 - 128; }
    else { rs = min(max(blk - 4, 0), 248); n_local = 16; ustart = rs * 64; }
    const int n_ctx = (mode == 0 && !qctx) ? 0 : 8;
    for (int tt = 0; tt < n_local + n_ctx; ++tt) {
        const bool loc = tt < n_local;
        const int u0 = loc ? ustart + 32 * tt : SEQ + 32 * (tt - n_local);
        const bool masked = loc && mode != 0;
        bf16x8 kf[2][2];
#pragma unroll
        for (int kt = 0; kt < 2; ++kt) {
            const int u = min(max(u0 + kt * 16 + qi, 0), RPB - 1);
            const u16* kp = Kb + (rowb + u) * pitch + quad * 8;
            kf[kt][0] = *(const bf16x8*)kp; kf[kt][1] = *(const bf16x8*)(kp + 32);
        }
#pragma unroll
        for (int c = 0; c < 4; ++c) {
            const int idx = c * 64 + lane, key = idx >> 3, dc = idx & 7;
            const int u = min(max(u0 + key, 0), RPB - 1);
            const uint4 v = *(const uint4*)(Vb + (rowb + u) * pitch + dc * 8);
            *(uint4*)(sV + key * 72 + dc * 8) = v;
        }
        bf16x8 vf[4];
#pragma unroll
        for (int dt = 0; dt < 4; ++dt)
#pragma unroll
            for (int jj = 0; jj < 8; ++jj) {
                const int key = (jj < 4) ? quad * 4 + jj : 16 + quad * 4 + (jj - 4);
                vf[dt][jj] = (short)sV[key * 72 + dt * 16 + qi];
            }
#pragma unroll
        for (int i = 0; i < 4; ++i) {
            if (mode == 2 && loc && ((i == 0 && (tt & 1) == 1) || (i == 3 && (tt & 1) == 0))) continue;
            f32x4 s0 = (f32x4){0.f, 0.f, 0.f, 0.f}, s1 = (f32x4){0.f, 0.f, 0.f, 0.f};
            s0 = __builtin_amdgcn_mfma_f32_16x16x32_bf16(kf[0][0], qf[i][0], s0, 0, 0, 0);
            s0 = __builtin_amdgcn_mfma_f32_16x16x32_bf16(kf[0][1], qf[i][1], s0, 0, 0, 0);
            s1 = __builtin_amdgcn_mfma_f32_16x16x32_bf16(kf[1][0], qf[i][0], s1, 0, 0, 0);
            s1 = __builtin_amdgcn_mfma_f32_16x16x32_bf16(kf[1][1], qf[i][1], s1, 0, 0, 0);
            float sc[8];
#pragma unroll
            for (int j = 0; j < 4; ++j) { sc[j] = s0[j] * SCL; sc[4 + j] = s1[j] * SCL; }
            if (masked) {
                const int t = qtok[i];
#pragma unroll
                for (int e = 0; e < 8; ++e) {
                    const int u = u0 + (e >> 2) * 16 + quad * 4 + (e & 3);
                    if (mode == 1) {
                        const int dd = t - u;
                        const bool ok = (u >= 0) && (u < SEQ) && (dd <= 128) && (dd >= -128);
                        if (!ok) sc[e] = -INFINITY;
                    } else {
                        const int c = t & 63, r = t >> 6, ur = u >> 6, uc = u & 63;
                        const int cst = min(max(c - 8, 0), 48);
                        const bool ok = (uc >= cst) && (uc < cst + 16);
                        const int dr = min(max(ur - r + 7, 0), 14), dcx = min(max(uc - c + 15, 0), 30);
                        const float bias = srpb[dr * 31 + dcx];
                        sc[e] = ok ? sc[e] + bias * LOG2E : -INFINITY;
                    }
                }
            }
            float mx = fmaxf(fmaxf(fmaxf(sc[0], sc[1]), fmaxf(sc[2], sc[3])), fmaxf(fmaxf(sc[4], sc[5]), fmaxf(sc[6], sc[7])));
            mx = fmaxf(mx, __shfl_xor(mx, 16)); mx = fmaxf(mx, __shfl_xor(mx, 32));
            const float mn = fmaxf(mrun[i], mx);
            const float al = __builtin_amdgcn_exp2f(mrun[i] - mn);
            mrun[i] = mn;
            float pe[8], ps = 0.f;
#pragma unroll
            for (int e = 0; e < 8; ++e) { pe[e] = __builtin_amdgcn_exp2f(sc[e] - mn); ps += pe[e]; }
            lrun[i] = lrun[i] * al + ps;
            union { unsigned u[4]; bf16x8 v; } pf;
            pf.u[0] = pk2(pe[0], pe[1]); pf.u[1] = pk2(pe[2], pe[3]); pf.u[2] = pk2(pe[4], pe[5]); pf.u[3] = pk2(pe[6], pe[7]);
#pragma unroll
            for (int dt = 0; dt < 4; ++dt) {
                o[i][dt] = o[i][dt] * al;
                o[i][dt] = __builtin_amdgcn_mfma_f32_16x16x32_bf16(vf[dt], pf.v, o[i][dt], 0, 0, 0);
            }
        }
    }
#pragma unroll
    for (int i = 0; i < 4; ++i) {
        float l = lrun[i]; l += __shfl_xor(l, 16); l += __shfl_xor(l, 32);
        const float inv = 1.f / l;
        const size_t m = rowb + (qctx ? SEQ : 0) + qtok[i];
        u16* op = AO + m * DM + ocol + qhead[i] * 64 + quad * 4;
#pragma unroll
        for (int dt = 0; dt < 4; ++dt) {
            uint2 w; w.x = pk2(o[i][dt][0] * inv, o[i][dt][1] * inv); w.y = pk2(o[i][dt][2] * inv, o[i][dt][3] * inv);
            *(uint2*)(op + dt * 16) = w;
        }
    }
}

DEV void phase_attn_even(PPtr p, int li, char* lds) {
    {
        const attn_body::bf16* RAWb = (const attn_body::bf16*)(p->ws + OFF_RAW); attn_body::bf16* AOb = (attn_body::bf16*)(p->ws + OFF_AO);
        const int G = gridDim.x, bx = blockIdx.x;
        if (G == 256) {
            const int vcu = (bx & 7) * 32 + (bx >> 3); const int x = vcu >> 5, combo = x >> 1, sub = (x & 1) * 32 + (vcu & 31);
            for (int i = 0; i < 4; ++i) attn_body::attn_unit<8>(combo >> 1, (combo & 1) * 4 + i, sub, RAWb, RAWb + 512, RAWb + 640, AOb, lds);
        } else {
            for (int u = bx; u < 1024; u += G) attn_body::attn_unit<8>(u >> 9, (u >> 6) & 7, u & 63, RAWb, RAWb + 512, RAWb + 640, AOb, lds);
        }
    }
    const int wave = tidx() >> 6, gw = blockIdx.x * NWAVE + wave, ngw = gridDim.x * NWAVE;
    u16* sV = (u16*)lds + wave * 3328;
    const u16* RAW = (const u16*)(p->ws + OFF_RAW); u16* AO = (u16*)(p->ws + OFF_AO);
    const float* sink = p->in[12] + li * 8;
    for (int t = gw; t < 4224; t += ngw) {
        if (t < 4096) attn_wave<1, false>(RAW, 1536, 768, 1280, 1408, AO, 512, t >> 11, (t >> 10) & 1, t & 1023, sink, nullptr, sV);
        else if (t < 4160) { const int u = t - 4096; attn_wave<0, true>(RAW, 1536, 0, 512, 640, AO, 0, u >> 5, (u >> 4) & 1, u & 15, nullptr, nullptr, sV); }
        else { const int u = t - 4160; attn_wave<1, true>(RAW, 1536, 768, 1280, 1408, AO, 512, u >> 5, (u >> 4) & 1, u & 15, sink, nullptr, sV); }
    }
}
DEV void phase_attn_odd(PPtr p, int li, char* lds) {
    const int wave = tidx() >> 6, gw = blockIdx.x * NWAVE + wave, ngw = gridDim.x * NWAVE;
    u16* sV = (u16*)lds + wave * 3328;
    const u16* QKV = (const u16*)(p->ws + OFF_RAW); u16* AO = (u16*)(p->ws + OFF_AO);
    const float* rpb = p->in[15] + li * 8 * 15 * 31;
    for (int t = gw; t < 4160; t += ngw) {
        if (t < 4096) attn_wave<2, false>(QKV, 1536, 0, 512, 1024, AO, 0, t >> 11, (t >> 8) & 7, t & 255, nullptr, rpb, sV);
        else { const int u = t - 4096; attn_wave<2, true>(QKV, 1536, 0, 512, 1024, AO, 0, u >> 5, (u >> 2) & 7, u & 3, nullptr, rpb, sV); }
    }
}

DEV float shiftmix_at(const u16* ZDb, int pp, int ch, float mu) {
    const bool lat = pp < SEQ; const int lo = lat ? 0 : SEQ, hi = lat ? SEQ : RPB;
    const u16* zc = ZDb + (size_t)pp * ZDW + ch;
    const float z = bf2f(zc[0]);
    const float a = (pp - 1 >= lo) ? bf2f(zc[-ZDW]) : 0.f, c = (pp + 1 < hi) ? bf2f(zc[ZDW]) : 0.f;
    return z + (0.5f * (a + c) - z) * mu;
}
DEV void phase_rwkv_prep(PPtr p, int li, int bb) {
    const int tid = tidx(), lane = tid & 63, gw = blockIdx.x * NWAVE + (tid >> 6), ngw = gridDim.x * NWAVE;
    const u16* ZDb = (const u16*)(p->ws + OFF_ZD) + (size_t)bb * RPB * ZDW;
    const float* mu = p->in[16] + li * ZDW; const float* kkw = p->in[22] + li * 512;
    u16* R = (u16*)(p->ws + OFF_R); u16* KK = (u16*)(p->ws + OFF_KK); u16* V = (u16*)(p->ws + OFF_V); u16* LA = (u16*)(p->ws + OFF_LA);
    {
        u16* LB = (u16*)(p->ws + OFF_PU);
        const float* w2 = p->in[18] + (size_t)li * 2 * 64 * 512; const float* a2 = p->in[20] + (size_t)li * 2 * 64 * 512; const float* g2 = p->in[21] + (size_t)li * 128 * 512;
        for (int idx = gw * 64 + lane; idx < 2560 * 32; idx += ngw * 64) {
            const int n = idx >> 5, kc = (idx & 31) * 8, type = n >> 9, nn = n & 511;
            float f[8];
#pragma unroll
            for (int e = 0; e < 8; ++e) {
                const int k = kc + e; float x = 0.f;
                if (type < 2) { if (k < 64) x = w2[((size_t)type * 64 + k) * 512 + nn]; }
                else if (type < 4) { if (k >= 64 && k < 128) x = a2[((size_t)(type - 2) * 64 + (k - 64)) * 512 + nn]; }
                else { if (k >= 128) x = g2[(size_t)(k - 128) * 512 + nn]; }
                f[e] = x;
            }
            *(uint4*)(LB + (size_t)n * 256 + kc) = pack8(f);
        }
    }
    for (int pp = gw; pp < RPB; pp += ngw) {
        const bool lat = pp < SEQ; const int lo = lat ? 0 : SEQ, hi = lat ? SEQ : RPB;
        const bool hp = pp - 1 >= lo, hn = pp + 1 < hi;
        const u16* zc = ZDb + (size_t)pp * ZDW;
#pragma unroll
        for (int j = 0; j < 4; ++j) {
            const int c8 = lane + 64 * j;
            if (j == 3 && lane >= 32) break;
            const int ch = 8 * c8;
            float z[8], a[8], c[8], zs[8];
            unpack8(*(const uint4*)(zc + ch), z);
            if (hp) unpack8(*(const uint4*)(zc - ZDW + ch), a); else { for (int e = 0; e < 8; ++e) a[e] = 0.f; }
            if (hn) unpack8(*(const uint4*)(zc + ZDW + ch), c); else { for (int e = 0; e < 8; ++e) c[e] = 0.f; }
            const float4 m0 = *(const float4*)(mu + ch), m1 = *(const float4*)(mu + ch + 4);
            const float mm[8] = {m0.x, m0.y, m0.z, m0.w, m1.x, m1.y, m1.z, m1.w};
#pragma unroll
            for (int e = 0; e < 8; ++e) zs[e] = z[e] + (0.5f * (a[e] + c[e]) - z[e]) * mm[e];
            if (j == 0) *(uint4*)(R + (size_t)pp * 512 + ch) = pack8(zs);
            else if (j == 1) {
                const float4 k0 = *(const float4*)(kkw + ch - 512), k1 = *(const float4*)(kkw + ch - 512 + 4);
                const float kw[8] = {k0.x, k0.y, k0.z, k0.w, k1.x, k1.y, k1.z, k1.w};
                float t[8], ss = 0.f;
#pragma unroll
                for (int e = 0; e < 8; ++e) { t[e] = zs[e] * kw[e]; ss += t[e] * t[e]; }
                ss += __shfl_xor(ss, 1); ss += __shfl_xor(ss, 2); ss += __shfl_xor(ss, 4);
                const float inv = 1.f / fmaxf(sqrtf(ss), 1e-12f);
#pragma unroll
                for (int e = 0; e < 8; ++e) t[e] *= inv;
                *(uint4*)(KK + (size_t)pp * 512 + ch - 512) = pack8(t);
            } else if (j == 2) *(uint4*)(V + (size_t)pp * 512 + ch - 1024) = pack8(zs);
            else {
                float o[8];
#pragma unroll
                for (int e = 0; e < 8; ++e) o[e] = (lane < 8) ? tanhf(zs[e]) : (lane < 16) ? zs[e] : sigmoidf_(zs[e]);
                *(uint4*)(LA + (size_t)pp * 256 + ch - 1536) = pack8(o);
            }
        }
    }
}
struct EpiDecay { float* DEC; const float* w0; int d;
    DEV void operator()(int r, int c, float v, float) const {
        const float x = -(w0[c] + v); const float sp = x > 20.f ? x : log1pf(expf(x)); const float w = -sp - 0.5f;
        DEC[((size_t)r * 2 + d) * 512 + c] = expf(-expf(w)); } };
struct EpiIclr { u16* KD; u16* BQ; const u16* KK; const u16* ZDb; const float* a0; const float* ka; const float* muk; int d;
    DEV void operator()(int r, int c, float v, float) const {
        const float a = sigmoidf_(a0[c] + v);
        const float k = shiftmix_at(ZDb, r, 512 + c, muk[c]);
        KD[((size_t)r * 2 + d) * 512 + c] = (u16)f2bf(k * (1.f + (a - 1.f) * ka[c]));
        BQ[((size_t)r * 2 + d) * 512 + c] = (u16)f2bf(bf2f(KK[(size_t)r * 512 + c]) * a); } };
struct EpiGate { u16* G; DEV void operator()(int r, int c, float v, float) const { G[(size_t)r * 512 + c] = (u16)f2bf(v); } };

DEV int pos_to_pp(int s, int d) { return (s < NCTX) ? (d ? SEQ + NCTX - 1 - s : SEQ + s) : (d ? SEQ - 1 - (s - NCTX) : s - NCTX); }
struct StepV { float d; unsigned a; unsigned b; float v; };
DEV StepV load_step(const float* DEC, const u16* KD, const u16* BQ, const u16* KK, const u16* R, const u16* V, int pp, int h, int d, int lane) {
    const size_t e1 = (size_t)pp * 512 + h * 64, e2 = ((size_t)pp * 2 + d) * 512 + h * 64;
    StepV s;
    s.d = DEC[e2 + lane];
    s.a = (lane < 32) ? ((const unsigned*)(KD + e2))[lane] : ((const unsigned*)(BQ + e2))[lane - 32];
    s.b = (lane < 32) ? ((const unsigned*)(KK + e1))[lane] : ((const unsigned*)(R + e1))[lane - 32];
    s.v = bf2f(V[e1 + lane]);
    return s;
}
typedef float f32x2 __attribute__((ext_vector_type(2)));
constexpr int SSLOT = 320;
typedef __attribute__((address_space(3))) float* ldsf;
typedef const __attribute__((address_space(3))) f32x4* lds4;
DEV void stage_step(ldsf slot, const StepV& s, int lane) {
    slot[lane] = s.d;
    *(__attribute__((address_space(3))) f32x2*)(slot + 64 + 2 * lane) = (f32x2){bflo(s.a), bfhi(s.a)};
    *(__attribute__((address_space(3))) f32x2*)(slot + 192 + 2 * lane) = (f32x2){bflo(s.b), bfhi(s.b)};
}
#define LO2(v) ((f32x2){(v)[0], (v)[1]})
#define HI2(v) ((f32x2){(v)[2], (v)[3]})
template <int MODE>
DEV float scan_step(f32x2 (&S)[32], ldsf sl, float vv) {
    lds4 D = (lds4)sl;
    f32x2 sa = {0.f, 0.f}, sb = {0.f, 0.f};
#pragma unroll
    for (int q = 0; q < 16; ++q) { const f32x4 k4 = D[48 + q]; sa += S[2 * q] * LO2(k4); sb += S[2 * q + 1] * HI2(k4);
        if ((q & 3) == 3) asm volatile("" : "+v"(D), "+v"(sa), "+v"(sb)); }
    const float nsa = -((sa[0] + sa[1]) + (sb[0] + sb[1]));
    const f32x2 nsa2 = {nsa, nsa}, vv2 = {vv, vv};
    f32x2 y = {0.f, 0.f}, z = {0.f, 0.f};
#pragma unroll
    for (int q = 0; q < 16; ++q) {
        const f32x4 d4 = D[q], b4 = D[32 + q];
        f32x2 t0 = nsa2 * LO2(b4), t1 = nsa2 * HI2(b4);
        if (MODE >= 1) { const f32x4 kd4 = D[16 + q]; t0 += vv2 * LO2(kd4); t1 += vv2 * HI2(kd4); }
        S[2 * q] = S[2 * q] * LO2(d4) + t0; S[2 * q + 1] = S[2 * q + 1] * HI2(d4) + t1;
        if (MODE == 2) { const f32x4 r4 = D[64 + q]; y += S[2 * q] * LO2(r4); z += S[2 * q + 1] * HI2(r4); }
        else y += S[2 * q + 1];
        if ((q & 1) == 1) asm volatile("" : "+v"(D), "+v"(y), "+v"(z), "+v"(S[2 * q + 1]));
    }
    return (y[0] + y[1]) + (z[0] + z[1]);
}
DEV void scan_step_pu(f32x2 (&P)[32], f32x2 (&U)[32], ldsf sl, float vv) {
    lds4 D = (lds4)sl;
    f32x2 pa = {0.f, 0.f}, pb = {0.f, 0.f}, ua = {0.f, 0.f}, ub = {0.f, 0.f};
#pragma unroll
    for (int q = 0; q < 16; ++q) { const f32x4 k4 = D[48 + q];
        pa += P[2 * q] * LO2(k4); pb += P[2 * q + 1] * HI2(k4); ua += U[2 * q] * LO2(k4); ub += U[2 * q + 1] * HI2(k4);
        if ((q & 3) == 3) asm volatile("" : "+v"(D), "+v"(pa), "+v"(pb), "+v"(ua), "+v"(ub)); }
    const float nsp = -((pa[0] + pa[1]) + (pb[0] + pb[1])), nsu = -((ua[0] + ua[1]) + (ub[0] + ub[1]));
    const f32x2 nsp2 = {nsp, nsp}, nsu2 = {nsu, nsu}, vv2 = {vv, vv};
#pragma unroll
    for (int q = 0; q < 16; ++q) {
        const f32x4 d4 = D[q], b4 = D[32 + q], kd4 = D[16 + q];
        P[2 * q] = P[2 * q] * LO2(d4) + nsp2 * LO2(b4); P[2 * q + 1] = P[2 * q + 1] * HI2(d4) + nsp2 * HI2(b4);
        U[2 * q] = U[2 * q] * LO2(d4) + (vv2 * LO2(kd4) + nsu2 * LO2(b4)); U[2 * q + 1] = U[2 * q + 1] * HI2(d4) + (vv2 * HI2(kd4) + nsu2 * HI2(b4));
        asm volatile("" : "+v"(D), "+v"(P[2 * q]), "+v"(P[2 * q + 1]), "+v"(U[2 * q]), "+v"(U[2 * q + 1]));
    }
}
DEV void phase_scan1(PPtr p, char* lds) {
    const int tid = tidx(), lane = tid & 63, wv = __builtin_amdgcn_readfirstlane(tid >> 6), gw = blockIdx.x * NWAVE + wv, ngw = gridDim.x * NWAVE;
    const float* DEC = (const float*)(p->ws + OFF_DEC); const u16* KD = (const u16*)(p->ws + OFF_KD); const u16* BQ = (const u16*)(p->ws + OFF_BQ);
    const u16* KK = (const u16*)(p->ws + OFF_KK); const u16* R = (const u16*)(p->ws + OFF_R); const u16* V = (const u16*)(p->ws + OFF_V);
    float* PU = (float*)(p->ws + OFF_PU);
    ldsf ring = (ldsf)lds + wv * (3 * SSLOT);
    for (int task = gw; task < 16 * NCH; task += ngw) {
        const int seq = task >> 7, c = task & 127, h = seq >> 1, d = seq & 1;
#define LD(st) load_step(DEC, KD, BQ, KK, R, V, pos_to_pp(c * CLEN + min((st), CLEN - 1), d), h, d, lane)
        f32x2 P[32], U[32];
        float lnf = (float)lane; asm volatile("" : "+v"(lnf));
#pragma unroll
        for (int j = 0; j < 32; ++j) { P[j] = (f32x2){fmaxf(1.f - fabsf(lnf - (float)(2 * j)), 0.f), fmaxf(1.f - fabsf(lnf - (float)(2 * j + 1)), 0.f)}; U[j] = (f32x2){0.f, 0.f}; }
        float vvA, vvB;
        { const StepV s0 = LD(0), s1 = LD(1); stage_step(ring, s0, lane); stage_step(ring + SSLOT, s1, lane); vvA = s0.v; vvB = s1.v; }
        StepV g0 = LD(2), g1 = LD(3), g2 = LD(4), g3 = LD(5);
        int cs = 0, ns = 2;
#pragma unroll 1
        for (int st = 0; st < CLEN; ++st) {
            scan_step_pu(P, U, ring + cs * SSLOT, vvA);
            stage_step(ring + ns * SSLOT, g0, lane);
            vvA = vvB; vvB = g0.v; g0 = g1; g1 = g2; g2 = g3; g3 = LD(st + 6);
            cs = (cs == 2) ? 0 : cs + 1; ns = (ns == 2) ? 0 : ns + 1;
        }
#undef LD
        float4* o = (float4*)(PU + ((size_t)task * 2) * 4096 + lane * 64);
#pragma unroll
        for (int j = 0; j < 16; ++j) { o[j] = (float4){P[2 * j][0], P[2 * j][1], P[2 * j + 1][0], P[2 * j + 1][1]}; o[1024 + j] = (float4){U[2 * j][0], U[2 * j][1], U[2 * j + 1][0], U[2 * j + 1][1]}; }
    }
}
#define S2_PLOAD(ent_, lo, hi) do { const float4* s_ = (const float4*)((ent_) + prow * 64 + pcol); lo = s_[0]; hi = s_[1]; } while (0)
#define S2_ULOAD(ent_, u_) do { const float* s_ = (ent_) + 4096; _Pragma("unroll") for (int t_ = 0; t_ < 2; ++t_) _Pragma("unroll") for (int j_ = 0; j_ < 4; ++j_) u_[t_][j_] = s_[(16 * rt + 4 * q + j_) * 64 + 16 * (ct0 + t_) + r]; } while (0)
#define S2_CSTORE(dst_, a0_, a1_) do { float* d_ = (dst_); _Pragma("unroll") for (int j_ = 0; j_ < 4; ++j_) { d_[(16 * rt + 4 * q + j_) * 64 + 16 * ct0 + r] = a0_[j_]; d_[(16 * rt + 4 * q + j_) * 64 + 16 * ct0 + 16 + r] = a1_[j_]; } } while (0)
#define S2_LSTORE(dst_, a0_, a1_) do { float* d_ = (dst_); _Pragma("unroll") for (int j_ = 0; j_ < 4; ++j_) { d_[(16 * rt + 4 * q + j_) * 68 + 16 * ct0 + r] = a0_[j_]; d_[(16 * rt + 4 * q + j_) * 68 + 16 * ct0 + 16 + r] = a1_[j_]; } } while (0)
DEV void phase_scan2a(PPtr p, char* lds) {
    if (blockIdx.x >= 128) return;
    const int tid = tidx(), lane = tid & 63, w = __builtin_amdgcn_readfirstlane(tid >> 6), seq = blockIdx.x >> 3, g = blockIdx.x & 7;
    float* sX = (float*)lds; float* sZ = sX + 2 * 64 * 68; float* sP = sZ + 2 * 64 * 68;
    float* PUg = (float*)(p->ws + OFF_PU) + (size_t)(seq * NCH + 16 * g) * 8192;
    float* TOT = (float*)(p->ws + OFF_LA) + (size_t)(seq * 8 + g) * 8192;
    const int rt = w >> 1, ct0 = (w & 1) * 2, r = lane & 15, q = lane >> 4;
    const int prow = tid >> 3, pcol = (tid & 7) * 8;
    for (int i = tid; i < 64 * 68; i += NTHR) { const int row = i / 68, col = i - row * 68; sX[i] = (row == col) ? 1.f : 0.f; sZ[i] = 0.f; }
    float4 pa0, pa1, pb0, pb1;
    { float4 t0, t1; S2_PLOAD(PUg, t0, t1); *(float4*)(sP + prow * 68 + pcol) = t0; *(float4*)(sP + prow * 68 + pcol + 4) = t1; }
    S2_PLOAD(PUg + 8192, pa0, pa1); S2_PLOAD(PUg + 2 * 8192, pb0, pb1);
    float ua[2][4], ub[2][4];
    S2_ULOAD(PUg, ua); S2_ULOAD(PUg + 8192, ub);
    __syncthreads();
    for (int jj = 0; jj < 16; ++jj) {
        const int cur = jj & 1;
        f32x4 x0 = {0.f, 0.f, 0.f, 0.f}, x1 = {0.f, 0.f, 0.f, 0.f};
        f32x4 z0 = {ua[0][0], ua[0][1], ua[0][2], ua[0][3]}, z1 = {ua[1][0], ua[1][1], ua[1][2], ua[1][3]};
        const float* Xc = sX + cur * (64 * 68); const float* Zc = sZ + cur * (64 * 68); const float* Pc = sP + cur * (64 * 68);
#pragma unroll
        for (int ks = 0; ks < 16; ++ks) {
            const float ax = Xc[(16 * rt + r) * 68 + 4 * ks + q], az = Zc[(16 * rt + r) * 68 + 4 * ks + q];
            const float b0 = Pc[(4 * ks + q) * 68 + 16 * ct0 + r], b1 = Pc[(4 * ks + q) * 68 + 16 * ct0 + 16 + r];
            x0 = __builtin_amdgcn_mfma_f32_16x16x4f32(ax, b0, x0, 0, 0, 0); x1 = __builtin_amdgcn_mfma_f32_16x16x4f32(ax, b1, x1, 0, 0, 0);
            z0 = __builtin_amdgcn_mfma_f32_16x16x4f32(az, b0, z0, 0, 0, 0); z1 = __builtin_amdgcn_mfma_f32_16x16x4f32(az, b1, z1, 0, 0, 0);
        }
        S2_LSTORE(sX + (cur ^ 1) * (64 * 68), x0, x1); S2_LSTORE(sZ + (cur ^ 1) * (64 * 68), z0, z1);
        S2_CSTORE(PUg + (size_t)jj * 8192, x0, x1); S2_CSTORE(PUg + (size_t)jj * 8192 + 4096, z0, z1);
        if (jj == 15) { S2_CSTORE(TOT, x0, x1); S2_CSTORE(TOT + 4096, z0, z1); }
        { float* Pn = sP + (cur ^ 1) * (64 * 68); *(float4*)(Pn + prow * 68 + pcol) = pa0; *(float4*)(Pn + prow * 68 + pcol + 4) = pa1; }
        pa0 = pb0; pa1 = pb1;
        S2_PLOAD(PUg + (size_t)min(jj + 3, 15) * 8192, pb0, pb1);
#pragma unroll
        for (int t = 0; t < 2; ++t)
#pragma unroll
            for (int j = 0; j < 4; ++j) ua[t][j] = ub[t][j];
        if (jj + 2 < 16) S2_ULOAD(PUg + (size_t)(jj + 2) * 8192, ub);
        __syncthreads();
    }
}
DEV void phase_scan2b(PPtr p, char* lds) {
    if (blockIdx.x >= 128) return;
    const int tid = tidx(), lane = tid & 63, w = __builtin_amdgcn_readfirstlane(tid >> 6), seq = blockIdx.x >> 3, g = blockIdx.x & 7;
    float* sS = (float*)lds; float* sP = sS + 2 * 64 * 68;
    float* PUg = (float*)(p->ws + OFF_PU) + (size_t)(seq * NCH + 16 * g) * 8192;
    float* TOTs = (float*)(p->ws + OFF_LA) + (size_t)(seq * 8) * 8192;
    const int rt = w >> 1, ct0 = (w & 1) * 2, r = lane & 15, q = lane >> 4;
    const int prow = tid >> 3, pcol = (tid & 7) * 8;
    const int T = g + 16;
#define S2_ENT(t_) ((min((t_), T - 1) < g) ? TOTs + (size_t)min((t_), T - 1) * 8192 : PUg + (size_t)(min((t_), T - 1) - g) * 8192)
    for (int i = tid; i < 64 * 68; i += NTHR) sS[i] = 0.f;
    float4 pa0, pa1, pb0, pb1;
    { float4 t0, t1; S2_PLOAD(S2_ENT(0), t0, t1); *(float4*)(sP + prow * 68 + pcol) = t0; *(float4*)(sP + prow * 68 + pcol + 4) = t1; }
    S2_PLOAD(S2_ENT(1), pa0, pa1); S2_PLOAD(S2_ENT(2), pb0, pb1);
    float ua[2][4], ub[2][4];
    S2_ULOAD(S2_ENT(0), ua); S2_ULOAD(S2_ENT(1), ub);
    f32x4 m0 = {0.f, 0.f, 0.f, 0.f}, m1 = {0.f, 0.f, 0.f, 0.f};
    int sb = 0;
    __syncthreads();
    for (int t = 0; t < T; ++t) {
        const int cur = t & 1; const bool chain = t < g;
        if (!chain) S2_CSTORE(PUg + (size_t)(t - g) * 8192 + 4096, m0, m1);
        f32x4 a0 = {ua[0][0], ua[0][1], ua[0][2], ua[0][3]}, a1 = {ua[1][0], ua[1][1], ua[1][2], ua[1][3]};
        const float* Sc = sS + sb * (64 * 68); const float* Pc = sP + cur * (64 * 68);
#pragma unroll
        for (int ks = 0; ks < 16; ++ks) {
            const float av = Sc[(16 * rt + r) * 68 + 4 * ks + q];
            const float b0 = Pc[(4 * ks + q) * 68 + 16 * ct0 + r], b1 = Pc[(4 * ks + q) * 68 + 16 * ct0 + 16 + r];
            a0 = __builtin_amdgcn_mfma_f32_16x16x4f32(av, b0, a0, 0, 0, 0);
            a1 = __builtin_amdgcn_mfma_f32_16x16x4f32(av, b1, a1, 0, 0, 0);
        }
        m0 = a0; m1 = a1;
        if (chain) { S2_LSTORE(sS + (sb ^ 1) * (64 * 68), a0, a1); sb ^= 1; }
        { float* Pn = sP + (cur ^ 1) * (64 * 68); *(float4*)(Pn + prow * 68 + pcol) = pa0; *(float4*)(Pn + prow * 68 + pcol + 4) = pa1; }
        pa0 = pb0; pa1 = pb1;
        S2_PLOAD(S2_ENT(t + 3), pb0, pb1);
#pragma unroll
        for (int u = 0; u < 2; ++u)
#pragma unroll
            for (int j = 0; j < 4; ++j) ua[u][j] = ub[u][j];
        if (t + 2 < T) S2_ULOAD(S2_ENT(t + 2), ub);
        __syncthreads();
    }
#undef S2_ENT
}
DEV void phase_scan3(PPtr p, char* lds) {
    const int tid = tidx(), lane = tid & 63, wv = __builtin_amdgcn_readfirstlane(tid >> 6), gw = blockIdx.x * NWAVE + wv, ngw = gridDim.x * NWAVE;
    const float* DEC = (const float*)(p->ws + OFF_DEC); const u16* KD = (const u16*)(p->ws + OFF_KD); const u16* BQ = (const u16*)(p->ws + OFF_BQ);
    const u16* KK = (const u16*)(p->ws + OFF_KK); const u16* R = (const u16*)(p->ws + OFF_R); const u16* V = (const u16*)(p->ws + OFF_V);
    const float* PU = (const float*)(p->ws + OFF_PU);
    ldsf ring = (ldsf)lds + wv * (3 * SSLOT);
    for (int task = gw; task < 16 * NCH; task += ngw) {
        const int seq = task >> 7, c = task & 127, h = seq >> 1, d = seq & 1;
        float* Yd = (float*)(p->ws + (d ? OFF_ZD : OFF_Y0));
        f32x2 S[32];
        {
            const float4* si = (const float4*)(PU + ((size_t)task * 2 + 1) * 4096 + lane * 64);
#pragma unroll
            for (int j = 0; j < 16; ++j) { const float4 t = si[j]; S[2 * j] = (f32x2){t.x, t.y}; S[2 * j + 1] = (f32x2){t.z, t.w}; }
        }
#define LD(st) load_step(DEC, KD, BQ, KK, R, V, pos_to_pp(c * CLEN + min((st), CLEN - 1), d), h, d, lane)
#define YADD(st, y) (Yd[(size_t)pos_to_pp(c * CLEN + (st), d) * 512 + h * 64 + lane] = (y))
        float vvA, vvB;
        { const StepV s0 = LD(0), s1 = LD(1); stage_step(ring, s0, lane); stage_step(ring + SSLOT, s1, lane); vvA = s0.v; vvB = s1.v; }
        StepV g0 = LD(2), g1 = LD(3), g2 = LD(4), g3 = LD(5);
        int cs = 0, ns = 2;
#pragma unroll 1
        for (int st = 0; st < CLEN; ++st) {
            const float y = scan_step<2>(S, ring + cs * SSLOT, vvA); YADD(st, y);
            stage_step(ring + ns * SSLOT, g0, lane);
            vvA = vvB; vvB = g0.v; g0 = g1; g1 = g2; g2 = g3; g3 = LD(st + 6);
            cs = (cs == 2) ? 0 : cs + 1; ns = (ns == 2) ? 0 : ns + 1;
        }
#undef LD
#undef YADD
    }
}
DEV void phase_readout(PPtr p, int li, int bb) {
    const int tid = tidx(), lane = tid & 63, gw = blockIdx.x * NWAVE + (tid >> 6), ngw = gridDim.x * NWAVE;
    const float* Y0 = (const float*)(p->ws + OFF_Y0);
    const u16* KD = (const u16*)(p->ws + OFF_KD); const u16* R = (const u16*)(p->ws + OFF_R); const u16* V = (const u16*)(p->ws + OFF_V); const u16* G = (const u16*)(p->ws + OFF_G);
    const float* rk = p->in[24] + li * 512; const float* lnw = p->in[25] + li * 512; const float* lnb = p->in[26] + li * 512;
    u16* AO = (u16*)(p->ws + OFF_AO);
    const int c = 8 * lane;
    float rkv[8], lw[8], lb[8];
    { const float4 a = *(const float4*)(rk + c), b = *(const float4*)(rk + c + 4); rkv[0] = a.x; rkv[1] = a.y; rkv[2] = a.z; rkv[3] = a.w; rkv[4] = b.x; rkv[5] = b.y; rkv[6] = b.z; rkv[7] = b.w; }
    { const float4 a = *(const float4*)(lnw + c), b = *(const float4*)(lnw + c + 4); lw[0] = a.x; lw[1] = a.y; lw[2] = a.z; lw[3] = a.w; lw[4] = b.x; lw[5] = b.y; lw[6] = b.z; lw[7] = b.w; }
    { const float4 a = *(const float4*)(lnb + c), b = *(const float4*)(lnb + c + 4); lb[0] = a.x; lb[1] = a.y; lb[2] = a.z; lb[3] = a.w; lb[4] = b.x; lb[5] = b.y; lb[6] = b.z; lb[7] = b.w; }
    for (int pp = gw; pp < RPB; pp += ngw) {
        const size_t m = (size_t)bb * RPB + pp, e = (size_t)pp * 512 + c;
        const float* Y1 = (const float*)(p->ws + OFF_ZD);
        const float4 ya = *(const float4*)(Y0 + e), yb = *(const float4*)(Y0 + e + 4), yc = *(const float4*)(Y1 + e), yd = *(const float4*)(Y1 + e + 4);
        const float y[8] = {ya.x + yc.x, ya.y + yc.y, ya.z + yc.z, ya.w + yc.w, yb.x + yd.x, yb.y + yd.y, yb.z + yd.z, yb.w + yd.w};
        float r[8], k0[8], k1[8], v[8], g[8];
        unpack8(*(const uint4*)(R + e), r); unpack8(*(const uint4*)(KD + ((size_t)pp * 2) * 512 + c), k0); unpack8(*(const uint4*)(KD + ((size_t)pp * 2 + 1) * 512 + c), k1);
        unpack8(*(const uint4*)(V + e), v); unpack8(*(const uint4*)(G + e), g);
        float sm = 0.f, bs = 0.f;
#pragma unroll
        for (int j = 0; j < 8; ++j) { sm += y[j]; bs += r[j] * (k0[j] + k1[j]) * rkv[j]; }
        sm += __shfl_xor(sm, 1); sm += __shfl_xor(sm, 2); sm += __shfl_xor(sm, 4);
        bs += __shfl_xor(bs, 1); bs += __shfl_xor(bs, 2); bs += __shfl_xor(bs, 4);
        const float mean = sm * (1.f / 64.f);
        float vs = 0.f;
#pragma unroll
        for (int j = 0; j < 8; ++j) { const float dv = y[j] - mean; vs += dv * dv; }
        vs += __shfl_xor(vs, 1); vs += __shfl_xor(vs, 2); vs += __shfl_xor(vs, 4);
        const float rstd = rsqrtf(vs * (1.f / 64.f) + 64e-5f);
        float o[8];
#pragma unroll
        for (int j = 0; j < 8; ++j) o[j] = ((y[j] - mean) * rstd * lw[j] + lb[j] + bs * v[j]) * g[j];
        *(uint4*)(AO + m * DM + 512 + c) = pack8(o);
    }
}
DEV void phase_final(PPtr p) {
    const int lane = tidx() & 63, gw = blockIdx.x * NWAVE + (tidx() >> 6), ngw = gridDim.x * NWAVE;
    const float* gain = p->in[29];
    for (int m = gw; m < NB * SEQ; m += ngw) {
        float4* xr = (float4*)(p->out + (size_t)m * DM);
        float4 v[4]; float ss = 0.f;
#pragma unroll
        for (int j = 0; j < 4; ++j) { v[j] = xr[lane + 64 * j]; ss += v[j].x * v[j].x + v[j].y * v[j].y + v[j].z * v[j].z + v[j].w * v[j].w; }
        ss = wave_sum(ss);
        const float rstd = rsqrtf(ss * (1.f / DM) + 1e-6f);
#pragma unroll
        for (int j = 0; j < 4; ++j) {
            const float4 g = *(const float4*)(gain + (lane + 64 * j) * 4);
            float4 o; o.x = v[j].x * rstd * g.x; o.y = v[j].y * rstd * g.y; o.z = v[j].z * rstd * g.z; o.w = v[j].w * rstd * g.w;
            xr[lane + 64 * j] = o;
        }
    }
}

#define LAS __attribute__((address_space(3)))
#define XB_TMO      128
#define XB_XCNT(j)  (256  + 64 * (j))
#define XB_XSUB(j)  (1280 + 64 * (j))
#define XB_XGEN(j)  (2304 + 64 * (j))
#define XB_TOP      3328
#define XB_TOPGEN   3392
#define XCD_BAR_WORDS 3456
#define XB_SPIN_CAP (1u << 18)

__device__ __forceinline__ unsigned xb_ld(unsigned* p)              { return __hip_atomic_load(p, __ATOMIC_RELAXED, __HIP_MEMORY_SCOPE_AGENT); }
__device__ __forceinline__ unsigned xb_add(unsigned* p, unsigned v) { return __hip_atomic_fetch_add(p, v, __ATOMIC_RELAXED, __HIP_MEMORY_SCOPE_AGENT); }
__device__ __forceinline__ unsigned xb_xcc_id() { return (unsigned)__builtin_amdgcn_s_getreg((3 << 11) | 20) & 0xFu; }
#define XB_SPIN(cond, bar) do { unsigned _sp = 0; while (cond) { __builtin_amdgcn_s_sleep(1); \
    if ((++_sp & 255u) == 0u) { if (xb_ld(&(bar)[XB_TMO])) break; if (_sp > XB_SPIN_CAP) { atomicAdd(&(bar)[XB_TMO], 1u); break; } } } } while (0)

struct XcdBarrier {
    unsigned* bar; unsigned x;
    volatile LAS unsigned* st;
};

__device__ __forceinline__ XcdBarrier xcd_barrier_post(unsigned* bar, volatile LAS unsigned* st) {
    XcdBarrier b; b.bar = bar; b.x = xb_xcc_id(); b.st = st;
    if (threadIdx.x == 0) (void)xb_add(&bar[XB_XCNT(b.x)], 1u);
    return b;
}
__device__ __forceinline__ void xcd_barrier_complete(unsigned* bar, unsigned x, unsigned& nloc, unsigned& nx) {
    const unsigned G = gridDim.x * gridDim.y * gridDim.z;
    unsigned sum, cnt, mine, sp = 0u;
    for (;;) {
        sum = 0u; cnt = 0u; mine = 0u;
#pragma unroll
        for (unsigned j = 0; j < 16; ++j) { const unsigned c = xb_ld(&bar[XB_XCNT(j)]); sum += c; cnt += (c > 0u) ? 1u : 0u; mine = (j == x) ? c : mine; }
        if (sum == G) break;
        __builtin_amdgcn_s_sleep(1);
        if ((++sp & 255u) == 0u) { if (xb_ld(&bar[XB_TMO])) break; if (sp > XB_SPIN_CAP) { atomicAdd(&bar[XB_TMO], 1u); break; } }
    }
    nloc = mine > 0u ? mine : 1u; nx = cnt > 0u ? cnt : 1u;
}

__device__ __forceinline__ void xcd_barrier(const XcdBarrier& b) {
    asm volatile("s_waitcnt vmcnt(0)" ::: "memory");
    __syncthreads();
    if (threadIdx.x == 0) {
        unsigned* bar = b.bar;
        __builtin_amdgcn_s_waitcnt(0);
        unsigned nloc = b.st[0], nx = b.st[1];
        if (nloc == 0u) { xcd_barrier_complete(bar, b.x, nloc, nx); b.st[0] = nloc; b.st[1] = nx; }
        const unsigned old = xb_add(&bar[XB_XSUB(b.x)], 1u);
        const unsigned gen = old / nloc;
        if (old + 1u == (gen + 1u) * nloc) {
            __builtin_amdgcn_fence(__ATOMIC_RELEASE, "agent");
            asm volatile("s_waitcnt vmcnt(0)" ::: "memory");
            const unsigned og = xb_add(&bar[XB_TOP], 1u);
            const unsigned tg = og / nx;
            if (og + 1u == (tg + 1u) * nx) xb_add(&bar[XB_TOPGEN], 1u);
            else XB_SPIN(xb_ld(&bar[XB_TOPGEN]) == tg, bar);
            __builtin_amdgcn_fence(__ATOMIC_ACQUIRE, "agent");
            xb_add(&bar[XB_XGEN(b.x)], 1u);
            asm volatile("s_waitcnt vmcnt(0)" ::: "memory");
        } else {
            XB_SPIN(xb_ld(&bar[XB_XGEN(b.x)]) == gen, bar);
            __builtin_amdgcn_fence(__ATOMIC_ACQUIRE, "agent");
            asm volatile("s_waitcnt vmcnt(0)" ::: "memory");
        }
    }
    __syncthreads();
}


constexpr size_t OFF_BAR = 768 * 1024;
DEV void gbar(PPtr kp_, unsigned& nbar) {
    asm volatile("s_waitcnt vmcnt(0)" ::: "memory");
    __syncthreads();
    if (threadIdx.x == 0) {
        unsigned* ctr = (unsigned*)(kp_->ws + OFF_BAR);
        __builtin_amdgcn_fence(__ATOMIC_RELEASE, "agent");
        asm volatile("s_waitcnt vmcnt(0)" ::: "memory");
        ++nbar;
        __hip_atomic_fetch_add(ctr, 1u, __ATOMIC_RELAXED, __HIP_MEMORY_SCOPE_AGENT);
        const unsigned target = nbar * gridDim.x;
        while (__hip_atomic_load(ctr, __ATOMIC_RELAXED, __HIP_MEMORY_SCOPE_AGENT) < target) __builtin_amdgcn_s_sleep(1);
        __builtin_amdgcn_fence(__ATOMIC_ACQUIRE, "agent");
        asm volatile("s_waitcnt vmcnt(0)" ::: "memory");
    }
    __syncthreads();
}
#define p launder(kp)
#define SYNC() xcd_barrier(nbar)
template <int bb>
DEV void do_rwkv_batch(PPtr kp, const XcdBarrier& nbar, char* lds, int li) {
    unsigned char* ws = launder(kp)->ws;
    u16* ZD = (u16*)(ws + OFF_ZD);
                phase_rwkv_prep(p, li, bb); SYNC();
                const u16* LA = (const u16*)(ws + OFF_LA); const u16* ZDb = ZD + (size_t)bb * RPB * ZDW;
                { pg8::EpiLoraT e{(float*)(ws + OFF_DEC), (u16*)(ws + OFF_KD), (u16*)(ws + OFF_BQ), (u16*)(ws + OFF_G), (const u16*)(ws + OFF_KK), ZDb,
                                  p->in[17] + (size_t)li * 1024, p->in[19] + (size_t)li * 1024, p->in[23] + li * 512, p->in[16] + li * ZDW + 512};
                  int kl_ = 256; asm volatile("" : "+s"(kl_));
                  pg8::Gemm g_{(const pg8::bf16_t*)LA, (const pg8::bf16_t*)(ws + OFF_PU), RPB, 2560, kl_}; pg8::StaticOrder S_; S_.init(RPB, 2560, (int)gridDim.x, (int)blockIdx.x);
                  pg8::gemm_phase<pg8::EpiLoraT, pg8::StaticOrder, true, true>((PG8_LAS unsigned char*)lds, g_, S_, e); }
                SYNC();
                phase_scan1(p, lds); SYNC();
                phase_scan2a(p, lds); SYNC();
                phase_scan2b(p, lds); SYNC();
                phase_scan3(p, lds); SYNC();
                phase_readout(p, li, bb); SYNC();
            }
template <int layer>
DEV void do_layer(PPtr kp, const XcdBarrier& nbar, char* lds) {
    unsigned char* ws = launder(kp)->ws;
    const float* mod = (const float*)(ws + OFF_MOD);
    u16* HN = (u16*)(ws + OFF_HN); u16* AO = (u16*)(ws + OFF_AO); u16* RAW = (u16*)(ws + OFF_RAW); u16* ZD = (u16*)(ws + OFF_ZD);
        const int li = layer >> 1;
        const float* lmod = mod + (size_t)layer * 3 * 6144;
        phase_wprep(p, layer, lds); phase_normmod(p, layer, 0); SYNC();
        const pg8::bf16_t* WB = (const pg8::bf16_t*)(ws + OFF_WB);
#define GEMM8(A_, B_, N_, K_, E_) do { pg8::Gemm g_{(const pg8::bf16_t*)(A_), (B_), MROWS, (N_), (K_)}; pg8::StaticOrder S_; S_.init(MROWS, (N_), (int)gridDim.x, (int)blockIdx.x); \
            pg8::gemm_phase<decltype(E_), pg8::StaticOrder, true, true>((PG8_LAS unsigned char*)lds, g_, S_, E_); } while (0)
#define GEMM8L(A_, B_, N_, K_, E_) do { pg8::Gemm g_{(const pg8::bf16_t*)(A_), (B_), MROWS, (N_), (K_)}; pg8::LatentOrder S_; S_.init((N_), (int)gridDim.x, (int)blockIdx.x); \
            pg8::gemm_phase<decltype(E_), pg8::LatentOrder, true, true>((PG8_LAS unsigned char*)lds, g_, S_, E_); } while (0)
        if (!(layer & 1)) {
            { pg8::EpiStoreT e{RAW, 1536, 1 << 30, RAW, 1536}; GEMM8(HN, WB + WB_IN, 1536, DM, e); } SYNC();
            phase_even_post(p, li); SYNC();
            phase_attn_even(p, li, lds); SYNC();
            { pg8::EpiResidT e{p, lmod + 2048}; GEMM8(AO, WB + WB_OUT, DM, DM, e); } SYNC();
        } else {
            { pg8::EpiStoreT e{RAW, 1536, 1536, ZD, ZDW}; GEMM8(HN, WB + WB_IN, 3328, DM, e); } SYNC();
            phase_attn_odd(p, li, lds); SYNC();
            do_rwkv_batch<0>(kp, nbar, lds, li);
            do_rwkv_batch<1>(kp, nbar, lds, li);
            if (layer == 3) { pg8::EpiResidT e{p, lmod + 2048}; GEMM8L(AO, WB + WB_OUT, DM, DM, e); }
            else { pg8::EpiResidT e{p, lmod + 2048}; GEMM8(AO, WB + WB_OUT, DM, DM, e); }
            SYNC();
        }
        phase_normmod(p, layer, 1); SYNC();
        if (layer == 3) { pg8::EpiSwigluT e{RAW}; GEMM8L(HN, WB + WB_F1, 5632, DM, e); }
        else { pg8::EpiSwigluT e{RAW}; GEMM8(HN, WB + WB_F1, 5632, DM, e); }
        SYNC();
        if (layer == 3) { pg8::EpiResidT e{p, lmod + 5120}; GEMM8L(RAW, WB + WB_F2, DM, FFH, e); }
        else { pg8::EpiResidT e{p, lmod + 5120}; GEMM8(RAW, WB + WB_F2, DM, FFH, e); }
        SYNC();
    }
__global__ void __launch_bounds__(NTHR) mega(Params p_unused) {
    PPtr kp = (PPtr)__builtin_amdgcn_kernarg_segment_ptr();
    extern __shared__ __attribute__((aligned(16))) char lds[];
    cg::grid_group grid = cg::this_grid();
    volatile LAS unsigned* xst = (volatile LAS unsigned*)((LAS char*)lds + (LDS_BYTES - 16));
    if (threadIdx.x < 4) xst[threadIdx.x] = 0u;
    __syncthreads();
    const XcdBarrier nbar = xcd_barrier_post((unsigned*)(launder(kp)->ws + OFF_BAR), xst);
    grid.sync();
    phase_init(p, lds); SYNC();
    do_layer<0>(kp, nbar, lds);
    do_layer<1>(kp, nbar, lds);
    do_layer<2>(kp, nbar, lds);
    do_layer<3>(kp, nbar, lds);
    phase_final(p);
}
#undef p
#undef SYNC

extern "C" void kernel_launch(void* const* d_in, const int* in_sizes, int n_in, void* d_out, int out_size, void* d_ws, size_t ws_size, hipStream_t stream) {
    static int grid = 0;
    if (grid == 0) {
        if (n_in != 30 || ws_size < WS_NEED || out_size != NB * SEQ * DM) { fprintf(stderr, "kernel_launch: unexpected problem shape (n_in %d ws %zu out %d)\n", n_in, ws_size, out_size); grid = -1; return; }
        int dev = 0, cus = 0, per_cu = 0;
        hipGetDevice(&dev);
        hipDeviceGetAttribute(&cus, hipDeviceAttributeMultiprocessorCount, dev);
        hipFuncSetAttribute((const void*)mega, hipFuncAttributeMaxDynamicSharedMemorySize, LDS_BYTES);
        hipOccupancyMaxActiveBlocksPerMultiprocessor(&per_cu, (const void*)mega, NTHR, LDS_BYTES);
        if (per_cu < 1) per_cu = 1;
        if (per_cu > 1) per_cu = 1;
        grid = cus * per_cu;
    }
    if (grid < 0) return;
    Params p{};
    for (int i = 0; i < 30; ++i) p.in[i] = (const float*)d_in[i];
    p.out = (float*)d_out; p.ws = (unsigned char*)d_ws;
    hipMemsetAsync((char*)d_ws + OFF_BAR, 0, XCD_BAR_WORDS * 4, stream);
    void* args[] = {&p};
    hipError_t e = hipLaunchCooperativeKernel((const void*)mega, dim3(grid), dim3(NTHR), args, LDS_BYTES, stream);
    if (e != hipSuccess) fprintf(stderr, "cooperative launch failed: %s (grid %d)\n", hipGetErrorString(e), grid);
}
```

```cpp
#include <hip/hip_runtime.h>
#include <hip/hip_cooperative_groups.h>
#include <cstdio>
#include <cstdint>
namespace cg = cooperative_groups;

#define DEV __device__ __forceinline__
typedef unsigned short u16;
typedef short bf16x8 __attribute__((ext_vector_type(8)));
typedef float f32x4 __attribute__((ext_vector_type(4)));
typedef const __attribute__((address_space(4))) float* cfp;
typedef const __attribute__((address_space(4))) unsigned* cup;

constexpr int DM = 1024, NB = 2, SEQ = 16384, NCTX = 256, RPB = SEQ + NCTX, MROWS = NB * RPB;
constexpr int FFH = 2816, ZDW = 1792;
constexpr float LOG2E = 1.4426950408889634f;
constexpr int NTHR = 512, NWAVE = 8;
constexpr int LDS_BYTES = 132096;

constexpr size_t MiB = 1u << 20;
constexpr size_t OFF_MOD = 0;
constexpr size_t OFF_ROPE = 512 * 1024;
constexpr size_t OFF_XC = 1 * MiB;
constexpr size_t OFF_WB = 3 * MiB;
constexpr size_t OFF_AO = 29 * MiB;
constexpr size_t OFF_HN = 94 * MiB;
constexpr size_t OFF_RAW = 159 * MiB;
constexpr size_t OFF_ZD = 257 * MiB;
constexpr size_t SZ_H = (size_t)RPB * 512 * 2;
constexpr size_t OFF_DEC = 94 * MiB;
constexpr size_t OFF_KD = OFF_DEC + 4 * SZ_H;
constexpr size_t OFF_BQ = OFF_KD + 2 * SZ_H;
constexpr size_t OFF_KK = OFF_BQ + 2 * SZ_H;
constexpr size_t OFF_R = OFF_KK + SZ_H;
constexpr size_t OFF_V = 371 * MiB;
constexpr size_t OFF_G = OFF_V + SZ_H;
constexpr size_t OFF_LA = OFF_G + SZ_H;
constexpr size_t OFF_Y0 = 412 * MiB;
constexpr size_t OFF_PU = OFF_Y0 + 2 * SZ_H;
constexpr size_t WS_NEED = 509 * MiB;
constexpr int NCH = 128, CLEN = 130;
static_assert(OFF_R + SZ_H <= OFF_ZD, "scan map");
static_assert(OFF_LA + SZ_H / 2 <= OFF_Y0, "scan map 2");
static_assert(OFF_PU + 64 * MiB <= WS_NEED, "scan map 3");
static_assert(OFF_RAW + (size_t)MROWS * FFH * 2 <= WS_NEED, "ffn hidden");

struct Params { const float* in[30]; float* out; unsigned char* ws; };
typedef const __attribute__((address_space(4))) Params* PPtr;
DEV int tidx() { int t = threadIdx.x; asm volatile("" : "+v"(t)); return t; }
DEV PPtr launder(PPtr p) { asm volatile("" : "+s"(p)); return p; }

DEV unsigned f2bf(float f) { unsigned u = __float_as_uint(f); return (u + 0x7fffu + ((u >> 16) & 1u)) >> 16; }
DEV float bf2f(u16 h) { return __uint_as_float(((unsigned)h) << 16); }
DEV float bflo(unsigned u) { return __uint_as_float(u << 16); }
DEV float bfhi(unsigned u) { return __uint_as_float(u & 0xffff0000u); }
DEV unsigned pk2(float lo, float hi) { return f2bf(lo) | (f2bf(hi) << 16); }
DEV void unpack8(const uint4 u, float (&f)[8]) {
    f[0] = bflo(u.x); f[1] = bfhi(u.x); f[2] = bflo(u.y); f[3] = bfhi(u.y); f[4] = bflo(u.z); f[5] = bfhi(u.z); f[6] = bflo(u.w); f[7] = bfhi(u.w);
}
DEV uint4 pack8(const float (&f)[8]) { uint4 o; o.x = pk2(f[0], f[1]); o.y = pk2(f[2], f[3]); o.z = pk2(f[4], f[5]); o.w = pk2(f[6], f[7]); return o; }
DEV float wave_sum(float v) {
#pragma unroll
    for (int o = 1; o < 64; o <<= 1) v += __shfl_xor(v, o);
    return v;
}
DEV float* xrow_ptr(PPtr p, int m) {
    int b = m / RPB, q = m - b * RPB;
    return q < SEQ ? p->out + (size_t)(b * SEQ + q) * DM : (float*)(p->ws + OFF_XC) + (size_t)(b * NCTX + (q - SEQ)) * DM;
}
DEV int mod_idx(int m) { int b = m / RPB, q = m - b * RPB; return q < SEQ ? b : 2; }
DEV float sigmoidf_(float x) { return 1.f / (1.f + __expf(-x)); }

DEV void phase_init(PPtr p, char* lds) {
    const int tid = tidx();
    const size_t gt = (size_t)blockIdx.x * NTHR + tid, ng = (size_t)gridDim.x * NTHR;
    {
        const float4* s = (const float4*)p->in[0]; float4* d = (float4*)p->out;
        const size_t n = (size_t)NB * SEQ * DM / 4;
        for (size_t i = gt; i < n; i += ng) d[i] = s[i];
        const float4* s2 = (const float4*)p->in[2]; float4* d2 = (float4*)(p->ws + OFF_XC);
        const size_t n2 = (size_t)NB * NCTX * DM / 4;
        for (size_t i = gt; i < n2; i += ng) d2[i] = s2[i];
    }
    {
        float* T = (float*)(p->ws + OFF_ROPE);
        for (size_t i = gt; i < 5120; i += ng) {
            const int pos = (int)(i >> 4), f = (int)(i & 15);
            const float inv = powf(10000.f, -(float)f / 16.f);
            if (pos < 256) { const float ang = (float)pos * inv; T[pos * 16 + f] = cosf(ang); T[4096 + pos * 16 + f] = sinf(ang); }
            else { const float ang = (float)(pos - 256) * inv; T[8192 + (pos - 256) * 16 + f] = cosf(ang); T[9216 + (pos - 256) * 16 + f] = sinf(ang); }
        }
    }
    float* red = (float*)lds;
    float* mod = (float*)(p->ws + OFF_MOD);
    const float* c = p->in[1]; const float* cc = p->in[3];
    for (int item = blockIdx.x; item < 768; item += gridDim.x) {
        const int l = item / 192, n0 = (item % 192) * 32, col = tid & 31, kp = tid >> 5;
        const float* w = p->in[4] + (size_t)l * DM * 6144 + n0 + col;
        float a0 = 0.f, a1 = 0.f, a2 = 0.f;
        for (int k = kp * 64; k < kp * 64 + 64; ++k) {
            const float wv = w[(size_t)k * 6144];
            const float c0 = c[k], c1 = c[DM + k], c2 = cc[k];
            a0 += c0 * sigmoidf_(c0) * wv; a1 += c1 * sigmoidf_(c1) * wv; a2 += c2 * sigmoidf_(c2) * wv;
        }
        red[(kp * 3 + 0) * 32 + col] = a0; red[(kp * 3 + 1) * 32 + col] = a1; red[(kp * 3 + 2) * 32 + col] = a2;
        __syncthreads();
        if (tid < 96) {
            const int mb = tid >> 5, cl = tid & 31;
            float sacc = 0.f;
#pragma unroll
            for (int q = 0; q < 16; ++q) sacc += red[(q * 3 + mb) * 32 + cl];
            mod[(size_t)(l * 3 + mb) * 6144 + n0 + cl] = sacc + p->in[5][l * 6144 + n0 + cl];
        }
        __syncthreads();
    }
}

DEV void phase_normmod(PPtr p, int layer, int which) {
    const int lane = tidx() & 63, gw = blockIdx.x * NWAVE + (tidx() >> 6), ngw = gridDim.x * NWAVE;
    const float* gain = p->in[which ? 7 : 6] + layer * DM;
    const float* mod = (const float*)(p->ws + OFF_MOD) + (size_t)layer * 3 * 6144;
    u16* HN = (u16*)(p->ws + OFF_HN);
    for (int m = gw; m < MROWS; m += ngw) {
        const float* xr = xrow_ptr(p, m);
        const float* md = mod + mod_idx(m) * 6144 + (which ? 3072 : 0);
        float4 v[4]; float ss = 0.f;
#pragma unroll
        for (int j = 0; j < 4; ++j) { v[j] = ((const float4*)xr)[lane + 64 * j]; ss += v[j].x * v[j].x + v[j].y * v[j].y + v[j].z * v[j].z + v[j].w * v[j].w; }
        ss = wave_sum(ss);
        const float rstd = rsqrtf(ss * (1.f / DM) + 1e-6f);
#pragma unroll
        for (int j = 0; j < 4; ++j) {
            const int k = (lane + 64 * j) * 4;
            const float4 g = *(const float4*)(gain + k), sh = *(const float4*)(md + k), sc = *(const float4*)(md + 1024 + k);
            const float o0 = v[j].x * rstd * g.x * (1.f + sc.x) + sh.x, o1 = v[j].y * rstd * g.y * (1.f + sc.y) + sh.y;
            const float o2 = v[j].z * rstd * g.z * (1.f + sc.z) + sh.z, o3 = v[j].w * rstd * g.w * (1.f + sc.w) + sh.w;
            uint2 w; w.x = pk2(o0, o1); w.y = pk2(o2, o3);
            *(uint2*)(HN + (size_t)m * DM + k) = w;
        }
    }
}

template <int DUAL, class Epi>
DEV void gemm_simple(const u16* A, int lda, const float* W, int ldw, int dualoff, int M, int N, int K, const Epi& epi, char* lds) {
    u16* sA = (u16*)lds; u16* sB = sA + 128 * 40; u16* sB2 = sB + 128 * 40;
    const int tid = tidx(), lane = tid & 63, wave = tid >> 6, wm = wave >> 2, wn = wave & 3, r16 = lane & 15, quad = lane >> 4;
    const int mt = M / 128, nt = N / 128;
    for (int item = blockIdx.x; item < mt * nt; item += gridDim.x) {
        const int tn = item / mt, tm = item - tn * mt, m0 = tm * 128, n0 = tn * 128;
        f32x4 acc[4][2], acc2[4][2];
#pragma unroll
        for (int a = 0; a < 4; ++a)
#pragma unroll
            for (int b = 0; b < 2; ++b) { acc[a][b] = (f32x4){0.f, 0.f, 0.f, 0.f}; acc2[a][b] = (f32x4){0.f, 0.f, 0.f, 0.f}; }
        for (int k0 = 0; k0 < K; k0 += 32) {
            {
                const int row = tid >> 2, kc = (tid & 3) * 8;
                const uint4 v = *(const uint4*)(A + (size_t)(m0 + row) * lda + k0 + kc);
                *(uint4*)(sA + row * 40 + kc) = v;
            }
            {
                const int kk = tid >> 4, nc = (tid & 15) * 8;
                const float* wp = W + (size_t)(k0 + kk) * ldw + n0 + nc;
                const float4 a = *(const float4*)wp, b = *(const float4*)(wp + 4);
                sB[(nc + 0) * 40 + kk] = (u16)f2bf(a.x); sB[(nc + 1) * 40 + kk] = (u16)f2bf(a.y); sB[(nc + 2) * 40 + kk] = (u16)f2bf(a.z); sB[(nc + 3) * 40 + kk] = (u16)f2bf(a.w);
                sB[(nc + 4) * 40 + kk] = (u16)f2bf(b.x); sB[(nc + 5) * 40 + kk] = (u16)f2bf(b.y); sB[(nc + 6) * 40 + kk] = (u16)f2bf(b.z); sB[(nc + 7) * 40 + kk] = (u16)f2bf(b.w);
                if (DUAL) {
                    const float4 c = *(const float4*)(wp + dualoff), d = *(const float4*)(wp + dualoff + 4);
                    sB2[(nc + 0) * 40 + kk] = (u16)f2bf(c.x); sB2[(nc + 1) * 40 + kk] = (u16)f2bf(c.y); sB2[(nc + 2) * 40 + kk] = (u16)f2bf(c.z); sB2[(nc + 3) * 40 + kk] = (u16)f2bf(c.w);
                    sB2[(nc + 4) * 40 + kk] = (u16)f2bf(d.x); sB2[(nc + 5) * 40 + kk] = (u16)f2bf(d.y); sB2[(nc + 6) * 40 + kk] = (u16)f2bf(d.z); sB2[(nc + 7) * 40 + kk] = (u16)f2bf(d.w);
                }
            }
            __syncthreads();
            bf16x8 af[4], bfr[2], bfr2[2];
#pragma unroll
            for (int mi = 0; mi < 4; ++mi) af[mi] = *(const bf16x8*)(sA + (wm * 64 + mi * 16 + r16) * 40 + quad * 8);
#pragma unroll
            for (int ni = 0; ni < 2; ++ni) {
                bfr[ni] = *(const bf16x8*)(sB + (wn * 32 + ni * 16 + r16) * 40 + quad * 8);
                if (DUAL) bfr2[ni] = *(const bf16x8*)(sB2 + (wn * 32 + ni * 16 + r16) * 40 + quad * 8);
            }
#pragma unroll
            for (int mi = 0; mi < 4; ++mi)
#pragma unroll
                for (int ni = 0; ni < 2; ++ni) {
                    acc[mi][ni] = __builtin_amdgcn_mfma_f32_16x16x32_bf16(af[mi], bfr[ni], acc[mi][ni], 0, 0, 0);
                    if (DUAL) acc2[mi][ni] = __builtin_amdgcn_mfma_f32_16x16x32_bf16(af[mi], bfr2[ni], acc2[mi][ni], 0, 0, 0);
                }
            __syncthreads();
        }
#pragma unroll
        for (int mi = 0; mi < 4; ++mi)
#pragma unroll
            for (int ni = 0; ni < 2; ++ni)
#pragma unroll
                for (int j = 0; j < 4; ++j) {
                    const int row = m0 + wm * 64 + mi * 16 + quad * 4 + j, col = n0 + wn * 32 + ni * 16 + r16;
                    epi(row, col, acc[mi][ni][j], DUAL ? acc2[mi][ni][j] : 0.f);
                }
    }
}

struct EpiStore { u16* O; int ld; DEV void operator()(int r, int c, float v, float) const { O[(size_t)r * ld + c] = (u16)f2bf(v); } };
struct EpiStoreOdd { u16* Q; u16* Z;
    DEV void operator()(int r, int c, float v, float) const { if (c < 1536) Q[(size_t)r * 1536 + c] = (u16)f2bf(v); else Z[(size_t)r * ZDW + (c - 1536)] = (u16)f2bf(v); } };
struct EpiResid { PPtr p; const float* gate;
    DEV void operator()(int r, int c, float v, float) const { float* xr = xrow_ptr(p, r); xr[c] += gate[mod_idx(r) * 6144 + c] * v; } };
struct EpiSwiglu { u16* H;
    DEV void operator()(int r, int c, float g, float u) const { H[(size_t)r * FFH + c] = (u16)f2bf(g * sigmoidf_(g) * u); } };


namespace pg8 {
#define PG8_LAS __attribute__((address_space(3)))
typedef unsigned short bf16_t;
typedef short bf16x8 __attribute__((ext_vector_type(8)));
typedef float f32x4 __attribute__((ext_vector_type(4)));
typedef unsigned u32x4 __attribute__((ext_vector_type(4)));
constexpr int BM = 256, BK = 64, HALF = 128, HTB = HALF * BK * 2  , STAGE_BYTES = 8 * HTB, NXCD = 8, WGM = 8;

__host__ __device__ __forceinline__ int lds_byte(int r, int c) { const int st = (r >> 4) * 2 + (c >> 5), rr = r & 15, cc = c & 31, ob = rr * 64 + cc * 2; return st * 1024 + (ob ^ (((ob >> 9) & 1) << 5)); }
__host__ __device__ __forceinline__ void stage_rc(int b, int& R, int& C) { const int st = b / 1024, sb = b % 1024, swz = sb ^ (((sb >> 9) & 1) << 5); R = (st >> 1) * 16 + swz / 64; C = (st & 1) * 32 + (swz % 64) / 2; }
__host__ __device__ __forceinline__ int perm32(int rho) { const int n = rho >> 4, i = rho & 15; return 8 * (i >> 2) + 4 * n + (i & 3); }

struct Unit { int pm, pn; };
struct Gemm { const bf16_t* A; const bf16_t* Bt; int M, N, K; };

struct StaticOrder {
    int nM, nN, nwg, G, c;
    __host__ __device__ void init(int M, int N, int G_, int c_) { nM = M / BM; nN = N / BM; nwg = nM * nN; G = G_; c = c_; }
    __host__ __device__ bool next(int i, Unit& u) const {
        const long L = (long)i * G + c; if (L >= nwg) return false;
        int wgid = (int)L; { const int q = nwg / NXCD, r = nwg % NXCD, xcd = wgid % NXCD, off = wgid / NXCD; wgid = (xcd < r ? xcd * (q + 1) : r * (q + 1) + (xcd - r) * q) + off; }
        const int nig = WGM * nN, gid = wgid / nig, fm = gid * WGM, gsz = (nM - fm) < WGM ? (nM - fm) : WGM;
        u.pm = fm + ((wgid % nig) % gsz); u.pn = (wgid % nig) / gsz; return true;
    }
    __device__ __forceinline__ void a_ready(const Unit&) const {}
    __device__ __forceinline__ void done(const Unit&) const {}
};
struct LatentOrder {
    StaticOrder S;
    __host__ __device__ void init(int N, int G_, int c_) { S.init(32768, N, G_, c_); }
    __host__ __device__ bool next(int i, Unit& u) const { if (!S.next(i, u)) return false; u.pm = u.pm < 64 ? u.pm : u.pm + 1; return true; }
    __device__ __forceinline__ void a_ready(const Unit&) const {}
    __device__ __forceinline__ void done(const Unit&) const {}
};

__device__ __forceinline__ unsigned cvt_pk_bf16(float lo, float hi) { unsigned r; asm volatile("v_cvt_pk_bf16_f32 %0, %1, %2" : "=v"(r) : "v"(lo), "v"(hi)); return r; }
template <class Epi, class Sched, bool ALIGN_EPI = false, bool SP2 = false>
__device__ __forceinline__ void gemm_phase(PG8_LAS unsigned char* lds, const Gemm g, const Sched& S, const Epi& E) {
    const int tid = tidx(), wid = __builtin_amdgcn_readfirstlane(tid >> 6), lane = tid & 63, wr = wid >> 2, wc = wid & 3, fr = lane & 15, fq = lane >> 4;
    const int K = g.K, nt = K / BK;
    unsigned voffA[2], voffB[2];
#pragma unroll
    for (int i = 0; i < 2; ++i) { int R, C; stage_rc(tid * 16 + i * 8192, R, C); const int Rb = Epi::PERM ? ((R & ~31) + perm32(R & 31)) : R;
        voffA[i] = (unsigned)(R * K + C) * 2u; voffB[i] = (unsigned)(Rb * K + C) * 2u; }
    const size_t kstep = (size_t)(BK * 2);
    const size_t hstep = (size_t)HALF * K * 2;
    const size_t tstep = 2 * hstep;
    const unsigned ldsw = (unsigned)wid * 1024u;
    const int aoff = lds_byte(wr * 64 + fr, fq * 8), boff = lds_byte(wc * 32 + fr, fq * 8);
#define PG8_SA(b, h) (((b) * 2 + (h)) * HTB)
#define PG8_SB(b, h) ((4 + (b) * 2 + (h)) * HTB)
#define PG8_STAGE(bufoff, gbase, voff) do { _Pragma("unroll") for (int _i = 0; _i < 2; ++_i) \
        __builtin_amdgcn_global_load_lds((const unsigned*)((const char*)(gbase) + (voff)[_i]), (PG8_LAS unsigned*)(lds + (bufoff) + ldsw + _i * 8192), 16, 0, 0); } while (0)
#define PG8_LDA(dst, b, h) do { _Pragma("unroll") for (int m = 0; m < 4; ++m) _Pragma("unroll") for (int k = 0; k < 2; ++k) dst[m][k] = *(const PG8_LAS bf16x8*)(lds + PG8_SA(b, h) + aoff + m * 2048 + k * 1024); } while (0)
#define PG8_LDB(dst, b, h) do { _Pragma("unroll") for (int n = 0; n < 2; ++n) _Pragma("unroll") for (int k = 0; k < 2; ++k) dst[n][k] = *(const PG8_LAS bf16x8*)(lds + PG8_SB(b, h) + boff + n * 2048 + k * 1024); } while (0)
#define PG8_MMA(ai, bj, At, Bt) do { __builtin_amdgcn_s_setprio(1); _Pragma("unroll") for (int m = 0; m < 4; ++m) _Pragma("unroll") for (int n = 0; n < 2; ++n) _Pragma("unroll") for (int k = 0; k < 2; ++k) \
        acc[ai][bj][m][n] = __builtin_amdgcn_mfma_f32_16x16x32_bf16(Bt[n][k], At[m][k], acc[ai][bj][m][n], 0, 0, 0); __builtin_amdgcn_s_setprio(0); } while (0)
#define PG8_WAIT_V(n) asm volatile("s_waitcnt vmcnt(" #n ")" ::: "memory")
#define PG8_WAIT_L(n) asm volatile("s_waitcnt lgkmcnt(" #n ")" ::: "memory")
#define PG8_BAR __builtin_amdgcn_s_barrier()
#define PG8_SCHED __builtin_amdgcn_sched_barrier(0)
    Unit cur, nxt; int ui = 0;
    if (!S.next(0, cur)) return;
    f32x4 acc[2][2][4][2];
#pragma unroll
    for (int a = 0; a < 2; ++a)
#pragma unroll
        for (int b = 0; b < 2; ++b)
#pragma unroll
            for (int m = 0; m < 4; ++m)
#pragma unroll
                for (int n = 0; n < 2; ++n) acc[a][b][m][n] = (f32x4){0.f, 0.f, 0.f, 0.f};
    bf16x8 At[4][2], B0[2][2], B1[2][2];
    const char* cA = (const char*)g.A + (size_t)cur.pm * tstep; const char* cB = (const char*)g.Bt + (size_t)cur.pn * tstep;
    S.a_ready(cur);
    if constexpr (SP2) {
        PG8_STAGE(PG8_SB(0, 0), cB, voffB); PG8_STAGE(PG8_SB(0, 1), cB + hstep, voffB); PG8_STAGE(PG8_SA(0, 0), cA, voffA); PG8_STAGE(PG8_SA(0, 1), cA + hstep, voffA);
        if (wr == 1) PG8_BAR;
        PG8_WAIT_V(2); PG8_BAR;
        PG8_STAGE(PG8_SB(1, 0), cB + kstep, voffB); PG8_STAGE(PG8_SA(1, 0), cA + kstep, voffA); PG8_STAGE(PG8_SB(1, 1), cB + hstep + kstep, voffB);
        PG8_WAIT_V(6); PG8_BAR;
    } else {
        PG8_STAGE(PG8_SB(0, 0), cB, voffB); PG8_STAGE(PG8_SA(0, 0), cA, voffA); PG8_STAGE(PG8_SB(0, 1), cB + hstep, voffB); PG8_STAGE(PG8_SA(0, 1), cA + hstep, voffA);
        if (wr == 1) PG8_BAR;
        PG8_WAIT_V(4); PG8_BAR;
        PG8_STAGE(PG8_SB(1, 0), cB + kstep, voffB); PG8_STAGE(PG8_SA(1, 0), cA + kstep, voffA); PG8_STAGE(PG8_SB(1, 1), cB + hstep + kstep, voffB);
        PG8_WAIT_V(6); PG8_BAR;
    }
    for (;;) {
        const bool has_next = S.next(ui + 1, nxt);
        const char* nA = has_next ? (const char*)g.A + (size_t)nxt.pm * tstep : cA; const char* nB = has_next ? (const char*)g.Bt + (size_t)nxt.pn * tstep : cB;
        for (int t = 0; t < nt; t += 2) {
            const bool last = (t == nt - 2);
            const char* a1 = cA + (size_t)(t + 1) * kstep;
            const char* a2 = last ? nA : cA + (size_t)(t + 2) * kstep; const char* b2 = last ? nB : cB + (size_t)(t + 2) * kstep;
            const char* a3 = a2 + kstep; const char* b3 = b2 + kstep;
            if (last && has_next) S.a_ready(nxt);
            if constexpr (SP2) {
            PG8_LDB(B0, 0, 0); PG8_LDB(B1, 0, 1); PG8_SCHED; PG8_LDA(At, 0, 0); PG8_STAGE(PG8_SA(1, 1), a1 + hstep, voffA);
            PG8_WAIT_V(8); PG8_WAIT_L(0); PG8_BAR; PG8_MMA(0, 0, At, B0); PG8_MMA(0, 1, At, B1); PG8_BAR; PG8_SCHED;
            PG8_LDA(At, 0, 1); PG8_STAGE(PG8_SB(0, 0), b2, voffB); PG8_STAGE(PG8_SB(0, 1), b2 + hstep, voffB); PG8_STAGE(PG8_SA(0, 0), a2, voffA);
            PG8_WAIT_V(8); PG8_WAIT_L(0); PG8_BAR; PG8_MMA(1, 0, At, B0); PG8_MMA(1, 1, At, B1); PG8_BAR; PG8_SCHED;
            PG8_LDB(B0, 1, 0); PG8_LDB(B1, 1, 1); PG8_SCHED; PG8_LDA(At, 1, 0); PG8_STAGE(PG8_SA(0, 1), a2 + hstep, voffA);
            PG8_WAIT_V(8); PG8_WAIT_L(0); PG8_BAR; PG8_MMA(0, 0, At, B0); PG8_MMA(0, 1, At, B1); PG8_BAR; PG8_SCHED;
            PG8_LDA(At, 1, 1); PG8_STAGE(PG8_SB(1, 0), b3, voffB); PG8_STAGE(PG8_SB(1, 1), b3 + hstep, voffB); PG8_STAGE(PG8_SA(1, 0), a3, voffA);
            PG8_WAIT_V(8); PG8_WAIT_L(0); PG8_BAR; PG8_MMA(1, 0, At, B0); PG8_MMA(1, 1, At, B1); PG8_BAR; PG8_SCHED;
            } else {
            PG8_LDB(B0, 0, 0); PG8_SCHED; PG8_LDA(At, 0, 0); PG8_STAGE(PG8_SA(1, 1), a1 + hstep, voffA);
            PG8_WAIT_L(8); PG8_BAR; PG8_WAIT_L(0); PG8_MMA(0, 0, At, B0); PG8_BAR; PG8_SCHED;
            PG8_LDB(B1, 0, 1); PG8_STAGE(PG8_SB(0, 0), b2, voffB);
            PG8_BAR; PG8_WAIT_L(0); PG8_MMA(0, 1, At, B1); PG8_BAR;
            PG8_LDA(At, 0, 1); PG8_STAGE(PG8_SA(0, 0), a2, voffA);
            PG8_BAR; PG8_WAIT_L(0); PG8_MMA(1, 0, At, B0); PG8_BAR; PG8_SCHED;
            PG8_STAGE(PG8_SB(0, 1), b2 + hstep, voffB);
            PG8_WAIT_V(6); PG8_BAR; PG8_MMA(1, 1, At, B1); PG8_BAR;
            PG8_LDB(B0, 1, 0); PG8_SCHED; PG8_LDA(At, 1, 0); PG8_STAGE(PG8_SA(0, 1), a2 + hstep, voffA);
            PG8_WAIT_L(8); PG8_BAR; PG8_WAIT_L(0); PG8_MMA(0, 0, At, B0); PG8_BAR; PG8_SCHED;
            PG8_LDB(B1, 1, 1); PG8_STAGE(PG8_SB(1, 0), b3, voffB);
            PG8_BAR; PG8_WAIT_L(0); PG8_MMA(0, 1, At, B1); PG8_BAR;
            PG8_LDA(At, 1, 1); PG8_STAGE(PG8_SA(1, 0), a3, voffA);
            PG8_BAR; PG8_WAIT_L(0); PG8_MMA(1, 0, At, B0); PG8_BAR; PG8_SCHED;
            PG8_STAGE(PG8_SB(1, 1), b3 + hstep, voffB);
            PG8_WAIT_V(6); PG8_BAR; PG8_MMA(1, 1, At, B1); PG8_BAR;
            }
        }
        if constexpr (ALIGN_EPI) { if (wr == 0) PG8_BAR; }
        if constexpr (!Epi::AFTER_DRAIN) { E(acc, cur, wr, wc, fr, fq); S.done(cur); }
        if (!has_next) break;
#pragma unroll
        for (int a = 0; a < 2; ++a)
#pragma unroll
            for (int b = 0; b < 2; ++b)
#pragma unroll
                for (int m = 0; m < 4; ++m)
#pragma unroll
                    for (int n = 0; n < 2; ++n) acc[a][b][m][n] = (f32x4){0.f, 0.f, 0.f, 0.f};
        cur = nxt; cA = nA; cB = nB; ++ui;
        if constexpr (ALIGN_EPI) { if (wr == 1) PG8_BAR; }
    }
    PG8_WAIT_V(0);
    if constexpr (!ALIGN_EPI) { if (wr == 0) PG8_BAR; }
    PG8_BAR;
    if constexpr (Epi::AFTER_DRAIN) { E.fused(acc, cur, wr, wc, fr, fq, lds, wid, lane); S.done(cur); }
#undef PG8_SA
#undef PG8_SB
#undef PG8_STAGE
#undef PG8_LDA
#undef PG8_LDB
#undef PG8_MMA
#undef PG8_WAIT_V
#undef PG8_WAIT_L
#undef PG8_BAR
#undef PG8_SCHED
}

struct EpiStoreT {
    static constexpr bool PERM = true, AFTER_DRAIN = false;
    bf16_t* O0; int ld0; int split; bf16_t* O1; int ld1;
    __device__ __forceinline__ void operator()(const f32x4 (&acc)[2][2][4][2], const Unit& u, int wr, int wc, int fr, int fq) const {
        const int row0 = u.pm * BM + wr * 64 + fr; int colt = u.pn * BM; bf16_t* base = O0; int ld = ld0;
        if (colt >= split) { base = O1; ld = ld1; colt -= split; }
        const int col0 = colt + wc * 32 + 8 * fq;
#pragma unroll
        for (int ai = 0; ai < 2; ++ai)
#pragma unroll
            for (int m = 0; m < 4; ++m) { bf16_t* rowp = base + (size_t)(row0 + ai * HALF + m * 16) * ld + col0;
#pragma unroll
                for (int bj = 0; bj < 2; ++bj) { const f32x4 v0 = acc[ai][bj][m][0], v1 = acc[ai][bj][m][1];
                    u32x4 w; w.x = cvt_pk_bf16(v0[0], v0[1]); w.y = cvt_pk_bf16(v0[2], v0[3]); w.z = cvt_pk_bf16(v1[0], v1[1]); w.w = cvt_pk_bf16(v1[2], v1[3]);
                    *(u32x4*)(rowp + bj * HALF) = w; } }
    }
};
struct EpiResidT {
    static constexpr bool PERM = true, AFTER_DRAIN = false;
    PPtr p; const float* gate;
    __device__ __forceinline__ void operator()(const f32x4 (&acc)[2][2][4][2], const Unit& u, int wr, int wc, int fr, int fq) const {
        float* xb = xrow_ptr(p, u.pm * BM); const float* g = gate + mod_idx(u.pm * BM) * 6144;
        const int col0 = u.pn * BM + wc * 32 + 8 * fq;
#pragma unroll
        for (int ai = 0; ai < 2; ++ai)
#pragma unroll
            for (int m = 0; m < 4; ++m) { float* xr = xb + (size_t)(ai * HALF + wr * 64 + m * 16 + fr) * DM;
#pragma unroll
                for (int bj = 0; bj < 2; ++bj) { const int col = col0 + bj * HALF; const f32x4 v0 = acc[ai][bj][m][0], v1 = acc[ai][bj][m][1];
                    const f32x4 g0 = *(const f32x4*)(g + col), g1 = *(const f32x4*)(g + col + 4);
                    f32x4 x0 = *(const f32x4*)(xr + col), x1 = *(const f32x4*)(xr + col + 4);
                    x0 += g0 * v0; x1 += g1 * v1;
                    *(f32x4*)(xr + col) = x0; *(f32x4*)(xr + col + 4) = x1; } }
    }
};
struct EpiSwigluT {
    static constexpr bool PERM = true, AFTER_DRAIN = false;
    bf16_t* H;
    __device__ __forceinline__ void operator()(const f32x4 (&acc)[2][2][4][2], const Unit& u, int wr, int wc, int fr, int fq) const {
        const int row0 = u.pm * BM + wr * 64 + fr; const int col0 = u.pn * BM + wc * 32 + 8 * fq;
#pragma unroll
        for (int ai = 0; ai < 2; ++ai)
#pragma unroll
            for (int m = 0; m < 4; ++m) { bf16_t* rowp = H + (size_t)(row0 + ai * HALF + m * 16) * FFH;
#pragma unroll
                for (int bj = 0; bj < 2; ++bj) { const f32x4 gt = acc[ai][bj][m][0], up = acc[ai][bj][m][1];
                    float h[4];
#pragma unroll
                    for (int j = 0; j < 4; ++j) h[j] = gt[j] * sigmoidf_(gt[j]) * up[j];
                    uint2 w; w.x = cvt_pk_bf16(h[0], h[1]); w.y = cvt_pk_bf16(h[2], h[3]);
                    *(uint2*)(rowp + ((col0 + bj * HALF) >> 1)) = w; } }
    }
};

struct EpiLoraT {
    static constexpr bool PERM = true, AFTER_DRAIN = false;
    float* DEC; bf16_t* KD; bf16_t* BQ; bf16_t* G; const bf16_t* KK; const bf16_t* ZDb;
    const float* w0; const float* a0; const float* ka; const float* muk;
    template <int TYPE>
    __device__ __forceinline__ void one(const f32x4 v, int r, int c, int d) const {
        if (TYPE == 0) {
            const float4 wa = *(const float4*)(w0 + d * 512 + c);
            const float ww[4] = {wa.x, wa.y, wa.z, wa.w};
            float o[4];
#pragma unroll
            for (int e = 0; e < 4; ++e) { const float x = -(ww[e] + v[e]); const float sp = x > 20.f ? x : __logf(1.f + __expf(x)); o[e] = __expf(-__expf(-sp - 0.5f)); }
            *(float4*)(DEC + ((size_t)r * 2 + d) * 512 + c) = (float4){o[0], o[1], o[2], o[3]};
        } else if (TYPE == 1) {
            const float4 aa = *(const float4*)(a0 + d * 512 + c), ka0 = *(const float4*)(ka + c), m0 = *(const float4*)(muk + c);
            const float a0v[4] = {aa.x, aa.y, aa.z, aa.w}, kav[4] = {ka0.x, ka0.y, ka0.z, ka0.w}, mm[4] = {m0.x, m0.y, m0.z, m0.w};
            const bool lat = r < SEQ; const int lo = lat ? 0 : SEQ, hi = lat ? SEQ : RPB;
            const bf16_t* zc = ZDb + (size_t)r * ZDW + 512 + c;
            const bool hp = r - 1 >= lo, hn = r + 1 < hi;
            const uint2 uz = *(const uint2*)zc, up = *(const uint2*)(hp ? zc - ZDW : zc), un = *(const uint2*)(hn ? zc + ZDW : zc), uk = *(const uint2*)(KK + (size_t)r * 512 + c);
            const float z[4] = {bflo(uz.x), bfhi(uz.x), bflo(uz.y), bfhi(uz.y)}, zp[4] = {bflo(up.x), bfhi(up.x), bflo(up.y), bfhi(up.y)};
            const float zn[4] = {bflo(un.x), bfhi(un.x), bflo(un.y), bfhi(un.y)}, kk[4] = {bflo(uk.x), bfhi(uk.x), bflo(uk.y), bfhi(uk.y)};
            const float fp = hp ? 0.5f : 0.f, fn = hn ? 0.5f : 0.f;
            float okd[4], obq[4];
#pragma unroll
            for (int e = 0; e < 4; ++e) {
                const float a = sigmoidf_(a0v[e] + v[e]);
                const float k = z[e] + ((fp * zp[e] + fn * zn[e]) - z[e]) * mm[e];
                okd[e] = k * (1.f + (a - 1.f) * kav[e]); obq[e] = kk[e] * a;
            }
            uint2 w1; w1.x = pk2(okd[0], okd[1]); w1.y = pk2(okd[2], okd[3]); *(uint2*)(KD + ((size_t)r * 2 + d) * 512 + c) = w1;
            uint2 w2; w2.x = pk2(obq[0], obq[1]); w2.y = pk2(obq[2], obq[3]); *(uint2*)(BQ + ((size_t)r * 2 + d) * 512 + c) = w2;
        } else {
            uint2 w; w.x = pk2(v[0], v[1]); w.y = pk2(v[2], v[3]); *(uint2*)(G + (size_t)r * 512 + c) = w;
        }
    }
    template <int TYPE>
    __device__ __forceinline__ void all(const f32x4 (&acc)[2][2][4][2], const Unit& u, int wr, int wc, int fr, int fq) const {
        const int d = (u.pn >> 1) & 1, cb = (u.pn & 1) * 256 + wc * 32 + 8 * fq;
#pragma unroll
        for (int ai = 0; ai < 2; ++ai)
#pragma unroll
            for (int m = 0; m < 4; ++m)
#pragma unroll
                for (int bj = 0; bj < 2; ++bj)
                {   const int r = u.pm * BM + ai * HALF + wr * 64 + m * 16 + fr, c = cb + bj * HALF;
                    one<TYPE>(acc[ai][bj][m][0], r, c, d); one<TYPE>(acc[ai][bj][m][1], r, c + 4, d); }
    }
    __device__ __forceinline__ void operator()(const f32x4 (&acc)[2][2][4][2], const Unit& u, int wr, int wc, int fr, int fq) const {
        const int type = u.pn >> 1;
        if (type < 2) all<0>(acc, u, wr, wc, fr, fq); else if (type < 4) all<1>(acc, u, wr, wc, fr, fq); else all<2>(acc, u, wr, wc, fr, fq);
    }
};
}

DEV void transpose_item(const float* W, int K, int N, u16* WT, int mode, float* scr, int item, int lane) {
    const int nblk = N / 32, kb = item / nblk, nb = item - kb * nblk, k0 = 64 * kb, n0 = 32 * nb;
#pragma unroll 8
    for (int i = 0; i < 32; ++i) { const int kk = 2 * i + (lane >> 5); scr[kk * 33 + (lane & 31)] = W[(size_t)(k0 + kk) * N + n0 + (lane & 31)]; }
    asm volatile("s_waitcnt lgkmcnt(0)" ::: "memory");
    const int c = lane & 7;
#pragma unroll
    for (int j = 0; j < 4; ++j) {
        const int n = (lane >> 3) + 8 * j; const float* sp = scr + (8 * c) * 33 + n;
        uint4 o; o.x = pk2(sp[0 * 33], sp[1 * 33]); o.y = pk2(sp[2 * 33], sp[3 * 33]); o.z = pk2(sp[4 * 33], sp[5 * 33]); o.w = pk2(sp[6 * 33], sp[7 * 33]);
        const int ns = n0 + n;
        int drow = ns;
        if (mode) { const int nn = ns >= FFH ? 1 : 0; const int g = ns - nn * FFH; drow = 8 * (g >> 2) + 4 * nn + (g & 3); }
        *(uint4*)(WT + (size_t)drow * K + k0 + 8 * c) = o;
    }
    asm volatile("s_waitcnt lgkmcnt(0)" ::: "memory");
}
constexpr size_t WB_IN = 0, WB_OUT = (size_t)3328 * 1024, WB_F1 = WB_OUT + (size_t)1024 * 1024, WB_F2 = WB_F1 + (size_t)5632 * 1024;
DEV void phase_wprep(PPtr p, int layer, char* lds) {
    const int tid = tidx(), lane = tid & 63, wave = tid >> 6, gw = blockIdx.x * NWAVE + wave, ngw = gridDim.x * NWAVE;
    float* scr = (float*)lds + wave * (64 * 33);
    u16* WB = (u16*)(p->ws + OFF_WB);
    const int li = layer >> 1, odd = layer & 1;
    const int nin = odd ? 3328 : 1536;
    const float* win = odd ? p->in[13] + (size_t)li * DM * 3328 : p->in[8] + (size_t)li * DM * 1536;
    const float* wout = (odd ? p->in[14] : p->in[9]) + (size_t)li * DM * DM;
    const float* wf1 = p->in[27] + (size_t)layer * DM * 5632; const float* wf2 = p->in[28] + (size_t)layer * FFH * DM;
    const int i0 = 16 * (nin / 32), i1 = i0 + 16 * 32, i2 = i1 + 16 * 176, i3 = i2 + 44 * 32;
    for (int it = gw; it < i3; it += ngw) {
        if (it < i0) transpose_item(win, DM, nin, WB + WB_IN, 0, scr, it, lane);
        else if (it < i1) transpose_item(wout, DM, DM, WB + WB_OUT, 0, scr, it - i0, lane);
        else if (it < i2) transpose_item(wf1, DM, 5632, WB + WB_F1, 1, scr, it - i1, lane);
        else transpose_item(wf2, FFH, DM, WB + WB_F2, 0, scr, it - i2, lane);
    }
}

#include <hip/hip_bf16.h>
#include <cmath>
namespace attn_body {
using bf16=__hip_bfloat16;
using bf16x8=__attribute__((ext_vector_type(8)))short;
using s16x4=__attribute__((ext_vector_type(4)))short;
using f32x16=__attribute__((ext_vector_type(16)))float;
using u32x4=__attribute__((ext_vector_type(4)))unsigned;
constexpr int D=64,PQ=1536,PO=1024,KROWS=16640,RPBA=16640;
constexpr int NW=8,QBLK=32,QB=QBLK*NW,KVBLK=64;
constexpr int ATTN_UNIT_ROWS=QB;
__device__ __forceinline__ int crow(int r,int hi){return (r&3)+8*(r>>2)+4*hi;}
#define SBAR() __builtin_amdgcn_sched_barrier(0)
__device__ __forceinline__ void cmask(f32x16&p0,f32x16&p1,int jb,int qrel,int hi){
  const float NEG=-INFINITY; int kb=64*jb+4*hi;
  #pragma unroll
  for(int r=0;r<16;++r){int kv=kb+(r&3)+8*(r>>2); if(kv>qrel)p0[r]=NEG; if(kv+32>qrel)p1[r]=NEG;}
}

constexpr int NSLOT=3, SLOTB=8192;
constexpr int LDS_K=0, LDS_V=NSLOT*SLOTB, LDS_WS=2*NSLOT*SLOTB, LDS_OST=LDS_WS+NW*64*4, LDS_BYTES=LDS_OST+NW*4096;
constexpr float C2=0.125f*1.4426950408889634f;
__device__ __forceinline__ void glds16(const void*gsrc,unsigned lds_dst){unsigned keep;
  asm volatile("s_mov_b32 %0, m0\n\ts_mov_b32 m0, %2\n\ts_nop 0\n\tglobal_load_lds_dwordx4 %1, off\n\ts_mov_b32 m0, %0":"=&s"(keep):"v"(gsrc),"s"(lds_dst):"memory");}
__device__ __forceinline__ float max3f(float a,float b,float c){float r;asm("v_max3_f32 %0, %1, %2, %3":"=v"(r):"v"(a),"v"(b),"v"(c));return r;}
__device__ __forceinline__ float max2f(float a,float b){float r;asm("v_max_f32_e32 %0, %1, %2":"=v"(r):"v"(a),"v"(b));return r;}
__device__ __forceinline__ float fadd_s(float a,float b){float r;asm("v_add_f32_e32 %0, %1, %2":"=v"(r):"v"(a),"v"(b));return r;}
__device__ __forceinline__ float fsub_s(float a,float b){float r;asm("v_sub_f32_e32 %0, %1, %2":"=v"(r):"v"(a),"v"(b));return r;}
typedef float f32x2_t __attribute__((ext_vector_type(2))); typedef __bf16 bf16x2_t __attribute__((ext_vector_type(2)));
__device__ __forceinline__ unsigned cvtpk_s(float lo,float hi){f32x2_t v={lo,hi};bf16x2_t b=__builtin_convertvector(v,bf16x2_t);return __builtin_bit_cast(unsigned,b);}
#define WAIT_BAR(N) asm volatile("s_waitcnt vmcnt(" #N ") lgkmcnt(0)\n\ts_barrier":::"memory")

__device__ __forceinline__ void qkt(f32x16&p0,f32x16&p1,const char*Kslot,const bf16x8*qr,const f32x16&negm,int r32,int hi){
  const char*kb=Kslot+hi*1024+r32*16;
  #pragma unroll
  for(int d0=0;d0<4;++d0){
    const bf16x8 b0=*reinterpret_cast<const bf16x8*>(kb+d0*2048);
    const bf16x8 b1=*reinterpret_cast<const bf16x8*>(kb+d0*2048+512);
    if(d0==0){p0=__builtin_amdgcn_mfma_f32_32x32x16_bf16(b0,qr[0],negm,0,0,0);p1=__builtin_amdgcn_mfma_f32_32x32x16_bf16(b1,qr[0],negm,0,0,0);}
    else{p0=__builtin_amdgcn_mfma_f32_32x32x16_bf16(b0,qr[d0],p0,0,0,0);p1=__builtin_amdgcn_mfma_f32_32x32x16_bf16(b1,qr[d0],p1,0,0,0);}}
}
typedef __attribute__((address_space(3))) const char* lds_cptr;
typedef short v4i16_t __attribute__((ext_vector_type(4)));
__device__ __forceinline__ void kload8(bf16x8*kf,lds_cptr kp){
  kf[0]=*(const __attribute__((address_space(3))) bf16x8*)(kp);      kf[1]=*(const __attribute__((address_space(3))) bf16x8*)(kp+512);
  kf[2]=*(const __attribute__((address_space(3))) bf16x8*)(kp+2048); kf[3]=*(const __attribute__((address_space(3))) bf16x8*)(kp+2560);
  kf[4]=*(const __attribute__((address_space(3))) bf16x8*)(kp+4096); kf[5]=*(const __attribute__((address_space(3))) bf16x8*)(kp+4608);
  kf[6]=*(const __attribute__((address_space(3))) bf16x8*)(kp+6144); kf[7]=*(const __attribute__((address_space(3))) bf16x8*)(kp+6656);
}
__device__ __forceinline__ void kload2(bf16x8*kf,lds_cptr kp,int j){ kf[2*j]=*(const __attribute__((address_space(3))) bf16x8*)(kp+j*2048); kf[2*j+1]=*(const __attribute__((address_space(3))) bf16x8*)(kp+j*2048+512); }
__device__ __forceinline__ s16x4 vtr(lds_cptr p){ return __builtin_bit_cast(s16x4,__builtin_amdgcn_ds_read_tr16_b64_v4i16((__attribute__((address_space(3))) v4i16_t*)p)); }
__device__ __forceinline__ float rowmax(const f32x16&p0,const f32x16&p1){
  float a=max3f(p0[0],p0[1],p1[0]),b=max3f(p0[2],p0[3],p1[1]);a=max3f(a,p1[2],p1[3]);
  #pragma unroll
  for(int r=4;r<16;r+=4){a=max3f(a,p0[r],p0[r+1]);b=max3f(b,p0[r+2],p0[r+3]);a=max3f(a,p1[r],p1[r+1]);b=max3f(b,p1[r+2],p1[r+3]);}
  const float m=max2f(a,b);
  auto rr=__builtin_amdgcn_permlane32_swap(__float_as_uint(m),__float_as_uint(m),false,false);
  return max2f(__uint_as_float(rr[0]),__uint_as_float(rr[1]));
}
__device__ __forceinline__ void pv(f32x16*o,int vb,bf16x8 pa0,bf16x8 pa1,bf16x8 pa2,bf16x8 pa3){
  #pragma unroll
  for(int d0=0;d0<2;++d0){s16x4 lo[4],hi[4];
    #pragma unroll
    for(int ks=0;ks<4;++ks){
      asm volatile("ds_read_b64_tr_b16 %0,%1 offset:%c2":"=&v"(lo[ks]):"v"(vb),"i"(d0*4096+ks*1024):"memory");
      asm volatile("ds_read_b64_tr_b16 %0,%1 offset:%c2":"=&v"(hi[ks]):"v"(vb),"i"(d0*4096+ks*1024+512):"memory");}
    asm volatile("s_waitcnt lgkmcnt(0)":::"memory");SBAR();
    #define PK(k) (bf16x8){lo[k][0],lo[k][1],lo[k][2],lo[k][3],hi[k][0],hi[k][1],hi[k][2],hi[k][3]}
    o[d0]=__builtin_amdgcn_mfma_f32_32x32x16_bf16(pa0,PK(0),o[d0],0,0,0);
    o[d0]=__builtin_amdgcn_mfma_f32_32x32x16_bf16(pa1,PK(1),o[d0],0,0,0);
    o[d0]=__builtin_amdgcn_mfma_f32_32x32x16_bf16(pa2,PK(2),o[d0],0,0,0);
    o[d0]=__builtin_amdgcn_mfma_f32_32x32x16_bf16(pa3,PK(3),o[d0],0,0,0);
    #undef PK
  }
}

#ifndef ATTN_STORE16
#define ATTN_STORE16(p,v) (*(u32x4*)(p)=(v))
#endif
template<int THRL> __device__ __forceinline__ void attn_unit(int b,int h,int qb,const bf16*Q,const bf16*__restrict__ K,const bf16*__restrict__ V,bf16*O,char*shm){
  const int tid=tidx(),lane=tid&63,r32=lane&31,hi=lane>>5; const int wid=__builtin_amdgcn_readfirstlane(tid>>6);
  const long rowbase=(long)b*RPBA; const int q0=qb*QB;
  const bf16*Qw=Q+(rowbase+q0+wid*QBLK)*PQ+h*D;
  const bf16*Kh=K+rowbase*PQ+(h>>2)*D,*Vh=V+rowbase*PQ+(h>>2)*D;
  const unsigned lds0=(unsigned)(uintptr_t)shm;
  float*wsf=(float*)(shm+LDS_WS)+wid*64;
  const bf16*ksrc=Kh+(long)lane*PQ+wid*8;
  const bf16*vsrc=Vh+(long)(16*(wid&3)+(lane>>2))*PQ+(wid>>2)*32+(lane&3)*8;
  const unsigned kdst=lds0+LDS_K+wid*1024, vdst=lds0+LDS_V+wid*1024;
  #define DMA_K(t,slot) glds16(ksrc+(long)(t)*KVBLK*PQ,(unsigned)__builtin_amdgcn_readfirstlane(kdst+(slot)))
  #define DMA_V(t,slot) glds16(vsrc+(long)(t)*KVBLK*PQ,(unsigned)__builtin_amdgcn_readfirstlane(vdst+(slot)))
  const int vb0=(int)(lds0+LDS_V)+((lane>>4)&1)*32+(lane&3)*8+(4*hi+((lane&15)>>2))*64;
  const char*Kbase=shm+LDS_K; bf16x8 kf[8];
  const lds_cptr shm3=(lds_cptr)shm; const lds_cptr kp0=shm3+LDS_K+hi*1024+r32*16; const lds_cptr vp0=shm3+LDS_V+((lane>>4)&1)*32+(lane&3)*8+(4*hi+((lane&15)>>2))*64;
  const int NT=KROWS/KVBLK;
  DMA_K(0,0);DMA_V(0,0);DMA_K(1,SLOTB);
  bf16x8 qr[4];
  #pragma unroll
  for(int d0=0;d0<4;++d0)qr[d0]=*reinterpret_cast<const bf16x8*>(&Qw[(long)r32*PQ+d0*16+hi*8]);
  float mhat=0.f,l_reg=0.f;f32x16 o[2];o[0]=f32x16{};o[1]=f32x16{};f32x16 negm=f32x16{};asm volatile("":"+v"(negm));
  const int qrel=wid*QBLK+r32;
  #define CMASK(P0,P1,t) do{}while(0)
  bool resc=false;
  #define START(P0,P1) do{ const float rm=rowmax(P0,P1); resc=false; \
    { const float dl=rm; mhat=fadd_s(mhat,dl); \
      _Pragma("unroll") for(int r=0;r<16;++r){P0[r]=fsub_s(P0[r],dl);P1[r]=fsub_s(P1[r],dl);} \
      _Pragma("unroll") for(int r=0;r<16;++r)negm[r]=-mhat; asm volatile("":"+v"(negm)); } \
    _Pragma("unroll") for(int r=0;r<16;++r)P0[r]=__builtin_amdgcn_exp2f(P0[r]); }while(0)
  #define RESC() do{ if(resc){ asm volatile("s_waitcnt lgkmcnt(0)":::"memory"); \
      _Pragma("unroll") for(int d_=0;d_<2;++d_) _Pragma("unroll") for(int r=0;r<16;++r)o[d_][r]*=wsf[crow(r,hi)]; } }while(0)
  f32x16 pA0,pA1,pB0,pB1;
  int sl_prev=0,sl_cur=0,sl_next=SLOTB;
  #define ROT() do{sl_prev=sl_cur;sl_cur=sl_next;sl_next=(sl_next==(NSLOT-1)*SLOTB)?0:sl_next+SLOTB;}while(0)
  DMA_K(2,2*SLOTB);
  WAIT_BAR(3);
  qkt(pA0,pA1,Kbase,qr,negm,r32,hi);asm volatile("s_nop 15\n\ts_nop 7":"+v"(pA0),"+v"(pA1));CMASK(pA0,pA1,0);
  START(pA0,pA1);
  _Pragma("unroll") for(int r=0;r<16;++r)pA1[r]=__builtin_amdgcn_exp2f(pA1[r]);
  WAIT_BAR(0);
  DMA_K(3,0);DMA_V(1,SLOTB);
  ROT();
  kload8(kf,kp0+sl_cur);
  WAIT_BAR(2);
  s16x4 vlo[8],vhi[8]; u32x4 pw0,pw1,pw2,pw3;
  #define PKW(P,B) cvtpk_s(P[B],P[B+1])
  #define PAF(k) __builtin_bit_cast(bf16x8,pw##k)
  #define VFR(i) (bf16x8){vlo[i][0],vlo[i][1],vlo[i][2],vlo[i][3],vhi[i][0],vhi[i][1],vhi[i][2],vhi[i][3]}
  #define PIN(x) asm volatile("":"+v"(x))
  #define MX3(a,b,c) __builtin_fmaxf(__builtin_fmaxf((a),(b)),(c))
  #define GAPA(MF,A0,A1,A2,A3,W0,W1,PW) do{ MF; sacc+=A0; sacc+=A1; sacc+=A2; sacc+=A3; PIN(sacc); W0; W1; PIN(PW); SBAR(); }while(0)
  #define EX(v) __builtin_amdgcn_exp2f(v)
  #define GAPB(MF,X,B) do{ MF; X[B]=EX(X[B]); X[B+1]=EX(X[B+1]); X[B+2]=EX(X[B+2]); X[B+3]=EX(X[B+3]); PIN(X); SBAR(); }while(0)
  #define VRD(i) do{ vlo[i]=vtr(vp_+(((i)>>2)*4096+((i)&3)*1024)); vhi[i]=vtr(vp_+(((i)>>2)*4096+((i)&3)*1024+512)); }while(0)
  #define KRD(G,j) do{ if(G){ kload2(kf,kp0+sl_next,j); SBAR(); } }while(0)
  #define STEP(C0,C1,P0,P1,t,GK,GV,GL) do{ SBAR(); \
    const lds_cptr vp_=vp0+sl_prev; \
    VRD(0); SBAR(); float sacc=(P0[0]+P0[1]); \
    GAPA(C0=__builtin_amdgcn_mfma_f32_32x32x16_bf16(kf[0],qr[0],negm,0,0,0), P0[2],P0[3],P0[4],P0[5],     pw0[0]=PKW(P0,0), pw0[1]=PKW(P0,2), pw0); \
    VRD(4); SBAR(); GAPA(C1=__builtin_amdgcn_mfma_f32_32x32x16_bf16(kf[1],qr[0],negm,0,0,0), P0[6],P0[7],P0[8],P0[9],     pw0[2]=PKW(P0,4), pw0[3]=PKW(P0,6), pw0); \
    VRD(1); SBAR(); GAPA(C0=__builtin_amdgcn_mfma_f32_32x32x16_bf16(kf[2],qr[1],C0,0,0,0),   P0[10],P0[11],P0[12],P0[13], pw1[0]=PKW(P0,8), pw1[1]=PKW(P0,10), pw1); \
    VRD(5); SBAR(); GAPA(C1=__builtin_amdgcn_mfma_f32_32x32x16_bf16(kf[3],qr[1],C1,0,0,0),   P0[14],P0[15],P1[0],P1[1],   pw1[2]=PKW(P0,12),pw1[3]=PKW(P0,14), pw1); \
    VRD(2); SBAR(); GAPA(C0=__builtin_amdgcn_mfma_f32_32x32x16_bf16(kf[4],qr[2],C0,0,0,0),   P1[2],P1[3],P1[4],P1[5],     pw2[0]=PKW(P1,0), pw2[1]=PKW(P1,2), pw2); \
    VRD(6); SBAR(); GAPA(C1=__builtin_amdgcn_mfma_f32_32x32x16_bf16(kf[5],qr[2],C1,0,0,0),   P1[6],P1[7],P1[8],P1[9],     pw2[2]=PKW(P1,4), pw2[3]=PKW(P1,6), pw2); \
    VRD(3); SBAR(); GAPA(C0=__builtin_amdgcn_mfma_f32_32x32x16_bf16(kf[6],qr[3],C0,0,0,0),   P1[10],P1[11],P1[12],P1[13], pw3[0]=PKW(P1,8), pw3[1]=PKW(P1,10), pw3); \
    VRD(7); SBAR(); GAPA(C1=__builtin_amdgcn_mfma_f32_32x32x16_bf16(kf[7],qr[3],C1,0,0,0),   P1[14],P1[15],0.f,0.f,       pw3[2]=PKW(P1,12),pw3[3]=PKW(P1,14), pw3); \
    l_reg+=sacc; \
    if(GK){DMA_K((t)+3,sl_cur);} if(GV){DMA_V((t)+1,sl_next);} \
    CMASK(C0,C1,t); \
    { float a=MX3(C0[0],C0[1],C1[0]),b=MX3(C0[2],C0[3],C1[1]); a=MX3(a,C1[2],C1[3]); \
      _Pragma("unroll") for(int r=4;r<16;r+=4){a=MX3(a,C0[r],C0[r+1]);b=MX3(b,C0[r+2],C0[r+3]);a=MX3(a,C1[r],C1[r+1]);b=MX3(b,C1[r+2],C1[r+3]);} \
      float rm=__builtin_fmaxf(a,b); { auto rr=__builtin_amdgcn_permlane32_swap(__float_as_uint(rm),__float_as_uint(rm),false,false); rm=__builtin_fmaxf(__uint_as_float(rr[0]),__uint_as_float(rr[1])); } \
      resc=false; \
      if(__builtin_expect(__any(rm>(float)THRL),0)){ const float dl=__builtin_fmaxf(rm,0.f); mhat+=dl; \
        _Pragma("unroll") for(int r=0;r<16;++r){C0[r]-=dl;C1[r]-=dl;} \
        _Pragma("unroll") for(int r=0;r<16;++r)negm[r]=-mhat; asm volatile("":"+v"(negm)); \
        const float f=__builtin_amdgcn_exp2f(-dl); l_reg*=f; if(hi==0)wsf[r32]=f; resc=true; } } \
    SBAR(); \
    GAPB(o[0]=__builtin_amdgcn_mfma_f32_32x32x16_bf16(PAF(0),VFR(0),o[0],0,0,0), C0,0); \
    GAPB(o[1]=__builtin_amdgcn_mfma_f32_32x32x16_bf16(PAF(0),VFR(4),o[1],0,0,0), C0,4); \
    KRD(GL,0); GAPB(o[0]=__builtin_amdgcn_mfma_f32_32x32x16_bf16(PAF(1),VFR(1),o[0],0,0,0), C0,8); \
    KRD(GL,1); GAPB(o[1]=__builtin_amdgcn_mfma_f32_32x32x16_bf16(PAF(1),VFR(5),o[1],0,0,0), C0,12); \
    KRD(GL,2); GAPB(o[0]=__builtin_amdgcn_mfma_f32_32x32x16_bf16(PAF(2),VFR(2),o[0],0,0,0), C1,0); \
    KRD(GL,3); GAPB(o[1]=__builtin_amdgcn_mfma_f32_32x32x16_bf16(PAF(2),VFR(6),o[1],0,0,0), C1,4); \
    GAPB(o[0]=__builtin_amdgcn_mfma_f32_32x32x16_bf16(PAF(3),VFR(3),o[0],0,0,0), C1,8); \
    GAPB(o[1]=__builtin_amdgcn_mfma_f32_32x32x16_bf16(PAF(3),VFR(7),o[1],0,0,0), C1,12); \
    }while(0)
  int t=1;
  #undef CMASK
  #define CMASK(P0,P1,t) do{}while(0)
  for(;t+5<NT;t+=2){
    STEP(pB0,pB1,pA0,pA1,t,true,true,true);     WAIT_BAR(2); RESC(); ROT();
    STEP(pA0,pA1,pB0,pB1,t+1,true,true,true);   WAIT_BAR(2); RESC(); ROT();
  }
  #undef CMASK
  #define CMASK(P0,P1,t) do{}while(0)
  #define ENDW(tt) do{ if((tt)+3<NT){WAIT_BAR(2);} else if((tt)+2<NT){WAIT_BAR(1);} else {WAIT_BAR(0);} }while(0)
  for(;t+1<NT;t+=2){
    STEP(pB0,pB1,pA0,pA1,t,(t+3<NT),(t+1<NT),(t+1<NT));       ENDW(t);   RESC(); ROT();
    STEP(pA0,pA1,pB0,pB1,t+1,(t+4<NT),(t+2<NT),(t+2<NT));     ENDW(t+1); RESC(); ROT();
  }
  STEP(pB0,pB1,pA0,pA1,NT-1,false,false,false); RESC();
  { float sacc=pB0[0]+pB0[1]; _Pragma("unroll") for(int r=2;r<16;++r)sacc+=pB0[r]; _Pragma("unroll") for(int r=0;r<16;++r)sacc+=pB1[r]; l_reg+=sacc;
    pw0=(u32x4){PKW(pB0,0),PKW(pB0,2),PKW(pB0,4),PKW(pB0,6)};pw1=(u32x4){PKW(pB0,8),PKW(pB0,10),PKW(pB0,12),PKW(pB0,14)};pw2=(u32x4){PKW(pB1,0),PKW(pB1,2),PKW(pB1,4),PKW(pB1,6)};pw3=(u32x4){PKW(pB1,8),PKW(pB1,10),PKW(pB1,12),PKW(pB1,14)};
    SBAR(); pv(o,vb0+sl_cur,PAF(0),PAF(1),PAF(2),PAF(3)); }
  #undef PKW
  #undef PAF
  #undef VFR
  #undef PIN
  #undef MX3
  #undef GAPA
  #undef GAPB
  #undef EX
  #undef VRD
  #undef KRD
  #undef STEP
  #undef ENDW
  {auto rr=__builtin_amdgcn_permlane32_swap(__float_as_uint(l_reg),__float_as_uint(l_reg),false,false);l_reg=__uint_as_float(rr[0])+__uint_as_float(rr[1]);}
  if(hi==0)wsf[32+r32]=l_reg;asm volatile("s_waitcnt lgkmcnt(0)":::"memory");
  float rli[16];
  #pragma unroll
  for(int r=0;r<16;++r)rli[r]=__builtin_amdgcn_rcpf(wsf[32+crow(r,hi)]);
  bf16*Ow=O+(rowbase+q0+wid*QBLK)*PO+h*D;
  { bf16*stg=(bf16*)(shm+LDS_OST)+wid*2048;
    #pragma unroll
    for(int r=0;r<16;++r){const int orow=crow(r,hi);
      #pragma unroll
      for(int d0=0;d0<2;++d0)stg[orow*64+d0*32+r32]=__float2bfloat16(o[d0][r]*rli[r]);}
    asm volatile("s_waitcnt lgkmcnt(0)":::"memory");
    #pragma unroll
    for(int i=0;i<4;++i){const int row=i*8+(lane>>3),ch=lane&7; const u32x4 v=*(const u32x4*)(stg+row*64+ch*8); ATTN_STORE16(Ow+(long)row*PO+ch*8,v);} }
  asm volatile("s_waitcnt lgkmcnt(0)\n\ts_barrier":::"memory");
  #undef DMA_K
  #undef DMA_V
  #undef CMASK
  #undef START
  #undef RESC
  #undef ROT
}
constexpr int ATTN_LDS_BYTES=LDS_BYTES;
#undef SBAR
#undef WAIT_BAR
}

DEV void phase_even_post(PPtr p, int li) {
    const int tid = tidx(), lane = tid & 63, gw = blockIdx.x * NWAVE + (tid >> 6), ngw = gridDim.x * NWAVE;
    u16* RAW = (u16*)(p->ws + OFF_RAW);
    const float* qg = p->in[10] + li * 64; const float* kg = p->in[11] + li * 64;
    const float* T = (const float*)(p->ws + OFF_ROPE);
    const int w8 = (lane & 7) * 8, i0 = w8 & 31; const bool second = (lane & 4) != 0;
    for (int item = gw; item < MROWS * 3; item += ngw) {
        const int m = item / 3, pass = item - 3 * m;
        if (pass == 2 && lane >= 32) continue;
        const int b = m / RPB, q = m - b * RPB;
        const int sl = pass * 8 + (lane >> 3);
        const int c0 = sl < 8 ? sl * 64 : sl < 10 ? 512 + (sl - 8) * 64 : sl < 18 ? 768 + (sl - 10) * 64 : 1280 + (sl - 18) * 64;
        u16* ptr = RAW + (size_t)m * 1536 + c0 + w8;
        float x[8]; unpack8(*(const uint4*)ptr, x);
        if (sl < 10) {
            const float* gn = (sl < 8 ? qg : kg) + w8;
            float ss = 0.f;
#pragma unroll
            for (int e = 0; e < 8; ++e) ss += x[e] * x[e];
            ss += __shfl_xor(ss, 1); ss += __shfl_xor(ss, 2); ss += __shfl_xor(ss, 4);
            const float rs = rsqrtf(ss * (1.f / 64.f) + 1e-6f);
            const float4 g0 = *(const float4*)gn, g1 = *(const float4*)(gn + 4);
            x[0] *= rs * g0.x; x[1] *= rs * g0.y; x[2] *= rs * g0.z; x[3] *= rs * g0.w; x[4] *= rs * g1.x; x[5] *= rs * g1.y; x[6] *= rs * g1.z; x[7] *= rs * g1.w;
        }
        if (q < SEQ) {
            const float* ct = (i0 < 16) ? T + (q >> 6) * 16 + i0 : T + 8192 + (q & 63) * 16 + (i0 - 16);
            const float* st = ct + ((i0 < 16) ? 4096 : 1024);
            const float4 c0v = *(const float4*)ct, c1v = *(const float4*)(ct + 4), s0v = *(const float4*)st, s1v = *(const float4*)(st + 4);
            const float cs[8] = {c0v.x, c0v.y, c0v.z, c0v.w, c1v.x, c1v.y, c1v.z, c1v.w}, sn[8] = {s0v.x, s0v.y, s0v.z, s0v.w, s1v.x, s1v.y, s1v.z, s1v.w};
            const float sc = (sl < 8) ? attn_body::C2 : 1.f;
#pragma unroll
            for (int e = 0; e < 8; ++e) {
                const float other = __shfl_xor(x[e], 4);
                const float o = second ? (other * sn[e] + x[e] * cs[e]) : (x[e] * cs[e] - other * sn[e]);
                x[e] = o * sc;
            }
        }
        *(uint4*)ptr = pack8(x);
    }
}

template <int mode, bool qctx>
DEV void attn_wave(const u16* QB, int pitch, int qcol, int kcol, int vcol, u16* AO, int ocol,
                   int b, int hk, int blk, const float* sinkp, const float* rpb, u16* sV) {
    const int lane = tidx() & 63, qi = lane & 15, quad = lane >> 4;
    const bool gqa = mode < 2;
    const size_t rowb = (size_t)b * RPB;
    const float SCL = 0.125f * LOG2E;
    int qtok[4], qhead[4]; bf16x8 qf[4][2];
#pragma unroll
    for (int i = 0; i < 4; ++i) {
        qtok[i] = gqa ? blk * 16 + qi : blk * 64 + i * 16 + qi; qhead[i] = gqa ? hk * 4 + i : hk;
        const size_t m = rowb + (qctx ? SEQ : 0) + qtok[i];
        const u16* qp = QB + m * pitch + qcol + qhead[i] * 64 + quad * 8;
        qf[i][0] = *(const bf16x8*)qp; qf[i][1] = *(const bf16x8*)(qp + 32);
    }
    f32x4 o[4][4]; float mrun[4], lrun[4];
#pragma unroll
    for (int i = 0; i < 4; ++i) {
#pragma unroll
        for (int d = 0; d < 4; ++d) o[i][d] = (f32x4){0.f, 0.f, 0.f, 0.f};
        if (mode == 1) { mrun[i] = sinkp[qhead[i]] * LOG2E; lrun[i] = (quad == 0) ? 1.f : 0.f; } else { mrun[i] = -1e30f; lrun[i] = 0.f; }
    }
    const u16* Kb = QB + kcol + hk * 64; const u16* Vb = QB + vcol + hk * 64;
    float* srpb = (float*)(sV + 32 * 72);
    if (mode == 2) { for (int t = lane; t < 15 * 31; t += 64) srpb[t] = rpb[hk * (15 * 31) + t]; }
    int n_local, ustart, rs = 0;
    if (qctx) { n_local = 0; ustart = 0; }
    else if (mode == 0) { n_local = RPB / 32; ustart = 0; }
    else if (mode == 1) { n_local = 9; ustart = blk * 16 - 128; }
    else { rs = min(max(blk - 4, 0), 248); n_local = 16; ustart = rs * 64; }
    const int n_ctx = (mode == 0 && !qctx) ? 0 : 8;
    for (int tt = 0; tt < n_local + n_ctx; ++tt) {
        const bool loc = tt < n_local;
        const int u0 = loc ? ustart + 32 * tt : SEQ + 32 * (tt - n_local);
        const bool masked = loc && mode != 0;
        bf16x8 kf[2][2];
#pragma unroll
        for (int kt = 0; kt < 2; ++kt) {
            const int u = min(max(u0 + kt * 16 + qi, 0), RPB - 1);
            const u16* kp = Kb + (rowb + u) * pitch + quad * 8;
            kf[kt][0] = *(const bf16x8*)kp; kf[kt][1] = *(const bf16x8*)(kp + 32);
        }
#pragma unroll
        for (int c = 0; c < 4; ++c) {
            const int idx = c * 64 + lane, key = idx >> 3, dc = idx & 7;
            const int u = min(max(u0 + key, 0), RPB - 1);
            const uint4 v = *(const uint4*)(Vb + (rowb + u) * pitch + dc * 8);
            *(uint4*)(sV + key * 72 + dc * 8) = v;
        }
        bf16x8 vf[4];
#pragma unroll
        for (int dt = 0; dt < 4; ++dt)
#pragma unroll
            for (int jj = 0; jj < 8; ++jj) {
                const int key = (jj < 4) ? quad * 4 + jj : 16 + quad * 4 + (jj - 4);
                vf[dt][jj] = (short)sV[key * 72 + dt * 16 + qi];
            }
#pragma unroll
        for (int i = 0; i < 4; ++i) {
            if (mode == 2 && loc && ((i == 0 && (tt & 1) == 1) || (i == 3 && (tt & 1) == 0))) continue;
            f32x4 s0 = (f32x4){0.f, 0.f, 0.f, 0.f}, s1 = (f32x4){0.f, 0.f, 0.f, 0.f};
            s0 = __builtin_amdgcn_mfma_f32_16x16x32_bf16(kf[0][0], qf[i][0], s0, 0, 0, 0);
            s0 = __builtin_amdgcn_mfma_f32_16x16x32_bf16(kf[0][1], qf[i][1], s0, 0, 0, 0);
            s1 = __builtin_amdgcn_mfma_f32_16x16x32_bf16(kf[1][0], qf[i][0], s1, 0, 0, 0);
            s1 = __builtin_amdgcn_mfma_f32_16x16x32_bf16(kf[1][1], qf[i][1], s1, 0, 0, 0);
            float sc[8];
#pragma unroll
            for (int j = 0; j < 4; ++j) { sc[j] = s0[j] * SCL; sc[4 + j] = s1[j] * SCL; }
            if (masked) {
                const int t = qtok[i];
#pragma unroll
                for (int e = 0; e < 8; ++e) {
                    const int u = u0 + (e >> 2) * 16 + quad * 4 + (e & 3);
                    if (mode == 1) {
                        const int dd = t - u;
                        const bool ok = (u >= 0) && (u < SEQ) && (dd <= 128) && (dd >= -128);
                        if (!ok) sc[e] = -INFINITY;
                    } else {
                        const int c = t & 63, r = t >> 6, ur = u >> 6, uc = u & 63;
                        const int cst = min(max(c - 8, 0), 48);
                        const bool ok = (uc >= cst) && (uc < cst + 16);
                        const int dr = min(max(ur - r + 7, 0), 14), dcx = min(max(uc - c + 15, 0), 30);
                        const float bias = srpb[dr * 31 + dcx];
                        sc[e] = ok ? sc[e] + bias * LOG2E : -INFINITY;
                    }
                }
            }
            float mx = fmaxf(fmaxf(fmaxf(sc[0], sc[1]), fmaxf(sc[2], sc[3])), fmaxf(fmaxf(sc[4], sc[5]), fmaxf(sc[6], sc[7])));
            mx = fmaxf(mx, __shfl_xor(mx, 16)); mx = fmaxf(mx, __shfl_xor(mx, 32));
            const float mn = fmaxf(mrun[i], mx);
            const float al = __builtin_amdgcn_exp2f(mrun[i] - mn);
            mrun[i] = mn;
            float pe[8], ps = 0.f;
#pragma unroll
            for (int e = 0; e < 8; ++e) { pe[e] = __builtin_amdgcn_exp2f(sc[e] - mn); ps += pe[e]; }
            lrun[i] = lrun[i] * al + ps;
            union { unsigned u[4]; bf16x8 v; } pf;
            pf.u[0] = pk2(pe[0], pe[1]); pf.u[1] = pk2(pe[2], pe[3]); pf.u[2] = pk2(pe[4], pe[5]); pf.u[3] = pk2(pe[6], pe[7]);
#pragma unroll
            for (int dt = 0; dt < 4; ++dt) {
                o[i][dt] = o[i][dt] * al;
                o[i][dt] = __builtin_amdgcn_mfma_f32_16x16x32_bf16(vf[dt], pf.v, o[i][dt], 0, 0, 0);
            }
        }
    }
#pragma unroll
    for (int i = 0; i < 4; ++i) {
        float l = lrun[i]; l += __shfl_xor(l, 16); l += __shfl_xor(l, 32);
        const float inv = 1.f / l;
        const size_t m = rowb + (qctx ? SEQ : 0) + qtok[i];
        u16* op = AO + m * DM + ocol + qhead[i] * 64 + quad * 4;
#pragma unroll
        for (int dt = 0; dt < 4; ++dt) {
            uint2 w; w.x = pk2(o[i][dt][0] * inv, o[i][dt][1] * inv); w.y = pk2(o[i][dt][2] * inv, o[i][dt][3] * inv);
            *(uint2*)(op + dt * 16) = w;
        }
    }
}

DEV void phase_attn_even(PPtr p, int li, char* lds) {
    {
        const attn_body::bf16* RAWb = (const attn_body::bf16*)(p->ws + OFF_RAW); attn_body::bf16* AOb = (attn_body::bf16*)(p->ws + OFF_AO);
        const int G = gridDim.x, bx = blockIdx.x;
        if (G == 256) {
            const int vcu = (bx & 7) * 32 + (bx >> 3); const int x = vcu >> 5, combo = x >> 1, sub = (x & 1) * 32 + (vcu & 31);
            for (int i = 0; i < 4; ++i) attn_body::attn_unit<8>(combo >> 1, (combo & 1) * 4 + i, sub, RAWb, RAWb + 512, RAWb + 640, AOb, lds);
        } else {
            for (int u = bx; u < 1024; u += G) attn_body::attn_unit<8>(u >> 9, (u >> 6) & 7, u & 63, RAWb, RAWb + 512, RAWb + 640, AOb, lds);
        }
    }
    const int wave = tidx() >> 6, gw = blockIdx.x * NWAVE + wave, ngw = gridDim.x * NWAVE;
    u16* sV = (u16*)lds + wave * 3328;
    const u16* RAW = (const u16*)(p->ws + OFF_RAW); u16* AO = (u16*)(p->ws + OFF_AO);
    const float* sink = p->in[12] + li * 8;
    for (int t = gw; t < 4224; t += ngw) {
        if (t < 4096) attn_wave<1, false>(RAW, 1536, 768, 1280, 1408, AO, 512, t >> 11, (t >> 10) & 1, t & 1023, sink, nullptr, sV);
        else if (t < 4160) { const int u = t - 4096; attn_wave<0, true>(RAW, 1536, 0, 512, 640, AO, 0, u >> 5, (u >> 4) & 1, u & 15, nullptr, nullptr, sV); }
        else { const int u = t - 4160; attn_wave<1, true>(RAW, 1536, 768, 1280, 1408, AO, 512, u >> 5, (u >> 4) & 1, u & 15, sink, nullptr, sV); }
    }
}
DEV void phase_attn_odd(PPtr p, int li, char* lds) {
    const int wave = tidx() >> 6, gw = blockIdx.x * NWAVE + wave, ngw = gridDim.x * NWAVE;
    u16* sV = (u16*)lds + wave * 3328;
    const u16* QKV = (const u16*)(p->ws + OFF_RAW); u16* AO = (u16*)(p->ws + OFF_AO);
    const float* rpb = p->in[15] + li * 8 * 15 * 31;
    for (int t = gw; t < 4160; t += ngw) {
        if (t < 4096) attn_wave<2, false>(QKV, 1536, 0, 512, 1024, AO, 0, t >> 11, (t >> 8) & 7, t & 255, nullptr, rpb, sV);
        else { const int u = t - 4096; attn_wave<2, true>(QKV, 1536, 0, 512, 1024, AO, 0, u >> 5, (u >> 2) & 7, u & 3, nullptr, rpb, sV); }
    }
}

DEV float shiftmix_at(const u16* ZDb, int pp, int ch, float mu) {
    const bool lat = pp < SEQ; const int lo = lat ? 0 : SEQ, hi = lat ? SEQ : RPB;
    const u16* zc = ZDb + (size_t)pp * ZDW + ch;
    const float z = bf2f(zc[0]);
    const float a = (pp - 1 >= lo) ? bf2f(zc[-ZDW]) : 0.f, c = (pp + 1 < hi) ? bf2f(zc[ZDW]) : 0.f;
    return z + (0.5f * (a + c) - z) * mu;
}
DEV void phase_rwkv_prep(PPtr p, int li, int bb) {
    const int tid = tidx(), lane = tid & 63, gw = blockIdx.x * NWAVE + (tid >> 6), ngw = gridDim.x * NWAVE;
    const u16* ZDb = (const u16*)(p->ws + OFF_ZD) + (size_t)bb * RPB * ZDW;
    const float* mu = p->in[16] + li * ZDW; const float* kkw = p->in[22] + li * 512;
    u16* R = (u16*)(p->ws + OFF_R); u16* KK = (u16*)(p->ws + OFF_KK); u16* V = (u16*)(p->ws + OFF_V); u16* LA = (u16*)(p->ws + OFF_LA);
    {
        u16* LB = (u16*)(p->ws + OFF_PU);
        const float* w2 = p->in[18] + (size_t)li * 2 * 64 * 512; const float* a2 = p->in[20] + (size_t)li * 2 * 64 * 512; const float* g2 = p->in[21] + (size_t)li * 128 * 512;
        for (int idx = gw * 64 + lane; idx < 2560 * 32; idx += ngw * 64) {
            const int n = idx >> 5, kc = (idx & 31) * 8, type = n >> 9, nn = n & 511;
            float f[8];
#pragma unroll
            for (int e = 0; e < 8; ++e) {
                const int k = kc + e; float x = 0.f;
                if (type < 2) { if (k < 64) x = w2[((size_t)type * 64 + k) * 512 + nn]; }
                else if (type < 4) { if (k >= 64 && k < 128) x = a2[((size_t)(type - 2) * 64 + (k - 64)) * 512 + nn]; }
                else { if (k >= 128) x = g2[(size_t)(k - 128) * 512 + nn]; }
                f[e] = x;
            }
            *(uint4*)(LB + (size_t)n * 256 + kc) = pack8(f);
        }
    }
    for (int pp = gw; pp < RPB; pp += ngw) {
        const bool lat = pp < SEQ; const int lo = lat ? 0 : SEQ, hi = lat ? SEQ : RPB;
        const bool hp = pp - 1 >= lo, hn = pp + 1 < hi;
        const u16* zc = ZDb + (size_t)pp * ZDW;
#pragma unroll
        for (int j = 0; j < 4; ++j) {
            const int c8 = lane + 64 * j;
            if (j == 3 && lane >= 32) break;
            const int ch = 8 * c8;
            float z[8], a[8], c[8], zs[8];
            unpack8(*(const uint4*)(zc + ch), z);
            if (hp) unpack8(*(const uint4*)(zc - ZDW + ch), a); else { for (int e = 0; e < 8; ++e) a[e] = 0.f; }
            if (hn) unpack8(*(const uint4*)(zc + ZDW + ch), c); else { for (int e = 0; e < 8; ++e) c[e] = 0.f; }
            const float4 m0 = *(const float4*)(mu + ch), m1 = *(const float4*)(mu + ch + 4);
            const float mm[8] = {m0.x, m0.y, m0.z, m0.w, m1.x, m1.y, m1.z, m1.w};
#pragma unroll
            for (int e = 0; e < 8; ++e) zs[e] = z[e] + (0.5f * (a[e] + c[e]) - z[e]) * mm[e];
            if (j == 0) *(uint4*)(R + (size_t)pp * 512 + ch) = pack8(zs);
            else if (j == 1) {
                const float4 k0 = *(const float4*)(kkw + ch - 512), k1 = *(const float4*)(kkw + ch - 512 + 4);
                const float kw[8] = {k0.x, k0.y, k0.z, k0.w, k1.x, k1.y, k1.z, k1.w};
                float t[8], ss = 0.f;
#pragma unroll
                for (int e = 0; e < 8; ++e) { t[e] = zs[e] * kw[e]; ss += t[e] * t[e]; }
                ss += __shfl_xor(ss, 1); ss += __shfl_xor(ss, 2); ss += __shfl_xor(ss, 4);
                const float inv = 1.f / fmaxf(sqrtf(ss), 1e-12f);
#pragma unroll
                for (int e = 0; e < 8; ++e) t[e] *= inv;
                *(uint4*)(KK + (size_t)pp * 512 + ch - 512) = pack8(t);
            } else if (j == 2) *(uint4*)(V + (size_t)pp * 512 + ch - 1024) = pack8(zs);
            else {
                float o[8];
#pragma unroll
                for (int e = 0; e < 8; ++e) o[e] = (lane < 8) ? tanhf(zs[e]) : (lane < 16) ? zs[e] : sigmoidf_(zs[e]);
                *(uint4*)(LA + (size_t)pp * 256 + ch - 1536) = pack8(o);
            }
        }
    }
}
struct EpiDecay { float* DEC; const float* w0; int d;
    DEV void operator()(int r, int c, float v, float) const {
        const float x = -(w0[c] + v); const float sp = x > 20.f ? x : log1pf(expf(x)); const float w = -sp - 0.5f;
        DEC[((size_t)r * 2 + d) * 512 + c] = expf(-expf(w)); } };
struct EpiIclr { u16* KD; u16* BQ; const u16* KK; const u16* ZDb; const float* a0; const float* ka; const float* muk; int d;
    DEV void operator()(int r, int c, float v, float) const {
        const float a = sigmoidf_(a0[c] + v);
        const float k = shiftmix_at(ZDb, r, 512 + c, muk[c]);
        KD[((size_t)r * 2 + d) * 512 + c] = (u16)f2bf(k * (1.f + (a - 1.f) * ka[c]));
        BQ[((size_t)r * 2 + d) * 512 + c] = (u16)f2bf(bf2f(KK[(size_t)r * 512 + c]) * a); } };
struct EpiGate { u16* G; DEV void operator()(int r, int c, float v, float) const { G[(size_t)r * 512 + c] = (u16)f2bf(v); } };

DEV int pos_to_pp(int s, int d) { return (s < NCTX) ? (d ? SEQ + NCTX - 1 - s : SEQ + s) : (d ? SEQ - 1 - (s - NCTX) : s - NCTX); }
struct StepV { float d; unsigned a; unsigned b; float v; };
DEV StepV load_step(const float* DEC, const u16* KD, const u16* BQ, const u16* KK, const u16* R, const u16* V, int pp, int h, int d, int lane) {
    const size_t e1 = (size_t)pp * 512 + h * 64, e2 = ((size_t)pp * 2 + d) * 512 + h * 64;
    StepV s;
    s.d = DEC[e2 + lane];
    s.a = (lane < 32) ? ((const unsigned*)(KD + e2))[lane] : ((const unsigned*)(BQ + e2))[lane - 32];
    s.b = (lane < 32) ? ((const unsigned*)(KK + e1))[lane] : ((const unsigned*)(R + e1))[lane - 32];
    s.v = bf2f(V[e1 + lane]);
    return s;
}
typedef float f32x2 __attribute__((ext_vector_type(2)));
constexpr int SSLOT = 320;
typedef __attribute__((address_space(3))) float* ldsf;
typedef const __attribute__((address_space(3))) f32x4* lds4;
DEV void stage_step(ldsf slot, const StepV& s, int lane) {
    slot[lane] = s.d;
    *(__attribute__((address_space(3))) f32x2*)(slot + 64 + 2 * lane) = (f32x2){bflo(s.a), bfhi(s.a)};
    *(__attribute__((address_space(3))) f32x2*)(slot + 192 + 2 * lane) = (f32x2){bflo(s.b), bfhi(s.b)};
}
#define LO2(v) ((f32x2){(v)[0], (v)[1]})
#define HI2(v) ((f32x2){(v)[2], (v)[3]})
template <int MODE>
DEV float scan_step(f32x2 (&S)[32], ldsf sl, float vv) {
    lds4 D = (lds4)sl;
    f32x2 sa = {0.f, 0.f}, sb = {0.f, 0.f};
#pragma unroll
    for (int q = 0; q < 16; ++q) { const f32x4 k4 = D[48 + q]; sa += S[2 * q] * LO2(k4); sb += S[2 * q + 1] * HI2(k4);
        if ((q & 3) == 3) asm volatile("" : "+v"(D), "+v"(sa), "+v"(sb)); }
    const float nsa = -((sa[0] + sa[1]) + (sb[0] + sb[1]));
    const f32x2 nsa2 = {nsa, nsa}, vv2 = {vv, vv};
    f32x2 y = {0.f, 0.f}, z = {0.f, 0.f};
#pragma unroll
    for (int q = 0; q < 16; ++q) {
        const f32x4 d4 = D[q], b4 = D[32 + q];
        f32x2 t0 = nsa2 * LO2(b4), t1 = nsa2 * HI2(b4);
        if (MODE >= 1) { const f32x4 kd4 = D[16 + q]; t0 += vv2 * LO2(kd4); t1 += vv2 * HI2(kd4); }
        S[2 * q] = S[2 * q] * LO2(d4) + t0; S[2 * q + 1] = S[2 * q + 1] * HI2(d4) + t1;
        if (MODE == 2) { const f32x4 r4 = D[64 + q]; y += S[2 * q] * LO2(r4); z += S[2 * q + 1] * HI2(r4); }
        else y += S[2 * q + 1];
        if ((q & 1) == 1) asm volatile("" : "+v"(D), "+v"(y), "+v"(z), "+v"(S[2 * q + 1]));
    }
    return (y[0] + y[1]) + (z[0] + z[1]);
}
DEV void scan_step_pu(f32x2 (&P)[32], f32x2 (&U)[32], ldsf sl, float vv) {
    lds4 D = (lds4)sl;
    f32x2 pa = {0.f, 0.f}, pb = {0.f, 0.f}, ua = {0.f, 0.f}, ub = {0.f, 0.f};
#pragma unroll
    for (int q = 0; q < 16; ++q) { const f32x4 k4 = D[48 + q];
        pa += P[2 * q] * LO2(k4); pb += P[2 * q + 1] * HI2(k4); ua += U[2 * q] * LO2(k4); ub += U[2 * q + 1] * HI2(k4);
        if ((q & 3) == 3) asm volatile("" : "+v"(D), "+v"(pa), "+v"(pb), "+v"(ua), "+v"(ub)); }
    const float nsp = -((pa[0] + pa[1]) + (pb[0] + pb[1])), nsu = -((ua[0] + ua[1]) + (ub[0] + ub[1]));
    const f32x2 nsp2 = {nsp, nsp}, nsu2 = {nsu, nsu}, vv2 = {vv, vv};
#pragma unroll
    for (int q = 0; q < 16; ++q) {
        const f32x4 d4 = D[q], b4 = D[32 + q], kd4 = D[16 + q];
        P[2 * q] = P[2 * q] * LO2(d4) + nsp2 * LO2(b4); P[2 * q + 1] = P[2 * q + 1] * HI2(d4) + nsp2 * HI2(b4);
        U[2 * q] = U[2 * q] * LO2(d4) + (vv2 * LO2(kd4) + nsu2 * LO2(b4)); U[2 * q + 1] = U[2 * q + 1] * HI2(d4) + (vv2 * HI2(kd4) + nsu2 * HI2(b4));
        asm volatile("" : "+v"(D), "+v"(P[2 * q]), "+v"(P[2 * q + 1]), "+v"(U[2 * q]), "+v"(U[2 * q + 1]));
    }
}
DEV void phase_scan1(PPtr p, char* lds) {
    const int tid = tidx(), lane = tid & 63, wv = __builtin_amdgcn_readfirstlane(tid >> 6), gw = blockIdx.x * NWAVE + wv, ngw = gridDim.x * NWAVE;
    const float* DEC = (const float*)(p->ws + OFF_DEC); const u16* KD = (const u16*)(p->ws + OFF_KD); const u16* BQ = (const u16*)(p->ws + OFF_BQ);
    const u16* KK = (const u16*)(p->ws + OFF_KK); const u16* R = (const u16*)(p->ws + OFF_R); const u16* V = (const u16*)(p->ws + OFF_V);
    float* PU = (float*)(p->ws + OFF_PU);
    ldsf ring = (ldsf)lds + wv * (3 * SSLOT);
    for (int task = gw; task < 16 * NCH; task += ngw) {
        const int seq = task >> 7, c = task & 127, h = seq >> 1, d = seq & 1;
#define LD(st) load_step(DEC, KD, BQ, KK, R, V, pos_to_pp(c * CLEN + min((st), CLEN - 1), d), h, d, lane)
        f32x2 P[32], U[32];
        float lnf = (float)lane; asm volatile("" : "+v"(lnf));
#pragma unroll
        for (int j = 0; j < 32; ++j) { P[j] = (f32x2){fmaxf(1.f - fabsf(lnf - (float)(2 * j)), 0.f), fmaxf(1.f - fabsf(lnf - (float)(2 * j + 1)), 0.f)}; U[j] = (f32x2){0.f, 0.f}; }
        float vvA, vvB;
        { const StepV s0 = LD(0), s1 = LD(1); stage_step(ring, s0, lane); stage_step(ring + SSLOT, s1, lane); vvA = s0.v; vvB = s1.v; }
        StepV g0 = LD(2), g1 = LD(3), g2 = LD(4), g3 = LD(5);
        int cs = 0, ns = 2;
#pragma unroll 1
        for (int st = 0; st < CLEN; ++st) {
            scan_step_pu(P, U, ring + cs * SSLOT, vvA);
            stage_step(ring + ns * SSLOT, g0, lane);
            vvA = vvB; vvB = g0.v; g0 = g1; g1 = g2; g2 = g3; g3 = LD(st + 6);
            cs = (cs == 2) ? 0 : cs + 1; ns = (ns == 2) ? 0 : ns + 1;
        }
#undef LD
        float4* o = (float4*)(PU + ((size_t)task * 2) * 4096 + lane * 64);
#pragma unroll
        for (int j = 0; j < 16; ++j) { o[j] = (float4){P[2 * j][0], P[2 * j][1], P[2 * j + 1][0], P[2 * j + 1][1]}; o[1024 + j] = (float4){U[2 * j][0], U[2 * j][1], U[2 * j + 1][0], U[2 * j + 1][1]}; }
    }
}
#define S2_PLOAD(ent_, lo, hi) do { const float4* s_ = (const float4*)((ent_) + prow * 64 + pcol); lo = s_[0]; hi = s_[1]; } while (0)
#define S2_ULOAD(ent_, u_) do { const float* s_ = (ent_) + 4096; _Pragma("unroll") for (int t_ = 0; t_ < 2; ++t_) _Pragma("unroll") for (int j_ = 0; j_ < 4; ++j_) u_[t_][j_] = s_[(16 * rt + 4 * q + j_) * 64 + 16 * (ct0 + t_) + r]; } while (0)
#define S2_CSTORE(dst_, a0_, a1_) do { float* d_ = (dst_); _Pragma("unroll") for (int j_ = 0; j_ < 4; ++j_) { d_[(16 * rt + 4 * q + j_) * 64 + 16 * ct0 + r] = a0_[j_]; d_[(16 * rt + 4 * q + j_) * 64 + 16 * ct0 + 16 + r] = a1_[j_]; } } while (0)
#define S2_LSTORE(dst_, a0_, a1_) do { float* d_ = (dst_); _Pragma("unroll") for (int j_ = 0; j_ < 4; ++j_) { d_[(16 * rt + 4 * q + j_) * 68 + 16 * ct0 + r] = a0_[j_]; d_[(16 * rt + 4 * q + j_) * 68 + 16 * ct0 + 16 + r] = a1_[j_]; } } while (0)
DEV void phase_scan2a(PPtr p, char* lds) {
    if (blockIdx.x >= 128) return;
    const int tid = tidx(), lane = tid & 63, w = __builtin_amdgcn_readfirstlane(tid >> 6), seq = blockIdx.x >> 3, g = blockIdx.x & 7;
    float* sX = (float*)lds; float* sZ = sX + 2 * 64 * 68; float* sP = sZ + 2 * 64 * 68;
    float* PUg = (float*)(p->ws + OFF_PU) + (size_t)(seq * NCH + 16 * g) * 8192;
    float* TOT = (float*)(p->ws + OFF_LA) + (size_t)(seq * 8 + g) * 8192;
    const int rt = w >> 1, ct0 = (w & 1) * 2, r = lane & 15, q = lane >> 4;
    const int prow = tid >> 3, pcol = (tid & 7) * 8;
    for (int i = tid; i < 64 * 68; i += NTHR) { const int row = i / 68, col = i - row * 68; sX[i] = (row == col) ? 1.f : 0.f; sZ[i] = 0.f; }
    float4 pa0, pa1, pb0, pb1;
    { float4 t0, t1; S2_PLOAD(PUg, t0, t1); *(float4*)(sP + prow * 68 + pcol) = t0; *(float4*)(sP + prow * 68 + pcol + 4) = t1; }
    S2_PLOAD(PUg + 8192, pa0, pa1); S2_PLOAD(PUg + 2 * 8192, pb0, pb1);
    float ua[2][4], ub[2][4];
    S2_ULOAD(PUg, ua); S2_ULOAD(PUg + 8192, ub);
    __syncthreads();
    for (int jj = 0; jj < 16; ++jj) {
        const int cur = jj & 1;
        f32x4 x0 = {0.f, 0.f, 0.f, 0.f}, x1 = {0.f, 0.f, 0.f, 0.f};
        f32x4 z0 = {ua[0][0], ua[0][1], ua[0][2], ua[0][3]}, z1 = {ua[1][0], ua[1][1], ua[1][2], ua[1][3]};
        const float* Xc = sX + cur * (64 * 68); const float* Zc = sZ + cur * (64 * 68); const float* Pc = sP + cur * (64 * 68);
#pragma unroll
        for (int ks = 0; ks < 16; ++ks) {
            const float ax = Xc[(16 * rt + r) * 68 + 4 * ks + q], az = Zc[(16 * rt + r) * 68 + 4 * ks + q];
            const float b0 = Pc[(4 * ks + q) * 68 + 16 * ct0 + r], b1 = Pc[(4 * ks + q) * 68 + 16 * ct0 + 16 + r];
            x0 = __builtin_amdgcn_mfma_f32_16x16x4f32(ax, b0, x0, 0, 0, 0); x1 = __builtin_amdgcn_mfma_f32_16x16x4f32(ax, b1, x1, 0, 0, 0);
            z0 = __builtin_amdgcn_mfma_f32_16x16x4f32(az, b0, z0, 0, 0, 0); z1 = __builtin_amdgcn_mfma_f32_16x16x4f32(az, b1, z1, 0, 0, 0);
        }
        S2_LSTORE(sX + (cur ^ 1) * (64 * 68), x0, x1); S2_LSTORE(sZ + (cur ^ 1) * (64 * 68), z0, z1);
        S2_CSTORE(PUg + (size_t)jj * 8192, x0, x1); S2_CSTORE(PUg + (size_t)jj * 8192 + 4096, z0, z1);
        if (jj == 15) { S2_CSTORE(TOT, x0, x1); S2_CSTORE(TOT + 4096, z0, z1); }
        { float* Pn = sP + (cur ^ 1) * (64 * 68); *(float4*)(Pn + prow * 68 + pcol) = pa0; *(float4*)(Pn + prow * 68 + pcol + 4) = pa1; }
        pa0 = pb0; pa1 = pb1;
        S2_PLOAD(PUg + (size_t)min(jj + 3, 15) * 8192, pb0, pb1);
#pragma unroll
        for (int t = 0; t < 2; ++t)
#pragma unroll
            for (int j = 0; j < 4; ++j) ua[t][j] = ub[t][j];
        if (jj + 2 < 16) S2_ULOAD(PUg + (size_t)(jj + 2) * 8192, ub);
        __syncthreads();
    }
}
DEV void phase_scan2b(PPtr p, char* lds) {
    if (blockIdx.x >= 128) return;
    const int tid = tidx(), lane = tid & 63, w = __builtin_amdgcn_readfirstlane(tid >> 6), seq = blockIdx.x >> 3, g = blockIdx.x & 7;
    float* sS = (float*)lds; float* sP = sS + 2 * 64 * 68;
    float* PUg = (float*)(p->ws + OFF_PU) + (size_t)(seq * NCH + 16 * g) * 8192;
    float* TOTs = (float*)(p->ws + OFF_LA) + (size_t)(seq * 8) * 8192;
    const int rt = w >> 1, ct0 = (w & 1) * 2, r = lane & 15, q = lane >> 4;
    const int prow = tid >> 3, pcol = (tid & 7) * 8;
    const int T = g + 16;
#define S2_ENT(t_) ((min((t_), T - 1) < g) ? TOTs + (size_t)min((t_), T - 1) * 8192 : PUg + (size_t)(min((t_), T - 1) - g) * 8192)
    for (int i = tid; i < 64 * 68; i += NTHR) sS[i] = 0.f;
    float4 pa0, pa1, pb0, pb1;
    { float4 t0, t1; S2_PLOAD(S2_ENT(0), t0, t1); *(float4*)(sP + prow * 68 + pcol) = t0; *(float4*)(sP + prow * 68 + pcol + 4) = t1; }
    S2_PLOAD(S2_ENT(1), pa0, pa1); S2_PLOAD(S2_ENT(2), pb0, pb1);
    float ua[2][4], ub[2][4];
    S2_ULOAD(S2_ENT(0), ua); S2_ULOAD(S2_ENT(1), ub);
    f32x4 m0 = {0.f, 0.f, 0.f, 0.f}, m1 = {0.f, 0.f, 0.f, 0.f};
    int sb = 0;
    __syncthreads();
    for (int t = 0; t < T; ++t) {
        const int cur = t & 1; const bool chain = t < g;
        if (!chain) S2_CSTORE(PUg + (size_t)(t - g) * 8192 + 4096, m0, m1);
        f32x4 a0 = {ua[0][0], ua[0][1], ua[0][2], ua[0][3]}, a1 = {ua[1][0], ua[1][1], ua[1][2], ua[1][3]};
        const float* Sc = sS + sb * (64 * 68); const float* Pc = sP + cur * (64 * 68);
#pragma unroll
        for (int ks = 0; ks < 16; ++ks) {
            const float av = Sc[(16 * rt + r) * 68 + 4 * ks + q];
            const float b0 = Pc[(4 * ks + q) * 68 + 16 * ct0 + r], b1 = Pc[(4 * ks + q) * 68 + 16 * ct0 + 16 + r];
            a0 = __builtin_amdgcn_mfma_f32_16x16x4f32(av, b0, a0, 0, 0, 0);
            a1 = __builtin_amdgcn_mfma_f32_16x16x4f32(av, b1, a1, 0, 0, 0);
        }
        m0 = a0; m1 = a1;
        if (chain) { S2_LSTORE(sS + (sb ^ 1) * (64 * 68), a0, a1); sb ^= 1; }
        { float* Pn = sP + (cur ^ 1) * (64 * 68); *(float4*)(Pn + prow * 68 + pcol) = pa0; *(float4*)(Pn + prow * 68 + pcol + 4) = pa1; }
        pa0 = pb0; pa1 = pb1;
        S2_PLOAD(S2_ENT(t + 3), pb0, pb1);
#pragma unroll
        for (int u = 0; u < 2; ++u)
#pragma unroll
            for (int j = 0; j < 4; ++j) ua[u][j] = ub[u][j];
        if (t + 2 < T) S2_ULOAD(S2_ENT(t + 2), ub);
        __syncthreads();
    }
#undef S2_ENT
}
DEV void phase_scan3(PPtr p, char* lds) {
    const int tid = tidx(), lane = tid & 63, wv = __builtin_amdgcn_readfirstlane(tid >> 6), gw = blockIdx.x * NWAVE + wv, ngw = gridDim.x * NWAVE;
    const float* DEC = (const float*)(p->ws + OFF_DEC); const u16* KD = (const u16*)(p->ws + OFF_KD); const u16* BQ = (const u16*)(p->ws + OFF_BQ);
    const u16* KK = (const u16*)(p->ws + OFF_KK); const u16* R = (const u16*)(p->ws + OFF_R); const u16* V = (const u16*)(p->ws + OFF_V);
    const float* PU = (const float*)(p->ws + OFF_PU);
    ldsf ring = (ldsf)lds + wv * (3 * SSLOT);
    for (int task = gw; task < 16 * NCH; task += ngw) {
        const int seq = task >> 7, c = task & 127, h = seq >> 1, d = seq & 1;
        float* Yd = (float*)(p->ws + (d ? OFF_ZD : OFF_Y0));
        f32x2 S[32];
        {
            const float4* si = (const float4*)(PU + ((size_t)task * 2 + 1) * 4096 + lane * 64);
#pragma unroll
            for (int j = 0; j < 16; ++j) { const float4 t = si[j]; S[2 * j] = (f32x2){t.x, t.y}; S[2 * j + 1] = (f32x2){t.z, t.w}; }
        }
#define LD(st) load_step(DEC, KD, BQ, KK, R, V, pos_to_pp(c * CLEN + min((st), CLEN - 1), d), h, d, lane)
#define YADD(st, y) (Yd[(size_t)pos_to_pp(c * CLEN + (st), d) * 512 + h * 64 + lane] = (y))
        float vvA, vvB;
        { const StepV s0 = LD(0), s1 = LD(1); stage_step(ring, s0, lane); stage_step(ring + SSLOT, s1, lane); vvA = s0.v; vvB = s1.v; }
        StepV g0 = LD(2), g1 = LD(3), g2 = LD(4), g3 = LD(5);
        int cs = 0, ns = 2;
#pragma unroll 1
        for (int st = 0; st < CLEN; ++st) {
            const float y = scan_step<2>(S, ring + cs * SSLOT, vvA); YADD(st, y);
            stage_step(ring + ns * SSLOT, g0, lane);
            vvA = vvB; vvB = g0.v; g0 = g1; g1 = g2; g2 = g3; g3 = LD(st + 6);
            cs = (cs == 2) ? 0 : cs + 1; ns = (ns == 2) ? 0 : ns + 1;
        }
#undef LD
#undef YADD
    }
}
DEV void phase_readout(PPtr p, int li, int bb) {
    const int tid = tidx(), lane = tid & 63, gw = blockIdx.x * NWAVE + (tid >> 6), ngw = gridDim.x * NWAVE;
    const float* Y0 = (const float*)(p->ws + OFF_Y0);
    const u16* KD = (const u16*)(p->ws + OFF_KD); const u16* R = (const u16*)(p->ws + OFF_R); const u16* V = (const u16*)(p->ws + OFF_V); const u16* G = (const u16*)(p->ws + OFF_G);
    const float* rk = p->in[24] + li * 512; const float* lnw = p->in[25] + li * 512; const float* lnb = p->in[26] + li * 512;
    u16* AO = (u16*)(p->ws + OFF_AO);
    const int c = 8 * lane;
    float rkv[8], lw[8], lb[8];
    { const float4 a = *(const float4*)(rk + c), b = *(const float4*)(rk + c + 4); rkv[0] = a.x; rkv[1] = a.y; rkv[2] = a.z; rkv[3] = a.w; rkv[4] = b.x; rkv[5] = b.y; rkv[6] = b.z; rkv[7] = b.w; }
    { const float4 a = *(const float4*)(lnw + c), b = *(const float4*)(lnw + c + 4); lw[0] = a.x; lw[1] = a.y; lw[2] = a.z; lw[3] = a.w; lw[4] = b.x; lw[5] = b.y; lw[6] = b.z; lw[7] = b.w; }
    { const float4 a = *(const float4*)(lnb + c), b = *(const float4*)(lnb + c + 4); lb[0] = a.x; lb[1] = a.y; lb[2] = a.z; lb[3] = a.w; lb[4] = b.x; lb[5] = b.y; lb[6] = b.z; lb[7] = b.w; }
    for (int pp = gw; pp < RPB; pp += ngw) {
        const size_t m = (size_t)bb * RPB + pp, e = (size_t)pp * 512 + c;
        const float* Y1 = (const float*)(p->ws + OFF_ZD);
        const float4 ya = *(const float4*)(Y0 + e), yb = *(const float4*)(Y0 + e + 4), yc = *(const float4*)(Y1 + e), yd = *(const float4*)(Y1 + e + 4);
        const float y[8] = {ya.x + yc.x, ya.y + yc.y, ya.z + yc.z, ya.w + yc.w, yb.x + yd.x, yb.y + yd.y, yb.z + yd.z, yb.w + yd.w};
        float r[8], k0[8], k1[8], v[8], g[8];
        unpack8(*(const uint4*)(R + e), r); unpack8(*(const uint4*)(KD + ((size_t)pp * 2) * 512 + c), k0); unpack8(*(const uint4*)(KD + ((size_t)pp * 2 + 1) * 512 + c), k1);
        unpack8(*(const uint4*)(V + e), v); unpack8(*(const uint4*)(G + e), g);
        float sm = 0.f, bs = 0.f;
#pragma unroll
        for (int j = 0; j < 8; ++j) { sm += y[j]; bs += r[j] * (k0[j] + k1[j]) * rkv[j]; }
        sm += __shfl_xor(sm, 1); sm += __shfl_xor(sm, 2); sm += __shfl_xor(sm, 4);
        bs += __shfl_xor(bs, 1); bs += __shfl_xor(bs, 2); bs += __shfl_xor(bs, 4);
        const float mean = sm * (1.f / 64.f);
        float vs = 0.f;
#pragma unroll
        for (int j = 0; j < 8; ++j) { const float dv = y[j] - mean; vs += dv * dv; }
        vs += __shfl_xor(vs, 1); vs += __shfl_xor(vs, 2); vs += __shfl_xor(vs, 4);
        const float rstd = rsqrtf(vs * (1.f / 64.f) + 64e-5f);
        float o[8];
#pragma unroll
        for (int j = 0; j < 8; ++j) o[j] = ((y[j] - mean) * rstd * lw[j] + lb[j] + bs * v[j]) * g[j];
        *(uint4*)(AO + m * DM + 512 + c) = pack8(o);
    }
}
DEV void phase_final(PPtr p) {
    const int lane = tidx() & 63, gw = blockIdx.x * NWAVE + (tidx() >> 6), ngw = gridDim.x * NWAVE;
    const float* gain = p->in[29];
    for (int m = gw; m < NB * SEQ; m += ngw) {
        float4* xr = (float4*)(p->out + (size_t)m * DM);
        float4 v[4]; float ss = 0.f;
#pragma unroll
        for (int j = 0; j < 4; ++j) { v[j] = xr[lane + 64 * j]; ss += v[j].x * v[j].x + v[j].y * v[j].y + v[j].z * v[j].z + v[j].w * v[j].w; }
        ss = wave_sum(ss);
        const float rstd = rsqrtf(ss * (1.f / DM) + 1e-6f);
#pragma unroll
        for (int j = 0; j < 4; ++j) {
            const float4 g = *(const float4*)(gain + (lane + 64 * j) * 4);
            float4 o; o.x = v[j].x * rstd * g.x; o.y = v[j].y * rstd * g.y; o.z = v[j].z * rstd * g.z; o.w = v[j].w * rstd * g.w;
            xr[lane + 64 * j] = o;
        }
    }
}

#define LAS __attribute__((address_space(3)))
#define XB_TMO      128
#define XB_XCNT(j)  (256  + 64 * (j))
#define XB_XSUB(j)  (1280 + 64 * (j))
#define XB_XGEN(j)  (2304 + 64 * (j))
#define XB_TOP      3328
#define XB_TOPGEN   3392
#define XCD_BAR_WORDS 3456
#define XB_SPIN_CAP (1u << 18)

__device__ __forceinline__ unsigned xb_ld(unsigned* p)              { return __hip_atomic_load(p, __ATOMIC_RELAXED, __HIP_MEMORY_SCOPE_AGENT); }
__device__ __forceinline__ unsigned xb_add(unsigned* p, unsigned v) { return __hip_atomic_fetch_add(p, v, __ATOMIC_RELAXED, __HIP_MEMORY_SCOPE_AGENT); }
__device__ __forceinline__ unsigned xb_xcc_id() { return (unsigned)__builtin_amdgcn_s_getreg((3 << 11) | 20) & 0xFu; }
#define XB_SPIN(cond, bar) do { unsigned _sp = 0; while (cond) { __builtin_amdgcn_s_sleep(1); \
    if ((++_sp & 255u) == 0u) { if (xb_ld(&(bar)[XB_TMO])) break; if (_sp > XB_SPIN_CAP) { atomicAdd(&(bar)[XB_TMO], 1u); break; } } } } while (0)

struct XcdBarrier {
    unsigned* bar; unsigned x;
    volatile LAS unsigned* st;
};

__device__ __forceinline__ XcdBarrier xcd_barrier_post(unsigned* bar, volatile LAS unsigned* st) {
    XcdBarrier b; b.bar = bar; b.x = xb_xcc_id(); b.st = st;
    if (threadIdx.x == 0) (void)xb_add(&bar[XB_XCNT(b.x)], 1u);
    return b;
}
__device__ __forceinline__ void xcd_barrier_complete(unsigned* bar, unsigned x, unsigned& nloc, unsigned& nx) {
    const unsigned G = gridDim.x * gridDim.y * gridDim.z;
    unsigned sum, cnt, mine, sp = 0u;
    for (;;) {
        sum = 0u; cnt = 0u; mine = 0u;
#pragma unroll
        for (unsigned j = 0; j < 16; ++j) { const unsigned c = xb_ld(&bar[XB_XCNT(j)]); sum += c; cnt += (c > 0u) ? 1u : 0u; mine = (j == x) ? c : mine; }
        if (sum == G) break;
        __builtin_amdgcn_s_sleep(1);
        if ((++sp & 255u) == 0u) { if (xb_ld(&bar[XB_TMO])) break; if (sp > XB_SPIN_CAP) { atomicAdd(&bar[XB_TMO], 1u); break; } }
    }
    nloc = mine > 0u ? mine : 1u; nx = cnt > 0u ? cnt : 1u;
}

__device__ __forceinline__ void xcd_barrier(const XcdBarrier& b) {
    asm volatile("s_waitcnt vmcnt(0)" ::: "memory");
    __syncthreads();
    if (threadIdx.x == 0) {
        unsigned* bar = b.bar;
        __builtin_amdgcn_s_waitcnt(0);
        unsigned nloc = b.st[0], nx = b.st[1];
        if (nloc == 0u) { xcd_barrier_complete(bar, b.x, nloc, nx); b.st[0] = nloc; b.st[1] = nx; }
        const unsigned old = xb_add(&bar[XB_XSUB(b.x)], 1u);
        const unsigned gen = old / nloc;
        if (old + 1u == (gen + 1u) * nloc) {
            __builtin_amdgcn_fence(__ATOMIC_RELEASE, "agent");
            asm volatile("s_waitcnt vmcnt(0)" ::: "memory");
            const unsigned og = xb_add(&bar[XB_TOP], 1u);
            const unsigned tg = og / nx;
            if (og + 1u == (tg + 1u) * nx) xb_add(&bar[XB_TOPGEN], 1u);
            else XB_SPIN(xb_ld(&bar[XB_TOPGEN]) == tg, bar);
            __builtin_amdgcn_fence(__ATOMIC_ACQUIRE, "agent");
            xb_add(&bar[XB_XGEN(b.x)], 1u);
            asm volatile("s_waitcnt vmcnt(0)" ::: "memory");
        } else {
            XB_SPIN(xb_ld(&bar[XB_XGEN(b.x)]) == gen, bar);
            __builtin_amdgcn_fence(__ATOMIC_ACQUIRE, "agent");
            asm volatile("s_waitcnt vmcnt(0)" ::: "memory");
        }
    }
    __syncthreads();
}


constexpr size_t OFF_BAR = 768 * 1024;
DEV void gbar(PPtr kp_, unsigned& nbar) {
    asm volatile("s_waitcnt vmcnt(0)" ::: "memory");
    __syncthreads();
    if (threadIdx.x == 0) {
        unsigned* ctr = (unsigned*)(kp_->ws + OFF_BAR);
        __builtin_amdgcn_fence(__ATOMIC_RELEASE, "agent");
        asm volatile("s_waitcnt vmcnt(0)" ::: "memory");
        ++nbar;
        __hip_atomic_fetch_add(ctr, 1u, __ATOMIC_RELAXED, __HIP_MEMORY_SCOPE_AGENT);
        const unsigned target = nbar * gridDim.x;
        while (__hip_atomic_load(ctr, __ATOMIC_RELAXED, __HIP_MEMORY_SCOPE_AGENT) < target) __builtin_amdgcn_s_sleep(1);
        __builtin_amdgcn_fence(__ATOMIC_ACQUIRE, "agent");
        asm volatile("s_waitcnt vmcnt(0)" ::: "memory");
    }
    __syncthreads();
}
#define p launder(kp)
#define SYNC() xcd_barrier(nbar)
template <int bb>
DEV void do_rwkv_batch(PPtr kp, const XcdBarrier& nbar, char* lds, int li) {
    unsigned char* ws = launder(kp)->ws;
    u16* ZD = (u16*)(ws + OFF_ZD);
                phase_rwkv_prep(p, li, bb); SYNC();
                const u16* LA = (const u16*)(ws + OFF_LA); const u16* ZDb = ZD + (size_t)bb * RPB * ZDW;
                { pg8::EpiLoraT e{(float*)(ws + OFF_DEC), (u16*)(ws + OFF_KD), (u16*)(ws + OFF_BQ), (u16*)(ws + OFF_G), (const u16*)(ws + OFF_KK), ZDb,
                                  p->in[17] + (size_t)li * 1024, p->in[19] + (size_t)li * 1024, p->in[23] + li * 512, p->in[16] + li * ZDW + 512};
                  int kl_ = 256; asm volatile("" : "+s"(kl_));
                  pg8::Gemm g_{(const pg8::bf16_t*)LA, (const pg8::bf16_t*)(ws + OFF_PU), RPB, 2560, kl_}; pg8::StaticOrder S_; S_.init(RPB, 2560, (int)gridDim.x, (int)blockIdx.x);
                  pg8::gemm_phase<pg8::EpiLoraT, pg8::StaticOrder, true, true>((PG8_LAS unsigned char*)lds, g_, S_, e); }
                SYNC();
                phase_scan1(p, lds); SYNC();
                phase_scan2a(p, lds); SYNC();
                phase_scan2b(p, lds); SYNC();
                phase_scan3(p, lds); SYNC();
                phase_readout(p, li, bb); SYNC();
            }
template <int layer>
DEV void do_layer(PPtr kp, const XcdBarrier& nbar, char* lds) {
    unsigned char* ws = launder(kp)->ws;
    const float* mod = (const float*)(ws + OFF_MOD);
    u16* HN = (u16*)(ws + OFF_HN); u16* AO = (u16*)(ws + OFF_AO); u16* RAW = (u16*)(ws + OFF_RAW); u16* ZD = (u16*)(ws + OFF_ZD);
        const int li = layer >> 1;
        const float* lmod = mod + (size_t)layer * 3 * 6144;
        phase_wprep(p, layer, lds); phase_normmod(p, layer, 0); SYNC();
        const pg8::bf16_t* WB = (const pg8::bf16_t*)(ws + OFF_WB);
#define GEMM8(A_, B_, N_, K_, E_) do { pg8::Gemm g_{(const pg8::bf16_t*)(A_), (B_), MROWS, (N_), (K_)}; pg8::StaticOrder S_; S_.init(MROWS, (N_), (int)gridDim.x, (int)blockIdx.x); \
            pg8::gemm_phase<decltype(E_), pg8::StaticOrder, true, true>((PG8_LAS unsigned char*)lds, g_, S_, E_); } while (0)
#define GEMM8L(A_, B_, N_, K_, E_) do { pg8::Gemm g_{(const pg8::bf16_t*)(A_), (B_), MROWS, (N_), (K_)}; pg8::LatentOrder S_; S_.init((N_), (int)gridDim.x, (int)blockIdx.x); \
            pg8::gemm_phase<decltype(E_), pg8::LatentOrder, true, true>((PG8_LAS unsigned char*)lds, g_, S_, E_); } while (0)
        if (!(layer & 1)) {
            { pg8::EpiStoreT e{RAW, 1536, 1 << 30, RAW, 1536}; GEMM8(HN, WB + WB_IN, 1536, DM, e); } SYNC();
            phase_even_post(p, li); SYNC();
            phase_attn_even(p, li, lds); SYNC();
            { pg8::EpiResidT e{p, lmod + 2048}; GEMM8(AO, WB + WB_OUT, DM, DM, e); } SYNC();
        } else {
            { pg8::EpiStoreT e{RAW, 1536, 1536, ZD, ZDW}; GEMM8(HN, WB + WB_IN, 3328, DM, e); } SYNC();
            phase_attn_odd(p, li, lds); SYNC();
            do_rwkv_batch<0>(kp, nbar, lds, li);
            do_rwkv_batch<1>(kp, nbar, lds, li);
            if (layer == 3) { pg8::EpiResidT e{p, lmod + 2048}; GEMM8L(AO, WB + WB_OUT, DM, DM, e); }
            else { pg8::EpiResidT e{p, lmod + 2048}; GEMM8(AO, WB + WB_OUT, DM, DM, e); }
            SYNC();
        }
        phase_normmod(p, layer, 1); SYNC();
        if (layer == 3) { pg8::EpiSwigluT e{RAW}; GEMM8L(HN, WB + WB_F1, 5632, DM, e); }
        else { pg8::EpiSwigluT e{RAW}; GEMM8(HN, WB + WB_F1, 5632, DM, e); }
        SYNC();
        if (layer == 3) { pg8::EpiResidT e{p, lmod + 5120}; GEMM8L(RAW, WB + WB_F2, DM, FFH, e); }
        else { pg8::EpiResidT e{p, lmod + 5120}; GEMM8(RAW, WB + WB_F2, DM, FFH, e); }
        SYNC();
    }
__global__ void __launch_bounds__(NTHR) mega(Params p_unused) {
    PPtr kp = (PPtr)__builtin_amdgcn_kernarg_segment_ptr();
    extern __shared__ __attribute__((aligned(16))) char lds[];
    cg::grid_group grid = cg::this_grid();
    volatile LAS unsigned* xst = (volatile LAS unsigned*)((LAS char*)lds + (LDS_BYTES - 16));
    if (threadIdx.x < 4) xst[threadIdx.x] = 0u;
    __syncthreads();
    const XcdBarrier nbar = xcd_barrier_post((unsigned*)(launder(kp)->ws + OFF_BAR), xst);
    grid.sync();
    phase_init(p, lds); SYNC();
    do_layer<0>(kp, nbar, lds);
    do_layer<1>(kp, nbar, lds);
    do_layer<2>(kp, nbar, lds);
    do_layer<3>(kp, nbar, lds);
    phase_final(p);
}
#undef p
#undef SYNC

extern "C" void kernel_launch(void* const* d_in, const int* in_sizes, int n_in, void* d_out, int out_size, void* d_ws, size_t ws_size, hipStream_t stream) {
    static int grid = 0;
    if (grid == 0) {
        if (n_in != 30 || ws_size < WS_NEED || out_size != NB * SEQ * DM) { fprintf(stderr, "kernel_launch: unexpected problem shape (n_in %d ws %zu out %d)\n", n_in, ws_size, out_size); grid = -1; return; }
        int dev = 0, cus = 0, per_cu = 0;
        hipGetDevice(&dev);
        hipDeviceGetAttribute(&cus, hipDeviceAttributeMultiprocessorCount, dev);
        hipFuncSetAttribute((const void*)mega, hipFuncAttributeMaxDynamicSharedMemorySize, LDS_BYTES);
        hipOccupancyMaxActiveBlocksPerMultiprocessor(&per_cu, (const void*)mega, NTHR, LDS_BYTES);
        if (per_cu < 1) per_cu = 1;
        if (per_cu > 1) per_cu = 1;
        grid = cus * per_cu;
    }
    if (grid < 0) return;
    Params p{};
    for (int i = 0; i < 30; ++i) p.in[i] = (const float*)d_in[i];
    p.out = (float*)d_out; p.ws = (unsigned char*)d_ws;
    hipMemsetAsync((char*)d_ws + OFF_BAR, 0, XCD_BAR_WORDS * 4, stream);
    void* args[] = {&p};
    hipError_t e = hipLaunchCooperativeKernel((const void*)mega, dim3(grid), dim3(NTHR), args, LDS_BYTES, stream);
    if (e != hipSuccess) fprintf(stderr, "cooperative launch failed: %s (grid %d)\n", hipGetErrorString(e), grid);
}
```
